# Optimizing an MI355X kernel written in HIP

```python
import math
import jax, jax.numpy as jnp
from jax import lax
import numpy as np

D_MODEL = 2048
BATCH = 2
SEQ = 8192
DEPTH = 2

GRID_W = 64
CTX_LEN = 256
EPS = 1e-6
MASK_VALUE = -1e30

HEAD_DIM = 128
NA_WIDTH = D_MODEL // 4
NA_HEADS = NA_WIDTH // HEAD_DIM
NA_WIN_R = 8
NA_WIN_C = 16
WA_WIDTH = D_MODEL // 4
WA_HEADS = WA_WIDTH // HEAD_DIM
WA_KV_HEADS = 2
WA_KV_WIDTH = WA_KV_HEADS * HEAD_DIM
WA_WINDOW = 128
WA_BLOCK = 128
ROPE_BASE = 10000.0
SSD_D_INNER = D_MODEL // 2
SSD_HEAD_DIM = 64
SSD_HEADS = SSD_D_INNER // SSD_HEAD_DIM
SSD_GROUPS = 2
SSD_D_STATE = 128
SSD_CONV = 5
SSD_CHUNK = 128
SSD_XBC_WIDTH = SSD_D_INNER + 2 * SSD_GROUPS * SSD_D_STATE
MIX_WIDTH = NA_WIDTH + WA_WIDTH + SSD_D_INNER
IN_SIZES = (NA_WIDTH, NA_WIDTH, NA_WIDTH, WA_WIDTH, WA_KV_WIDTH, WA_KV_WIDTH, SSD_D_INNER, SSD_XBC_WIDTH, 2 * SSD_HEADS)
IN_WIDTH = 3 * NA_WIDTH + WA_WIDTH + 2 * WA_KV_WIDTH + SSD_D_INNER + SSD_XBC_WIDTH + 2 * SSD_HEADS
N_EXPERTS = 32
N_EXPERT_GROUPS = 4
EXPERTS_PER_GROUP = N_EXPERTS // N_EXPERT_GROUPS
TOP_K = 2
D_FF_EXPERT = D_MODEL // 2
MOE_BLOCK = 128

kernel_name = 'hybrid_na_swa_ssd_moe_dit'

f32 = jnp.float32


def rms_norm(x, gain):
    xf = x.astype(f32)
    y = xf * lax.rsqrt(jnp.mean(xf * xf, axis=-1, keepdims=True) + EPS)
    return (y * gain.astype(f32)).astype(x.dtype)


def split_columns(u):
    parts, off = [], 0
    for size in IN_SIZES:
        parts.append(u[..., off:off + size])
        off += size
    return parts


def heads(t, n):
    return t.reshape(t.shape[0], t.shape[1], n, HEAD_DIM)


def axial_rope_tables(n_tokens):
    t = jnp.arange(n_tokens, dtype=jnp.int32)
    m = HEAD_DIM // 4
    inv = jnp.power(ROPE_BASE, -jnp.arange(m, dtype=f32) / m)
    ang_r = (t // GRID_W).astype(f32)[:, None] * inv
    ang_c = (t % GRID_W).astype(f32)[:, None] * inv
    return (jnp.cos(ang_r), jnp.sin(ang_r), jnp.cos(ang_c), jnp.sin(ang_c))


def rope_1d(x, cos, sin):
    x1, x2 = jnp.split(x, 2, axis=-1)
    cos = cos[:, None, :].astype(x.dtype)
    sin = sin[:, None, :].astype(x.dtype)
    return jnp.concatenate([x1 * cos - x2 * sin, x2 * cos + x1 * sin], axis=-1)


def axial_rope(x, rope):
    cos_r, sin_r, cos_c, sin_c = rope
    xr, xc = jnp.split(x, 2, axis=-1)
    return jnp.concatenate([rope_1d(xr, cos_r, sin_r), rope_1d(xc, cos_c, sin_c)], axis=-1)


def context_attention(q, k, v, sink):
    b, l = q.shape[:2]
    s = jnp.einsum('blhgd,bmhd->bhglm', q, k).astype(f32) * (q.shape[-1] ** -0.5)
    if sink is not None:
        s = jnp.concatenate([s, jnp.broadcast_to(sink.astype(f32)[None, :, :, None, None], s.shape[:-1] + (1,))], axis=-1)
    p = jax.nn.softmax(s, axis=-1)
    if sink is not None:
        p = p[..., :-1]
    o = jnp.einsum('bhglm,bmhd->blhgd', p.astype(v.dtype), v)
    return o.reshape(b, l, -1)


def neighbourhood_attention(q, k, v, kc, vc, rpb):
    b, s, h, dh = q.shape
    rows = s // GRID_W
    kr = min(NA_WIN_R, rows)
    r = jnp.arange(rows)
    key_rows = jnp.clip(r - kr // 2, 0, rows - kr)[:, None] + jnp.arange(kr)[None, :]
    grid = lambda t: t.reshape(b, rows, GRID_W, h, dh)
    nk = kr * GRID_W
    kg = jnp.take(grid(k), key_rows, axis=1).reshape(b, rows, nk, h, dh)
    vg = jnp.take(grid(v), key_rows, axis=1).reshape(b, rows, nk, h, dh)
    col = jnp.arange(GRID_W)
    c0 = jnp.clip(col - NA_WIN_C // 2, 0, GRID_W - NA_WIN_C)
    col_ok = (col[None, :] >= c0[:, None]) & (col[None, :] < c0[:, None] + NA_WIN_C)
    dr = key_rows - r[:, None] + NA_WIN_R - 1
    dc = jnp.clip(col[None, :] - col[:, None] + NA_WIN_C - 1, 0, 2 * NA_WIN_C - 2)
    bias = rpb.astype(f32)[:, dr[:, None, :, None], dc[None, :, None, :]]
    bias = jnp.where(col_ok[None, None, :, None, :], bias, MASK_VALUE).reshape(h, rows, GRID_W, nk)
    scale = dh ** -0.5
    qg = grid(q)
    s_loc = jnp.einsum('brqhd,brkhd->bhrqk', qg, kg).astype(f32) * scale + bias
    s_ctx = jnp.einsum('brqhd,bchd->bhrqc', qg, kc).astype(f32) * scale
    p = jax.nn.softmax(jnp.concatenate([s_loc, s_ctx], axis=-1), axis=-1).astype(v.dtype)
    o = jnp.einsum('bhrqk,brkhd->brqhd', p[..., :nk], vg) + jnp.einsum('bhrqc,bchd->brqhd', p[..., nk:], vc)
    return o.reshape(b, s, h * dh)


def window_attention(q, k, v, kc, vc, sink):
    b, s, hq, dh = q.shape
    hkv = k.shape[2]
    g = hq // hkv
    nb = s // WA_BLOCK
    nk = WA_BLOCK + 2 * WA_WINDOW
    band = jnp.arange(nb)[:, None] * WA_BLOCK + jnp.arange(nk)[None, :]
    pad = ((0, 0), (WA_WINDOW, WA_WINDOW), (0, 0), (0, 0))
    kb = jnp.take(jnp.pad(k, pad), band, axis=1)
    vb = jnp.take(jnp.pad(v, pad), band, axis=1)
    qpos = jnp.arange(s).reshape(nb, WA_BLOCK)
    kpos = band - WA_WINDOW
    ok = (jnp.abs(qpos[:, :, None] - kpos[:, None, :]) <= WA_WINDOW) & (kpos[:, None, :] >= 0) & (kpos[:, None, :] < s)
    qb = q.reshape(b, nb, WA_BLOCK, hkv, g, dh)
    scale = dh ** -0.5
    s_loc = jnp.where(ok, jnp.einsum('bnqhgd,bnkhd->bhgnqk', qb, kb).astype(f32) * scale, MASK_VALUE)
    s_ctx = jnp.einsum('bnqhgd,bchd->bhgnqc', qb, kc).astype(f32) * scale
    sink_col = jnp.broadcast_to(sink.astype(f32).reshape(1, hkv, g, 1, 1, 1), s_loc.shape[:-1] + (1,))
    p = jax.nn.softmax(jnp.concatenate([s_loc, s_ctx, sink_col], axis=-1), axis=-1).astype(v.dtype)
    cl = kc.shape[1]
    o = jnp.einsum('bhgnqk,bnkhd->bnqhgd', p[..., :nk], vb) + jnp.einsum('bhgnqc,bchd->bnqhgd', p[..., nk:nk + cl], vc)
    return o.reshape(b, s, hq * dh)


def centred_dwconv(x, w, bias):
    kw, ch = w.shape
    pad = kw // 2
    y = lax.conv_general_dilated(x, w[:, None, :].astype(x.dtype), window_strides=(1,), padding=[(pad, kw - 1 - pad)],
                                 dimension_numbers=('NWC', 'WIO', 'NWC'), feature_group_count=ch)
    return y + bias.astype(x.dtype)


def ssd_inputs(xbc, dt_raw, conv_w, conv_b, dt_bias):
    xbc = jax.nn.silu(centred_dwconv(xbc, conv_w, conv_b)).astype(f32)
    b, l, _ = xbc.shape
    xs, bm, cm = jnp.split(xbc, [SSD_D_INNER, SSD_D_INNER + SSD_GROUPS * SSD_D_STATE], axis=-1)
    xs = xs.reshape(b, l, SSD_HEADS, SSD_HEAD_DIM)
    bm = bm.reshape(b, l, SSD_GROUPS, SSD_D_STATE)
    cm = cm.reshape(b, l, SSD_GROUPS, SSD_D_STATE)
    dt = jax.nn.softplus(dt_raw.astype(f32).reshape(b, l, 2, SSD_HEADS) + dt_bias.astype(f32))
    return (xs, bm, cm, dt)


def _ssd_chunks(x, dt, a, bm):
    b, l, h, p = x.shape
    g, n = bm.shape[2], bm.shape[3]
    k = h // g
    nc = l // SSD_CHUNK
    xc = x.reshape(b, nc, SSD_CHUNK, g, k, p)
    dtc = dt.reshape(b, nc, SSD_CHUNK, g, k)
    bc = bm.reshape(b, nc, SSD_CHUNK, g, n)
    acs = jnp.cumsum(dtc * a.reshape(g, k), axis=2)
    states = jnp.einsum('bclgn,bclgkp->bcgkpn', bc, xc * (jnp.exp(acs[:, :, -1:] - acs) * dtc)[..., None])
    return xc, dtc, acs, states.reshape(b, nc, h, p, n), jnp.exp(acs[:, :, -1]).reshape(b, nc, h)


def _ssd_state_scan(states, chunk_decay, h0):
    def step(hc, inp):
        st, dec = inp
        return dec[..., None, None] * hc + st, hc
    h_final, h_start = lax.scan(step, h0, (jnp.swapaxes(states, 0, 1), jnp.swapaxes(chunk_decay, 0, 1)))
    return jnp.swapaxes(h_start, 0, 1), h_final


def ssd_final_state(x, dt, a, bm, h0):
    _, _, _, states, decay = _ssd_chunks(x, dt, a, bm)
    return _ssd_state_scan(states, decay, h0)[1]


def ssd_scan(x, dt, a, bm, cm, d_skip, h0):
    b, l, h, p = x.shape
    g, n = bm.shape[2], bm.shape[3]
    k = h // g
    nc = l // SSD_CHUNK
    xc, dtc, acs, states, decay = _ssd_chunks(x, dt, a, bm)
    h_start, h_final = _ssd_state_scan(states, decay, h0)
    bc = bm.reshape(b, nc, SSD_CHUNK, g, n)
    cc = cm.reshape(b, nc, SSD_CHUNK, g, n)
    cb = jnp.einsum('bclgn,bcsgn->bcgls', cc, bc)
    acs_t = jnp.moveaxis(acs, 2, -1)
    dt_t = jnp.moveaxis(dtc, 2, -1)
    causal_in_chunk = jnp.tril(jnp.ones((SSD_CHUNK, SSD_CHUNK), dtype=bool))
    seg = jnp.exp(jnp.where(causal_in_chunk, acs_t[..., :, None] - acs_t[..., None, :], -jnp.inf))
    y = jnp.einsum('bcgkls,bcsgkp->bclgkp', cb[:, :, :, None] * seg * dt_t[..., None, :], xc)
    y = y + jnp.einsum('bclgn,bcgkpn->bclgkp', cc, h_start.reshape(b, nc, g, k, p, n)) * jnp.exp(acs)[..., None]
    return y.reshape(b, l, h, p) + x * d_skip[:, None], h_final


def bidirectional_ssd(lat, ctx, a_log, d_skip, ctx_out):
    xl, bl, cl, dtl = lat
    xc, bc, cc, dtc = ctx
    a = -jnp.exp(a_log.astype(f32))
    d = d_skip.astype(f32)
    h0 = jnp.zeros((xl.shape[0], SSD_HEADS, SSD_HEAD_DIM, SSD_D_STATE), f32)

    def run(direction):
        f = (lambda t: jnp.flip(t, axis=1)) if direction == 1 else (lambda t: t)
        if ctx_out:
            yc, hc = ssd_scan(f(xc), f(dtc[:, :, direction]), a[direction], f(bc), f(cc), d[direction], h0)
            yc = f(yc)
        else:
            yc, hc = None, ssd_final_state(f(xc), f(dtc[:, :, direction]), a[direction], f(bc), h0)
        yl, _ = ssd_scan(f(xl), f(dtl[:, :, direction]), a[direction], f(bl), f(cl), d[direction], hc)
        return f(yl), yc

    yl_f, yc_f = run(0)
    yl_b, yc_b = run(1)
    return yl_f + yl_b, (yc_f + yc_b if ctx_out else None)


def gated_group_norm(y, z, gain):
    b, l = z.shape[:2]
    u = y.reshape(b, l, SSD_GROUPS, -1) * jax.nn.silu(z.astype(f32)).reshape(b, l, SSD_GROUPS, -1)
    u = u * lax.rsqrt(jnp.mean(u * u, axis=-1, keepdims=True) + EPS)
    return (u.reshape(b, l, -1) * gain.astype(f32)).astype(z.dtype)


def token_mixers(hl, hc, w_in, w_out, rpb, sink, conv_w, conv_b, a_log, dt_bias, d_skip, ssd_norm, rope, ctx_out):
    b, cl = hc.shape[0], hc.shape[1]
    ql_a, kl_a, vl_a, ql_b, kl_b, vl_b, zl, xbcl, dtl = split_columns(hl @ w_in)
    qc_a, kc_a, vc_a, qc_b, kc_b, vc_b, zc, xbcc, dtc = split_columns(hc @ w_in)
    kc_a_h, vc_a_h = heads(kc_a, NA_HEADS), heads(vc_a, NA_HEADS)
    o_a = neighbourhood_attention(heads(ql_a, NA_HEADS), heads(kl_a, NA_HEADS), heads(vl_a, NA_HEADS), kc_a_h, vc_a_h, rpb)
    kc_b_h, vc_b_h = heads(kc_b, WA_KV_HEADS), heads(vc_b, WA_KV_HEADS)
    o_b = window_attention(axial_rope(heads(ql_b, WA_HEADS), rope), axial_rope(heads(kl_b, WA_KV_HEADS), rope),
                           heads(vl_b, WA_KV_HEADS), kc_b_h, vc_b_h, sink)
    yl, yc = bidirectional_ssd(ssd_inputs(xbcl, dtl, conv_w, conv_b, dt_bias), ssd_inputs(xbcc, dtc, conv_w, conv_b, dt_bias),
                               a_log, d_skip, ctx_out)
    out_l = jnp.concatenate([o_a, o_b, gated_group_norm(yl, zl, ssd_norm)], axis=-1) @ w_out
    if not ctx_out:
        return out_l, None
    g_wa = WA_HEADS // WA_KV_HEADS
    oc_a = context_attention(heads(qc_a, NA_HEADS)[:, :, :, None], kc_a_h, vc_a_h, None)
    oc_b = context_attention(heads(qc_b, WA_HEADS).reshape(b, cl, WA_KV_HEADS, g_wa, HEAD_DIM), kc_b_h, vc_b_h,
                             sink.reshape(WA_KV_HEADS, g_wa))
    out_c = jnp.concatenate([oc_a, oc_b, gated_group_norm(yc, zc, ssd_norm)], axis=-1) @ w_out
    return out_l, out_c


def moe_ffn(h, w_router, router_bias, w_gate, w_up, w_down):
    t, d = h.shape
    aff = jax.nn.sigmoid((h @ w_router).astype(f32))
    sel = (aff + router_bias.astype(f32)).reshape(t, N_EXPERT_GROUPS, EXPERTS_PER_GROUP)
    grp = jnp.argmax(lax.top_k(sel, 2)[0].sum(-1), axis=-1)
    local = lax.top_k(jnp.take_along_axis(sel, grp[:, None, None], axis=1)[:, 0], TOP_K)[1]
    expert = grp[:, None] * EXPERTS_PER_GROUP + local
    gate = jnp.take_along_axis(aff, expert, axis=1)
    gate = gate / jnp.sum(gate, axis=-1, keepdims=True)
    n = t * TOP_K
    flat = expert.reshape(n)
    order = jnp.argsort(flat)
    e_sorted = flat[order]
    tok = order // TOP_K
    counts = jnp.bincount(flat, length=N_EXPERTS)
    padded = (counts + MOE_BLOCK - 1) // MOE_BLOCK * MOE_BLOCK
    pend = jnp.cumsum(padded)
    slot = (pend - padded)[e_sorted] + jnp.arange(n) - (jnp.cumsum(counts) - counts)[e_sorted]
    n_blocks = -(-n // MOE_BLOCK) + N_EXPERTS
    block_expert = jnp.minimum(jnp.searchsorted(pend, jnp.arange(n_blocks) * MOE_BLOCK, side='right'), N_EXPERTS - 1)
    xbuf = jnp.zeros((n_blocks * MOE_BLOCK, d), h.dtype).at[slot].set(h[tok])

    def expert_block(args):
        xb, e = args
        return (jax.nn.silu(xb @ w_gate[e]) * (xb @ w_up[e])) @ w_down[e]

    ybuf = lax.map(expert_block, (xbuf.reshape(n_blocks, MOE_BLOCK, d), block_expert))
    y = ybuf.reshape(-1, d)[slot] * gate.reshape(n)[order][:, None].astype(h.dtype)
    return jnp.zeros_like(h).at[tok].add(y)


def setup_inputs(seed: int = 0) -> dict:
    key = jax.random.key(seed)
    ks = jax.random.split(key, 24)
    nrm = lambda k, shape, scale: jax.random.normal(k, shape, f32) * scale
    D = D_MODEL
    dt0 = jnp.exp(jax.random.uniform(ks[16], (DEPTH, 2, SSD_HEADS), f32, math.log(1e-3), math.log(1e-1)))
    return {
        'x': nrm(ks[0], (BATCH, SEQ, D), 1.0),
        'c': nrm(ks[1], (BATCH, D), 1.0),
        'ctx': nrm(ks[2], (BATCH, CTX_LEN, D), 1.0),
        'c_ctx': nrm(ks[3], (D,), 1.0),
        'w_ada': nrm(ks[4], (DEPTH, D, 6 * D), 0.5 * D ** -0.5),
        'b_ada': nrm(ks[5], (DEPTH, 6 * D), 0.02),
        'norm_mix': 1.0 + nrm(ks[6], (DEPTH, D), 0.02),
        'norm_ffn': 1.0 + nrm(ks[7], (DEPTH, D), 0.02),
        'norm_final': 1.0 + nrm(ks[8], (D,), 0.02),
        'w_in': nrm(ks[9], (DEPTH, D, IN_WIDTH), D ** -0.5),
        'w_out': nrm(ks[10], (DEPTH, MIX_WIDTH, D), MIX_WIDTH ** -0.5),
        'na_rpb': nrm(ks[11], (DEPTH, NA_HEADS, 2 * NA_WIN_R - 1, 2 * NA_WIN_C - 1), 0.1),
        'wa_sink': nrm(ks[12], (DEPTH, WA_HEADS), 0.5),
        'ssd_conv_w': nrm(ks[13], (DEPTH, SSD_CONV, SSD_XBC_WIDTH), SSD_CONV ** -0.5),
        'ssd_conv_b': nrm(ks[14], (DEPTH, SSD_XBC_WIDTH), 0.02),
        'ssd_a_log': jnp.log(jax.random.uniform(ks[15], (DEPTH, 2, SSD_HEADS), f32, 1.0, 16.0)),
        'ssd_dt_bias': dt0 + jnp.log(-jnp.expm1(-dt0)),
        'ssd_d': 1.0 + nrm(ks[17], (DEPTH, 2, SSD_HEADS), 0.1),
        'ssd_norm': 1.0 + nrm(ks[18], (DEPTH, SSD_D_INNER), 0.02),
        'w_router': nrm(ks[19], (D, N_EXPERTS), D ** -0.5),
        'router_bias': nrm(ks[20], (N_EXPERTS,), 0.01),
        'w_gate': nrm(ks[21], (DEPTH, N_EXPERTS, D, D_FF_EXPERT), D ** -0.5),
        'w_up': nrm(ks[22], (DEPTH, N_EXPERTS, D, D_FF_EXPERT), D ** -0.5),
        'w_down': nrm(ks[23], (DEPTH, N_EXPERTS, D_FF_EXPERT, D), D_FF_EXPERT ** -0.5),
    }


def reference(x, c, ctx, c_ctx, w_ada, b_ada, norm_mix, norm_ffn, norm_final, w_in, w_out, na_rpb, wa_sink,
              ssd_conv_w, ssd_conv_b, ssd_a_log, ssd_dt_bias, ssd_d, ssd_norm, w_router, router_bias,
              w_gate, w_up, w_down):
    b, s, d = x.shape
    rope = axial_rope_tables(s)
    silu_c = jax.nn.silu(c)
    silu_cc = jax.nn.silu(c_ctx)
    xc = ctx
    for l in range(DEPTH):
        ctx_out = l < DEPTH - 1
        mod = silu_c @ w_ada[l] + b_ada[l]
        sh_m, sc_m, g_m, sh_f, sc_f, g_f = jnp.split(mod[:, None, :], 6, axis=-1)
        cmod = silu_cc @ w_ada[l] + b_ada[l]
        csh_m, csc_m, cg_m, csh_f, csc_f, cg_f = jnp.split(cmod, 6)
        hl = rms_norm(x, norm_mix[l]) * (1.0 + sc_m) + sh_m
        hc = rms_norm(xc, norm_mix[l]) * (1.0 + csc_m) + csh_m
        o_l, o_c = token_mixers(hl, hc, w_in[l], w_out[l], na_rpb[l], wa_sink[l], ssd_conv_w[l], ssd_conv_b[l],
                                ssd_a_log[l], ssd_dt_bias[l], ssd_d[l], ssd_norm[l], rope, ctx_out)
        x = x + g_m * o_l
        hf = rms_norm(x, norm_ffn[l]) * (1.0 + sc_f) + sh_f
        if ctx_out:
            xc = xc + cg_m * o_c
            hfc = rms_norm(xc, norm_ffn[l]) * (1.0 + csc_f) + csh_f
            y = moe_ffn(jnp.concatenate([hf.reshape(-1, d), hfc.reshape(-1, d)], axis=0),
                        w_router, router_bias, w_gate[l], w_up[l], w_down[l])
            x = x + g_f * y[:b * s].reshape(b, s, d)
            xc = xc + cg_f * y[b * s:].reshape(xc.shape)
        else:
            x = x + g_f * moe_ffn(hf.reshape(-1, d), w_router, router_bias, w_gate[l], w_up[l], w_down[l]).reshape(b, s, d)
    return rms_norm(x, norm_final)
```

```cpp
#include <hip/hip_runtime.h>
#include <cstdio>
#include <cstdint>

#ifndef MK_ONE_LAUNCH
#define MK_ONE_LAUNCH 0
#endif

namespace pg8 {
#define PG8_LAS __attribute__((address_space(3)))
typedef unsigned short bf16_t;
typedef short bf16x8 __attribute__((ext_vector_type(8)));
typedef float f32x4 __attribute__((ext_vector_type(4)));
typedef unsigned u32x4 __attribute__((ext_vector_type(4)));
constexpr int BM = 256, BK = 64, HALF = 128, HTB = HALF * BK * 2  , STAGE_BYTES = 8 * HTB, NXCD = 8, WGM = 8;

__host__ __device__ __forceinline__ int lds_byte(int r, int c) { const int st = (r >> 4) * 2 + (c >> 5), rr = r & 15, cc = c & 31, ob = rr * 64 + cc * 2; return st * 1024 + (ob ^ (((ob >> 9) & 1) << 5)); }
__host__ __device__ __forceinline__ void stage_rc(int b, int& R, int& C) { const int st = b / 1024, sb = b % 1024, swz = sb ^ (((sb >> 9) & 1) << 5); R = (st >> 1) * 16 + swz / 64; C = (st & 1) * 32 + (swz % 64) / 2; }
__host__ __device__ __forceinline__ int perm32(int rho) { const int n = rho >> 4, i = rho & 15; return 8 * (i >> 2) + 4 * n + (i & 3); }

struct Unit { int pm, pn; long boff; };
struct Gemm { const bf16_t* A; const bf16_t* Bt; int M, N, K; };

struct StaticOrder {
    int nM, nN, nwg, G, c;
    __host__ __device__ void init(int M, int N, int G_, int c_) { nM = M / BM; nN = N / BM; nwg = nM * nN; G = G_; c = c_; }
    __host__ __device__ bool next(int i, Unit& u) const {
        const long L = (long)i * G + c; if (L >= nwg) return false;
        int wgid = (int)L; { const int q = nwg / NXCD, r = nwg % NXCD, xcd = wgid % NXCD, off = wgid / NXCD; wgid = (xcd < r ? xcd * (q + 1) : r * (q + 1) + (xcd - r) * q) + off; }
        const int nig = WGM * nN, gid = wgid / nig, fm = gid * WGM, gsz = (nM - fm) < WGM ? (nM - fm) : WGM;
        u.pm = fm + ((wgid % nig) % gsz); u.pn = (wgid % nig) / gsz; u.boff = 0; return true;
    }
    __device__ __forceinline__ void a_ready(const Unit&) const {}
    __device__ __forceinline__ void done(const Unit&) const {}
};

__device__ __forceinline__ unsigned cvt_pk_bf16(float lo, float hi) { unsigned r; asm volatile("v_cvt_pk_bf16_f32 %0, %1, %2" : "=v"(r) : "v"(lo), "v"(hi)); return r; }
typedef float f32x2 __attribute__((ext_vector_type(2)));
__device__ __forceinline__ f32x2 gelu_pk(f32x2 v) {
    const f32x2 av = __builtin_elementwise_abs(v), d = av * 0.2316418882f + 1.0f;
    f32x2 t; t.x = __builtin_amdgcn_rcpf(d.x); t.y = __builtin_amdgcn_rcpf(d.y);
    f32x2 q = t * 0.5307027145f + (-0.7265760135f); q = q * t + 0.7107068705f; q = q * t + (-0.142248368f); q = q * t + 0.127414796f; q = q * t;
    const f32x2 s = (v * v) * (-0.72134752044f);
    f32x2 e; e.x = __builtin_amdgcn_exp2f(s.x); e.y = __builtin_amdgcn_exp2f(s.y);
    const f32x2 m = v * (q * e), r = v - m;
    f32x2 o; o.x = v.x < 0.f ? m.x : r.x; o.y = v.y < 0.f ? m.y : r.y; return o;
}

template <class Epi, class Sched, bool ALIGN_EPI = false, bool SP2 = false>
__device__ __forceinline__ void gemm_phase(PG8_LAS unsigned char* lds, const Gemm g, const Sched& S, const Epi& E) {
    int tid_o = threadIdx.x; asm volatile("" : "+v"(tid_o));
    const int tid = tid_o, wid = __builtin_amdgcn_readfirstlane(tid >> 6), lane = tid & 63, wr = wid >> 2, wc = wid & 3, fr = lane & 15, fq = lane >> 4;
    const int K = g.K, nt = K / BK;
    unsigned voffA[2], voffB[2];
#pragma unroll
    for (int i = 0; i < 2; ++i) { int R, C; stage_rc(tid * 16 + i * 8192, R, C); const int Rb = Epi::PERM ? ((R & ~31) + perm32(R & 31)) : R;
        voffA[i] = (unsigned)(R * K + C) * 2u; voffB[i] = (unsigned)(Rb * K + C) * 2u; }
    const size_t kstep = (size_t)(BK * 2);
    const size_t hstep = (size_t)HALF * K * 2;
    const size_t tstep = 2 * hstep;
    const unsigned ldsw = (unsigned)wid * 1024u;
    const int aoff = lds_byte(wr * 64 + fr, fq * 8), boff = lds_byte(wc * 32 + fr, fq * 8);
#define PG8_SA(b, h) (((b) * 2 + (h)) * HTB)
#define PG8_SB(b, h) ((4 + (b) * 2 + (h)) * HTB)
#define PG8_STAGE(bufoff, gbase, voff) do { _Pragma("unroll") for (int _i = 0; _i < 2; ++_i) \
        __builtin_amdgcn_global_load_lds((const unsigned*)((const char*)(gbase) + (voff)[_i]), (PG8_LAS unsigned*)(lds + (bufoff) + ldsw + _i * 8192), 16, 0, 0); } while (0)
#define PG8_LDA(dst, b, h) do { _Pragma("unroll") for (int m = 0; m < 4; ++m) _Pragma("unroll") for (int k = 0; k < 2; ++k) dst[m][k] = *(const PG8_LAS bf16x8*)(lds + PG8_SA(b, h) + aoff + m * 2048 + k * 1024); } while (0)
#define PG8_LDB(dst, b, h) do { _Pragma("unroll") for (int n = 0; n < 2; ++n) _Pragma("unroll") for (int k = 0; k < 2; ++k) dst[n][k] = *(const PG8_LAS bf16x8*)(lds + PG8_SB(b, h) + boff + n * 2048 + k * 1024); } while (0)
#define PG8_MMA(ai, bj, At, Bt) do { __builtin_amdgcn_s_setprio(1); _Pragma("unroll") for (int m = 0; m < 4; ++m) _Pragma("unroll") for (int n = 0; n < 2; ++n) _Pragma("unroll") for (int k = 0; k < 2; ++k) \
        acc[ai][bj][m][n] = __builtin_amdgcn_mfma_f32_16x16x32_bf16(Bt[n][k], At[m][k], acc[ai][bj][m][n], 0, 0, 0); __builtin_amdgcn_s_setprio(0); } while (0)
#define PG8_WAIT_V(n) asm volatile("s_waitcnt vmcnt(" #n ")" ::: "memory")
#define PG8_WAIT_L(n) asm volatile("s_waitcnt lgkmcnt(" #n ")" ::: "memory")
#define PG8_BAR __builtin_amdgcn_s_barrier()
#define PG8_SCHED __builtin_amdgcn_sched_barrier(0)
    Unit cur, nxt; int ui = 0;
    if (!S.next(0, cur)) return;
    f32x4 acc[2][2][4][2];
#pragma unroll
    for (int a = 0; a < 2; ++a)
#pragma unroll
        for (int b = 0; b < 2; ++b)
#pragma unroll
            for (int m = 0; m < 4; ++m)
#pragma unroll
                for (int n = 0; n < 2; ++n) acc[a][b][m][n] = (f32x4){0.f, 0.f, 0.f, 0.f};
    bf16x8 At[4][2], B0[2][2], B1[2][2];
    const char* cA = (const char*)g.A + (size_t)cur.pm * tstep; const char* cB = (const char*)g.Bt + (size_t)cur.pn * tstep + cur.boff;
    S.a_ready(cur);
    if constexpr (SP2) {
        PG8_STAGE(PG8_SB(0, 0), cB, voffB); PG8_STAGE(PG8_SB(0, 1), cB + hstep, voffB); PG8_STAGE(PG8_SA(0, 0), cA, voffA); PG8_STAGE(PG8_SA(0, 1), cA + hstep, voffA);
        if (wr == 1) PG8_BAR;
        PG8_WAIT_V(2); PG8_BAR;
        PG8_STAGE(PG8_SB(1, 0), cB + kstep, voffB); PG8_STAGE(PG8_SA(1, 0), cA + kstep, voffA); PG8_STAGE(PG8_SB(1, 1), cB + hstep + kstep, voffB);
        PG8_WAIT_V(6); PG8_BAR;
    } else {
        PG8_STAGE(PG8_SB(0, 0), cB, voffB); PG8_STAGE(PG8_SA(0, 0), cA, voffA); PG8_STAGE(PG8_SB(0, 1), cB + hstep, voffB); PG8_STAGE(PG8_SA(0, 1), cA + hstep, voffA);
        if (wr == 1) PG8_BAR;
        PG8_WAIT_V(4); PG8_BAR;
        PG8_STAGE(PG8_SB(1, 0), cB + kstep, voffB); PG8_STAGE(PG8_SA(1, 0), cA + kstep, voffA); PG8_STAGE(PG8_SB(1, 1), cB + hstep + kstep, voffB);
        PG8_WAIT_V(6); PG8_BAR;
    }
    for (;;) {
        const bool has_next = S.next(ui + 1, nxt);
        const char* nA = has_next ? (const char*)g.A + (size_t)nxt.pm * tstep : cA; const char* nB = has_next ? (const char*)g.Bt + (size_t)nxt.pn * tstep + nxt.boff : cB;
        for (int t = 0; t < nt; t += 2) {
            const bool last = (t == nt - 2);
            const char* a1 = cA + (size_t)(t + 1) * kstep;
            const char* a2 = last ? nA : cA + (size_t)(t + 2) * kstep; const char* b2 = last ? nB : cB + (size_t)(t + 2) * kstep;
            const char* a3 = a2 + kstep; const char* b3 = b2 + kstep;
            if (last && has_next) S.a_ready(nxt);
            if constexpr (SP2) {
            PG8_LDB(B0, 0, 0); PG8_LDB(B1, 0, 1); PG8_SCHED; PG8_LDA(At, 0, 0); PG8_STAGE(PG8_SA(1, 1), a1 + hstep, voffA);
            PG8_WAIT_V(8); PG8_WAIT_L(0); PG8_BAR; PG8_MMA(0, 0, At, B0); PG8_MMA(0, 1, At, B1); PG8_BAR; PG8_SCHED;
            PG8_LDA(At, 0, 1); PG8_STAGE(PG8_SB(0, 0), b2, voffB); PG8_STAGE(PG8_SB(0, 1), b2 + hstep, voffB); PG8_STAGE(PG8_SA(0, 0), a2, voffA);
            PG8_WAIT_V(8); PG8_WAIT_L(0); PG8_BAR; PG8_MMA(1, 0, At, B0); PG8_MMA(1, 1, At, B1); PG8_BAR; PG8_SCHED;
            PG8_LDB(B0, 1, 0); PG8_LDB(B1, 1, 1); PG8_SCHED; PG8_LDA(At, 1, 0); PG8_STAGE(PG8_SA(0, 1), a2 + hstep, voffA);
            PG8_WAIT_V(8); PG8_WAIT_L(0); PG8_BAR; PG8_MMA(0, 0, At, B0); PG8_MMA(0, 1, At, B1); PG8_BAR; PG8_SCHED;
            PG8_LDA(At, 1, 1); PG8_STAGE(PG8_SB(1, 0), b3, voffB); PG8_STAGE(PG8_SB(1, 1), b3 + hstep, voffB); PG8_STAGE(PG8_SA(1, 0), a3, voffA);
            PG8_WAIT_V(8); PG8_WAIT_L(0); PG8_BAR; PG8_MMA(1, 0, At, B0); PG8_MMA(1, 1, At, B1); PG8_BAR; PG8_SCHED;
            } else {
            PG8_LDB(B0, 0, 0); PG8_SCHED; PG8_LDA(At, 0, 0); PG8_STAGE(PG8_SA(1, 1), a1 + hstep, voffA);
            PG8_WAIT_L(8); PG8_BAR; PG8_WAIT_L(0); PG8_MMA(0, 0, At, B0); PG8_BAR; PG8_SCHED;
            PG8_LDB(B1, 0, 1); PG8_STAGE(PG8_SB(0, 0), b2, voffB);
            PG8_BAR; PG8_WAIT_L(0); PG8_MMA(0, 1, At, B1); PG8_BAR;
            PG8_LDA(At, 0, 1); PG8_STAGE(PG8_SA(0, 0), a2, voffA);
            PG8_BAR; PG8_WAIT_L(0); PG8_MMA(1, 0, At, B0); PG8_BAR; PG8_SCHED;
            PG8_STAGE(PG8_SB(0, 1), b2 + hstep, voffB);
            PG8_WAIT_V(6); PG8_BAR; PG8_MMA(1, 1, At, B1); PG8_BAR;
            PG8_LDB(B0, 1, 0); PG8_SCHED; PG8_LDA(At, 1, 0); PG8_STAGE(PG8_SA(0, 1), a2 + hstep, voffA);
            PG8_WAIT_L(8); PG8_BAR; PG8_WAIT_L(0); PG8_MMA(0, 0, At, B0); PG8_BAR; PG8_SCHED;
            PG8_LDB(B1, 1, 1); PG8_STAGE(PG8_SB(1, 0), b3, voffB);
            PG8_BAR; PG8_WAIT_L(0); PG8_MMA(0, 1, At, B1); PG8_BAR;
            PG8_LDA(At, 1, 1); PG8_STAGE(PG8_SA(1, 0), a3, voffA);
            PG8_BAR; PG8_WAIT_L(0); PG8_MMA(1, 0, At, B0); PG8_BAR; PG8_SCHED;
            PG8_STAGE(PG8_SB(1, 1), b3 + hstep, voffB);
            PG8_WAIT_V(6); PG8_BAR; PG8_MMA(1, 1, At, B1); PG8_BAR;
            }
        }
        if constexpr (ALIGN_EPI) { if (wr == 0) PG8_BAR; }
        if constexpr (!Epi::AFTER_DRAIN) { E(acc, cur, wr, wc, fr, fq); S.done(cur); }
        if (!has_next) break;
#pragma unroll
        for (int a = 0; a < 2; ++a)
#pragma unroll
            for (int b = 0; b < 2; ++b)
#pragma unroll
                for (int m = 0; m < 4; ++m)
#pragma unroll
                    for (int n = 0; n < 2; ++n) acc[a][b][m][n] = (f32x4){0.f, 0.f, 0.f, 0.f};
        cur = nxt; cA = nA; cB = nB; ++ui;
        if constexpr (ALIGN_EPI) { if (wr == 1) PG8_BAR; }
    }
    PG8_WAIT_V(0);
    if constexpr (!ALIGN_EPI) { if (wr == 0) PG8_BAR; }
    PG8_BAR;
    if constexpr (Epi::AFTER_DRAIN) { E.fused(acc, cur, wr, wc, fr, fq, lds, wid, lane); S.done(cur); }
#undef PG8_SA
#undef PG8_SB
#undef PG8_STAGE
#undef PG8_LDA
#undef PG8_LDB
#undef PG8_MMA
#undef PG8_WAIT_V
#undef PG8_WAIT_L
#undef PG8_BAR
#undef PG8_SCHED
}
typedef unsigned u32x2e __attribute__((ext_vector_type(2)));
struct EpiPlain {
    static constexpr bool PERM = true, AFTER_DRAIN = false;
    bf16_t* O; int ldc;
    __device__ __forceinline__ void operator()(const f32x4 (&acc)[2][2][4][2], const Unit& u, int wr, int wc, int fr, int fq) const {
        const int row0 = u.pm * BM + wr * 64 + fr, col0 = u.pn * BM + wc * 32 + 8 * fq;
#pragma unroll
        for (int ai = 0; ai < 2; ++ai)
#pragma unroll
            for (int m = 0; m < 4; ++m) { bf16_t* rowp = O + (size_t)(row0 + ai * HALF + m * 16) * ldc + col0;
#pragma unroll
                for (int bj = 0; bj < 2; ++bj) { const f32x4 v0 = acc[ai][bj][m][0], v1 = acc[ai][bj][m][1];
                    u32x4 w; w.x = cvt_pk_bf16(v0[0], v0[1]); w.y = cvt_pk_bf16(v0[2], v0[3]); w.z = cvt_pk_bf16(v1[0], v1[1]); w.w = cvt_pk_bf16(v1[2], v1[3]);
                    *(u32x4*)(rowp + bj * HALF) = w; } }
    }
};
struct EpiInProj {
    static constexpr bool PERM = true, AFTER_DRAIN = false;
    bf16_t* O; int ldc; const float* rope; int rope_lo, rope_hi, lat_rows;
    __device__ __forceinline__ void operator()(const f32x4 (&acc)[2][2][4][2], const Unit& u, int wr, int wc, int fr, int fq) const {
        const int row0 = u.pm * BM + wr * 64 + fr, col0 = u.pn * BM + wc * 32 + 8 * fq;
        const bool do_rope = (u.pn >= rope_lo) && (u.pn < rope_hi) && (u.pm * BM < lat_rows);
        const int i0 = 16 * (wc & 1) + 4 * fq, half = wc >> 1;
#pragma unroll
        for (int ai = 0; ai < 2; ++ai)
#pragma unroll
            for (int m = 0; m < 4; ++m) { const int row = row0 + ai * HALF + m * 16; bf16_t* rowp = O + (size_t)row * ldc + col0;
                f32x4 cs0 = {1.f, 0.f, 1.f, 0.f}, cs1 = {1.f, 0.f, 1.f, 0.f};
                if (do_rope) { const int s = row & 8191, pos = half ? (s & 63) : (s >> 6); const f32x4* tp = (const f32x4*)(rope + (size_t)(pos * 32 + i0) * 2); cs0 = tp[0]; cs1 = tp[1]; }
#pragma unroll
                for (int bj = 0; bj < 2; ++bj) { f32x4 v0 = acc[ai][bj][m][0], v1 = acc[ai][bj][m][1];
                    if (do_rope) {
                        const f32x4 a = v0, b = v1;
                        v0[0] = a[0] * cs0[0] - a[1] * cs0[1]; v0[1] = a[1] * cs0[0] + a[0] * cs0[1];
                        v0[2] = a[2] * cs0[2] - a[3] * cs0[3]; v0[3] = a[3] * cs0[2] + a[2] * cs0[3];
                        v1[0] = b[0] * cs1[0] - b[1] * cs1[1]; v1[1] = b[1] * cs1[0] + b[0] * cs1[1];
                        v1[2] = b[2] * cs1[2] - b[3] * cs1[3]; v1[3] = b[3] * cs1[2] + b[2] * cs1[3];
                    }
                    u32x4 w; w.x = cvt_pk_bf16(v0[0], v0[1]); w.y = cvt_pk_bf16(v0[2], v0[3]); w.z = cvt_pk_bf16(v1[0], v1[1]); w.w = cvt_pk_bf16(v1[2], v1[3]);
                    *(u32x4*)(rowp + bj * HALF) = w; } }
    }
};
struct EpiRes {
    static constexpr bool PERM = true, AFTER_DRAIN = false;
    const float* xin; float* xout; const float* cin; float* cout; const float* gate;
    int ldc, lat_rows, gstride;
    __device__ __forceinline__ void operator()(const f32x4 (&acc)[2][2][4][2], const Unit& u, int wr, int wc, int fr, int fq) const {
        const int row0 = u.pm * BM + wr * 64 + fr, col0 = u.pn * BM + wc * 32 + 8 * fq;
        const bool isc = u.pm * BM >= lat_rows;
        const int vs = isc ? 2 : ((u.pm * BM) >> 13);
        const float* bp = isc ? cin - (size_t)lat_rows * ldc : xin; float* op = isc ? cout - (size_t)lat_rows * ldc : xout;
        f32x4 gv[2][2];
#pragma unroll
        for (int bj = 0; bj < 2; ++bj)
#pragma unroll
            for (int n = 0; n < 2; ++n) { typedef int i32x4 __attribute__((ext_vector_type(4))); const i32x4 q = *(const i32x4*)(gate + (size_t)vs * gstride + col0 + bj * HALF + 4 * n);
                gv[bj][n] = (f32x4){(float)q[0], (float)q[1], (float)q[2], (float)q[3]} * (1.f / 16777216.f); }
#pragma unroll
        for (int ai = 0; ai < 2; ++ai)
#pragma unroll
            for (int m = 0; m < 4; ++m) { const size_t off = (size_t)(row0 + ai * HALF + m * 16) * ldc + col0;
#pragma unroll
                for (int bj = 0; bj < 2; ++bj)
#pragma unroll
                    for (int n = 0; n < 2; ++n) { const f32x4 b = *(const f32x4*)(bp + off + bj * HALF + 4 * n);
                        *(f32x4*)(op + off + bj * HALF + 4 * n) = b + gv[bj][n] * acc[ai][bj][m][n]; } }
    }
};
struct EpiGateUp {
    static constexpr bool PERM = true, AFTER_DRAIN = false;
    bf16_t* O; int ldc;
    __device__ __forceinline__ void operator()(const f32x4 (&acc)[2][2][4][2], const Unit& u, int wr, int wc, int fr, int fq) const {
        const int row0 = u.pm * BM + wr * 64 + fr, col0 = (u.pn * BM + wc * 32 + 8 * fq) >> 1;
#pragma unroll
        for (int ai = 0; ai < 2; ++ai)
#pragma unroll
            for (int m = 0; m < 4; ++m) { bf16_t* rowp = O + (size_t)(row0 + ai * HALF + m * 16) * ldc + col0;
#pragma unroll
                for (int bj = 0; bj < 2; ++bj) { const f32x4 g = acc[ai][bj][m][0], up = acc[ai][bj][m][1]; f32x4 a;
#pragma unroll
                    for (int i = 0; i < 4; ++i) a[i] = g[i] * __builtin_amdgcn_rcpf(1.f + __expf(-g[i])) * up[i];
                    u32x2e w; w.x = cvt_pk_bf16(a[0], a[1]); w.y = cvt_pk_bf16(a[2], a[3]);
                    *(u32x2e*)(rowp + bj * (HALF / 2)) = w; } }
    }
};
struct GroupedOrder {
    static constexpr int nN = 8;
    int G, c, nblk; const PG8_LAS int* blk_e; long estride;
    __device__ __forceinline__ bool next(int i, Unit& u) const {
        const int L = i * G + c; if (L >= nblk * nN) return false;
        u.pm = L >> 3; u.pn = L & 7; u.boff = (long)__builtin_amdgcn_readfirstlane(blk_e[u.pm]) * estride; return true;
    }
    __device__ __forceinline__ void a_ready(const Unit&) const {}
    __device__ __forceinline__ void done(const Unit&) const {}
};
}
constexpr int DM = 2048, T_LAT = 16384, T_CTX = 512, T_ALL = 16896, SEQL = 8192, CTXL = 256;
constexpr int NIN = 5152, NINP = 5376;
constexpr int C_QA = 0, C_KA = 512, C_VA = 1024, C_QB = 1536, C_KB = 2048, C_VB = 2304, C_Z = 2560, C_XBC = 3584, C_DT = 5120;
constexpr int XBCW = 1536, DFF = 1024, NEXP = 32, MODW = 12288;
constexpr float EPS = 1e-6f, ATT_SCALE = 0.088388347648318440f;
constexpr int MAXBLK = 165, MAXSLOT = MAXBLK * 256;
constexpr int NWAVES = 8;

constexpr size_t MiB = 1u << 20;
constexpr size_t WS_CTL = 0, CTL_ZERO_BYTES = 2 * MiB;
constexpr int CW_BAR = 4096;
constexpr size_t OFF_CNT = 65536;
constexpr size_t OFF_MOD = 1 * MiB;
constexpr size_t WS_ROPE = 2 * MiB;
constexpr size_t WS_WRT = 3 * MiB;
constexpr size_t WS_WIN = 8 * MiB;
constexpr size_t WS_WOUT = 50 * MiB;
constexpr size_t WS_WGU = 66 * MiB;
constexpr size_t WS_WDN = 578 * MiB;
constexpr size_t WS_H = 834 * MiB;
constexpr size_t WS_U = 900 * MiB;
constexpr size_t WS_X = 1074 * MiB;
constexpr size_t WS_XC = 1202 * MiB;
constexpr size_t WS_XBC = 1206 * MiB;
constexpr size_t WS_DT = 1256 * MiB;
constexpr size_t WS_YD = 1260 * MiB;
constexpr size_t WS_XG = 1392 * MiB;
constexpr size_t WS_ACT = 1557 * MiB;
constexpr size_t WS_YB = 1640 * MiB;
constexpr size_t WS_TOK = 1805 * MiB;
constexpr size_t WS_END = 1808 * MiB;
constexpr size_t TOKTAB = (size_t)T_ALL * 2 * 4;
static_assert(WS_WIN + (size_t)2 * NINP * DM * 2 <= WS_WOUT && WS_WGU + (size_t)2 * 32 * 2048 * 2048 * 2 <= WS_WDN && WS_WDN + (size_t)2 * 32 * 2048 * 1024 * 2 <= WS_H, "ws map 1");
static_assert(WS_H + (size_t)T_ALL * DM * 2 <= WS_U && WS_U + (size_t)T_ALL * NINP * 2 <= WS_X && WS_X + (size_t)T_LAT * DM * 4 <= WS_XC && WS_XBC + (size_t)T_ALL * XBCW * 2 <= WS_DT, "ws map 2");
static_assert(WS_DT + (size_t)T_ALL * 32 * 4 <= WS_YD && WS_YD + (size_t)2 * T_ALL * 1024 * 4 <= WS_XG && WS_XG + (size_t)MAXSLOT * DM * 2 <= WS_ACT && WS_ACT + (size_t)MAXSLOT * DFF * 2 <= WS_YB && WS_YB + (size_t)MAXSLOT * DM * 2 <= WS_TOK && WS_TOK + 4 * TOKTAB <= WS_END, "ws map 3");

constexpr int RING_BYTES = 131072, LDSCTL_OFF = RING_BYTES, LDS_BYTES = 147456;
constexpr int L_BARW = LDSCTL_OFF;
constexpr int L_SEG = LDSCTL_OFF + 64;
constexpr int L_CNT = LDSCTL_OFF + 256;
constexpr int L_BLKE = LDSCTL_OFF + 512;
constexpr int L_NBLK = LDSCTL_OFF + 1536;
constexpr int L_INCL = LDSCTL_OFF + 1600;

#define GAS __attribute__((address_space(1)))
#define LAS __attribute__((address_space(3)))
typedef unsigned short bf16;
typedef unsigned v4u __attribute__((ext_vector_type(4)));
typedef unsigned v2u __attribute__((ext_vector_type(2)));
typedef float f32x4 __attribute__((ext_vector_type(4)));
typedef float f32x2 __attribute__((ext_vector_type(2)));
typedef short bf16x8 __attribute__((ext_vector_type(8)));
#define LDS_WAIT() asm volatile("s_waitcnt lgkmcnt(0)" ::: "memory")
#define VM_WAIT() asm volatile("s_waitcnt vmcnt(0)" ::: "memory")
__device__ __forceinline__ unsigned f2bf(float f) { unsigned u = __builtin_bit_cast(unsigned, f); return (u + 0x7fffu + ((u >> 16) & 1u)) >> 16; }
__device__ __forceinline__ unsigned pk2(float lo, float hi) { return f2bf(lo) | (f2bf(hi) << 16); }
__device__ __forceinline__ float bflo(unsigned w) { return __builtin_bit_cast(float, w << 16); }
__device__ __forceinline__ float bfhi(unsigned w) { return __builtin_bit_cast(float, w & 0xffff0000u); }
__device__ __forceinline__ float bf2f(bf16 b) { return __builtin_bit_cast(float, (unsigned)b << 16); }
__device__ __forceinline__ float wave_sum(float v) {
#pragma unroll
    for (int o = 1; o < 64; o <<= 1) v += __shfl_xor(v, o);
    return v;
}
__device__ __forceinline__ float wave_max(float v) {
#pragma unroll
    for (int o = 1; o < 64; o <<= 1) v = fmaxf(v, __shfl_xor(v, o));
    return v;
}
__device__ __forceinline__ float silu_f(float x) { return x / (1.f + __expf(-x)); }
__device__ __forceinline__ float sigmoid_f(float x) { return 1.f / (1.f + __expf(-x)); }
__device__ __forceinline__ float softplus_f(float x) { return x > 20.f ? x : log1pf(__expf(x)); }

#define XB_TMO      128
#define XB_XCNT(j)  (256  + 64 * (j))
#define XB_XSUB(j)  (1280 + 64 * (j))
#define XB_XGEN(j)  (2304 + 64 * (j))
#define XB_TOP      3328
#define XB_TOPGEN   3392
#define XCD_BAR_WORDS 3456
#define XB_SPIN_CAP (1u << 18)


__device__ __forceinline__ unsigned xb_ld(unsigned* p)              { return __hip_atomic_load(p, __ATOMIC_RELAXED, __HIP_MEMORY_SCOPE_AGENT); }
__device__ __forceinline__ unsigned xb_add(unsigned* p, unsigned v) { return __hip_atomic_fetch_add(p, v, __ATOMIC_RELAXED, __HIP_MEMORY_SCOPE_AGENT); }
__device__ __forceinline__ unsigned xb_xcc_id() { return (unsigned)__builtin_amdgcn_s_getreg((3 << 11) | 20) & 0xFu; }
#define XB_SPIN(cond, bar) do { unsigned _sp = 0; while (cond) { __builtin_amdgcn_s_sleep(1); \
    if ((++_sp & 255u) == 0u) { if (xb_ld(&(bar)[XB_TMO])) break; if (_sp > XB_SPIN_CAP) { atomicAdd(&(bar)[XB_TMO], 1u); break; } } } } while (0)

struct XcdBarrier {
    unsigned* bar; unsigned x;
    volatile LAS unsigned* st;
};

__device__ __forceinline__ XcdBarrier xcd_barrier_post(unsigned* bar, volatile LAS unsigned* st) {
    XcdBarrier b; b.bar = bar; b.x = xb_xcc_id(); b.st = st;
    if (threadIdx.x == 0) (void)xb_add(&bar[XB_XCNT(b.x)], 1u);
    return b;
}
__device__ __forceinline__ void xcd_barrier_complete(unsigned* bar, unsigned x, unsigned& nloc, unsigned& nx) {
    const unsigned G = gridDim.x * gridDim.y * gridDim.z;
    unsigned sum, cnt, mine, sp = 0u;
    for (;;) {
        sum = 0u; cnt = 0u; mine = 0u;
#pragma unroll
        for (unsigned j = 0; j < 16; ++j) { const unsigned c = xb_ld(&bar[XB_XCNT(j)]); sum += c; cnt += (c > 0u) ? 1u : 0u; mine = (j == x) ? c : mine; }
        if (sum == G) break;
        __builtin_amdgcn_s_sleep(1);
        if ((++sp & 255u) == 0u) { if (xb_ld(&bar[XB_TMO])) break; if (sp > XB_SPIN_CAP) { atomicAdd(&bar[XB_TMO], 1u); break; } }
    }
    nloc = mine > 0u ? mine : 1u; nx = cnt > 0u ? cnt : 1u;
}

__device__ __forceinline__ void xcd_barrier(const XcdBarrier& b) {
    asm volatile("s_waitcnt vmcnt(0)" ::: "memory");
    __syncthreads();
    if (threadIdx.x == 0) {
        unsigned* bar = b.bar;
        __builtin_amdgcn_s_waitcnt(0);
        unsigned nloc = b.st[0], nx = b.st[1];
        if (nloc == 0u) { xcd_barrier_complete(bar, b.x, nloc, nx); b.st[0] = nloc; b.st[1] = nx; }
        const unsigned old = xb_add(&bar[XB_XSUB(b.x)], 1u);
        const unsigned gen = old / nloc;
        if (old + 1u == (gen + 1u) * nloc) {
            __builtin_amdgcn_fence(__ATOMIC_RELEASE, "agent");
            asm volatile("s_waitcnt vmcnt(0)" ::: "memory");
            const unsigned og = xb_add(&bar[XB_TOP], 1u);
            const unsigned tg = og / nx;
            if (og + 1u == (tg + 1u) * nx) xb_add(&bar[XB_TOPGEN], 1u);
            else XB_SPIN(xb_ld(&bar[XB_TOPGEN]) == tg, bar);
            __builtin_amdgcn_fence(__ATOMIC_ACQUIRE, "agent");
            xb_add(&bar[XB_XGEN(b.x)], 1u);
            asm volatile("s_waitcnt vmcnt(0)" ::: "memory");
        } else {
            XB_SPIN(xb_ld(&bar[XB_XGEN(b.x)]) == gen, bar);
            __builtin_amdgcn_fence(__ATOMIC_ACQUIRE, "agent");
            asm volatile("s_waitcnt vmcnt(0)" ::: "memory");
        }
    }
    __syncthreads();
}
struct Prm {
    const float *x, *c, *ctx, *c_ctx, *w_ada, *b_ada, *norm_mix, *norm_ffn, *norm_final, *w_in, *w_out, *na_rpb, *wa_sink,
                *conv_w, *conv_b, *a_log, *dt_bias, *d_skip, *ssd_norm, *w_router, *router_bias, *w_gate, *w_up, *w_down;
    float* out; unsigned char* ws; int ph_lo, ph_hi;
};

__device__ __forceinline__ int perm_in(int n) {
    if (n >= C_QB && n < C_VB) { const int p = (n - C_QB) & 127, hb = n - p, half = p >> 6, pp = p & 63; return hb + half * 64 + (pp >> 1) + 32 * (pp & 1); }
    return n;
}
__device__ __forceinline__ void transpose_tile(const float* colp, size_t ld, bool ok, int K, bf16* WT, int n0, int k0, LAS float* scr, int lane) {
#pragma unroll 8
    for (int i = 0; i < 32; ++i) { const int kk = 2 * i + (lane >> 5); scr[kk * 33 + (lane & 31)] = ok ? colp[(size_t)(k0 + kk) * ld] : 0.f; }
    LDS_WAIT(); asm volatile("" ::: "memory");
    const int c = lane & 7;
#pragma unroll
    for (int j = 0; j < 4; ++j) { const int n = (lane >> 3) + 8 * j; const LAS float* s = scr + (8 * c) * 33 + n;
        v4u o; o.x = pk2(s[0 * 33], s[1 * 33]); o.y = pk2(s[2 * 33], s[3 * 33]); o.z = pk2(s[4 * 33], s[5 * 33]); o.w = pk2(s[6 * 33], s[7 * 33]);
        *(v4u*)(WT + (size_t)(n0 + n) * K + k0 + 8 * c) = o; }
    LDS_WAIT(); asm volatile("" ::: "memory");
}
__device__ __forceinline__ void phase_prologue(const Prm& p, LAS unsigned char* lds, int gw, int ngw, int wave, int lane) {
    LAS float* scr = (LAS float*)(lds + wave * 16384);
    unsigned char* ws = p.ws;
    constexpr int I_IN = 32 * (NINP / 32), I_OUT = 32 * 64, I_GU = 32 * 32 * 64, I_DN = 32 * 16 * 64, I_L = I_IN + I_OUT + I_GU + I_DN, I_RT = 32, I_ALL = 2 * I_L + I_RT;
    for (int it = gw; it < I_ALL; it += ngw) {
        if (it >= 2 * I_L) {
            const int kb = it - 2 * I_L; const int nn = lane & 31;
            transpose_tile(p.w_router + nn, 32, true, 2048, (bf16*)(ws + WS_WRT), 0, 64 * kb, scr, lane);
            continue;
        }
        const int l = it / I_L; int r = it % I_L;
        if (r < I_IN) { const int nb = r / 32, kb = r % 32, nn = 32 * nb + (lane & 31); const bool ok = nn < NIN;
            transpose_tile(p.w_in + (size_t)l * DM * NIN + (ok ? perm_in(nn) : 0), NIN, ok, 2048, (bf16*)(ws + WS_WIN) + (size_t)l * NINP * DM, 32 * nb, 64 * kb, scr, lane); continue; }
        r -= I_IN;
        if (r < I_OUT) { const int nb = r / 32, kb = r % 32, nn = 32 * nb + (lane & 31);
            transpose_tile(p.w_out + (size_t)l * DM * DM + nn, DM, true, 2048, (bf16*)(ws + WS_WOUT) + (size_t)l * DM * DM, 32 * nb, 64 * kb, scr, lane); continue; }
        r -= I_OUT;
        if (r < I_GU) { const int e = r / 2048, q = r % 2048, nb = q / 32, kb = q % 32, nn = 32 * nb + (lane & 31), j = nn >> 3, t = nn & 7;
            const float* src = (t < 4 ? p.w_gate : p.w_up) + (size_t)(l * 32 + e) * 2048 * 1024 + 4 * j + (t & 3);
            transpose_tile(src, 1024, true, 2048, (bf16*)(ws + WS_WGU) + (size_t)(l * 32 + e) * 2048 * 2048, 32 * nb, 64 * kb, scr, lane); continue; }
        r -= I_GU;
        { const int e = r / 1024, q = r % 1024, nb = q / 16, kb = q % 16, nn = 32 * nb + (lane & 31);
            transpose_tile(p.w_down + (size_t)(l * 32 + e) * 1024 * 2048 + nn, 2048, true, 1024, (bf16*)(ws + WS_WDN) + (size_t)(l * 32 + e) * 2048 * 1024, 32 * nb, 64 * kb, scr, lane); }
    }
    int* mod = (int*)(ws + OFF_MOD);
    for (int it = gw; it < 2 * 32 * 48; it += ngw) {
        const int l = it / (32 * 48), q = it % (32 * 48), kc = q / 48, nc = q % 48, k0 = 64 * kc, n0 = 256 * nc + 4 * lane;
        scr[lane] = silu_f(p.c[k0 + lane]); scr[64 + lane] = silu_f(p.c[DM + k0 + lane]); scr[128 + lane] = silu_f(p.c_ctx[k0 + lane]);
        LDS_WAIT(); asm volatile("" ::: "memory");
        f32x4 a0 = {0.f, 0.f, 0.f, 0.f}, a1 = a0, a2 = a0;
        const float* wp = p.w_ada + ((size_t)l * DM + k0) * MODW + n0;
#pragma unroll 8
        for (int kk = 0; kk < 64; ++kk) { const f32x4 w = *(const f32x4*)(wp + (size_t)kk * MODW); a0 += w * scr[kk]; a1 += w * scr[64 + kk]; a2 += w * scr[128 + kk]; }
        if (kc == 0) { const f32x4 bb = *(const f32x4*)(p.b_ada + (size_t)l * MODW + n0); a0 += bb; a1 += bb; a2 += bb; }
        int* m0 = mod + (size_t)(l * 3) * MODW + n0;
#pragma unroll
        for (int i = 0; i < 4; ++i) { atomicAdd(m0 + i, (int)rintf(a0[i] * 16777216.f)); atomicAdd(m0 + MODW + i, (int)rintf(a1[i] * 16777216.f)); atomicAdd(m0 + 2 * MODW + i, (int)rintf(a2[i] * 16777216.f)); }
        LDS_WAIT(); asm volatile("" ::: "memory");
    }
    for (int it = gw * 64 + lane; it < 128 * 32; it += ngw * 64) { const int pos = it >> 5, i = it & 31; const float inv = powf(10000.f, -(float)i / 32.f), ang = (float)pos * inv;
        ((float*)(ws + WS_ROPE))[2 * it] = cosf(ang); ((float*)(ws + WS_ROPE))[2 * it + 1] = sinf(ang); }
}

__device__ __forceinline__ f32x4 modv4(const float* p) {
    typedef int i32x4 __attribute__((ext_vector_type(4)));
    const i32x4 v = *(const i32x4*)p; return (f32x4){(float)v[0], (float)v[1], (float)v[2], (float)v[3]} * (1.f / 16777216.f);
}
__device__ __forceinline__ void load_row(const Prm& p, int l, int lcomb, int m, int lane, f32x4 (&v)[8]) {
    const bool isc = m >= T_LAT; const int vs = isc ? 2 : (m >> 13);
    float* wsrow = isc ? (float*)(p.ws + WS_XC) + (size_t)(m - T_LAT) * DM : (float*)(p.ws + WS_X) + (size_t)m * DM;
    const float* src = (l == 0) ? (isc ? p.ctx + (size_t)(m - T_LAT) * DM : p.x + (size_t)m * DM) : wsrow;
#pragma unroll
    for (int j = 0; j < 8; ++j) v[j] = *(const f32x4*)(src + 256 * j + 4 * lane);
    if (lcomb >= 0) {
        const int* tslot = (const int*)(p.ws + WS_TOK + 3 * TOKTAB); const float* tgate = (const float*)(p.ws + WS_TOK + 2 * TOKTAB);
        const int s0 = tslot[2 * m], s1 = tslot[2 * m + 1]; const float g0 = tgate[2 * m], g1 = tgate[2 * m + 1];
        const bf16* y0 = (const bf16*)(p.ws + WS_YB) + (size_t)s0 * DM; const bf16* y1 = (const bf16*)(p.ws + WS_YB) + (size_t)s1 * DM;
        const float* gf = (const float*)(p.ws + OFF_MOD) + (size_t)(lcomb * 3 + vs) * MODW + 5 * DM;
#pragma unroll
        for (int j = 0; j < 8; ++j) { const int col = 256 * j + 4 * lane; const v2u a = *(const v2u*)(y0 + col), b = *(const v2u*)(y1 + col); const f32x4 g = modv4(gf + col);
            v[j][0] += g[0] * (g0 * bflo(a.x) + g1 * bflo(b.x)); v[j][1] += g[1] * (g0 * bfhi(a.x) + g1 * bfhi(b.x));
            v[j][2] += g[2] * (g0 * bflo(a.y) + g1 * bflo(b.y)); v[j][3] += g[3] * (g0 * bfhi(a.y) + g1 * bfhi(b.y));
            *(f32x4*)(wsrow + col) = v[j]; }
    }
}
__device__ __forceinline__ float row_rstd(const f32x4 (&v)[8]) {
    float s = 0.f;
#pragma unroll
    for (int j = 0; j < 8; ++j) s += (v[j][0] * v[j][0] + v[j][1] * v[j][1]) + (v[j][2] * v[j][2] + v[j][3] * v[j][3]);
    return rsqrtf(wave_sum(s) * (1.f / DM) + EPS);
}
__device__ __forceinline__ v2u modulate4(const f32x4 v, float rstd, const float* gain, const float* sc, const float* sh, int col) {
    const f32x4 g = *(const f32x4*)(gain + col), s1 = modv4(sc + col), s0 = modv4(sh + col);
    const f32x4 o = (v * rstd * g) * (s1 + 1.f) + s0;
    v2u w; w.x = pk2(o[0], o[1]); w.y = pk2(o[2], o[3]); return w;
}
__device__ __forceinline__ void phase_norm1(const Prm& p, int l, int gw, int ngw, int lane) {
    bf16* H = (bf16*)(p.ws + WS_H);
    for (int m = gw; m < T_ALL; m += ngw) {
        f32x4 v[8]; load_row(p, l, l - 1, m, lane, v);
        const float rstd = row_rstd(v);
        const int vs = m >= T_LAT ? 2 : (m >> 13);
        const float* md = (const float*)(p.ws + OFF_MOD) + (size_t)(l * 3 + vs) * MODW;
#pragma unroll
        for (int j = 0; j < 8; ++j) { const int col = 256 * j + 4 * lane; *(v2u*)(H + (size_t)m * DM + col) = modulate4(v[j], rstd, p.norm_mix + l * DM, md + DM, md, col); }
    }
}
__device__ __forceinline__ void phase_final(const Prm& p, int gw, int ngw, int lane) {
    for (int m = gw; m < T_LAT; m += ngw) {
        f32x4 v[8]; load_row(p, 1, 1, m, lane, v);
        const float rstd = row_rstd(v);
#pragma unroll
        for (int j = 0; j < 8; ++j) { const int col = 256 * j + 4 * lane; *(f32x4*)(p.out + (size_t)m * DM + col) = v[j] * rstd * *(const f32x4*)(p.norm_final + col); }
    }
}
__device__ __forceinline__ void phase_conv(const Prm& p, int l, int gw, int ngw, int lane) {
    const bf16* U = (const bf16*)(p.ws + WS_U); bf16* XA = (bf16*)(p.ws + WS_XBC); float* DT = (float*)(p.ws + WS_DT);
    constexpr int NRUN = T_ALL / 16;
    for (int it = gw; it < NRUN * 3; it += ngw) {
        const int run = it / 3, cb = it % 3, t0 = run * 16, ch = cb * 512 + lane * 8;
        int seq0, seq1; if (t0 < T_LAT) { seq0 = t0 & ~(SEQL - 1); seq1 = seq0 + SEQL; } else { seq0 = T_LAT + ((t0 - T_LAT) & ~(CTXL - 1)); seq1 = seq0 + CTXL; }
        float w[5][8], bias[8];
#pragma unroll
        for (int j = 0; j < 5; ++j) { const f32x4 a = *(const f32x4*)(p.conv_w + ((size_t)l * 5 + j) * XBCW + ch), b = *(const f32x4*)(p.conv_w + ((size_t)l * 5 + j) * XBCW + ch + 4);
            w[j][0] = a[0]; w[j][1] = a[1]; w[j][2] = a[2]; w[j][3] = a[3]; w[j][4] = b[0]; w[j][5] = b[1]; w[j][6] = b[2]; w[j][7] = b[3]; }
        { const f32x4 a = *(const f32x4*)(p.conv_b + (size_t)l * XBCW + ch), b = *(const f32x4*)(p.conv_b + (size_t)l * XBCW + ch + 4);
            bias[0] = a[0]; bias[1] = a[1]; bias[2] = a[2]; bias[3] = a[3]; bias[4] = b[0]; bias[5] = b[1]; bias[6] = b[2]; bias[7] = b[3]; }
        v4u win[5];
#pragma unroll
        for (int j = 0; j < 4; ++j) { const int t = t0 - 2 + j; win[j + 1] = (t >= seq0 && t < seq1) ? *(const v4u*)(U + (size_t)t * NINP + C_XBC + ch) : (v4u){0u, 0u, 0u, 0u}; }
#pragma unroll
        for (int i = 0; i < 16; ++i) {
            const int t = t0 + i;
#pragma unroll
            for (int j = 0; j < 4; ++j) win[j] = win[j + 1];
            win[4] = (t + 2 < seq1) ? *(const v4u*)(U + (size_t)(t + 2) * NINP + C_XBC + ch) : (v4u){0u, 0u, 0u, 0u};
            float o[8];
#pragma unroll
            for (int c = 0; c < 8; ++c) o[c] = bias[c];
#pragma unroll
            for (int j = 0; j < 5; ++j) {
                o[0] += w[j][0] * bflo(win[j].x); o[1] += w[j][1] * bfhi(win[j].x); o[2] += w[j][2] * bflo(win[j].y); o[3] += w[j][3] * bfhi(win[j].y);
                o[4] += w[j][4] * bflo(win[j].z); o[5] += w[j][5] * bfhi(win[j].z); o[6] += w[j][6] * bflo(win[j].w); o[7] += w[j][7] * bfhi(win[j].w); }
            v4u r; r.x = pk2(silu_f(o[0]), silu_f(o[1])); r.y = pk2(silu_f(o[2]), silu_f(o[3])); r.z = pk2(silu_f(o[4]), silu_f(o[5])); r.w = pk2(silu_f(o[6]), silu_f(o[7]));
            *(v4u*)(XA + (size_t)t * XBCW + ch) = r;
        }
    }
    for (int it = gw * 64 + lane; it < T_ALL * 32; it += ngw * 64) { const int m = it >> 5, j = it & 31;
        DT[it] = softplus_f(bf2f(U[(size_t)m * NINP + C_DT + j]) + p.dt_bias[l * 32 + j]); }
}

__device__ __forceinline__ void naive_attn_item(const Prm& p, int l, int type, int m, int hh, LAS float* qs, LAS float* sc, int lane) {
    const bf16* U = (const bf16*)(p.ws + WS_U); bf16* MIX = (bf16*)(p.ws + WS_H);
    int qcol, kcol, vcol, ocol;
    if (type == 0 || type == 2) { qcol = C_QA + hh * 128; kcol = C_KA + hh * 128; vcol = C_VA + hh * 128; ocol = hh * 128; }
    else { const int kvh = hh >> 1; qcol = C_QB + hh * 128; kcol = C_KB + kvh * 128; vcol = C_VB + kvh * 128; ocol = 512 + hh * 128; }
    { const unsigned w = *(const unsigned*)(U + (size_t)m * NINP + qcol + 2 * lane); qs[2 * lane] = bflo(w); qs[2 * lane + 1] = bfhi(w); }
    int b, s = 0, qr = 0, qc = 0, krow0 = 0, kpos0 = 0;
    if (type < 2) { b = m >> 13; s = m & 8191; qr = s >> 6; qc = s & 63; } else { b = (m - T_LAT) >> 8; }
    const int nloc = type == 0 ? 512 : (type == 1 ? 384 : 0), nk = nloc + 256;
    if (type == 0) krow0 = min(max(qr - 4, 0), 120);
    if (type == 1) kpos0 = (s >> 7) * 128 - 128;
    const float* rpb = p.na_rpb + (size_t)(l * 4 + hh) * 15 * 31;
    LDS_WAIT(); __builtin_amdgcn_wave_barrier(); asm volatile("" ::: "memory");
    float mx = -INFINITY;
    for (int k0 = 0; k0 < nk; k0 += 64) {
        const int kidx = k0 + lane; int row; float bias = 0.f; bool valid = true;
        if (kidx < nloc) {
            if (type == 0) { const int kr = krow0 + (kidx >> 6), kc = kidx & 63; row = b * SEQL + kr * 64 + kc; const int c0 = min(max(qc - 8, 0), 48); valid = (kc >= c0) && (kc < c0 + 16);
                const int dr = kr - qr + 7, dc = min(max(kc - qc + 15, 0), 30); bias = rpb[dr * 31 + dc]; }
            else { const int kpos = kpos0 + kidx; valid = (kpos >= 0) && (kpos < SEQL) && (abs(s - kpos) <= 128); row = b * SEQL + min(max(kpos, 0), SEQL - 1); }
        } else row = T_LAT + b * CTXL + (kidx - nloc);
        const bf16* kp = U + (size_t)row * NINP + kcol; float d = 0.f;
#pragma unroll 4
        for (int c = 0; c < 16; ++c) { const v4u w = *(const v4u*)(kp + 8 * c); const LAS float* q = qs + 8 * c;
            d += bflo(w.x) * q[0] + bfhi(w.x) * q[1] + bflo(w.y) * q[2] + bfhi(w.y) * q[3] + bflo(w.z) * q[4] + bfhi(w.z) * q[5] + bflo(w.w) * q[6] + bfhi(w.w) * q[7]; }
        const float sv = valid ? d * ATT_SCALE + bias : -INFINITY;
        sc[kidx] = sv; mx = fmaxf(mx, sv);
    }
    mx = wave_max(mx);
    float sum = 0.f;
    for (int k0 = 0; k0 < nk; k0 += 64) { const float e = __expf(sc[k0 + lane] - mx); sc[k0 + lane] = e; sum += e; }
    sum = wave_sum(sum);
    if (type == 1 || type == 3) sum += __expf(p.wa_sink[l * 4 + hh] - mx);
    LDS_WAIT(); __builtin_amdgcn_wave_barrier(); asm volatile("" ::: "memory");
    float o0 = 0.f, o1 = 0.f;
    for (int kidx = 0; kidx < nk; ++kidx) {
        int row;
        if (kidx < nloc) { if (type == 0) row = b * SEQL + (krow0 + (kidx >> 6)) * 64 + (kidx & 63); else row = b * SEQL + min(max(kpos0 + kidx, 0), SEQL - 1); }
        else row = T_LAT + b * CTXL + (kidx - nloc);
        const float pv = sc[kidx]; const unsigned w = *(const unsigned*)(U + (size_t)row * NINP + vcol + 2 * lane);
        o0 += pv * bflo(w); o1 += pv * bfhi(w);
    }
    const float inv = 1.f / sum;
    *(unsigned*)(MIX + (size_t)m * DM + ocol + 2 * lane) = pk2(o0 * inv, o1 * inv);
    LDS_WAIT(); __builtin_amdgcn_wave_barrier(); asm volatile("" ::: "memory");
}
__device__ __forceinline__ void phase_attn_naive(const Prm& p, int l, LAS unsigned char* lds, int gw, int ngw, int wave, int lane) {
    LAS float* qs = (LAS float*)(lds + wave * 4096); LAS float* sc = qs + 128;
    const int nlat = T_LAT * 8, nctx = (l == 0) ? T_CTX * 8 : 0;
    for (int it = gw; it < nlat + nctx; it += ngw) {
        if (it < nlat) { const int m = it >> 3, h8 = it & 7; naive_attn_item(p, l, h8 >> 2, m, h8 & 3, qs, sc, lane); }
        else { const int r = it - nlat, m = T_LAT + (r >> 3), h8 = r & 7; naive_attn_item(p, l, 2 + (h8 >> 2), m, h8 & 3, qs, sc, lane); }
    }
}

__device__ __forceinline__ void phase_ssd_naive(const Prm& p, int l, int wg, int nwg, int tid) {
    const bf16* XA = (const bf16*)(p.ws + WS_XBC); const float* DT = (const float*)(p.ws + WS_DT); float* YD = (float*)(p.ws + WS_YD);
    for (int it = wg; it < 64; it += nwg) {
        const int b = it >> 5, dir = (it >> 4) & 1, h = it & 15, g = h >> 3;
        const int pp = tid >> 3, nq = tid & 7;
        const float a = -__expf(p.a_log[l * 32 + dir * 16 + h]), dsk = p.d_skip[l * 32 + dir * 16 + h];
        float hs[16];
#pragma unroll
        for (int i = 0; i < 16; ++i) hs[i] = 0.f;
#pragma unroll 4
        for (int st = 0; st < CTXL + SEQL; ++st) {
            int m; if (st < CTXL) m = T_LAT + b * CTXL + (dir ? CTXL - 1 - st : st); else { const int s = st - CTXL; m = b * SEQL + (dir ? SEQL - 1 - s : s); }
            const float dtv = DT[(size_t)m * 32 + dir * 16 + h];
            const bf16* row = XA + (size_t)m * XBCW;
            const float xv = bf2f(row[h * 64 + pp]);
            const v4u b0 = *(const v4u*)(row + 1024 + g * 128 + 16 * nq), b1 = *(const v4u*)(row + 1024 + g * 128 + 16 * nq + 8);
            const v4u c0 = *(const v4u*)(row + 1280 + g * 128 + 16 * nq), c1 = *(const v4u*)(row + 1280 + g * 128 + 16 * nq + 8);
            const float dA = __expf(a * dtv), dx = dtv * xv;
            float bv[16], cv[16];
            bv[0] = bflo(b0.x); bv[1] = bfhi(b0.x); bv[2] = bflo(b0.y); bv[3] = bfhi(b0.y); bv[4] = bflo(b0.z); bv[5] = bfhi(b0.z); bv[6] = bflo(b0.w); bv[7] = bfhi(b0.w);
            bv[8] = bflo(b1.x); bv[9] = bfhi(b1.x); bv[10] = bflo(b1.y); bv[11] = bfhi(b1.y); bv[12] = bflo(b1.z); bv[13] = bfhi(b1.z); bv[14] = bflo(b1.w); bv[15] = bfhi(b1.w);
            cv[0] = bflo(c0.x); cv[1] = bfhi(c0.x); cv[2] = bflo(c0.y); cv[3] = bfhi(c0.y); cv[4] = bflo(c0.z); cv[5] = bfhi(c0.z); cv[6] = bflo(c0.w); cv[7] = bfhi(c0.w);
            cv[8] = bflo(c1.x); cv[9] = bfhi(c1.x); cv[10] = bflo(c1.y); cv[11] = bfhi(c1.y); cv[12] = bflo(c1.z); cv[13] = bfhi(c1.z); cv[14] = bflo(c1.w); cv[15] = bfhi(c1.w);
            float part = 0.f;
#pragma unroll
            for (int i = 0; i < 16; ++i) { hs[i] = dA * hs[i] + dx * bv[i]; part += cv[i] * hs[i]; }
            part += __shfl_xor(part, 1); part += __shfl_xor(part, 2); part += __shfl_xor(part, 4);
            if (nq == 0) YD[((size_t)dir * T_ALL + m) * 1024 + h * 64 + pp] = part + dsk * xv;
        }
    }
}
__device__ __forceinline__ void phase_gnorm(const Prm& p, int l, int gw, int ngw, int lane) {
    const bf16* U = (const bf16*)(p.ws + WS_U); const float* YD = (const float*)(p.ws + WS_YD); bf16* MIX = (bf16*)(p.ws + WS_H);
    const int nrow = (l == 0) ? T_ALL : T_LAT;
    for (int m = gw; m < nrow; m += ngw) {
        f32x4 u[4]; float ss[2] = {0.f, 0.f};
#pragma unroll
        for (int j = 0; j < 4; ++j) { const int col = 256 * j + 4 * lane;
            const f32x4 y = *(const f32x4*)(YD + (size_t)m * 1024 + col) + *(const f32x4*)(YD + ((size_t)T_ALL + m) * 1024 + col);
            const v2u zz = *(const v2u*)(U + (size_t)m * NINP + C_Z + col);
            u[j][0] = y[0] * silu_f(bflo(zz.x)); u[j][1] = y[1] * silu_f(bfhi(zz.x)); u[j][2] = y[2] * silu_f(bflo(zz.y)); u[j][3] = y[3] * silu_f(bfhi(zz.y));
            ss[j >> 1] += (u[j][0] * u[j][0] + u[j][1] * u[j][1]) + (u[j][2] * u[j][2] + u[j][3] * u[j][3]); }
        const float r0 = rsqrtf(wave_sum(ss[0]) * (1.f / 512.f) + EPS), r1 = rsqrtf(wave_sum(ss[1]) * (1.f / 512.f) + EPS);
#pragma unroll
        for (int j = 0; j < 4; ++j) { const int col = 256 * j + 4 * lane; const f32x4 g = *(const f32x4*)(p.ssd_norm + l * 1024 + col); const f32x4 o = u[j] * (j < 2 ? r0 : r1) * g;
            v2u w; w.x = pk2(o[0], o[1]); w.y = pk2(o[2], o[3]); *(v2u*)(MIX + (size_t)m * DM + 1024 + col) = w; }
    }
}
__device__ __forceinline__ void phase_norm2_router(const Prm& p, int l, LAS unsigned char* lds, int wg, int nwg, int tid, int wave, int lane) {
    bf16* H = (bf16*)(p.ws + WS_H); const bf16* WR = (const bf16*)(p.ws + WS_WRT);
    const int ntok = (l == 0) ? T_ALL : T_LAT;
    constexpr int HROW = 4096 + 16;
    LAS unsigned char* hfL = lds; LAS float* part = (LAS float*)(lds + 66048); LAS float* affL = (LAS float*)(lds + 66048 + 16384);
    int* tok_e = (int*)(p.ws + WS_TOK); int* tok_pos = (int*)(p.ws + WS_TOK + TOKTAB); float* tok_gate = (float*)(p.ws + WS_TOK + 2 * TOKTAB);
    unsigned* cnt = (unsigned*)(p.ws + OFF_CNT) + l * 32 * 16;
    for (int it = wg; it < ntok / 16; it += nwg) {
        const int m0 = it * 16;
#pragma unroll
        for (int rr = 0; rr < 2; ++rr) {
            const int r = wave * 2 + rr, m = m0 + r;
            f32x4 v[8]; load_row(p, 1, -1, m, lane, v);
            const float rstd = row_rstd(v);
            const int vs = m >= T_LAT ? 2 : (m >> 13);
            const float* md = (const float*)(p.ws + OFF_MOD) + (size_t)(l * 3 + vs) * MODW;
#pragma unroll
            for (int j = 0; j < 8; ++j) { const int col = 256 * j + 4 * lane; const v2u w = modulate4(v[j], rstd, p.norm_ffn + l * DM, md + 4 * DM, md + 3 * DM, col);
                *(v2u*)(H + (size_t)m * DM + col) = w; *(LAS v2u*)(hfL + r * HROW + col * 2) = w; }
        }
        __syncthreads();
        {
            f32x4 a0 = {0.f, 0.f, 0.f, 0.f}, a1 = a0; const int fr = lane & 15, fq = lane >> 4;
#pragma unroll
            for (int ks = 0; ks < 8; ++ks) { const int k0 = wave * 256 + ks * 32 + 8 * fq;
                const bf16x8 af = *(const LAS bf16x8*)(hfL + fr * HROW + k0 * 2);
                const bf16x8 b0 = *(const bf16x8*)(WR + (size_t)fr * DM + k0), b1 = *(const bf16x8*)(WR + (size_t)(16 + fr) * DM + k0);
                a0 = __builtin_amdgcn_mfma_f32_16x16x32_bf16(af, b0, a0, 0, 0, 0); a1 = __builtin_amdgcn_mfma_f32_16x16x32_bf16(af, b1, a1, 0, 0, 0); }
#pragma unroll
            for (int i = 0; i < 4; ++i) { part[(wave * 16 + 4 * fq + i) * 32 + fr] = a0[i]; part[(wave * 16 + 4 * fq + i) * 32 + 16 + fr] = a1[i]; }
        }
        __syncthreads();
        { float s = 0.f;
#pragma unroll
          for (int w = 0; w < 8; ++w) s += part[w * 512 + tid];
          affL[tid] = sigmoid_f(s); }
        __syncthreads();
        if (tid < 16) {
            const LAS float* af = affL + tid * 32; const int m = m0 + tid;
            int bg = 0; float bs = -INFINITY;
#pragma unroll
            for (int g = 0; g < 4; ++g) { float t1 = -INFINITY, t2 = -INFINITY;
#pragma unroll
                for (int j = 0; j < 8; ++j) { const float s = af[8 * g + j] + p.router_bias[8 * g + j]; if (s > t1) { t2 = t1; t1 = s; } else if (s > t2) t2 = s; }
                const float gs = t1 + t2; if (gs > bs) { bs = gs; bg = g; } }
            float t1 = -INFINITY, t2 = -INFINITY; int i1 = 0, i2 = 0;
#pragma unroll
            for (int j = 0; j < 8; ++j) { const float s = af[8 * bg + j] + p.router_bias[8 * bg + j]; if (s > t1) { t2 = t1; i2 = i1; t1 = s; i1 = j; } else if (s > t2) { t2 = s; i2 = j; } }
            const int e0 = 8 * bg + i1, e1 = 8 * bg + i2; const float f0 = af[e0], f1 = af[e1], inv = 1.f / (f0 + f1);
            const unsigned p0 = atomicAdd(cnt + e0 * 16, 1u), p1 = atomicAdd(cnt + e1 * 16, 1u);
            tok_e[2 * m] = e0; tok_e[2 * m + 1] = e1; tok_pos[2 * m] = (int)p0; tok_pos[2 * m + 1] = (int)p1; tok_gate[2 * m] = f0 * inv; tok_gate[2 * m + 1] = f1 * inv;
        }
        __syncthreads();
    }
}
__device__ __forceinline__ void build_seg_tables(const Prm& p, int l, LAS unsigned char* lds, int tid) {
    LAS int* seg = (LAS int*)(lds + L_SEG); LAS int* cntL = (LAS int*)(lds + L_CNT); LAS int* blke = (LAS int*)(lds + L_BLKE); LAS int* nblkp = (LAS int*)(lds + L_NBLK);
    LAS int* incl = (LAS int*)(lds + L_INCL);
    const unsigned* cnt = (const unsigned*)(p.ws + OFF_CNT) + l * 32 * 16;
    __syncthreads();
    if (tid < 64) {
        const int e = tid & 31; const int c = (int)cnt[e * 16], pb = (c + 255) >> 8; int inc = pb;
#pragma unroll
        for (int o = 1; o < 32; o <<= 1) { const int t = __shfl_up(inc, o); if (e >= o) inc += t; }
        if (tid < 32) { cntL[e] = c; seg[e] = (inc - pb) * 256; incl[e] = inc; if (e == 31) { seg[32] = inc * 256; *nblkp = inc; } }
    }
    __syncthreads();
    if (tid < MAXBLK + 3) { int e = 0;
#pragma unroll
        for (int k = 0; k < 32; ++k) e += (incl[k] <= tid) ? 1 : 0;
        blke[tid] = e < 31 ? e : 31; }
    __syncthreads();
}
__device__ __forceinline__ void phase_gather(const Prm& p, int l, LAS unsigned char* lds, int gw, int ngw, int tid, int lane) {
    build_seg_tables(p, l, lds, tid);
    const LAS int* seg = (const LAS int*)(lds + L_SEG); const LAS int* cntL = (const LAS int*)(lds + L_CNT);
    const bf16* H = (const bf16*)(p.ws + WS_H); bf16* XG = (bf16*)(p.ws + WS_XG);
    const int* tok_e = (const int*)(p.ws + WS_TOK); const int* tok_pos = (const int*)(p.ws + WS_TOK + TOKTAB); int* tok_slot = (int*)(p.ws + WS_TOK + 3 * TOKTAB);
    const int ntok = (l == 0) ? T_ALL : T_LAT;
    for (int m = gw; m < ntok; m += ngw) {
        const int s0 = seg[tok_e[2 * m]] + tok_pos[2 * m], s1 = seg[tok_e[2 * m + 1]] + tok_pos[2 * m + 1];
        if (lane == 0) { tok_slot[2 * m] = s0; tok_slot[2 * m + 1] = s1; }
#pragma unroll
        for (int j = 0; j < 4; ++j) { const v4u w = *(const v4u*)(H + (size_t)m * DM + 512 * j + 8 * lane);
            *(v4u*)(XG + (size_t)s0 * DM + 512 * j + 8 * lane) = w; *(v4u*)(XG + (size_t)s1 * DM + 512 * j + 8 * lane) = w; }
    }
    for (int e = 0; e < 32; ++e) { const int c = cntL[e], pe = (c + 255) & ~255;
        for (int r = c + gw; r < pe; r += ngw) {
#pragma unroll
            for (int j = 0; j < 4; ++j) *(v4u*)(XG + (size_t)(seg[e] + r) * DM + 512 * j + 8 * lane) = (v4u){0u, 0u, 0u, 0u}; } }
}
constexpr int N_PHASES = 22;
__global__ void __launch_bounds__(NWAVES * 64, 2) mk_fwd(Prm p) {
    extern __shared__ __attribute__((aligned(16))) unsigned char lds_raw[];
    LAS unsigned char* lds = (LAS unsigned char*)lds_raw;
    const int tid0 = threadIdx.x, wave = __builtin_amdgcn_readfirstlane(tid0 >> 6);
#define OPQ int tid = tid0; asm volatile("" : "+v"(tid)); const int lane = tid & 63;
    const int G = gridDim.x, bx = blockIdx.x, vcu = (G % 8 == 0) ? (bx % 8) * (G / 8) + bx / 8 : bx;
    const int gw = vcu * NWAVES + wave, ngw = G * NWAVES;
    unsigned char* ws = p.ws;
    for (int u = tid0; u < (LDS_BYTES - LDSCTL_OFF) / 4; u += NWAVES * 64) ((LAS unsigned*)(lds + LDSCTL_OFF))[u] = 0u;
    __syncthreads();
#if MK_ONE_LAUNCH
    XcdBarrier bar = xcd_barrier_post((unsigned*)ws + CW_BAR, (volatile LAS unsigned*)(lds + L_BARW));
#define GRID_BAR() xcd_barrier(bar)
#else
#define GRID_BAR() do {} while (0)
#endif
    const int lo = p.ph_lo, hi = p.ph_hi;
#define IN(k) (lo <= (k) && (k) < hi)
    if (IN(0)) { OPQ phase_prologue(p, lds, gw, ngw, wave, lane); GRID_BAR(); }
    for (int l = 0; l < 2; ++l) {
        const int pb = 1 + 10 * l;
        if (IN(pb + 0)) { OPQ phase_norm1(p, l, gw, ngw, lane); GRID_BAR(); }
        if (IN(pb + 1)) {
            pg8::Gemm g{(const pg8::bf16_t*)(ws + WS_H), (const pg8::bf16_t*)(ws + WS_WIN) + (size_t)l * NINP * DM, T_ALL, NINP, DM};
            pg8::StaticOrder S; S.init(T_ALL, NINP, G, bx);
            pg8::EpiInProj E{(pg8::bf16_t*)(ws + WS_U), NINP, (const float*)(ws + WS_ROPE), C_QB / 256, C_VB / 256, T_LAT};
            pg8::gemm_phase<pg8::EpiInProj, pg8::StaticOrder, true, true>(lds, g, S, E);
            GRID_BAR();
        }
        if (IN(pb + 2)) { OPQ phase_conv(p, l, gw, ngw, lane); phase_attn_naive(p, l, lds, gw, ngw, wave, lane); GRID_BAR(); }
        if (IN(pb + 3)) { OPQ phase_ssd_naive(p, l, bx, G, tid); GRID_BAR(); }
        if (IN(pb + 4)) { OPQ phase_gnorm(p, l, gw, ngw, lane); GRID_BAR(); }
        if (IN(pb + 5)) {
            const int M = (l == 0) ? T_ALL : T_LAT;
            pg8::Gemm g{(const pg8::bf16_t*)(ws + WS_H), (const pg8::bf16_t*)(ws + WS_WOUT) + (size_t)l * DM * DM, M, DM, DM};
            pg8::StaticOrder S; S.init(M, DM, G, bx);
            pg8::EpiRes E{(l == 0) ? p.x : (const float*)(ws + WS_X), (float*)(ws + WS_X), (l == 0) ? p.ctx : (const float*)(ws + WS_XC), (float*)(ws + WS_XC),
                          (const float*)(ws + OFF_MOD) + (size_t)l * 3 * MODW + 2 * DM, DM, T_LAT, MODW};
            pg8::gemm_phase<pg8::EpiRes, pg8::StaticOrder, true, true>(lds, g, S, E);
            GRID_BAR();
        }
        if (IN(pb + 6)) { OPQ phase_norm2_router(p, l, lds, bx, G, tid, wave, lane); GRID_BAR(); }
        if (IN(pb + 7)) { OPQ phase_gather(p, l, lds, gw, ngw, tid, lane); GRID_BAR(); }
        if (IN(pb + 8)) {
            OPQ build_seg_tables(p, l, lds, tid);
            const int nblk = __builtin_amdgcn_readfirstlane(*(const LAS int*)(lds + L_NBLK));
            pg8::Gemm g{(const pg8::bf16_t*)(ws + WS_XG), (const pg8::bf16_t*)(ws + WS_WGU) + (size_t)l * 32 * 2048 * 2048, nblk * 256, 2048, DM};
            pg8::GroupedOrder S{G, vcu, nblk, (const LAS int*)(lds + L_BLKE), (long)2048 * 2048 * 2};
            pg8::EpiGateUp E{(pg8::bf16_t*)(ws + WS_ACT), DFF};
            pg8::gemm_phase<pg8::EpiGateUp, pg8::GroupedOrder, true, true>(lds, g, S, E);
            GRID_BAR();
        }
        if (IN(pb + 9)) {
            OPQ build_seg_tables(p, l, lds, tid);
            const int nblk = __builtin_amdgcn_readfirstlane(*(const LAS int*)(lds + L_NBLK));
            pg8::Gemm g{(const pg8::bf16_t*)(ws + WS_ACT), (const pg8::bf16_t*)(ws + WS_WDN) + (size_t)l * 32 * 2048 * 1024, nblk * 256, DM, DFF};
            pg8::GroupedOrder S{G, vcu, nblk, (const LAS int*)(lds + L_BLKE), (long)2048 * 1024 * 2};
            pg8::EpiPlain E{(pg8::bf16_t*)(ws + WS_YB), DM};
            pg8::gemm_phase<pg8::EpiPlain, pg8::GroupedOrder, true, true>(lds, g, S, E);
            GRID_BAR();
        }
    }
    if (IN(21)) { OPQ phase_final(p, gw, ngw, lane); }
#undef IN
}

extern "C" void kernel_launch(void* const* d_in, const int* in_sizes, int n_in, void* d_out, int out_size, void* d_ws, size_t ws_size, hipStream_t stream) {
    static int grid = 0;
    if (grid == 0) {
        if (n_in != 24 || in_sizes[0] != T_LAT * DM || out_size != T_LAT * DM || ws_size < WS_END) {
            fprintf(stderr, "kernel_launch: unexpected shapes: n_in %d in0 %d out %d ws %zu (need %zu)\n", n_in, n_in > 0 ? in_sizes[0] : -1, out_size, ws_size, (size_t)WS_END); grid = -1; return; }
        int dev = 0, cus = 0, per_cu = 0;
        if (hipGetDevice(&dev) != hipSuccess || hipDeviceGetAttribute(&cus, hipDeviceAttributeMultiprocessorCount, dev) != hipSuccess) { grid = -1; return; }
        if (hipFuncSetAttribute((const void*)mk_fwd, hipFuncAttributeMaxDynamicSharedMemorySize, LDS_BYTES) != hipSuccess) { fprintf(stderr, "kernel_launch: hipFuncSetAttribute failed\n"); grid = -1; return; }
        if (hipOccupancyMaxActiveBlocksPerMultiprocessor(&per_cu, (const void*)mk_fwd, NWAVES * 64, LDS_BYTES) != hipSuccess || per_cu < 1) {
            fprintf(stderr, "kernel_launch: occupancy query reports %d blocks per CU\n", per_cu); }
        (void)hipGetLastError();
        grid = cus;
    }
    if (grid < 0) return;
    if (hipMemsetAsync((char*)d_ws + WS_CTL, 0, CTL_ZERO_BYTES, stream) != hipSuccess) { fprintf(stderr, "kernel_launch: memset failed\n"); return; }
    Prm p{};
    p.x = (const float*)d_in[0]; p.c = (const float*)d_in[1]; p.ctx = (const float*)d_in[2]; p.c_ctx = (const float*)d_in[3]; p.w_ada = (const float*)d_in[4]; p.b_ada = (const float*)d_in[5];
    p.norm_mix = (const float*)d_in[6]; p.norm_ffn = (const float*)d_in[7]; p.norm_final = (const float*)d_in[8]; p.w_in = (const float*)d_in[9]; p.w_out = (const float*)d_in[10];
    p.na_rpb = (const float*)d_in[11]; p.wa_sink = (const float*)d_in[12]; p.conv_w = (const float*)d_in[13]; p.conv_b = (const float*)d_in[14]; p.a_log = (const float*)d_in[15];
    p.dt_bias = (const float*)d_in[16]; p.d_skip = (const float*)d_in[17]; p.ssd_norm = (const float*)d_in[18]; p.w_router = (const float*)d_in[19]; p.router_bias = (const float*)d_in[20];
    p.w_gate = (const float*)d_in[21]; p.w_up = (const float*)d_in[22]; p.w_down = (const float*)d_in[23];
    p.out = (float*)d_out; p.ws = (unsigned char*)d_ws;
#if MK_ONE_LAUNCH
    p.ph_lo = 0; p.ph_hi = N_PHASES;
    hipLaunchKernelGGL(mk_fwd, dim3(grid), dim3(NWAVES * 64), LDS_BYTES, stream, p);
#else
    for (int ph = 0; ph < N_PHASES; ++ph) { p.ph_lo = ph; p.ph_hi = ph + 1; hipLaunchKernelGGL(mk_fwd, dim3(grid), dim3(NWAVES * 64), LDS_BYTES, stream, p); }
#endif
    const hipError_t le = hipPeekAtLastError();
    if (le != hipSuccess) fprintf(stderr, "kernel_launch: launch failed: %s\n", hipGetErrorName(le));
}
```

```cpp
#include <hip/hip_runtime.h>
#include <cstdio>
#include <cstdint>

#ifndef MK_ONE_LAUNCH
#define MK_ONE_LAUNCH 1
#endif

#ifndef F8_INPROJ
#define F8_INPROJ 1
#endif
#ifndef F8_OUTPROJ
#define F8_OUTPROJ 1
#endif

namespace pg8 {
#define PG8_LAS __attribute__((address_space(3)))
typedef unsigned short bf16_t;
typedef short bf16x8 __attribute__((ext_vector_type(8)));
typedef float f32x4 __attribute__((ext_vector_type(4)));
typedef unsigned u32x4 __attribute__((ext_vector_type(4)));
constexpr int BM = 256, BK = 64, HALF = 128, HTB = HALF * BK * 2  , STAGE_BYTES = 8 * HTB, NXCD = 8, WGM = 8;

__host__ __device__ __forceinline__ int lds_byte(int r, int c) { const int st = (r >> 4) * 2 + (c >> 5), rr = r & 15, cc = c & 31, ob = rr * 64 + cc * 2; return st * 1024 + (ob ^ (((ob >> 9) & 1) << 5)); }
__host__ __device__ __forceinline__ void stage_rc(int b, int& R, int& C) { const int st = b / 1024, sb = b % 1024, swz = sb ^ (((sb >> 9) & 1) << 5); R = (st >> 1) * 16 + swz / 64; C = (st & 1) * 32 + (swz % 64) / 2; }
__host__ __device__ __forceinline__ int perm32(int rho) { const int n = rho >> 4, i = rho & 15; return 8 * (i >> 2) + 4 * n + (i & 3); }

typedef int i32x4v __attribute__((ext_vector_type(4)));
typedef int i32x8v __attribute__((ext_vector_type(8)));
__device__ __forceinline__ i32x8v cat8(bf16x8 a, bf16x8 b) { const i32x4v x = __builtin_bit_cast(i32x4v, a), y = __builtin_bit_cast(i32x4v, b); return __builtin_shufflevector(x, y, 0, 1, 2, 3, 4, 5, 6, 7); }
struct Unit { int pm, pn; long boff; int lo_only; };
struct Gemm { const bf16_t* A; const bf16_t* Bt; int M, N, K; };

struct StaticOrder {
    static constexpr bool SKIP_HI = false, GATHER = false; const PG8_LAS unsigned* rowtab;
    int nM, nN, nwg, G, c;
    __host__ __device__ void init(int M, int N, int G_, int c_) { nM = M / BM; nN = N / BM; nwg = nM * nN; G = G_; c = c_; }
    __host__ __device__ bool next(int i, Unit& u) const {
        const long L = (long)i * G + c; if (L >= nwg) return false;
        int wgid = (int)L; { const int q = nwg / NXCD, r = nwg % NXCD, xcd = wgid % NXCD, off = wgid / NXCD; wgid = (xcd < r ? xcd * (q + 1) : r * (q + 1) + (xcd - r) * q) + off; }
        const int nig = WGM * nN, gid = wgid / nig, fm = gid * WGM, gsz = (nM - fm) < WGM ? (nM - fm) : WGM;
        u.pm = fm + ((wgid % nig) % gsz); u.pn = (wgid % nig) / gsz; u.boff = 0; u.lo_only = 0; return true;
    }
    __device__ __forceinline__ void a_ready(const Unit&) const {}
    __device__ __forceinline__ void done(const Unit&) const {}
};

__device__ __forceinline__ unsigned cvt_pk_bf16(float lo, float hi) { unsigned r; asm volatile("v_cvt_pk_bf16_f32 %0, %1, %2" : "=v"(r) : "v"(lo), "v"(hi)); return r; }
typedef float f32x2 __attribute__((ext_vector_type(2)));
__device__ __forceinline__ f32x2 gelu_pk(f32x2 v) {
    const f32x2 av = __builtin_elementwise_abs(v), d = av * 0.2316418882f + 1.0f;
    f32x2 t; t.x = __builtin_amdgcn_rcpf(d.x); t.y = __builtin_amdgcn_rcpf(d.y);
    f32x2 q = t * 0.5307027145f + (-0.7265760135f); q = q * t + 0.7107068705f; q = q * t + (-0.142248368f); q = q * t + 0.127414796f; q = q * t;
    const f32x2 s = (v * v) * (-0.72134752044f);
    f32x2 e; e.x = __builtin_amdgcn_exp2f(s.x); e.y = __builtin_amdgcn_exp2f(s.y);
    const f32x2 m = v * (q * e), r = v - m;
    f32x2 o; o.x = v.x < 0.f ? m.x : r.x; o.y = v.y < 0.f ? m.y : r.y; return o;
}

template <class Epi, class Sched, bool ALIGN_EPI = false, bool SP2 = false, bool F8 = false>
__device__ __forceinline__ void gemm_phase(PG8_LAS unsigned char* lds, const Gemm g, const Sched& S, const Epi& E) {
    int tid_o = threadIdx.x; asm volatile("" : "+v"(tid_o));
    const int tid = tid_o, wid = __builtin_amdgcn_readfirstlane(tid >> 6), lane = tid & 63, wr = wid >> 2, wc = wid & 3, fr = lane & 15, fq = lane >> 4;
    const int K = g.K, nt = K / BK;
    unsigned voffA[2], voffB[2];
#pragma unroll
    for (int i = 0; i < 2; ++i) { int R, C; stage_rc(tid * 16 + i * 8192, R, C); const int Rb = Epi::PERM ? ((R & ~31) + perm32(R & 31)) : R;
        voffA[i] = (unsigned)(R * K + C) * 2u; voffB[i] = (unsigned)(Rb * K + C) * 2u; }
    int gR[2]; unsigned gC[2];
#pragma unroll
    for (int i = 0; i < 2; ++i) { int R, C; stage_rc(tid * 16 + i * 8192, R, C); gR[i] = R; gC[i] = (unsigned)C * 2u; }
    unsigned gc[2][2] = {{0u, 0u}, {0u, 0u}}, gn[2][2] = {{0u, 0u}, {0u, 0u}};
#define PG8_GROWS(dst, u) do { if constexpr (Sched::GATHER) { _Pragma("unroll") for (int h_ = 0; h_ < 2; ++h_) _Pragma("unroll") for (int i_ = 0; i_ < 2; ++i_) dst[h_][i_] = S.rowtab[(u) * 256 + h_ * 128 + gR[i_]] + gC[i_]; } } while (0)
#define PG8_STAGE_A(bufoff, kbase, h, nx) do { if constexpr (Sched::GATHER) { _Pragma("unroll") for (int _i = 0; _i < 2; ++_i) \
        __builtin_amdgcn_global_load_lds((const unsigned*)((const char*)(kbase) + ((nx) ? gn[h][_i] : gc[h][_i])), (PG8_LAS unsigned*)(lds + (bufoff) + ldsw + _i * 8192), 16, 0, 0); } \
        else PG8_STAGE(bufoff, (kbase) + ((h) ? hstep : 0), voffA); } while (0)
    const size_t kstep = (size_t)(BK * 2);
    const size_t hstep = (size_t)HALF * K * 2;
    const size_t tstep = 2 * hstep;
    const unsigned ldsw = (unsigned)wid * 1024u;
    const int aoff = lds_byte(wr * 64 + fr, fq * 8), boff = lds_byte(wc * 32 + fr, fq * 8);
    const int aoff8 = lds_byte(wr * 64 + fr, (fq & 1) * 16) + (fq >> 1) * 1024, boff8 = lds_byte(wc * 32 + fr, (fq & 1) * 16) + (fq >> 1) * 1024;
#define PG8_SA(b, h) (((b) * 2 + (h)) * HTB)
#define PG8_SB(b, h) ((4 + (b) * 2 + (h)) * HTB)
#define PG8_STAGE(bufoff, gbase, voff) do { _Pragma("unroll") for (int _i = 0; _i < 2; ++_i) \
        __builtin_amdgcn_global_load_lds((const unsigned*)((const char*)(gbase) + (voff)[_i]), (PG8_LAS unsigned*)(lds + (bufoff) + ldsw + _i * 8192), 16, 0, 0); } while (0)
#define PG8_LDA(dst, b, h) do { if constexpr (F8) { _Pragma("unroll") for (int m = 0; m < 4; ++m) dst##8[m] = cat8(*(const PG8_LAS bf16x8*)(lds + PG8_SA(b, h) + aoff8 + m * 2048), *(const PG8_LAS bf16x8*)(lds + PG8_SA(b, h) + aoff8 + m * 2048 + 16)); } else { \
        _Pragma("unroll") for (int m = 0; m < 4; ++m) _Pragma("unroll") for (int k = 0; k < 2; ++k) dst[m][k] = *(const PG8_LAS bf16x8*)(lds + PG8_SA(b, h) + aoff + m * 2048 + k * 1024); } } while (0)
#define PG8_LDB(dst, b, h) do { if constexpr (F8) { _Pragma("unroll") for (int n = 0; n < 2; ++n) dst##8[n] = cat8(*(const PG8_LAS bf16x8*)(lds + PG8_SB(b, h) + boff8 + n * 2048), *(const PG8_LAS bf16x8*)(lds + PG8_SB(b, h) + boff8 + n * 2048 + 16)); } else { \
        _Pragma("unroll") for (int n = 0; n < 2; ++n) _Pragma("unroll") for (int k = 0; k < 2; ++k) dst[n][k] = *(const PG8_LAS bf16x8*)(lds + PG8_SB(b, h) + boff + n * 2048 + k * 1024); } } while (0)
#define PG8_MMA(ai, bj, At, Bt) do { __builtin_amdgcn_s_setprio(1); if constexpr (F8) { _Pragma("unroll") for (int m = 0; m < 4; ++m) _Pragma("unroll") for (int n = 0; n < 2; ++n) \
        asm volatile("v_mfma_scale_f32_16x16x128_f8f6f4 %0, %1, %2, %0, %3, %3 op_sel_hi:[0,0,0]" : "+v"(acc[ai][bj][m][n]) : "v"(Bt##8[n]), "v"(At##8[m]), "v"(sc1)); } else { \
        _Pragma("unroll") for (int m = 0; m < 4; ++m) _Pragma("unroll") for (int n = 0; n < 2; ++n) _Pragma("unroll") for (int k = 0; k < 2; ++k) \
        acc[ai][bj][m][n] = __builtin_amdgcn_mfma_f32_16x16x32_bf16(Bt[n][k], At[m][k], acc[ai][bj][m][n], 0, 0, 0); } __builtin_amdgcn_s_setprio(0); } while (0)
#define PG8_WAIT_V(n) asm volatile("s_waitcnt vmcnt(" #n ")" ::: "memory")
#define PG8_WAIT_L(n) asm volatile("s_waitcnt lgkmcnt(" #n ")" ::: "memory")
#define PG8_BAR __builtin_amdgcn_s_barrier()
#define PG8_SCHED __builtin_amdgcn_sched_barrier(0)
    Unit cur, nxt; int ui = 0;
    if (!S.next(0, cur)) return;
    f32x4 acc[2][2][4][2];
#pragma unroll
    for (int a = 0; a < 2; ++a)
#pragma unroll
        for (int b = 0; b < 2; ++b)
#pragma unroll
            for (int m = 0; m < 4; ++m)
#pragma unroll
                for (int n = 0; n < 2; ++n) acc[a][b][m][n] = (f32x4){0.f, 0.f, 0.f, 0.f};
    const int sc1 = 0x7F7F7F7F;
    bf16x8 At[4][2], B0[2][2], B1[2][2]; i32x8v At8[4], B08[2], B18[2];
    const char* cA = (const char*)g.A + (Sched::GATHER ? (size_t)0 : (size_t)cur.pm * tstep); PG8_GROWS(gc, 0); const char* cB = (const char*)g.Bt + (size_t)cur.pn * tstep + cur.boff;
    S.a_ready(cur);
    if constexpr (SP2) {
        PG8_STAGE(PG8_SB(0, 0), cB, voffB); PG8_STAGE(PG8_SB(0, 1), cB + hstep, voffB); PG8_STAGE_A(PG8_SA(0, 0), cA, 0, false); PG8_STAGE_A(PG8_SA(0, 1), cA, 1, false);
        if (wr == 1) PG8_BAR;
        PG8_WAIT_V(2); PG8_BAR;
        PG8_STAGE(PG8_SB(1, 0), cB + kstep, voffB); PG8_STAGE_A(PG8_SA(1, 0), cA + kstep, 0, false); PG8_STAGE(PG8_SB(1, 1), cB + hstep + kstep, voffB);
        PG8_WAIT_V(6); PG8_BAR;
    } else {
        PG8_STAGE(PG8_SB(0, 0), cB, voffB); PG8_STAGE_A(PG8_SA(0, 0), cA, 0, false); PG8_STAGE(PG8_SB(0, 1), cB + hstep, voffB); PG8_STAGE_A(PG8_SA(0, 1), cA, 1, false);
        if (wr == 1) PG8_BAR;
        PG8_WAIT_V(4); PG8_BAR;
        PG8_STAGE(PG8_SB(1, 0), cB + kstep, voffB); PG8_STAGE_A(PG8_SA(1, 0), cA + kstep, 0, false); PG8_STAGE(PG8_SB(1, 1), cB + hstep + kstep, voffB);
        PG8_WAIT_V(6); PG8_BAR;
    }
    for (;;) {
        const bool has_next = S.next(ui + 1, nxt);
        const char* nA = has_next ? (const char*)g.A + (Sched::GATHER ? (size_t)0 : (size_t)nxt.pm * tstep) : cA; if (has_next) PG8_GROWS(gn, ui + 1); const char* nB = has_next ? (const char*)g.Bt + (size_t)nxt.pn * tstep + nxt.boff : cB;
        const bool hi_on = !Sched::SKIP_HI || cur.lo_only == 0;
#pragma unroll 1
        for (int t = 0; t < nt; t += 2) {
            const bool last = (t == nt - 2);
            const char* a1 = cA + (size_t)(t + 1) * kstep;
            const char* a2 = last ? nA : cA + (size_t)(t + 2) * kstep; const char* b2 = last ? nB : cB + (size_t)(t + 2) * kstep;
            const char* a3 = a2 + kstep; const char* b3 = b2 + kstep;
            const bool nx_ = last && has_next;
            if (last && has_next) S.a_ready(nxt);
            if constexpr (SP2) {
            PG8_LDB(B0, 0, 0); PG8_LDB(B1, 0, 1); PG8_SCHED; PG8_LDA(At, 0, 0); PG8_STAGE_A(PG8_SA(1, 1), a1, 1, false);
            PG8_WAIT_V(8); PG8_WAIT_L(0); PG8_BAR; PG8_MMA(0, 0, At, B0); PG8_MMA(0, 1, At, B1); PG8_BAR; PG8_SCHED;
            PG8_LDA(At, 0, 1); PG8_STAGE(PG8_SB(0, 0), b2, voffB); PG8_STAGE(PG8_SB(0, 1), b2 + hstep, voffB); PG8_STAGE_A(PG8_SA(0, 0), a2, 0, nx_);
            PG8_WAIT_V(8); PG8_WAIT_L(0); PG8_BAR; if (__builtin_expect(hi_on, 1)) { PG8_MMA(1, 0, At, B0); PG8_MMA(1, 1, At, B1); } PG8_BAR; PG8_SCHED;
            PG8_LDB(B0, 1, 0); PG8_LDB(B1, 1, 1); PG8_SCHED; PG8_LDA(At, 1, 0); PG8_STAGE_A(PG8_SA(0, 1), a2, 1, nx_);
            PG8_WAIT_V(8); PG8_WAIT_L(0); PG8_BAR; PG8_MMA(0, 0, At, B0); PG8_MMA(0, 1, At, B1); PG8_BAR; PG8_SCHED;
            PG8_LDA(At, 1, 1); PG8_STAGE(PG8_SB(1, 0), b3, voffB); PG8_STAGE(PG8_SB(1, 1), b3 + hstep, voffB); PG8_STAGE_A(PG8_SA(1, 0), a3, 0, nx_);
            PG8_WAIT_V(8); PG8_WAIT_L(0); PG8_BAR; if (__builtin_expect(hi_on, 1)) { PG8_MMA(1, 0, At, B0); PG8_MMA(1, 1, At, B1); } PG8_BAR; PG8_SCHED;
            } else {
            PG8_LDB(B0, 0, 0); PG8_SCHED; PG8_LDA(At, 0, 0); PG8_STAGE_A(PG8_SA(1, 1), a1, 1, false);
            PG8_WAIT_L(8); PG8_BAR; PG8_WAIT_L(0); PG8_MMA(0, 0, At, B0); PG8_BAR; PG8_SCHED;
            PG8_LDB(B1, 0, 1); PG8_STAGE(PG8_SB(0, 0), b2, voffB);
            PG8_BAR; PG8_WAIT_L(0); PG8_MMA(0, 1, At, B1); PG8_BAR;
            PG8_LDA(At, 0, 1); PG8_STAGE_A(PG8_SA(0, 0), a2, 0, nx_);
            PG8_BAR; PG8_WAIT_L(0); PG8_MMA(1, 0, At, B0); PG8_BAR; PG8_SCHED;
            PG8_STAGE(PG8_SB(0, 1), b2 + hstep, voffB);
            PG8_WAIT_V(6); PG8_BAR; PG8_MMA(1, 1, At, B1); PG8_BAR;
            PG8_LDB(B0, 1, 0); PG8_SCHED; PG8_LDA(At, 1, 0); PG8_STAGE_A(PG8_SA(0, 1), a2, 1, nx_);
            PG8_WAIT_L(8); PG8_BAR; PG8_WAIT_L(0); PG8_MMA(0, 0, At, B0); PG8_BAR; PG8_SCHED;
            PG8_LDB(B1, 1, 1); PG8_STAGE(PG8_SB(1, 0), b3, voffB);
            PG8_BAR; PG8_WAIT_L(0); PG8_MMA(0, 1, At, B1); PG8_BAR;
            PG8_LDA(At, 1, 1); PG8_STAGE_A(PG8_SA(1, 0), a3, 0, nx_);
            PG8_BAR; PG8_WAIT_L(0); PG8_MMA(1, 0, At, B0); PG8_BAR; PG8_SCHED;
            PG8_STAGE(PG8_SB(1, 1), b3 + hstep, voffB);
            PG8_WAIT_V(6); PG8_BAR; PG8_MMA(1, 1, At, B1); PG8_BAR;
            }
        }
        if constexpr (F8) asm volatile("s_nop 15\n\ts_nop 15" ::: "memory");
        if constexpr (ALIGN_EPI) { if (wr == 0) PG8_BAR; }
        if constexpr (!Epi::AFTER_DRAIN) { E(acc, cur, wr, wc, fr, fq); S.done(cur); }
        if (!has_next) break;
#pragma unroll
        for (int a = 0; a < 2; ++a)
#pragma unroll
            for (int b = 0; b < 2; ++b)
#pragma unroll
                for (int m = 0; m < 4; ++m)
#pragma unroll
                    for (int n = 0; n < 2; ++n) acc[a][b][m][n] = (f32x4){0.f, 0.f, 0.f, 0.f};
        cur = nxt; cA = nA; cB = nB; ++ui;
        if constexpr (Sched::GATHER) { gc[0][0] = gn[0][0]; gc[0][1] = gn[0][1]; gc[1][0] = gn[1][0]; gc[1][1] = gn[1][1]; }
        if constexpr (ALIGN_EPI) { if (wr == 1) PG8_BAR; }
    }
    PG8_WAIT_V(0);
    if constexpr (!ALIGN_EPI) { if (wr == 0) PG8_BAR; }
    PG8_BAR;
    if constexpr (Epi::AFTER_DRAIN) { E.fused(acc, cur, wr, wc, fr, fq, lds, wid, lane); S.done(cur); }
#undef PG8_SA
#undef PG8_SB
#undef PG8_STAGE
#undef PG8_STAGE_A
#undef PG8_GROWS
#undef PG8_LDA
#undef PG8_LDB
#undef PG8_MMA
#undef PG8_WAIT_V
#undef PG8_WAIT_L
#undef PG8_BAR
#undef PG8_SCHED
}
typedef unsigned u32x2e __attribute__((ext_vector_type(2)));
struct EpiPlain {
    static constexpr bool PERM = true, AFTER_DRAIN = false;
    bf16_t* O; int ldc; float scale;
    __device__ __forceinline__ void operator()(const f32x4 (&acc)[2][2][4][2], const Unit& u, int wr, int wc, int fr, int fq) const {
        const int row0 = u.pm * BM + wr * 64 + fr, col0 = u.pn * BM + wc * 32 + 8 * fq;
        float one = scale; asm volatile("" : "+v"(one));
#pragma unroll
        for (int ai = 0; ai < 2; ++ai)
#pragma unroll
            for (int m = 0; m < 4; ++m) { bf16_t* rowp = O + (size_t)(row0 + ai * HALF + m * 16) * ldc + col0;
#pragma unroll
                for (int bj = 0; bj < 2; ++bj) { const f32x4 v0 = acc[ai][bj][m][0] * one, v1 = acc[ai][bj][m][1] * one;
                    u32x4 w; w.x = cvt_pk_bf16(v0[0], v0[1]); w.y = cvt_pk_bf16(v0[2], v0[3]); w.z = cvt_pk_bf16(v1[0], v1[1]); w.w = cvt_pk_bf16(v1[2], v1[3]);
                    *(u32x4*)(rowp + bj * HALF) = w; } }
    }
};
struct EpiF8 {
    static constexpr bool PERM = true, AFTER_DRAIN = false;
    unsigned char* O; int ldc; float scale;
    __device__ __forceinline__ void operator()(const f32x4 (&acc)[2][2][4][2], const Unit& u, int wr, int wc, int fr, int fq) const {
        const int row0 = u.pm * BM + wr * 64 + fr, col0 = u.pn * BM + wc * 32 + 8 * fq;
        float one = scale; asm volatile("" : "+v"(one));
#pragma unroll
        for (int ai = 0; ai < 2; ++ai)
#pragma unroll
            for (int m = 0; m < 4; ++m) { unsigned char* rowp = O + (size_t)(row0 + ai * HALF + m * 16) * ldc + col0;
#pragma unroll
                for (int bj = 0; bj < 2; ++bj) { const f32x4 v0 = acc[ai][bj][m][0] * one, v1 = acc[ai][bj][m][1] * one;
                    u32x2e w; { int t = __builtin_amdgcn_cvt_pk_fp8_f32(v0[0], v0[1], 0, false); t = __builtin_amdgcn_cvt_pk_fp8_f32(v0[2], v0[3], t, true); w.x = (unsigned)t; }
                    { int t = __builtin_amdgcn_cvt_pk_fp8_f32(v1[0], v1[1], 0, false); t = __builtin_amdgcn_cvt_pk_fp8_f32(v1[2], v1[3], t, true); w.y = (unsigned)t; }
                    *(u32x2e*)(rowp + bj * HALF) = w; } }
    }
};
struct EpiInProj {
    static constexpr bool PERM = true, AFTER_DRAIN = false;
    bf16_t* O; int ldc; const float* rope; int rope_lo, rope_hi, lat_rows; float scale;
    __device__ __forceinline__ void operator()(const f32x4 (&acc)[2][2][4][2], const Unit& u, int wr, int wc, int fr, int fq) const {
        const int row0 = u.pm * BM + wr * 64 + fr, col0 = u.pn * BM + wc * 32 + 8 * fq;
        const bool do_rope = (u.pn >= rope_lo) && (u.pn < rope_hi) && (u.pm * BM < lat_rows);
        const int i0 = 16 * (wc & 1) + 4 * fq, half = wc >> 1;
        float one = scale; asm volatile("" : "+v"(one));
#pragma unroll
        for (int ai = 0; ai < 2; ++ai)
#pragma unroll
            for (int m = 0; m < 4; ++m) { const int row = row0 + ai * HALF + m * 16; bf16_t* rowp = O + (size_t)row * ldc + col0;
                f32x4 cs0 = {1.f, 0.f, 1.f, 0.f}, cs1 = {1.f, 0.f, 1.f, 0.f};
                if (do_rope) { const int s = row & 8191, pos = half ? (s & 63) : (s >> 6); const f32x4* tp = (const f32x4*)(rope + (size_t)(pos * 32 + i0) * 2); cs0 = tp[0]; cs1 = tp[1]; }
#pragma unroll
                for (int bj = 0; bj < 2; ++bj) { f32x4 v0 = acc[ai][bj][m][0] * one, v1 = acc[ai][bj][m][1] * one;
                    if (do_rope) {
                        const f32x4 a = v0, b = v1;
                        v0[0] = a[0] * cs0[0] - a[1] * cs0[1]; v0[1] = a[1] * cs0[0] + a[0] * cs0[1];
                        v0[2] = a[2] * cs0[2] - a[3] * cs0[3]; v0[3] = a[3] * cs0[2] + a[2] * cs0[3];
                        v1[0] = b[0] * cs1[0] - b[1] * cs1[1]; v1[1] = b[1] * cs1[0] + b[0] * cs1[1];
                        v1[2] = b[2] * cs1[2] - b[3] * cs1[3]; v1[3] = b[3] * cs1[2] + b[2] * cs1[3];
                    }
                    u32x4 w; w.x = cvt_pk_bf16(v0[0], v0[1]); w.y = cvt_pk_bf16(v0[2], v0[3]); w.z = cvt_pk_bf16(v1[0], v1[1]); w.w = cvt_pk_bf16(v1[2], v1[3]);
                    *(u32x4*)(rowp + bj * HALF) = w; } }
    }
};
struct EpiRes {
    static constexpr bool PERM = true, AFTER_DRAIN = false;
    const void* xin; bf16_t* xout; const void* cin; bf16_t* cout; const float* gate;
    int ldc, lat_rows, gstride; float scale; int in_f32;
    __device__ __forceinline__ void operator()(const f32x4 (&acc)[2][2][4][2], const Unit& u, int wr, int wc, int fr, int fq) const {
        const int row0 = u.pm * BM + wr * 64 + fr, col0 = u.pn * BM + wc * 32 + 8 * fq;
        const bool isc = u.pm * BM >= lat_rows;
        const int vs = isc ? 2 : ((u.pm * BM) >> 13), rsub = isc ? lat_rows : 0;
        const void* bp = isc ? cin : xin; bf16_t* op = isc ? cout : xout;
        f32x4 gv[2][2];
#pragma unroll
        for (int bj = 0; bj < 2; ++bj)
#pragma unroll
            for (int n = 0; n < 2; ++n) { typedef int i32x4 __attribute__((ext_vector_type(4))); const i32x4 q = *(const i32x4*)(gate + (size_t)vs * gstride + col0 + bj * HALF + 4 * n);
                gv[bj][n] = (f32x4){(float)q[0], (float)q[1], (float)q[2], (float)q[3]} * (scale * (1.f / 16777216.f)); }
#pragma unroll
        for (int ai = 0; ai < 2; ++ai)
#pragma unroll
            for (int m = 0; m < 4; ++m) { const size_t off = (size_t)(row0 - rsub + ai * HALF + m * 16) * ldc + col0;
#pragma unroll
                for (int bj = 0; bj < 2; ++bj) { f32x4 b0, b1;
                    if (in_f32) { b0 = *(const f32x4*)((const float*)bp + off + bj * HALF); b1 = *(const f32x4*)((const float*)bp + off + bj * HALF + 4); }
                    else { const u32x4 w = *(const u32x4*)((const bf16_t*)bp + off + bj * HALF);
                        b0 = (f32x4){__builtin_bit_cast(float, w.x << 16), __builtin_bit_cast(float, w.x & 0xffff0000u), __builtin_bit_cast(float, w.y << 16), __builtin_bit_cast(float, w.y & 0xffff0000u)};
                        b1 = (f32x4){__builtin_bit_cast(float, w.z << 16), __builtin_bit_cast(float, w.z & 0xffff0000u), __builtin_bit_cast(float, w.w << 16), __builtin_bit_cast(float, w.w & 0xffff0000u)}; }
                    const f32x4 o0 = b0 + gv[bj][0] * acc[ai][bj][m][0], o1 = b1 + gv[bj][1] * acc[ai][bj][m][1];
                    u32x4 w; w.x = cvt_pk_bf16(o0[0], o0[1]); w.y = cvt_pk_bf16(o0[2], o0[3]); w.z = cvt_pk_bf16(o1[0], o1[1]); w.w = cvt_pk_bf16(o1[2], o1[3]);
                    *(u32x4*)(op + off + bj * HALF) = w; } }
    }
};
__device__ __forceinline__ unsigned pack4_fp8(float a, float b, float c, float d) { int w = __builtin_amdgcn_cvt_pk_fp8_f32(a, b, 0, false); w = __builtin_amdgcn_cvt_pk_fp8_f32(c, d, w, true); return (unsigned)w; }
struct EpiGateUp {
    static constexpr bool PERM = true, AFTER_DRAIN = false;
    unsigned char* O; int ldc; float wscale;
    __device__ __forceinline__ void operator()(const f32x4 (&acc)[2][2][4][2], const Unit& u, int wr, int wc, int fr, int fq) const {
        const int row0 = u.pm * BM + wr * 64 + fr, col0 = (u.pn * BM + wc * 32 + 8 * fq) >> 1;
        float ws = wscale; asm volatile("" : "+v"(ws));
#pragma unroll
        for (int ai = 0; ai < 2; ++ai)
#pragma unroll
            for (int m = 0; m < 4; ++m) { unsigned char* rowp = O + (size_t)(row0 + ai * HALF + m * 16) * ldc + col0;
#pragma unroll
                for (int bj = 0; bj < 2; ++bj) { const f32x4 g = acc[ai][bj][m][0] * ws, up = acc[ai][bj][m][1] * ws; f32x4 a;
#pragma unroll
                    for (int i = 0; i < 4; ++i) a[i] = g[i] * __builtin_amdgcn_rcpf(1.f + __expf(-g[i])) * up[i];
                    *(unsigned*)(rowp + bj * (HALF / 2)) = pack4_fp8(a[0], a[1], a[2], a[3]); } }
    }
};
template <bool SKIP, bool GATH = false> struct GroupedOrderT {
    static constexpr bool SKIP_HI = SKIP, GATHER = GATH;
    static constexpr int nN = 8;
    int G, c, nblk; const PG8_LAS int* blk_e; const PG8_LAS int* blk_h; long estride; const PG8_LAS unsigned* rowtab;
    __device__ __forceinline__ bool next(int i, Unit& u) const {
        const int L = i * G + c; if (L >= nblk * nN) return false;
        u.pm = L >> 3; u.pn = L & 7; u.boff = (long)__builtin_amdgcn_readfirstlane(blk_e[u.pm]) * estride; u.lo_only = __builtin_amdgcn_readfirstlane(blk_h[u.pm]); return true;
    }
    __device__ __forceinline__ void a_ready(const Unit&) const {}
    __device__ __forceinline__ void done(const Unit&) const {}
};
}
constexpr int DM = 2048, T_LAT = 16384, T_CTX = 512, T_ALL = 16896, SEQL = 8192, CTXL = 256;
constexpr int NIN = 5152, NINP = 5376;
constexpr int C_QA = 0, C_KA = 512, C_VA = 1024, C_QB = 1536, C_KB = 2048, C_VB = 2304, C_Z = 2560, C_XBC = 3584, C_DT = 5120;
constexpr int XBCW = 1536, DFF = 1024, NEXP = 32, MODW = 12288;
constexpr float EPS = 1e-6f, ATT_SCALE = 0.088388347648318440f;
constexpr int MAXBLK = 165, MAXSLOT = MAXBLK * 256;
constexpr int NWAVES = 8;

constexpr size_t MiB = 1u << 20;
constexpr size_t WS_CTL = 0, CTL_ZERO_BYTES = 2 * MiB;
constexpr int CW_BAR = 4096;
constexpr size_t OFF_Q = 32768;
constexpr size_t OFF_CNT = 65536;
constexpr size_t OFF_MOD = 1 * MiB;
constexpr size_t WS_ROPE = 2 * MiB;
constexpr size_t WS_WRT = 3 * MiB;
constexpr size_t WS_WIN = 8 * MiB;
constexpr size_t WS_WOUT = 50 * MiB;
constexpr size_t WS_WGU = 66 * MiB;
constexpr size_t WS_WDN = 578 * MiB;
constexpr size_t WS_H = 834 * MiB;
constexpr size_t WS_U = 900 * MiB;
constexpr size_t WS_X = 1074 * MiB;
constexpr size_t WS_XC = 1202 * MiB;
constexpr size_t WS_XBC = 1206 * MiB;
constexpr size_t WS_DT = 1256 * MiB;
constexpr size_t WS_YD = 1260 * MiB;
constexpr size_t WS_XG = 1392 * MiB;
constexpr size_t WS_ACT = 1557 * MiB;
constexpr size_t WS_YB = 1640 * MiB;
constexpr size_t WS_TOK = 1805 * MiB;
constexpr size_t WS_END = 1808 * MiB;
constexpr size_t WS_LIST = WS_XG + 64 * MiB;
constexpr int LCAP = 2 * T_ALL;
constexpr unsigned ZERO_OFF = 1536u * 1024u;
constexpr size_t TOKTAB = (size_t)T_ALL * 2 * 4;
static_assert(WS_WIN + (size_t)2 * NINP * DM * 2 <= WS_WOUT && WS_WGU + (size_t)2 * 32 * 2048 * 2048 * 2 <= WS_WDN && WS_WDN + (size_t)2 * 32 * 2048 * 1024 * 2 <= WS_H, "ws map 1");
static_assert(WS_H + (size_t)T_ALL * DM * 2 <= WS_U && WS_U + (size_t)T_ALL * NINP * 2 <= WS_X && WS_X + (size_t)T_LAT * DM * 4 <= WS_XC && WS_XBC + (size_t)T_ALL * XBCW * 2 <= WS_DT, "ws map 2");
static_assert(WS_DT + (size_t)T_ALL * 32 * 4 <= WS_YD && WS_YD + (size_t)2 * T_ALL * 1024 * 4 <= WS_XG && WS_XG + (size_t)MAXSLOT * DM * 2 <= WS_ACT && WS_ACT + (size_t)MAXSLOT * DFF * 2 <= WS_YB && WS_YB + (size_t)MAXSLOT * DM * 2 <= WS_TOK && WS_TOK + 4 * TOKTAB <= WS_END, "ws map 3");

constexpr int RING_BYTES = 131072, LDSCTL_OFF = RING_BYTES, LDS_BYTES = 147456;
constexpr int L_BARW = LDSCTL_OFF;
constexpr int L_BWORK = LDSCTL_OFF + 32;
constexpr int L_SEG = LDSCTL_OFF + 64;
constexpr int L_CNT = LDSCTL_OFF + 256;
constexpr int L_BLKE = LDSCTL_OFF + 512;
constexpr int L_NBLK = LDSCTL_OFF + 1536;
constexpr int L_INCL = LDSCTL_OFF + 1600;
constexpr int L_PB = LDSCTL_OFF + 1792;
constexpr int L_ROWT = LDSCTL_OFF + 4096;
constexpr int L_BLKH = LDSCTL_OFF + 2048;

#define GAS __attribute__((address_space(1)))
#define LAS __attribute__((address_space(3)))
typedef unsigned short bf16;
typedef unsigned v4u __attribute__((ext_vector_type(4)));
typedef unsigned v2u __attribute__((ext_vector_type(2)));
typedef float f32x4 __attribute__((ext_vector_type(4)));
typedef float f32x2 __attribute__((ext_vector_type(2)));
typedef short bf16x8 __attribute__((ext_vector_type(8)));
#define LDS_WAIT() asm volatile("s_waitcnt lgkmcnt(0)" ::: "memory")
#define VM_WAIT() asm volatile("s_waitcnt vmcnt(0)" ::: "memory")
__device__ __forceinline__ unsigned f2bf(float f) { unsigned u = __builtin_bit_cast(unsigned, f); return (u + 0x7fffu + ((u >> 16) & 1u)) >> 16; }
__device__ __forceinline__ unsigned pk2(float lo, float hi) { return f2bf(lo) | (f2bf(hi) << 16); }
__device__ __forceinline__ float bflo(unsigned w) { return __builtin_bit_cast(float, w << 16); }
__device__ __forceinline__ float bfhi(unsigned w) { return __builtin_bit_cast(float, w & 0xffff0000u); }
__device__ __forceinline__ float bf2f(bf16 b) { return __builtin_bit_cast(float, (unsigned)b << 16); }
__device__ __forceinline__ float wave_sum(float v) {
#pragma unroll
    for (int o = 1; o < 64; o <<= 1) v += __shfl_xor(v, o);
    return v;
}
__device__ __forceinline__ float wave_max(float v) {
#pragma unroll
    for (int o = 1; o < 64; o <<= 1) v = fmaxf(v, __shfl_xor(v, o));
    return v;
}
__device__ __forceinline__ float silu_f(float x) { return x / (1.f + __expf(-x)); }
__device__ __forceinline__ float sigmoid_f(float x) { return 1.f / (1.f + __expf(-x)); }
__device__ __forceinline__ float softplus_f(float x) { return x > 20.f ? x : log1pf(__expf(x)); }

#define XB_TMO      128
#define XB_XCNT(j)  (256  + 64 * (j))
#define XB_XSUB(j)  (1280 + 64 * (j))
#define XB_XGEN(j)  (2304 + 64 * (j))
#define XB_TOP      3328
#define XB_TOPGEN   3392
#define XCD_BAR_WORDS 3456
#define XB_SPIN_CAP (1u << 18)


__device__ __forceinline__ unsigned xb_ld(unsigned* p)              { return __hip_atomic_load(p, __ATOMIC_RELAXED, __HIP_MEMORY_SCOPE_AGENT); }
__device__ __forceinline__ unsigned xb_add(unsigned* p, unsigned v) { return __hip_atomic_fetch_add(p, v, __ATOMIC_RELAXED, __HIP_MEMORY_SCOPE_AGENT); }
__device__ __forceinline__ unsigned xb_xcc_id() { return (unsigned)__builtin_amdgcn_s_getreg((3 << 11) | 20) & 0xFu; }
#define XB_SPIN(cond, bar) do { unsigned _sp = 0; while (cond) { __builtin_amdgcn_s_sleep(1); \
    if ((++_sp & 255u) == 0u) { if (xb_ld(&(bar)[XB_TMO])) break; if (_sp > XB_SPIN_CAP) { atomicAdd(&(bar)[XB_TMO], 1u); break; } } } } while (0)

struct XcdBarrier {
    unsigned* bar; unsigned x;
    volatile LAS unsigned* st;
};

__device__ __forceinline__ XcdBarrier xcd_barrier_post(unsigned* bar, volatile LAS unsigned* st) {
    XcdBarrier b; b.bar = bar; b.x = xb_xcc_id(); b.st = st;
    if (threadIdx.x == 0) (void)xb_add(&bar[XB_XCNT(b.x)], 1u);
    return b;
}
__device__ __forceinline__ void xcd_barrier_complete(unsigned* bar, unsigned x, unsigned& nloc, unsigned& nx) {
    const unsigned G = gridDim.x * gridDim.y * gridDim.z;
    unsigned sum, cnt, mine, sp = 0u;
    for (;;) {
        sum = 0u; cnt = 0u; mine = 0u;
#pragma unroll
        for (unsigned j = 0; j < 16; ++j) { const unsigned c = xb_ld(&bar[XB_XCNT(j)]); sum += c; cnt += (c > 0u) ? 1u : 0u; mine = (j == x) ? c : mine; }
        if (sum == G) break;
        __builtin_amdgcn_s_sleep(1);
        if ((++sp & 255u) == 0u) { if (xb_ld(&bar[XB_TMO])) break; if (sp > XB_SPIN_CAP) { atomicAdd(&bar[XB_TMO], 1u); break; } }
    }
    nloc = mine > 0u ? mine : 1u; nx = cnt > 0u ? cnt : 1u;
}

__device__ __forceinline__ void xcd_barrier(const XcdBarrier& b) {
    asm volatile("s_waitcnt vmcnt(0)" ::: "memory");
    __syncthreads();
    if (threadIdx.x == 0) {
        unsigned* bar = b.bar;
        __builtin_amdgcn_s_waitcnt(0);
        unsigned nloc = b.st[0], nx = b.st[1];
        if (nloc == 0u) { xcd_barrier_complete(bar, b.x, nloc, nx); b.st[0] = nloc; b.st[1] = nx; }
        const unsigned old = xb_add(&bar[XB_XSUB(b.x)], 1u);
        const unsigned gen = old / nloc;
        if (old + 1u == (gen + 1u) * nloc) {
            __builtin_amdgcn_fence(__ATOMIC_RELEASE, "agent");
            asm volatile("s_waitcnt vmcnt(0)" ::: "memory");
            const unsigned og = xb_add(&bar[XB_TOP], 1u);
            const unsigned tg = og / nx;
            if (og + 1u == (tg + 1u) * nx) xb_add(&bar[XB_TOPGEN], 1u);
            else XB_SPIN(xb_ld(&bar[XB_TOPGEN]) == tg, bar);
            __builtin_amdgcn_fence(__ATOMIC_ACQUIRE, "agent");
            xb_add(&bar[XB_XGEN(b.x)], 1u);
            asm volatile("s_waitcnt vmcnt(0)" ::: "memory");
        } else {
            XB_SPIN(xb_ld(&bar[XB_XGEN(b.x)]) == gen, bar);
            __builtin_amdgcn_fence(__ATOMIC_ACQUIRE, "agent");
            asm volatile("s_waitcnt vmcnt(0)" ::: "memory");
        }
    }
    __syncthreads();
}
struct Prm {
    const float *x, *c, *ctx, *c_ctx, *w_ada, *b_ada, *norm_mix, *norm_ffn, *norm_final, *w_in, *w_out, *na_rpb, *wa_sink,
                *conv_w, *conv_b, *a_log, *dt_bias, *d_skip, *ssd_norm, *w_router, *router_bias, *w_gate, *w_up, *w_down;
    float* out; unsigned char* ws; int ph_lo, ph_hi;
};

__device__ __forceinline__ int perm_in(int n) {
    if (n >= C_QB && n < C_VB) { const int p = (n - C_QB) & 127, hb = n - p, half = p >> 6, pp = p & 63; return hb + half * 64 + (pp >> 1) + 32 * (pp & 1); }
    return n;
}
__device__ __forceinline__ unsigned pack4f8(float a, float b, float c, float d) { int w = __builtin_amdgcn_cvt_pk_fp8_f32(a, b, 0, false); w = __builtin_amdgcn_cvt_pk_fp8_f32(c, d, w, true); return (unsigned)w; }
#ifndef CONV_QUEUE
#define CONV_QUEUE 1
#endif
constexpr float W8_SCALE = 64.f, MIX_SCALE = 8.f, Y8_SCALE = 8.f;
struct TDesc { const float* colp; size_t ld; unsigned char* wt; int ok, k0, K, n0; };
constexpr int TK_IN = 2 * 32 * (NINP / 32), TK_OUT = 2 * 32 * 64, TK_GU = 2 * 32 * 32 * 64, TK_DN = 2 * 32 * 16 * 64, TK_RT = 32;
template <bool F8SEL> __device__ __forceinline__ constexpr int t_count() {
    return ((F8_INPROJ != 0) == F8SEL ? TK_IN : 0) + ((F8_OUTPROJ != 0) == F8SEL ? TK_OUT : 0) + (F8SEL ? TK_GU + TK_DN : TK_RT);
}
template <bool F8SEL> __device__ __forceinline__ TDesc t_decode(const Prm& p, int it, int lane) {
    unsigned char* ws = p.ws; TDesc d; int r = it;
    if ((F8_INPROJ != 0) == F8SEL) { if (r < TK_IN) { const int sub = r & 1, r2 = r >> 1, l = r2 / (TK_IN / 4), q = r2 % (TK_IN / 4), kb = 2 * (q / (NINP / 32)) + sub, nb = q % (NINP / 32), nn = 32 * nb + (lane & 31); const bool ok = nn < NIN;
            d.colp = p.w_in + (size_t)l * DM * NIN + (ok ? perm_in(nn) : 0); d.ld = NIN; d.ok = ok; d.K = 2048; d.wt = ws + WS_WIN + (size_t)l * NINP * DM * (F8_INPROJ ? 1 : 2); d.n0 = 32 * nb; d.k0 = 64 * kb; return d; } r -= TK_IN; }
    if ((F8_OUTPROJ != 0) == F8SEL) { if (r < TK_OUT) { const int sub = r & 1, r2 = r >> 1, l = r2 / (TK_OUT / 4), q = r2 % (TK_OUT / 4), kb = 2 * (q / 64) + sub, nb = q % 64, nn = 32 * nb + (lane & 31);
            d.colp = p.w_out + (size_t)l * DM * DM + nn; d.ld = DM; d.ok = 1; d.K = 2048; d.wt = ws + WS_WOUT + (size_t)l * DM * DM * (F8_OUTPROJ ? 1 : 2); d.n0 = 32 * nb; d.k0 = 64 * kb; return d; } r -= TK_OUT; }
    if (F8SEL) {
        if (r < TK_GU) { const int sub = r & 1, r2 = r >> 1, le = r2 / 1024, q = r2 % 1024, kb = 2 * (q / 64) + sub, nb = q % 64, nn = 32 * nb + (lane & 31), j = nn >> 3, t = nn & 7;
            d.colp = (t < 4 ? p.w_gate : p.w_up) + (size_t)le * 2048 * 1024 + 4 * j + (t & 3); d.ld = 1024; d.ok = 1; d.K = 2048; d.wt = ws + WS_WGU + (size_t)le * 2048 * 2048; d.n0 = 32 * nb; d.k0 = 64 * kb; return d; }
        r -= TK_GU;
        { const int sub = r & 1, r2 = r >> 1, le = r2 / 512, q = r2 % 512, kb = 2 * (q / 64) + sub, nb = q % 64, nn = 32 * nb + (lane & 31);
            d.colp = p.w_down + (size_t)le * 1024 * 2048 + nn; d.ld = 2048; d.ok = 1; d.K = 1024; d.wt = ws + WS_WDN + (size_t)le * 2048 * 1024; d.n0 = 32 * nb; d.k0 = 64 * kb; return d; }
    } else { const int kb = r; d.colp = p.w_router + (lane & 31); d.ld = 32; d.ok = 1; d.K = 2048; d.wt = ws + WS_WRT; d.n0 = 0; d.k0 = 64 * kb; return d; }
}
__device__ __forceinline__ void t_load(const TDesc& d, float (&tv)[32], int lane) {
#pragma unroll
    for (int i = 0; i < 32; ++i) tv[i] = d.colp[(size_t)(d.k0 + 2 * i + (lane >> 5)) * d.ld];
}
template <bool F8> __device__ __forceinline__ void t_lds_in(const TDesc& d, const float (&tv)[32], LAS float* scr, int lane) {
#pragma unroll
    for (int i = 0; i < 32; ++i) scr[(2 * i + (lane >> 5)) * 33 + (lane & 31)] = d.ok ? tv[i] : 0.f;
    LDS_WAIT(); asm volatile("" ::: "memory");
}
template <bool F8> __device__ __forceinline__ void t_out(const TDesc& d, LAS float* scr, int lane) {
    const int c = lane & 7;
#pragma unroll
    for (int j = 0; j < 4; ++j) { const int n = (lane >> 3) + 8 * j; const LAS float* s = scr + (8 * c) * 33 + n;
        if constexpr (F8) { v2u o; o.x = pack4f8(s[0 * 33] * W8_SCALE, s[1 * 33] * W8_SCALE, s[2 * 33] * W8_SCALE, s[3 * 33] * W8_SCALE); o.y = pack4f8(s[4 * 33] * W8_SCALE, s[5 * 33] * W8_SCALE, s[6 * 33] * W8_SCALE, s[7 * 33] * W8_SCALE);
            *(v2u*)(d.wt + (size_t)(d.n0 + n) * d.K + d.k0 + 8 * c) = o; }
        else { v4u o; o.x = pk2(s[0 * 33], s[1 * 33]); o.y = pk2(s[2 * 33], s[3 * 33]); o.z = pk2(s[4 * 33], s[5 * 33]); o.w = pk2(s[6 * 33], s[7 * 33]);
            *(v4u*)((bf16*)d.wt + (size_t)(d.n0 + n) * d.K + d.k0 + 8 * c) = o; } }
    LDS_WAIT(); asm volatile("" ::: "memory");
}
__device__ __forceinline__ void t_cvt8(LAS float* scr, int lane, v2u (&o)[4]) {
    const int c = lane & 7;
#pragma unroll
    for (int j = 0; j < 4; ++j) { const int n = (lane >> 3) + 8 * j; const LAS float* s = scr + (8 * c) * 33 + n;
        o[j].x = pack4f8(s[0 * 33] * W8_SCALE, s[1 * 33] * W8_SCALE, s[2 * 33] * W8_SCALE, s[3 * 33] * W8_SCALE); o[j].y = pack4f8(s[4 * 33] * W8_SCALE, s[5 * 33] * W8_SCALE, s[6 * 33] * W8_SCALE, s[7 * 33] * W8_SCALE); }
    LDS_WAIT(); asm volatile("" ::: "memory");
}
constexpr int TL_IN = 32 * (NINP / 32), TL_OUT = 32 * 64, TL_GU = 32 * 32 * 64, TL_DN = 32 * 16 * 64, TL_ALL = TL_IN + TL_OUT + TL_GU + TL_DN, NPL = TL_ALL / 2;
static_assert(F8_INPROJ && F8_OUTPROJ, "the per-layer conversion queue assumes fp8 copies of every GEMM weight");
__device__ __forceinline__ TDesc t_decode_layer(const Prm& p, int l, int it, int lane) {
    unsigned char* ws = p.ws; TDesc d; int r = it; const int sub = r & 1;
    if (r < TL_IN) { const int q = r >> 1, kb = 2 * (q / (NINP / 32)) + sub, nb = q % (NINP / 32), nn = 32 * nb + (lane & 31); const bool ok = nn < NIN;
        d.colp = p.w_in + (size_t)l * DM * NIN + (ok ? perm_in(nn) : 0); d.ld = NIN; d.ok = ok; d.K = 2048; d.wt = ws + WS_WIN + (size_t)l * NINP * DM; d.n0 = 32 * nb; d.k0 = 64 * kb; return d; }
    r -= TL_IN;
    if (r < TL_OUT) { const int q = r >> 1, kb = 2 * (q / 64) + sub, nb = q % 64, nn = 32 * nb + (lane & 31);
        d.colp = p.w_out + (size_t)l * DM * DM + nn; d.ld = DM; d.ok = 1; d.K = 2048; d.wt = ws + WS_WOUT + (size_t)l * DM * DM; d.n0 = 32 * nb; d.k0 = 64 * kb; return d; }
    r -= TL_OUT;
    if (r < TL_GU) { const int r2 = r >> 1, le = l * 32 + r2 / 1024, q = r2 % 1024, kb = 2 * (q / 64) + sub, nb = q % 64, nn = 32 * nb + (lane & 31), j = nn >> 3, t = nn & 7;
        d.colp = (t < 4 ? p.w_gate : p.w_up) + (size_t)le * 2048 * 1024 + 4 * j + (t & 3); d.ld = 1024; d.ok = 1; d.K = 2048; d.wt = ws + WS_WGU + (size_t)le * 2048 * 2048; d.n0 = 32 * nb; d.k0 = 64 * kb; return d; }
    r -= TL_GU;
    { const int r2 = r >> 1, le = l * 32 + r2 / 512, q = r2 % 512, kb = 2 * (q / 64) + sub, nb = q % 64, nn = 32 * nb + (lane & 31);
        d.colp = p.w_down + (size_t)le * 1024 * 2048 + nn; d.ld = 2048; d.ok = 1; d.K = 1024; d.wt = ws + WS_WDN + (size_t)le * 2048 * 1024; d.n0 = 32 * nb; d.k0 = 64 * kb; return d; }
}
__device__ __forceinline__ void t_pair_store(const TDesc& dS, const v2u (&oa)[4], const v2u (&ob)[4], int lane) {
    const int c = lane & 7, odd = c & 1;
#pragma unroll
    for (int j = 0; j < 4; ++j) { const int n = (lane >> 3) + 8 * j;
        const v2u snd = odd ? oa[j] : ob[j]; v2u got; got.x = (unsigned)__builtin_amdgcn_update_dpp(0, (int)snd.x, 0xB1, 0xF, 0xF, false); got.y = (unsigned)__builtin_amdgcn_update_dpp(0, (int)snd.y, 0xB1, 0xF, 0xF, false);
        v4u w; if (odd) { w.x = got.x; w.y = got.y; w.z = ob[j].x; w.w = ob[j].y; } else { w.x = oa[j].x; w.y = oa[j].y; w.z = got.x; w.w = got.y; }
        *(v4u*)(dS.wt + (size_t)(dS.n0 + n) * dS.K + dS.k0 + (odd ? 64 : 0) + 16 * (c >> 1)) = w; }
}
constexpr int NP_PROJ = (TL_IN + TL_OUT) / 2, NP_EXP = (TL_GU + TL_DN) / 2;
__device__ __forceinline__ void t_convert_pairs(const Prm& p, int l, int npairs, LAS float* scr, int gw, int ngw, int lane) {
    if (gw >= npairs) return;
    TDesc dA = t_decode_layer(p, l, 2 * gw, lane), dB = t_decode_layer(p, l, 2 * gw + 1, lane); float ta[32], tb[32]; t_load(dA, ta, lane); t_load(dB, tb, lane);
#pragma unroll 1
    for (int pi = gw; pi < npairs; pi += ngw) {
        v2u oa[4], ob[4];
        t_lds_in<true>(dA, ta, scr, lane); t_cvt8(scr, lane, oa);
        t_lds_in<true>(dB, tb, scr, lane);
        const TDesc dS = dA; const int pn = pi + ngw;
        if (pn < npairs) { dA = t_decode_layer(p, l, 2 * pn, lane); dB = t_decode_layer(p, l, 2 * pn + 1, lane); t_load(dA, ta, lane); t_load(dB, tb, lane); }
        t_cvt8(scr, lane, ob);
        t_pair_store(dS, oa, ob, lane);
    }
}
__device__ __forceinline__ void t_convert_one(const Prm& p, int l, int pi, LAS float* scr, int lane) {
    const TDesc dA = t_decode_layer(p, l, 2 * pi, lane), dB = t_decode_layer(p, l, 2 * pi + 1, lane); float ta[32], tb[32]; t_load(dA, ta, lane); t_load(dB, tb, lane);
    v2u oa[4], ob[4];
    t_lds_in<true>(dA, ta, scr, lane); t_cvt8(scr, lane, oa);
    t_lds_in<true>(dB, tb, scr, lane); t_cvt8(scr, lane, ob);
    t_pair_store(dA, oa, ob, lane);
}
template <bool F8SEL> __device__ __forceinline__ void t_convert_all(const Prm& p, LAS float* scr, int gw, int ngw, int lane) {
    constexpr int N = t_count<F8SEL>();
    if (2 * gw >= N) return;
    TDesc d0 = t_decode<F8SEL>(p, 2 * gw, lane); float tv[32]; t_load(d0, tv, lane);
#pragma unroll 1
    for (int it = 2 * gw; it < N; ) {
        t_lds_in<F8SEL>(d0, tv, scr, lane);
        const int itn = (it & 1) ? it - 1 + 2 * ngw : it + 1; TDesc d1 = d0;
        if (itn < N) { d1 = t_decode<F8SEL>(p, itn, lane); t_load(d1, tv, lane); }
        t_out<F8SEL>(d0, scr, lane);
        d0 = d1; it = itn;
    }
}
__device__ __forceinline__ void phase_prologue(const Prm& p, LAS unsigned char* lds, int gw, int ngw, int wave, int lane, bool first) {
    LAS float* scr = (LAS float*)(lds + wave * 16384);
    unsigned char* ws = p.ws;
    t_convert_pairs(p, 0, NPL, scr, gw, ngw, lane);
    if (!CONV_QUEUE) t_convert_pairs(p, 1, NPL, scr, gw, ngw, lane);
    t_convert_all<false>(p, scr, gw, ngw, lane);
    int* mod = (int*)(ws + OFF_MOD);
    for (int it = gw; first && it < 2 * 32 * 48; it += ngw) {
        const int l = it / (32 * 48), q = it % (32 * 48), kc = q / 48, nc = q % 48, k0 = 64 * kc, n0 = 256 * nc + 4 * lane;
        scr[lane] = silu_f(p.c[k0 + lane]); scr[64 + lane] = silu_f(p.c[DM + k0 + lane]); scr[128 + lane] = silu_f(p.c_ctx[k0 + lane]);
        LDS_WAIT(); asm volatile("" ::: "memory");
        f32x4 a0 = {0.f, 0.f, 0.f, 0.f}, a1 = a0, a2 = a0;
        const float* wp = p.w_ada + ((size_t)l * DM + k0) * MODW + n0;
#pragma unroll 8
        for (int kk = 0; kk < 64; ++kk) { const f32x4 w = *(const f32x4*)(wp + (size_t)kk * MODW); a0 += w * scr[kk]; a1 += w * scr[64 + kk]; a2 += w * scr[128 + kk]; }
        if (kc == 0) { const f32x4 bb = *(const f32x4*)(p.b_ada + (size_t)l * MODW + n0); a0 += bb; a1 += bb; a2 += bb; }
        int* m0 = mod + (size_t)(l * 3) * MODW + n0;
#pragma unroll
        for (int i = 0; i < 4; ++i) { atomicAdd(m0 + i, (int)rintf(a0[i] * 16777216.f)); atomicAdd(m0 + MODW + i, (int)rintf(a1[i] * 16777216.f)); atomicAdd(m0 + 2 * MODW + i, (int)rintf(a2[i] * 16777216.f)); }
        LDS_WAIT(); asm volatile("" ::: "memory");
    }
    for (int it = gw * 64 + lane; it < 128 * 32; it += ngw * 64) { const int pos = it >> 5, i = it & 31; const float inv = powf(10000.f, -(float)i / 32.f), ang = (float)pos * inv;
        ((float*)(ws + WS_ROPE))[2 * it] = cosf(ang); ((float*)(ws + WS_ROPE))[2 * it + 1] = sinf(ang); }
}

__device__ __forceinline__ f32x4 modv4(const float* p) {
    typedef int i32x4 __attribute__((ext_vector_type(4)));
    const i32x4 v = *(const i32x4*)p; return (f32x4){(float)v[0], (float)v[1], (float)v[2], (float)v[3]} * (1.f / 16777216.f);
}
__device__ __forceinline__ f32x4 bf4(v2u w) { return (f32x4){bflo(w.x), bfhi(w.x), bflo(w.y), bfhi(w.y)}; }
__device__ __forceinline__ void load_row(const Prm& p, int l, int lcomb, int m, int lane, f32x4 (&v)[8], bool wb = true, const LAS int* segL = nullptr) {
    const bool isc = m >= T_LAT;
    const bf16* wsrow = isc ? (const bf16*)(p.ws + WS_XC) + (size_t)(m - T_LAT) * DM : (const bf16*)(p.ws + WS_X) + (size_t)m * DM;
#pragma unroll
    for (int j = 0; j < 8; ++j) v[j] = bf4(*(const v2u*)(wsrow + 256 * j + 4 * lane));
}
__device__ __forceinline__ float row_rstd(const f32x4 (&v)[8]) {
    float s = 0.f;
#pragma unroll
    for (int j = 0; j < 8; ++j) s += (v[j][0] * v[j][0] + v[j][1] * v[j][1]) + (v[j][2] * v[j][2] + v[j][3] * v[j][3]);
    return rsqrtf(wave_sum(s) * (1.f / DM) + EPS);
}
__device__ __forceinline__ f32x4 modulate4f(const f32x4 v, float rstd, const float* gain, const float* sc, const float* sh, int col) {
    const f32x4 g = *(const f32x4*)(gain + col), s1 = modv4(sc + col), s0 = modv4(sh + col);
    return (v * rstd * g) * (s1 + 1.f) + s0;
}
__device__ __forceinline__ v2u modulate4(const f32x4 v, float rstd, const float* gain, const float* sc, const float* sh, int col) {
    const f32x4 g = *(const f32x4*)(gain + col), s1 = modv4(sc + col), s0 = modv4(sh + col);
    const f32x4 o = (v * rstd * g) * (s1 + 1.f) + s0;
    v2u w; w.x = pk2(o[0], o[1]); w.y = pk2(o[2], o[3]); return w;
}
constexpr int RS_A = 0, RS_SH = 3 * 8192, RS_GF = 6 * 8192, RS_END = 9 * 8192;
struct RowX { f32x4 x[8]; v2u xb[8]; unsigned ya[8], yb[8]; };
struct RowI { int s; float g; };
template <bool COMB> __device__ __forceinline__ RowI rs_idx_issue(const Prm& p, int m, int lane, int& e_out, int& pos_out) {
    RowI r; r.s = 0; r.g = 0.f; e_out = 0; pos_out = 0;
    if constexpr (COMB) { const int k = lane & 1; const int* te = (const int*)(p.ws + WS_TOK); const int* tp = (const int*)(p.ws + WS_TOK + TOKTAB); const float* tg = (const float*)(p.ws + WS_TOK + 2 * TOKTAB);
        e_out = te[2 * m + k]; pos_out = tp[2 * m + k]; r.g = tg[2 * m + k]; }
    return r;
}
template <bool COMB, bool SRC32> __device__ __forceinline__ void rs_issue(const Prm& p, int m, int s0, int s1, int lane, RowX& b) {
    const bool isc = m >= T_LAT;
    if constexpr (SRC32) { const float* src = isc ? p.ctx + (size_t)(m - T_LAT) * DM : p.x + (size_t)m * DM;
#pragma unroll
        for (int j = 0; j < 8; ++j) b.x[j] = *(const f32x4*)(src + 256 * j + 4 * lane); }
    else { const bf16* src = isc ? (const bf16*)(p.ws + WS_XC) + (size_t)(m - T_LAT) * DM : (const bf16*)(p.ws + WS_X) + (size_t)m * DM;
#pragma unroll
        for (int j = 0; j < 8; ++j) b.xb[j] = *(const v2u*)(src + 256 * j + 4 * lane); }
    if constexpr (COMB) { const unsigned char* y0 = p.ws + WS_YB + (size_t)s0 * DM; const unsigned char* y1 = p.ws + WS_YB + (size_t)s1 * DM;
#pragma unroll
        for (int j = 0; j < 8; ++j) { b.ya[j] = *(const unsigned*)(y0 + 256 * j + 4 * lane); b.yb[j] = *(const unsigned*)(y1 + 256 * j + 4 * lane); } }
}
template <bool COMB, bool FINAL, bool SRC32> __device__ __forceinline__ void rs_finish(const Prm& p, int l, int m, float g0, float g1, int lane, RowX& b, const LAS unsigned char* vl, bool live) {
    const bool isc = m >= T_LAT; const int vs = isc ? 2 : (m >> 13);
    const LAS float* A = (const LAS float*)(vl + RS_A) + vs * 2048; const LAS float* SH = (const LAS float*)(vl + RS_SH) + vs * 2048; const LAS float* GF = (const LAS float*)(vl + RS_GF) + vs * 2048;
    if constexpr (!SRC32) {
#pragma unroll
        for (int j = 0; j < 8; ++j) b.x[j] = bf4(b.xb[j]); }
    if constexpr (COMB) {
        bf16* wsrow = isc ? (bf16*)(p.ws + WS_XC) + (size_t)(m - T_LAT) * DM : (bf16*)(p.ws + WS_X) + (size_t)m * DM;
#pragma unroll
        for (int j = 0; j < 8; ++j) { const int col = 256 * j + 4 * lane; const unsigned a = b.ya[j], c = b.yb[j]; const f32x4 gq = *(const LAS f32x4*)(GF + col);
            const f32x2 a01 = __builtin_amdgcn_cvt_pk_f32_fp8(a, false), a23 = __builtin_amdgcn_cvt_pk_f32_fp8(a, true), c01 = __builtin_amdgcn_cvt_pk_f32_fp8(c, false), c23 = __builtin_amdgcn_cvt_pk_f32_fp8(c, true);
            b.x[j][0] += gq[0] * (g0 * a01[0] + g1 * c01[0]); b.x[j][1] += gq[1] * (g0 * a01[1] + g1 * c01[1]);
            b.x[j][2] += gq[2] * (g0 * a23[0] + g1 * c23[0]); b.x[j][3] += gq[3] * (g0 * a23[1] + g1 * c23[1]);
            if (!FINAL && live) { v2u w; w.x = pk2(b.x[j][0], b.x[j][1]); w.y = pk2(b.x[j][2], b.x[j][3]); *(v2u*)(wsrow + col) = w; } } }
    const float rstd = row_rstd(b.x);
    if (!live) return;
#pragma unroll
    for (int j = 0; j < 8; ++j) { const int col = 256 * j + 4 * lane; const f32x4 av = *(const LAS f32x4*)(A + col);
        if constexpr (FINAL) { *(f32x4*)(p.out + (size_t)m * DM + col) = b.x[j] * rstd * av; }
        else { const f32x4 o = b.x[j] * rstd * av + *(const LAS f32x4*)(SH + col);
            if (F8_INPROJ) *(unsigned*)(p.ws + WS_H + (size_t)m * DM + col) = pack4f8(o[0], o[1], o[2], o[3]);
            else { v2u w; w.x = pk2(o[0], o[1]); w.y = pk2(o[2], o[3]); *(v2u*)((bf16*)(p.ws + WS_H) + (size_t)m * DM + col) = w; } } }
}
template <bool COMB, bool FINAL, bool SRC32> __device__ __forceinline__ void row_stream(const Prm& p, int l, int lc, int nrows, int gw, int ngw, int tid, int lane, LAS unsigned char* vl, const LAS int* segL) {
    { const float* md = (const float*)(p.ws + OFF_MOD);
      for (int q = tid; q < 3 * 512; q += NWAVES * 64) { const int vs = q >> 9, c4 = (q & 511) * 4;
          if (FINAL) { if (vs == 0) *(LAS f32x4*)(vl + RS_A + (size_t)c4 * 4) = *(const f32x4*)(p.norm_final + c4); }
          else { const f32x4 gn = *(const f32x4*)(p.norm_mix + l * DM + c4), sc = modv4(md + (size_t)(l * 3 + vs) * MODW + DM + c4), sh = modv4(md + (size_t)(l * 3 + vs) * MODW + c4);
              *(LAS f32x4*)(vl + RS_A + ((size_t)vs * 2048 + c4) * 4) = gn * (sc + 1.f); *(LAS f32x4*)(vl + RS_SH + ((size_t)vs * 2048 + c4) * 4) = sh; }
          if (COMB) *(LAS f32x4*)(vl + RS_GF + ((size_t)vs * 2048 + c4) * 4) = modv4(md + (size_t)(lc * 3 + vs) * MODW + 5 * DM + c4) * (1.f / Y8_SCALE); }
      if (FINAL) { for (int q = tid; q < 2 * 512; q += NWAVES * 64) { const int c4 = (q & 511) * 4; *(LAS f32x4*)(vl + RS_A + ((size_t)(1 + (q >> 9)) * 2048 + c4) * 4) = *(const f32x4*)(p.norm_final + c4); } }
      __syncthreads(); }
    const int nit = gw < nrows ? (nrows - gw + ngw - 1) / ngw : 0;
    if (nit == 0) return;
    const int last = gw + (nit - 1) * ngw;
#define RS_ROW(i) min(gw + (i) * ngw, last)
    RowX bA, bB; int e0, p0, e1, p1; RowI i0 = rs_idx_issue<COMB>(p, RS_ROW(0), lane, e0, p0), i1 = rs_idx_issue<COMB>(p, RS_ROW(1), lane, e1, p1);
    { int s = COMB ? segL[e0] + p0 : 0; rs_issue<COMB, SRC32>(p, RS_ROW(0), __shfl(s, 0), __shfl(s, 1), lane, bA); }
#pragma unroll 1
    for (int i = 0; i < nit; i += 2) {
        int e2, p2, e3, p3;
        const RowI i2 = rs_idx_issue<COMB>(p, RS_ROW(i + 2), lane, e2, p2);
        { int s = COMB ? segL[e1] + p1 : 0; rs_issue<COMB, SRC32>(p, RS_ROW(i + 1), __shfl(s, 0), __shfl(s, 1), lane, bB); }
        rs_finish<COMB, FINAL, SRC32>(p, l, RS_ROW(i), __shfl(i0.g, 0), __shfl(i0.g, 1), lane, bA, vl, true);
        const RowI i3 = rs_idx_issue<COMB>(p, RS_ROW(i + 3), lane, e3, p3);
        { int s = COMB ? segL[e2] + p2 : 0; rs_issue<COMB, SRC32>(p, RS_ROW(i + 2), __shfl(s, 0), __shfl(s, 1), lane, bA); }
        rs_finish<COMB, FINAL, SRC32>(p, l, RS_ROW(i + 1), __shfl(i1.g, 0), __shfl(i1.g, 1), lane, bB, vl, i + 1 < nit);
        i0 = i2; i1 = i3; e1 = e3; p1 = p3;
    }
#undef RS_ROW
}
constexpr int Q_TOTAL = NPL;
__device__ __forceinline__ void queue_convert8(const Prm& p, unsigned base, LAS unsigned char* lds, int tid_in) {
    int tid = tid_in;
    asm volatile("" : "+v"(tid));
    const int wave = __builtin_amdgcn_readfirstlane(tid >> 6), lane = tid & 63; const unsigned pi = base + (unsigned)wave;
    if (pi < (unsigned)Q_TOTAL) t_convert_one(p, 1, (int)pi, (LAS float*)(lds + wave * 16384), lane);
}
__device__ __forceinline__ void xcd_barrier_work(const XcdBarrier& b, const Prm& p, LAS unsigned char* lds, int tid) {
    asm volatile("s_waitcnt vmcnt(0)" ::: "memory");
    __syncthreads();
    volatile LAS unsigned* bw = (volatile LAS unsigned*)(lds + L_BWORK);
    unsigned* bar = b.bar; unsigned* q = (unsigned*)(p.ws + OFF_Q);
    if (threadIdx.x == 0) {
        __builtin_amdgcn_s_waitcnt(0);
        unsigned nloc = b.st[0], nx = b.st[1];
        if (nloc == 0u) { xcd_barrier_complete(bar, b.x, nloc, nx); b.st[0] = nloc; b.st[1] = nx; }
        const unsigned old = xb_add(&bar[XB_XSUB(b.x)], 1u);
        const unsigned gen = old / nloc;
        if (old + 1u == (gen + 1u) * nloc) {
            __builtin_amdgcn_fence(__ATOMIC_RELEASE, "agent");
            asm volatile("s_waitcnt vmcnt(0)" ::: "memory");
            const unsigned og = xb_add(&bar[XB_TOP], 1u);
            const unsigned tg = og / nx;
            if (og + 1u == (tg + 1u) * nx) xb_add(&bar[XB_TOPGEN], 1u);
            else XB_SPIN(xb_ld(&bar[XB_TOPGEN]) == tg, bar);
            __builtin_amdgcn_fence(__ATOMIC_ACQUIRE, "agent");
            xb_add(&bar[XB_XGEN(b.x)], 1u);
            asm volatile("s_waitcnt vmcnt(0)" ::: "memory");
            bw[0] = 1u;
        } else { bw[0] = 0u; bw[2] = gen; }
    }
    __syncthreads();
    if (bw[0] == 0u) {
        unsigned sp = 0u;
        for (;;) {
            if (threadIdx.x == 0) {
                const unsigned gen = bw[2];
                bool rel = xb_ld(&bar[XB_XGEN(b.x)]) != gen;
                if (!rel && ((++sp & 63u) == 0u)) { if (xb_ld(&bar[XB_TMO])) rel = true; else if (sp > XB_SPIN_CAP) { atomicAdd(&bar[XB_TMO], 1u); rel = true; } }
                if (rel) { __builtin_amdgcn_fence(__ATOMIC_ACQUIRE, "agent"); asm volatile("s_waitcnt vmcnt(0)" ::: "memory"); bw[0] = 1u; }
                else { unsigned base = 0xffffffffu; if (xb_ld(q) < (unsigned)Q_TOTAL) { base = xb_add(q, 8u); if (base >= (unsigned)Q_TOTAL) base = 0xffffffffu; } bw[1] = base; }
            }
            __syncthreads();
            if (bw[0]) break;
            const unsigned base = bw[1];
            if (base != 0xffffffffu) queue_convert8(p, base, lds, tid); else __builtin_amdgcn_s_sleep(4);
            __syncthreads();
        }
    }
    __syncthreads();
}
__device__ __forceinline__ void queue_drain(const Prm& p, LAS unsigned char* lds, int tid, unsigned target) {
    volatile LAS unsigned* bw = (volatile LAS unsigned*)(lds + L_BWORK); unsigned* q = (unsigned*)(p.ws + OFF_Q);
    __syncthreads();
    for (;;) {
        if (threadIdx.x == 0) bw[1] = (xb_ld(q) < target) ? xb_add(q, 8u) : 0xffffffffu;
        __syncthreads();
        const unsigned base = bw[1];
        if (base >= target) break;
        queue_convert8(p, base, lds, tid);
        __syncthreads();
    }
    __syncthreads();
}
__device__ __forceinline__ void phase_conv(const Prm& p, int l, int gw, int ngw, int lane) {
    const bf16* U = (const bf16*)(p.ws + WS_U); bf16* XA = (bf16*)(p.ws + WS_XBC); float* DT = (float*)(p.ws + WS_DT);
    constexpr int NRUN = T_ALL / 16;
    for (int it = gw; it < NRUN * 3; it += ngw) {
        const int run = it / 3, cb = it % 3, t0 = run * 16, ch = cb * 512 + lane * 8;
        int seq0, seq1; if (t0 < T_LAT) { seq0 = t0 & ~(SEQL - 1); seq1 = seq0 + SEQL; } else { seq0 = T_LAT + ((t0 - T_LAT) & ~(CTXL - 1)); seq1 = seq0 + CTXL; }
        float w[5][8], bias[8];
#pragma unroll
        for (int j = 0; j < 5; ++j) { const f32x4 a = *(const f32x4*)(p.conv_w + ((size_t)l * 5 + j) * XBCW + ch), b = *(const f32x4*)(p.conv_w + ((size_t)l * 5 + j) * XBCW + ch + 4);
            w[j][0] = a[0]; w[j][1] = a[1]; w[j][2] = a[2]; w[j][3] = a[3]; w[j][4] = b[0]; w[j][5] = b[1]; w[j][6] = b[2]; w[j][7] = b[3]; }
        { const f32x4 a = *(const f32x4*)(p.conv_b + (size_t)l * XBCW + ch), b = *(const f32x4*)(p.conv_b + (size_t)l * XBCW + ch + 4);
            bias[0] = a[0]; bias[1] = a[1]; bias[2] = a[2]; bias[3] = a[3]; bias[4] = b[0]; bias[5] = b[1]; bias[6] = b[2]; bias[7] = b[3]; }
        v4u rows[20];
#pragma unroll
        for (int j = 0; j < 20; ++j) { const int t = t0 - 2 + j, tc = min(max(t, seq0), seq1 - 1); rows[j] = *(const v4u*)(U + (size_t)tc * NINP + C_XBC + ch); }
#pragma unroll
        for (int j = 0; j < 20; ++j) { const int t = t0 - 2 + j; if (t < seq0 || t >= seq1) rows[j] = (v4u){0u, 0u, 0u, 0u}; }
#pragma unroll
        for (int i = 0; i < 16; ++i) {
            const int t = t0 + i;
            float o[8];
#pragma unroll
            for (int c = 0; c < 8; ++c) o[c] = bias[c];
#pragma unroll
            for (int j = 0; j < 5; ++j) { const v4u wv = rows[i + j];
                o[0] += w[j][0] * bflo(wv.x); o[1] += w[j][1] * bfhi(wv.x); o[2] += w[j][2] * bflo(wv.y); o[3] += w[j][3] * bfhi(wv.y);
                o[4] += w[j][4] * bflo(wv.z); o[5] += w[j][5] * bfhi(wv.z); o[6] += w[j][6] * bflo(wv.w); o[7] += w[j][7] * bfhi(wv.w); }
            v4u r; r.x = pk2(silu_f(o[0]), silu_f(o[1])); r.y = pk2(silu_f(o[2]), silu_f(o[3])); r.z = pk2(silu_f(o[4]), silu_f(o[5])); r.w = pk2(silu_f(o[6]), silu_f(o[7]));
            *(v4u*)(XA + (size_t)t * XBCW + ch) = r;
        }
    }
    for (int it = gw * 64 + lane; it < T_ALL * 32; it += ngw * 64) { const int m = it >> 5, j = it & 31;
        DT[it] = softplus_f(bf2f(U[(size_t)m * NINP + C_DT + j]) + p.dt_bias[l * 32 + j]); }
}

__device__ __forceinline__ void naive_attn_item(const Prm& p, int l, int type, int m, int hh, LAS float* qs, LAS float* sc, int lane) {
    const bf16* U = (const bf16*)(p.ws + WS_U); bf16* MIX = (bf16*)(p.ws + WS_H);
    int qcol, kcol, vcol, ocol;
    if (type == 0 || type == 2) { qcol = C_QA + hh * 128; kcol = C_KA + hh * 128; vcol = C_VA + hh * 128; ocol = hh * 128; }
    else { const int kvh = hh >> 1; qcol = C_QB + hh * 128; kcol = C_KB + kvh * 128; vcol = C_VB + kvh * 128; ocol = 512 + hh * 128; }
    { const unsigned w = *(const unsigned*)(U + (size_t)m * NINP + qcol + 2 * lane); qs[2 * lane] = bflo(w); qs[2 * lane + 1] = bfhi(w); }
    int b, s = 0, qr = 0, qc = 0, krow0 = 0, kpos0 = 0;
    if (type < 2) { b = m >> 13; s = m & 8191; qr = s >> 6; qc = s & 63; } else { b = (m - T_LAT) >> 8; }
    const int nloc = type == 0 ? 512 : (type == 1 ? 384 : 0), nk = nloc + 256;
    if (type == 0) krow0 = min(max(qr - 4, 0), 120);
    if (type == 1) kpos0 = (s >> 7) * 128 - 128;
    const float* rpb = p.na_rpb + (size_t)(l * 4 + hh) * 15 * 31;
    LDS_WAIT(); __builtin_amdgcn_wave_barrier(); asm volatile("" ::: "memory");
    float mx = -INFINITY;
    for (int k0 = 0; k0 < nk; k0 += 64) {
        const int kidx = k0 + lane; int row; float bias = 0.f; bool valid = true;
        if (kidx < nloc) {
            if (type == 0) { const int kr = krow0 + (kidx >> 6), kc = kidx & 63; row = b * SEQL + kr * 64 + kc; const int c0 = min(max(qc - 8, 0), 48); valid = (kc >= c0) && (kc < c0 + 16);
                const int dr = kr - qr + 7, dc = min(max(kc - qc + 15, 0), 30); bias = rpb[dr * 31 + dc]; }
            else { const int kpos = kpos0 + kidx; valid = (kpos >= 0) && (kpos < SEQL) && (abs(s - kpos) <= 128); row = b * SEQL + min(max(kpos, 0), SEQL - 1); }
        } else row = T_LAT + b * CTXL + (kidx - nloc);
        const bf16* kp = U + (size_t)row * NINP + kcol; float d = 0.f;
#pragma unroll 4
        for (int c = 0; c < 16; ++c) { const v4u w = *(const v4u*)(kp + 8 * c); const LAS float* q = qs + 8 * c;
            d += bflo(w.x) * q[0] + bfhi(w.x) * q[1] + bflo(w.y) * q[2] + bfhi(w.y) * q[3] + bflo(w.z) * q[4] + bfhi(w.z) * q[5] + bflo(w.w) * q[6] + bfhi(w.w) * q[7]; }
        const float sv = valid ? d * ATT_SCALE + bias : -INFINITY;
        sc[kidx] = sv; mx = fmaxf(mx, sv);
    }
    mx = wave_max(mx);
    float sum = 0.f;
    for (int k0 = 0; k0 < nk; k0 += 64) { const float e = __expf(sc[k0 + lane] - mx); sc[k0 + lane] = e; sum += e; }
    sum = wave_sum(sum);
    if (type == 1 || type == 3) sum += __expf(p.wa_sink[l * 4 + hh] - mx);
    LDS_WAIT(); __builtin_amdgcn_wave_barrier(); asm volatile("" ::: "memory");
    float o0 = 0.f, o1 = 0.f;
    for (int kidx = 0; kidx < nk; ++kidx) {
        int row;
        if (kidx < nloc) { if (type == 0) row = b * SEQL + (krow0 + (kidx >> 6)) * 64 + (kidx & 63); else row = b * SEQL + min(max(kpos0 + kidx, 0), SEQL - 1); }
        else row = T_LAT + b * CTXL + (kidx - nloc);
        const float pv = sc[kidx]; const unsigned w = *(const unsigned*)(U + (size_t)row * NINP + vcol + 2 * lane);
        o0 += pv * bflo(w); o1 += pv * bfhi(w);
    }
    const float inv = 1.f / sum;
    *(unsigned*)(MIX + (size_t)m * DM + ocol + 2 * lane) = pk2(o0 * inv, o1 * inv);
    LDS_WAIT(); __builtin_amdgcn_wave_barrier(); asm volatile("" ::: "memory");
}
__device__ __forceinline__ void phase_attn_naive(const Prm& p, int l, LAS unsigned char* lds, int gw, int ngw, int wave, int lane) {
    LAS float* qs = (LAS float*)(lds + wave * 4096); LAS float* sc = qs + 128;
    const int nlat = T_LAT * 8, nctx = (l == 0) ? T_CTX * 8 : 0;
    for (int it = gw; it < nlat + nctx; it += ngw) {
        if (it < nlat) { const int m = it >> 3, h8 = it & 7; naive_attn_item(p, l, h8 >> 2, m, h8 & 3, qs, sc, lane); }
        else { const int r = it - nlat, m = T_LAT + (r >> 3), h8 = r & 7; naive_attn_item(p, l, 2 + (h8 >> 2), m, h8 & 3, qs, sc, lane); }
    }
}

__device__ __forceinline__ void phase_ssd_naive(const Prm& p, int l, int wg, int nwg, int tid) {
    const bf16* XA = (const bf16*)(p.ws + WS_XBC); const float* DT = (const float*)(p.ws + WS_DT); float* YD = (float*)(p.ws + WS_YD);
    for (int it = wg; it < 64; it += nwg) {
        const int b = it >> 5, dir = (it >> 4) & 1, h = it & 15, g = h >> 3;
        const int pp = tid >> 3, nq = tid & 7;
        const float a = -__expf(p.a_log[l * 32 + dir * 16 + h]), dsk = p.d_skip[l * 32 + dir * 16 + h];
        float hs[16];
#pragma unroll
        for (int i = 0; i < 16; ++i) hs[i] = 0.f;
#pragma unroll 4
        for (int st = 0; st < CTXL + SEQL; ++st) {
            int m; if (st < CTXL) m = T_LAT + b * CTXL + (dir ? CTXL - 1 - st : st); else { const int s = st - CTXL; m = b * SEQL + (dir ? SEQL - 1 - s : s); }
            const float dtv = DT[(size_t)m * 32 + dir * 16 + h];
            const bf16* row = XA + (size_t)m * XBCW;
            const float xv = bf2f(row[h * 64 + pp]);
            const v4u b0 = *(const v4u*)(row + 1024 + g * 128 + 16 * nq), b1 = *(const v4u*)(row + 1024 + g * 128 + 16 * nq + 8);
            const v4u c0 = *(const v4u*)(row + 1280 + g * 128 + 16 * nq), c1 = *(const v4u*)(row + 1280 + g * 128 + 16 * nq + 8);
            const float dA = __expf(a * dtv), dx = dtv * xv;
            float bv[16], cv[16];
            bv[0] = bflo(b0.x); bv[1] = bfhi(b0.x); bv[2] = bflo(b0.y); bv[3] = bfhi(b0.y); bv[4] = bflo(b0.z); bv[5] = bfhi(b0.z); bv[6] = bflo(b0.w); bv[7] = bfhi(b0.w);
            bv[8] = bflo(b1.x); bv[9] = bfhi(b1.x); bv[10] = bflo(b1.y); bv[11] = bfhi(b1.y); bv[12] = bflo(b1.z); bv[13] = bfhi(b1.z); bv[14] = bflo(b1.w); bv[15] = bfhi(b1.w);
            cv[0] = bflo(c0.x); cv[1] = bfhi(c0.x); cv[2] = bflo(c0.y); cv[3] = bfhi(c0.y); cv[4] = bflo(c0.z); cv[5] = bfhi(c0.z); cv[6] = bflo(c0.w); cv[7] = bfhi(c0.w);
            cv[8] = bflo(c1.x); cv[9] = bfhi(c1.x); cv[10] = bflo(c1.y); cv[11] = bfhi(c1.y); cv[12] = bflo(c1.z); cv[13] = bfhi(c1.z); cv[14] = bflo(c1.w); cv[15] = bfhi(c1.w);
            float part = 0.f;
#pragma unroll
            for (int i = 0; i < 16; ++i) { hs[i] = dA * hs[i] + dx * bv[i]; part += cv[i] * hs[i]; }
            part += __shfl_xor(part, 1); part += __shfl_xor(part, 2); part += __shfl_xor(part, 4);
            if (nq == 0) YD[((size_t)dir * T_ALL + m) * 1024 + h * 64 + pp] = part + dsk * xv;
        }
    }
}
__device__ __forceinline__ void phase_gnorm(const Prm& p, int l, int gw, int ngw, int lane) {
    const bf16* U = (const bf16*)(p.ws + WS_U); const bf16* YD = (const bf16*)(p.ws + WS_XG); bf16* MIX = (bf16*)(p.ws + WS_H);
    const int nrow = (l == 0) ? T_ALL : T_LAT;
    for (int m0 = gw; m0 < nrow; m0 += 2 * ngw) {
        const int m1 = (m0 + ngw < nrow) ? m0 + ngw : m0;
        v2u yv[2][4], zv[2][4];
#pragma unroll
        for (int q = 0; q < 2; ++q) { const int m = q ? m1 : m0;
#pragma unroll
            for (int j = 0; j < 4; ++j) { const int col = 256 * j + 4 * lane; yv[q][j] = *(const v2u*)(YD + (size_t)m * 1024 + col); zv[q][j] = *(const v2u*)(U + (size_t)m * NINP + C_Z + col); } }
#pragma unroll
        for (int q = 0; q < 2; ++q) { const int m = q ? m1 : m0;
            f32x4 u[4]; float ss[2] = {0.f, 0.f};
#pragma unroll
            for (int j = 0; j < 4; ++j) { const v2u yy = yv[q][j], zz = zv[q][j];
                u[j][0] = bflo(yy.x) * silu_f(bflo(zz.x)); u[j][1] = bfhi(yy.x) * silu_f(bfhi(zz.x)); u[j][2] = bflo(yy.y) * silu_f(bflo(zz.y)); u[j][3] = bfhi(yy.y) * silu_f(bfhi(zz.y));
                ss[j >> 1] += (u[j][0] * u[j][0] + u[j][1] * u[j][1]) + (u[j][2] * u[j][2] + u[j][3] * u[j][3]); }
            const float r0 = rsqrtf(wave_sum(ss[0]) * (1.f / 512.f) + EPS), r1 = rsqrtf(wave_sum(ss[1]) * (1.f / 512.f) + EPS);
            if (q == 1 && m1 == m0) continue;
#pragma unroll
            for (int j = 0; j < 4; ++j) { const int col = 256 * j + 4 * lane; const f32x4 g = *(const f32x4*)(p.ssd_norm + l * 1024 + col); const f32x4 o = u[j] * (j < 2 ? r0 : r1) * g;
                if (F8_OUTPROJ) *(unsigned*)((unsigned char*)MIX + (size_t)m * DM + 1024 + col) = pack4f8(o[0] * MIX_SCALE, o[1] * MIX_SCALE, o[2] * MIX_SCALE, o[3] * MIX_SCALE);
                else { v2u w; w.x = pk2(o[0], o[1]); w.y = pk2(o[2], o[3]); *(v2u*)(MIX + (size_t)m * DM + 1024 + col) = w; } }
        }
    }
}
namespace att {
typedef short s16x4 __attribute__((ext_vector_type(4)));
typedef float f32x16 __attribute__((ext_vector_type(16)));
constexpr int KVBLK = 64;
constexpr float THR = 8.f;
#ifndef ATT_SDEPTH
#define ATT_SDEPTH 1
#endif
constexpr int SDEPTH = ATT_SDEPTH;
constexpr int SHM_V = KVBLK * 128 * 2, SHM_K = KVBLK * 128 * 2;
constexpr int OFF_V = 0, OFF_K = 2 * SHM_V, OFF_WS = 2 * SHM_V + 2 * SHM_K, OFF_RPB = OFF_WS + 8 * 64 * 4, ATT_LDS = OFF_RPB + 576 * 4;
#define KSWZ(row, colB) ((row) * 256 + ((colB) ^ (((row) & 7) << 4)))
#define SBAR() __builtin_amdgcn_sched_barrier(0)
__device__ __forceinline__ int crow(int r, int hi) { return (r & 3) + 8 * (r >> 2) + 4 * hi; }
__device__ __forceinline__ unsigned cvtpk(float lo, float hi) { unsigned r; asm volatile("v_cvt_pk_bf16_f32 %0, %1, %2" : "=v"(r) : "v"(lo), "v"(hi)); return r; }
__device__ __forceinline__ void partialSM(f32x16& p0, f32x16& p1, float& m_reg, float& mn, float& alpha) {
  constexpr float C = ATT_SCALE * 1.4426950408889634f;
  float pmax = p0[0];
#pragma unroll
  for (int r = 1; r < 16; ++r) pmax = fmaxf(pmax, p0[r]);
#pragma unroll
  for (int r = 0; r < 16; ++r) pmax = fmaxf(pmax, p1[r]);
  { auto rr = __builtin_amdgcn_permlane32_swap(__float_as_uint(pmax), __float_as_uint(pmax), false, false);
    pmax = fmaxf(__uint_as_float(rr[0]), __uint_as_float(rr[1])); }
  if (__builtin_expect(__all(pmax - m_reg <= THR / ATT_SCALE), 1)) { mn = m_reg; alpha = 1.f; }
  else { mn = fmaxf(m_reg, pmax); alpha = __builtin_amdgcn_exp2f((m_reg - mn) * C); m_reg = mn; }
  float mnC = -mn * C;
#pragma unroll
  for (int r = 0; r < 16; ++r) p0[r] = fmaf(p0[r], C, mnC);
#pragma unroll
  for (int r = 0; r < 16; ++r) p1[r] = fmaf(p1[r], C, mnC);
#pragma unroll
  for (int r = 0; r < 16; ++r) p0[r] = __builtin_amdgcn_exp2f(p0[r]);
}
__device__ __forceinline__ void finishSM(f32x16& p0, f32x16& p1, float alpha, float& l_reg, bf16x8& pa0, bf16x8& pa1, bf16x8& pa2, bf16x8& pa3) {
#pragma unroll
  for (int r = 0; r < 16; ++r) p1[r] = __builtin_amdgcn_exp2f(p1[r]);
  float ps = 0;
#pragma unroll
  for (int r = 0; r < 16; ++r) ps += p0[r];
#pragma unroll
  for (int r = 0; r < 16; ++r) ps += p1[r];
  { auto rr = __builtin_amdgcn_permlane32_swap(__float_as_uint(ps), __float_as_uint(ps), false, false);
    ps = __uint_as_float(rr[0]) + __uint_as_float(rr[1]); }
  l_reg = l_reg * alpha + ps;
#define PK4(P, BASE, OUT) do { unsigned a0 = cvtpk(P[BASE + 0], P[BASE + 1]), a1 = cvtpk(P[BASE + 2], P[BASE + 3]);   \
    unsigned b0 = cvtpk(P[BASE + 4], P[BASE + 5]), b1 = cvtpk(P[BASE + 6], P[BASE + 7]);                              \
    auto r0 = __builtin_amdgcn_permlane32_swap(a0, b0, false, false); auto r1 = __builtin_amdgcn_permlane32_swap(a1, b1, false, false); \
    v4u w = {r0[0], r1[0], r0[1], r1[1]}; OUT = *reinterpret_cast<bf16x8*>(&w); } while (0)
  PK4(p0, 0, pa0); PK4(p0, 8, pa1); PK4(p1, 0, pa2); PK4(p1, 8, pa3);
#undef PK4
}
__device__ __forceinline__ void qkt(f32x16& p0, f32x16& p1, const LAS unsigned char* Ks, const bf16x8* qr, int r32, int hi) {
  p0 = f32x16{}; p1 = f32x16{};
#pragma unroll
  for (int d0 = 0; d0 < 8; ++d0) { int cb = (d0 * 16 + hi * 8) * 2;
    bf16x8 b0 = *reinterpret_cast<const LAS bf16x8*>(Ks + KSWZ(r32, cb));
    bf16x8 b1 = *reinterpret_cast<const LAS bf16x8*>(Ks + KSWZ(32 + r32, cb));
    p0 = __builtin_amdgcn_mfma_f32_32x32x16_bf16(b0, qr[d0], p0, 0, 0, 0);
    p1 = __builtin_amdgcn_mfma_f32_32x32x16_bf16(b1, qr[d0], p1, 0, 0, 0); }
}
__device__ __forceinline__ int v_st(int k, int c) { const int kk = (k & ~0xC) | ((k & 4) << 1) | ((k & 8) >> 1); return ((kk >> 3) * 4 + (c >> 5)) * 512 + ((kk & 7) * 32 + (c & 31)) * 2; }
__device__ __forceinline__ int v_rd_base(int lane) { return ((lane & 3) << 3) | (((lane >> 2) & 3) << 6) | (((lane >> 4) & 1) << 5) | (((lane >> 5) & 1) << 8); }
constexpr int v_rd_off(int d0, int ks, int half) { return d0 * 512 + ks * 4096 + half * 2048; }
template <int OFF> __device__ __forceinline__ s16x4 tr_read(int vb) {
  s16x4 r; asm volatile("ds_read_b64_tr_b16 %0, %1 offset:%2" : "=&v"(r) : "v"(vb), "i"(OFF) : "memory"); return r;
}
template <int D0> __device__ __forceinline__ void pv_one(f32x16& od, int vb, bf16x8 pa0, bf16x8 pa1, bf16x8 pa2, bf16x8 pa3) {
  const s16x4 l0 = tr_read<v_rd_off(D0, 0, 0)>(vb), h0 = tr_read<v_rd_off(D0, 0, 1)>(vb), l1 = tr_read<v_rd_off(D0, 1, 0)>(vb), h1 = tr_read<v_rd_off(D0, 1, 1)>(vb);
  const s16x4 l2 = tr_read<v_rd_off(D0, 2, 0)>(vb), h2 = tr_read<v_rd_off(D0, 2, 1)>(vb), l3 = tr_read<v_rd_off(D0, 3, 0)>(vb), h3 = tr_read<v_rd_off(D0, 3, 1)>(vb);
  asm volatile("s_waitcnt lgkmcnt(0)" ::: "memory"); SBAR();
#define PK(L, H) (bf16x8){L[0], L[1], L[2], L[3], H[0], H[1], H[2], H[3]}
  od = __builtin_amdgcn_mfma_f32_32x32x16_bf16(pa0, PK(l0, h0), od, 0, 0, 0);
  od = __builtin_amdgcn_mfma_f32_32x32x16_bf16(pa1, PK(l1, h1), od, 0, 0, 0);
  od = __builtin_amdgcn_mfma_f32_32x32x16_bf16(pa2, PK(l2, h2), od, 0, 0, 0);
  od = __builtin_amdgcn_mfma_f32_32x32x16_bf16(pa3, PK(l3, h3), od, 0, 0, 0);
#undef PK
}
__device__ __forceinline__ void pv_d0(f32x16* o, int vb, bf16x8 pa0, bf16x8 pa1, bf16x8 pa2, bf16x8 pa3) {
  pv_one<0>(o[0], vb, pa0, pa1, pa2, pa3); pv_one<1>(o[1], vb, pa0, pa1, pa2, pa3); pv_one<2>(o[2], vb, pa0, pa1, pa2, pa3); pv_one<3>(o[3], vb, pa0, pa1, pa2, pa3);
}
struct UnitD { int type, b, hh, q0  , nloc  , kbase  ; };
__device__ __forceinline__ int tile_row(const UnitD& u, int j) {
    if (j >= u.nloc) return T_LAT + u.b * CTXL + (j - u.nloc) * 64;
    if (u.type == 0) return u.b * SEQL + (u.kbase + j) * 64;
    const int kp = u.kbase + j * 64; return u.b * SEQL + min(max(kp, 0), SEQL - 64);
}
__device__ __forceinline__ bool tile_active(const UnitD& u, int j, int wid) {
    if (j >= u.nloc) return true;
    if (u.type == 0) { const int qr = (u.q0 >> 6) + (wid >> 1), kr = u.kbase + j, start = min(max(qr - 4, 0), 120); return kr >= start && kr < start + 8; }
    const int qw = u.q0 + 32 * wid, kp0 = u.kbase + j * 64;
    return (kp0 >= 0) && (kp0 < SEQL) && (kp0 - (qw + 31) <= 128) && (qw - (kp0 + 63) <= 128);
}
__device__ __forceinline__ void apply_mask(f32x16& p0, f32x16& p1, const UnitD& u, int j, int wid, int r32, int hi, const LAS float* rpbL) {
    if (j >= u.nloc) return;
    if (u.type == 0) {
        const int qr = (u.q0 >> 6) + (wid >> 1), qc = (wid & 1) * 32 + r32, kr = u.kbase + j;
        const int c0 = min(max(qc - 8, 0), 48), cb = 4 * hi - c0;
        const LAS float* rp = rpbL + (kr - qr + 7) * 31 + 4 * hi - qc + 15 + 32;
#pragma unroll
        for (int r = 0; r < 16; ++r) {
            const int k0 = (r & 3) + 8 * (r >> 2);
            p0[r] = ((unsigned)(k0 + cb) < 16u) ? p0[r] + rp[k0] : -INFINITY;
            p1[r] = ((unsigned)(k0 + 32 + cb) < 16u) ? p1[r] + rp[k0 + 32] : -INFINITY;
            if ((r & 3) == 3) SBAR(); }
    } else {
        const int qw = u.q0 + 32 * wid, kp0 = u.kbase + j * 64;
        if ((kp0 + 63 - qw <= 128) && (qw + 31 - kp0 <= 128)) return;
        const int cb = kp0 + 4 * hi - (qw + r32) + 128;
#pragma unroll
        for (int r = 0; r < 16; ++r) {
            const int k0 = (r & 3) + 8 * (r >> 2);
            p0[r] = ((unsigned)(k0 + cb) <= 256u) ? p0[r] : -INFINITY;
            p1[r] = ((unsigned)(k0 + 32 + cb) <= 256u) ? p1[r] : -INFINITY; }
    }
}
__device__ __forceinline__ void fill_ninf(f32x16& p0, f32x16& p1) {
#pragma unroll
    for (int r = 0; r < 16; ++r) { p0[r] = -INFINITY; p1[r] = -INFINITY; }
}
__device__ __forceinline__ void attn_unit(const Prm& p, int l, const UnitD u, LAS unsigned char* lds, int tid) {
  const bf16* U = (const bf16*)(p.ws + WS_U); bf16* MIX = (bf16*)(p.ws + WS_H);
  const int wid = __builtin_amdgcn_readfirstlane(tid >> 6), lane = tid & 63, r32 = lane & 31, hi = lane >> 5;
  int qcol, kcol, vcol, ocol;
  if (u.type == 0 || u.type == 2) { qcol = C_QA + u.hh * 128; kcol = C_KA + u.hh * 128; vcol = C_VA + u.hh * 128; ocol = u.hh * 128; }
  else { const int kvh = u.hh >> 1; qcol = C_QB + u.hh * 128; kcol = C_KB + kvh * 128; vcol = C_VB + kvh * 128; ocol = 512 + u.hh * 128; }
  const int qrow0 = (u.type < 2 ? u.b * SEQL : T_LAT + u.b * CTXL) + u.q0;
  LAS unsigned char* V_lds = lds + OFF_V; LAS unsigned char* K_lds = lds + OFF_K;
  LAS float* wsl = (LAS float*)(lds + OFF_WS) + wid * 64; LAS float* li_l = wsl; LAS float* al_l = wsl + 32;
  LAS float* rpbL = (LAS float*)(lds + OFF_RPB);
  if (u.type == 0 && tid < 465) rpbL[32 + tid] = p.na_rpb[(size_t)(l * 4 + u.hh) * 465 + tid] * (1.f / ATT_SCALE);
  float m_reg = -1e30f, l_reg = 0; f32x16 o[4] = {}; bf16x8 qr[8];
  const bf16* Qw = U + (size_t)(qrow0 + wid * 32 + r32) * NINP + qcol + hi * 8;
#pragma unroll
  for (int d0 = 0; d0 < 8; ++d0) qr[d0] = *reinterpret_cast<const bf16x8*>(Qw + d0 * 16);
  const int sr = tid >> 4, sc = (tid & 15) * 8, vst0 = v_st(sr, sc), vst1 = v_st(32 + sr, sc);
  const int vb0 = (int)(uintptr_t)V_lds + v_rd_base(lane);
  struct { bf16x8 vs0, vs1, ks0, ks1; } sr_[SDEPTH];
#define SLOAD(i, jt) do { const bf16* rb_ = U + (size_t)(tile_row(u, (jt)) + sr) * NINP + sc; \
    sr_[i].vs0 = *reinterpret_cast<const bf16x8*>(rb_ + vcol); sr_[i].vs1 = *reinterpret_cast<const bf16x8*>(rb_ + (size_t)32 * NINP + vcol); \
    sr_[i].ks0 = *reinterpret_cast<const bf16x8*>(rb_ + kcol); sr_[i].ks1 = *reinterpret_cast<const bf16x8*>(rb_ + (size_t)32 * NINP + kcol); } while (0)
#define SWRITE(b, i) do { *(LAS bf16x8*)(V_lds + (b) * SHM_V + vst0) = sr_[i].vs0;          \
    *(LAS bf16x8*)(V_lds + (b) * SHM_V + vst1) = sr_[i].vs1; int kc = sc * 2;               \
    *(LAS bf16x8*)(K_lds + (b) * SHM_K + KSWZ(sr, kc)) = sr_[i].ks0;                       \
    *(LAS bf16x8*)(K_lds + (b) * SHM_K + KSWZ(32 + sr, kc)) = sr_[i].ks1; } while (0)
#define SWAIT() do { if constexpr (SDEPTH == 2) asm volatile("s_waitcnt vmcnt(4)" ::: "memory"); else asm volatile("s_waitcnt vmcnt(0)" ::: "memory"); } while (0)
#define RESC(a) do { if (__any((a) < 1.f)) { if (hi == 0) al_l[r32] = (a); asm volatile("s_waitcnt lgkmcnt(0)" ::: "memory"); \
    _Pragma("unroll") for (int d = 0; d < 4; ++d) _Pragma("unroll") for (int r = 0; r < 16; ++r) o[d][r] *= al_l[crow(r, hi)]; } } while (0)
  f32x16 pA0, pA1, pB0, pB1; float mnA, mnB, alA, alB; bf16x8 pa0, pa1, pa2, pa3; const int NT = u.nloc + 4;
  constexpr int SE = 0, SO = SDEPTH - 1;
  SLOAD(SE, 0); asm volatile("s_waitcnt vmcnt(0)" ::: "memory"); SWRITE(0, SE); __syncthreads();
#define SCORE(P0, P1, KB, jt, ACT) do { ACT = tile_active(u, (jt), wid); if (ACT) { qkt(P0, P1, KB, qr, r32, hi); apply_mask(P0, P1, u, (jt), wid, r32, hi, rpbL); } else fill_ninf(P0, P1); } while (0)
  bool actA, actB;
  SCORE(pA0, pA1, K_lds, 0, actA); partialSM(pA0, pA1, m_reg, mnA, alA);
  SLOAD(SO, 1); if constexpr (SDEPTH == 2) { if (2 < NT) SLOAD(SE, 2); }
  SWAIT(); SWRITE(1, SO); __syncthreads();
  for (int j = 1; j + 1 < NT; j += 2) {
    SBAR(); SCORE(pB0, pB1, K_lds + SHM_K, j, actB);
    finishSM(pA0, pA1, alA, l_reg, pa0, pa1, pa2, pa3); SBAR();
    SLOAD(SO, j + SDEPTH); SBAR();
    if (actA) pv_d0(o, vb0, pa0, pa1, pa2, pa3); partialSM(pB0, pB1, m_reg, mnB, alB);
    __syncthreads(); SWAIT(); SWRITE(0, SE);
    RESC(alB); __syncthreads();
    SBAR(); SCORE(pA0, pA1, K_lds, j + 1, actA);
    finishSM(pB0, pB1, alB, l_reg, pa0, pa1, pa2, pa3); SBAR();
    if (SDEPTH == 1 || j + 3 < NT) SLOAD(SE, j + 1 + SDEPTH); SBAR();
    if (actB) pv_d0(o, vb0 + SHM_V, pa0, pa1, pa2, pa3); partialSM(pA0, pA1, m_reg, mnA, alA);
    __syncthreads(); SWAIT(); SWRITE(1, SO);
    RESC(alA); __syncthreads();
  }
  SBAR(); SCORE(pB0, pB1, K_lds + SHM_K, NT - 1, actB);
  finishSM(pA0, pA1, alA, l_reg, pa0, pa1, pa2, pa3); SBAR();
  if (actA) pv_d0(o, vb0, pa0, pa1, pa2, pa3); partialSM(pB0, pB1, m_reg, mnB, alB);
  __syncthreads(); RESC(alB);
  finishSM(pB0, pB1, alB, l_reg, pa0, pa1, pa2, pa3); SBAR();
  if (actB) pv_d0(o, vb0 + SHM_V, pa0, pa1, pa2, pa3);
  if (u.type & 1) { constexpr float C = ATT_SCALE * 1.4426950408889634f; l_reg += __builtin_amdgcn_exp2f((p.wa_sink[l * 4 + u.hh] * (1.f / ATT_SCALE) - m_reg) * C); }
  if (hi == 0) li_l[r32] = l_reg; asm volatile("s_waitcnt lgkmcnt(0)" ::: "memory");
  float rli[16];
#pragma unroll
  for (int r = 0; r < 16; ++r) rli[r] = __builtin_amdgcn_rcpf(li_l[crow(r, hi)]);
  bf16* Ow = MIX + (size_t)(qrow0 + wid * 32) * DM + ocol;
#pragma unroll
  for (int r = 0; r < 16; r += 2) {
#pragma unroll
    for (int d0 = 0; d0 < 4; ++d0) {
      const float a = o[d0][r] * rli[r], b = o[d0][r + 1] * rli[r + 1];
      const float send = (lane & 1) ? a : b, got = __shfl_xor(send, 1);
      const int orow = crow(r, hi) + (lane & 1), ocl = d0 * 32 + (r32 & ~1);
      if (F8_OUTPROJ) { const float lo = ((lane & 1) ? got : a) * MIX_SCALE, hi2 = ((lane & 1) ? b : got) * MIX_SCALE;
        *(unsigned short*)((unsigned char*)MIX + (size_t)(qrow0 + wid * 32 + orow) * DM + ocol + ocl) = (unsigned short)pack4f8(lo, hi2, 0.f, 0.f); }
      else { const unsigned w = (lane & 1) ? pk2(got, b) : pk2(a, got); *(unsigned*)(Ow + (size_t)orow * DM + ocl) = w; } } }
  __syncthreads();
#undef SCORE
#undef SLOAD
#undef SWRITE
#undef SWAIT
#undef RESC
}
constexpr int NSLOT = 3;
constexpr int OFFD_K = 0, OFFD_V = NSLOT * SHM_K, OFFD_WS = NSLOT * (SHM_K + SHM_V), OFFD_RPB = OFFD_WS + 8 * 64 * 4, ATT_LDS_D = OFFD_RPB + 576 * 4;
static_assert(ATT_LDS_D <= RING_BYTES, "attention LDS");
__device__ __forceinline__ void attn_unit_dma(const Prm& p, int l, const UnitD u, LAS unsigned char* lds, int tid) {
  const bf16* U = (const bf16*)(p.ws + WS_U); bf16* MIX = (bf16*)(p.ws + WS_H);
  const int wid = __builtin_amdgcn_readfirstlane(tid >> 6), lane = tid & 63, r32 = lane & 31, hi = lane >> 5;
  int qcol, kcol, vcol, ocol;
  if (u.type == 0 || u.type == 2) { qcol = C_QA + u.hh * 128; kcol = C_KA + u.hh * 128; vcol = C_VA + u.hh * 128; ocol = u.hh * 128; }
  else { const int kvh = u.hh >> 1; qcol = C_QB + u.hh * 128; kcol = C_KB + kvh * 128; vcol = C_VB + kvh * 128; ocol = 512 + u.hh * 128; }
  const int qrow0 = (u.type < 2 ? u.b * SEQL : T_LAT + u.b * CTXL) + u.q0;
  LAS unsigned char* K_lds = lds + OFFD_K; LAS unsigned char* V_lds = lds + OFFD_V;
  LAS float* wsl = (LAS float*)(lds + OFFD_WS) + wid * 64; LAS float* li_l = wsl; LAS float* al_l = wsl + 32;
  LAS float* rpbL = (LAS float*)(lds + OFFD_RPB);
  if (u.type == 0 && tid < 465) rpbL[32 + tid] = p.na_rpb[(size_t)(l * 4 + u.hh) * 465 + tid] * (1.f / ATT_SCALE);
  float m_reg = -1e30f, l_reg = 0; f32x16 o[4] = {}; bf16x8 qr[8];
  const bf16* Qw = U + (size_t)(qrow0 + wid * 32 + r32) * NINP + qcol + hi * 8;
#pragma unroll
  for (int d0 = 0; d0 < 8; ++d0) qr[d0] = *reinterpret_cast<const bf16x8*>(Qw + d0 * 16);
  unsigned koff[2], voff[2];
#pragma unroll
  for (int i = 0; i < 2; ++i) { const int pch = (wid * 2 + i) * 64 + lane;
    { const int row = pch >> 4, c = (pch & 15) ^ (row & 7); koff[i] = (unsigned)(row * NINP + kcol + c * 8); }
    { const int sidx = pch >> 5, q = pch & 31, kk = (sidx >> 2) * 8 + (q >> 2), k = (kk & ~0xC) | ((kk & 4) << 1) | ((kk & 8) >> 1);
      voff[i] = (unsigned)(k * NINP + vcol + (sidx & 3) * 32 + (q & 3) * 8); } }
  const int vb0 = (int)(uintptr_t)V_lds + v_rd_base(lane);
#define DMA_K(jt) do { const bf16* tb_ = U + (size_t)tile_row(u, (jt)) * NINP; LAS unsigned char* dst_ = K_lds + ((jt) % NSLOT) * SHM_K + wid * 2048; \
    _Pragma("unroll") for (int i_ = 0; i_ < 2; ++i_) __builtin_amdgcn_global_load_lds((const unsigned*)(tb_ + koff[i_]), (LAS unsigned*)(dst_ + i_ * 1024), 16, 0, 0); } while (0)
#define DMA_V(jt) do { const bf16* tb_ = U + (size_t)tile_row(u, (jt)) * NINP; LAS unsigned char* dst_ = V_lds + ((jt) % NSLOT) * SHM_V + wid * 2048; \
    _Pragma("unroll") for (int i_ = 0; i_ < 2; ++i_) __builtin_amdgcn_global_load_lds((const unsigned*)(tb_ + voff[i_]), (LAS unsigned*)(dst_ + i_ * 1024), 16, 0, 0); } while (0)
#define STEP_SYNC4() asm volatile("s_waitcnt vmcnt(4) lgkmcnt(0)\n\ts_barrier" ::: "memory")
#define STEP_SYNC0() asm volatile("s_waitcnt vmcnt(0) lgkmcnt(0)\n\ts_barrier" ::: "memory")
#define RESC(a) do { if (__any((a) < 1.f)) { if (hi == 0) al_l[r32] = (a); asm volatile("s_waitcnt lgkmcnt(0)" ::: "memory"); \
    _Pragma("unroll") for (int d = 0; d < 4; ++d) _Pragma("unroll") for (int r = 0; r < 16; ++r) o[d][r] *= al_l[crow(r, hi)]; } } while (0)
#define SCORE(P0, P1, jt, ACT) do { ACT = tile_active(u, (jt), wid); if (ACT) { qkt(P0, P1, K_lds + ((jt) % NSLOT) * SHM_K, qr, r32, hi); apply_mask(P0, P1, u, (jt), wid, r32, hi, rpbL); } else fill_ninf(P0, P1); } while (0)
  f32x16 pA0, pA1, pB0, pB1; float mnA, mnB, alA, alB; bf16x8 pa0, pa1, pa2, pa3; const int NT = u.nloc + 4; bool actA, actB;
  DMA_K(0); DMA_K(1); DMA_V(0);
  STEP_SYNC4();
  DMA_K(2); DMA_V(1);
  SCORE(pA0, pA1, 0, actA); partialSM(pA0, pA1, m_reg, mnA, alA);
#pragma unroll 1
  for (int s = 1; s + 1 < NT; s += 2) {
    STEP_SYNC4();
    DMA_K(s + 2); DMA_V(s + 1);
    SBAR(); SCORE(pB0, pB1, s, actB);
    finishSM(pA0, pA1, alA, l_reg, pa0, pa1, pa2, pa3); SBAR();
    if (actA) pv_d0(o, vb0 + ((s - 1) % NSLOT) * SHM_V, pa0, pa1, pa2, pa3); partialSM(pB0, pB1, m_reg, mnB, alB);
    RESC(alB);
    STEP_SYNC4();
    if (s + 3 < NT) DMA_K(s + 3); DMA_V(s + 2);
    SBAR(); SCORE(pA0, pA1, s + 1, actA);
    finishSM(pB0, pB1, alB, l_reg, pa0, pa1, pa2, pa3); SBAR();
    if (actB) pv_d0(o, vb0 + (s % NSLOT) * SHM_V, pa0, pa1, pa2, pa3); partialSM(pA0, pA1, m_reg, mnA, alA);
    RESC(alA);
  }
  STEP_SYNC0();
  SBAR(); SCORE(pB0, pB1, NT - 1, actB);
  finishSM(pA0, pA1, alA, l_reg, pa0, pa1, pa2, pa3); SBAR();
  if (actA) pv_d0(o, vb0 + ((NT - 2) % NSLOT) * SHM_V, pa0, pa1, pa2, pa3); partialSM(pB0, pB1, m_reg, mnB, alB);
  RESC(alB);
  finishSM(pB0, pB1, alB, l_reg, pa0, pa1, pa2, pa3); SBAR();
  if (actB) pv_d0(o, vb0 + ((NT - 1) % NSLOT) * SHM_V, pa0, pa1, pa2, pa3);
  if (u.type & 1) { constexpr float C = ATT_SCALE * 1.4426950408889634f; l_reg += __builtin_amdgcn_exp2f((p.wa_sink[l * 4 + u.hh] * (1.f / ATT_SCALE) - m_reg) * C); }
  if (hi == 0) li_l[r32] = l_reg; asm volatile("s_waitcnt lgkmcnt(0)" ::: "memory");
  float rli[16];
#pragma unroll
  for (int r = 0; r < 16; ++r) rli[r] = __builtin_amdgcn_rcpf(li_l[crow(r, hi)]);
  bf16* Ow = MIX + (size_t)(qrow0 + wid * 32) * DM + ocol;
#pragma unroll
  for (int r = 0; r < 16; r += 2) {
#pragma unroll
    for (int d0 = 0; d0 < 4; ++d0) {
      const float a = o[d0][r] * rli[r], b = o[d0][r + 1] * rli[r + 1];
      const float send = (lane & 1) ? a : b, got = __shfl_xor(send, 1);
      const int orow = crow(r, hi) + (lane & 1), ocl = d0 * 32 + (r32 & ~1);
      if (F8_OUTPROJ) { const float lo = ((lane & 1) ? got : a) * MIX_SCALE, hi2 = ((lane & 1) ? b : got) * MIX_SCALE;
        *(unsigned short*)((unsigned char*)MIX + (size_t)(qrow0 + wid * 32 + orow) * DM + ocol + ocl) = (unsigned short)pack4f8(lo, hi2, 0.f, 0.f); }
      else { const unsigned w = (lane & 1) ? pk2(got, b) : pk2(a, got); *(unsigned*)(Ow + (size_t)orow * DM + ocl) = w; } } }
  asm volatile("s_waitcnt lgkmcnt(0)\n\ts_barrier" ::: "memory");
#undef DMA_K
#undef DMA_V
#undef STEP_SYNC4
#undef STEP_SYNC0
#undef RESC
#undef SCORE
}
#ifndef ATT_DMA
#define ATT_DMA 1
#endif
__device__ __forceinline__ void phase_attn(const Prm& p, int l, LAS unsigned char* lds, int wg, int nwg, int tid) {
    const int nu = 512 + (l == 0 ? 16 : 0);
    for (int it = wg; it < nu; it += nwg) {
        UnitD u;
        if (it < 256) { u.type = 0; u.b = it >> 7; u.hh = (it >> 5) & 3; const int blk = it & 31; u.q0 = blk * 256; u.nloc = 12; u.kbase = min(max(blk * 4 - 4, 0), 116); }
        else if (it < 512) { const int r = it - 256; u.type = 1; u.b = r >> 7; u.hh = (r >> 5) & 3; const int blk = r & 31; u.q0 = blk * 256; u.nloc = 8; u.kbase = blk * 256 - 128; }
        else { const int r = it - 512; u.type = 2 + (r >> 3); u.b = (r >> 2) & 1; u.hh = r & 3; u.q0 = 0; u.nloc = 0; u.kbase = 0; }
        if (ATT_DMA) attn_unit_dma(p, l, u, lds, tid); else attn_unit(p, l, u, lds, tid);
    }
}
}
namespace ssd {
typedef short s16x4 __attribute__((ext_vector_type(4)));
typedef float f32x16 __attribute__((ext_vector_type(16)));
constexpr int NCH = 66;
constexpr size_t WS_ST = WS_YD, WS_HS = WS_YD + 66 * MiB, WS_DEC = 1259 * MiB;
__device__ __forceinline__ int crow(int r, int hi) { return (r & 3) + 8 * (r >> 2) + 4 * hi; }
__device__ __forceinline__ int chunk_row0(int b, int c) { return c < 2 ? T_LAT + b * CTXL + c * 128 : b * SEQL + (c - 2) * 128; }
__device__ __forceinline__ s16x4 ds_tr(unsigned addr) { s16x4 r; asm volatile("ds_read_b64_tr_b16 %0, %1" : "=&v"(r) : "v"(addr) : "memory"); return r; }
struct Raw { s16x4 lo, hi; };
__device__ __forceinline__ Raw raw_tr_nat(unsigned base, int stride, int k0, int idx0, int lane) {
    const int i16 = lane & 15, g16 = (lane >> 4) & 1, hl = lane >> 5;
    const unsigned a = base + (unsigned)((k0 + 8 * hl + (i16 >> 2)) * stride + (idx0 + 16 * g16 + 4 * (i16 & 3)) * 2);
    Raw r; r.lo = ds_tr(a); r.hi = ds_tr(a + 4 * stride); return r;
}
__device__ __forceinline__ Raw raw_tr_acc(unsigned base, int stride, int k0, int idx0, int lane) {
    const int i16 = lane & 15, g16 = (lane >> 4) & 1, hl = lane >> 5;
    const unsigned a = base + (unsigned)((k0 + 4 * hl + (i16 >> 2)) * stride + (idx0 + 16 * g16 + 4 * (i16 & 3)) * 2);
    Raw r; r.lo = ds_tr(a); r.hi = ds_tr(a + 8 * stride); return r;
}
__device__ __forceinline__ void raw_wait2(Raw& a, Raw& b) { asm volatile("s_waitcnt lgkmcnt(0)" : "+v"(a.lo), "+v"(a.hi), "+v"(b.lo), "+v"(b.hi) :: "memory"); }
__device__ __forceinline__ void raw_wait6(Raw& a, Raw& b, Raw& c, Raw& d, Raw& e, Raw& f) {
    asm volatile("s_waitcnt lgkmcnt(0)" : "+v"(a.lo), "+v"(a.hi), "+v"(b.lo), "+v"(b.hi), "+v"(c.lo), "+v"(c.hi), "+v"(d.lo), "+v"(d.hi), "+v"(e.lo), "+v"(e.hi), "+v"(f.lo), "+v"(f.hi) :: "memory"); }
__device__ __forceinline__ bf16x8 join8(const Raw& r) { return (bf16x8){r.lo[0], r.lo[1], r.lo[2], r.lo[3], r.hi[0], r.hi[1], r.hi[2], r.hi[3]}; }
__device__ __forceinline__ unsigned cvtpk(float lo, float hi) { unsigned r; asm volatile("v_cvt_pk_bf16_f32 %0, %1, %2\n\ts_nop 1" : "=v"(r) : "v"(lo), "v"(hi)); return r; }
__device__ __forceinline__ void scan128(float& v0, float& v1, int lane) {
#pragma unroll
    for (int o = 1; o < 64; o <<= 1) { const int src = (lane >= o ? lane - o : lane) << 2;
        const float t0 = __builtin_bit_cast(float, __builtin_amdgcn_ds_bpermute(src, __builtin_bit_cast(int, v0))), t1 = __builtin_bit_cast(float, __builtin_amdgcn_ds_bpermute(src, __builtin_bit_cast(int, v1)));
        if (lane >= o) { v0 += t0; v1 += t1; } }
    v1 += __builtin_bit_cast(float, __builtin_amdgcn_ds_bpermute(63 << 2, __builtin_bit_cast(int, v0)));
}
__device__ __forceinline__ float lane63(float v) { return __builtin_bit_cast(float, __builtin_amdgcn_ds_bpermute(63 << 2, __builtin_bit_cast(int, v))); }

constexpr int BST = 272, XST = 528;
constexpr int S2_B = 0, S2_X = 128 * BST, S2_W = S2_X + 128 * XST, S2_END = S2_W + 8 * 128 * 4;
__device__ __forceinline__ void phase_states(const Prm& p, int l, LAS unsigned char* lds, int wg, int nwg, int tid) {
    const bf16* XA = (const bf16*)(p.ws + WS_XBC); const float* DT = (const float*)(p.ws + WS_DT);
    bf16* ST = (bf16*)(p.ws + WS_ST); float* DEC = (float*)(p.ws + WS_DEC);
    const int wid = __builtin_amdgcn_readfirstlane(tid >> 6), lane = tid & 63, hl = lane >> 5;
    for (int it = wg; it < 2 * NCH * 4; it += nwg) {
        const int b = it / (NCH * 4), rem = it % (NCH * 4), c = rem >> 2, g = (rem >> 1) & 1, hq = rem & 1;
        const int row0 = chunk_row0(b, c), h = 8 * g + 4 * hq + (wid & 3), dir = wid >> 2;
        { v4u tb[4], tx[8];
#pragma unroll
          for (int i = 0; i < 4; ++i) { const int id = tid + 512 * i, r = id >> 4, ch = id & 15; tb[i] = *(const v4u*)(XA + (size_t)(row0 + r) * XBCW + 1024 + g * 128 + ch * 8); }
#pragma unroll
          for (int i = 0; i < 8; ++i) { const int id = tid + 512 * i, r = id >> 5, ch = id & 31; tx[i] = *(const v4u*)(XA + (size_t)(row0 + r) * XBCW + (8 * g + 4 * hq) * 64 + ch * 8); }
#pragma unroll
          for (int i = 0; i < 4; ++i) { const int id = tid + 512 * i, r = id >> 4, ch = id & 15; *(LAS v4u*)(lds + S2_B + r * BST + ch * 16) = tb[i]; }
#pragma unroll
          for (int i = 0; i < 8; ++i) { const int id = tid + 512 * i, r = id >> 5, ch = id & 31; *(LAS v4u*)(lds + S2_X + r * XST + ch * 16) = tx[i]; } }
        const float a = -__expf(p.a_log[l * 32 + dir * 16 + h]);
        const float d0 = DT[(size_t)(row0 + lane) * 32 + dir * 16 + h], d1 = DT[(size_t)(row0 + 64 + lane) * 32 + dir * 16 + h];
        float P0 = a * d0, P1 = a * d1; scan128(P0, P1, lane);
        const float tot = lane63(P1);
        LAS float* wL = (LAS float*)(lds + S2_W) + wid * 128;
        wL[lane] = (dir == 0 ? __expf(tot - P0) : __expf(P0 - a * d0)) * d0;
        wL[64 + lane] = (dir == 0 ? __expf(tot - P1) : __expf(P1 - a * d1)) * d1;
        if (lane == 0) DEC[((b * NCH + c) * 2 + dir) * 16 + h] = __expf(tot);
        __syncthreads();
        f32x16 acc[2][4];
#pragma unroll
        for (int i = 0; i < 2; ++i)
#pragma unroll
            for (int j = 0; j < 4; ++j) acc[i][j] = f32x16{};
        const unsigned bB = (unsigned)(uintptr_t)(lds + S2_B), bX = (unsigned)(uintptr_t)(lds + S2_X);
#pragma unroll 1
        for (int ks = 0; ks < 8; ++ks) {
            const f32x4 w0 = *(const LAS f32x4*)(wL + 16 * ks + 8 * hl), w1 = *(const LAS f32x4*)(wL + 16 * ks + 8 * hl + 4);
            bf16x8 xa[2], bb[4];
            { Raw rx0 = raw_tr_nat(bX, XST, 16 * ks, (wid & 3) * 64, lane), rx1 = raw_tr_nat(bX, XST, 16 * ks, (wid & 3) * 64 + 32, lane);
              Raw rb0 = raw_tr_nat(bB, BST, 16 * ks, 0, lane), rb1 = raw_tr_nat(bB, BST, 16 * ks, 32, lane), rb2 = raw_tr_nat(bB, BST, 16 * ks, 64, lane), rb3 = raw_tr_nat(bB, BST, 16 * ks, 96, lane);
              raw_wait6(rx0, rx1, rb0, rb1, rb2, rb3);
              xa[0] = join8(rx0); xa[1] = join8(rx1); bb[0] = join8(rb0); bb[1] = join8(rb1); bb[2] = join8(rb2); bb[3] = join8(rb3); }
#pragma unroll
            for (int pt = 0; pt < 2; ++pt) {
                v4u q = *reinterpret_cast<v4u*>(&xa[pt]);
                q.x = cvtpk(bflo(q.x) * w0[0], bfhi(q.x) * w0[1]); q.y = cvtpk(bflo(q.y) * w0[2], bfhi(q.y) * w0[3]);
                q.z = cvtpk(bflo(q.z) * w1[0], bfhi(q.z) * w1[1]); q.w = cvtpk(bflo(q.w) * w1[2], bfhi(q.w) * w1[3]);
                xa[pt] = *reinterpret_cast<bf16x8*>(&q); }
#pragma unroll
            for (int pt = 0; pt < 2; ++pt)
#pragma unroll
                for (int nt = 0; nt < 4; ++nt) acc[pt][nt] = __builtin_amdgcn_mfma_f32_32x32x16_bf16(xa[pt], bb[nt], acc[pt][nt], 0, 0, 0);
        }
        bf16* so = ST + ((size_t)((b * NCH + c) * 2 + dir) * 16 + h) * 8192;
#pragma unroll
        for (int pt = 0; pt < 2; ++pt)
#pragma unroll
            for (int nt = 0; nt < 4; ++nt)
#pragma unroll
                for (int r = 0; r < 16; r += 2) {
                    const float x0 = acc[pt][nt][r], x1 = acc[pt][nt][r + 1];
                    const float send = (lane & 1) ? x0 : x1, got = __shfl_xor(send, 1);
                    const unsigned w = (lane & 1) ? pk2(got, x1) : pk2(x0, got);
                    *(unsigned*)(so + (size_t)(pt * 32 + crow(r, hl) + (lane & 1)) * 128 + nt * 32 + ((lane & 31) & ~1)) = w; }
        __syncthreads();
    }
}

__device__ __forceinline__ void phase_scan(const Prm& p, int gtid, int ngt) {
    const bf16* ST = (const bf16*)(p.ws + WS_ST); bf16* HS = (bf16*)(p.ws + WS_HS); const float* DEC = (const float*)(p.ws + WS_DEC);
    for (int e = gtid; e < 2 * 2 * 16 * 2048; e += ngt) {
        const int q = e & 2047, h = (e >> 11) & 15, dir = (e >> 15) & 1, b = e >> 16;
        f32x4 hs = {0.f, 0.f, 0.f, 0.f};
#pragma unroll 6
        for (int i = 0; i < NCH; ++i) {
            const int c = dir == 0 ? i : (i < 2 ? 1 - i : NCH + 1 - i);
            const size_t off = ((size_t)((b * NCH + c) * 2 + dir) * 16 + h) * 8192 + q * 4;
            const v2u sv = *(const v2u*)(ST + off); const float dc = DEC[((b * NCH + c) * 2 + dir) * 16 + h];
            v2u o; o.x = pk2(hs[0], hs[1]); o.y = pk2(hs[2], hs[3]); *(v2u*)(HS + off) = o;
            hs[0] = dc * hs[0] + bflo(sv.x); hs[1] = dc * hs[1] + bfhi(sv.x); hs[2] = dc * hs[2] + bflo(sv.y); hs[3] = dc * hs[3] + bfhi(sv.y);
        }
    }
}

constexpr int CST = 272, XSS = 80;
constexpr size_t WS_Y = WS_XG;
constexpr int S4_B = 0, S4_C = 128 * CST, S4_X = 2 * 128 * CST, S4_ARR = 3 * 128 * CST, S4_YX = S4_ARR + 8 * 2 * 128 * 4, S4_END = S4_YX + 4 * 16 * 64 * 4;
static_assert(S4_END <= RING_BYTES && S2_END <= RING_BYTES && 8 * 32 * XSS <= 128 * CST, "ssd LDS");
__device__ __forceinline__ void phase_ssd_out(const Prm& p, int l, LAS unsigned char* lds, int wg, int nwg, int tid) {
    const bf16* XA = (const bf16*)(p.ws + WS_XBC); const float* DT = (const float*)(p.ws + WS_DT); const bf16* HS = (const bf16*)(p.ws + WS_HS);
    bf16* Y = (bf16*)(p.ws + WS_Y);
    const int wid = __builtin_amdgcn_readfirstlane(tid >> 6), lane = tid & 63, hl = lane >> 5, l31 = lane & 31, pt = (wid >> 1) & 1, dir = wid >> 2;
    const int c_lo = (l == 0) ? 0 : 2, ncu = NCH - c_lo;
    for (int it = wg; it < 2 * ncu * 8; it += nwg) {
        const int b = it / (ncu * 8), rem = it % (ncu * 8), c = c_lo + (rem >> 3), g = (rem >> 2) & 1, hp = rem & 3, h = 8 * g + 2 * hp + (wid & 1);
        const int row0 = chunk_row0(b, c);
        { v4u tb[4], tc[4];
#pragma unroll
          for (int i = 0; i < 4; ++i) { const int id = tid + 512 * i, r = id >> 4, ch = id & 15; const bf16* src = XA + (size_t)(row0 + r) * XBCW + g * 128 + ch * 8; tb[i] = *(const v4u*)(src + 1024); tc[i] = *(const v4u*)(src + 1280); }
#pragma unroll
          for (int i = 0; i < 4; ++i) { const int id = tid + 512 * i, r = id >> 4, ch = id & 15; *(LAS v4u*)(lds + S4_B + r * CST + ch * 16) = tb[i]; *(LAS v4u*)(lds + S4_C + r * CST + ch * 16) = tc[i]; } }
        v4u tx[4];
#pragma unroll
        for (int i = 0; i < 4; ++i) { const int id = tid + 512 * i, r = id >> 4, ch = id & 15; tx[i] = *(const v4u*)(XA + (size_t)(row0 + r) * XBCW + (8 * g + 2 * hp) * 64 + ch * 8); }
        bf16x8 hs[8];
        { const bf16* hp_ = HS + ((size_t)((b * NCH + c) * 2 + dir) * 16 + h) * 8192 + (size_t)(pt * 32 + l31) * 128 + 8 * hl;
#pragma unroll
          for (int ks = 0; ks < 8; ++ks) hs[ks] = *(const bf16x8*)(hp_ + 16 * ks); }
        LAS float* QL = (LAS float*)(lds + S4_ARR) + wid * 256; LAS float* DL = QL + 128;
        float ebase;
        { const float a = -__expf(p.a_log[l * 32 + dir * 16 + h]);
          const float d0 = DT[(size_t)(row0 + lane) * 32 + dir * 16 + h], d1 = DT[(size_t)(row0 + 64 + lane) * 32 + dir * 16 + h];
          float q0 = a * d0, q1 = a * d1; scan128(q0, q1, lane); const float tot = lane63(q1);
          QL[lane] = dir == 0 ? q0 : a * d0 - q0; QL[64 + lane] = dir == 0 ? q1 : a * d1 - q1; DL[lane] = d0; DL[64 + lane] = d1; ebase = dir == 0 ? 0.f : tot; }
        __syncthreads();
#pragma unroll
        for (int j = 0; j < 2; ++j) { const int id = wid * 2 + j, st = id >> 2, tt = id & 3; f32x16 X = f32x16{};
#pragma unroll
            for (int ks = 0; ks < 8; ++ks) { const bf16x8 bfr = *(const LAS bf16x8*)(lds + S4_B + (st * 32 + l31) * CST + (16 * ks + 8 * hl) * 2), cfr = *(const LAS bf16x8*)(lds + S4_C + (tt * 32 + l31) * CST + (16 * ks + 8 * hl) * 2);
                X = __builtin_amdgcn_mfma_f32_32x32x16_bf16(bfr, cfr, X, 0, 0, 0); }
#pragma unroll
            for (int i = 0; i < 4; ++i) { v2u w; w.x = pk2(X[4 * i], X[4 * i + 1]); w.y = pk2(X[4 * i + 2], X[4 * i + 3]);
                *(LAS v2u*)(lds + S4_X + (tt * 32 + l31) * CST + (st * 32 + 8 * i + 4 * hl) * 2) = w; } }
        __syncthreads();
        bf16x8 xf[8];
        {
#pragma unroll
          for (int i = 0; i < 4; ++i) { const int id = tid + 512 * i, r = id >> 4, ch = id & 15; *(LAS v4u*)(lds + S4_B + r * CST + ch * 16) = tx[i]; }
          __syncthreads();
          const unsigned bXs = (unsigned)(uintptr_t)(lds + S4_B); const int c0 = (wid & 1) * 64 + pt * 32;
#pragma unroll
          for (int q = 0; q < 4; ++q) { Raw r0 = raw_tr_acc(bXs, CST, 32 * q, c0, lane), r1 = raw_tr_acc(bXs, CST, 32 * q + 16, c0, lane); raw_wait2(r0, r1); xf[2 * q] = join8(r0); xf[2 * q + 1] = join8(r1); }
        }
        const float dsum = p.d_skip[l * 32 + h] + p.d_skip[l * 32 + 16 + h];
        LAS float* YX = (LAS float*)(lds + S4_YX) + (wid & 3) * 1024;
#pragma unroll 1
        for (int tt = 0; tt < 4; ++tt) {
            const int tl = tt * 32 + l31;
            const float Qt = QL[tl];
            f32x16 yacc = f32x16{};
#pragma unroll
            for (int st = 0; st < 4; ++st) {
                if (dir == 0 ? (st > tt) : (st < tt)) continue;
                __builtin_amdgcn_sched_barrier(0);
                float mv[16];
#pragma unroll
                for (int i = 0; i < 4; ++i) { const v2u w = *(const LAS v2u*)(lds + S4_X + tl * CST + (st * 32 + 8 * i + 4 * hl) * 2);
                    const f32x4 qv = *(const LAS f32x4*)(QL + st * 32 + 8 * i + 4 * hl), dv = *(const LAS f32x4*)(DL + st * 32 + 8 * i + 4 * hl);
                    const float xv[4] = {bflo(w.x), bfhi(w.x), bflo(w.y), bfhi(w.y)};
#pragma unroll
                    for (int j = 0; j < 4; ++j) { const int s = st * 32 + 8 * i + 4 * hl + j; const bool ok = dir == 0 ? (s <= tl) : (s >= tl);
                        mv[4 * i + j] = ok ? __expf(Qt - qv[j]) * dv[j] * xv[j] : 0.f; } }
#pragma unroll
                for (int s2 = 0; s2 < 2; ++s2) { v4u q; q.x = cvtpk(mv[8 * s2 + 0], mv[8 * s2 + 1]); q.y = cvtpk(mv[8 * s2 + 2], mv[8 * s2 + 3]); q.z = cvtpk(mv[8 * s2 + 4], mv[8 * s2 + 5]); q.w = cvtpk(mv[8 * s2 + 6], mv[8 * s2 + 7]);
                    yacc = __builtin_amdgcn_mfma_f32_32x32x16_bf16(xf[2 * st + s2], *reinterpret_cast<bf16x8*>(&q), yacc, 0, 0, 0); }
            }
            __builtin_amdgcn_sched_barrier(0);
            { const LAS unsigned char* cfp = lds + S4_C + tl * CST + 16 * hl; f32x16 G = f32x16{};
#pragma unroll
              for (int ks = 0; ks < 8; ++ks) G = __builtin_amdgcn_mfma_f32_32x32x16_bf16(hs[ks], *(const LAS bf16x8*)(cfp + 32 * ks), G, 0, 0, 0);
              const float e = __expf(ebase + Qt);
#pragma unroll
              for (int r = 0; r < 16; ++r) yacc[r] += e * G[r]; }
            if (dir == 1) {
#pragma unroll
                for (int r = 0; r < 16; ++r) YX[r * 64 + lane] = yacc[r]; }
            __syncthreads();
            if (dir == 0) {
                const size_t trow = (size_t)(row0 + tl);
#pragma unroll
                for (int i = 0; i < 4; ++i) { const int pc = h * 64 + pt * 32 + 8 * i + 4 * hl; const v2u xw = *(const v2u*)(XA + trow * XBCW + pc);
                    f32x4 o; o[0] = yacc[4 * i] + YX[(4 * i) * 64 + lane] + dsum * bflo(xw.x); o[1] = yacc[4 * i + 1] + YX[(4 * i + 1) * 64 + lane] + dsum * bfhi(xw.x);
                    o[2] = yacc[4 * i + 2] + YX[(4 * i + 2) * 64 + lane] + dsum * bflo(xw.y); o[3] = yacc[4 * i + 3] + YX[(4 * i + 3) * 64 + lane] + dsum * bfhi(xw.y);
                    v2u w; w.x = pk2(o[0], o[1]); w.y = pk2(o[2], o[3]); *(v2u*)(Y + trow * 1024 + pc) = w; } }
            __syncthreads();
        }
    }
}
}
__device__ __forceinline__ void phase_norm2_router(const Prm& p, int l, LAS unsigned char* lds, int wg, int nwg, int tid, int wave, int lane) {
    bf16* H = (bf16*)(p.ws + WS_H); const bf16* WR = (const bf16*)(p.ws + WS_WRT);
    const int ntok = (l == 0) ? T_ALL : T_LAT;
    constexpr int HROW = 4096 + 16;
    LAS unsigned char* hfL = lds; LAS float* part = (LAS float*)(lds + 66048); LAS float* affL = (LAS float*)(lds + 66048 + 16384);
    int* tok_e = (int*)(p.ws + WS_TOK); int* tok_pos = (int*)(p.ws + WS_TOK + TOKTAB); float* tok_gate = (float*)(p.ws + WS_TOK + 2 * TOKTAB);
    unsigned* cnt = (unsigned*)(p.ws + OFF_CNT) + l * 32 * 16;
    for (int it = wg; it < ntok / 16; it += nwg) {
        const int m0 = it * 16;
#pragma unroll
        for (int rr = 0; rr < 2; ++rr) {
            const int r = wave * 2 + rr, m = m0 + r;
            f32x4 v[8]; load_row(p, 1, -1, m, lane, v);
            const float rstd = row_rstd(v);
            const int vs = m >= T_LAT ? 2 : (m >> 13);
            const float* md = (const float*)(p.ws + OFF_MOD) + (size_t)(l * 3 + vs) * MODW;
#pragma unroll
            for (int j = 0; j < 8; ++j) { const int col = 256 * j + 4 * lane; const f32x4 o = modulate4f(v[j], rstd, p.norm_ffn + l * DM, md + 4 * DM, md + 3 * DM, col);
                v2u w; w.x = pk2(o[0], o[1]); w.y = pk2(o[2], o[3]);
                *(unsigned*)((unsigned char*)H + (size_t)m * DM + col) = pack4f8(o[0], o[1], o[2], o[3]);
                *(LAS v2u*)(hfL + r * HROW + col * 2) = w; }
        }
        __syncthreads();
        {
            f32x4 a0 = {0.f, 0.f, 0.f, 0.f}, a1 = a0; const int fr = lane & 15, fq = lane >> 4;
#pragma unroll
            for (int ks = 0; ks < 8; ++ks) { const int k0 = wave * 256 + ks * 32 + 8 * fq;
                const bf16x8 af = *(const LAS bf16x8*)(hfL + fr * HROW + k0 * 2);
                const bf16x8 b0 = *(const bf16x8*)(WR + (size_t)fr * DM + k0), b1 = *(const bf16x8*)(WR + (size_t)(16 + fr) * DM + k0);
                a0 = __builtin_amdgcn_mfma_f32_16x16x32_bf16(af, b0, a0, 0, 0, 0); a1 = __builtin_amdgcn_mfma_f32_16x16x32_bf16(af, b1, a1, 0, 0, 0); }
#pragma unroll
            for (int i = 0; i < 4; ++i) { part[(wave * 16 + 4 * fq + i) * 32 + fr] = a0[i]; part[(wave * 16 + 4 * fq + i) * 32 + 16 + fr] = a1[i]; }
        }
        __syncthreads();
        { float s = 0.f;
#pragma unroll
          for (int w = 0; w < 8; ++w) s += part[w * 512 + tid];
          affL[tid] = sigmoid_f(s); }
        __syncthreads();
        if (tid < 16) {
            const LAS float* af = affL + tid * 32; const int m = m0 + tid;
            int bg = 0; float bs = -INFINITY;
#pragma unroll
            for (int g = 0; g < 4; ++g) { float t1 = -INFINITY, t2 = -INFINITY;
#pragma unroll
                for (int j = 0; j < 8; ++j) { const float s = af[8 * g + j] + p.router_bias[8 * g + j]; if (s > t1) { t2 = t1; t1 = s; } else if (s > t2) t2 = s; }
                const float gs = t1 + t2; if (gs > bs) { bs = gs; bg = g; } }
            float t1 = -INFINITY, t2 = -INFINITY; int i1 = 0, i2 = 0;
#pragma unroll
            for (int j = 0; j < 8; ++j) { const float s = af[8 * bg + j] + p.router_bias[8 * bg + j]; if (s > t1) { t2 = t1; i2 = i1; t1 = s; i1 = j; } else if (s > t2) { t2 = s; i2 = j; } }
            const int e0 = 8 * bg + i1, e1 = 8 * bg + i2; const float f0 = af[e0], f1 = af[e1], inv = 1.f / (f0 + f1);
            const unsigned p0 = atomicAdd(cnt + e0 * 16, 1u), p1 = atomicAdd(cnt + e1 * 16, 1u);
            int* list = (int*)(p.ws + WS_LIST); list[(size_t)e0 * LCAP + p0] = m; list[(size_t)e1 * LCAP + p1] = m;
            tok_e[2 * m] = e0; tok_e[2 * m + 1] = e1; tok_pos[2 * m] = (int)p0; tok_pos[2 * m + 1] = (int)p1; tok_gate[2 * m] = f0 * inv; tok_gate[2 * m + 1] = f1 * inv;
        }
        __syncthreads();
    }
}
__device__ __forceinline__ void build_seg_tables(const Prm& p, int l, LAS unsigned char* lds, int tid) {
    LAS int* seg = (LAS int*)(lds + L_SEG); LAS int* cntL = (LAS int*)(lds + L_CNT); LAS int* blke = (LAS int*)(lds + L_BLKE); LAS int* nblkp = (LAS int*)(lds + L_NBLK);
    LAS int* incl = (LAS int*)(lds + L_INCL);
    const unsigned* cnt = (const unsigned*)(p.ws + OFF_CNT) + l * 32 * 16;
    __syncthreads();
    LAS int* pbL = (LAS int*)(lds + L_PB);
    if (tid < 32) { const int c = (int)cnt[tid * 16]; cntL[tid] = c; pbL[tid] = (c + 255) >> 8; }
    __syncthreads();
    if (tid < 32) { int inc = 0;
#pragma unroll
        for (int k = 0; k < 32; ++k) inc += (k <= tid) ? pbL[k] : 0;
        seg[tid] = (inc - pbL[tid]) * 256; incl[tid] = inc; if (tid == 31) { seg[32] = inc * 256; *nblkp = inc; } }
    __syncthreads();
    if (tid < MAXBLK + 3) { int e = 0;
#pragma unroll
        for (int k = 0; k < 32; ++k) e += (incl[k] <= tid) ? 1 : 0;
        e = e < 31 ? e : 31; blke[tid] = e; ((LAS int*)(lds + L_BLKH))[tid] = (cntL[e] - 256 * (tid - (seg[e] >> 8)) <= 128) ? 1 : 0; }
    __syncthreads();
}
template <class Sched>
__device__ __forceinline__ void build_row_table(const Prm& p, const Sched& S, LAS unsigned char* lds, int tid) {
    const LAS int* seg = (const LAS int*)(lds + L_SEG); const LAS int* cntL = (const LAS int*)(lds + L_CNT); const LAS int* blke = (const LAS int*)(lds + L_BLKE);
    LAS unsigned* T = (LAS unsigned*)(lds + L_ROWT); const int* list = (const int*)(p.ws + WS_LIST);
#pragma unroll 1
    for (int i = 0; i < 8; ++i) { pg8::Unit u; if (!S.next(i, u)) break;
        const int e = blke[u.pm], base = (u.pm - (seg[e] >> 8)) * 256;
        if (tid < 256) { const int pos = base + tid; T[i * 256 + tid] = pos < cntL[e] ? (unsigned)WS_H + (unsigned)list[(size_t)e * LCAP + pos] * 2048u : ZERO_OFF; } }
    __syncthreads();
}
#ifndef SKIP_GU
#define SKIP_GU true
#endif
#ifndef SKIP_DN
#define SKIP_DN true
#endif
constexpr int N_PHASES = 24;
__global__ void __launch_bounds__(NWAVES * 64, 2) mk_fwd(Prm p) {
    extern __shared__ __attribute__((aligned(16))) unsigned char lds_raw[];
    LAS unsigned char* lds = (LAS unsigned char*)lds_raw;
    const int tid0 = threadIdx.x, wave = __builtin_amdgcn_readfirstlane(tid0 >> 6);
#define OPQ int tid = tid0; asm volatile("" : "+v"(tid)); const int lane = tid & 63;
    const int G = gridDim.x, bx = blockIdx.x, vcu = (G % 8 == 0) ? (bx % 8) * (G / 8) + bx / 8 : bx;
    const int gw = vcu * NWAVES + wave, ngw = G * NWAVES;
    unsigned char* ws = p.ws;
    for (int u = tid0; u < (LDS_BYTES - LDSCTL_OFF) / 4; u += NWAVES * 64) ((LAS unsigned*)(lds + LDSCTL_OFF))[u] = 0u;
    __syncthreads();
#if MK_ONE_LAUNCH
    XcdBarrier bar = xcd_barrier_post((unsigned*)ws + CW_BAR, (volatile LAS unsigned*)(lds + L_BARW));
#define GRID_BAR() xcd_barrier(bar)
#define GRID_BAR_W() do { if (CONV_QUEUE && l == 0) xcd_barrier_work(bar, p, lds, tid0); else xcd_barrier(bar); } while (0)
#else
#define GRID_BAR() do {} while (0)
#define GRID_BAR_W() do {} while (0)
#endif
    const int lo = p.ph_lo, hi = p.ph_hi;
#define IN(k) (lo <= (k) && (k) < hi)
#ifndef DUPMASK
#define DUPMASK 0
#endif
#define REPS(kind) for (int rep_ = 0; rep_ < (((DUPMASK) >> (kind)) & 1) + 1; ++rep_)
    if (IN(0)) REPS(0) { OPQ phase_prologue(p, lds, gw, ngw, wave, lane, rep_ == 0); GRID_BAR(); }
    for (int l = 0; l < 2; ++l) {
        const int pb = 1 + 11 * l;
        if (IN(pb + 0)) { OPQ if (l > 0) { if (CONV_QUEUE) queue_drain(p, lds, tid, (unsigned)Q_TOTAL); build_seg_tables(p, l - 1, lds, tid); row_stream<true, false, false>(p, l, l - 1, T_ALL, gw, ngw, tid, lane, lds, (const LAS int*)(lds + L_SEG)); } else row_stream<false, false, true>(p, l, 0, T_ALL, gw, ngw, tid, lane, lds, (const LAS int*)(lds + L_SEG)); GRID_BAR_W(); }
        if (IN(pb + 1)) REPS(2) {
            pg8::Gemm g{(const pg8::bf16_t*)(ws + WS_H), (const pg8::bf16_t*)(ws + WS_WIN + (size_t)l * NINP * DM * (F8_INPROJ ? 1 : 2)), T_ALL, NINP, F8_INPROJ ? DM / 2 : DM};
            pg8::StaticOrder S; S.init(T_ALL, NINP, G, bx);
            pg8::EpiInProj E{(pg8::bf16_t*)(ws + WS_U), NINP, (const float*)(ws + WS_ROPE), C_QB / 256, C_VB / 256, T_LAT, F8_INPROJ ? 1.f / W8_SCALE : 1.f};
            pg8::gemm_phase<pg8::EpiInProj, pg8::StaticOrder, true, true, F8_INPROJ != 0>(lds, g, S, E);
            GRID_BAR_W();
        }
        if (IN(pb + 2)) REPS(3) { OPQ phase_conv(p, l, gw, ngw, lane); att::phase_attn(p, l, lds, bx, G, tid); GRID_BAR_W(); }
        if (IN(pb + 3)) REPS(4) { OPQ ssd::phase_states(p, l, lds, bx, G, tid); GRID_BAR_W(); }
        if (IN(pb + 4)) REPS(5) { OPQ ssd::phase_scan(p, bx * (NWAVES * 64) + tid, G * NWAVES * 64); GRID_BAR_W(); }
        if (IN(pb + 5)) REPS(6) { OPQ ssd::phase_ssd_out(p, l, lds, bx, G, tid); GRID_BAR_W(); }
        if (IN(pb + 6)) REPS(7) { OPQ phase_gnorm(p, l, gw, ngw, lane); GRID_BAR_W(); }
        if (IN(pb + 7)) {
            const int M = (l == 0) ? T_ALL : T_LAT;
            pg8::Gemm g{(const pg8::bf16_t*)(ws + WS_H), (const pg8::bf16_t*)(ws + WS_WOUT + (size_t)l * DM * DM * (F8_OUTPROJ ? 1 : 2)), M, DM, F8_OUTPROJ ? DM / 2 : DM};
            pg8::StaticOrder S; S.init(M, DM, G, bx);
            pg8::EpiRes E{(l == 0) ? (const void*)p.x : (const void*)(ws + WS_X), (pg8::bf16_t*)(ws + WS_X), (l == 0) ? (const void*)p.ctx : (const void*)(ws + WS_XC), (pg8::bf16_t*)(ws + WS_XC),
                          (const float*)(ws + OFF_MOD) + (size_t)l * 3 * MODW + 2 * DM, DM, T_LAT, MODW, F8_OUTPROJ ? 1.f / (W8_SCALE * MIX_SCALE) : 1.f, l == 0 ? 1 : 0};
            pg8::gemm_phase<pg8::EpiRes, pg8::StaticOrder, true, true, F8_OUTPROJ != 0>(lds, g, S, E);
            GRID_BAR_W();
        }
        if (IN(pb + 8)) { OPQ phase_norm2_router(p, l, lds, bx, G, tid, wave, lane); GRID_BAR_W(); }
        if (IN(pb + 9)) REPS(11) {
            OPQ build_seg_tables(p, l, lds, tid);
            const int nblk = __builtin_amdgcn_readfirstlane(*(const LAS int*)(lds + L_NBLK));
            pg8::Gemm g{(const pg8::bf16_t*)ws, (const pg8::bf16_t*)(ws + WS_WGU + (size_t)l * 32 * 2048 * 2048), nblk * 256, 2048, DM / 2};
            pg8::GroupedOrderT<SKIP_GU, true> S{G, vcu, nblk, (const LAS int*)(lds + L_BLKE), (const LAS int*)(lds + L_BLKH), (long)2048 * 2048, (const LAS unsigned*)(lds + L_ROWT)};
            build_row_table(p, S, lds, tid);
            pg8::EpiGateUp E{ws + WS_ACT, DFF, 1.f / W8_SCALE};
            pg8::gemm_phase<pg8::EpiGateUp, pg8::GroupedOrderT<SKIP_GU, true>, true, true, true>(lds, g, S, E);
            GRID_BAR_W();
        }
        if (IN(pb + 10)) REPS(12) {
            OPQ build_seg_tables(p, l, lds, tid);
            const int nblk = __builtin_amdgcn_readfirstlane(*(const LAS int*)(lds + L_NBLK));
            pg8::Gemm g{(const pg8::bf16_t*)(ws + WS_ACT), (const pg8::bf16_t*)(ws + WS_WDN + (size_t)l * 32 * 2048 * 1024), nblk * 256, DM, DFF / 2};
            pg8::GroupedOrderT<SKIP_DN> S{G, vcu, nblk, (const LAS int*)(lds + L_BLKE), (const LAS int*)(lds + L_BLKH), (long)2048 * 1024, nullptr};
            pg8::EpiF8 E{ws + WS_YB, DM, Y8_SCALE / W8_SCALE};
            pg8::gemm_phase<pg8::EpiF8, pg8::GroupedOrderT<SKIP_DN>, true, true, true>(lds, g, S, E);
            GRID_BAR_W();
        }
    }
    if (IN(23)) { OPQ build_seg_tables(p, 1, lds, tid); row_stream<true, true, false>(p, 1, 1, T_LAT, gw, ngw, tid, lane, lds, (const LAS int*)(lds + L_SEG)); }
#undef IN
}

extern "C" void kernel_launch(void* const* d_in, const int* in_sizes, int n_in, void* d_out, int out_size, void* d_ws, size_t ws_size, hipStream_t stream) {
    static int grid = 0;
    if (grid == 0) {
        if (n_in != 24 || in_sizes[0] != T_LAT * DM || out_size != T_LAT * DM || ws_size < WS_END) {
            fprintf(stderr, "kernel_launch: unexpected shapes: n_in %d in0 %d out %d ws %zu (need %zu)\n", n_in, n_in > 0 ? in_sizes[0] : -1, out_size, ws_size, (size_t)WS_END); grid = -1; return; }
        int dev = 0, cus = 0, per_cu = 0;
        if (hipGetDevice(&dev) != hipSuccess || hipDeviceGetAttribute(&cus, hipDeviceAttributeMultiprocessorCount, dev) != hipSuccess) { grid = -1; return; }
        if (hipFuncSetAttribute((const void*)mk_fwd, hipFuncAttributeMaxDynamicSharedMemorySize, LDS_BYTES) != hipSuccess) { fprintf(stderr, "kernel_launch: hipFuncSetAttribute failed\n"); grid = -1; return; }
        if (hipOccupancyMaxActiveBlocksPerMultiprocessor(&per_cu, (const void*)mk_fwd, NWAVES * 64, LDS_BYTES) != hipSuccess || per_cu < 1) {
            fprintf(stderr, "kernel_launch: occupancy query reports %d blocks per CU\n", per_cu); }
        (void)hipGetLastError();
        grid = cus;
    }
    if (grid < 0) return;
    if (hipMemsetAsync((char*)d_ws + WS_CTL, 0, CTL_ZERO_BYTES, stream) != hipSuccess) { fprintf(stderr, "kernel_launch: memset failed\n"); return; }
    Prm p{};
    p.x = (const float*)d_in[0]; p.c = (const float*)d_in[1]; p.ctx = (const float*)d_in[2]; p.c_ctx = (const float*)d_in[3]; p.w_ada = (const float*)d_in[4]; p.b_ada = (const float*)d_in[5];
    p.norm_mix = (const float*)d_in[6]; p.norm_ffn = (const float*)d_in[7]; p.norm_final = (const float*)d_in[8]; p.w_in = (const float*)d_in[9]; p.w_out = (const float*)d_in[10];
    p.na_rpb = (const float*)d_in[11]; p.wa_sink = (const float*)d_in[12]; p.conv_w = (const float*)d_in[13]; p.conv_b = (const float*)d_in[14]; p.a_log = (const float*)d_in[15];
    p.dt_bias = (const float*)d_in[16]; p.d_skip = (const float*)d_in[17]; p.ssd_norm = (const float*)d_in[18]; p.w_router = (const float*)d_in[19]; p.router_bias = (const float*)d_in[20];
    p.w_gate = (const float*)d_in[21]; p.w_up = (const float*)d_in[22]; p.w_down = (const float*)d_in[23];
    p.out = (float*)d_out; p.ws = (unsigned char*)d_ws;
#if MK_ONE_LAUNCH
    p.ph_lo = 0; p.ph_hi = N_PHASES;
    hipLaunchKernelGGL(mk_fwd, dim3(grid), dim3(NWAVES * 64), LDS_BYTES, stream, p);
#else
    for (int ph = 0; ph < N_PHASES; ++ph) { p.ph_lo = ph; p.ph_hi = ph + 1; hipLaunchKernelGGL(mk_fwd, dim3(grid), dim3(NWAVES * 64), LDS_BYTES, stream, p); }
#endif
    const hipError_t le = hipPeekAtLastError();
    if (le != hipSuccess) fprintf(stderr, "kernel_launch: launch failed: %s\n", hipGetErrorName(le));
}
```

```cpp
#include <hip/hip_runtime.h>
#include <cstdio>
#include <cstdint>

#ifndef MK_ONE_LAUNCH
#define MK_ONE_LAUNCH 1
#endif

#ifndef F8_INPROJ
#define F8_INPROJ 1
#endif
#ifndef F8_OUTPROJ
#define F8_OUTPROJ 1
#endif

namespace pg8 {
#define PG8_LAS __attribute__((address_space(3)))
typedef unsigned short bf16_t;
typedef short bf16x8 __attribute__((ext_vector_type(8)));
typedef float f32x4 __attribute__((ext_vector_type(4)));
typedef unsigned u32x4 __attribute__((ext_vector_type(4)));
constexpr int BM = 256, BK = 64, HALF = 128, HTB = HALF * BK * 2  , STAGE_BYTES = 8 * HTB, NXCD = 8, WGM = 8;

__host__ __device__ __forceinline__ int lds_byte(int r, int c) { const int st = (r >> 4) * 2 + (c >> 5), rr = r & 15, cc = c & 31, ob = rr * 64 + cc * 2; return st * 1024 + (ob ^ (((ob >> 9) & 1) << 5)); }
__host__ __device__ __forceinline__ void stage_rc(int b, int& R, int& C) { const int st = b / 1024, sb = b % 1024, swz = sb ^ (((sb >> 9) & 1) << 5); R = (st >> 1) * 16 + swz / 64; C = (st & 1) * 32 + (swz % 64) / 2; }
__host__ __device__ __forceinline__ int perm32(int rho) { const int n = rho >> 4, i = rho & 15; return 8 * (i >> 2) + 4 * n + (i & 3); }

typedef int i32x4v __attribute__((ext_vector_type(4)));
typedef int i32x8v __attribute__((ext_vector_type(8)));
__device__ __forceinline__ i32x8v cat8(bf16x8 a, bf16x8 b) { const i32x4v x = __builtin_bit_cast(i32x4v, a), y = __builtin_bit_cast(i32x4v, b); return __builtin_shufflevector(x, y, 0, 1, 2, 3, 4, 5, 6, 7); }
struct Unit { int pm, pn; long boff; int lo_only; };
struct Gemm { const bf16_t* A; const bf16_t* Bt; int M, N, K; };

struct StaticOrder {
    static constexpr bool SKIP_HI = false, GATHER = false; const PG8_LAS unsigned* rowtab;
    int nM, nN, nwg, G, c;
    __host__ __device__ void init(int M, int N, int G_, int c_) { nM = M / BM; nN = N / BM; nwg = nM * nN; G = G_; c = c_; }
    __host__ __device__ bool next(int i, Unit& u) const {
        const long L = (long)i * G + c; if (L >= nwg) return false;
        int wgid = (int)L; { const int q = nwg / NXCD, r = nwg % NXCD, xcd = wgid % NXCD, off = wgid / NXCD; wgid = (xcd < r ? xcd * (q + 1) : r * (q + 1) + (xcd - r) * q) + off; }
        const int nig = WGM * nN, gid = wgid / nig, fm = gid * WGM, gsz = (nM - fm) < WGM ? (nM - fm) : WGM;
        u.pm = fm + ((wgid % nig) % gsz); u.pn = (wgid % nig) / gsz; u.boff = 0; u.lo_only = 0; return true;
    }
    __device__ __forceinline__ void a_ready(const Unit&) const {}
    __device__ __forceinline__ void done(const Unit&) const {}
};

__device__ __forceinline__ unsigned cvt_pk_bf16(float lo, float hi) { unsigned r; asm volatile("v_cvt_pk_bf16_f32 %0, %1, %2" : "=v"(r) : "v"(lo), "v"(hi)); return r; }
typedef float f32x2 __attribute__((ext_vector_type(2)));
__device__ __forceinline__ f32x2 gelu_pk(f32x2 v) {
    const f32x2 av = __builtin_elementwise_abs(v), d = av * 0.2316418882f + 1.0f;
    f32x2 t; t.x = __builtin_amdgcn_rcpf(d.x); t.y = __builtin_amdgcn_rcpf(d.y);
    f32x2 q = t * 0.5307027145f + (-0.7265760135f); q = q * t + 0.7107068705f; q = q * t + (-0.142248368f); q = q * t + 0.127414796f; q = q * t;
    const f32x2 s = (v * v) * (-0.72134752044f);
    f32x2 e; e.x = __builtin_amdgcn_exp2f(s.x); e.y = __builtin_amdgcn_exp2f(s.y);
    const f32x2 m = v * (q * e), r = v - m;
    f32x2 o; o.x = v.x < 0.f ? m.x : r.x; o.y = v.y < 0.f ? m.y : r.y; return o;
}

template <class Epi, class Sched, bool ALIGN_EPI = false, bool SP2 = false, bool F8 = false>
__device__ __forceinline__ void gemm_phase(PG8_LAS unsigned char* lds, const Gemm g, const Sched& S, const Epi& E) {
    int tid_o = threadIdx.x; asm volatile("" : "+v"(tid_o));
    const int tid = tid_o, wid = __builtin_amdgcn_readfirstlane(tid >> 6), lane = tid & 63, wr = wid >> 2, wc = wid & 3, fr = lane & 15, fq = lane >> 4;
    const int K = g.K, nt = K / BK;
    unsigned voffA[2], voffB[2];
#pragma unroll
    for (int i = 0; i < 2; ++i) { int R, C; stage_rc(tid * 16 + i * 8192, R, C); const int Rb = Epi::PERM ? ((R & ~31) + perm32(R & 31)) : R;
        voffA[i] = (unsigned)(R * K + C) * 2u; voffB[i] = (unsigned)(Rb * K + C) * 2u; }
    int gR[2]; unsigned gC[2];
#pragma unroll
    for (int i = 0; i < 2; ++i) { int R, C; stage_rc(tid * 16 + i * 8192, R, C); gR[i] = R; gC[i] = (unsigned)C * 2u; }
    unsigned gc[2][2] = {{0u, 0u}, {0u, 0u}}, gn[2][2] = {{0u, 0u}, {0u, 0u}};
#define PG8_GROWS(dst, u) do { if constexpr (Sched::GATHER) { _Pragma("unroll") for (int h_ = 0; h_ < 2; ++h_) _Pragma("unroll") for (int i_ = 0; i_ < 2; ++i_) dst[h_][i_] = S.rowtab[(u) * 256 + h_ * 128 + gR[i_]] + gC[i_]; } } while (0)
#define PG8_STAGE_A(bufoff, kbase, h, nx) do { if constexpr (Sched::GATHER) { _Pragma("unroll") for (int _i = 0; _i < 2; ++_i) \
        __builtin_amdgcn_global_load_lds((const unsigned*)((const char*)(kbase) + ((nx) ? gn[h][_i] : gc[h][_i])), (PG8_LAS unsigned*)(lds + (bufoff) + ldsw + _i * 8192), 16, 0, 0); } \
        else PG8_STAGE(bufoff, (kbase) + ((h) ? hstep : 0), voffA); } while (0)
    const size_t kstep = (size_t)(BK * 2);
    const size_t hstep = (size_t)HALF * K * 2;
    const size_t tstep = 2 * hstep;
    const unsigned ldsw = (unsigned)wid * 1024u;
    const int aoff = lds_byte(wr * 64 + fr, fq * 8), boff = lds_byte(wc * 32 + fr, fq * 8);
    const int aoff8 = lds_byte(wr * 64 + fr, (fq & 1) * 16) + (fq >> 1) * 1024, boff8 = lds_byte(wc * 32 + fr, (fq & 1) * 16) + (fq >> 1) * 1024;
#define PG8_SA(b, h) (((b) * 2 + (h)) * HTB)
#define PG8_SB(b, h) ((4 + (b) * 2 + (h)) * HTB)
#define PG8_STAGE(bufoff, gbase, voff) do { _Pragma("unroll") for (int _i = 0; _i < 2; ++_i) \
        __builtin_amdgcn_global_load_lds((const unsigned*)((const char*)(gbase) + (voff)[_i]), (PG8_LAS unsigned*)(lds + (bufoff) + ldsw + _i * 8192), 16, 0, 0); } while (0)
#define PG8_LDA(dst, b, h) do { if constexpr (F8) { _Pragma("unroll") for (int m = 0; m < 4; ++m) dst##8[m] = cat8(*(const PG8_LAS bf16x8*)(lds + PG8_SA(b, h) + aoff8 + m * 2048), *(const PG8_LAS bf16x8*)(lds + PG8_SA(b, h) + aoff8 + m * 2048 + 16)); } else { \
        _Pragma("unroll") for (int m = 0; m < 4; ++m) _Pragma("unroll") for (int k = 0; k < 2; ++k) dst[m][k] = *(const PG8_LAS bf16x8*)(lds + PG8_SA(b, h) + aoff + m * 2048 + k * 1024); } } while (0)
#define PG8_LDB(dst, b, h) do { if constexpr (F8) { _Pragma("unroll") for (int n = 0; n < 2; ++n) dst##8[n] = cat8(*(const PG8_LAS bf16x8*)(lds + PG8_SB(b, h) + boff8 + n * 2048), *(const PG8_LAS bf16x8*)(lds + PG8_SB(b, h) + boff8 + n * 2048 + 16)); } else { \
        _Pragma("unroll") for (int n = 0; n < 2; ++n) _Pragma("unroll") for (int k = 0; k < 2; ++k) dst[n][k] = *(const PG8_LAS bf16x8*)(lds + PG8_SB(b, h) + boff + n * 2048 + k * 1024); } } while (0)
#define PG8_MMA(ai, bj, At, Bt) do { __builtin_amdgcn_s_setprio(1); if constexpr (F8) { _Pragma("unroll") for (int m = 0; m < 4; ++m) _Pragma("unroll") for (int n = 0; n < 2; ++n) \
        asm volatile("v_mfma_scale_f32_16x16x128_f8f6f4 %0, %1, %2, %0, %3, %3 op_sel_hi:[0,0,0]" : "+v"(acc[ai][bj][m][n]) : "v"(Bt##8[n]), "v"(At##8[m]), "v"(sc1)); } else { \
        _Pragma("unroll") for (int m = 0; m < 4; ++m) _Pragma("unroll") for (int n = 0; n < 2; ++n) _Pragma("unroll") for (int k = 0; k < 2; ++k) \
        acc[ai][bj][m][n] = __builtin_amdgcn_mfma_f32_16x16x32_bf16(Bt[n][k], At[m][k], acc[ai][bj][m][n], 0, 0, 0); } __builtin_amdgcn_s_setprio(0); } while (0)
#define PG8_WAIT_V(n) asm volatile("s_waitcnt vmcnt(" #n ")" ::: "memory")
#define PG8_WAIT_L(n) asm volatile("s_waitcnt lgkmcnt(" #n ")" ::: "memory")
#define PG8_BAR __builtin_amdgcn_s_barrier()
#define PG8_SCHED __builtin_amdgcn_sched_barrier(0)
    Unit cur, nxt; int ui = 0;
    if (!S.next(0, cur)) return;
    f32x4 acc[2][2][4][2];
#pragma unroll
    for (int a = 0; a < 2; ++a)
#pragma unroll
        for (int b = 0; b < 2; ++b)
#pragma unroll
            for (int m = 0; m < 4; ++m)
#pragma unroll
                for (int n = 0; n < 2; ++n) acc[a][b][m][n] = (f32x4){0.f, 0.f, 0.f, 0.f};
    const int sc1 = 0x7F7F7F7F;
    bf16x8 At[4][2], B0[2][2], B1[2][2]; i32x8v At8[4], B08[2], B18[2];
    const char* cA = (const char*)g.A + (Sched::GATHER ? (size_t)0 : (size_t)cur.pm * tstep); PG8_GROWS(gc, 0); const char* cB = (const char*)g.Bt + (size_t)cur.pn * tstep + cur.boff;
    S.a_ready(cur);
    if constexpr (SP2) {
        PG8_STAGE(PG8_SB(0, 0), cB, voffB); PG8_STAGE(PG8_SB(0, 1), cB + hstep, voffB); PG8_STAGE_A(PG8_SA(0, 0), cA, 0, false); PG8_STAGE_A(PG8_SA(0, 1), cA, 1, false);
        if (wr == 1) PG8_BAR;
        PG8_WAIT_V(2); PG8_BAR;
        PG8_STAGE(PG8_SB(1, 0), cB + kstep, voffB); PG8_STAGE_A(PG8_SA(1, 0), cA + kstep, 0, false); PG8_STAGE(PG8_SB(1, 1), cB + hstep + kstep, voffB);
        PG8_WAIT_V(6); PG8_BAR;
    } else {
        PG8_STAGE(PG8_SB(0, 0), cB, voffB); PG8_STAGE_A(PG8_SA(0, 0), cA, 0, false); PG8_STAGE(PG8_SB(0, 1), cB + hstep, voffB); PG8_STAGE_A(PG8_SA(0, 1), cA, 1, false);
        if (wr == 1) PG8_BAR;
        PG8_WAIT_V(4); PG8_BAR;
        PG8_STAGE(PG8_SB(1, 0), cB + kstep, voffB); PG8_STAGE_A(PG8_SA(1, 0), cA + kstep, 0, false); PG8_STAGE(PG8_SB(1, 1), cB + hstep + kstep, voffB);
        PG8_WAIT_V(6); PG8_BAR;
    }
    for (;;) {
        const bool has_next = S.next(ui + 1, nxt);
        const char* nA = has_next ? (const char*)g.A + (Sched::GATHER ? (size_t)0 : (size_t)nxt.pm * tstep) : cA; if (has_next) PG8_GROWS(gn, ui + 1); const char* nB = has_next ? (const char*)g.Bt + (size_t)nxt.pn * tstep + nxt.boff : cB;
        const bool hi_on = !Sched::SKIP_HI || cur.lo_only == 0;
#pragma unroll 1
        for (int t = 0; t < nt; t += 2) {
            const bool last = (t == nt - 2);
            const char* a1 = cA + (size_t)(t + 1) * kstep;
            const char* a2 = last ? nA : cA + (size_t)(t + 2) * kstep; const char* b2 = last ? nB : cB + (size_t)(t + 2) * kstep;
            const char* a3 = a2 + kstep; const char* b3 = b2 + kstep;
            const bool nx_ = last && has_next;
            if (last && has_next) S.a_ready(nxt);
            if constexpr (SP2) {
            PG8_LDB(B0, 0, 0); PG8_LDB(B1, 0, 1); PG8_SCHED; PG8_LDA(At, 0, 0); PG8_STAGE_A(PG8_SA(1, 1), a1, 1, false);
            PG8_WAIT_V(8); PG8_WAIT_L(0); PG8_BAR; PG8_MMA(0, 0, At, B0); PG8_MMA(0, 1, At, B1); PG8_BAR; PG8_SCHED;
            PG8_LDA(At, 0, 1); PG8_STAGE(PG8_SB(0, 0), b2, voffB); PG8_STAGE(PG8_SB(0, 1), b2 + hstep, voffB); PG8_STAGE_A(PG8_SA(0, 0), a2, 0, nx_);
            PG8_WAIT_V(8); PG8_WAIT_L(0); PG8_BAR; if (__builtin_expect(hi_on, 1)) { PG8_MMA(1, 0, At, B0); PG8_MMA(1, 1, At, B1); } PG8_BAR; PG8_SCHED;
            PG8_LDB(B0, 1, 0); PG8_LDB(B1, 1, 1); PG8_SCHED; PG8_LDA(At, 1, 0); PG8_STAGE_A(PG8_SA(0, 1), a2, 1, nx_);
            PG8_WAIT_V(8); PG8_WAIT_L(0); PG8_BAR; PG8_MMA(0, 0, At, B0); PG8_MMA(0, 1, At, B1); PG8_BAR; PG8_SCHED;
            PG8_LDA(At, 1, 1); PG8_STAGE(PG8_SB(1, 0), b3, voffB); PG8_STAGE(PG8_SB(1, 1), b3 + hstep, voffB); PG8_STAGE_A(PG8_SA(1, 0), a3, 0, nx_);
            PG8_WAIT_V(8); PG8_WAIT_L(0); PG8_BAR; if (__builtin_expect(hi_on, 1)) { PG8_MMA(1, 0, At, B0); PG8_MMA(1, 1, At, B1); } PG8_BAR; PG8_SCHED;
            } else {
            PG8_LDB(B0, 0, 0); PG8_SCHED; PG8_LDA(At, 0, 0); PG8_STAGE_A(PG8_SA(1, 1), a1, 1, false);
            PG8_WAIT_L(8); PG8_BAR; PG8_WAIT_L(0); PG8_MMA(0, 0, At, B0); PG8_BAR; PG8_SCHED;
            PG8_LDB(B1, 0, 1); PG8_STAGE(PG8_SB(0, 0), b2, voffB);
            PG8_BAR; PG8_WAIT_L(0); PG8_MMA(0, 1, At, B1); PG8_BAR;
            PG8_LDA(At, 0, 1); PG8_STAGE_A(PG8_SA(0, 0), a2, 0, nx_);
            PG8_BAR; PG8_WAIT_L(0); PG8_MMA(1, 0, At, B0); PG8_BAR; PG8_SCHED;
            PG8_STAGE(PG8_SB(0, 1), b2 + hstep, voffB);
            PG8_WAIT_V(6); PG8_BAR; PG8_MMA(1, 1, At, B1); PG8_BAR;
            PG8_LDB(B0, 1, 0); PG8_SCHED; PG8_LDA(At, 1, 0); PG8_STAGE_A(PG8_SA(0, 1), a2, 1, nx_);
            PG8_WAIT_L(8); PG8_BAR; PG8_WAIT_L(0); PG8_MMA(0, 0, At, B0); PG8_BAR; PG8_SCHED;
            PG8_LDB(B1, 1, 1); PG8_STAGE(PG8_SB(1, 0), b3, voffB);
            PG8_BAR; PG8_WAIT_L(0); PG8_MMA(0, 1, At, B1); PG8_BAR;
            PG8_LDA(At, 1, 1); PG8_STAGE_A(PG8_SA(1, 0), a3, 0, nx_);
            PG8_BAR; PG8_WAIT_L(0); PG8_MMA(1, 0, At, B0); PG8_BAR; PG8_SCHED;
            PG8_STAGE(PG8_SB(1, 1), b3 + hstep, voffB);
            PG8_WAIT_V(6); PG8_BAR; PG8_MMA(1, 1, At, B1); PG8_BAR;
            }
        }
        if constexpr (F8) asm volatile("s_nop 15\n\ts_nop 15" ::: "memory");
        if constexpr (ALIGN_EPI) { if (wr == 0) PG8_BAR; }
        if constexpr (!Epi::AFTER_DRAIN) { E(acc, cur, wr, wc, fr, fq); S.done(cur); }
        if (!has_next) break;
#pragma unroll
        for (int a = 0; a < 2; ++a)
#pragma unroll
            for (int b = 0; b < 2; ++b)
#pragma unroll
                for (int m = 0; m < 4; ++m)
#pragma unroll
                    for (int n = 0; n < 2; ++n) acc[a][b][m][n] = (f32x4){0.f, 0.f, 0.f, 0.f};
        cur = nxt; cA = nA; cB = nB; ++ui;
        if constexpr (Sched::GATHER) { gc[0][0] = gn[0][0]; gc[0][1] = gn[0][1]; gc[1][0] = gn[1][0]; gc[1][1] = gn[1][1]; }
        if constexpr (ALIGN_EPI) { if (wr == 1) PG8_BAR; }
    }
    PG8_WAIT_V(0);
    if constexpr (!ALIGN_EPI) { if (wr == 0) PG8_BAR; }
    PG8_BAR;
    if constexpr (Epi::AFTER_DRAIN) { E.fused(acc, cur, wr, wc, fr, fq, lds, wid, lane); S.done(cur); }
#undef PG8_SA
#undef PG8_SB
#undef PG8_STAGE
#undef PG8_STAGE_A
#undef PG8_GROWS
#undef PG8_LDA
#undef PG8_LDB
#undef PG8_MMA
#undef PG8_WAIT_V
#undef PG8_WAIT_L
#undef PG8_BAR
#undef PG8_SCHED
}
typedef unsigned u32x2e __attribute__((ext_vector_type(2)));
struct EpiPlain {
    static constexpr bool PERM = true, AFTER_DRAIN = false;
    bf16_t* O; int ldc; float scale;
    __device__ __forceinline__ void operator()(const f32x4 (&acc)[2][2][4][2], const Unit& u, int wr, int wc, int fr, int fq) const {
        const int row0 = u.pm * BM + wr * 64 + fr, col0 = u.pn * BM + wc * 32 + 8 * fq;
        float one = scale; asm volatile("" : "+v"(one));
#pragma unroll
        for (int ai = 0; ai < 2; ++ai)
#pragma unroll
            for (int m = 0; m < 4; ++m) { bf16_t* rowp = O + (size_t)(row0 + ai * HALF + m * 16) * ldc + col0;
#pragma unroll
                for (int bj = 0; bj < 2; ++bj) { const f32x4 v0 = acc[ai][bj][m][0] * one, v1 = acc[ai][bj][m][1] * one;
                    u32x4 w; w.x = cvt_pk_bf16(v0[0], v0[1]); w.y = cvt_pk_bf16(v0[2], v0[3]); w.z = cvt_pk_bf16(v1[0], v1[1]); w.w = cvt_pk_bf16(v1[2], v1[3]);
                    *(u32x4*)(rowp + bj * HALF) = w; } }
    }
};
struct EpiF8 {
    static constexpr bool PERM = true, AFTER_DRAIN = false;
    unsigned char* O; int ldc; float scale;
    __device__ __forceinline__ void operator()(const f32x4 (&acc)[2][2][4][2], const Unit& u, int wr, int wc, int fr, int fq) const {
        const int row0 = u.pm * BM + wr * 64 + fr, col0 = u.pn * BM + wc * 32 + 8 * fq;
        float one = scale; asm volatile("" : "+v"(one));
#pragma unroll
        for (int ai = 0; ai < 2; ++ai)
#pragma unroll
            for (int m = 0; m < 4; ++m) { unsigned char* rowp = O + (size_t)(row0 + ai * HALF + m * 16) * ldc + col0;
#pragma unroll
                for (int bj = 0; bj < 2; ++bj) { const f32x4 v0 = acc[ai][bj][m][0] * one, v1 = acc[ai][bj][m][1] * one;
                    u32x2e w; { int t = __builtin_amdgcn_cvt_pk_fp8_f32(v0[0], v0[1], 0, false); t = __builtin_amdgcn_cvt_pk_fp8_f32(v0[2], v0[3], t, true); w.x = (unsigned)t; }
                    { int t = __builtin_amdgcn_cvt_pk_fp8_f32(v1[0], v1[1], 0, false); t = __builtin_amdgcn_cvt_pk_fp8_f32(v1[2], v1[3], t, true); w.y = (unsigned)t; }
                    *(u32x2e*)(rowp + bj * HALF) = w; } }
    }
};
struct EpiInProj {
    static constexpr bool PERM = true, AFTER_DRAIN = false;
    bf16_t* O; int ldc; const float* rope; int rope_lo, rope_hi, lat_rows; float scale;
    __device__ __forceinline__ void operator()(const f32x4 (&acc)[2][2][4][2], const Unit& u, int wr, int wc, int fr, int fq) const {
        const int row0 = u.pm * BM + wr * 64 + fr, col0 = u.pn * BM + wc * 32 + 8 * fq;
        const bool do_rope = (u.pn >= rope_lo) && (u.pn < rope_hi) && (u.pm * BM < lat_rows);
        const int i0 = 16 * (wc & 1) + 4 * fq, half = wc >> 1;
        float one = scale; asm volatile("" : "+v"(one));
#pragma unroll
        for (int ai = 0; ai < 2; ++ai)
#pragma unroll
            for (int m = 0; m < 4; ++m) { const int row = row0 + ai * HALF + m * 16; bf16_t* rowp = O + (size_t)row * ldc + col0;
                f32x4 cs0 = {1.f, 0.f, 1.f, 0.f}, cs1 = {1.f, 0.f, 1.f, 0.f};
                if (do_rope) { const int s = row & 8191, pos = half ? (s & 63) : (s >> 6); const f32x4* tp = (const f32x4*)(rope + (size_t)(pos * 32 + i0) * 2); cs0 = tp[0]; cs1 = tp[1]; }
#pragma unroll
                for (int bj = 0; bj < 2; ++bj) { f32x4 v0 = acc[ai][bj][m][0] * one, v1 = acc[ai][bj][m][1] * one;
                    if (do_rope) {
                        const f32x4 a = v0, b = v1;
                        v0[0] = a[0] * cs0[0] - a[1] * cs0[1]; v0[1] = a[1] * cs0[0] + a[0] * cs0[1];
                        v0[2] = a[2] * cs0[2] - a[3] * cs0[3]; v0[3] = a[3] * cs0[2] + a[2] * cs0[3];
                        v1[0] = b[0] * cs1[0] - b[1] * cs1[1]; v1[1] = b[1] * cs1[0] + b[0] * cs1[1];
                        v1[2] = b[2] * cs1[2] - b[3] * cs1[3]; v1[3] = b[3] * cs1[2] + b[2] * cs1[3];
                    }
                    u32x4 w; w.x = cvt_pk_bf16(v0[0], v0[1]); w.y = cvt_pk_bf16(v0[2], v0[3]); w.z = cvt_pk_bf16(v1[0], v1[1]); w.w = cvt_pk_bf16(v1[2], v1[3]);
                    *(u32x4*)(rowp + bj * HALF) = w; } }
    }
};
struct EpiRes {
    static constexpr bool PERM = true, AFTER_DRAIN = false;
    const void* xin; bf16_t* xout; const void* cin; bf16_t* cout; const float* gate;
    int ldc, lat_rows, gstride; float scale; int in_f32;
    __device__ __forceinline__ void operator()(const f32x4 (&acc)[2][2][4][2], const Unit& u, int wr, int wc, int fr, int fq) const {
        const int row0 = u.pm * BM + wr * 64 + fr, col0 = u.pn * BM + wc * 32 + 8 * fq;
        const bool isc = u.pm * BM >= lat_rows;
        const int vs = isc ? 2 : ((u.pm * BM) >> 13), rsub = isc ? lat_rows : 0;
        const void* bp = isc ? cin : xin; bf16_t* op = isc ? cout : xout;
        f32x4 gv[2][2];
#pragma unroll
        for (int bj = 0; bj < 2; ++bj)
#pragma unroll
            for (int n = 0; n < 2; ++n) { typedef int i32x4 __attribute__((ext_vector_type(4))); const i32x4 q = *(const i32x4*)(gate + (size_t)vs * gstride + col0 + bj * HALF + 4 * n);
                gv[bj][n] = (f32x4){(float)q[0], (float)q[1], (float)q[2], (float)q[3]} * (scale * (1.f / 16777216.f)); }
#pragma unroll
        for (int ai = 0; ai < 2; ++ai)
#pragma unroll
            for (int m = 0; m < 4; ++m) { const size_t off = (size_t)(row0 - rsub + ai * HALF + m * 16) * ldc + col0;
#pragma unroll
                for (int bj = 0; bj < 2; ++bj) { f32x4 b0, b1;
                    if (in_f32) { b0 = *(const f32x4*)((const float*)bp + off + bj * HALF); b1 = *(const f32x4*)((const float*)bp + off + bj * HALF + 4); }
                    else { const u32x4 w = *(const u32x4*)((const bf16_t*)bp + off + bj * HALF);
                        b0 = (f32x4){__builtin_bit_cast(float, w.x << 16), __builtin_bit_cast(float, w.x & 0xffff0000u), __builtin_bit_cast(float, w.y << 16), __builtin_bit_cast(float, w.y & 0xffff0000u)};
                        b1 = (f32x4){__builtin_bit_cast(float, w.z << 16), __builtin_bit_cast(float, w.z & 0xffff0000u), __builtin_bit_cast(float, w.w << 16), __builtin_bit_cast(float, w.w & 0xffff0000u)}; }
                    const f32x4 o0 = b0 + gv[bj][0] * acc[ai][bj][m][0], o1 = b1 + gv[bj][1] * acc[ai][bj][m][1];
                    u32x4 w; w.x = cvt_pk_bf16(o0[0], o0[1]); w.y = cvt_pk_bf16(o0[2], o0[3]); w.z = cvt_pk_bf16(o1[0], o1[1]); w.w = cvt_pk_bf16(o1[2], o1[3]);
                    *(u32x4*)(op + off + bj * HALF) = w; } }
    }
};
__device__ __forceinline__ unsigned pack4_fp8(float a, float b, float c, float d) { int w = __builtin_amdgcn_cvt_pk_fp8_f32(a, b, 0, false); w = __builtin_amdgcn_cvt_pk_fp8_f32(c, d, w, true); return (unsigned)w; }
struct EpiGateUp {
    static constexpr bool PERM = true, AFTER_DRAIN = false;
    unsigned char* O; int ldc; float wscale;
    __device__ __forceinline__ void operator()(const f32x4 (&acc)[2][2][4][2], const Unit& u, int wr, int wc, int fr, int fq) const {
        const int row0 = u.pm * BM + wr * 64 + fr, col0 = (u.pn * BM + wc * 32 + 8 * fq) >> 1;
        float ws = wscale; asm volatile("" : "+v"(ws));
#pragma unroll
        for (int ai = 0; ai < 2; ++ai)
#pragma unroll
            for (int m = 0; m < 4; ++m) { unsigned char* rowp = O + (size_t)(row0 + ai * HALF + m * 16) * ldc + col0;
#pragma unroll
                for (int bj = 0; bj < 2; ++bj) { const f32x4 g = acc[ai][bj][m][0] * ws, up = acc[ai][bj][m][1] * ws; f32x4 a;
#pragma unroll
                    for (int i = 0; i < 4; ++i) a[i] = g[i] * __builtin_amdgcn_rcpf(1.f + __expf(-g[i])) * up[i];
                    *(unsigned*)(rowp + bj * (HALF / 2)) = pack4_fp8(a[0], a[1], a[2], a[3]); } }
    }
};
template <bool SKIP, bool GATH = false> struct GroupedOrderT {
    static constexpr bool SKIP_HI = SKIP, GATHER = GATH;
    static constexpr int nN = 8;
    int G, c, nblk; const PG8_LAS int* blk_e; const PG8_LAS int* blk_h; long estride; const PG8_LAS unsigned* rowtab;
    __device__ __forceinline__ bool next(int i, Unit& u) const {
        const int L = i * G + c; if (L >= nblk * nN) return false;
        u.pm = L >> 3; u.pn = L & 7; u.boff = (long)__builtin_amdgcn_readfirstlane(blk_e[u.pm]) * estride; u.lo_only = __builtin_amdgcn_readfirstlane(blk_h[u.pm]); return true;
    }
    __device__ __forceinline__ void a_ready(const Unit&) const {}
    __device__ __forceinline__ void done(const Unit&) const {}
};
}
constexpr int DM = 2048, T_LAT = 16384, T_CTX = 512, T_ALL = 16896, SEQL = 8192, CTXL = 256;
constexpr int NIN = 5152, NINP = 5376;
constexpr int C_QA = 0, C_KA = 512, C_VA = 1024, C_QB = 1536, C_KB = 2048, C_VB = 2304, C_Z = 2560, C_XBC = 3584, C_DT = 5120;
constexpr int XBCW = 1536, DFF = 1024, NEXP = 32, MODW = 12288;
constexpr float EPS = 1e-6f, ATT_SCALE = 0.088388347648318440f;
constexpr int MAXBLK = 165, MAXSLOT = MAXBLK * 256;
constexpr int NWAVES = 8;

constexpr size_t MiB = 1u << 20;
constexpr size_t WS_CTL = 0, CTL_ZERO_BYTES = 2 * MiB;
constexpr int CW_BAR = 4096;
constexpr size_t OFF_Q = 32768;
constexpr size_t OFF_CNT = 65536;
constexpr size_t OFF_MOD = 1 * MiB;
constexpr size_t WS_ROPE = 2 * MiB;
constexpr size_t WS_WRT = 3 * MiB;
constexpr size_t WS_WIN = 8 * MiB;
constexpr size_t WS_WOUT = 50 * MiB;
constexpr size_t WS_WGU = 66 * MiB;
constexpr size_t WS_WDN = 578 * MiB;
constexpr size_t WS_H = 834 * MiB;
constexpr size_t WS_U = 900 * MiB;
constexpr size_t WS_X = 1074 * MiB;
constexpr size_t WS_XC = 1202 * MiB;
constexpr size_t WS_XBC = 1206 * MiB;
constexpr size_t WS_DT = 1256 * MiB;
constexpr size_t WS_YD = 1260 * MiB;
constexpr size_t WS_XG = 1392 * MiB;
constexpr size_t WS_ACT = 1557 * MiB;
constexpr size_t WS_YB = 1640 * MiB;
constexpr size_t WS_TOK = 1805 * MiB;
constexpr size_t WS_END = 1808 * MiB;
constexpr size_t WS_LIST = WS_XG + 64 * MiB;
constexpr int LCAP = 2 * T_ALL;
constexpr unsigned ZERO_OFF = 1536u * 1024u;
constexpr size_t TOKTAB = (size_t)T_ALL * 2 * 4;
static_assert(WS_WIN + (size_t)2 * NINP * DM * 2 <= WS_WOUT && WS_WGU + (size_t)2 * 32 * 2048 * 2048 * 2 <= WS_WDN && WS_WDN + (size_t)2 * 32 * 2048 * 1024 * 2 <= WS_H, "ws map 1");
static_assert(WS_H + (size_t)T_ALL * DM * 2 <= WS_U && WS_U + (size_t)T_ALL * NINP * 2 <= WS_X && WS_X + (size_t)T_LAT * DM * 4 <= WS_XC && WS_XBC + (size_t)T_ALL * XBCW * 2 <= WS_DT, "ws map 2");
static_assert(WS_DT + (size_t)T_ALL * 32 * 4 <= WS_YD && WS_YD + (size_t)2 * T_ALL * 1024 * 4 <= WS_XG && WS_XG + (size_t)MAXSLOT * DM * 2 <= WS_ACT && WS_ACT + (size_t)MAXSLOT * DFF * 2 <= WS_YB && WS_YB + (size_t)MAXSLOT * DM * 2 <= WS_TOK && WS_TOK + 4 * TOKTAB <= WS_END, "ws map 3");

constexpr int RING_BYTES = 131072, LDSCTL_OFF = RING_BYTES, LDS_BYTES = 147456;
constexpr int L_BARW = LDSCTL_OFF;
constexpr int L_BWORK = LDSCTL_OFF + 32;
constexpr int L_SEG = LDSCTL_OFF + 64;
constexpr int L_CNT = LDSCTL_OFF + 256;
constexpr int L_BLKE = LDSCTL_OFF + 512;
constexpr int L_NBLK = LDSCTL_OFF + 1536;
constexpr int L_INCL = LDSCTL_OFF + 1600;
constexpr int L_PB = LDSCTL_OFF + 1792;
constexpr int L_ROWT = LDSCTL_OFF + 4096;
constexpr int L_BLKH = LDSCTL_OFF + 2048;

#define GAS __attribute__((address_space(1)))
#define LAS __attribute__((address_space(3)))
typedef unsigned short bf16;
typedef unsigned v4u __attribute__((ext_vector_type(4)));
typedef unsigned v2u __attribute__((ext_vector_type(2)));
typedef float f32x4 __attribute__((ext_vector_type(4)));
typedef float f32x2 __attribute__((ext_vector_type(2)));
typedef short bf16x8 __attribute__((ext_vector_type(8)));
#define LDS_WAIT() asm volatile("s_waitcnt lgkmcnt(0)" ::: "memory")
#define VM_WAIT() asm volatile("s_waitcnt vmcnt(0)" ::: "memory")
__device__ __forceinline__ unsigned f2bf(float f) { unsigned u = __builtin_bit_cast(unsigned, f); return (u + 0x7fffu + ((u >> 16) & 1u)) >> 16; }
__device__ __forceinline__ unsigned pk2(float lo, float hi) { return f2bf(lo) | (f2bf(hi) << 16); }
__device__ __forceinline__ float bflo(unsigned w) { return __builtin_bit_cast(float, w << 16); }
__device__ __forceinline__ float bfhi(unsigned w) { return __builtin_bit_cast(float, w & 0xffff0000u); }
__device__ __forceinline__ float bf2f(bf16 b) { return __builtin_bit_cast(float, (unsigned)b << 16); }
__device__ __forceinline__ float wave_sum(float v) {
#pragma unroll
    for (int o = 1; o < 64; o <<= 1) v += __shfl_xor(v, o);
    return v;
}
__device__ __forceinline__ float wave_max(float v) {
#pragma unroll
    for (int o = 1; o < 64; o <<= 1) v = fmaxf(v, __shfl_xor(v, o));
    return v;
}
__device__ __forceinline__ float silu_f(float x) { return x / (1.f + __expf(-x)); }
__device__ __forceinline__ float sigmoid_f(float x) { return 1.f / (1.f + __expf(-x)); }
__device__ __forceinline__ float softplus_f(float x) { return x > 20.f ? x : log1pf(__expf(x)); }

#define XB_TMO      128
#define XB_XCNT(j)  (256  + 64 * (j))
#define XB_XSUB(j)  (1280 + 64 * (j))
#define XB_XGEN(j)  (2304 + 64 * (j))
#define XB_TOP      3328
#define XB_TOPGEN   3392
#define XCD_BAR_WORDS 3456
#define XB_SPIN_CAP (1u << 18)


__device__ __forceinline__ unsigned xb_ld(unsigned* p)              { return __hip_atomic_load(p, __ATOMIC_RELAXED, __HIP_MEMORY_SCOPE_AGENT); }
__device__ __forceinline__ unsigned xb_add(unsigned* p, unsigned v) { return __hip_atomic_fetch_add(p, v, __ATOMIC_RELAXED, __HIP_MEMORY_SCOPE_AGENT); }
__device__ __forceinline__ unsigned xb_xcc_id() { return (unsigned)__builtin_amdgcn_s_getreg((3 << 11) | 20) & 0xFu; }
#define XB_SPIN(cond, bar) do { unsigned _sp = 0; while (cond) { __builtin_amdgcn_s_sleep(1); \
    if ((++_sp & 255u) == 0u) { if (xb_ld(&(bar)[XB_TMO])) break; if (_sp > XB_SPIN_CAP) { atomicAdd(&(bar)[XB_TMO], 1u); break; } } } } while (0)

struct XcdBarrier {
    unsigned* bar; unsigned x;
    volatile LAS unsigned* st;
};

__device__ __forceinline__ XcdBarrier xcd_barrier_post(unsigned* bar, volatile LAS unsigned* st) {
    XcdBarrier b; b.bar = bar; b.x = xb_xcc_id(); b.st = st;
    if (threadIdx.x == 0) (void)xb_add(&bar[XB_XCNT(b.x)], 1u);
    return b;
}
__device__ __forceinline__ void xcd_barrier_complete(unsigned* bar, unsigned x, unsigned& nloc, unsigned& nx) {
    const unsigned G = gridDim.x * gridDim.y * gridDim.z;
    unsigned sum, cnt, mine, sp = 0u;
    for (;;) {
        sum = 0u; cnt = 0u; mine = 0u;
#pragma unroll
        for (unsigned j = 0; j < 16; ++j) { const unsigned c = xb_ld(&bar[XB_XCNT(j)]); sum += c; cnt += (c > 0u) ? 1u : 0u; mine = (j == x) ? c : mine; }
        if (sum == G) break;
        __builtin_amdgcn_s_sleep(1);
        if ((++sp & 255u) == 0u) { if (xb_ld(&bar[XB_TMO])) break; if (sp > XB_SPIN_CAP) { atomicAdd(&bar[XB_TMO], 1u); break; } }
    }
    nloc = mine > 0u ? mine : 1u; nx = cnt > 0u ? cnt : 1u;
}

__device__ __forceinline__ void xcd_barrier(const XcdBarrier& b) {
    asm volatile("s_waitcnt vmcnt(0)" ::: "memory");
    __syncthreads();
    if (threadIdx.x == 0) {
        unsigned* bar = b.bar;
        __builtin_amdgcn_s_waitcnt(0);
        unsigned nloc = b.st[0], nx = b.st[1];
        if (nloc == 0u) { xcd_barrier_complete(bar, b.x, nloc, nx); b.st[0] = nloc; b.st[1] = nx; }
        const unsigned old = xb_add(&bar[XB_XSUB(b.x)], 1u);
        const unsigned gen = old / nloc;
        if (old + 1u == (gen + 1u) * nloc) {
            __builtin_amdgcn_fence(__ATOMIC_RELEASE, "agent");
            asm volatile("s_waitcnt vmcnt(0)" ::: "memory");
            const unsigned og = xb_add(&bar[XB_TOP], 1u);
            const unsigned tg = og / nx;
            if (og + 1u == (tg + 1u) * nx) xb_add(&bar[XB_TOPGEN], 1u);
            else XB_SPIN(xb_ld(&bar[XB_TOPGEN]) == tg, bar);
            __builtin_amdgcn_fence(__ATOMIC_ACQUIRE, "agent");
            xb_add(&bar[XB_XGEN(b.x)], 1u);
            asm volatile("s_waitcnt vmcnt(0)" ::: "memory");
        } else {
            XB_SPIN(xb_ld(&bar[XB_XGEN(b.x)]) == gen, bar);
            __builtin_amdgcn_fence(__ATOMIC_ACQUIRE, "agent");
            asm volatile("s_waitcnt vmcnt(0)" ::: "memory");
        }
    }
    __syncthreads();
}
struct Prm {
    const float *x, *c, *ctx, *c_ctx, *w_ada, *b_ada, *norm_mix, *norm_ffn, *norm_final, *w_in, *w_out, *na_rpb, *wa_sink,
                *conv_w, *conv_b, *a_log, *dt_bias, *d_skip, *ssd_norm, *w_router, *router_bias, *w_gate, *w_up, *w_down;
    float* out; unsigned char* ws; int ph_lo, ph_hi;
};

__device__ __forceinline__ int perm_in(int n) {
    if (n >= C_QB && n < C_VB) { const int p = (n - C_QB) & 127, hb = n - p, half = p >> 6, pp = p & 63; return hb + half * 64 + (pp >> 1) + 32 * (pp & 1); }
    return n;
}
__device__ __forceinline__ unsigned pack4f8(float a, float b, float c, float d) { int w = __builtin_amdgcn_cvt_pk_fp8_f32(a, b, 0, false); w = __builtin_amdgcn_cvt_pk_fp8_f32(c, d, w, true); return (unsigned)w; }
#ifndef CONV_QUEUE
#define CONV_QUEUE 1
#endif
constexpr float W8_SCALE = 64.f, MIX_SCALE = 8.f, Y8_SCALE = 8.f;
struct TDesc { const float* colp; size_t ld; unsigned char* wt; int ok, k0, K, n0; };
constexpr int TK_IN = 2 * 32 * (NINP / 32), TK_OUT = 2 * 32 * 64, TK_GU = 2 * 32 * 32 * 64, TK_DN = 2 * 32 * 16 * 64, TK_RT = 32;
template <bool F8SEL> __device__ __forceinline__ constexpr int t_count() {
    return ((F8_INPROJ != 0) == F8SEL ? TK_IN : 0) + ((F8_OUTPROJ != 0) == F8SEL ? TK_OUT : 0) + (F8SEL ? TK_GU + TK_DN : TK_RT);
}
template <bool F8SEL> __device__ __forceinline__ TDesc t_decode(const Prm& p, int it, int lane) {
    unsigned char* ws = p.ws; TDesc d; int r = it;
    if ((F8_INPROJ != 0) == F8SEL) { if (r < TK_IN) { const int sub = r & 1, r2 = r >> 1, l = r2 / (TK_IN / 4), q = r2 % (TK_IN / 4), kb = 2 * (q / (NINP / 32)) + sub, nb = q % (NINP / 32), nn = 32 * nb + (lane & 31); const bool ok = nn < NIN;
            d.colp = p.w_in + (size_t)l * DM * NIN + (ok ? perm_in(nn) : 0); d.ld = NIN; d.ok = ok; d.K = 2048; d.wt = ws + WS_WIN + (size_t)l * NINP * DM * (F8_INPROJ ? 1 : 2); d.n0 = 32 * nb; d.k0 = 64 * kb; return d; } r -= TK_IN; }
    if ((F8_OUTPROJ != 0) == F8SEL) { if (r < TK_OUT) { const int sub = r & 1, r2 = r >> 1, l = r2 / (TK_OUT / 4), q = r2 % (TK_OUT / 4), kb = 2 * (q / 64) + sub, nb = q % 64, nn = 32 * nb + (lane & 31);
            d.colp = p.w_out + (size_t)l * DM * DM + nn; d.ld = DM; d.ok = 1; d.K = 2048; d.wt = ws + WS_WOUT + (size_t)l * DM * DM * (F8_OUTPROJ ? 1 : 2); d.n0 = 32 * nb; d.k0 = 64 * kb; return d; } r -= TK_OUT; }
    if (F8SEL) {
        if (r < TK_GU) { const int sub = r & 1, r2 = r >> 1, le = r2 / 1024, q = r2 % 1024, kb = 2 * (q / 64) + sub, nb = q % 64, nn = 32 * nb + (lane & 31), j = nn >> 3, t = nn & 7;
            d.colp = (t < 4 ? p.w_gate : p.w_up) + (size_t)le * 2048 * 1024 + 4 * j + (t & 3); d.ld = 1024; d.ok = 1; d.K = 2048; d.wt = ws + WS_WGU + (size_t)le * 2048 * 2048; d.n0 = 32 * nb; d.k0 = 64 * kb; return d; }
        r -= TK_GU;
        { const int sub = r & 1, r2 = r >> 1, le = r2 / 512, q = r2 % 512, kb = 2 * (q / 64) + sub, nb = q % 64, nn = 32 * nb + (lane & 31);
            d.colp = p.w_down + (size_t)le * 1024 * 2048 + nn; d.ld = 2048; d.ok = 1; d.K = 1024; d.wt = ws + WS_WDN + (size_t)le * 2048 * 1024; d.n0 = 32 * nb; d.k0 = 64 * kb; return d; }
    } else { const int kb = r; d.colp = p.w_router + (lane & 31); d.ld = 32; d.ok = 1; d.K = 2048; d.wt = ws + WS_WRT; d.n0 = 0; d.k0 = 64 * kb; return d; }
}
__device__ __forceinline__ void t_load(const TDesc& d, float (&tv)[32], int lane) {
#pragma unroll
    for (int i = 0; i < 32; ++i) tv[i] = d.colp[(size_t)(d.k0 + 2 * i + (lane >> 5)) * d.ld];
}
template <bool F8> __device__ __forceinline__ void t_lds_in(const TDesc& d, const float (&tv)[32], LAS float* scr, int lane) {
#pragma unroll
    for (int i = 0; i < 32; ++i) scr[(2 * i + (lane >> 5)) * 33 + (lane & 31)] = d.ok ? tv[i] : 0.f;
    LDS_WAIT(); asm volatile("" ::: "memory");
}
template <bool F8> __device__ __forceinline__ void t_out(const TDesc& d, LAS float* scr, int lane) {
    const int c = lane & 7;
#pragma unroll
    for (int j = 0; j < 4; ++j) { const int n = (lane >> 3) + 8 * j; const LAS float* s = scr + (8 * c) * 33 + n;
        if constexpr (F8) { v2u o; o.x = pack4f8(s[0 * 33] * W8_SCALE, s[1 * 33] * W8_SCALE, s[2 * 33] * W8_SCALE, s[3 * 33] * W8_SCALE); o.y = pack4f8(s[4 * 33] * W8_SCALE, s[5 * 33] * W8_SCALE, s[6 * 33] * W8_SCALE, s[7 * 33] * W8_SCALE);
            *(v2u*)(d.wt + (size_t)(d.n0 + n) * d.K + d.k0 + 8 * c) = o; }
        else { v4u o; o.x = pk2(s[0 * 33], s[1 * 33]); o.y = pk2(s[2 * 33], s[3 * 33]); o.z = pk2(s[4 * 33], s[5 * 33]); o.w = pk2(s[6 * 33], s[7 * 33]);
            *(v4u*)((bf16*)d.wt + (size_t)(d.n0 + n) * d.K + d.k0 + 8 * c) = o; } }
    LDS_WAIT(); asm volatile("" ::: "memory");
}
__device__ __forceinline__ void t_cvt8(LAS float* scr, int lane, v2u (&o)[4]) {
    const int c = lane & 7;
#pragma unroll
    for (int j = 0; j < 4; ++j) { const int n = (lane >> 3) + 8 * j; const LAS float* s = scr + (8 * c) * 33 + n;
        o[j].x = pack4f8(s[0 * 33] * W8_SCALE, s[1 * 33] * W8_SCALE, s[2 * 33] * W8_SCALE, s[3 * 33] * W8_SCALE); o[j].y = pack4f8(s[4 * 33] * W8_SCALE, s[5 * 33] * W8_SCALE, s[6 * 33] * W8_SCALE, s[7 * 33] * W8_SCALE); }
    LDS_WAIT(); asm volatile("" ::: "memory");
}
constexpr int TL_IN = 32 * (NINP / 32), TL_OUT = 32 * 64, TL_GU = 32 * 32 * 64, TL_DN = 32 * 16 * 64, TL_ALL = TL_IN + TL_OUT + TL_GU + TL_DN, NPL = TL_ALL / 2;
static_assert(F8_INPROJ && F8_OUTPROJ, "the per-layer conversion queue assumes fp8 copies of every GEMM weight");
__device__ __forceinline__ TDesc t_decode_layer(const Prm& p, int l, int it, int lane) {
    unsigned char* ws = p.ws; TDesc d; int r = it; const int sub = r & 1;
    if (r < TL_IN) { const int q = r >> 1, kb = 2 * (q / (NINP / 32)) + sub, nb = q % (NINP / 32), nn = 32 * nb + (lane & 31); const bool ok = nn < NIN;
        d.colp = p.w_in + (size_t)l * DM * NIN + (ok ? perm_in(nn) : 0); d.ld = NIN; d.ok = ok; d.K = 2048; d.wt = ws + WS_WIN + (size_t)l * NINP * DM; d.n0 = 32 * nb; d.k0 = 64 * kb; return d; }
    r -= TL_IN;
    if (r < TL_OUT) { const int q = r >> 1, kb = 2 * (q / 64) + sub, nb = q % 64, nn = 32 * nb + (lane & 31);
        d.colp = p.w_out + (size_t)l * DM * DM + nn; d.ld = DM; d.ok = 1; d.K = 2048; d.wt = ws + WS_WOUT + (size_t)l * DM * DM; d.n0 = 32 * nb; d.k0 = 64 * kb; return d; }
    r -= TL_OUT;
    if (r < TL_GU) { const int r2 = r >> 1, le = l * 32 + r2 / 1024, q = r2 % 1024, kb = 2 * (q / 64) + sub, nb = q % 64, nn = 32 * nb + (lane & 31), j = nn >> 3, t = nn & 7;
        d.colp = (t < 4 ? p.w_gate : p.w_up) + (size_t)le * 2048 * 1024 + 4 * j + (t & 3); d.ld = 1024; d.ok = 1; d.K = 2048; d.wt = ws + WS_WGU + (size_t)le * 2048 * 2048; d.n0 = 32 * nb; d.k0 = 64 * kb; return d; }
    r -= TL_GU;
    { const int r2 = r >> 1, le = l * 32 + r2 / 512, q = r2 % 512, kb = 2 * (q / 64) + sub, nb = q % 64, nn = 32 * nb + (lane & 31);
        d.colp = p.w_down + (size_t)le * 1024 * 2048 + nn; d.ld = 2048; d.ok = 1; d.K = 1024; d.wt = ws + WS_WDN + (size_t)le * 2048 * 1024; d.n0 = 32 * nb; d.k0 = 64 * kb; return d; }
}
__device__ __forceinline__ void t_pair_store(const TDesc& dS, const v2u (&oa)[4], const v2u (&ob)[4], int lane) {
    const int c = lane & 7, odd = c & 1;
#pragma unroll
    for (int j = 0; j < 4; ++j) { const int n = (lane >> 3) + 8 * j;
        const v2u snd = odd ? oa[j] : ob[j]; v2u got; got.x = (unsigned)__builtin_amdgcn_update_dpp(0, (int)snd.x, 0xB1, 0xF, 0xF, false); got.y = (unsigned)__builtin_amdgcn_update_dpp(0, (int)snd.y, 0xB1, 0xF, 0xF, false);
        v4u w; if (odd) { w.x = got.x; w.y = got.y; w.z = ob[j].x; w.w = ob[j].y; } else { w.x = oa[j].x; w.y = oa[j].y; w.z = got.x; w.w = got.y; }
        *(v4u*)(dS.wt + (size_t)(dS.n0 + n) * dS.K + dS.k0 + (odd ? 64 : 0) + 16 * (c >> 1)) = w; }
}
constexpr int NP_PROJ = (TL_IN + TL_OUT) / 2, NP_EXP = (TL_GU + TL_DN) / 2;
__device__ __forceinline__ void t_convert_pairs(const Prm& p, int l, int npairs, LAS float* scr, int gw, int ngw, int lane) {
    if (gw >= npairs) return;
    TDesc dA = t_decode_layer(p, l, 2 * gw, lane), dB = t_decode_layer(p, l, 2 * gw + 1, lane); float ta[32], tb[32]; t_load(dA, ta, lane); t_load(dB, tb, lane);
#pragma unroll 1
    for (int pi = gw; pi < npairs; pi += ngw) {
        v2u oa[4], ob[4];
        t_lds_in<true>(dA, ta, scr, lane); t_cvt8(scr, lane, oa);
        t_lds_in<true>(dB, tb, scr, lane);
        const TDesc dS = dA; const int pn = pi + ngw;
        if (pn < npairs) { dA = t_decode_layer(p, l, 2 * pn, lane); dB = t_decode_layer(p, l, 2 * pn + 1, lane); t_load(dA, ta, lane); t_load(dB, tb, lane); }
        t_cvt8(scr, lane, ob);
        t_pair_store(dS, oa, ob, lane);
    }
}
__device__ __forceinline__ void t_convert_one(const Prm& p, int l, int pi, LAS float* scr, int lane) {
    const TDesc dA = t_decode_layer(p, l, 2 * pi, lane), dB = t_decode_layer(p, l, 2 * pi + 1, lane); float ta[32], tb[32]; t_load(dA, ta, lane); t_load(dB, tb, lane);
    v2u oa[4], ob[4];
    t_lds_in<true>(dA, ta, scr, lane); t_cvt8(scr, lane, oa);
    t_lds_in<true>(dB, tb, scr, lane); t_cvt8(scr, lane, ob);
    t_pair_store(dA, oa, ob, lane);
}
template <bool F8SEL> __device__ __forceinline__ void t_convert_all(const Prm& p, LAS float* scr, int gw, int ngw, int lane) {
    constexpr int N = t_count<F8SEL>();
    if (2 * gw >= N) return;
    TDesc d0 = t_decode<F8SEL>(p, 2 * gw, lane); float tv[32]; t_load(d0, tv, lane);
#pragma unroll 1
    for (int it = 2 * gw; it < N; ) {
        t_lds_in<F8SEL>(d0, tv, scr, lane);
        const int itn = (it & 1) ? it - 1 + 2 * ngw : it + 1; TDesc d1 = d0;
        if (itn < N) { d1 = t_decode<F8SEL>(p, itn, lane); t_load(d1, tv, lane); }
        t_out<F8SEL>(d0, scr, lane);
        d0 = d1; it = itn;
    }
}
__device__ __forceinline__ void phase_prologue(const Prm& p, LAS unsigned char* lds, int gw, int ngw, int wave, int lane, bool first) {
    LAS float* scr = (LAS float*)(lds + wave * 16384);
    unsigned char* ws = p.ws;
    t_convert_pairs(p, 0, NPL, scr, gw, ngw, lane);
    if (!CONV_QUEUE) t_convert_pairs(p, 1, NPL, scr, gw, ngw, lane);
    t_convert_all<false>(p, scr, gw, ngw, lane);
    int* mod = (int*)(ws + OFF_MOD);
    for (int it = gw; first && it < 2 * 32 * 48; it += ngw) {
        const int l = it / (32 * 48), q = it % (32 * 48), kc = q / 48, nc = q % 48, k0 = 64 * kc, n0 = 256 * nc + 4 * lane;
        scr[lane] = silu_f(p.c[k0 + lane]); scr[64 + lane] = silu_f(p.c[DM + k0 + lane]); scr[128 + lane] = silu_f(p.c_ctx[k0 + lane]);
        LDS_WAIT(); asm volatile("" ::: "memory");
        f32x4 a0 = {0.f, 0.f, 0.f, 0.f}, a1 = a0, a2 = a0;
        const float* wp = p.w_ada + ((size_t)l * DM + k0) * MODW + n0;
#pragma unroll 8
        for (int kk = 0; kk < 64; ++kk) { const f32x4 w = *(const f32x4*)(wp + (size_t)kk * MODW); a0 += w * scr[kk]; a1 += w * scr[64 + kk]; a2 += w * scr[128 + kk]; }
        if (kc == 0) { const f32x4 bb = *(const f32x4*)(p.b_ada + (size_t)l * MODW + n0); a0 += bb; a1 += bb; a2 += bb; }
        int* m0 = mod + (size_t)(l * 3) * MODW + n0;
#pragma unroll
        for (int i = 0; i < 4; ++i) { atomicAdd(m0 + i, (int)rintf(a0[i] * 16777216.f)); atomicAdd(m0 + MODW + i, (int)rintf(a1[i] * 16777216.f)); atomicAdd(m0 + 2 * MODW + i, (int)rintf(a2[i] * 16777216.f)); }
        LDS_WAIT(); asm volatile("" ::: "memory");
    }
    for (int it = gw * 64 + lane; it < 128 * 32; it += ngw * 64) { const int pos = it >> 5, i = it & 31; const float inv = powf(10000.f, -(float)i / 32.f), ang = (float)pos * inv;
        ((float*)(ws + WS_ROPE))[2 * it] = cosf(ang); ((float*)(ws + WS_ROPE))[2 * it + 1] = sinf(ang); }
}

__device__ __forceinline__ f32x4 modv4(const float* p) {
    typedef int i32x4 __attribute__((ext_vector_type(4)));
    const i32x4 v = *(const i32x4*)p; return (f32x4){(float)v[0], (float)v[1], (float)v[2], (float)v[3]} * (1.f / 16777216.f);
}
__device__ __forceinline__ f32x4 bf4(v2u w) { return (f32x4){bflo(w.x), bfhi(w.x), bflo(w.y), bfhi(w.y)}; }
__device__ __forceinline__ void load_row(const Prm& p, int l, int lcomb, int m, int lane, f32x4 (&v)[8], bool wb = true, const LAS int* segL = nullptr) {
    const bool isc = m >= T_LAT;
    const bf16* wsrow = isc ? (const bf16*)(p.ws + WS_XC) + (size_t)(m - T_LAT) * DM : (const bf16*)(p.ws + WS_X) + (size_t)m * DM;
#pragma unroll
    for (int j = 0; j < 8; ++j) v[j] = bf4(*(const v2u*)(wsrow + 256 * j + 4 * lane));
}
__device__ __forceinline__ float row_rstd(const f32x4 (&v)[8]) {
    float s = 0.f;
#pragma unroll
    for (int j = 0; j < 8; ++j) s += (v[j][0] * v[j][0] + v[j][1] * v[j][1]) + (v[j][2] * v[j][2] + v[j][3] * v[j][3]);
    return rsqrtf(wave_sum(s) * (1.f / DM) + EPS);
}
__device__ __forceinline__ f32x4 modulate4f(const f32x4 v, float rstd, const float* gain, const float* sc, const float* sh, int col) {
    const f32x4 g = *(const f32x4*)(gain + col), s1 = modv4(sc + col), s0 = modv4(sh + col);
    return (v * rstd * g) * (s1 + 1.f) + s0;
}
__device__ __forceinline__ v2u modulate4(const f32x4 v, float rstd, const float* gain, const float* sc, const float* sh, int col) {
    const f32x4 g = *(const f32x4*)(gain + col), s1 = modv4(sc + col), s0 = modv4(sh + col);
    const f32x4 o = (v * rstd * g) * (s1 + 1.f) + s0;
    v2u w; w.x = pk2(o[0], o[1]); w.y = pk2(o[2], o[3]); return w;
}
constexpr int RS_A = 0, RS_SH = 3 * 8192, RS_GF = 6 * 8192, RS_END = 9 * 8192;
struct RowX { f32x4 x[8]; v2u xb[8]; unsigned ya[8], yb[8]; };
struct RowI { int s; float g; };
template <bool COMB> __device__ __forceinline__ RowI rs_idx_issue(const Prm& p, int m, int lane, int& e_out, int& pos_out) {
    RowI r; r.s = 0; r.g = 0.f; e_out = 0; pos_out = 0;
    if constexpr (COMB) { const int k = lane & 1; const int* te = (const int*)(p.ws + WS_TOK); const int* tp = (const int*)(p.ws + WS_TOK + TOKTAB); const float* tg = (const float*)(p.ws + WS_TOK + 2 * TOKTAB);
        e_out = te[2 * m + k]; pos_out = tp[2 * m + k]; r.g = tg[2 * m + k]; }
    return r;
}
template <bool COMB, bool SRC32> __device__ __forceinline__ void rs_issue(const Prm& p, int m, int s0, int s1, int lane, RowX& b) {
    const bool isc = m >= T_LAT;
    if constexpr (SRC32) { const float* src = isc ? p.ctx + (size_t)(m - T_LAT) * DM : p.x + (size_t)m * DM;
#pragma unroll
        for (int j = 0; j < 8; ++j) b.x[j] = *(const f32x4*)(src + 256 * j + 4 * lane); }
    else { const bf16* src = isc ? (const bf16*)(p.ws + WS_XC) + (size_t)(m - T_LAT) * DM : (const bf16*)(p.ws + WS_X) + (size_t)m * DM;
#pragma unroll
        for (int j = 0; j < 8; ++j) b.xb[j] = *(const v2u*)(src + 256 * j + 4 * lane); }
    if constexpr (COMB) { const unsigned char* y0 = p.ws + WS_YB + (size_t)s0 * DM; const unsigned char* y1 = p.ws + WS_YB + (size_t)s1 * DM;
#pragma unroll
        for (int j = 0; j < 8; ++j) { b.ya[j] = *(const unsigned*)(y0 + 256 * j + 4 * lane); b.yb[j] = *(const unsigned*)(y1 + 256 * j + 4 * lane); } }
}
template <bool COMB, bool FINAL, bool SRC32> __device__ __forceinline__ void rs_finish(const Prm& p, int l, int m, float g0, float g1, int lane, RowX& b, const LAS unsigned char* vl, bool live) {
    const bool isc = m >= T_LAT; const int vs = isc ? 2 : (m >> 13);
    const LAS float* A = (const LAS float*)(vl + RS_A) + vs * 2048; const LAS float* SH = (const LAS float*)(vl + RS_SH) + vs * 2048; const LAS float* GF = (const LAS float*)(vl + RS_GF) + vs * 2048;
    if constexpr (!SRC32) {
#pragma unroll
        for (int j = 0; j < 8; ++j) b.x[j] = bf4(b.xb[j]); }
    if constexpr (COMB) {
        bf16* wsrow = isc ? (bf16*)(p.ws + WS_XC) + (size_t)(m - T_LAT) * DM : (bf16*)(p.ws + WS_X) + (size_t)m * DM;
#pragma unroll
        for (int j = 0; j < 8; ++j) { const int col = 256 * j + 4 * lane; const unsigned a = b.ya[j], c = b.yb[j]; const f32x4 gq = *(const LAS f32x4*)(GF + col);
            const f32x2 a01 = __builtin_amdgcn_cvt_pk_f32_fp8(a, false), a23 = __builtin_amdgcn_cvt_pk_f32_fp8(a, true), c01 = __builtin_amdgcn_cvt_pk_f32_fp8(c, false), c23 = __builtin_amdgcn_cvt_pk_f32_fp8(c, true);
            b.x[j][0] += gq[0] * (g0 * a01[0] + g1 * c01[0]); b.x[j][1] += gq[1] * (g0 * a01[1] + g1 * c01[1]);
            b.x[j][2] += gq[2] * (g0 * a23[0] + g1 * c23[0]); b.x[j][3] += gq[3] * (g0 * a23[1] + g1 * c23[1]);
            if (!FINAL && live) { v2u w; w.x = pk2(b.x[j][0], b.x[j][1]); w.y = pk2(b.x[j][2], b.x[j][3]); *(v2u*)(wsrow + col) = w; } } }
    const float rstd = row_rstd(b.x);
    if (!live) return;
#pragma unroll
    for (int j = 0; j < 8; ++j) { const int col = 256 * j + 4 * lane; const f32x4 av = *(const LAS f32x4*)(A + col);
        if constexpr (FINAL) { *(f32x4*)(p.out + (size_t)m * DM + col) = b.x[j] * rstd * av; }
        else { const f32x4 o = b.x[j] * rstd * av + *(const LAS f32x4*)(SH + col);
            if (F8_INPROJ) *(unsigned*)(p.ws + WS_H + (size_t)m * DM + col) = pack4f8(o[0], o[1], o[2], o[3]);
            else { v2u w; w.x = pk2(o[0], o[1]); w.y = pk2(o[2], o[3]); *(v2u*)((bf16*)(p.ws + WS_H) + (size_t)m * DM + col) = w; } } }
}
template <bool COMB, bool FINAL, bool SRC32> __device__ __forceinline__ void row_stream(const Prm& p, int l, int lc, int nrows, int gw, int ngw, int tid, int lane, LAS unsigned char* vl, const LAS int* segL) {
    { const float* md = (const float*)(p.ws + OFF_MOD);
      for (int q = tid; q < 3 * 512; q += NWAVES * 64) { const int vs = q >> 9, c4 = (q & 511) * 4;
          if (FINAL) { if (vs == 0) *(LAS f32x4*)(vl + RS_A + (size_t)c4 * 4) = *(const f32x4*)(p.norm_final + c4); }
          else { const f32x4 gn = *(const f32x4*)(p.norm_mix + l * DM + c4), sc = modv4(md + (size_t)(l * 3 + vs) * MODW + DM + c4), sh = modv4(md + (size_t)(l * 3 + vs) * MODW + c4);
              *(LAS f32x4*)(vl + RS_A + ((size_t)vs * 2048 + c4) * 4) = gn * (sc + 1.f); *(LAS f32x4*)(vl + RS_SH + ((size_t)vs * 2048 + c4) * 4) = sh; }
          if (COMB) *(LAS f32x4*)(vl + RS_GF + ((size_t)vs * 2048 + c4) * 4) = modv4(md + (size_t)(lc * 3 + vs) * MODW + 5 * DM + c4) * (1.f / Y8_SCALE); }
      if (FINAL) { for (int q = tid; q < 2 * 512; q += NWAVES * 64) { const int c4 = (q & 511) * 4; *(LAS f32x4*)(vl + RS_A + ((size_t)(1 + (q >> 9)) * 2048 + c4) * 4) = *(const f32x4*)(p.norm_final + c4); } }
      __syncthreads(); }
    const int nit = gw < nrows ? (nrows - gw + ngw - 1) / ngw : 0;
    if (nit == 0) return;
    const int last = gw + (nit - 1) * ngw;
#define RS_ROW(i) min(gw + (i) * ngw, last)
    RowX bA, bB; int e0, p0, e1, p1; RowI i0 = rs_idx_issue<COMB>(p, RS_ROW(0), lane, e0, p0), i1 = rs_idx_issue<COMB>(p, RS_ROW(1), lane, e1, p1);
    { int s = COMB ? segL[e0] + p0 : 0; rs_issue<COMB, SRC32>(p, RS_ROW(0), __shfl(s, 0), __shfl(s, 1), lane, bA); }
#pragma unroll 1
    for (int i = 0; i < nit; i += 2) {
        int e2, p2, e3, p3;
        const RowI i2 = rs_idx_issue<COMB>(p, RS_ROW(i + 2), lane, e2, p2);
        { int s = COMB ? segL[e1] + p1 : 0; rs_issue<COMB, SRC32>(p, RS_ROW(i + 1), __shfl(s, 0), __shfl(s, 1), lane, bB); }
        rs_finish<COMB, FINAL, SRC32>(p, l, RS_ROW(i), __shfl(i0.g, 0), __shfl(i0.g, 1), lane, bA, vl, true);
        const RowI i3 = rs_idx_issue<COMB>(p, RS_ROW(i + 3), lane, e3, p3);
        { int s = COMB ? segL[e2] + p2 : 0; rs_issue<COMB, SRC32>(p, RS_ROW(i + 2), __shfl(s, 0), __shfl(s, 1), lane, bA); }
        rs_finish<COMB, FINAL, SRC32>(p, l, RS_ROW(i + 1), __shfl(i1.g, 0), __shfl(i1.g, 1), lane, bB, vl, i + 1 < nit);
        i0 = i2; i1 = i3; e1 = e3; p1 = p3;
    }
#undef RS_ROW
}
constexpr int Q_TOTAL = NPL;
__device__ __forceinline__ void queue_convert8(const Prm& p, unsigned base, LAS unsigned char* lds, int tid_in) {
    int tid = tid_in;
    asm volatile("" : "+v"(tid));
    const int wave = __builtin_amdgcn_readfirstlane(tid >> 6), lane = tid & 63; const unsigned pi = base + (unsigned)wave;
    if (pi < (unsigned)Q_TOTAL) t_convert_one(p, 1, (int)pi, (LAS float*)(lds + wave * 16384), lane);
}
__device__ __forceinline__ void xcd_barrier_work(const XcdBarrier& b, const Prm& p, LAS unsigned char* lds, int tid) {
    asm volatile("s_waitcnt vmcnt(0)" ::: "memory");
    __syncthreads();
    volatile LAS unsigned* bw = (volatile LAS unsigned*)(lds + L_BWORK);
    unsigned* bar = b.bar; unsigned* q = (unsigned*)(p.ws + OFF_Q);
    if (threadIdx.x == 0) {
        __builtin_amdgcn_s_waitcnt(0);
        unsigned nloc = b.st[0], nx = b.st[1];
        if (nloc == 0u) { xcd_barrier_complete(bar, b.x, nloc, nx); b.st[0] = nloc; b.st[1] = nx; }
        const unsigned old = xb_add(&bar[XB_XSUB(b.x)], 1u);
        const unsigned gen = old / nloc;
        if (old + 1u == (gen + 1u) * nloc) {
            __builtin_amdgcn_fence(__ATOMIC_RELEASE, "agent");
            asm volatile("s_waitcnt vmcnt(0)" ::: "memory");
            const unsigned og = xb_add(&bar[XB_TOP], 1u);
            const unsigned tg = og / nx;
            if (og + 1u == (tg + 1u) * nx) xb_add(&bar[XB_TOPGEN], 1u);
            else XB_SPIN(xb_ld(&bar[XB_TOPGEN]) == tg, bar);
            __builtin_amdgcn_fence(__ATOMIC_ACQUIRE, "agent");
            xb_add(&bar[XB_XGEN(b.x)], 1u);
            asm volatile("s_waitcnt vmcnt(0)" ::: "memory");
            bw[0] = 1u;
        } else { bw[0] = 0u; bw[2] = gen; }
    }
    __syncthreads();
    if (bw[0] == 0u) {
        unsigned sp = 0u;
        for (;;) {
            if (threadIdx.x == 0) {
                const unsigned gen = bw[2];
                bool rel = xb_ld(&bar[XB_XGEN(b.x)]) != gen;
                if (!rel && ((++sp & 63u) == 0u)) { if (xb_ld(&bar[XB_TMO])) rel = true; else if (sp > XB_SPIN_CAP) { atomicAdd(&bar[XB_TMO], 1u); rel = true; } }
                if (rel) { __builtin_amdgcn_fence(__ATOMIC_ACQUIRE, "agent"); asm volatile("s_waitcnt vmcnt(0)" ::: "memory"); bw[0] = 1u; }
                else { unsigned base = 0xffffffffu; if (xb_ld(q) < (unsigned)Q_TOTAL) { base = xb_add(q, 8u); if (base >= (unsigned)Q_TOTAL) base = 0xffffffffu; } bw[1] = base; }
            }
            __syncthreads();
            if (bw[0]) break;
            const unsigned base = bw[1];
            if (base != 0xffffffffu) queue_convert8(p, base, lds, tid); else __builtin_amdgcn_s_sleep(4);
            __syncthreads();
        }
    }
    __syncthreads();
}
__device__ __forceinline__ void queue_drain(const Prm& p, LAS unsigned char* lds, int tid, unsigned target) {
    volatile LAS unsigned* bw = (volatile LAS unsigned*)(lds + L_BWORK); unsigned* q = (unsigned*)(p.ws + OFF_Q);
    __syncthreads();
    for (;;) {
        if (threadIdx.x == 0) bw[1] = (xb_ld(q) < target) ? xb_add(q, 8u) : 0xffffffffu;
        __syncthreads();
        const unsigned base = bw[1];
        if (base >= target) break;
        queue_convert8(p, base, lds, tid);
        __syncthreads();
    }
    __syncthreads();
}
__device__ __forceinline__ void phase_conv(const Prm& p, int l, int gw, int ngw, int lane) {
    const bf16* U = (const bf16*)(p.ws + WS_U); bf16* XA = (bf16*)(p.ws + WS_XBC); float* DT = (float*)(p.ws + WS_DT);
    constexpr int NRUN = T_ALL / 16;
    for (int it = gw; it < NRUN * 3; it += ngw) {
        const int run = it / 3, cb = it % 3, t0 = run * 16, ch = cb * 512 + lane * 8;
        int seq0, seq1; if (t0 < T_LAT) { seq0 = t0 & ~(SEQL - 1); seq1 = seq0 + SEQL; } else { seq0 = T_LAT + ((t0 - T_LAT) & ~(CTXL - 1)); seq1 = seq0 + CTXL; }
        float w[5][8], bias[8];
#pragma unroll
        for (int j = 0; j < 5; ++j) { const f32x4 a = *(const f32x4*)(p.conv_w + ((size_t)l * 5 + j) * XBCW + ch), b = *(const f32x4*)(p.conv_w + ((size_t)l * 5 + j) * XBCW + ch + 4);
            w[j][0] = a[0]; w[j][1] = a[1]; w[j][2] = a[2]; w[j][3] = a[3]; w[j][4] = b[0]; w[j][5] = b[1]; w[j][6] = b[2]; w[j][7] = b[3]; }
        { const f32x4 a = *(const f32x4*)(p.conv_b + (size_t)l * XBCW + ch), b = *(const f32x4*)(p.conv_b + (size_t)l * XBCW + ch + 4);
            bias[0] = a[0]; bias[1] = a[1]; bias[2] = a[2]; bias[3] = a[3]; bias[4] = b[0]; bias[5] = b[1]; bias[6] = b[2]; bias[7] = b[3]; }
        v4u rows[20];
#pragma unroll
        for (int j = 0; j < 20; ++j) { const int t = t0 - 2 + j, tc = min(max(t, seq0), seq1 - 1); rows[j] = *(const v4u*)(U + (size_t)tc * NINP + C_XBC + ch); }
#pragma unroll
        for (int j = 0; j < 20; ++j) { const int t = t0 - 2 + j; if (t < seq0 || t >= seq1) rows[j] = (v4u){0u, 0u, 0u, 0u}; }
#pragma unroll
        for (int i = 0; i < 16; ++i) {
            const int t = t0 + i;
            float o[8];
#pragma unroll
            for (int c = 0; c < 8; ++c) o[c] = bias[c];
#pragma unroll
            for (int j = 0; j < 5; ++j) { const v4u wv = rows[i + j];
                o[0] += w[j][0] * bflo(wv.x); o[1] += w[j][1] * bfhi(wv.x); o[2] += w[j][2] * bflo(wv.y); o[3] += w[j][3] * bfhi(wv.y);
                o[4] += w[j][4] * bflo(wv.z); o[5] += w[j][5] * bfhi(wv.z); o[6] += w[j][6] * bflo(wv.w); o[7] += w[j][7] * bfhi(wv.w); }
            v4u r; r.x = pk2(silu_f(o[0]), silu_f(o[1])); r.y = pk2(silu_f(o[2]), silu_f(o[3])); r.z = pk2(silu_f(o[4]), silu_f(o[5])); r.w = pk2(silu_f(o[6]), silu_f(o[7]));
            *(v4u*)(XA + (size_t)t * XBCW + ch) = r;
        }
    }
    for (int it = gw * 64 + lane; it < T_ALL * 32; it += ngw * 64) { const int m = it >> 5, j = it & 31;
        DT[it] = softplus_f(bf2f(U[(size_t)m * NINP + C_DT + j]) + p.dt_bias[l * 32 + j]); }
}

__device__ __forceinline__ void naive_attn_item(const Prm& p, int l, int type, int m, int hh, LAS float* qs, LAS float* sc, int lane) {
    const bf16* U = (const bf16*)(p.ws + WS_U); bf16* MIX = (bf16*)(p.ws + WS_H);
    int qcol, kcol, vcol, ocol;
    if (type == 0 || type == 2) { qcol = C_QA + hh * 128; kcol = C_KA + hh * 128; vcol = C_VA + hh * 128; ocol = hh * 128; }
    else { const int kvh = hh >> 1; qcol = C_QB + hh * 128; kcol = C_KB + kvh * 128; vcol = C_VB + kvh * 128; ocol = 512 + hh * 128; }
    { const unsigned w = *(const unsigned*)(U + (size_t)m * NINP + qcol + 2 * lane); qs[2 * lane] = bflo(w); qs[2 * lane + 1] = bfhi(w); }
    int b, s = 0, qr = 0, qc = 0, krow0 = 0, kpos0 = 0;
    if (type < 2) { b = m >> 13; s = m & 8191; qr = s >> 6; qc = s & 63; } else { b = (m - T_LAT) >> 8; }
    const int nloc = type == 0 ? 512 : (type == 1 ? 384 : 0), nk = nloc + 256;
    if (type == 0) krow0 = min(max(qr - 4, 0), 120);
    if (type == 1) kpos0 = (s >> 7) * 128 - 128;
    const float* rpb = p.na_rpb + (size_t)(l * 4 + hh) * 15 * 31;
    LDS_WAIT(); __builtin_amdgcn_wave_barrier(); asm volatile("" ::: "memory");
    float mx = -INFINITY;
    for (int k0 = 0; k0 < nk; k0 += 64) {
        const int kidx = k0 + lane; int row; float bias = 0.f; bool valid = true;
        if (kidx < nloc) {
            if (type == 0) { const int kr = krow0 + (kidx >> 6), kc = kidx & 63; row = b * SEQL + kr * 64 + kc; const int c0 = min(max(qc - 8, 0), 48); valid = (kc >= c0) && (kc < c0 + 16);
                const int dr = kr - qr + 7, dc = min(max(kc - qc + 15, 0), 30); bias = rpb[dr * 31 + dc]; }
            else { const int kpos = kpos0 + kidx; valid = (kpos >= 0) && (kpos < SEQL) && (abs(s - kpos) <= 128); row = b * SEQL + min(max(kpos, 0), SEQL - 1); }
        } else row = T_LAT + b * CTXL + (kidx - nloc);
        const bf16* kp = U + (size_t)row * NINP + kcol; float d = 0.f;
#pragma unroll 4
        for (int c = 0; c < 16; ++c) { const v4u w = *(const v4u*)(kp + 8 * c); const LAS float* q = qs + 8 * c;
            d += bflo(w.x) * q[0] + bfhi(w.x) * q[1] + bflo(w.y) * q[2] + bfhi(w.y) * q[3] + bflo(w.z) * q[4] + bfhi(w.z) * q[5] + bflo(w.w) * q[6] + bfhi(w.w) * q[7]; }
        const float sv = valid ? d * ATT_SCALE + bias : -INFINITY;
        sc[kidx] = sv; mx = fmaxf(mx, sv);
    }
    mx = wave_max(mx);
    float sum = 0.f;
    for (int k0 = 0; k0 < nk; k0 += 64) { const float e = __expf(sc[k0 + lane] - mx); sc[k0 + lane] = e; sum += e; }
    sum = wave_sum(sum);
    if (type == 1 || type == 3) sum += __expf(p.wa_sink[l * 4 + hh] - mx);
    LDS_WAIT(); __builtin_amdgcn_wave_barrier(); asm volatile("" ::: "memory");
    float o0 = 0.f, o1 = 0.f;
    for (int kidx = 0; kidx < nk; ++kidx) {
        int row;
        if (kidx < nloc) { if (type == 0) row = b * SEQL + (krow0 + (kidx >> 6)) * 64 + (kidx & 63); else row = b * SEQL + min(max(kpos0 + kidx, 0), SEQL - 1); }
        else row = T_LAT + b * CTXL + (kidx - nloc);
        const float pv = sc[kidx]; const unsigned w = *(const unsigned*)(U + (size_t)row * NINP + vcol + 2 * lane);
        o0 += pv * bflo(w); o1 += pv * bfhi(w);
    }
    const float inv = 1.f / sum;
    *(unsigned*)(MIX + (size_t)m * DM + ocol + 2 * lane) = pk2(o0 * inv, o1 * inv);
    LDS_WAIT(); __builtin_amdgcn_wave_barrier(); asm volatile("" ::: "memory");
}
__device__ __forceinline__ void phase_attn_naive(const Prm& p, int l, LAS unsigned char* lds, int gw, int ngw, int wave, int lane) {
    LAS float* qs = (LAS float*)(lds + wave * 4096); LAS float* sc = qs + 128;
    const int nlat = T_LAT * 8, nctx = (l == 0) ? T_CTX * 8 : 0;
    for (int it = gw; it < nlat + nctx; it += ngw) {
        if (it < nlat) { const int m = it >> 3, h8 = it & 7; naive_attn_item(p, l, h8 >> 2, m, h8 & 3, qs, sc, lane); }
        else { const int r = it - nlat, m = T_LAT + (r >> 3), h8 = r & 7; naive_attn_item(p, l, 2 + (h8 >> 2), m, h8 & 3, qs, sc, lane); }
    }
}

__device__ __forceinline__ void phase_ssd_naive(const Prm& p, int l, int wg, int nwg, int tid) {
    const bf16* XA = (const bf16*)(p.ws + WS_XBC); const float* DT = (const float*)(p.ws + WS_DT); float* YD = (float*)(p.ws + WS_YD);
    for (int it = wg; it < 64; it += nwg) {
        const int b = it >> 5, dir = (it >> 4) & 1, h = it & 15, g = h >> 3;
        const int pp = tid >> 3, nq = tid & 7;
        const float a = -__expf(p.a_log[l * 32 + dir * 16 + h]), dsk = p.d_skip[l * 32 + dir * 16 + h];
        float hs[16];
#pragma unroll
        for (int i = 0; i < 16; ++i) hs[i] = 0.f;
#pragma unroll 4
        for (int st = 0; st < CTXL + SEQL; ++st) {
            int m; if (st < CTXL) m = T_LAT + b * CTXL + (dir ? CTXL - 1 - st : st); else { const int s = st - CTXL; m = b * SEQL + (dir ? SEQL - 1 - s : s); }
            const float dtv = DT[(size_t)m * 32 + dir * 16 + h];
            const bf16* row = XA + (size_t)m * XBCW;
            const float xv = bf2f(row[h * 64 + pp]);
            const v4u b0 = *(const v4u*)(row + 1024 + g * 128 + 16 * nq), b1 = *(const v4u*)(row + 1024 + g * 128 + 16 * nq + 8);
            const v4u c0 = *(const v4u*)(row + 1280 + g * 128 + 16 * nq), c1 = *(const v4u*)(row + 1280 + g * 128 + 16 * nq + 8);
            const float dA = __expf(a * dtv), dx = dtv * xv;
            float bv[16], cv[16];
            bv[0] = bflo(b0.x); bv[1] = bfhi(b0.x); bv[2] = bflo(b0.y); bv[3] = bfhi(b0.y); bv[4] = bflo(b0.z); bv[5] = bfhi(b0.z); bv[6] = bflo(b0.w); bv[7] = bfhi(b0.w);
            bv[8] = bflo(b1.x); bv[9] = bfhi(b1.x); bv[10] = bflo(b1.y); bv[11] = bfhi(b1.y); bv[12] = bflo(b1.z); bv[13] = bfhi(b1.z); bv[14] = bflo(b1.w); bv[15] = bfhi(b1.w);
            cv[0] = bflo(c0.x); cv[1] = bfhi(c0.x); cv[2] = bflo(c0.y); cv[3] = bfhi(c0.y); cv[4] = bflo(c0.z); cv[5] = bfhi(c0.z); cv[6] = bflo(c0.w); cv[7] = bfhi(c0.w);
            cv[8] = bflo(c1.x); cv[9] = bfhi(c1.x); cv[10] = bflo(c1.y); cv[11] = bfhi(c1.y); cv[12] = bflo(c1.z); cv[13] = bfhi(c1.z); cv[14] = bflo(c1.w); cv[15] = bfhi(c1.w);
            float part = 0.f;
#pragma unroll
            for (int i = 0; i < 16; ++i) { hs[i] = dA * hs[i] + dx * bv[i]; part += cv[i] * hs[i]; }
            part += __shfl_xor(part, 1); part += __shfl_xor(part, 2); part += __shfl_xor(part, 4);
            if (nq == 0) YD[((size_t)dir * T_ALL + m) * 1024 + h * 64 + pp] = part + dsk * xv;
        }
    }
}
__device__ __forceinline__ void phase_gnorm(const Prm& p, int l, int gw, int ngw, int lane) {
    const bf16* U = (const bf16*)(p.ws + WS_U); const bf16* YD = (const bf16*)(p.ws + WS_XG); bf16* MIX = (bf16*)(p.ws + WS_H);
    const int nrow = (l == 0) ? T_ALL : T_LAT;
    for (int m0 = gw; m0 < nrow; m0 += 2 * ngw) {
        const int m1 = (m0 + ngw < nrow) ? m0 + ngw : m0;
        v2u yv[2][4], zv[2][4];
#pragma unroll
        for (int q = 0; q < 2; ++q) { const int m = q ? m1 : m0;
#pragma unroll
            for (int j = 0; j < 4; ++j) { const int col = 256 * j + 4 * lane; yv[q][j] = *(const v2u*)(YD + (size_t)m * 1024 + col); zv[q][j] = *(const v2u*)(U + (size_t)m * NINP + C_Z + col); } }
#pragma unroll
        for (int q = 0; q < 2; ++q) { const int m = q ? m1 : m0;
            f32x4 u[4]; float ss[2] = {0.f, 0.f};
#pragma unroll
            for (int j = 0; j < 4; ++j) { const v2u yy = yv[q][j], zz = zv[q][j];
                u[j][0] = bflo(yy.x) * silu_f(bflo(zz.x)); u[j][1] = bfhi(yy.x) * silu_f(bfhi(zz.x)); u[j][2] = bflo(yy.y) * silu_f(bflo(zz.y)); u[j][3] = bfhi(yy.y) * silu_f(bfhi(zz.y));
                ss[j >> 1] += (u[j][0] * u[j][0] + u[j][1] * u[j][1]) + (u[j][2] * u[j][2] + u[j][3] * u[j][3]); }
            const float r0 = rsqrtf(wave_sum(ss[0]) * (1.f / 512.f) + EPS), r1 = rsqrtf(wave_sum(ss[1]) * (1.f / 512.f) + EPS);
            if (q == 1 && m1 == m0) continue;
#pragma unroll
            for (int j = 0; j < 4; ++j) { const int col = 256 * j + 4 * lane; const f32x4 g = *(const f32x4*)(p.ssd_norm + l * 1024 + col); const f32x4 o = u[j] * (j < 2 ? r0 : r1) * g;
                if (F8_OUTPROJ) *(unsigned*)((unsigned char*)MIX + (size_t)m * DM + 1024 + col) = pack4f8(o[0] * MIX_SCALE, o[1] * MIX_SCALE, o[2] * MIX_SCALE, o[3] * MIX_SCALE);
                else { v2u w; w.x = pk2(o[0], o[1]); w.y = pk2(o[2], o[3]); *(v2u*)(MIX + (size_t)m * DM + 1024 + col) = w; } }
        }
    }
}
namespace att {
typedef short s16x4 __attribute__((ext_vector_type(4)));
typedef float f32x16 __attribute__((ext_vector_type(16)));
constexpr int KVBLK = 64;
constexpr float THR = 8.f;
#ifndef ATT_SDEPTH
#define ATT_SDEPTH 1
#endif
constexpr int SDEPTH = ATT_SDEPTH;
constexpr int SHM_V = KVBLK * 128 * 2, SHM_K = KVBLK * 128 * 2;
constexpr int OFF_V = 0, OFF_K = 2 * SHM_V, OFF_WS = 2 * SHM_V + 2 * SHM_K, OFF_RPB = OFF_WS + 8 * 64 * 4, ATT_LDS = OFF_RPB + 576 * 4;
#define KSWZ(row, colB) ((row) * 256 + ((colB) ^ (((row) & 7) << 4)))
#define SBAR() __builtin_amdgcn_sched_barrier(0)
__device__ __forceinline__ int crow(int r, int hi) { return (r & 3) + 8 * (r >> 2) + 4 * hi; }
__device__ __forceinline__ unsigned cvtpk(float lo, float hi) { unsigned r; asm volatile("v_cvt_pk_bf16_f32 %0, %1, %2" : "=v"(r) : "v"(lo), "v"(hi)); return r; }
__device__ __forceinline__ void partialSM(f32x16& p0, f32x16& p1, float& m_reg, float& mn, float& alpha) {
  constexpr float C = ATT_SCALE * 1.4426950408889634f;
  float pmax = p0[0];
#pragma unroll
  for (int r = 1; r < 16; ++r) pmax = fmaxf(pmax, p0[r]);
#pragma unroll
  for (int r = 0; r < 16; ++r) pmax = fmaxf(pmax, p1[r]);
  { auto rr = __builtin_amdgcn_permlane32_swap(__float_as_uint(pmax), __float_as_uint(pmax), false, false);
    pmax = fmaxf(__uint_as_float(rr[0]), __uint_as_float(rr[1])); }
  if (__builtin_expect(__all(pmax - m_reg <= THR / ATT_SCALE), 1)) { mn = m_reg; alpha = 1.f; }
  else { mn = fmaxf(m_reg, pmax); alpha = __builtin_amdgcn_exp2f((m_reg - mn) * C); m_reg = mn; }
  float mnC = -mn * C;
#pragma unroll
  for (int r = 0; r < 16; ++r) p0[r] = fmaf(p0[r], C, mnC);
#pragma unroll
  for (int r = 0; r < 16; ++r) p1[r] = fmaf(p1[r], C, mnC);
#pragma unroll
  for (int r = 0; r < 16; ++r) p0[r] = __builtin_amdgcn_exp2f(p0[r]);
}
__device__ __forceinline__ void finishSM(f32x16& p0, f32x16& p1, float alpha, float& l_reg, bf16x8& pa0, bf16x8& pa1, bf16x8& pa2, bf16x8& pa3) {
#pragma unroll
  for (int r = 0; r < 16; ++r) p1[r] = __builtin_amdgcn_exp2f(p1[r]);
  float ps = 0;
#pragma unroll
  for (int r = 0; r < 16; ++r) ps += p0[r];
#pragma unroll
  for (int r = 0; r < 16; ++r) ps += p1[r];
  { auto rr = __builtin_amdgcn_permlane32_swap(__float_as_uint(ps), __float_as_uint(ps), false, false);
    ps = __uint_as_float(rr[0]) + __uint_as_float(rr[1]); }
  l_reg = l_reg * alpha + ps;
#define PK4(P, BASE, OUT) do { unsigned a0 = cvtpk(P[BASE + 0], P[BASE + 1]), a1 = cvtpk(P[BASE + 2], P[BASE + 3]);   \
    unsigned b0 = cvtpk(P[BASE + 4], P[BASE + 5]), b1 = cvtpk(P[BASE + 6], P[BASE + 7]);                              \
    auto r0 = __builtin_amdgcn_permlane32_swap(a0, b0, false, false); auto r1 = __builtin_amdgcn_permlane32_swap(a1, b1, false, false); \
    v4u w = {r0[0], r1[0], r0[1], r1[1]}; OUT = *reinterpret_cast<bf16x8*>(&w); } while (0)
  PK4(p0, 0, pa0); PK4(p0, 8, pa1); PK4(p1, 0, pa2); PK4(p1, 8, pa3);
#undef PK4
}
__device__ __forceinline__ void qkt(f32x16& p0, f32x16& p1, const LAS unsigned char* Ks, const bf16x8* qr, int r32, int hi) {
  p0 = f32x16{}; p1 = f32x16{};
#pragma unroll
  for (int d0 = 0; d0 < 8; ++d0) { int cb = (d0 * 16 + hi * 8) * 2;
    bf16x8 b0 = *reinterpret_cast<const LAS bf16x8*>(Ks + KSWZ(r32, cb));
    bf16x8 b1 = *reinterpret_cast<const LAS bf16x8*>(Ks + KSWZ(32 + r32, cb));
    p0 = __builtin_amdgcn_mfma_f32_32x32x16_bf16(b0, qr[d0], p0, 0, 0, 0);
    p1 = __builtin_amdgcn_mfma_f32_32x32x16_bf16(b1, qr[d0], p1, 0, 0, 0); }
}
__device__ __forceinline__ int v_st(int k, int c) { const int kk = (k & ~0xC) | ((k & 4) << 1) | ((k & 8) >> 1); return ((kk >> 3) * 4 + (c >> 5)) * 512 + ((kk & 7) * 32 + (c & 31)) * 2; }
__device__ __forceinline__ int v_rd_base(int lane) { return ((lane & 3) << 3) | (((lane >> 2) & 3) << 6) | (((lane >> 4) & 1) << 5) | (((lane >> 5) & 1) << 8); }
constexpr int v_rd_off(int d0, int ks, int half) { return d0 * 512 + ks * 4096 + half * 2048; }
template <int OFF> __device__ __forceinline__ s16x4 tr_read(int vb) {
  s16x4 r; asm volatile("ds_read_b64_tr_b16 %0, %1 offset:%2" : "=&v"(r) : "v"(vb), "i"(OFF) : "memory"); return r;
}
template <int D0> __device__ __forceinline__ void pv_one(f32x16& od, int vb, bf16x8 pa0, bf16x8 pa1, bf16x8 pa2, bf16x8 pa3) {
  const s16x4 l0 = tr_read<v_rd_off(D0, 0, 0)>(vb), h0 = tr_read<v_rd_off(D0, 0, 1)>(vb), l1 = tr_read<v_rd_off(D0, 1, 0)>(vb), h1 = tr_read<v_rd_off(D0, 1, 1)>(vb);
  const s16x4 l2 = tr_read<v_rd_off(D0, 2, 0)>(vb), h2 = tr_read<v_rd_off(D0, 2, 1)>(vb), l3 = tr_read<v_rd_off(D0, 3, 0)>(vb), h3 = tr_read<v_rd_off(D0, 3, 1)>(vb);
  asm volatile("s_waitcnt lgkmcnt(0)" ::: "memory"); SBAR();
#define PK(L, H) (bf16x8){L[0], L[1], L[2], L[3], H[0], H[1], H[2], H[3]}
  od = __builtin_amdgcn_mfma_f32_32x32x16_bf16(pa0, PK(l0, h0), od, 0, 0, 0);
  od = __builtin_amdgcn_mfma_f32_32x32x16_bf16(pa1, PK(l1, h1), od, 0, 0, 0);
  od = __builtin_amdgcn_mfma_f32_32x32x16_bf16(pa2, PK(l2, h2), od, 0, 0, 0);
  od = __builtin_amdgcn_mfma_f32_32x32x16_bf16(pa3, PK(l3, h3), od, 0, 0, 0);
#undef PK
}
__device__ __forceinline__ void pv_d0(f32x16* o, int vb, bf16x8 pa0, bf16x8 pa1, bf16x8 pa2, bf16x8 pa3) {
  pv_one<0>(o[0], vb, pa0, pa1, pa2, pa3); pv_one<1>(o[1], vb, pa0, pa1, pa2, pa3); pv_one<2>(o[2], vb, pa0, pa1, pa2, pa3); pv_one<3>(o[3], vb, pa0, pa1, pa2, pa3);
}
struct UnitD { int type, b, hh, q0  , nloc  , kbase  ; };
__device__ __forceinline__ int tile_row(const UnitD& u, int j) {
    if (j >= u.nloc) return T_LAT + u.b * CTXL + (j - u.nloc) * 64;
    if (u.type == 0) return u.b * SEQL + (u.kbase + j) * 64;
    const int kp = u.kbase + j * 64; return u.b * SEQL + min(max(kp, 0), SEQL - 64);
}
__device__ __forceinline__ bool tile_active(const UnitD& u, int j, int wid) {
    if (j >= u.nloc) return true;
    if (u.type == 0) { const int qr = (u.q0 >> 6) + (wid >> 1), kr = u.kbase + j, start = min(max(qr - 4, 0), 120); return kr >= start && kr < start + 8; }
    const int qw = u.q0 + 32 * wid, kp0 = u.kbase + j * 64;
    return (kp0 >= 0) && (kp0 < SEQL) && (kp0 - (qw + 31) <= 128) && (qw - (kp0 + 63) <= 128);
}
__device__ __forceinline__ void apply_mask(f32x16& p0, f32x16& p1, const UnitD& u, int j, int wid, int r32, int hi, const LAS float* rpbL) {
    if (j >= u.nloc) return;
    if (u.type == 0) {
        const int qr = (u.q0 >> 6) + (wid >> 1), qc = (wid & 1) * 32 + r32, kr = u.kbase + j;
        const int c0 = min(max(qc - 8, 0), 48), cb = 4 * hi - c0;
        const LAS float* rp = rpbL + (kr - qr + 7) * 31 + 4 * hi - qc + 15 + 32;
#pragma unroll
        for (int r = 0; r < 16; ++r) {
            const int k0 = (r & 3) + 8 * (r >> 2);
            p0[r] = ((unsigned)(k0 + cb) < 16u) ? p0[r] + rp[k0] : -INFINITY;
            p1[r] = ((unsigned)(k0 + 32 + cb) < 16u) ? p1[r] + rp[k0 + 32] : -INFINITY;
            if ((r & 3) == 3) SBAR(); }
    } else {
        const int qw = u.q0 + 32 * wid, kp0 = u.kbase + j * 64;
        if ((kp0 + 63 - qw <= 128) && (qw + 31 - kp0 <= 128)) return;
        const int cb = kp0 + 4 * hi - (qw + r32) + 128;
#pragma unroll
        for (int r = 0; r < 16; ++r) {
            const int k0 = (r & 3) + 8 * (r >> 2);
            p0[r] = ((unsigned)(k0 + cb) <= 256u) ? p0[r] : -INFINITY;
            p1[r] = ((unsigned)(k0 + 32 + cb) <= 256u) ? p1[r] : -INFINITY; }
    }
}
__device__ __forceinline__ void fill_ninf(f32x16& p0, f32x16& p1) {
#pragma unroll
    for (int r = 0; r < 16; ++r) { p0[r] = -INFINITY; p1[r] = -INFINITY; }
}
__device__ __forceinline__ void attn_unit(const Prm& p, int l, const UnitD u, LAS unsigned char* lds, int tid) {
  const bf16* U = (const bf16*)(p.ws + WS_U); bf16* MIX = (bf16*)(p.ws + WS_H);
  const int wid = __builtin_amdgcn_readfirstlane(tid >> 6), lane = tid & 63, r32 = lane & 31, hi = lane >> 5;
  int qcol, kcol, vcol, ocol;
  if (u.type == 0 || u.type == 2) { qcol = C_QA + u.hh * 128; kcol = C_KA + u.hh * 128; vcol = C_VA + u.hh * 128; ocol = u.hh * 128; }
  else { const int kvh = u.hh >> 1; qcol = C_QB + u.hh * 128; kcol = C_KB + kvh * 128; vcol = C_VB + kvh * 128; ocol = 512 + u.hh * 128; }
  const int qrow0 = (u.type < 2 ? u.b * SEQL : T_LAT + u.b * CTXL) + u.q0;
  LAS unsigned char* V_lds = lds + OFF_V; LAS unsigned char* K_lds = lds + OFF_K;
  LAS float* wsl = (LAS float*)(lds + OFF_WS) + wid * 64; LAS float* li_l = wsl; LAS float* al_l = wsl + 32;
  LAS float* rpbL = (LAS float*)(lds + OFF_RPB);
  if (u.type == 0 && tid < 465) rpbL[32 + tid] = p.na_rpb[(size_t)(l * 4 + u.hh) * 465 + tid] * (1.f / ATT_SCALE);
  float m_reg = -1e30f, l_reg = 0; f32x16 o[4] = {}; bf16x8 qr[8];
  const bf16* Qw = U + (size_t)(qrow0 + wid * 32 + r32) * NINP + qcol + hi * 8;
#pragma unroll
  for (int d0 = 0; d0 < 8; ++d0) qr[d0] = *reinterpret_cast<const bf16x8*>(Qw + d0 * 16);
  const int sr = tid >> 4, sc = (tid & 15) * 8, vst0 = v_st(sr, sc), vst1 = v_st(32 + sr, sc);
  const int vb0 = (int)(uintptr_t)V_lds + v_rd_base(lane);
  struct { bf16x8 vs0, vs1, ks0, ks1; } sr_[SDEPTH];
#define SLOAD(i, jt) do { const bf16* rb_ = U + (size_t)(tile_row(u, (jt)) + sr) * NINP + sc; \
    sr_[i].vs0 = *reinterpret_cast<const bf16x8*>(rb_ + vcol); sr_[i].vs1 = *reinterpret_cast<const bf16x8*>(rb_ + (size_t)32 * NINP + vcol); \
    sr_[i].ks0 = *reinterpret_cast<const bf16x8*>(rb_ + kcol); sr_[i].ks1 = *reinterpret_cast<const bf16x8*>(rb_ + (size_t)32 * NINP + kcol); } while (0)
#define SWRITE(b, i) do { *(LAS bf16x8*)(V_lds + (b) * SHM_V + vst0) = sr_[i].vs0;          \
    *(LAS bf16x8*)(V_lds + (b) * SHM_V + vst1) = sr_[i].vs1; int kc = sc * 2;               \
    *(LAS bf16x8*)(K_lds + (b) * SHM_K + KSWZ(sr, kc)) = sr_[i].ks0;                       \
    *(LAS bf16x8*)(K_lds + (b) * SHM_K + KSWZ(32 + sr, kc)) = sr_[i].ks1; } while (0)
#define SWAIT() do { if constexpr (SDEPTH == 2) asm volatile("s_waitcnt vmcnt(4)" ::: "memory"); else asm volatile("s_waitcnt vmcnt(0)" ::: "memory"); } while (0)
#define RESC(a) do { if (__any((a) < 1.f)) { if (hi == 0) al_l[r32] = (a); asm volatile("s_waitcnt lgkmcnt(0)" ::: "memory"); \
    _Pragma("unroll") for (int d = 0; d < 4; ++d) _Pragma("unroll") for (int r = 0; r < 16; ++r) o[d][r] *= al_l[crow(r, hi)]; } } while (0)
  f32x16 pA0, pA1, pB0, pB1; float mnA, mnB, alA, alB; bf16x8 pa0, pa1, pa2, pa3; const int NT = u.nloc + 4;
  constexpr int SE = 0, SO = SDEPTH - 1;
  SLOAD(SE, 0); asm volatile("s_waitcnt vmcnt(0)" ::: "memory"); SWRITE(0, SE); __syncthreads();
#define SCORE(P0, P1, KB, jt, ACT) do { ACT = tile_active(u, (jt), wid); if (ACT) { qkt(P0, P1, KB, qr, r32, hi); apply_mask(P0, P1, u, (jt), wid, r32, hi, rpbL); } else fill_ninf(P0, P1); } while (0)
  bool actA, actB;
  SCORE(pA0, pA1, K_lds, 0, actA); partialSM(pA0, pA1, m_reg, mnA, alA);
  SLOAD(SO, 1); if constexpr (SDEPTH == 2) { if (2 < NT) SLOAD(SE, 2); }
  SWAIT(); SWRITE(1, SO); __syncthreads();
  for (int j = 1; j + 1 < NT; j += 2) {
    SBAR(); SCORE(pB0, pB1, K_lds + SHM_K, j, actB);
    finishSM(pA0, pA1, alA, l_reg, pa0, pa1, pa2, pa3); SBAR();
    SLOAD(SO, j + SDEPTH); SBAR();
    if (actA) pv_d0(o, vb0, pa0, pa1, pa2, pa3); partialSM(pB0, pB1, m_reg, mnB, alB);
    __syncthreads(); SWAIT(); SWRITE(0, SE);
    RESC(alB); __syncthreads();
    SBAR(); SCORE(pA0, pA1, K_lds, j + 1, actA);
    finishSM(pB0, pB1, alB, l_reg, pa0, pa1, pa2, pa3); SBAR();
    if (SDEPTH == 1 || j + 3 < NT) SLOAD(SE, j + 1 + SDEPTH); SBAR();
    if (actB) pv_d0(o, vb0 + SHM_V, pa0, pa1, pa2, pa3); partialSM(pA0, pA1, m_reg, mnA, alA);
    __syncthreads(); SWAIT(); SWRITE(1, SO);
    RESC(alA); __syncthreads();
  }
  SBAR(); SCORE(pB0, pB1, K_lds + SHM_K, NT - 1, actB);
  finishSM(pA0, pA1, alA, l_reg, pa0, pa1, pa2, pa3); SBAR();
  if (actA) pv_d0(o, vb0, pa0, pa1, pa2, pa3); partialSM(pB0, pB1, m_reg, mnB, alB);
  __syncthreads(); RESC(alB);
  finishSM(pB0, pB1, alB, l_reg, pa0, pa1, pa2, pa3); SBAR();
  if (actB) pv_d0(o, vb0 + SHM_V, pa0, pa1, pa2, pa3);
  if (u.type & 1) { constexpr float C = ATT_SCALE * 1.4426950408889634f; l_reg += __builtin_amdgcn_exp2f((p.wa_sink[l * 4 + u.hh] * (1.f / ATT_SCALE) - m_reg) * C); }
  if (hi == 0) li_l[r32] = l_reg; asm volatile("s_waitcnt lgkmcnt(0)" ::: "memory");
  float rli[16];
#pragma unroll
  for (int r = 0; r < 16; ++r) rli[r] = __builtin_amdgcn_rcpf(li_l[crow(r, hi)]);
  bf16* Ow = MIX + (size_t)(qrow0 + wid * 32) * DM + ocol;
#pragma unroll
  for (int r = 0; r < 16; r += 2) {
#pragma unroll
    for (int d0 = 0; d0 < 4; ++d0) {
      const float a = o[d0][r] * rli[r], b = o[d0][r + 1] * rli[r + 1];
      const float send = (lane & 1) ? a : b, got = __shfl_xor(send, 1);
      const int orow = crow(r, hi) + (lane & 1), ocl = d0 * 32 + (r32 & ~1);
      if (F8_OUTPROJ) { const float lo = ((lane & 1) ? got : a) * MIX_SCALE, hi2 = ((lane & 1) ? b : got) * MIX_SCALE;
        *(unsigned short*)((unsigned char*)MIX + (size_t)(qrow0 + wid * 32 + orow) * DM + ocol + ocl) = (unsigned short)pack4f8(lo, hi2, 0.f, 0.f); }
      else { const unsigned w = (lane & 1) ? pk2(got, b) : pk2(a, got); *(unsigned*)(Ow + (size_t)orow * DM + ocl) = w; } } }
  __syncthreads();
#undef SCORE
#undef SLOAD
#undef SWRITE
#undef SWAIT
#undef RESC
}
constexpr int NSLOT = 3;
constexpr int OFFD_K = 0, OFFD_V = NSLOT * SHM_K, OFFD_WS = NSLOT * (SHM_K + SHM_V), OFFD_RPB = OFFD_WS + 8 * 64 * 4, ATT_LDS_D = OFFD_RPB + 576 * 4;
static_assert(ATT_LDS_D <= RING_BYTES, "attention LDS");
__device__ __forceinline__ void attn_unit_dma(const Prm& p, int l, const UnitD u, LAS unsigned char* lds, int tid) {
  const bf16* U = (const bf16*)(p.ws + WS_U); bf16* MIX = (bf16*)(p.ws + WS_H);
  const int wid = __builtin_amdgcn_readfirstlane(tid >> 6), lane = tid & 63, r32 = lane & 31, hi = lane >> 5;
  int qcol, kcol, vcol, ocol;
  if (u.type == 0 || u.type == 2) { qcol = C_QA + u.hh * 128; kcol = C_KA + u.hh * 128; vcol = C_VA + u.hh * 128; ocol = u.hh * 128; }
  else { const int kvh = u.hh >> 1; qcol = C_QB + u.hh * 128; kcol = C_KB + kvh * 128; vcol = C_VB + kvh * 128; ocol = 512 + u.hh * 128; }
  const int qrow0 = (u.type < 2 ? u.b * SEQL : T_LAT + u.b * CTXL) + u.q0;
  LAS unsigned char* K_lds = lds + OFFD_K; LAS unsigned char* V_lds = lds + OFFD_V;
  LAS float* wsl = (LAS float*)(lds + OFFD_WS) + wid * 64; LAS float* li_l = wsl; LAS float* al_l = wsl + 32;
  LAS float* rpbL = (LAS float*)(lds + OFFD_RPB);
  if (u.type == 0 && tid < 465) rpbL[32 + tid] = p.na_rpb[(size_t)(l * 4 + u.hh) * 465 + tid] * (1.f / ATT_SCALE);
  float m_reg = -1e30f, l_reg = 0; f32x16 o[4] = {}; bf16x8 qr[8];
  const bf16* Qw = U + (size_t)(qrow0 + wid * 32 + r32) * NINP + qcol + hi * 8;
#pragma unroll
  for (int d0 = 0; d0 < 8; ++d0) qr[d0] = *reinterpret_cast<const bf16x8*>(Qw + d0 * 16);
  unsigned koff[2], voff[2];
#pragma unroll
  for (int i = 0; i < 2; ++i) { const int pch = (wid * 2 + i) * 64 + lane;
    { const int row = pch >> 4, c = (pch & 15) ^ (row & 7); koff[i] = (unsigned)(row * NINP + kcol + c * 8); }
    { const int sidx = pch >> 5, q = pch & 31, kk = (sidx >> 2) * 8 + (q >> 2), k = (kk & ~0xC) | ((kk & 4) << 1) | ((kk & 8) >> 1);
      voff[i] = (unsigned)(k * NINP + vcol + (sidx & 3) * 32 + (q & 3) * 8); } }
  const int vb0 = (int)(uintptr_t)V_lds + v_rd_base(lane);
#define DMA_K(jt) do { const bf16* tb_ = U + (size_t)tile_row(u, (jt)) * NINP; LAS unsigned char* dst_ = K_lds + ((jt) % NSLOT) * SHM_K + wid * 2048; \
    _Pragma("unroll") for (int i_ = 0; i_ < 2; ++i_) __builtin_amdgcn_global_load_lds((const unsigned*)(tb_ + koff[i_]), (LAS unsigned*)(dst_ + i_ * 1024), 16, 0, 0); } while (0)
#define DMA_V(jt) do { const bf16* tb_ = U + (size_t)tile_row(u, (jt)) * NINP; LAS unsigned char* dst_ = V_lds + ((jt) % NSLOT) * SHM_V + wid * 2048; \
    _Pragma("unroll") for (int i_ = 0; i_ < 2; ++i_) __builtin_amdgcn_global_load_lds((const unsigned*)(tb_ + voff[i_]), (LAS unsigned*)(dst_ + i_ * 1024), 16, 0, 0); } while (0)
#define STEP_SYNC4() asm volatile("s_waitcnt vmcnt(4) lgkmcnt(0)\n\ts_barrier" ::: "memory")
#define STEP_SYNC0() asm volatile("s_waitcnt vmcnt(0) lgkmcnt(0)\n\ts_barrier" ::: "memory")
#define RESC(a) do { if (__any((a) < 1.f)) { if (hi == 0) al_l[r32] = (a); asm volatile("s_waitcnt lgkmcnt(0)" ::: "memory"); \
    _Pragma("unroll") for (int d = 0; d < 4; ++d) _Pragma("unroll") for (int r = 0; r < 16; ++r) o[d][r] *= al_l[crow(r, hi)]; } } while (0)
#define SCORE(P0, P1, jt, ACT) do { ACT = tile_active(u, (jt), wid); if (ACT) { qkt(P0, P1, K_lds + ((jt) % NSLOT) * SHM_K, qr, r32, hi); apply_mask(P0, P1, u, (jt), wid, r32, hi, rpbL); } else fill_ninf(P0, P1); } while (0)
  f32x16 pA0, pA1, pB0, pB1; float mnA, mnB, alA, alB; bf16x8 pa0, pa1, pa2, pa3; const int NT = u.nloc + 4; bool actA, actB;
  DMA_K(0); DMA_K(1); DMA_V(0);
  STEP_SYNC4();
  DMA_K(2); DMA_V(1);
  SCORE(pA0, pA1, 0, actA); partialSM(pA0, pA1, m_reg, mnA, alA);
#pragma unroll 1
  for (int s = 1; s + 1 < NT; s += 2) {
    STEP_SYNC4();
    DMA_K(s + 2); DMA_V(s + 1);
    SBAR(); SCORE(pB0, pB1, s, actB);
    finishSM(pA0, pA1, alA, l_reg, pa0, pa1, pa2, pa3); SBAR();
    if (actA) pv_d0(o, vb0 + ((s - 1) % NSLOT) * SHM_V, pa0, pa1, pa2, pa3); partialSM(pB0, pB1, m_reg, mnB, alB);
    RESC(alB);
    STEP_SYNC4();
    if (s + 3 < NT) DMA_K(s + 3); DMA_V(s + 2);
    SBAR(); SCORE(pA0, pA1, s + 1, actA);
    finishSM(pB0, pB1, alB, l_reg, pa0, pa1, pa2, pa3); SBAR();
    if (actB) pv_d0(o, vb0 + (s % NSLOT) * SHM_V, pa0, pa1, pa2, pa3); partialSM(pA0, pA1, m_reg, mnA, alA);
    RESC(alA);
  }
  STEP_SYNC0();
  SBAR(); SCORE(pB0, pB1, NT - 1, actB);
  finishSM(pA0, pA1, alA, l_reg, pa0, pa1, pa2, pa3); SBAR();
  if (actA) pv_d0(o, vb0 + ((NT - 2) % NSLOT) * SHM_V, pa0, pa1, pa2, pa3); partialSM(pB0, pB1, m_reg, mnB, alB);
  RESC(alB);
  finishSM(pB0, pB1, alB, l_reg, pa0, pa1, pa2, pa3); SBAR();
  if (actB) pv_d0(o, vb0 + ((NT - 1) % NSLOT) * SHM_V, pa0, pa1, pa2, pa3);
  if (u.type & 1) { constexpr float C = ATT_SCALE * 1.4426950408889634f; l_reg += __builtin_amdgcn_exp2f((p.wa_sink[l * 4 + u.hh] * (1.f / ATT_SCALE) - m_reg) * C); }
  if (hi == 0) li_l[r32] = l_reg; asm volatile("s_waitcnt lgkmcnt(0)" ::: "memory");
  float rli[16];
#pragma unroll
  for (int r = 0; r < 16; ++r) rli[r] = __builtin_amdgcn_rcpf(li_l[crow(r, hi)]);
  bf16* Ow = MIX + (size_t)(qrow0 + wid * 32) * DM + ocol;
#pragma unroll
  for (int r = 0; r < 16; r += 2) {
#pragma unroll
    for (int d0 = 0; d0 < 4; ++d0) {
      const float a = o[d0][r] * rli[r], b = o[d0][r + 1] * rli[r + 1];
      const float send = (lane & 1) ? a : b, got = __shfl_xor(send, 1);
      const int orow = crow(r, hi) + (lane & 1), ocl = d0 * 32 + (r32 & ~1);
      if (F8_OUTPROJ) { const float lo = ((lane & 1) ? got : a) * MIX_SCALE, hi2 = ((lane & 1) ? b : got) * MIX_SCALE;
        *(unsigned short*)((unsigned char*)MIX + (size_t)(qrow0 + wid * 32 + orow) * DM + ocol + ocl) = (unsigned short)pack4f8(lo, hi2, 0.f, 0.f); }
      else { const unsigned w = (lane & 1) ? pk2(got, b) : pk2(a, got); *(unsigned*)(Ow + (size_t)orow * DM + ocl) = w; } } }
  asm volatile("s_waitcnt lgkmcnt(0)\n\ts_barrier" ::: "memory");
#undef DMA_K
#undef DMA_V
#undef STEP_SYNC4
#undef STEP_SYNC0
#undef RESC
#undef SCORE
}
#ifndef ATT_DMA
#define ATT_DMA 1
#endif
__device__ __forceinline__ void phase_attn(const Prm& p, int l, LAS unsigned char* lds, int wg, int nwg, int tid) {
    const int nu = 512 + (l == 0 ? 16 : 0);
    for (int it = wg; it < nu; it += nwg) {
        UnitD u;
        if (it < 256) { u.type = 0; u.b = it >> 7; u.hh = (it >> 5) & 3; const int blk = it & 31; u.q0 = blk * 256; u.nloc = 12; u.kbase = min(max(blk * 4 - 4, 0), 116); }
        else if (it < 512) { const int r = it - 256; u.type = 1; u.b = r >> 7; u.hh = (r >> 5) & 3; const int blk = r & 31; u.q0 = blk * 256; u.nloc = 8; u.kbase = blk * 256 - 128; }
        else { const int r = it - 512; u.type = 2 + (r >> 3); u.b = (r >> 2) & 1; u.hh = r & 3; u.q0 = 0; u.nloc = 0; u.kbase = 0; }
        if (ATT_DMA) attn_unit_dma(p, l, u, lds, tid); else attn_unit(p, l, u, lds, tid);
    }
}
}
namespace ssd {
typedef short s16x4 __attribute__((ext_vector_type(4)));
typedef float f32x16 __attribute__((ext_vector_type(16)));
constexpr int NCH = 66;
constexpr size_t WS_ST = WS_YD, WS_HS = WS_YD + 66 * MiB, WS_DEC = 1259 * MiB;
__device__ __forceinline__ int crow(int r, int hi) { return (r & 3) + 8 * (r >> 2) + 4 * hi; }
__device__ __forceinline__ int chunk_row0(int b, int c) { return c < 2 ? T_LAT + b * CTXL + c * 128 : b * SEQL + (c - 2) * 128; }
__device__ __forceinline__ s16x4 ds_tr(unsigned addr) { s16x4 r; asm volatile("ds_read_b64_tr_b16 %0, %1" : "=&v"(r) : "v"(addr) : "memory"); return r; }
struct Raw { s16x4 lo, hi; };
__device__ __forceinline__ Raw raw_tr_nat(unsigned base, int stride, int k0, int idx0, int lane) {
    const int i16 = lane & 15, g16 = (lane >> 4) & 1, hl = lane >> 5;
    const unsigned a = base + (unsigned)((k0 + 8 * hl + (i16 >> 2)) * stride + (idx0 + 16 * g16 + 4 * (i16 & 3)) * 2);
    Raw r; r.lo = ds_tr(a); r.hi = ds_tr(a + 4 * stride); return r;
}
__device__ __forceinline__ Raw raw_tr_acc(unsigned base, int stride, int k0, int idx0, int lane) {
    const int i16 = lane & 15, g16 = (lane >> 4) & 1, hl = lane >> 5;
    const unsigned a = base + (unsigned)((k0 + 4 * hl + (i16 >> 2)) * stride + (idx0 + 16 * g16 + 4 * (i16 & 3)) * 2);
    Raw r; r.lo = ds_tr(a); r.hi = ds_tr(a + 8 * stride); return r;
}
__device__ __forceinline__ void raw_wait2(Raw& a, Raw& b) { asm volatile("s_waitcnt lgkmcnt(0)" : "+v"(a.lo), "+v"(a.hi), "+v"(b.lo), "+v"(b.hi) :: "memory"); }
__device__ __forceinline__ void raw_wait6(Raw& a, Raw& b, Raw& c, Raw& d, Raw& e, Raw& f) {
    asm volatile("s_waitcnt lgkmcnt(0)" : "+v"(a.lo), "+v"(a.hi), "+v"(b.lo), "+v"(b.hi), "+v"(c.lo), "+v"(c.hi), "+v"(d.lo), "+v"(d.hi), "+v"(e.lo), "+v"(e.hi), "+v"(f.lo), "+v"(f.hi) :: "memory"); }
__device__ __forceinline__ bf16x8 join8(const Raw& r) { return (bf16x8){r.lo[0], r.lo[1], r.lo[2], r.lo[3], r.hi[0], r.hi[1], r.hi[2], r.hi[3]}; }
__device__ __forceinline__ unsigned cvtpk(float lo, float hi) { unsigned r; asm volatile("v_cvt_pk_bf16_f32 %0, %1, %2\n\ts_nop 1" : "=v"(r) : "v"(lo), "v"(hi)); return r; }
__device__ __forceinline__ void scan128(float& v0, float& v1, int lane) {
#pragma unroll
    for (int o = 1; o < 64; o <<= 1) { const int src = (lane >= o ? lane - o : lane) << 2;
        const float t0 = __builtin_bit_cast(float, __builtin_amdgcn_ds_bpermute(src, __builtin_bit_cast(int, v0))), t1 = __builtin_bit_cast(float, __builtin_amdgcn_ds_bpermute(src, __builtin_bit_cast(int, v1)));
        if (lane >= o) { v0 += t0; v1 += t1; } }
    v1 += __builtin_bit_cast(float, __builtin_amdgcn_ds_bpermute(63 << 2, __builtin_bit_cast(int, v0)));
}
__device__ __forceinline__ float lane63(float v) { return __builtin_bit_cast(float, __builtin_amdgcn_ds_bpermute(63 << 2, __builtin_bit_cast(int, v))); }

constexpr int BST = 272, XST = 528;
constexpr int S2_B = 0, S2_X = 128 * BST, S2_W = S2_X + 128 * XST, S2_END = S2_W + 8 * 128 * 4;
__device__ __forceinline__ void phase_states(const Prm& p, int l, LAS unsigned char* lds, int wg, int nwg, int tid) {
    const bf16* XA = (const bf16*)(p.ws + WS_XBC); const float* DT = (const float*)(p.ws + WS_DT);
    bf16* ST = (bf16*)(p.ws + WS_ST); float* DEC = (float*)(p.ws + WS_DEC);
    const int wid = __builtin_amdgcn_readfirstlane(tid >> 6), lane = tid & 63, hl = lane >> 5;
    for (int it = wg; it < 2 * NCH * 4; it += nwg) {
        const int b = it / (NCH * 4), rem = it % (NCH * 4), c = rem >> 2, g = (rem >> 1) & 1, hq = rem & 1;
        const int row0 = chunk_row0(b, c), h = 8 * g + 4 * hq + (wid & 3), dir = wid >> 2;
        { v4u tb[4], tx[8];
#pragma unroll
          for (int i = 0; i < 4; ++i) { const int id = tid + 512 * i, r = id >> 4, ch = id & 15; tb[i] = *(const v4u*)(XA + (size_t)(row0 + r) * XBCW + 1024 + g * 128 + ch * 8); }
#pragma unroll
          for (int i = 0; i < 8; ++i) { const int id = tid + 512 * i, r = id >> 5, ch = id & 31; tx[i] = *(const v4u*)(XA + (size_t)(row0 + r) * XBCW + (8 * g + 4 * hq) * 64 + ch * 8); }
#pragma unroll
          for (int i = 0; i < 4; ++i) { const int id = tid + 512 * i, r = id >> 4, ch = id & 15; *(LAS v4u*)(lds + S2_B + r * BST + ch * 16) = tb[i]; }
#pragma unroll
          for (int i = 0; i < 8; ++i) { const int id = tid + 512 * i, r = id >> 5, ch = id & 31; *(LAS v4u*)(lds + S2_X + r * XST + ch * 16) = tx[i]; } }
        const float a = -__expf(p.a_log[l * 32 + dir * 16 + h]);
        const float d0 = DT[(size_t)(row0 + lane) * 32 + dir * 16 + h], d1 = DT[(size_t)(row0 + 64 + lane) * 32 + dir * 16 + h];
        float P0 = a * d0, P1 = a * d1; scan128(P0, P1, lane);
        const float tot = lane63(P1);
        LAS float* wL = (LAS float*)(lds + S2_W) + wid * 128;
        wL[lane] = (dir == 0 ? __expf(tot - P0) : __expf(P0 - a * d0)) * d0;
        wL[64 + lane] = (dir == 0 ? __expf(tot - P1) : __expf(P1 - a * d1)) * d1;
        if (lane == 0) DEC[((b * NCH + c) * 2 + dir) * 16 + h] = __expf(tot);
        __syncthreads();
        f32x16 acc[2][4];
#pragma unroll
        for (int i = 0; i < 2; ++i)
#pragma unroll
            for (int j = 0; j < 4; ++j) acc[i][j] = f32x16{};
        const unsigned bB = (unsigned)(uintptr_t)(lds + S2_B), bX = (unsigned)(uintptr_t)(lds + S2_X);
#pragma unroll 1
        for (int ks = 0; ks < 8; ++ks) {
            const f32x4 w0 = *(const LAS f32x4*)(wL + 16 * ks + 8 * hl), w1 = *(const LAS f32x4*)(wL + 16 * ks + 8 * hl + 4);
            bf16x8 xa[2], bb[4];
            { Raw rx0 = raw_tr_nat(bX, XST, 16 * ks, (wid & 3) * 64, lane), rx1 = raw_tr_nat(bX, XST, 16 * ks, (wid & 3) * 64 + 32, lane);
              Raw rb0 = raw_tr_nat(bB, BST, 16 * ks, 0, lane), rb1 = raw_tr_nat(bB, BST, 16 * ks, 32, lane), rb2 = raw_tr_nat(bB, BST, 16 * ks, 64, lane), rb3 = raw_tr_nat(bB, BST, 16 * ks, 96, lane);
              raw_wait6(rx0, rx1, rb0, rb1, rb2, rb3);
              xa[0] = join8(rx0); xa[1] = join8(rx1); bb[0] = join8(rb0); bb[1] = join8(rb1); bb[2] = join8(rb2); bb[3] = join8(rb3); }
#pragma unroll
            for (int pt = 0; pt < 2; ++pt) {
                v4u q = *reinterpret_cast<v4u*>(&xa[pt]);
                q.x = cvtpk(bflo(q.x) * w0[0], bfhi(q.x) * w0[1]); q.y = cvtpk(bflo(q.y) * w0[2], bfhi(q.y) * w0[3]);
                q.z = cvtpk(bflo(q.z) * w1[0], bfhi(q.z) * w1[1]); q.w = cvtpk(bflo(q.w) * w1[2], bfhi(q.w) * w1[3]);
                xa[pt] = *reinterpret_cast<bf16x8*>(&q); }
#pragma unroll
            for (int pt = 0; pt < 2; ++pt)
#pragma unroll
                for (int nt = 0; nt < 4; ++nt) acc[pt][nt] = __builtin_amdgcn_mfma_f32_32x32x16_bf16(xa[pt], bb[nt], acc[pt][nt], 0, 0, 0);
        }
        bf16* so = ST + ((size_t)((b * NCH + c) * 2 + dir) * 16 + h) * 8192;
#pragma unroll
        for (int pt = 0; pt < 2; ++pt)
#pragma unroll
            for (int nt = 0; nt < 4; ++nt)
#pragma unroll
                for (int r = 0; r < 16; r += 2) {
                    const float x0 = acc[pt][nt][r], x1 = acc[pt][nt][r + 1];
                    const float send = (lane & 1) ? x0 : x1, got = __shfl_xor(send, 1);
                    const unsigned w = (lane & 1) ? pk2(got, x1) : pk2(x0, got);
                    *(unsigned*)(so + (size_t)(pt * 32 + crow(r, hl) + (lane & 1)) * 128 + nt * 32 + ((lane & 31) & ~1)) = w; }
        __syncthreads();
    }
}

__device__ __forceinline__ void phase_scan(const Prm& p, int gtid, int ngt) {
    const bf16* ST = (const bf16*)(p.ws + WS_ST); bf16* HS = (bf16*)(p.ws + WS_HS); const float* DEC = (const float*)(p.ws + WS_DEC);
    for (int e = gtid; e < 2 * 2 * 16 * 2048; e += ngt) {
        const int q = e & 2047, h = (e >> 11) & 15, dir = (e >> 15) & 1, b = e >> 16;
        f32x4 hs = {0.f, 0.f, 0.f, 0.f};
#pragma unroll 6
        for (int i = 0; i < NCH; ++i) {
            const int c = dir == 0 ? i : (i < 2 ? 1 - i : NCH + 1 - i);
            const size_t off = ((size_t)((b * NCH + c) * 2 + dir) * 16 + h) * 8192 + q * 4;
            const v2u sv = *(const v2u*)(ST + off); const float dc = DEC[((b * NCH + c) * 2 + dir) * 16 + h];
            v2u o; o.x = pk2(hs[0], hs[1]); o.y = pk2(hs[2], hs[3]); *(v2u*)(HS + off) = o;
            hs[0] = dc * hs[0] + bflo(sv.x); hs[1] = dc * hs[1] + bfhi(sv.x); hs[2] = dc * hs[2] + bflo(sv.y); hs[3] = dc * hs[3] + bfhi(sv.y);
        }
    }
}

constexpr int CST = 272, XSS = 80;
constexpr size_t WS_Y = WS_XG;
constexpr int S4_B = 0, S4_C = 128 * CST, S4_X = 2 * 128 * CST, S4_ARR = 3 * 128 * CST, S4_YX = S4_ARR + 8 * 2 * 128 * 4, S4_END = S4_YX + 4 * 16 * 64 * 4;
static_assert(S4_END <= RING_BYTES && S2_END <= RING_BYTES && 8 * 32 * XSS <= 128 * CST, "ssd LDS");
__device__ __forceinline__ void phase_ssd_out(const Prm& p, int l, LAS unsigned char* lds, int wg, int nwg, int tid) {
    const bf16* XA = (const bf16*)(p.ws + WS_XBC); const float* DT = (const float*)(p.ws + WS_DT); const bf16* HS = (const bf16*)(p.ws + WS_HS);
    bf16* Y = (bf16*)(p.ws + WS_Y);
    const int wid = __builtin_amdgcn_readfirstlane(tid >> 6), lane = tid & 63, hl = lane >> 5, l31 = lane & 31, pt = (wid >> 1) & 1, dir = wid >> 2;
    const int c_lo = (l == 0) ? 0 : 2, ncu = NCH - c_lo;
    for (int it = wg; it < 2 * ncu * 8; it += nwg) {
        const int b = it / (ncu * 8), rem = it % (ncu * 8), c = c_lo + (rem >> 3), g = (rem >> 2) & 1, hp = rem & 3, h = 8 * g + 2 * hp + (wid & 1);
        const int row0 = chunk_row0(b, c);
        { v4u tb[4], tc[4];
#pragma unroll
          for (int i = 0; i < 4; ++i) { const int id = tid + 512 * i, r = id >> 4, ch = id & 15; const bf16* src = XA + (size_t)(row0 + r) * XBCW + g * 128 + ch * 8; tb[i] = *(const v4u*)(src + 1024); tc[i] = *(const v4u*)(src + 1280); }
#pragma unroll
          for (int i = 0; i < 4; ++i) { const int id = tid + 512 * i, r = id >> 4, ch = id & 15; *(LAS v4u*)(lds + S4_B + r * CST + ch * 16) = tb[i]; *(LAS v4u*)(lds + S4_C + r * CST + ch * 16) = tc[i]; } }
        v4u tx[4];
#pragma unroll
        for (int i = 0; i < 4; ++i) { const int id = tid + 512 * i, r = id >> 4, ch = id & 15; tx[i] = *(const v4u*)(XA + (size_t)(row0 + r) * XBCW + (8 * g + 2 * hp) * 64 + ch * 8); }
        bf16x8 hs[8];
        { const bf16* hp_ = HS + ((size_t)((b * NCH + c) * 2 + dir) * 16 + h) * 8192 + (size_t)(pt * 32 + l31) * 128 + 8 * hl;
#pragma unroll
          for (int ks = 0; ks < 8; ++ks) hs[ks] = *(const bf16x8*)(hp_ + 16 * ks); }
        LAS float* QL = (LAS float*)(lds + S4_ARR) + wid * 256; LAS float* DL = QL + 128;
        float ebase;
        { const float a = -__expf(p.a_log[l * 32 + dir * 16 + h]);
          const float d0 = DT[(size_t)(row0 + lane) * 32 + dir * 16 + h], d1 = DT[(size_t)(row0 + 64 + lane) * 32 + dir * 16 + h];
          float q0 = a * d0, q1 = a * d1; scan128(q0, q1, lane); const float tot = lane63(q1);
          QL[lane] = dir == 0 ? q0 : a * d0 - q0; QL[64 + lane] = dir == 0 ? q1 : a * d1 - q1; DL[lane] = d0; DL[64 + lane] = d1; ebase = dir == 0 ? 0.f : tot; }
        __syncthreads();
#pragma unroll
        for (int j = 0; j < 2; ++j) { const int id = wid * 2 + j, st = id >> 2, tt = id & 3; f32x16 X = f32x16{};
#pragma unroll
            for (int ks = 0; ks < 8; ++ks) { const bf16x8 bfr = *(const LAS bf16x8*)(lds + S4_B + (st * 32 + l31) * CST + (16 * ks + 8 * hl) * 2), cfr = *(const LAS bf16x8*)(lds + S4_C + (tt * 32 + l31) * CST + (16 * ks + 8 * hl) * 2);
                X = __builtin_amdgcn_mfma_f32_32x32x16_bf16(bfr, cfr, X, 0, 0, 0); }
#pragma unroll
            for (int i = 0; i < 4; ++i) { v2u w; w.x = pk2(X[4 * i], X[4 * i + 1]); w.y = pk2(X[4 * i + 2], X[4 * i + 3]);
                *(LAS v2u*)(lds + S4_X + (tt * 32 + l31) * CST + (st * 32 + 8 * i + 4 * hl) * 2) = w; } }
        __syncthreads();
        bf16x8 xf[8];
        {
#pragma unroll
          for (int i = 0; i < 4; ++i) { const int id = tid + 512 * i, r = id >> 4, ch = id & 15; *(LAS v4u*)(lds + S4_B + r * CST + ch * 16) = tx[i]; }
          __syncthreads();
          const unsigned bXs = (unsigned)(uintptr_t)(lds + S4_B); const int c0 = (wid & 1) * 64 + pt * 32;
#pragma unroll
          for (int q = 0; q < 4; ++q) { Raw r0 = raw_tr_acc(bXs, CST, 32 * q, c0, lane), r1 = raw_tr_acc(bXs, CST, 32 * q + 16, c0, lane); raw_wait2(r0, r1); xf[2 * q] = join8(r0); xf[2 * q + 1] = join8(r1); }
        }
        const float dsum = p.d_skip[l * 32 + h] + p.d_skip[l * 32 + 16 + h];
        LAS float* YX = (LAS float*)(lds + S4_YX) + (wid & 3) * 1024;
#pragma unroll 1
        for (int tt = 0; tt < 4; ++tt) {
            const int tl = tt * 32 + l31;
            const float Qt = QL[tl];
            f32x16 yacc = f32x16{};
#pragma unroll
            for (int st = 0; st < 4; ++st) {
                if (dir == 0 ? (st > tt) : (st < tt)) continue;
                __builtin_amdgcn_sched_barrier(0);
                float mv[16];
#pragma unroll
                for (int i = 0; i < 4; ++i) { const v2u w = *(const LAS v2u*)(lds + S4_X + tl * CST + (st * 32 + 8 * i + 4 * hl) * 2);
                    const f32x4 qv = *(const LAS f32x4*)(QL + st * 32 + 8 * i + 4 * hl), dv = *(const LAS f32x4*)(DL + st * 32 + 8 * i + 4 * hl);
                    const float xv[4] = {bflo(w.x), bfhi(w.x), bflo(w.y), bfhi(w.y)};
#pragma unroll
                    for (int j = 0; j < 4; ++j) { const int s = st * 32 + 8 * i + 4 * hl + j; const bool ok = dir == 0 ? (s <= tl) : (s >= tl);
                        mv[4 * i + j] = ok ? __expf(Qt - qv[j]) * dv[j] * xv[j] : 0.f; } }
#pragma unroll
                for (int s2 = 0; s2 < 2; ++s2) { v4u q; q.x = cvtpk(mv[8 * s2 + 0], mv[8 * s2 + 1]); q.y = cvtpk(mv[8 * s2 + 2], mv[8 * s2 + 3]); q.z = cvtpk(mv[8 * s2 + 4], mv[8 * s2 + 5]); q.w = cvtpk(mv[8 * s2 + 6], mv[8 * s2 + 7]);
                    yacc = __builtin_amdgcn_mfma_f32_32x32x16_bf16(xf[2 * st + s2], *reinterpret_cast<bf16x8*>(&q), yacc, 0, 0, 0); }
            }
            __builtin_amdgcn_sched_barrier(0);
            { const LAS unsigned char* cfp = lds + S4_C + tl * CST + 16 * hl; f32x16 G = f32x16{};
#pragma unroll
              for (int ks = 0; ks < 8; ++ks) G = __builtin_amdgcn_mfma_f32_32x32x16_bf16(hs[ks], *(const LAS bf16x8*)(cfp + 32 * ks), G, 0, 0, 0);
              const float e = __expf(ebase + Qt);
#pragma unroll
              for (int r = 0; r < 16; ++r) yacc[r] += e * G[r]; }
            if (dir == 1) {
#pragma unroll
                for (int r = 0; r < 16; ++r) YX[r * 64 + lane] = yacc[r]; }
            __syncthreads();
            if (dir == 0) {
                const size_t trow = (size_t)(row0 + tl);
#pragma unroll
                for (int i = 0; i < 4; ++i) { const int pc = h * 64 + pt * 32 + 8 * i + 4 * hl; const v2u xw = *(const v2u*)(XA + trow * XBCW + pc);
                    f32x4 o; o[0] = yacc[4 * i] + YX[(4 * i) * 64 + lane] + dsum * bflo(xw.x); o[1] = yacc[4 * i + 1] + YX[(4 * i + 1) * 64 + lane] + dsum * bfhi(xw.x);
                    o[2] = yacc[4 * i + 2] + YX[(4 * i + 2) * 64 + lane] + dsum * bflo(xw.y); o[3] = yacc[4 * i + 3] + YX[(4 * i + 3) * 64 + lane] + dsum * bfhi(xw.y);
                    v2u w; w.x = pk2(o[0], o[1]); w.y = pk2(o[2], o[3]); *(v2u*)(Y + trow * 1024 + pc) = w; } }
            __syncthreads();
        }
    }
}
}
__device__ __forceinline__ void phase_norm2_router(const Prm& p, int l, LAS unsigned char* lds, int wg, int nwg, int tid, int wave, int lane) {
    bf16* H = (bf16*)(p.ws + WS_H); const bf16* WR = (const bf16*)(p.ws + WS_WRT);
    const int ntok = (l == 0) ? T_ALL : T_LAT;
    constexpr int HROW = 4096 + 16;
    LAS unsigned char* hfL = lds; LAS float* part = (LAS float*)(lds + 66048); LAS float* affL = (LAS float*)(lds + 66048 + 16384);
    int* tok_e = (int*)(p.ws + WS_TOK); int* tok_pos = (int*)(p.ws + WS_TOK + TOKTAB); float* tok_gate = (float*)(p.ws + WS_TOK + 2 * TOKTAB);
    unsigned* cnt = (unsigned*)(p.ws + OFF_CNT) + l * 32 * 16;
    for (int it = wg; it < ntok / 16; it += nwg) {
        const int m0 = it * 16;
#pragma unroll
        for (int rr = 0; rr < 2; ++rr) {
            const int r = wave * 2 + rr, m = m0 + r;
            f32x4 v[8]; load_row(p, 1, -1, m, lane, v);
            const float rstd = row_rstd(v);
            const int vs = m >= T_LAT ? 2 : (m >> 13);
            const float* md = (const float*)(p.ws + OFF_MOD) + (size_t)(l * 3 + vs) * MODW;
#pragma unroll
            for (int j = 0; j < 8; ++j) { const int col = 256 * j + 4 * lane; const f32x4 o = modulate4f(v[j], rstd, p.norm_ffn + l * DM, md + 4 * DM, md + 3 * DM, col);
                v2u w; w.x = pk2(o[0], o[1]); w.y = pk2(o[2], o[3]);
                *(unsigned*)((unsigned char*)H + (size_t)m * DM + col) = pack4f8(o[0], o[1], o[2], o[3]);
                *(LAS v2u*)(hfL + r * HROW + col * 2) = w; }
        }
        __syncthreads();
        {
            f32x4 a0 = {0.f, 0.f, 0.f, 0.f}, a1 = a0; const int fr = lane & 15, fq = lane >> 4;
#pragma unroll
            for (int ks = 0; ks < 8; ++ks) { const int k0 = wave * 256 + ks * 32 + 8 * fq;
                const bf16x8 af = *(const LAS bf16x8*)(hfL + fr * HROW + k0 * 2);
                const bf16x8 b0 = *(const bf16x8*)(WR + (size_t)fr * DM + k0), b1 = *(const bf16x8*)(WR + (size_t)(16 + fr) * DM + k0);
                a0 = __builtin_amdgcn_mfma_f32_16x16x32_bf16(af, b0, a0, 0, 0, 0); a1 = __builtin_amdgcn_mfma_f32_16x16x32_bf16(af, b1, a1, 0, 0, 0); }
#pragma unroll
            for (int i = 0; i < 4; ++i) { part[(wave * 16 + 4 * fq + i) * 32 + fr] = a0[i]; part[(wave * 16 + 4 * fq + i) * 32 + 16 + fr] = a1[i]; }
        }
        __syncthreads();
        { float s = 0.f;
#pragma unroll
          for (int w = 0; w < 8; ++w) s += part[w * 512 + tid];
          affL[tid] = sigmoid_f(s); }
        __syncthreads();
        if (tid < 16) {
            const LAS float* af = affL + tid * 32; const int m = m0 + tid;
            int bg = 0; float bs = -INFINITY;
#pragma unroll
            for (int g = 0; g < 4; ++g) { float t1 = -INFINITY, t2 = -INFINITY;
#pragma unroll
                for (int j = 0; j < 8; ++j) { const float s = af[8 * g + j] + p.router_bias[8 * g + j]; if (s > t1) { t2 = t1; t1 = s; } else if (s > t2) t2 = s; }
                const float gs = t1 + t2; if (gs > bs) { bs = gs; bg = g; } }
            float t1 = -INFINITY, t2 = -INFINITY; int i1 = 0, i2 = 0;
#pragma unroll
            for (int j = 0; j < 8; ++j) { const float s = af[8 * bg + j] + p.router_bias[8 * bg + j]; if (s > t1) { t2 = t1; i2 = i1; t1 = s; i1 = j; } else if (s > t2) { t2 = s; i2 = j; } }
            const int e0 = 8 * bg + i1, e1 = 8 * bg + i2; const float f0 = af[e0], f1 = af[e1], inv = 1.f / (f0 + f1);
            const unsigned p0 = atomicAdd(cnt + e0 * 16, 1u), p1 = atomicAdd(cnt + e1 * 16, 1u);
            int* list = (int*)(p.ws + WS_LIST); list[(size_t)e0 * LCAP + p0] = m; list[(size_t)e1 * LCAP + p1] = m;
            tok_e[2 * m] = e0; tok_e[2 * m + 1] = e1; tok_pos[2 * m] = (int)p0; tok_pos[2 * m + 1] = (int)p1; tok_gate[2 * m] = f0 * inv; tok_gate[2 * m + 1] = f1 * inv;
        }
        __syncthreads();
    }
}
__device__ __forceinline__ void build_seg_tables(const Prm& p, int l, LAS unsigned char* lds, int tid) {
    LAS int* seg = (LAS int*)(lds + L_SEG); LAS int* cntL = (LAS int*)(lds + L_CNT); LAS int* blke = (LAS int*)(lds + L_BLKE); LAS int* nblkp = (LAS int*)(lds + L_NBLK);
    LAS int* incl = (LAS int*)(lds + L_INCL);
    const unsigned* cnt = (const unsigned*)(p.ws + OFF_CNT) + l * 32 * 16;
    __syncthreads();
    LAS int* pbL = (LAS int*)(lds + L_PB);
    if (tid < 32) { const int c = (int)cnt[tid * 16]; cntL[tid] = c; pbL[tid] = (c + 255) >> 8; }
    __syncthreads();
    if (tid < 32) { int inc = 0;
#pragma unroll
        for (int k = 0; k < 32; ++k) inc += (k <= tid) ? pbL[k] : 0;
        seg[tid] = (inc - pbL[tid]) * 256; incl[tid] = inc; if (tid == 31) { seg[32] = inc * 256; *nblkp = inc; } }
    __syncthreads();
    if (tid < MAXBLK + 3) { int e = 0;
#pragma unroll
        for (int k = 0; k < 32; ++k) e += (incl[k] <= tid) ? 1 : 0;
        e = e < 31 ? e : 31; blke[tid] = e; ((LAS int*)(lds + L_BLKH))[tid] = (cntL[e] - 256 * (tid - (seg[e] >> 8)) <= 128) ? 1 : 0; }
    __syncthreads();
}
template <class Sched>
__device__ __forceinline__ void build_row_table(const Prm& p, const Sched& S, LAS unsigned char* lds, int tid) {
    const LAS int* seg = (const LAS int*)(lds + L_SEG); const LAS int* cntL = (const LAS int*)(lds + L_CNT); const LAS int* blke = (const LAS int*)(lds + L_BLKE);
    LAS unsigned* T = (LAS unsigned*)(lds + L_ROWT); const int* list = (const int*)(p.ws + WS_LIST);
#pragma unroll 1
    for (int i = 0; i < 8; ++i) { pg8::Unit u; if (!S.next(i, u)) break;
        const int e = blke[u.pm], base = (u.pm - (seg[e] >> 8)) * 256;
        if (tid < 256) { const int pos = base + tid; T[i * 256 + tid] = pos < cntL[e] ? (unsigned)WS_H + (unsigned)list[(size_t)e * LCAP + pos] * 2048u : ZERO_OFF; } }
    __syncthreads();
}
#ifndef SKIP_GU
#define SKIP_GU true
#endif
#ifndef SKIP_DN
#define SKIP_DN true
#endif
constexpr int N_PHASES = 24;
__global__ void __launch_bounds__(NWAVES * 64, 2) mk_fwd(Prm p) {
    extern __shared__ __attribute__((aligned(16))) unsigned char lds_raw[];
    LAS unsigned char* lds = (LAS unsigned char*)lds_raw;
    const int tid0 = threadIdx.x, wave = __builtin_amdgcn_readfirstlane(tid0 >> 6);
#define OPQ int tid = tid0; asm volatile("" : "+v"(tid)); const int lane = tid & 63;
    const int G = gridDim.x, bx = blockIdx.x, vcu = (G % 8 == 0) ? (bx % 8) * (G / 8) + bx / 8 : bx;
    const int gw = vcu * NWAVES + wave, ngw = G * NWAVES;
    unsigned char* ws = p.ws;
    for (int u = tid0; u < (LDS_BYTES - LDSCTL_OFF) / 4; u += NWAVES * 64) ((LAS unsigned*)(lds + LDSCTL_OFF))[u] = 0u;
    __syncthreads();
#if MK_ONE_LAUNCH
    XcdBarrier bar = xcd_barrier_post((unsigned*)ws + CW_BAR, (volatile LAS unsigned*)(lds + L_BARW));
#define GRID_BAR() xcd_barrier(bar)
#define GRID_BAR_W() do { if (CONV_QUEUE) xcd_barrier_work(bar, p, lds, tid0); else xcd_barrier(bar); } while (0)
#else
#define GRID_BAR() do {} while (0)
#define GRID_BAR_W() do {} while (0)
#endif
    const int lo = p.ph_lo, hi = p.ph_hi;
#define IN(k) (lo <= (k) && (k) < hi)
#ifndef DUPMASK
#define DUPMASK 0
#endif
#define REPS(kind) for (int rep_ = 0; rep_ < (((DUPMASK) >> (kind)) & 1) + 1; ++rep_)
    if (IN(0)) REPS(0) { OPQ phase_prologue(p, lds, gw, ngw, wave, lane, rep_ == 0); GRID_BAR(); }
    for (int l = 0; l < 2; ++l) {
        const int pb = 1 + 11 * l;
        if (IN(pb + 0)) { OPQ if (l > 0) { if (CONV_QUEUE) queue_drain(p, lds, tid, (unsigned)NP_PROJ);     build_seg_tables(p, l - 1, lds, tid); row_stream<true, false, false>(p, l, l - 1, T_ALL, gw, ngw, tid, lane, lds, (const LAS int*)(lds + L_SEG)); } else row_stream<false, false, true>(p, l, 0, T_ALL, gw, ngw, tid, lane, lds, (const LAS int*)(lds + L_SEG)); GRID_BAR_W(); }
        if (IN(pb + 1)) REPS(2) {
            pg8::Gemm g{(const pg8::bf16_t*)(ws + WS_H), (const pg8::bf16_t*)(ws + WS_WIN + (size_t)l * NINP * DM * (F8_INPROJ ? 1 : 2)), T_ALL, NINP, F8_INPROJ ? DM / 2 : DM};
            pg8::StaticOrder S; S.init(T_ALL, NINP, G, bx);
            pg8::EpiInProj E{(pg8::bf16_t*)(ws + WS_U), NINP, (const float*)(ws + WS_ROPE), C_QB / 256, C_VB / 256, T_LAT, F8_INPROJ ? 1.f / W8_SCALE : 1.f};
            pg8::gemm_phase<pg8::EpiInProj, pg8::StaticOrder, true, true, F8_INPROJ != 0>(lds, g, S, E);
            GRID_BAR_W();
        }
        if (IN(pb + 2)) REPS(3) { OPQ phase_conv(p, l, gw, ngw, lane); att::phase_attn(p, l, lds, bx, G, tid); GRID_BAR_W(); }
        if (IN(pb + 3)) REPS(4) { OPQ ssd::phase_states(p, l, lds, bx, G, tid); GRID_BAR_W(); }
        if (IN(pb + 4)) REPS(5) { OPQ ssd::phase_scan(p, bx * (NWAVES * 64) + tid, G * NWAVES * 64); GRID_BAR_W(); }
        if (IN(pb + 5)) REPS(6) { OPQ ssd::phase_ssd_out(p, l, lds, bx, G, tid); GRID_BAR_W(); }
        if (IN(pb + 6)) REPS(7) { OPQ phase_gnorm(p, l, gw, ngw, lane); GRID_BAR_W(); }
        if (IN(pb + 7)) {
            const int M = (l == 0) ? T_ALL : T_LAT;
            pg8::Gemm g{(const pg8::bf16_t*)(ws + WS_H), (const pg8::bf16_t*)(ws + WS_WOUT + (size_t)l * DM * DM * (F8_OUTPROJ ? 1 : 2)), M, DM, F8_OUTPROJ ? DM / 2 : DM};
            pg8::StaticOrder S; S.init(M, DM, G, bx);
            pg8::EpiRes E{(l == 0) ? (const void*)p.x : (const void*)(ws + WS_X), (pg8::bf16_t*)(ws + WS_X), (l == 0) ? (const void*)p.ctx : (const void*)(ws + WS_XC), (pg8::bf16_t*)(ws + WS_XC),
                          (const float*)(ws + OFF_MOD) + (size_t)l * 3 * MODW + 2 * DM, DM, T_LAT, MODW, F8_OUTPROJ ? 1.f / (W8_SCALE * MIX_SCALE) : 1.f, l == 0 ? 1 : 0};
            pg8::gemm_phase<pg8::EpiRes, pg8::StaticOrder, true, true, F8_OUTPROJ != 0>(lds, g, S, E);
            GRID_BAR_W();
        }
        if (IN(pb + 8)) { OPQ phase_norm2_router(p, l, lds, bx, G, tid, wave, lane); GRID_BAR_W(); }
        if (IN(pb + 9) && CONV_QUEUE && l == 1) { OPQ queue_drain(p, lds, tid, (unsigned)Q_TOTAL); GRID_BAR(); }
        if (IN(pb + 9)) REPS(11) {
            OPQ build_seg_tables(p, l, lds, tid);
            const int nblk = __builtin_amdgcn_readfirstlane(*(const LAS int*)(lds + L_NBLK));
            pg8::Gemm g{(const pg8::bf16_t*)ws, (const pg8::bf16_t*)(ws + WS_WGU + (size_t)l * 32 * 2048 * 2048), nblk * 256, 2048, DM / 2};
            pg8::GroupedOrderT<SKIP_GU, true> S{G, vcu, nblk, (const LAS int*)(lds + L_BLKE), (const LAS int*)(lds + L_BLKH), (long)2048 * 2048, (const LAS unsigned*)(lds + L_ROWT)};
            build_row_table(p, S, lds, tid);
            pg8::EpiGateUp E{ws + WS_ACT, DFF, 1.f / W8_SCALE};
            pg8::gemm_phase<pg8::EpiGateUp, pg8::GroupedOrderT<SKIP_GU, true>, true, true, true>(lds, g, S, E);
            GRID_BAR_W();
        }
        if (IN(pb + 10)) REPS(12) {
            OPQ build_seg_tables(p, l, lds, tid);
            const int nblk = __builtin_amdgcn_readfirstlane(*(const LAS int*)(lds + L_NBLK));
            pg8::Gemm g{(const pg8::bf16_t*)(ws + WS_ACT), (const pg8::bf16_t*)(ws + WS_WDN + (size_t)l * 32 * 2048 * 1024), nblk * 256, DM, DFF / 2};
            pg8::GroupedOrderT<SKIP_DN> S{G, vcu, nblk, (const LAS int*)(lds + L_BLKE), (const LAS int*)(lds + L_BLKH), (long)2048 * 1024, nullptr};
            pg8::EpiF8 E{ws + WS_YB, DM, Y8_SCALE / W8_SCALE};
            pg8::gemm_phase<pg8::EpiF8, pg8::GroupedOrderT<SKIP_DN>, true, true, true>(lds, g, S, E);
            GRID_BAR_W();
        }
    }
    if (IN(23)) { OPQ build_seg_tables(p, 1, lds, tid); row_stream<true, true, false>(p, 1, 1, T_LAT, gw, ngw, tid, lane, lds, (const LAS int*)(lds + L_SEG)); }
#undef IN
}

extern "C" void kernel_launch(void* const* d_in, const int* in_sizes, int n_in, void* d_out, int out_size, void* d_ws, size_t ws_size, hipStream_t stream) {
    static int grid = 0;
    if (grid == 0) {
        if (n_in != 24 || in_sizes[0] != T_LAT * DM || out_size != T_LAT * DM || ws_size < WS_END) {
            fprintf(stderr, "kernel_launch: unexpected shapes: n_in %d in0 %d out %d ws %zu (need %zu)\n", n_in, n_in > 0 ? in_sizes[0] : -1, out_size, ws_size, (size_t)WS_END); grid = -1; return; }
        int dev = 0, cus = 0, per_cu = 0;
        if (hipGetDevice(&dev) != hipSuccess || hipDeviceGetAttribute(&cus, hipDeviceAttributeMultiprocessorCount, dev) != hipSuccess) { grid = -1; return; }
        if (hipFuncSetAttribute((const void*)mk_fwd, hipFuncAttributeMaxDynamicSharedMemorySize, LDS_BYTES) != hipSuccess) { fprintf(stderr, "kernel_launch: hipFuncSetAttribute failed\n"); grid = -1; return; }
        if (hipOccupancyMaxActiveBlocksPerMultiprocessor(&per_cu, (const void*)mk_fwd, NWAVES * 64, LDS_BYTES) != hipSuccess || per_cu < 1) {
            fprintf(stderr, "kernel_launch: occupancy query reports %d blocks per CU\n", per_cu); }
        (void)hipGetLastError();
        grid = cus;
    }
    if (grid < 0) return;
    if (hipMemsetAsync((char*)d_ws + WS_CTL, 0, CTL_ZERO_BYTES, stream) != hipSuccess) { fprintf(stderr, "kernel_launch: memset failed\n"); return; }
    Prm p{};
    p.x = (const float*)d_in[0]; p.c = (const float*)d_in[1]; p.ctx = (const float*)d_in[2]; p.c_ctx = (const float*)d_in[3]; p.w_ada = (const float*)d_in[4]; p.b_ada = (const float*)d_in[5];
    p.norm_mix = (const float*)d_in[6]; p.norm_ffn = (const float*)d_in[7]; p.norm_final = (const float*)d_in[8]; p.w_in = (const float*)d_in[9]; p.w_out = (const float*)d_in[10];
    p.na_rpb = (const float*)d_in[11]; p.wa_sink = (const float*)d_in[12]; p.conv_w = (const float*)d_in[13]; p.conv_b = (const float*)d_in[14]; p.a_log = (const float*)d_in[15];
    p.dt_bias = (const float*)d_in[16]; p.d_skip = (const float*)d_in[17]; p.ssd_norm = (const float*)d_in[18]; p.w_router = (const float*)d_in[19]; p.router_bias = (const float*)d_in[20];
    p.w_gate = (const float*)d_in[21]; p.w_up = (const float*)d_in[22]; p.w_down = (const float*)d_in[23];
    p.out = (float*)d_out; p.ws = (unsigned char*)d_ws;
#if MK_ONE_LAUNCH
    p.ph_lo = 0; p.ph_hi = N_PHASES;
    hipLaunchKernelGGL(mk_fwd, dim3(grid), dim3(NWAVES * 64), LDS_BYTES, stream, p);
#else
    for (int ph = 0; ph < N_PHASES; ++ph) { p.ph_lo = ph; p.ph_hi = ph + 1; hipLaunchKernelGGL(mk_fwd, dim3(grid), dim3(NWAVES * 64), LDS_BYTES, stream, p); }
#endif
    const hipError_t le = hipPeekAtLastError();
    if (le != hipSuccess) fprintf(stderr, "kernel_launch: launch failed: %s\n", hipGetErrorName(le));
}
```

```cpp
#include <hip/hip_runtime.h>
#include <cstdio>
#include <cstdint>

#ifndef MK_ONE_LAUNCH
#define MK_ONE_LAUNCH 1
#endif

#ifndef F8_INPROJ
#define F8_INPROJ 1
#endif
#ifndef F8_OUTPROJ
#define F8_OUTPROJ 1
#endif

namespace pg8 {
#define PG8_LAS __attribute__((address_space(3)))
typedef unsigned short bf16_t;
typedef short bf16x8 __attribute__((ext_vector_type(8)));
typedef float f32x4 __attribute__((ext_vector_type(4)));
typedef unsigned u32x4 __attribute__((ext_vector_type(4)));
constexpr int BM = 256, BK = 64, HALF = 128, HTB = HALF * BK * 2  , STAGE_BYTES = 8 * HTB, NXCD = 8, WGM = 8;

__host__ __device__ __forceinline__ int lds_byte(int r, int c) { const int st = (r >> 4) * 2 + (c >> 5), rr = r & 15, cc = c & 31, ob = rr * 64 + cc * 2; return st * 1024 + (ob ^ (((ob >> 9) & 1) << 5)); }
__host__ __device__ __forceinline__ void stage_rc(int b, int& R, int& C) { const int st = b / 1024, sb = b % 1024, swz = sb ^ (((sb >> 9) & 1) << 5); R = (st >> 1) * 16 + swz / 64; C = (st & 1) * 32 + (swz % 64) / 2; }
__host__ __device__ __forceinline__ int perm32(int rho) { const int n = rho >> 4, i = rho & 15; return 8 * (i >> 2) + 4 * n + (i & 3); }

typedef int i32x4v __attribute__((ext_vector_type(4)));
typedef int i32x8v __attribute__((ext_vector_type(8)));
__device__ __forceinline__ i32x8v cat8(bf16x8 a, bf16x8 b) { const i32x4v x = __builtin_bit_cast(i32x4v, a), y = __builtin_bit_cast(i32x4v, b); return __builtin_shufflevector(x, y, 0, 1, 2, 3, 4, 5, 6, 7); }
struct Unit { int pm, pn; long boff; int lo_only; };
struct Gemm { const bf16_t* A; const bf16_t* Bt; int M, N, K; };

struct StaticOrder {
    static constexpr bool SKIP_HI = false, GATHER = false; const PG8_LAS unsigned* rowtab;
    int nM, nN, nwg, G, c;
    __host__ __device__ void init(int M, int N, int G_, int c_) { nM = M / BM; nN = N / BM; nwg = nM * nN; G = G_; c = c_; }
    __host__ __device__ bool next(int i, Unit& u) const {
        const long L = (long)i * G + c; if (L >= nwg) return false;
        int wgid = (int)L; { const int q = nwg / NXCD, r = nwg % NXCD, xcd = wgid % NXCD, off = wgid / NXCD; wgid = (xcd < r ? xcd * (q + 1) : r * (q + 1) + (xcd - r) * q) + off; }
        const int nig = WGM * nN, gid = wgid / nig, fm = gid * WGM, gsz = (nM - fm) < WGM ? (nM - fm) : WGM;
        u.pm = fm + ((wgid % nig) % gsz); u.pn = (wgid % nig) / gsz; u.boff = 0; u.lo_only = 0; return true;
    }
    __device__ __forceinline__ void a_ready(const Unit&) const {}
    __device__ __forceinline__ void done(const Unit&) const {}
};

__device__ __forceinline__ unsigned cvt_pk_bf16(float lo, float hi) { unsigned r; asm volatile("v_cvt_pk_bf16_f32 %0, %1, %2" : "=v"(r) : "v"(lo), "v"(hi)); return r; }
typedef float f32x2 __attribute__((ext_vector_type(2)));
__device__ __forceinline__ f32x2 gelu_pk(f32x2 v) {
    const f32x2 av = __builtin_elementwise_abs(v), d = av * 0.2316418882f + 1.0f;
    f32x2 t; t.x = __builtin_amdgcn_rcpf(d.x); t.y = __builtin_amdgcn_rcpf(d.y);
    f32x2 q = t * 0.5307027145f + (-0.7265760135f); q = q * t + 0.7107068705f; q = q * t + (-0.142248368f); q = q * t + 0.127414796f; q = q * t;
    const f32x2 s = (v * v) * (-0.72134752044f);
    f32x2 e; e.x = __builtin_amdgcn_exp2f(s.x); e.y = __builtin_amdgcn_exp2f(s.y);
    const f32x2 m = v * (q * e), r = v - m;
    f32x2 o; o.x = v.x < 0.f ? m.x : r.x; o.y = v.y < 0.f ? m.y : r.y; return o;
}

template <class Epi, class Sched, bool ALIGN_EPI = false, bool SP2 = false, bool F8 = false>
__device__ __forceinline__ void gemm_phase(PG8_LAS unsigned char* lds, const Gemm g, const Sched& S, const Epi& E) {
    int tid_o = threadIdx.x; asm volatile("" : "+v"(tid_o));
    const int tid = tid_o, wid = __builtin_amdgcn_readfirstlane(tid >> 6), lane = tid & 63, wr = wid >> 2, wc = wid & 3, fr = lane & 15, fq = lane >> 4;
    const int K = g.K, nt = K / BK;
    unsigned voffA[2], voffB[2];
#pragma unroll
    for (int i = 0; i < 2; ++i) { int R, C; stage_rc(tid * 16 + i * 8192, R, C); const int Rb = Epi::PERM ? ((R & ~31) + perm32(R & 31)) : R;
        voffA[i] = (unsigned)(R * K + C) * 2u; voffB[i] = (unsigned)(Rb * K + C) * 2u; }
    int gR[2]; unsigned gC[2];
#pragma unroll
    for (int i = 0; i < 2; ++i) { int R, C; stage_rc(tid * 16 + i * 8192, R, C); gR[i] = R; gC[i] = (unsigned)C * 2u; }
    unsigned gc[2][2] = {{0u, 0u}, {0u, 0u}}, gn[2][2] = {{0u, 0u}, {0u, 0u}};
#define PG8_GROWS(dst, u) do { if constexpr (Sched::GATHER) { _Pragma("unroll") for (int h_ = 0; h_ < 2; ++h_) _Pragma("unroll") for (int i_ = 0; i_ < 2; ++i_) dst[h_][i_] = S.rowtab[(u) * 256 + h_ * 128 + gR[i_]] + gC[i_]; } } while (0)
#define PG8_STAGE_A(bufoff, kbase, h, nx) do { if constexpr (Sched::GATHER) { _Pragma("unroll") for (int _i = 0; _i < 2; ++_i) \
        __builtin_amdgcn_global_load_lds((const unsigned*)((const char*)(kbase) + ((nx) ? gn[h][_i] : gc[h][_i])), (PG8_LAS unsigned*)(lds + (bufoff) + ldsw + _i * 8192), 16, 0, 0); } \
        else PG8_STAGE(bufoff, (kbase) + ((h) ? hstep : 0), voffA); } while (0)
    const size_t kstep = (size_t)(BK * 2);
    const size_t hstep = (size_t)HALF * K * 2;
    const size_t tstep = 2 * hstep;
    const unsigned ldsw = (unsigned)wid * 1024u;
    const int aoff = lds_byte(wr * 64 + fr, fq * 8), boff = lds_byte(wc * 32 + fr, fq * 8);
    const int aoff8 = lds_byte(wr * 64 + fr, (fq & 1) * 16) + (fq >> 1) * 1024, boff8 = lds_byte(wc * 32 + fr, (fq & 1) * 16) + (fq >> 1) * 1024;
#define PG8_SA(b, h) (((b) * 2 + (h)) * HTB)
#define PG8_SB(b, h) ((4 + (b) * 2 + (h)) * HTB)
#define PG8_STAGE(bufoff, gbase, voff) do { _Pragma("unroll") for (int _i = 0; _i < 2; ++_i) \
        __builtin_amdgcn_global_load_lds((const unsigned*)((const char*)(gbase) + (voff)[_i]), (PG8_LAS unsigned*)(lds + (bufoff) + ldsw + _i * 8192), 16, 0, 0); } while (0)
#define PG8_LDA(dst, b, h) do { if constexpr (F8) { _Pragma("unroll") for (int m = 0; m < 4; ++m) dst##8[m] = cat8(*(const PG8_LAS bf16x8*)(lds + PG8_SA(b, h) + aoff8 + m * 2048), *(const PG8_LAS bf16x8*)(lds + PG8_SA(b, h) + aoff8 + m * 2048 + 16)); } else { \
        _Pragma("unroll") for (int m = 0; m < 4; ++m) _Pragma("unroll") for (int k = 0; k < 2; ++k) dst[m][k] = *(const PG8_LAS bf16x8*)(lds + PG8_SA(b, h) + aoff + m * 2048 + k * 1024); } } while (0)
#define PG8_LDB(dst, b, h) do { if constexpr (F8) { _Pragma("unroll") for (int n = 0; n < 2; ++n) dst##8[n] = cat8(*(const PG8_LAS bf16x8*)(lds + PG8_SB(b, h) + boff8 + n * 2048), *(const PG8_LAS bf16x8*)(lds + PG8_SB(b, h) + boff8 + n * 2048 + 16)); } else { \
        _Pragma("unroll") for (int n = 0; n < 2; ++n) _Pragma("unroll") for (int k = 0; k < 2; ++k) dst[n][k] = *(const PG8_LAS bf16x8*)(lds + PG8_SB(b, h) + boff + n * 2048 + k * 1024); } } while (0)
#define PG8_MMA(ai, bj, At, Bt) do { __builtin_amdgcn_s_setprio(1); if constexpr (F8) { _Pragma("unroll") for (int m = 0; m < 4; ++m) _Pragma("unroll") for (int n = 0; n < 2; ++n) \
        asm volatile("v_mfma_scale_f32_16x16x128_f8f6f4 %0, %1, %2, %0, %3, %3 op_sel_hi:[0,0,0]" : "+v"(acc[ai][bj][m][n]) : "v"(Bt##8[n]), "v"(At##8[m]), "v"(sc1)); } else { \
        _Pragma("unroll") for (int m = 0; m < 4; ++m) _Pragma("unroll") for (int n = 0; n < 2; ++n) _Pragma("unroll") for (int k = 0; k < 2; ++k) \
        acc[ai][bj][m][n] = __builtin_amdgcn_mfma_f32_16x16x32_bf16(Bt[n][k], At[m][k], acc[ai][bj][m][n], 0, 0, 0); } __builtin_amdgcn_s_setprio(0); } while (0)
#define PG8_WAIT_V(n) asm volatile("s_waitcnt vmcnt(" #n ")" ::: "memory")
#define PG8_WAIT_L(n) asm volatile("s_waitcnt lgkmcnt(" #n ")" ::: "memory")
#define PG8_BAR __builtin_amdgcn_s_barrier()
#define PG8_SCHED __builtin_amdgcn_sched_barrier(0)
    Unit cur, nxt; int ui = 0;
    if (!S.next(0, cur)) return;
    f32x4 acc[2][2][4][2];
#pragma unroll
    for (int a = 0; a < 2; ++a)
#pragma unroll
        for (int b = 0; b < 2; ++b)
#pragma unroll
            for (int m = 0; m < 4; ++m)
#pragma unroll
                for (int n = 0; n < 2; ++n) acc[a][b][m][n] = (f32x4){0.f, 0.f, 0.f, 0.f};
    const int sc1 = 0x7F7F7F7F;
    bf16x8 At[4][2], B0[2][2], B1[2][2]; i32x8v At8[4], B08[2], B18[2];
    const char* cA = (const char*)g.A + (Sched::GATHER ? (size_t)0 : (size_t)cur.pm * tstep); PG8_GROWS(gc, 0); const char* cB = (const char*)g.Bt + (size_t)cur.pn * tstep + cur.boff;
    S.a_ready(cur);
    if constexpr (SP2) {
        PG8_STAGE(PG8_SB(0, 0), cB, voffB); PG8_STAGE(PG8_SB(0, 1), cB + hstep, voffB); PG8_STAGE_A(PG8_SA(0, 0), cA, 0, false); PG8_STAGE_A(PG8_SA(0, 1), cA, 1, false);
        if (wr == 1) PG8_BAR;
        PG8_WAIT_V(2); PG8_BAR;
        PG8_STAGE(PG8_SB(1, 0), cB + kstep, voffB); PG8_STAGE_A(PG8_SA(1, 0), cA + kstep, 0, false); PG8_STAGE(PG8_SB(1, 1), cB + hstep + kstep, voffB);
        PG8_WAIT_V(6); PG8_BAR;
    } else {
        PG8_STAGE(PG8_SB(0, 0), cB, voffB); PG8_STAGE_A(PG8_SA(0, 0), cA, 0, false); PG8_STAGE(PG8_SB(0, 1), cB + hstep, voffB); PG8_STAGE_A(PG8_SA(0, 1), cA, 1, false);
        if (wr == 1) PG8_BAR;
        PG8_WAIT_V(4); PG8_BAR;
        PG8_STAGE(PG8_SB(1, 0), cB + kstep, voffB); PG8_STAGE_A(PG8_SA(1, 0), cA + kstep, 0, false); PG8_STAGE(PG8_SB(1, 1), cB + hstep + kstep, voffB);
        PG8_WAIT_V(6); PG8_BAR;
    }
    for (;;) {
        const bool has_next = S.next(ui + 1, nxt);
        const char* nA = has_next ? (const char*)g.A + (Sched::GATHER ? (size_t)0 : (size_t)nxt.pm * tstep) : cA; if (has_next) PG8_GROWS(gn, ui + 1); const char* nB = has_next ? (const char*)g.Bt + (size_t)nxt.pn * tstep + nxt.boff : cB;
        const bool hi_on = !Sched::SKIP_HI || cur.lo_only == 0;
#pragma unroll 1
        for (int t = 0; t < nt; t += 2) {
            const bool last = (t == nt - 2);
            const char* a1 = cA + (size_t)(t + 1) * kstep;
            const char* a2 = last ? nA : cA + (size_t)(t + 2) * kstep; const char* b2 = last ? nB : cB + (size_t)(t + 2) * kstep;
            const char* a3 = a2 + kstep; const char* b3 = b2 + kstep;
            const bool nx_ = last && has_next;
            if (last && has_next) S.a_ready(nxt);
            if constexpr (SP2) {
            PG8_LDB(B0, 0, 0); PG8_LDB(B1, 0, 1); PG8_SCHED; PG8_LDA(At, 0, 0); PG8_STAGE_A(PG8_SA(1, 1), a1, 1, false);
            PG8_WAIT_V(8); PG8_WAIT_L(0); PG8_BAR; PG8_MMA(0, 0, At, B0); PG8_MMA(0, 1, At, B1); PG8_BAR; PG8_SCHED;
            PG8_LDA(At, 0, 1); PG8_STAGE(PG8_SB(0, 0), b2, voffB); PG8_STAGE(PG8_SB(0, 1), b2 + hstep, voffB); PG8_STAGE_A(PG8_SA(0, 0), a2, 0, nx_);
            PG8_WAIT_V(8); PG8_WAIT_L(0); PG8_BAR; if (__builtin_expect(hi_on, 1)) { PG8_MMA(1, 0, At, B0); PG8_MMA(1, 1, At, B1); } PG8_BAR; PG8_SCHED;
            PG8_LDB(B0, 1, 0); PG8_LDB(B1, 1, 1); PG8_SCHED; PG8_LDA(At, 1, 0); PG8_STAGE_A(PG8_SA(0, 1), a2, 1, nx_);
            PG8_WAIT_V(8); PG8_WAIT_L(0); PG8_BAR; PG8_MMA(0, 0, At, B0); PG8_MMA(0, 1, At, B1); PG8_BAR; PG8_SCHED;
            PG8_LDA(At, 1, 1); PG8_STAGE(PG8_SB(1, 0), b3, voffB); PG8_STAGE(PG8_SB(1, 1), b3 + hstep, voffB); PG8_STAGE_A(PG8_SA(1, 0), a3, 0, nx_);
            PG8_WAIT_V(8); PG8_WAIT_L(0); PG8_BAR; if (__builtin_expect(hi_on, 1)) { PG8_MMA(1, 0, At, B0); PG8_MMA(1, 1, At, B1); } PG8_BAR; PG8_SCHED;
            } else {
            PG8_LDB(B0, 0, 0); PG8_SCHED; PG8_LDA(At, 0, 0); PG8_STAGE_A(PG8_SA(1, 1), a1, 1, false);
            PG8_WAIT_L(8); PG8_BAR; PG8_WAIT_L(0); PG8_MMA(0, 0, At, B0); PG8_BAR; PG8_SCHED;
            PG8_LDB(B1, 0, 1); PG8_STAGE(PG8_SB(0, 0), b2, voffB);
            PG8_BAR; PG8_WAIT_L(0); PG8_MMA(0, 1, At, B1); PG8_BAR;
            PG8_LDA(At, 0, 1); PG8_STAGE_A(PG8_SA(0, 0), a2, 0, nx_);
            PG8_BAR; PG8_WAIT_L(0); PG8_MMA(1, 0, At, B0); PG8_BAR; PG8_SCHED;
            PG8_STAGE(PG8_SB(0, 1), b2 + hstep, voffB);
            PG8_WAIT_V(6); PG8_BAR; PG8_MMA(1, 1, At, B1); PG8_BAR;
            PG8_LDB(B0, 1, 0); PG8_SCHED; PG8_LDA(At, 1, 0); PG8_STAGE_A(PG8_SA(0, 1), a2, 1, nx_);
            PG8_WAIT_L(8); PG8_BAR; PG8_WAIT_L(0); PG8_MMA(0, 0, At, B0); PG8_BAR; PG8_SCHED;
            PG8_LDB(B1, 1, 1); PG8_STAGE(PG8_SB(1, 0), b3, voffB);
            PG8_BAR; PG8_WAIT_L(0); PG8_MMA(0, 1, At, B1); PG8_BAR;
            PG8_LDA(At, 1, 1); PG8_STAGE_A(PG8_SA(1, 0), a3, 0, nx_);
            PG8_BAR; PG8_WAIT_L(0); PG8_MMA(1, 0, At, B0); PG8_BAR; PG8_SCHED;
            PG8_STAGE(PG8_SB(1, 1), b3 + hstep, voffB);
            PG8_WAIT_V(6); PG8_BAR; PG8_MMA(1, 1, At, B1); PG8_BAR;
            }
        }
        if constexpr (F8) asm volatile("s_nop 15\n\ts_nop 15" ::: "memory");
        if constexpr (ALIGN_EPI) { if (wr == 0) PG8_BAR; }
        if constexpr (!Epi::AFTER_DRAIN) { E(acc, cur, wr, wc, fr, fq); S.done(cur); }
        if (!has_next) break;
#pragma unroll
        for (int a = 0; a < 2; ++a)
#pragma unroll
            for (int b = 0; b < 2; ++b)
#pragma unroll
                for (int m = 0; m < 4; ++m)
#pragma unroll
                    for (int n = 0; n < 2; ++n) acc[a][b][m][n] = (f32x4){0.f, 0.f, 0.f, 0.f};
        cur = nxt; cA = nA; cB = nB; ++ui;
        if constexpr (Sched::GATHER) { gc[0][0] = gn[0][0]; gc[0][1] = gn[0][1]; gc[1][0] = gn[1][0]; gc[1][1] = gn[1][1]; }
        if constexpr (ALIGN_EPI) { if (wr == 1) PG8_BAR; }
    }
    PG8_WAIT_V(0);
    if constexpr (!ALIGN_EPI) { if (wr == 0) PG8_BAR; }
    PG8_BAR;
    if constexpr (Epi::AFTER_DRAIN) { E.fused(acc, cur, wr, wc, fr, fq, lds, wid, lane); S.done(cur); }
#undef PG8_SA
#undef PG8_SB
#undef PG8_STAGE
#undef PG8_STAGE_A
#undef PG8_GROWS
#undef PG8_LDA
#undef PG8_LDB
#undef PG8_MMA
#undef PG8_WAIT_V
#undef PG8_WAIT_L
#undef PG8_BAR
#undef PG8_SCHED
}
typedef unsigned u32x2e __attribute__((ext_vector_type(2)));
struct EpiPlain {
    static constexpr bool PERM = true, AFTER_DRAIN = false;
    bf16_t* O; int ldc; float scale;
    __device__ __forceinline__ void operator()(const f32x4 (&acc)[2][2][4][2], const Unit& u, int wr, int wc, int fr, int fq) const {
        const int row0 = u.pm * BM + wr * 64 + fr, col0 = u.pn * BM + wc * 32 + 8 * fq;
        float one = scale; asm volatile("" : "+v"(one));
#pragma unroll
        for (int ai = 0; ai < 2; ++ai)
#pragma unroll
            for (int m = 0; m < 4; ++m) { bf16_t* rowp = O + (size_t)(row0 + ai * HALF + m * 16) * ldc + col0;
#pragma unroll
                for (int bj = 0; bj < 2; ++bj) { const f32x4 v0 = acc[ai][bj][m][0] * one, v1 = acc[ai][bj][m][1] * one;
                    u32x4 w; w.x = cvt_pk_bf16(v0[0], v0[1]); w.y = cvt_pk_bf16(v0[2], v0[3]); w.z = cvt_pk_bf16(v1[0], v1[1]); w.w = cvt_pk_bf16(v1[2], v1[3]);
                    *(u32x4*)(rowp + bj * HALF) = w; } }
    }
};
struct EpiF8 {
    static constexpr bool PERM = true, AFTER_DRAIN = false;
    unsigned char* O; int ldc; float scale;
    __device__ __forceinline__ void operator()(const f32x4 (&acc)[2][2][4][2], const Unit& u, int wr, int wc, int fr, int fq) const {
        const int row0 = u.pm * BM + wr * 64 + fr, col0 = u.pn * BM + wc * 32 + 8 * fq;
        float one = scale; asm volatile("" : "+v"(one));
#pragma unroll
        for (int ai = 0; ai < 2; ++ai)
#pragma unroll
            for (int m = 0; m < 4; ++m) { unsigned char* rowp = O + (size_t)(row0 + ai * HALF + m * 16) * ldc + col0;
#pragma unroll
                for (int bj = 0; bj < 2; ++bj) { const f32x4 v0 = acc[ai][bj][m][0] * one, v1 = acc[ai][bj][m][1] * one;
                    u32x2e w; { int t = __builtin_amdgcn_cvt_pk_fp8_f32(v0[0], v0[1], 0, false); t = __builtin_amdgcn_cvt_pk_fp8_f32(v0[2], v0[3], t, true); w.x = (unsigned)t; }
                    { int t = __builtin_amdgcn_cvt_pk_fp8_f32(v1[0], v1[1], 0, false); t = __builtin_amdgcn_cvt_pk_fp8_f32(v1[2], v1[3], t, true); w.y = (unsigned)t; }
                    *(u32x2e*)(rowp + bj * HALF) = w; } }
    }
};
struct EpiInProj {
    static constexpr bool PERM = true, AFTER_DRAIN = false;
    bf16_t* O; int ldc; const float* rope; int rope_lo, rope_hi, lat_rows; float scale;
    __device__ __forceinline__ void operator()(const f32x4 (&acc)[2][2][4][2], const Unit& u, int wr, int wc, int fr, int fq) const {
        const int row0 = u.pm * BM + wr * 64 + fr, col0 = u.pn * BM + wc * 32 + 8 * fq;
        const bool do_rope = (u.pn >= rope_lo) && (u.pn < rope_hi) && (u.pm * BM < lat_rows);
        const int i0 = 16 * (wc & 1) + 4 * fq, half = wc >> 1;
        float one = scale; asm volatile("" : "+v"(one));
#pragma unroll
        for (int ai = 0; ai < 2; ++ai)
#pragma unroll
            for (int m = 0; m < 4; ++m) { const int row = row0 + ai * HALF + m * 16; bf16_t* rowp = O + (size_t)row * ldc + col0;
                f32x4 cs0 = {1.f, 0.f, 1.f, 0.f}, cs1 = {1.f, 0.f, 1.f, 0.f};
                if (do_rope) { const int s = row & 8191, pos = half ? (s & 63) : (s >> 6); const f32x4* tp = (const f32x4*)(rope + (size_t)(pos * 32 + i0) * 2); cs0 = tp[0]; cs1 = tp[1]; }
#pragma unroll
                for (int bj = 0; bj < 2; ++bj) { f32x4 v0 = acc[ai][bj][m][0] * one, v1 = acc[ai][bj][m][1] * one;
                    if (do_rope) {
                        const f32x4 a = v0, b = v1;
                        v0[0] = a[0] * cs0[0] - a[1] * cs0[1]; v0[1] = a[1] * cs0[0] + a[0] * cs0[1];
                        v0[2] = a[2] * cs0[2] - a[3] * cs0[3]; v0[3] = a[3] * cs0[2] + a[2] * cs0[3];
                        v1[0] = b[0] * cs1[0] - b[1] * cs1[1]; v1[1] = b[1] * cs1[0] + b[0] * cs1[1];
                        v1[2] = b[2] * cs1[2] - b[3] * cs1[3]; v1[3] = b[3] * cs1[2] + b[2] * cs1[3];
                    }
                    u32x4 w; w.x = cvt_pk_bf16(v0[0], v0[1]); w.y = cvt_pk_bf16(v0[2], v0[3]); w.z = cvt_pk_bf16(v1[0], v1[1]); w.w = cvt_pk_bf16(v1[2], v1[3]);
                    *(u32x4*)(rowp + bj * HALF) = w; } }
    }
};
struct EpiRes {
    static constexpr bool PERM = true, AFTER_DRAIN = false;
    const void* xin; bf16_t* xout; const void* cin; bf16_t* cout; const float* gate;
    int ldc, lat_rows, gstride; float scale; int in_f32;
    __device__ __forceinline__ void operator()(const f32x4 (&acc)[2][2][4][2], const Unit& u, int wr, int wc, int fr, int fq) const {
        const int row0 = u.pm * BM + wr * 64 + fr, col0 = u.pn * BM + wc * 32 + 8 * fq;
        const bool isc = u.pm * BM >= lat_rows;
        const int vs = isc ? 2 : ((u.pm * BM) >> 13), rsub = isc ? lat_rows : 0;
        const void* bp = isc ? cin : xin; bf16_t* op = isc ? cout : xout;
        f32x4 gv[2][2];
#pragma unroll
        for (int bj = 0; bj < 2; ++bj)
#pragma unroll
            for (int n = 0; n < 2; ++n) { typedef int i32x4 __attribute__((ext_vector_type(4))); const i32x4 q = *(const i32x4*)(gate + (size_t)vs * gstride + col0 + bj * HALF + 4 * n);
                gv[bj][n] = (f32x4){(float)q[0], (float)q[1], (float)q[2], (float)q[3]} * (scale * (1.f / 16777216.f)); }
#pragma unroll
        for (int ai = 0; ai < 2; ++ai)
#pragma unroll
        for (int mh = 0; mh < 2; ++mh) {
            if (in_f32) {
                f32x4 bb[2][2][2];
#pragma unroll
                for (int mm = 0; mm < 2; ++mm)
#pragma unroll
                    for (int bj = 0; bj < 2; ++bj) { const float* q = (const float*)bp + (size_t)(row0 - rsub + ai * HALF + (2 * mh + mm) * 16) * ldc + col0 + bj * HALF; bb[mm][bj][0] = *(const f32x4*)q; bb[mm][bj][1] = *(const f32x4*)(q + 4); }
#pragma unroll
                for (int mm = 0; mm < 2; ++mm)
#pragma unroll
                    for (int bj = 0; bj < 2; ++bj) { const int m = 2 * mh + mm; const size_t off = (size_t)(row0 - rsub + ai * HALF + m * 16) * ldc + col0 + bj * HALF;
                        const f32x4 o0 = bb[mm][bj][0] + gv[bj][0] * acc[ai][bj][m][0], o1 = bb[mm][bj][1] + gv[bj][1] * acc[ai][bj][m][1];
                        u32x4 w; w.x = cvt_pk_bf16(o0[0], o0[1]); w.y = cvt_pk_bf16(o0[2], o0[3]); w.z = cvt_pk_bf16(o1[0], o1[1]); w.w = cvt_pk_bf16(o1[2], o1[3]);
                        *(u32x4*)(op + off) = w; }
            } else {
                u32x4 bw[2][2];
#pragma unroll
                for (int mm = 0; mm < 2; ++mm)
#pragma unroll
                    for (int bj = 0; bj < 2; ++bj) bw[mm][bj] = *(const u32x4*)((const bf16_t*)bp + (size_t)(row0 - rsub + ai * HALF + (2 * mh + mm) * 16) * ldc + col0 + bj * HALF);
#pragma unroll
                for (int mm = 0; mm < 2; ++mm)
#pragma unroll
                    for (int bj = 0; bj < 2; ++bj) { const int m = 2 * mh + mm; const size_t off = (size_t)(row0 - rsub + ai * HALF + m * 16) * ldc + col0 + bj * HALF; const u32x4 w0 = bw[mm][bj];
                        const f32x4 b0 = (f32x4){__builtin_bit_cast(float, w0.x << 16), __builtin_bit_cast(float, w0.x & 0xffff0000u), __builtin_bit_cast(float, w0.y << 16), __builtin_bit_cast(float, w0.y & 0xffff0000u)};
                        const f32x4 b1 = (f32x4){__builtin_bit_cast(float, w0.z << 16), __builtin_bit_cast(float, w0.z & 0xffff0000u), __builtin_bit_cast(float, w0.w << 16), __builtin_bit_cast(float, w0.w & 0xffff0000u)};
                        const f32x4 o0 = b0 + gv[bj][0] * acc[ai][bj][m][0], o1 = b1 + gv[bj][1] * acc[ai][bj][m][1];
                        u32x4 w; w.x = cvt_pk_bf16(o0[0], o0[1]); w.y = cvt_pk_bf16(o0[2], o0[3]); w.z = cvt_pk_bf16(o1[0], o1[1]); w.w = cvt_pk_bf16(o1[2], o1[3]);
                        *(u32x4*)(op + off) = w; }
            }
        }
    }
};
__device__ __forceinline__ unsigned pack4_fp8(float a, float b, float c, float d) { int w = __builtin_amdgcn_cvt_pk_fp8_f32(a, b, 0, false); w = __builtin_amdgcn_cvt_pk_fp8_f32(c, d, w, true); return (unsigned)w; }
struct EpiGateUp {
    static constexpr bool PERM = true, AFTER_DRAIN = false;
    unsigned char* O; int ldc; float wscale;
    __device__ __forceinline__ void operator()(const f32x4 (&acc)[2][2][4][2], const Unit& u, int wr, int wc, int fr, int fq) const {
        const int row0 = u.pm * BM + wr * 64 + fr, col0 = (u.pn * BM + wc * 32 + 8 * fq) >> 1;
        float ws = wscale; asm volatile("" : "+v"(ws));
#pragma unroll
        for (int ai = 0; ai < 2; ++ai)
#pragma unroll
            for (int m = 0; m < 4; ++m) { unsigned char* rowp = O + (size_t)(row0 + ai * HALF + m * 16) * ldc + col0;
#pragma unroll
                for (int bj = 0; bj < 2; ++bj) { const f32x4 g = acc[ai][bj][m][0] * ws, up = acc[ai][bj][m][1] * ws; f32x4 a;
#pragma unroll
                    for (int i = 0; i < 4; ++i) a[i] = g[i] * __builtin_amdgcn_rcpf(1.f + __expf(-g[i])) * up[i];
                    *(unsigned*)(rowp + bj * (HALF / 2)) = pack4_fp8(a[0], a[1], a[2], a[3]); } }
    }
};
template <bool SKIP, bool GATH = false> struct GroupedOrderT {
    static constexpr bool SKIP_HI = SKIP, GATHER = GATH;
    static constexpr int nN = 8;
    int G, c, nblk; const PG8_LAS int* blk_e; const PG8_LAS int* blk_h; long estride; const PG8_LAS unsigned* rowtab;
    __device__ __forceinline__ bool next(int i, Unit& u) const {
        const int L = i * G + c; if (L >= nblk * nN) return false;
        u.pm = L >> 3; u.pn = L & 7; u.boff = (long)__builtin_amdgcn_readfirstlane(blk_e[u.pm]) * estride; u.lo_only = __builtin_amdgcn_readfirstlane(blk_h[u.pm]); return true;
    }
    __device__ __forceinline__ void a_ready(const Unit&) const {}
    __device__ __forceinline__ void done(const Unit&) const {}
};
}
constexpr int DM = 2048, T_LAT = 16384, T_CTX = 512, T_ALL = 16896, SEQL = 8192, CTXL = 256;
constexpr int NIN = 5152, NINP = 5376;
constexpr int C_QA = 0, C_KA = 512, C_VA = 1024, C_QB = 1536, C_KB = 2048, C_VB = 2304, C_Z = 2560, C_XBC = 3584, C_DT = 5120;
constexpr int XBCW = 1536, DFF = 1024, NEXP = 32, MODW = 12288;
constexpr float EPS = 1e-6f, ATT_SCALE = 0.088388347648318440f;
constexpr int MAXBLK = 165, MAXSLOT = MAXBLK * 256;
constexpr int NWAVES = 8;

constexpr size_t MiB = 1u << 20;
constexpr size_t WS_CTL = 0, CTL_ZERO_BYTES = 2 * MiB;
constexpr int CW_BAR = 4096;
constexpr size_t OFF_Q = 32768;
constexpr size_t OFF_CNT = 65536;
constexpr size_t OFF_MOD = 1 * MiB;
constexpr size_t WS_ROPE = 2 * MiB;
constexpr size_t WS_WRT = 3 * MiB;
constexpr size_t WS_WIN = 8 * MiB;
constexpr size_t WS_WOUT = 50 * MiB;
constexpr size_t WS_WGU = 66 * MiB;
constexpr size_t WS_WDN = 578 * MiB;
constexpr size_t WS_H = 834 * MiB;
constexpr size_t WS_U = 900 * MiB;
constexpr size_t WS_X = 1074 * MiB;
constexpr size_t WS_XC = 1202 * MiB;
constexpr size_t WS_XBC = 1206 * MiB;
constexpr size_t WS_DT = 1256 * MiB;
constexpr size_t WS_YD = 1260 * MiB;
constexpr size_t WS_XG = 1392 * MiB;
constexpr size_t WS_ACT = 1557 * MiB;
constexpr size_t WS_YB = 1640 * MiB;
constexpr size_t WS_TOK = 1805 * MiB;
constexpr size_t WS_END = 1808 * MiB;
constexpr size_t WS_LIST = WS_XG + 64 * MiB;
constexpr int LCAP = 2 * T_ALL;
constexpr unsigned ZERO_OFF = 1536u * 1024u;
constexpr size_t TOKTAB = (size_t)T_ALL * 2 * 4;
static_assert(WS_WIN + (size_t)2 * NINP * DM * 2 <= WS_WOUT && WS_WGU + (size_t)2 * 32 * 2048 * 2048 * 2 <= WS_WDN && WS_WDN + (size_t)2 * 32 * 2048 * 1024 * 2 <= WS_H, "ws map 1");
static_assert(WS_H + (size_t)T_ALL * DM * 2 <= WS_U && WS_U + (size_t)T_ALL * NINP * 2 <= WS_X && WS_X + (size_t)T_LAT * DM * 4 <= WS_XC && WS_XBC + (size_t)T_ALL * XBCW * 2 <= WS_DT, "ws map 2");
static_assert(WS_DT + (size_t)T_ALL * 32 * 4 <= WS_YD && WS_YD + (size_t)2 * T_ALL * 1024 * 4 <= WS_XG && WS_XG + (size_t)MAXSLOT * DM * 2 <= WS_ACT && WS_ACT + (size_t)MAXSLOT * DFF * 2 <= WS_YB && WS_YB + (size_t)MAXSLOT * DM * 2 <= WS_TOK && WS_TOK + 4 * TOKTAB <= WS_END, "ws map 3");

constexpr int RING_BYTES = 131072, LDSCTL_OFF = RING_BYTES, LDS_BYTES = 147456;
constexpr int L_BARW = LDSCTL_OFF;
constexpr int L_BWORK = LDSCTL_OFF + 32;
constexpr int L_SEG = LDSCTL_OFF + 64;
constexpr int L_CNT = LDSCTL_OFF + 256;
constexpr int L_BLKE = LDSCTL_OFF + 512;
constexpr int L_NBLK = LDSCTL_OFF + 1536;
constexpr int L_INCL = LDSCTL_OFF + 1600;
constexpr int L_PB = LDSCTL_OFF + 1792;
constexpr int L_ROWT = LDSCTL_OFF + 4096;
constexpr int L_BLKH = LDSCTL_OFF + 2048;

#define GAS __attribute__((address_space(1)))
#define LAS __attribute__((address_space(3)))
typedef unsigned short bf16;
typedef unsigned v4u __attribute__((ext_vector_type(4)));
typedef unsigned v2u __attribute__((ext_vector_type(2)));
typedef float f32x4 __attribute__((ext_vector_type(4)));
typedef float f32x2 __attribute__((ext_vector_type(2)));
typedef short bf16x8 __attribute__((ext_vector_type(8)));
#define LDS_WAIT() asm volatile("s_waitcnt lgkmcnt(0)" ::: "memory")
#define VM_WAIT() asm volatile("s_waitcnt vmcnt(0)" ::: "memory")
__device__ __forceinline__ unsigned f2bf(float f) { unsigned u = __builtin_bit_cast(unsigned, f); return (u + 0x7fffu + ((u >> 16) & 1u)) >> 16; }
__device__ __forceinline__ unsigned pk2(float lo, float hi) { return f2bf(lo) | (f2bf(hi) << 16); }
__device__ __forceinline__ float bflo(unsigned w) { return __builtin_bit_cast(float, w << 16); }
__device__ __forceinline__ float bfhi(unsigned w) { return __builtin_bit_cast(float, w & 0xffff0000u); }
__device__ __forceinline__ float bf2f(bf16 b) { return __builtin_bit_cast(float, (unsigned)b << 16); }
__device__ __forceinline__ float wave_sum(float v) {
#pragma unroll
    for (int o = 1; o < 64; o <<= 1) v += __shfl_xor(v, o);
    return v;
}
__device__ __forceinline__ float wave_max(float v) {
#pragma unroll
    for (int o = 1; o < 64; o <<= 1) v = fmaxf(v, __shfl_xor(v, o));
    return v;
}
__device__ __forceinline__ float silu_f(float x) { return x / (1.f + __expf(-x)); }
__device__ __forceinline__ float sigmoid_f(float x) { return 1.f / (1.f + __expf(-x)); }
__device__ __forceinline__ float softplus_f(float x) { return x > 20.f ? x : log1pf(__expf(x)); }

#define XB_TMO      128
#define XB_XCNT(j)  (256  + 64 * (j))
#define XB_XSUB(j)  (1280 + 64 * (j))
#define XB_XGEN(j)  (2304 + 64 * (j))
#define XB_TOP      3328
#define XB_TOPGEN   3392
#define XCD_BAR_WORDS 3456
#define XB_SPIN_CAP (1u << 18)


__device__ __forceinline__ unsigned xb_ld(unsigned* p)              { return __hip_atomic_load(p, __ATOMIC_RELAXED, __HIP_MEMORY_SCOPE_AGENT); }
__device__ __forceinline__ unsigned xb_add(unsigned* p, unsigned v) { return __hip_atomic_fetch_add(p, v, __ATOMIC_RELAXED, __HIP_MEMORY_SCOPE_AGENT); }
__device__ __forceinline__ unsigned xb_xcc_id() { return (unsigned)__builtin_amdgcn_s_getreg((3 << 11) | 20) & 0xFu; }
#define XB_SPIN(cond, bar) do { unsigned _sp = 0; while (cond) { __builtin_amdgcn_s_sleep(1); \
    if ((++_sp & 255u) == 0u) { if (xb_ld(&(bar)[XB_TMO])) break; if (_sp > XB_SPIN_CAP) { atomicAdd(&(bar)[XB_TMO], 1u); break; } } } } while (0)

struct XcdBarrier {
    unsigned* bar; unsigned x;
    volatile LAS unsigned* st;
};

__device__ __forceinline__ XcdBarrier xcd_barrier_post(unsigned* bar, volatile LAS unsigned* st) {
    XcdBarrier b; b.bar = bar; b.x = xb_xcc_id(); b.st = st;
    if (threadIdx.x == 0) (void)xb_add(&bar[XB_XCNT(b.x)], 1u);
    return b;
}
__device__ __forceinline__ void xcd_barrier_complete(unsigned* bar, unsigned x, unsigned& nloc, unsigned& nx) {
    const unsigned G = gridDim.x * gridDim.y * gridDim.z;
    unsigned sum, cnt, mine, sp = 0u;
    for (;;) {
        sum = 0u; cnt = 0u; mine = 0u;
#pragma unroll
        for (unsigned j = 0; j < 16; ++j) { const unsigned c = xb_ld(&bar[XB_XCNT(j)]); sum += c; cnt += (c > 0u) ? 1u : 0u; mine = (j == x) ? c : mine; }
        if (sum == G) break;
        __builtin_amdgcn_s_sleep(1);
        if ((++sp & 255u) == 0u) { if (xb_ld(&bar[XB_TMO])) break; if (sp > XB_SPIN_CAP) { atomicAdd(&bar[XB_TMO], 1u); break; } }
    }
    nloc = mine > 0u ? mine : 1u; nx = cnt > 0u ? cnt : 1u;
}

__device__ __forceinline__ void xcd_barrier(const XcdBarrier& b) {
    asm volatile("s_waitcnt vmcnt(0)" ::: "memory");
    __syncthreads();
    if (threadIdx.x == 0) {
        unsigned* bar = b.bar;
        __builtin_amdgcn_s_waitcnt(0);
        unsigned nloc = b.st[0], nx = b.st[1];
        if (nloc == 0u) { xcd_barrier_complete(bar, b.x, nloc, nx); b.st[0] = nloc; b.st[1] = nx; }
        const unsigned old = xb_add(&bar[XB_XSUB(b.x)], 1u);
        const unsigned gen = old / nloc;
        if (old + 1u == (gen + 1u) * nloc) {
            __builtin_amdgcn_fence(__ATOMIC_RELEASE, "agent");
            asm volatile("s_waitcnt vmcnt(0)" ::: "memory");
            const unsigned og = xb_add(&bar[XB_TOP], 1u);
            const unsigned tg = og / nx;
            if (og + 1u == (tg + 1u) * nx) xb_add(&bar[XB_TOPGEN], 1u);
            else XB_SPIN(xb_ld(&bar[XB_TOPGEN]) == tg, bar);
            __builtin_amdgcn_fence(__ATOMIC_ACQUIRE, "agent");
            xb_add(&bar[XB_XGEN(b.x)], 1u);
            asm volatile("s_waitcnt vmcnt(0)" ::: "memory");
        } else {
            XB_SPIN(xb_ld(&bar[XB_XGEN(b.x)]) == gen, bar);
            __builtin_amdgcn_fence(__ATOMIC_ACQUIRE, "agent");
            asm volatile("s_waitcnt vmcnt(0)" ::: "memory");
        }
    }
    __syncthreads();
}
struct Prm {
    const float *x, *c, *ctx, *c_ctx, *w_ada, *b_ada, *norm_mix, *norm_ffn, *norm_final, *w_in, *w_out, *na_rpb, *wa_sink,
                *conv_w, *conv_b, *a_log, *dt_bias, *d_skip, *ssd_norm, *w_router, *router_bias, *w_gate, *w_up, *w_down;
    float* out; unsigned char* ws; int ph_lo, ph_hi;
};

__device__ __forceinline__ int perm_in(int n) {
    if (n >= C_QB && n < C_VB) { const int p = (n - C_QB) & 127, hb = n - p, half = p >> 6, pp = p & 63; return hb + half * 64 + (pp >> 1) + 32 * (pp & 1); }
    return n;
}
__device__ __forceinline__ unsigned pack4f8(float a, float b, float c, float d) { int w = __builtin_amdgcn_cvt_pk_fp8_f32(a, b, 0, false); w = __builtin_amdgcn_cvt_pk_fp8_f32(c, d, w, true); return (unsigned)w; }
#ifndef CONV_QUEUE
#define CONV_QUEUE 1
#endif
constexpr float W8_SCALE = 64.f, MIX_SCALE = 8.f, Y8_SCALE = 8.f;
struct TDesc { const float* colp; size_t ld; unsigned char* wt; int ok, k0, K, n0; };
constexpr int TK_IN = 2 * 32 * (NINP / 32), TK_OUT = 2 * 32 * 64, TK_GU = 2 * 32 * 32 * 64, TK_DN = 2 * 32 * 16 * 64, TK_RT = 32;
template <bool F8SEL> __device__ __forceinline__ constexpr int t_count() {
    return ((F8_INPROJ != 0) == F8SEL ? TK_IN : 0) + ((F8_OUTPROJ != 0) == F8SEL ? TK_OUT : 0) + (F8SEL ? TK_GU + TK_DN : TK_RT);
}
template <bool F8SEL> __device__ __forceinline__ TDesc t_decode(const Prm& p, int it, int lane) {
    unsigned char* ws = p.ws; TDesc d; int r = it;
    if ((F8_INPROJ != 0) == F8SEL) { if (r < TK_IN) { const int sub = r & 1, r2 = r >> 1, l = r2 / (TK_IN / 4), q = r2 % (TK_IN / 4), kb = 2 * (q / (NINP / 32)) + sub, nb = q % (NINP / 32), nn = 32 * nb + (lane & 31); const bool ok = nn < NIN;
            d.colp = p.w_in + (size_t)l * DM * NIN + (ok ? perm_in(nn) : 0); d.ld = NIN; d.ok = ok; d.K = 2048; d.wt = ws + WS_WIN + (size_t)l * NINP * DM * (F8_INPROJ ? 1 : 2); d.n0 = 32 * nb; d.k0 = 64 * kb; return d; } r -= TK_IN; }
    if ((F8_OUTPROJ != 0) == F8SEL) { if (r < TK_OUT) { const int sub = r & 1, r2 = r >> 1, l = r2 / (TK_OUT / 4), q = r2 % (TK_OUT / 4), kb = 2 * (q / 64) + sub, nb = q % 64, nn = 32 * nb + (lane & 31);
            d.colp = p.w_out + (size_t)l * DM * DM + nn; d.ld = DM; d.ok = 1; d.K = 2048; d.wt = ws + WS_WOUT + (size_t)l * DM * DM * (F8_OUTPROJ ? 1 : 2); d.n0 = 32 * nb; d.k0 = 64 * kb; return d; } r -= TK_OUT; }
    if (F8SEL) {
        if (r < TK_GU) { const int sub = r & 1, r2 = r >> 1, le = r2 / 1024, q = r2 % 1024, kb = 2 * (q / 64) + sub, nb = q % 64, nn = 32 * nb + (lane & 31), j = nn >> 3, t = nn & 7;
            d.colp = (t < 4 ? p.w_gate : p.w_up) + (size_t)le * 2048 * 1024 + 4 * j + (t & 3); d.ld = 1024; d.ok = 1; d.K = 2048; d.wt = ws + WS_WGU + (size_t)le * 2048 * 2048; d.n0 = 32 * nb; d.k0 = 64 * kb; return d; }
        r -= TK_GU;
        { const int sub = r & 1, r2 = r >> 1, le = r2 / 512, q = r2 % 512, kb = 2 * (q / 64) + sub, nb = q % 64, nn = 32 * nb + (lane & 31);
            d.colp = p.w_down + (size_t)le * 1024 * 2048 + nn; d.ld = 2048; d.ok = 1; d.K = 1024; d.wt = ws + WS_WDN + (size_t)le * 2048 * 1024; d.n0 = 32 * nb; d.k0 = 64 * kb; return d; }
    } else { const int kb = r; d.colp = p.w_router + (lane & 31); d.ld = 32; d.ok = 1; d.K = 2048; d.wt = ws + WS_WRT; d.n0 = 0; d.k0 = 64 * kb; return d; }
}
__device__ __forceinline__ void t_load(const TDesc& d, float (&tv)[32], int lane) {
#pragma unroll
    for (int i = 0; i < 32; ++i) tv[i] = d.colp[(size_t)(d.k0 + 2 * i + (lane >> 5)) * d.ld];
}
template <bool F8> __device__ __forceinline__ void t_lds_in(const TDesc& d, const float (&tv)[32], LAS float* scr, int lane) {
#pragma unroll
    for (int i = 0; i < 32; ++i) scr[(2 * i + (lane >> 5)) * 33 + (lane & 31)] = d.ok ? tv[i] : 0.f;
    LDS_WAIT(); asm volatile("" ::: "memory");
}
template <bool F8> __device__ __forceinline__ void t_out(const TDesc& d, LAS float* scr, int lane) {
    const int c = lane & 7;
#pragma unroll
    for (int j = 0; j < 4; ++j) { const int n = (lane >> 3) + 8 * j; const LAS float* s = scr + (8 * c) * 33 + n;
        if constexpr (F8) { v2u o; o.x = pack4f8(s[0 * 33] * W8_SCALE, s[1 * 33] * W8_SCALE, s[2 * 33] * W8_SCALE, s[3 * 33] * W8_SCALE); o.y = pack4f8(s[4 * 33] * W8_SCALE, s[5 * 33] * W8_SCALE, s[6 * 33] * W8_SCALE, s[7 * 33] * W8_SCALE);
            *(v2u*)(d.wt + (size_t)(d.n0 + n) * d.K + d.k0 + 8 * c) = o; }
        else { v4u o; o.x = pk2(s[0 * 33], s[1 * 33]); o.y = pk2(s[2 * 33], s[3 * 33]); o.z = pk2(s[4 * 33], s[5 * 33]); o.w = pk2(s[6 * 33], s[7 * 33]);
            *(v4u*)((bf16*)d.wt + (size_t)(d.n0 + n) * d.K + d.k0 + 8 * c) = o; } }
    LDS_WAIT(); asm volatile("" ::: "memory");
}
__device__ __forceinline__ void t_cvt8(LAS float* scr, int lane, v2u (&o)[4]) {
    const int c = lane & 7;
#pragma unroll
    for (int j = 0; j < 4; ++j) { const int n = (lane >> 3) + 8 * j; const LAS float* s = scr + (8 * c) * 33 + n;
        o[j].x = pack4f8(s[0 * 33] * W8_SCALE, s[1 * 33] * W8_SCALE, s[2 * 33] * W8_SCALE, s[3 * 33] * W8_SCALE); o[j].y = pack4f8(s[4 * 33] * W8_SCALE, s[5 * 33] * W8_SCALE, s[6 * 33] * W8_SCALE, s[7 * 33] * W8_SCALE); }
    LDS_WAIT(); asm volatile("" ::: "memory");
}
constexpr int TL_IN = 32 * (NINP / 32), TL_OUT = 32 * 64, TL_GU = 32 * 32 * 64, TL_DN = 32 * 16 * 64, TL_ALL = TL_IN + TL_OUT + TL_GU + TL_DN, NPL = TL_ALL / 2;
static_assert(F8_INPROJ && F8_OUTPROJ, "the per-layer conversion queue assumes fp8 copies of every GEMM weight");
__device__ __forceinline__ TDesc t_decode_layer(const Prm& p, int l, int it, int lane) {
    unsigned char* ws = p.ws; TDesc d; int r = it; const int sub = r & 1;
    if (r < TL_IN) { const int q = r >> 1, kb = 2 * (q / (NINP / 32)) + sub, nb = q % (NINP / 32), nn = 32 * nb + (lane & 31); const bool ok = nn < NIN;
        d.colp = p.w_in + (size_t)l * DM * NIN + (ok ? perm_in(nn) : 0); d.ld = NIN; d.ok = ok; d.K = 2048; d.wt = ws + WS_WIN + (size_t)l * NINP * DM; d.n0 = 32 * nb; d.k0 = 64 * kb; return d; }
    r -= TL_IN;
    if (r < TL_OUT) { const int q = r >> 1, kb = 2 * (q / 64) + sub, nb = q % 64, nn = 32 * nb + (lane & 31);
        d.colp = p.w_out + (size_t)l * DM * DM + nn; d.ld = DM; d.ok = 1; d.K = 2048; d.wt = ws + WS_WOUT + (size_t)l * DM * DM; d.n0 = 32 * nb; d.k0 = 64 * kb; return d; }
    r -= TL_OUT;
    if (r < TL_GU) { const int r2 = r >> 1, le = l * 32 + r2 / 1024, q = r2 % 1024, kb = 2 * (q / 64) + sub, nb = q % 64, nn = 32 * nb + (lane & 31), j = nn >> 3, t = nn & 7;
        d.colp = (t < 4 ? p.w_gate : p.w_up) + (size_t)le * 2048 * 1024 + 4 * j + (t & 3); d.ld = 1024; d.ok = 1; d.K = 2048; d.wt = ws + WS_WGU + (size_t)le * 2048 * 2048; d.n0 = 32 * nb; d.k0 = 64 * kb; return d; }
    r -= TL_GU;
    { const int r2 = r >> 1, le = l * 32 + r2 / 512, q = r2 % 512, kb = 2 * (q / 64) + sub, nb = q % 64, nn = 32 * nb + (lane & 31);
        d.colp = p.w_down + (size_t)le * 1024 * 2048 + nn; d.ld = 2048; d.ok = 1; d.K = 1024; d.wt = ws + WS_WDN + (size_t)le * 2048 * 1024; d.n0 = 32 * nb; d.k0 = 64 * kb; return d; }
}
__device__ __forceinline__ void t_pair_store(const TDesc& dS, const v2u (&oa)[4], const v2u (&ob)[4], int lane) {
    const int c = lane & 7, odd = c & 1;
#pragma unroll
    for (int j = 0; j < 4; ++j) { const int n = (lane >> 3) + 8 * j;
        const v2u snd = odd ? oa[j] : ob[j]; v2u got; got.x = (unsigned)__builtin_amdgcn_update_dpp(0, (int)snd.x, 0xB1, 0xF, 0xF, false); got.y = (unsigned)__builtin_amdgcn_update_dpp(0, (int)snd.y, 0xB1, 0xF, 0xF, false);
        v4u w; if (odd) { w.x = got.x; w.y = got.y; w.z = ob[j].x; w.w = ob[j].y; } else { w.x = oa[j].x; w.y = oa[j].y; w.z = got.x; w.w = got.y; }
        *(v4u*)(dS.wt + (size_t)(dS.n0 + n) * dS.K + dS.k0 + (odd ? 64 : 0) + 16 * (c >> 1)) = w; }
}
constexpr int NP_PROJ = (TL_IN + TL_OUT) / 2, NP_EXP = (TL_GU + TL_DN) / 2;
__device__ __forceinline__ void t_convert_pairs(const Prm& p, int l, int npairs, LAS float* scr, int gw, int ngw, int lane) {
    if (gw >= npairs) return;
    TDesc dA = t_decode_layer(p, l, 2 * gw, lane), dB = t_decode_layer(p, l, 2 * gw + 1, lane); float ta[32], tb[32]; t_load(dA, ta, lane); t_load(dB, tb, lane);
#pragma unroll 1
    for (int pi = gw; pi < npairs; pi += ngw) {
        v2u oa[4], ob[4];
        t_lds_in<true>(dA, ta, scr, lane); t_cvt8(scr, lane, oa);
        t_lds_in<true>(dB, tb, scr, lane);
        const TDesc dS = dA; const int pn = pi + ngw;
        if (pn < npairs) { dA = t_decode_layer(p, l, 2 * pn, lane); dB = t_decode_layer(p, l, 2 * pn + 1, lane); t_load(dA, ta, lane); t_load(dB, tb, lane); }
        t_cvt8(scr, lane, ob);
        t_pair_store(dS, oa, ob, lane);
    }
}
__device__ __forceinline__ void t_convert_two(const Prm& p, int l, int pi0, int pi1, bool has1, LAS float* scr, int lane) {
    const TDesc dA = t_decode_layer(p, l, 2 * pi0, lane), dB = t_decode_layer(p, l, 2 * pi0 + 1, lane), dC = t_decode_layer(p, l, 2 * pi1, lane), dD = t_decode_layer(p, l, 2 * pi1 + 1, lane);
    float ta[32], tb[32], tc[32], td[32]; t_load(dA, ta, lane); t_load(dB, tb, lane); t_load(dC, tc, lane); t_load(dD, td, lane);
    v2u oa[4], ob[4];
    t_lds_in<true>(dA, ta, scr, lane); t_cvt8(scr, lane, oa);
    t_lds_in<true>(dB, tb, scr, lane); t_cvt8(scr, lane, ob);
    t_pair_store(dA, oa, ob, lane);
    if (has1) {
        t_lds_in<true>(dC, tc, scr, lane); t_cvt8(scr, lane, oa);
        t_lds_in<true>(dD, td, scr, lane); t_cvt8(scr, lane, ob);
        t_pair_store(dC, oa, ob, lane);
    }
}
__device__ __forceinline__ void t_convert_one(const Prm& p, int l, int pi, LAS float* scr, int lane) {
    const TDesc dA = t_decode_layer(p, l, 2 * pi, lane), dB = t_decode_layer(p, l, 2 * pi + 1, lane); float ta[32], tb[32]; t_load(dA, ta, lane); t_load(dB, tb, lane);
    v2u oa[4], ob[4];
    t_lds_in<true>(dA, ta, scr, lane); t_cvt8(scr, lane, oa);
    t_lds_in<true>(dB, tb, scr, lane); t_cvt8(scr, lane, ob);
    t_pair_store(dA, oa, ob, lane);
}
template <bool F8SEL> __device__ __forceinline__ void t_convert_all(const Prm& p, LAS float* scr, int gw, int ngw, int lane) {
    constexpr int N = t_count<F8SEL>();
    if (2 * gw >= N) return;
    TDesc d0 = t_decode<F8SEL>(p, 2 * gw, lane); float tv[32]; t_load(d0, tv, lane);
#pragma unroll 1
    for (int it = 2 * gw; it < N; ) {
        t_lds_in<F8SEL>(d0, tv, scr, lane);
        const int itn = (it & 1) ? it - 1 + 2 * ngw : it + 1; TDesc d1 = d0;
        if (itn < N) { d1 = t_decode<F8SEL>(p, itn, lane); t_load(d1, tv, lane); }
        t_out<F8SEL>(d0, scr, lane);
        d0 = d1; it = itn;
    }
}
__device__ __forceinline__ void phase_prologue(const Prm& p, LAS unsigned char* lds, int gw, int ngw, int wave, int lane, bool first) {
    LAS float* scr = (LAS float*)(lds + wave * 16384);
    unsigned char* ws = p.ws;
    t_convert_pairs(p, 0, NPL, scr, gw, ngw, lane);
    if (!CONV_QUEUE) t_convert_pairs(p, 1, NPL, scr, gw, ngw, lane);
    t_convert_all<false>(p, scr, gw, ngw, lane);
    int* mod = (int*)(ws + OFF_MOD);
    for (int it = gw; first && it < 2 * 32 * 48; it += ngw) {
        const int l = it / (32 * 48), q = it % (32 * 48), kc = q / 48, nc = q % 48, k0 = 64 * kc, n0 = 256 * nc + 4 * lane;
        scr[lane] = silu_f(p.c[k0 + lane]); scr[64 + lane] = silu_f(p.c[DM + k0 + lane]); scr[128 + lane] = silu_f(p.c_ctx[k0 + lane]);
        LDS_WAIT(); asm volatile("" ::: "memory");
        f32x4 a0 = {0.f, 0.f, 0.f, 0.f}, a1 = a0, a2 = a0;
        const float* wp = p.w_ada + ((size_t)l * DM + k0) * MODW + n0;
#pragma unroll 8
        for (int kk = 0; kk < 64; ++kk) { const f32x4 w = *(const f32x4*)(wp + (size_t)kk * MODW); a0 += w * scr[kk]; a1 += w * scr[64 + kk]; a2 += w * scr[128 + kk]; }
        if (kc == 0) { const f32x4 bb = *(const f32x4*)(p.b_ada + (size_t)l * MODW + n0); a0 += bb; a1 += bb; a2 += bb; }
        int* m0 = mod + (size_t)(l * 3) * MODW + n0;
#pragma unroll
        for (int i = 0; i < 4; ++i) { atomicAdd(m0 + i, (int)rintf(a0[i] * 16777216.f)); atomicAdd(m0 + MODW + i, (int)rintf(a1[i] * 16777216.f)); atomicAdd(m0 + 2 * MODW + i, (int)rintf(a2[i] * 16777216.f)); }
        LDS_WAIT(); asm volatile("" ::: "memory");
    }
    for (int it = gw * 64 + lane; it < 128 * 32; it += ngw * 64) { const int pos = it >> 5, i = it & 31; const float inv = powf(10000.f, -(float)i / 32.f), ang = (float)pos * inv;
        ((float*)(ws + WS_ROPE))[2 * it] = cosf(ang); ((float*)(ws + WS_ROPE))[2 * it + 1] = sinf(ang); }
}

__device__ __forceinline__ f32x4 modv4(const float* p) {
    typedef int i32x4 __attribute__((ext_vector_type(4)));
    const i32x4 v = *(const i32x4*)p; return (f32x4){(float)v[0], (float)v[1], (float)v[2], (float)v[3]} * (1.f / 16777216.f);
}
__device__ __forceinline__ f32x4 bf4(v2u w) { return (f32x4){bflo(w.x), bfhi(w.x), bflo(w.y), bfhi(w.y)}; }
__device__ __forceinline__ void load_row(const Prm& p, int l, int lcomb, int m, int lane, f32x4 (&v)[8], bool wb = true, const LAS int* segL = nullptr) {
    const bool isc = m >= T_LAT;
    const bf16* wsrow = isc ? (const bf16*)(p.ws + WS_XC) + (size_t)(m - T_LAT) * DM : (const bf16*)(p.ws + WS_X) + (size_t)m * DM;
#pragma unroll
    for (int j = 0; j < 8; ++j) v[j] = bf4(*(const v2u*)(wsrow + 256 * j + 4 * lane));
}
__device__ __forceinline__ float row_rstd(const f32x4 (&v)[8]) {
    float s = 0.f;
#pragma unroll
    for (int j = 0; j < 8; ++j) s += (v[j][0] * v[j][0] + v[j][1] * v[j][1]) + (v[j][2] * v[j][2] + v[j][3] * v[j][3]);
    return rsqrtf(wave_sum(s) * (1.f / DM) + EPS);
}
__device__ __forceinline__ f32x4 modulate4f(const f32x4 v, float rstd, const float* gain, const float* sc, const float* sh, int col) {
    const f32x4 g = *(const f32x4*)(gain + col), s1 = modv4(sc + col), s0 = modv4(sh + col);
    return (v * rstd * g) * (s1 + 1.f) + s0;
}
__device__ __forceinline__ v2u modulate4(const f32x4 v, float rstd, const float* gain, const float* sc, const float* sh, int col) {
    const f32x4 g = *(const f32x4*)(gain + col), s1 = modv4(sc + col), s0 = modv4(sh + col);
    const f32x4 o = (v * rstd * g) * (s1 + 1.f) + s0;
    v2u w; w.x = pk2(o[0], o[1]); w.y = pk2(o[2], o[3]); return w;
}
constexpr int RS_A = 0, RS_SH = 3 * 8192, RS_GF = 6 * 8192, RS_END = 9 * 8192;
struct RowX { f32x4 x[8]; v2u xb[8]; unsigned ya[8], yb[8]; };
struct RowI { int s; float g; };
template <bool COMB> __device__ __forceinline__ RowI rs_idx_issue(const Prm& p, int m, int lane, int& e_out, int& pos_out) {
    RowI r; r.s = 0; r.g = 0.f; e_out = 0; pos_out = 0;
    if constexpr (COMB) { const int k = lane & 1; const int* te = (const int*)(p.ws + WS_TOK); const int* tp = (const int*)(p.ws + WS_TOK + TOKTAB); const float* tg = (const float*)(p.ws + WS_TOK + 2 * TOKTAB);
        e_out = te[2 * m + k]; pos_out = tp[2 * m + k]; r.g = tg[2 * m + k]; }
    return r;
}
template <bool COMB, bool SRC32> __device__ __forceinline__ void rs_issue(const Prm& p, int m, int s0, int s1, int lane, RowX& b) {
    const bool isc = m >= T_LAT;
    if constexpr (SRC32) { const float* src = isc ? p.ctx + (size_t)(m - T_LAT) * DM : p.x + (size_t)m * DM;
#pragma unroll
        for (int j = 0; j < 8; ++j) b.x[j] = *(const f32x4*)(src + 256 * j + 4 * lane); }
    else { const bf16* src = isc ? (const bf16*)(p.ws + WS_XC) + (size_t)(m - T_LAT) * DM : (const bf16*)(p.ws + WS_X) + (size_t)m * DM;
#pragma unroll
        for (int j = 0; j < 8; ++j) b.xb[j] = *(const v2u*)(src + 256 * j + 4 * lane); }
    if constexpr (COMB) { const unsigned char* y0 = p.ws + WS_YB + (size_t)s0 * DM; const unsigned char* y1 = p.ws + WS_YB + (size_t)s1 * DM;
#pragma unroll
        for (int j = 0; j < 8; ++j) { b.ya[j] = *(const unsigned*)(y0 + 256 * j + 4 * lane); b.yb[j] = *(const unsigned*)(y1 + 256 * j + 4 * lane); } }
}
template <bool COMB, bool FINAL, bool SRC32> __device__ __forceinline__ void rs_finish(const Prm& p, int l, int m, float g0, float g1, int lane, RowX& b, const LAS unsigned char* vl, bool live) {
    const bool isc = m >= T_LAT; const int vs = isc ? 2 : (m >> 13);
    const LAS float* A = (const LAS float*)(vl + RS_A) + vs * 2048; const LAS float* SH = (const LAS float*)(vl + RS_SH) + vs * 2048; const LAS float* GF = (const LAS float*)(vl + RS_GF) + vs * 2048;
    if constexpr (!SRC32) {
#pragma unroll
        for (int j = 0; j < 8; ++j) b.x[j] = bf4(b.xb[j]); }
    if constexpr (COMB) {
        bf16* wsrow = isc ? (bf16*)(p.ws + WS_XC) + (size_t)(m - T_LAT) * DM : (bf16*)(p.ws + WS_X) + (size_t)m * DM;
#pragma unroll
        for (int j = 0; j < 8; ++j) { const int col = 256 * j + 4 * lane; const unsigned a = b.ya[j], c = b.yb[j]; const f32x4 gq = *(const LAS f32x4*)(GF + col);
            const f32x2 a01 = __builtin_amdgcn_cvt_pk_f32_fp8(a, false), a23 = __builtin_amdgcn_cvt_pk_f32_fp8(a, true), c01 = __builtin_amdgcn_cvt_pk_f32_fp8(c, false), c23 = __builtin_amdgcn_cvt_pk_f32_fp8(c, true);
            b.x[j][0] += gq[0] * (g0 * a01[0] + g1 * c01[0]); b.x[j][1] += gq[1] * (g0 * a01[1] + g1 * c01[1]);
            b.x[j][2] += gq[2] * (g0 * a23[0] + g1 * c23[0]); b.x[j][3] += gq[3] * (g0 * a23[1] + g1 * c23[1]);
            if (!FINAL && live) { v2u w; w.x = pk2(b.x[j][0], b.x[j][1]); w.y = pk2(b.x[j][2], b.x[j][3]); *(v2u*)(wsrow + col) = w; } } }
    const float rstd = row_rstd(b.x);
    if (!live) return;
#pragma unroll
    for (int j = 0; j < 8; ++j) { const int col = 256 * j + 4 * lane; const f32x4 av = *(const LAS f32x4*)(A + col);
        if constexpr (FINAL) { *(f32x4*)(p.out + (size_t)m * DM + col) = b.x[j] * rstd * av; }
        else { const f32x4 o = b.x[j] * rstd * av + *(const LAS f32x4*)(SH + col);
            if (F8_INPROJ) *(unsigned*)(p.ws + WS_H + (size_t)m * DM + col) = pack4f8(o[0], o[1], o[2], o[3]);
            else { v2u w; w.x = pk2(o[0], o[1]); w.y = pk2(o[2], o[3]); *(v2u*)((bf16*)(p.ws + WS_H) + (size_t)m * DM + col) = w; } } }
}
template <bool COMB, bool FINAL, bool SRC32> __device__ __forceinline__ void row_stream(const Prm& p, int l, int lc, int nrows, int gw, int ngw, int tid, int lane, LAS unsigned char* vl, const LAS int* segL) {
    { const float* md = (const float*)(p.ws + OFF_MOD);
      for (int q = tid; q < 3 * 512; q += NWAVES * 64) { const int vs = q >> 9, c4 = (q & 511) * 4;
          if (FINAL) { if (vs == 0) *(LAS f32x4*)(vl + RS_A + (size_t)c4 * 4) = *(const f32x4*)(p.norm_final + c4); }
          else { const f32x4 gn = *(const f32x4*)(p.norm_mix + l * DM + c4), sc = modv4(md + (size_t)(l * 3 + vs) * MODW + DM + c4), sh = modv4(md + (size_t)(l * 3 + vs) * MODW + c4);
              *(LAS f32x4*)(vl + RS_A + ((size_t)vs * 2048 + c4) * 4) = gn * (sc + 1.f); *(LAS f32x4*)(vl + RS_SH + ((size_t)vs * 2048 + c4) * 4) = sh; }
          if (COMB) *(LAS f32x4*)(vl + RS_GF + ((size_t)vs * 2048 + c4) * 4) = modv4(md + (size_t)(lc * 3 + vs) * MODW + 5 * DM + c4) * (1.f / Y8_SCALE); }
      if (FINAL) { for (int q = tid; q < 2 * 512; q += NWAVES * 64) { const int c4 = (q & 511) * 4; *(LAS f32x4*)(vl + RS_A + ((size_t)(1 + (q >> 9)) * 2048 + c4) * 4) = *(const f32x4*)(p.norm_final + c4); } }
      __syncthreads(); }
    const int nit = gw < nrows ? (nrows - gw + ngw - 1) / ngw : 0;
    if (nit == 0) return;
    const int last = gw + (nit - 1) * ngw;
#define RS_ROW(i) min(gw + (i) * ngw, last)
    RowX bA, bB; int e0, p0, e1, p1; RowI i0 = rs_idx_issue<COMB>(p, RS_ROW(0), lane, e0, p0), i1 = rs_idx_issue<COMB>(p, RS_ROW(1), lane, e1, p1);
    { int s = COMB ? segL[e0] + p0 : 0; rs_issue<COMB, SRC32>(p, RS_ROW(0), __shfl(s, 0), __shfl(s, 1), lane, bA); }
#pragma unroll 1
    for (int i = 0; i < nit; i += 2) {
        int e2, p2, e3, p3;
        const RowI i2 = rs_idx_issue<COMB>(p, RS_ROW(i + 2), lane, e2, p2);
        { int s = COMB ? segL[e1] + p1 : 0; rs_issue<COMB, SRC32>(p, RS_ROW(i + 1), __shfl(s, 0), __shfl(s, 1), lane, bB); }
        rs_finish<COMB, FINAL, SRC32>(p, l, RS_ROW(i), __shfl(i0.g, 0), __shfl(i0.g, 1), lane, bA, vl, true);
        const RowI i3 = rs_idx_issue<COMB>(p, RS_ROW(i + 3), lane, e3, p3);
        { int s = COMB ? segL[e2] + p2 : 0; rs_issue<COMB, SRC32>(p, RS_ROW(i + 2), __shfl(s, 0), __shfl(s, 1), lane, bA); }
        rs_finish<COMB, FINAL, SRC32>(p, l, RS_ROW(i + 1), __shfl(i1.g, 0), __shfl(i1.g, 1), lane, bB, vl, i + 1 < nit);
        i0 = i2; i1 = i3; e1 = e3; p1 = p3;
    }
#undef RS_ROW
}
constexpr int Q_TOTAL = NPL;
__device__ __forceinline__ void queue_convert8(const Prm& p, unsigned base, LAS unsigned char* lds, int tid_in) {
    int tid = tid_in;
    asm volatile("" : "+v"(tid));
    const int wave = __builtin_amdgcn_readfirstlane(tid >> 6), lane = tid & 63; const unsigned pi = base + (unsigned)wave, pj = pi + 8u;
    if (pi < (unsigned)Q_TOTAL) { const bool h1 = pj < (unsigned)Q_TOTAL; t_convert_two(p, 1, (int)pi, h1 ? (int)pj : (int)pi, h1, (LAS float*)(lds + wave * 16384), lane); }
}
__device__ __forceinline__ void xcd_barrier_work(const XcdBarrier& b, const Prm& p, LAS unsigned char* lds, int tid) {
    asm volatile("s_waitcnt vmcnt(0)" ::: "memory");
    __syncthreads();
    volatile LAS unsigned* bw = (volatile LAS unsigned*)(lds + L_BWORK);
    unsigned* bar = b.bar; unsigned* q = (unsigned*)(p.ws + OFF_Q);
    if (threadIdx.x == 0) {
        __builtin_amdgcn_s_waitcnt(0);
        unsigned nloc = b.st[0], nx = b.st[1];
        if (nloc == 0u) { xcd_barrier_complete(bar, b.x, nloc, nx); b.st[0] = nloc; b.st[1] = nx; }
        const unsigned old = xb_add(&bar[XB_XSUB(b.x)], 1u);
        const unsigned gen = old / nloc;
        if (old + 1u == (gen + 1u) * nloc) {
            __builtin_amdgcn_fence(__ATOMIC_RELEASE, "agent");
            asm volatile("s_waitcnt vmcnt(0)" ::: "memory");
            const unsigned og = xb_add(&bar[XB_TOP], 1u);
            const unsigned tg = og / nx;
            if (og + 1u == (tg + 1u) * nx) xb_add(&bar[XB_TOPGEN], 1u);
            else XB_SPIN(xb_ld(&bar[XB_TOPGEN]) == tg, bar);
            __builtin_amdgcn_fence(__ATOMIC_ACQUIRE, "agent");
            xb_add(&bar[XB_XGEN(b.x)], 1u);
            asm volatile("s_waitcnt vmcnt(0)" ::: "memory");
            bw[0] = 1u;
        } else { bw[0] = 0u; bw[2] = gen; }
    }
    __syncthreads();
    if (bw[0] == 0u) {
        unsigned sp = 0u;
        for (;;) {
            if (threadIdx.x == 0) {
                const unsigned gen = bw[2];
                bool rel = xb_ld(&bar[XB_XGEN(b.x)]) != gen;
                if (!rel && ((++sp & 63u) == 0u)) { if (xb_ld(&bar[XB_TMO])) rel = true; else if (sp > XB_SPIN_CAP) { atomicAdd(&bar[XB_TMO], 1u); rel = true; } }
                if (rel) { __builtin_amdgcn_fence(__ATOMIC_ACQUIRE, "agent"); asm volatile("s_waitcnt vmcnt(0)" ::: "memory"); bw[0] = 1u; }
                else { unsigned base = 0xffffffffu; if (xb_ld(q) < (unsigned)Q_TOTAL) { base = xb_add(q, 16u); if (base >= (unsigned)Q_TOTAL) base = 0xffffffffu; } bw[1] = base; }
            }
            __syncthreads();
            if (bw[0]) break;
            const unsigned base = bw[1];
            if (base != 0xffffffffu) queue_convert8(p, base, lds, tid); else __builtin_amdgcn_s_sleep(4);
            __syncthreads();
        }
    }
    __syncthreads();
}
__device__ __forceinline__ void queue_drain(const Prm& p, LAS unsigned char* lds, int tid, unsigned target) {
    volatile LAS unsigned* bw = (volatile LAS unsigned*)(lds + L_BWORK); unsigned* q = (unsigned*)(p.ws + OFF_Q);
    __syncthreads();
    for (;;) {
        if (threadIdx.x == 0) bw[1] = (xb_ld(q) < target) ? xb_add(q, 16u) : 0xffffffffu;
        __syncthreads();
        const unsigned base = bw[1];
        if (base >= target) break;
        queue_convert8(p, base, lds, tid);
        __syncthreads();
    }
    __syncthreads();
}
__device__ __forceinline__ void phase_conv(const Prm& p, int l, int gw, int ngw, int lane) {
    const bf16* U = (const bf16*)(p.ws + WS_U); bf16* XA = (bf16*)(p.ws + WS_XBC); float* DT = (float*)(p.ws + WS_DT);
    constexpr int NRUN = T_ALL / 16;
    for (int it = gw; it < NRUN * 3; it += ngw) {
        const int run = it / 3, cb = it % 3, t0 = run * 16, ch = cb * 512 + lane * 8;
        int seq0, seq1; if (t0 < T_LAT) { seq0 = t0 & ~(SEQL - 1); seq1 = seq0 + SEQL; } else { seq0 = T_LAT + ((t0 - T_LAT) & ~(CTXL - 1)); seq1 = seq0 + CTXL; }
        float w[5][8], bias[8];
#pragma unroll
        for (int j = 0; j < 5; ++j) { const f32x4 a = *(const f32x4*)(p.conv_w + ((size_t)l * 5 + j) * XBCW + ch), b = *(const f32x4*)(p.conv_w + ((size_t)l * 5 + j) * XBCW + ch + 4);
            w[j][0] = a[0]; w[j][1] = a[1]; w[j][2] = a[2]; w[j][3] = a[3]; w[j][4] = b[0]; w[j][5] = b[1]; w[j][6] = b[2]; w[j][7] = b[3]; }
        { const f32x4 a = *(const f32x4*)(p.conv_b + (size_t)l * XBCW + ch), b = *(const f32x4*)(p.conv_b + (size_t)l * XBCW + ch + 4);
            bias[0] = a[0]; bias[1] = a[1]; bias[2] = a[2]; bias[3] = a[3]; bias[4] = b[0]; bias[5] = b[1]; bias[6] = b[2]; bias[7] = b[3]; }
        v4u rows[20];
#pragma unroll
        for (int j = 0; j < 20; ++j) { const int t = t0 - 2 + j, tc = min(max(t, seq0), seq1 - 1); rows[j] = *(const v4u*)(U + (size_t)tc * NINP + C_XBC + ch); }
#pragma unroll
        for (int j = 0; j < 20; ++j) { const int t = t0 - 2 + j; if (t < seq0 || t >= seq1) rows[j] = (v4u){0u, 0u, 0u, 0u}; }
#pragma unroll
        for (int i = 0; i < 16; ++i) {
            const int t = t0 + i;
            float o[8];
#pragma unroll
            for (int c = 0; c < 8; ++c) o[c] = bias[c];
#pragma unroll
            for (int j = 0; j < 5; ++j) { const v4u wv = rows[i + j];
                o[0] += w[j][0] * bflo(wv.x); o[1] += w[j][1] * bfhi(wv.x); o[2] += w[j][2] * bflo(wv.y); o[3] += w[j][3] * bfhi(wv.y);
                o[4] += w[j][4] * bflo(wv.z); o[5] += w[j][5] * bfhi(wv.z); o[6] += w[j][6] * bflo(wv.w); o[7] += w[j][7] * bfhi(wv.w); }
            v4u r; r.x = pk2(silu_f(o[0]), silu_f(o[1])); r.y = pk2(silu_f(o[2]), silu_f(o[3])); r.z = pk2(silu_f(o[4]), silu_f(o[5])); r.w = pk2(silu_f(o[6]), silu_f(o[7]));
            *(v4u*)(XA + (size_t)t * XBCW + ch) = r;
        }
    }
    for (int it = gw * 64 + lane; it < T_ALL * 32; it += ngw * 64) { const int m = it >> 5, j = it & 31;
        DT[it] = softplus_f(bf2f(U[(size_t)m * NINP + C_DT + j]) + p.dt_bias[l * 32 + j]); }
}

__device__ __forceinline__ void naive_attn_item(const Prm& p, int l, int type, int m, int hh, LAS float* qs, LAS float* sc, int lane) {
    const bf16* U = (const bf16*)(p.ws + WS_U); bf16* MIX = (bf16*)(p.ws + WS_H);
    int qcol, kcol, vcol, ocol;
    if (type == 0 || type == 2) { qcol = C_QA + hh * 128; kcol = C_KA + hh * 128; vcol = C_VA + hh * 128; ocol = hh * 128; }
    else { const int kvh = hh >> 1; qcol = C_QB + hh * 128; kcol = C_KB + kvh * 128; vcol = C_VB + kvh * 128; ocol = 512 + hh * 128; }
    { const unsigned w = *(const unsigned*)(U + (size_t)m * NINP + qcol + 2 * lane); qs[2 * lane] = bflo(w); qs[2 * lane + 1] = bfhi(w); }
    int b, s = 0, qr = 0, qc = 0, krow0 = 0, kpos0 = 0;
    if (type < 2) { b = m >> 13; s = m & 8191; qr = s >> 6; qc = s & 63; } else { b = (m - T_LAT) >> 8; }
    const int nloc = type == 0 ? 512 : (type == 1 ? 384 : 0), nk = nloc + 256;
    if (type == 0) krow0 = min(max(qr - 4, 0), 120);
    if (type == 1) kpos0 = (s >> 7) * 128 - 128;
    const float* rpb = p.na_rpb + (size_t)(l * 4 + hh) * 15 * 31;
    LDS_WAIT(); __builtin_amdgcn_wave_barrier(); asm volatile("" ::: "memory");
    float mx = -INFINITY;
    for (int k0 = 0; k0 < nk; k0 += 64) {
        const int kidx = k0 + lane; int row; float bias = 0.f; bool valid = true;
        if (kidx < nloc) {
            if (type == 0) { const int kr = krow0 + (kidx >> 6), kc = kidx & 63; row = b * SEQL + kr * 64 + kc; const int c0 = min(max(qc - 8, 0), 48); valid = (kc >= c0) && (kc < c0 + 16);
                const int dr = kr - qr + 7, dc = min(max(kc - qc + 15, 0), 30); bias = rpb[dr * 31 + dc]; }
            else { const int kpos = kpos0 + kidx; valid = (kpos >= 0) && (kpos < SEQL) && (abs(s - kpos) <= 128); row = b * SEQL + min(max(kpos, 0), SEQL - 1); }
        } else row = T_LAT + b * CTXL + (kidx - nloc);
        const bf16* kp = U + (size_t)row * NINP + kcol; float d = 0.f;
#pragma unroll 4
        for (int c = 0; c < 16; ++c) { const v4u w = *(const v4u*)(kp + 8 * c); const LAS float* q = qs + 8 * c;
            d += bflo(w.x) * q[0] + bfhi(w.x) * q[1] + bflo(w.y) * q[2] + bfhi(w.y) * q[3] + bflo(w.z) * q[4] + bfhi(w.z) * q[5] + bflo(w.w) * q[6] + bfhi(w.w) * q[7]; }
        const float sv = valid ? d * ATT_SCALE + bias : -INFINITY;
        sc[kidx] = sv; mx = fmaxf(mx, sv);
    }
    mx = wave_max(mx);
    float sum = 0.f;
    for (int k0 = 0; k0 < nk; k0 += 64) { const float e = __expf(sc[k0 + lane] - mx); sc[k0 + lane] = e; sum += e; }
    sum = wave_sum(sum);
    if (type == 1 || type == 3) sum += __expf(p.wa_sink[l * 4 + hh] - mx);
    LDS_WAIT(); __builtin_amdgcn_wave_barrier(); asm volatile("" ::: "memory");
    float o0 = 0.f, o1 = 0.f;
    for (int kidx = 0; kidx < nk; ++kidx) {
        int row;
        if (kidx < nloc) { if (type == 0) row = b * SEQL + (krow0 + (kidx >> 6)) * 64 + (kidx & 63); else row = b * SEQL + min(max(kpos0 + kidx, 0), SEQL - 1); }
        else row = T_LAT + b * CTXL + (kidx - nloc);
        const float pv = sc[kidx]; const unsigned w = *(const unsigned*)(U + (size_t)row * NINP + vcol + 2 * lane);
        o0 += pv * bflo(w); o1 += pv * bfhi(w);
    }
    const float inv = 1.f / sum;
    *(unsigned*)(MIX + (size_t)m * DM + ocol + 2 * lane) = pk2(o0 * inv, o1 * inv);
    LDS_WAIT(); __builtin_amdgcn_wave_barrier(); asm volatile("" ::: "memory");
}
__device__ __forceinline__ void phase_attn_naive(const Prm& p, int l, LAS unsigned char* lds, int gw, int ngw, int wave, int lane) {
    LAS float* qs = (LAS float*)(lds + wave * 4096); LAS float* sc = qs + 128;
    const int nlat = T_LAT * 8, nctx = (l == 0) ? T_CTX * 8 : 0;
    for (int it = gw; it < nlat + nctx; it += ngw) {
        if (it < nlat) { const int m = it >> 3, h8 = it & 7; naive_attn_item(p, l, h8 >> 2, m, h8 & 3, qs, sc, lane); }
        else { const int r = it - nlat, m = T_LAT + (r >> 3), h8 = r & 7; naive_attn_item(p, l, 2 + (h8 >> 2), m, h8 & 3, qs, sc, lane); }
    }
}

__device__ __forceinline__ void phase_ssd_naive(const Prm& p, int l, int wg, int nwg, int tid) {
    const bf16* XA = (const bf16*)(p.ws + WS_XBC); const float* DT = (const float*)(p.ws + WS_DT); float* YD = (float*)(p.ws + WS_YD);
    for (int it = wg; it < 64; it += nwg) {
        const int b = it >> 5, dir = (it >> 4) & 1, h = it & 15, g = h >> 3;
        const int pp = tid >> 3, nq = tid & 7;
        const float a = -__expf(p.a_log[l * 32 + dir * 16 + h]), dsk = p.d_skip[l * 32 + dir * 16 + h];
        float hs[16];
#pragma unroll
        for (int i = 0; i < 16; ++i) hs[i] = 0.f;
#pragma unroll 4
        for (int st = 0; st < CTXL + SEQL; ++st) {
            int m; if (st < CTXL) m = T_LAT + b * CTXL + (dir ? CTXL - 1 - st : st); else { const int s = st - CTXL; m = b * SEQL + (dir ? SEQL - 1 - s : s); }
            const float dtv = DT[(size_t)m * 32 + dir * 16 + h];
            const bf16* row = XA + (size_t)m * XBCW;
            const float xv = bf2f(row[h * 64 + pp]);
            const v4u b0 = *(const v4u*)(row + 1024 + g * 128 + 16 * nq), b1 = *(const v4u*)(row + 1024 + g * 128 + 16 * nq + 8);
            const v4u c0 = *(const v4u*)(row + 1280 + g * 128 + 16 * nq), c1 = *(const v4u*)(row + 1280 + g * 128 + 16 * nq + 8);
            const float dA = __expf(a * dtv), dx = dtv * xv;
            float bv[16], cv[16];
            bv[0] = bflo(b0.x); bv[1] = bfhi(b0.x); bv[2] = bflo(b0.y); bv[3] = bfhi(b0.y); bv[4] = bflo(b0.z); bv[5] = bfhi(b0.z); bv[6] = bflo(b0.w); bv[7] = bfhi(b0.w);
            bv[8] = bflo(b1.x); bv[9] = bfhi(b1.x); bv[10] = bflo(b1.y); bv[11] = bfhi(b1.y); bv[12] = bflo(b1.z); bv[13] = bfhi(b1.z); bv[14] = bflo(b1.w); bv[15] = bfhi(b1.w);
            cv[0] = bflo(c0.x); cv[1] = bfhi(c0.x); cv[2] = bflo(c0.y); cv[3] = bfhi(c0.y); cv[4] = bflo(c0.z); cv[5] = bfhi(c0.z); cv[6] = bflo(c0.w); cv[7] = bfhi(c0.w);
            cv[8] = bflo(c1.x); cv[9] = bfhi(c1.x); cv[10] = bflo(c1.y); cv[11] = bfhi(c1.y); cv[12] = bflo(c1.z); cv[13] = bfhi(c1.z); cv[14] = bflo(c1.w); cv[15] = bfhi(c1.w);
            float part = 0.f;
#pragma unroll
            for (int i = 0; i < 16; ++i) { hs[i] = dA * hs[i] + dx * bv[i]; part += cv[i] * hs[i]; }
            part += __shfl_xor(part, 1); part += __shfl_xor(part, 2); part += __shfl_xor(part, 4);
            if (nq == 0) YD[((size_t)dir * T_ALL + m) * 1024 + h * 64 + pp] = part + dsk * xv;
        }
    }
}
__device__ __forceinline__ void phase_gnorm(const Prm& p, int l, int gw, int ngw, int lane) {
    const bf16* U = (const bf16*)(p.ws + WS_U); const bf16* YD = (const bf16*)(p.ws + WS_XG); bf16* MIX = (bf16*)(p.ws + WS_H);
    const int nrow = (l == 0) ? T_ALL : T_LAT;
    for (int m0 = gw; m0 < nrow; m0 += 2 * ngw) {
        const int m1 = (m0 + ngw < nrow) ? m0 + ngw : m0;
        v2u yv[2][4], zv[2][4];
#pragma unroll
        for (int q = 0; q < 2; ++q) { const int m = q ? m1 : m0;
#pragma unroll
            for (int j = 0; j < 4; ++j) { const int col = 256 * j + 4 * lane; yv[q][j] = *(const v2u*)(YD + (size_t)m * 1024 + col); zv[q][j] = *(const v2u*)(U + (size_t)m * NINP + C_Z + col); } }
#pragma unroll
        for (int q = 0; q < 2; ++q) { const int m = q ? m1 : m0;
            f32x4 u[4]; float ss[2] = {0.f, 0.f};
#pragma unroll
            for (int j = 0; j < 4; ++j) { const v2u yy = yv[q][j], zz = zv[q][j];
                u[j][0] = bflo(yy.x) * silu_f(bflo(zz.x)); u[j][1] = bfhi(yy.x) * silu_f(bfhi(zz.x)); u[j][2] = bflo(yy.y) * silu_f(bflo(zz.y)); u[j][3] = bfhi(yy.y) * silu_f(bfhi(zz.y));
                ss[j >> 1] += (u[j][0] * u[j][0] + u[j][1] * u[j][1]) + (u[j][2] * u[j][2] + u[j][3] * u[j][3]); }
            const float r0 = rsqrtf(wave_sum(ss[0]) * (1.f / 512.f) + EPS), r1 = rsqrtf(wave_sum(ss[1]) * (1.f / 512.f) + EPS);
            if (q == 1 && m1 == m0) continue;
#pragma unroll
            for (int j = 0; j < 4; ++j) { const int col = 256 * j + 4 * lane; const f32x4 g = *(const f32x4*)(p.ssd_norm + l * 1024 + col); const f32x4 o = u[j] * (j < 2 ? r0 : r1) * g;
                if (F8_OUTPROJ) *(unsigned*)((unsigned char*)MIX + (size_t)m * DM + 1024 + col) = pack4f8(o[0] * MIX_SCALE, o[1] * MIX_SCALE, o[2] * MIX_SCALE, o[3] * MIX_SCALE);
                else { v2u w; w.x = pk2(o[0], o[1]); w.y = pk2(o[2], o[3]); *(v2u*)(MIX + (size_t)m * DM + 1024 + col) = w; } }
        }
    }
}
namespace att {
typedef short s16x4 __attribute__((ext_vector_type(4)));
typedef float f32x16 __attribute__((ext_vector_type(16)));
constexpr int KVBLK = 64;
constexpr float THR = 8.f;
#ifndef ATT_SDEPTH
#define ATT_SDEPTH 1
#endif
constexpr int SDEPTH = ATT_SDEPTH;
constexpr int SHM_V = KVBLK * 128 * 2, SHM_K = KVBLK * 128 * 2;
constexpr int OFF_V = 0, OFF_K = 2 * SHM_V, OFF_WS = 2 * SHM_V + 2 * SHM_K, OFF_RPB = OFF_WS + 8 * 64 * 4, ATT_LDS = OFF_RPB + 576 * 4;
#define KSWZ(row, colB) ((row) * 256 + ((colB) ^ (((row) & 7) << 4)))
#define SBAR() __builtin_amdgcn_sched_barrier(0)
__device__ __forceinline__ int crow(int r, int hi) { return (r & 3) + 8 * (r >> 2) + 4 * hi; }
__device__ __forceinline__ unsigned cvtpk(float lo, float hi) { unsigned r; asm volatile("v_cvt_pk_bf16_f32 %0, %1, %2" : "=v"(r) : "v"(lo), "v"(hi)); return r; }
__device__ __forceinline__ void partialSM(f32x16& p0, f32x16& p1, float& m_reg, float& mn, float& alpha) {
  constexpr float C = ATT_SCALE * 1.4426950408889634f;
  float pmax = p0[0];
#pragma unroll
  for (int r = 1; r < 16; ++r) pmax = fmaxf(pmax, p0[r]);
#pragma unroll
  for (int r = 0; r < 16; ++r) pmax = fmaxf(pmax, p1[r]);
  { auto rr = __builtin_amdgcn_permlane32_swap(__float_as_uint(pmax), __float_as_uint(pmax), false, false);
    pmax = fmaxf(__uint_as_float(rr[0]), __uint_as_float(rr[1])); }
  if (__builtin_expect(__all(pmax - m_reg <= THR / ATT_SCALE), 1)) { mn = m_reg; alpha = 1.f; }
  else { mn = fmaxf(m_reg, pmax); alpha = __builtin_amdgcn_exp2f((m_reg - mn) * C); m_reg = mn; }
  float mnC = -mn * C;
#pragma unroll
  for (int r = 0; r < 16; ++r) p0[r] = fmaf(p0[r], C, mnC);
#pragma unroll
  for (int r = 0; r < 16; ++r) p1[r] = fmaf(p1[r], C, mnC);
#pragma unroll
  for (int r = 0; r < 16; ++r) p0[r] = __builtin_amdgcn_exp2f(p0[r]);
}
__device__ __forceinline__ void finishSM(f32x16& p0, f32x16& p1, float alpha, float& l_reg, bf16x8& pa0, bf16x8& pa1, bf16x8& pa2, bf16x8& pa3) {
#pragma unroll
  for (int r = 0; r < 16; ++r) p1[r] = __builtin_amdgcn_exp2f(p1[r]);
  float ps = 0;
#pragma unroll
  for (int r = 0; r < 16; ++r) ps += p0[r];
#pragma unroll
  for (int r = 0; r < 16; ++r) ps += p1[r];
  { auto rr = __builtin_amdgcn_permlane32_swap(__float_as_uint(ps), __float_as_uint(ps), false, false);
    ps = __uint_as_float(rr[0]) + __uint_as_float(rr[1]); }
  l_reg = l_reg * alpha + ps;
#define PK4(P, BASE, OUT) do { unsigned a0 = cvtpk(P[BASE + 0], P[BASE + 1]), a1 = cvtpk(P[BASE + 2], P[BASE + 3]);   \
    unsigned b0 = cvtpk(P[BASE + 4], P[BASE + 5]), b1 = cvtpk(P[BASE + 6], P[BASE + 7]);                              \
    auto r0 = __builtin_amdgcn_permlane32_swap(a0, b0, false, false); auto r1 = __builtin_amdgcn_permlane32_swap(a1, b1, false, false); \
    v4u w = {r0[0], r1[0], r0[1], r1[1]}; OUT = *reinterpret_cast<bf16x8*>(&w); } while (0)
  PK4(p0, 0, pa0); PK4(p0, 8, pa1); PK4(p1, 0, pa2); PK4(p1, 8, pa3);
#undef PK4
}
__device__ __forceinline__ void qkt(f32x16& p0, f32x16& p1, const LAS unsigned char* Ks, const bf16x8* qr, int r32, int hi) {
  p0 = f32x16{}; p1 = f32x16{};
#pragma unroll
  for (int d0 = 0; d0 < 8; ++d0) { int cb = (d0 * 16 + hi * 8) * 2;
    bf16x8 b0 = *reinterpret_cast<const LAS bf16x8*>(Ks + KSWZ(r32, cb));
    bf16x8 b1 = *reinterpret_cast<const LAS bf16x8*>(Ks + KSWZ(32 + r32, cb));
    p0 = __builtin_amdgcn_mfma_f32_32x32x16_bf16(b0, qr[d0], p0, 0, 0, 0);
    p1 = __builtin_amdgcn_mfma_f32_32x32x16_bf16(b1, qr[d0], p1, 0, 0, 0); }
}
__device__ __forceinline__ int v_st(int k, int c) { const int kk = (k & ~0xC) | ((k & 4) << 1) | ((k & 8) >> 1); return ((kk >> 3) * 4 + (c >> 5)) * 512 + ((kk & 7) * 32 + (c & 31)) * 2; }
__device__ __forceinline__ int v_rd_base(int lane) { return ((lane & 3) << 3) | (((lane >> 2) & 3) << 6) | (((lane >> 4) & 1) << 5) | (((lane >> 5) & 1) << 8); }
constexpr int v_rd_off(int d0, int ks, int half) { return d0 * 512 + ks * 4096 + half * 2048; }
template <int OFF> __device__ __forceinline__ s16x4 tr_read(int vb) {
  s16x4 r; asm volatile("ds_read_b64_tr_b16 %0, %1 offset:%2" : "=&v"(r) : "v"(vb), "i"(OFF) : "memory"); return r;
}
template <int D0> __device__ __forceinline__ void pv_one(f32x16& od, int vb, bf16x8 pa0, bf16x8 pa1, bf16x8 pa2, bf16x8 pa3) {
  const s16x4 l0 = tr_read<v_rd_off(D0, 0, 0)>(vb), h0 = tr_read<v_rd_off(D0, 0, 1)>(vb), l1 = tr_read<v_rd_off(D0, 1, 0)>(vb), h1 = tr_read<v_rd_off(D0, 1, 1)>(vb);
  const s16x4 l2 = tr_read<v_rd_off(D0, 2, 0)>(vb), h2 = tr_read<v_rd_off(D0, 2, 1)>(vb), l3 = tr_read<v_rd_off(D0, 3, 0)>(vb), h3 = tr_read<v_rd_off(D0, 3, 1)>(vb);
  asm volatile("s_waitcnt lgkmcnt(0)" ::: "memory"); SBAR();
#define PK(L, H) (bf16x8){L[0], L[1], L[2], L[3], H[0], H[1], H[2], H[3]}
  od = __builtin_amdgcn_mfma_f32_32x32x16_bf16(pa0, PK(l0, h0), od, 0, 0, 0);
  od = __builtin_amdgcn_mfma_f32_32x32x16_bf16(pa1, PK(l1, h1), od, 0, 0, 0);
  od = __builtin_amdgcn_mfma_f32_32x32x16_bf16(pa2, PK(l2, h2), od, 0, 0, 0);
  od = __builtin_amdgcn_mfma_f32_32x32x16_bf16(pa3, PK(l3, h3), od, 0, 0, 0);
#undef PK
}
__device__ __forceinline__ void pv_d0(f32x16* o, int vb, bf16x8 pa0, bf16x8 pa1, bf16x8 pa2, bf16x8 pa3) {
  pv_one<0>(o[0], vb, pa0, pa1, pa2, pa3); pv_one<1>(o[1], vb, pa0, pa1, pa2, pa3); pv_one<2>(o[2], vb, pa0, pa1, pa2, pa3); pv_one<3>(o[3], vb, pa0, pa1, pa2, pa3);
}
struct UnitD { int type, b, hh, q0  , nloc  , kbase  ; };
__device__ __forceinline__ int tile_row(const UnitD& u, int j) {
    if (j >= u.nloc) return T_LAT + u.b * CTXL + (j - u.nloc) * 64;
    if (u.type == 0) return u.b * SEQL + (u.kbase + j) * 64;
    const int kp = u.kbase + j * 64; return u.b * SEQL + min(max(kp, 0), SEQL - 64);
}
__device__ __forceinline__ bool tile_active(const UnitD& u, int j, int wid) {
    if (j >= u.nloc) return true;
    if (u.type == 0) { const int qr = (u.q0 >> 6) + (wid >> 1), kr = u.kbase + j, start = min(max(qr - 4, 0), 120); return kr >= start && kr < start + 8; }
    const int qw = u.q0 + 32 * wid, kp0 = u.kbase + j * 64;
    return (kp0 >= 0) && (kp0 < SEQL) && (kp0 - (qw + 31) <= 128) && (qw - (kp0 + 63) <= 128);
}
__device__ __forceinline__ void apply_mask(f32x16& p0, f32x16& p1, const UnitD& u, int j, int wid, int r32, int hi, const LAS float* rpbL) {
    if (j >= u.nloc) return;
    if (u.type == 0) {
        const int qr = (u.q0 >> 6) + (wid >> 1), qc = (wid & 1) * 32 + r32, kr = u.kbase + j;
        const int c0 = min(max(qc - 8, 0), 48), cb = 4 * hi - c0;
        const LAS float* rp = rpbL + (kr - qr + 7) * 31 + 4 * hi - qc + 15 + 32;
#pragma unroll
        for (int r = 0; r < 16; ++r) {
            const int k0 = (r & 3) + 8 * (r >> 2);
            p0[r] = ((unsigned)(k0 + cb) < 16u) ? p0[r] + rp[k0] : -INFINITY;
            p1[r] = ((unsigned)(k0 + 32 + cb) < 16u) ? p1[r] + rp[k0 + 32] : -INFINITY;
            if ((r & 3) == 3) SBAR(); }
    } else {
        const int qw = u.q0 + 32 * wid, kp0 = u.kbase + j * 64;
        if ((kp0 + 63 - qw <= 128) && (qw + 31 - kp0 <= 128)) return;
        const int cb = kp0 + 4 * hi - (qw + r32) + 128;
#pragma unroll
        for (int r = 0; r < 16; ++r) {
            const int k0 = (r & 3) + 8 * (r >> 2);
            p0[r] = ((unsigned)(k0 + cb) <= 256u) ? p0[r] : -INFINITY;
            p1[r] = ((unsigned)(k0 + 32 + cb) <= 256u) ? p1[r] : -INFINITY; }
    }
}
__device__ __forceinline__ void fill_ninf(f32x16& p0, f32x16& p1) {
#pragma unroll
    for (int r = 0; r < 16; ++r) { p0[r] = -INFINITY; p1[r] = -INFINITY; }
}
__device__ __forceinline__ void attn_unit(const Prm& p, int l, const UnitD u, LAS unsigned char* lds, int tid) {
  const bf16* U = (const bf16*)(p.ws + WS_U); bf16* MIX = (bf16*)(p.ws + WS_H);
  const int wid = __builtin_amdgcn_readfirstlane(tid >> 6), lane = tid & 63, r32 = lane & 31, hi = lane >> 5;
  int qcol, kcol, vcol, ocol;
  if (u.type == 0 || u.type == 2) { qcol = C_QA + u.hh * 128; kcol = C_KA + u.hh * 128; vcol = C_VA + u.hh * 128; ocol = u.hh * 128; }
  else { const int kvh = u.hh >> 1; qcol = C_QB + u.hh * 128; kcol = C_KB + kvh * 128; vcol = C_VB + kvh * 128; ocol = 512 + u.hh * 128; }
  const int qrow0 = (u.type < 2 ? u.b * SEQL : T_LAT + u.b * CTXL) + u.q0;
  LAS unsigned char* V_lds = lds + OFF_V; LAS unsigned char* K_lds = lds + OFF_K;
  LAS float* wsl = (LAS float*)(lds + OFF_WS) + wid * 64; LAS float* li_l = wsl; LAS float* al_l = wsl + 32;
  LAS float* rpbL = (LAS float*)(lds + OFF_RPB);
  if (u.type == 0 && tid < 465) rpbL[32 + tid] = p.na_rpb[(size_t)(l * 4 + u.hh) * 465 + tid] * (1.f / ATT_SCALE);
  float m_reg = -1e30f, l_reg = 0; f32x16 o[4] = {}; bf16x8 qr[8];
  const bf16* Qw = U + (size_t)(qrow0 + wid * 32 + r32) * NINP + qcol + hi * 8;
#pragma unroll
  for (int d0 = 0; d0 < 8; ++d0) qr[d0] = *reinterpret_cast<const bf16x8*>(Qw + d0 * 16);
  const int sr = tid >> 4, sc = (tid & 15) * 8, vst0 = v_st(sr, sc), vst1 = v_st(32 + sr, sc);
  const int vb0 = (int)(uintptr_t)V_lds + v_rd_base(lane);
  struct { bf16x8 vs0, vs1, ks0, ks1; } sr_[SDEPTH];
#define SLOAD(i, jt) do { const bf16* rb_ = U + (size_t)(tile_row(u, (jt)) + sr) * NINP + sc; \
    sr_[i].vs0 = *reinterpret_cast<const bf16x8*>(rb_ + vcol); sr_[i].vs1 = *reinterpret_cast<const bf16x8*>(rb_ + (size_t)32 * NINP + vcol); \
    sr_[i].ks0 = *reinterpret_cast<const bf16x8*>(rb_ + kcol); sr_[i].ks1 = *reinterpret_cast<const bf16x8*>(rb_ + (size_t)32 * NINP + kcol); } while (0)
#define SWRITE(b, i) do { *(LAS bf16x8*)(V_lds + (b) * SHM_V + vst0) = sr_[i].vs0;          \
    *(LAS bf16x8*)(V_lds + (b) * SHM_V + vst1) = sr_[i].vs1; int kc = sc * 2;               \
    *(LAS bf16x8*)(K_lds + (b) * SHM_K + KSWZ(sr, kc)) = sr_[i].ks0;                       \
    *(LAS bf16x8*)(K_lds + (b) * SHM_K + KSWZ(32 + sr, kc)) = sr_[i].ks1; } while (0)
#define SWAIT() do { if constexpr (SDEPTH == 2) asm volatile("s_waitcnt vmcnt(4)" ::: "memory"); else asm volatile("s_waitcnt vmcnt(0)" ::: "memory"); } while (0)
#define RESC(a) do { if (__any((a) < 1.f)) { if (hi == 0) al_l[r32] = (a); asm volatile("s_waitcnt lgkmcnt(0)" ::: "memory"); \
    _Pragma("unroll") for (int d = 0; d < 4; ++d) _Pragma("unroll") for (int r = 0; r < 16; ++r) o[d][r] *= al_l[crow(r, hi)]; } } while (0)
  f32x16 pA0, pA1, pB0, pB1; float mnA, mnB, alA, alB; bf16x8 pa0, pa1, pa2, pa3; const int NT = u.nloc + 4;
  constexpr int SE = 0, SO = SDEPTH - 1;
  SLOAD(SE, 0); asm volatile("s_waitcnt vmcnt(0)" ::: "memory"); SWRITE(0, SE); __syncthreads();
#define SCORE(P0, P1, KB, jt, ACT) do { ACT = tile_active(u, (jt), wid); if (ACT) { qkt(P0, P1, KB, qr, r32, hi); apply_mask(P0, P1, u, (jt), wid, r32, hi, rpbL); } else fill_ninf(P0, P1); } while (0)
  bool actA, actB;
  SCORE(pA0, pA1, K_lds, 0, actA); partialSM(pA0, pA1, m_reg, mnA, alA);
  SLOAD(SO, 1); if constexpr (SDEPTH == 2) { if (2 < NT) SLOAD(SE, 2); }
  SWAIT(); SWRITE(1, SO); __syncthreads();
  for (int j = 1; j + 1 < NT; j += 2) {
    SBAR(); SCORE(pB0, pB1, K_lds + SHM_K, j, actB);
    finishSM(pA0, pA1, alA, l_reg, pa0, pa1, pa2, pa3); SBAR();
    SLOAD(SO, j + SDEPTH); SBAR();
    if (actA) pv_d0(o, vb0, pa0, pa1, pa2, pa3); partialSM(pB0, pB1, m_reg, mnB, alB);
    __syncthreads(); SWAIT(); SWRITE(0, SE);
    RESC(alB); __syncthreads();
    SBAR(); SCORE(pA0, pA1, K_lds, j + 1, actA);
    finishSM(pB0, pB1, alB, l_reg, pa0, pa1, pa2, pa3); SBAR();
    if (SDEPTH == 1 || j + 3 < NT) SLOAD(SE, j + 1 + SDEPTH); SBAR();
    if (actB) pv_d0(o, vb0 + SHM_V, pa0, pa1, pa2, pa3); partialSM(pA0, pA1, m_reg, mnA, alA);
    __syncthreads(); SWAIT(); SWRITE(1, SO);
    RESC(alA); __syncthreads();
  }
  SBAR(); SCORE(pB0, pB1, K_lds + SHM_K, NT - 1, actB);
  finishSM(pA0, pA1, alA, l_reg, pa0, pa1, pa2, pa3); SBAR();
  if (actA) pv_d0(o, vb0, pa0, pa1, pa2, pa3); partialSM(pB0, pB1, m_reg, mnB, alB);
  __syncthreads(); RESC(alB);
  finishSM(pB0, pB1, alB, l_reg, pa0, pa1, pa2, pa3); SBAR();
  if (actB) pv_d0(o, vb0 + SHM_V, pa0, pa1, pa2, pa3);
  if (u.type & 1) { constexpr float C = ATT_SCALE * 1.4426950408889634f; l_reg += __builtin_amdgcn_exp2f((p.wa_sink[l * 4 + u.hh] * (1.f / ATT_SCALE) - m_reg) * C); }
  if (hi == 0) li_l[r32] = l_reg; asm volatile("s_waitcnt lgkmcnt(0)" ::: "memory");
  float rli[16];
#pragma unroll
  for (int r = 0; r < 16; ++r) rli[r] = __builtin_amdgcn_rcpf(li_l[crow(r, hi)]);
  bf16* Ow = MIX + (size_t)(qrow0 + wid * 32) * DM + ocol;
#pragma unroll
  for (int r = 0; r < 16; r += 2) {
#pragma unroll
    for (int d0 = 0; d0 < 4; ++d0) {
      const float a = o[d0][r] * rli[r], b = o[d0][r + 1] * rli[r + 1];
      const float send = (lane & 1) ? a : b, got = __shfl_xor(send, 1);
      const int orow = crow(r, hi) + (lane & 1), ocl = d0 * 32 + (r32 & ~1);
      if (F8_OUTPROJ) { const float lo = ((lane & 1) ? got : a) * MIX_SCALE, hi2 = ((lane & 1) ? b : got) * MIX_SCALE;
        *(unsigned short*)((unsigned char*)MIX + (size_t)(qrow0 + wid * 32 + orow) * DM + ocol + ocl) = (unsigned short)pack4f8(lo, hi2, 0.f, 0.f); }
      else { const unsigned w = (lane & 1) ? pk2(got, b) : pk2(a, got); *(unsigned*)(Ow + (size_t)orow * DM + ocl) = w; } } }
  __syncthreads();
#undef SCORE
#undef SLOAD
#undef SWRITE
#undef SWAIT
#undef RESC
}
constexpr int NSLOT = 3;
constexpr int OFFD_K = 0, OFFD_V = NSLOT * SHM_K, OFFD_WS = NSLOT * (SHM_K + SHM_V), OFFD_RPB = OFFD_WS + 8 * 64 * 4, ATT_LDS_D = OFFD_RPB + 576 * 4;
static_assert(ATT_LDS_D <= RING_BYTES, "attention LDS");
__device__ __forceinline__ void attn_unit_dma(const Prm& p, int l, const UnitD u, LAS unsigned char* lds, int tid) {
  const bf16* U = (const bf16*)(p.ws + WS_U); bf16* MIX = (bf16*)(p.ws + WS_H);
  const int wid = __builtin_amdgcn_readfirstlane(tid >> 6), lane = tid & 63, r32 = lane & 31, hi = lane >> 5;
  int qcol, kcol, vcol, ocol;
  if (u.type == 0 || u.type == 2) { qcol = C_QA + u.hh * 128; kcol = C_KA + u.hh * 128; vcol = C_VA + u.hh * 128; ocol = u.hh * 128; }
  else { const int kvh = u.hh >> 1; qcol = C_QB + u.hh * 128; kcol = C_KB + kvh * 128; vcol = C_VB + kvh * 128; ocol = 512 + u.hh * 128; }
  const int qrow0 = (u.type < 2 ? u.b * SEQL : T_LAT + u.b * CTXL) + u.q0;
  LAS unsigned char* K_lds = lds + OFFD_K; LAS unsigned char* V_lds = lds + OFFD_V;
  LAS float* wsl = (LAS float*)(lds + OFFD_WS) + wid * 64; LAS float* li_l = wsl; LAS float* al_l = wsl + 32;
  LAS float* rpbL = (LAS float*)(lds + OFFD_RPB);
  if (u.type == 0 && tid < 465) rpbL[32 + tid] = p.na_rpb[(size_t)(l * 4 + u.hh) * 465 + tid] * (1.f / ATT_SCALE);
  float m_reg = -1e30f, l_reg = 0; f32x16 o[4] = {}; bf16x8 qr[8];
  const bf16* Qw = U + (size_t)(qrow0 + wid * 32 + r32) * NINP + qcol + hi * 8;
#pragma unroll
  for (int d0 = 0; d0 < 8; ++d0) qr[d0] = *reinterpret_cast<const bf16x8*>(Qw + d0 * 16);
  unsigned koff[2], voff[2];
#pragma unroll
  for (int i = 0; i < 2; ++i) { const int pch = (wid * 2 + i) * 64 + lane;
    { const int row = pch >> 4, c = (pch & 15) ^ (row & 7); koff[i] = (unsigned)(row * NINP + kcol + c * 8); }
    { const int sidx = pch >> 5, q = pch & 31, kk = (sidx >> 2) * 8 + (q >> 2), k = (kk & ~0xC) | ((kk & 4) << 1) | ((kk & 8) >> 1);
      voff[i] = (unsigned)(k * NINP + vcol + (sidx & 3) * 32 + (q & 3) * 8); } }
  const int vb0 = (int)(uintptr_t)V_lds + v_rd_base(lane);
#define DMA_K(jt) do { const bf16* tb_ = U + (size_t)tile_row(u, (jt)) * NINP; LAS unsigned char* dst_ = K_lds + ((jt) % NSLOT) * SHM_K + wid * 2048; \
    _Pragma("unroll") for (int i_ = 0; i_ < 2; ++i_) __builtin_amdgcn_global_load_lds((const unsigned*)(tb_ + koff[i_]), (LAS unsigned*)(dst_ + i_ * 1024), 16, 0, 0); } while (0)
#define DMA_V(jt) do { const bf16* tb_ = U + (size_t)tile_row(u, (jt)) * NINP; LAS unsigned char* dst_ = V_lds + ((jt) % NSLOT) * SHM_V + wid * 2048; \
    _Pragma("unroll") for (int i_ = 0; i_ < 2; ++i_) __builtin_amdgcn_global_load_lds((const unsigned*)(tb_ + voff[i_]), (LAS unsigned*)(dst_ + i_ * 1024), 16, 0, 0); } while (0)
#define STEP_SYNC4() asm volatile("s_waitcnt vmcnt(4) lgkmcnt(0)\n\ts_barrier" ::: "memory")
#define STEP_SYNC0() asm volatile("s_waitcnt vmcnt(0) lgkmcnt(0)\n\ts_barrier" ::: "memory")
#define RESC(a) do { if (__any((a) < 1.f)) { if (hi == 0) al_l[r32] = (a); asm volatile("s_waitcnt lgkmcnt(0)" ::: "memory"); \
    _Pragma("unroll") for (int d = 0; d < 4; ++d) _Pragma("unroll") for (int r = 0; r < 16; ++r) o[d][r] *= al_l[crow(r, hi)]; } } while (0)
#define SCORE(P0, P1, jt, ACT) do { ACT = tile_active(u, (jt), wid); if (ACT) { qkt(P0, P1, K_lds + ((jt) % NSLOT) * SHM_K, qr, r32, hi); apply_mask(P0, P1, u, (jt), wid, r32, hi, rpbL); } else fill_ninf(P0, P1); } while (0)
  f32x16 pA0, pA1, pB0, pB1; float mnA, mnB, alA, alB; bf16x8 pa0, pa1, pa2, pa3; const int NT = u.nloc + 4; bool actA, actB;
  DMA_K(0); DMA_K(1); DMA_V(0);
  STEP_SYNC4();
  DMA_K(2); DMA_V(1);
  SCORE(pA0, pA1, 0, actA); partialSM(pA0, pA1, m_reg, mnA, alA);
#pragma unroll 1
  for (int s = 1; s + 1 < NT; s += 2) {
    STEP_SYNC4();
    DMA_K(s + 2); DMA_V(s + 1);
    SBAR(); SCORE(pB0, pB1, s, actB);
    finishSM(pA0, pA1, alA, l_reg, pa0, pa1, pa2, pa3); SBAR();
    if (actA) pv_d0(o, vb0 + ((s - 1) % NSLOT) * SHM_V, pa0, pa1, pa2, pa3); partialSM(pB0, pB1, m_reg, mnB, alB);
    RESC(alB);
    STEP_SYNC4();
    if (s + 3 < NT) DMA_K(s + 3); DMA_V(s + 2);
    SBAR(); SCORE(pA0, pA1, s + 1, actA);
    finishSM(pB0, pB1, alB, l_reg, pa0, pa1, pa2, pa3); SBAR();
    if (actB) pv_d0(o, vb0 + (s % NSLOT) * SHM_V, pa0, pa1, pa2, pa3); partialSM(pA0, pA1, m_reg, mnA, alA);
    RESC(alA);
  }
  STEP_SYNC0();
  SBAR(); SCORE(pB0, pB1, NT - 1, actB);
  finishSM(pA0, pA1, alA, l_reg, pa0, pa1, pa2, pa3); SBAR();
  if (actA) pv_d0(o, vb0 + ((NT - 2) % NSLOT) * SHM_V, pa0, pa1, pa2, pa3); partialSM(pB0, pB1, m_reg, mnB, alB);
  RESC(alB);
  finishSM(pB0, pB1, alB, l_reg, pa0, pa1, pa2, pa3); SBAR();
  if (actB) pv_d0(o, vb0 + ((NT - 1) % NSLOT) * SHM_V, pa0, pa1, pa2, pa3);
  if (u.type & 1) { constexpr float C = ATT_SCALE * 1.4426950408889634f; l_reg += __builtin_amdgcn_exp2f((p.wa_sink[l * 4 + u.hh] * (1.f / ATT_SCALE) - m_reg) * C); }
  if (hi == 0) li_l[r32] = l_reg; asm volatile("s_waitcnt lgkmcnt(0)" ::: "memory");
  float rli[16];
#pragma unroll
  for (int r = 0; r < 16; ++r) rli[r] = __builtin_amdgcn_rcpf(li_l[crow(r, hi)]);
  bf16* Ow = MIX + (size_t)(qrow0 + wid * 32) * DM + ocol;
#pragma unroll
  for (int r = 0; r < 16; r += 2) {
#pragma unroll
    for (int d0 = 0; d0 < 4; ++d0) {
      const float a = o[d0][r] * rli[r], b = o[d0][r + 1] * rli[r + 1];
      const float send = (lane & 1) ? a : b, got = __shfl_xor(send, 1);
      const int orow = crow(r, hi) + (lane & 1), ocl = d0 * 32 + (r32 & ~1);
      if (F8_OUTPROJ) { const float lo = ((lane & 1) ? got : a) * MIX_SCALE, hi2 = ((lane & 1) ? b : got) * MIX_SCALE;
        *(unsigned short*)((unsigned char*)MIX + (size_t)(qrow0 + wid * 32 + orow) * DM + ocol + ocl) = (unsigned short)pack4f8(lo, hi2, 0.f, 0.f); }
      else { const unsigned w = (lane & 1) ? pk2(got, b) : pk2(a, got); *(unsigned*)(Ow + (size_t)orow * DM + ocl) = w; } } }
  asm volatile("s_waitcnt lgkmcnt(0)\n\ts_barrier" ::: "memory");
#undef DMA_K
#undef DMA_V
#undef STEP_SYNC4
#undef STEP_SYNC0
#undef RESC
#undef SCORE
}
#ifndef ATT_DMA
#define ATT_DMA 1
#endif
__device__ __forceinline__ void phase_attn(const Prm& p, int l, LAS unsigned char* lds, int wg, int nwg, int tid) {
    const int nu = 512 + (l == 0 ? 16 : 0);
    for (int it = wg; it < nu; it += nwg) {
        UnitD u;
        if (it < 256) { u.type = 0; u.b = it >> 7; u.hh = (it >> 5) & 3; const int blk = it & 31; u.q0 = blk * 256; u.nloc = 12; u.kbase = min(max(blk * 4 - 4, 0), 116); }
        else if (it < 512) { const int r = it - 256; u.type = 1; u.b = r >> 7; u.hh = (r >> 5) & 3; const int blk = r & 31; u.q0 = blk * 256; u.nloc = 8; u.kbase = blk * 256 - 128; }
        else { const int r = it - 512; u.type = 2 + (r >> 3); u.b = (r >> 2) & 1; u.hh = r & 3; u.q0 = 0; u.nloc = 0; u.kbase = 0; }
        if (ATT_DMA) attn_unit_dma(p, l, u, lds, tid); else attn_unit(p, l, u, lds, tid);
    }
}
}
namespace ssd {
typedef short s16x4 __attribute__((ext_vector_type(4)));
typedef float f32x16 __attribute__((ext_vector_type(16)));
constexpr int NCH = 66;
constexpr size_t WS_ST = WS_YD, WS_HS = WS_YD + 66 * MiB, WS_DEC = 1259 * MiB;
__device__ __forceinline__ int crow(int r, int hi) { return (r & 3) + 8 * (r >> 2) + 4 * hi; }
__device__ __forceinline__ int chunk_row0(int b, int c) { return c < 2 ? T_LAT + b * CTXL + c * 128 : b * SEQL + (c - 2) * 128; }
__device__ __forceinline__ s16x4 ds_tr(unsigned addr) { s16x4 r; asm volatile("ds_read_b64_tr_b16 %0, %1" : "=&v"(r) : "v"(addr) : "memory"); return r; }
struct Raw { s16x4 lo, hi; };
__device__ __forceinline__ Raw raw_tr_nat(unsigned base, int stride, int k0, int idx0, int lane) {
    const int i16 = lane & 15, g16 = (lane >> 4) & 1, hl = lane >> 5;
    const unsigned a = base + (unsigned)((k0 + 8 * hl + (i16 >> 2)) * stride + (idx0 + 16 * g16 + 4 * (i16 & 3)) * 2);
    Raw r; r.lo = ds_tr(a); r.hi = ds_tr(a + 4 * stride); return r;
}
__device__ __forceinline__ Raw raw_tr_acc(unsigned base, int stride, int k0, int idx0, int lane) {
    const int i16 = lane & 15, g16 = (lane >> 4) & 1, hl = lane >> 5;
    const unsigned a = base + (unsigned)((k0 + 4 * hl + (i16 >> 2)) * stride + (idx0 + 16 * g16 + 4 * (i16 & 3)) * 2);
    Raw r; r.lo = ds_tr(a); r.hi = ds_tr(a + 8 * stride); return r;
}
__device__ __forceinline__ void raw_wait2(Raw& a, Raw& b) { asm volatile("s_waitcnt lgkmcnt(0)" : "+v"(a.lo), "+v"(a.hi), "+v"(b.lo), "+v"(b.hi) :: "memory"); }
__device__ __forceinline__ void raw_wait6(Raw& a, Raw& b, Raw& c, Raw& d, Raw& e, Raw& f) {
    asm volatile("s_waitcnt lgkmcnt(0)" : "+v"(a.lo), "+v"(a.hi), "+v"(b.lo), "+v"(b.hi), "+v"(c.lo), "+v"(c.hi), "+v"(d.lo), "+v"(d.hi), "+v"(e.lo), "+v"(e.hi), "+v"(f.lo), "+v"(f.hi) :: "memory"); }
__device__ __forceinline__ bf16x8 join8(const Raw& r) { return (bf16x8){r.lo[0], r.lo[1], r.lo[2], r.lo[3], r.hi[0], r.hi[1], r.hi[2], r.hi[3]}; }
__device__ __forceinline__ unsigned cvtpk(float lo, float hi) { unsigned r; asm volatile("v_cvt_pk_bf16_f32 %0, %1, %2\n\ts_nop 1" : "=v"(r) : "v"(lo), "v"(hi)); return r; }
__device__ __forceinline__ void scan128(float& v0, float& v1, int lane) {
#pragma unroll
    for (int o = 1; o < 64; o <<= 1) { const int src = (lane >= o ? lane - o : lane) << 2;
        const float t0 = __builtin_bit_cast(float, __builtin_amdgcn_ds_bpermute(src, __builtin_bit_cast(int, v0))), t1 = __builtin_bit_cast(float, __builtin_amdgcn_ds_bpermute(src, __builtin_bit_cast(int, v1)));
        if (lane >= o) { v0 += t0; v1 += t1; } }
    v1 += __builtin_bit_cast(float, __builtin_amdgcn_ds_bpermute(63 << 2, __builtin_bit_cast(int, v0)));
}
__device__ __forceinline__ float lane63(float v) { return __builtin_bit_cast(float, __builtin_amdgcn_ds_bpermute(63 << 2, __builtin_bit_cast(int, v))); }

constexpr int BST = 272, XST = 528;
constexpr int S2_B = 0, S2_X = 128 * BST, S2_W = S2_X + 128 * XST, S2_END = S2_W + 8 * 128 * 4;
__device__ __forceinline__ void phase_states(const Prm& p, int l, LAS unsigned char* lds, int wg, int nwg, int tid) {
    const bf16* XA = (const bf16*)(p.ws + WS_XBC); const float* DT = (const float*)(p.ws + WS_DT);
    bf16* ST = (bf16*)(p.ws + WS_ST); float* DEC = (float*)(p.ws + WS_DEC);
    const int wid = __builtin_amdgcn_readfirstlane(tid >> 6), lane = tid & 63, hl = lane >> 5;
    for (int it = wg; it < 2 * NCH * 4; it += nwg) {
        const int b = it / (NCH * 4), rem = it % (NCH * 4), c = rem >> 2, g = (rem >> 1) & 1, hq = rem & 1;
        const int row0 = chunk_row0(b, c), h = 8 * g + 4 * hq + (wid & 3), dir = wid >> 2;
        { v4u tb[4], tx[8];
#pragma unroll
          for (int i = 0; i < 4; ++i) { const int id = tid + 512 * i, r = id >> 4, ch = id & 15; tb[i] = *(const v4u*)(XA + (size_t)(row0 + r) * XBCW + 1024 + g * 128 + ch * 8); }
#pragma unroll
          for (int i = 0; i < 8; ++i) { const int id = tid + 512 * i, r = id >> 5, ch = id & 31; tx[i] = *(const v4u*)(XA + (size_t)(row0 + r) * XBCW + (8 * g + 4 * hq) * 64 + ch * 8); }
#pragma unroll
          for (int i = 0; i < 4; ++i) { const int id = tid + 512 * i, r = id >> 4, ch = id & 15; *(LAS v4u*)(lds + S2_B + r * BST + ch * 16) = tb[i]; }
#pragma unroll
          for (int i = 0; i < 8; ++i) { const int id = tid + 512 * i, r = id >> 5, ch = id & 31; *(LAS v4u*)(lds + S2_X + r * XST + ch * 16) = tx[i]; } }
        const float a = -__expf(p.a_log[l * 32 + dir * 16 + h]);
        const float d0 = DT[(size_t)(row0 + lane) * 32 + dir * 16 + h], d1 = DT[(size_t)(row0 + 64 + lane) * 32 + dir * 16 + h];
        float P0 = a * d0, P1 = a * d1; scan128(P0, P1, lane);
        const float tot = lane63(P1);
        LAS float* wL = (LAS float*)(lds + S2_W) + wid * 128;
        wL[lane] = (dir == 0 ? __expf(tot - P0) : __expf(P0 - a * d0)) * d0;
        wL[64 + lane] = (dir == 0 ? __expf(tot - P1) : __expf(P1 - a * d1)) * d1;
        if (lane == 0) DEC[((b * NCH + c) * 2 + dir) * 16 + h] = __expf(tot);
        __syncthreads();
        f32x16 acc[2][4];
#pragma unroll
        for (int i = 0; i < 2; ++i)
#pragma unroll
            for (int j = 0; j < 4; ++j) acc[i][j] = f32x16{};
        const unsigned bB = (unsigned)(uintptr_t)(lds + S2_B), bX = (unsigned)(uintptr_t)(lds + S2_X);
#pragma unroll 1
        for (int ks = 0; ks < 8; ++ks) {
            const f32x4 w0 = *(const LAS f32x4*)(wL + 16 * ks + 8 * hl), w1 = *(const LAS f32x4*)(wL + 16 * ks + 8 * hl + 4);
            bf16x8 xa[2], bb[4];
            { Raw rx0 = raw_tr_nat(bX, XST, 16 * ks, (wid & 3) * 64, lane), rx1 = raw_tr_nat(bX, XST, 16 * ks, (wid & 3) * 64 + 32, lane);
              Raw rb0 = raw_tr_nat(bB, BST, 16 * ks, 0, lane), rb1 = raw_tr_nat(bB, BST, 16 * ks, 32, lane), rb2 = raw_tr_nat(bB, BST, 16 * ks, 64, lane), rb3 = raw_tr_nat(bB, BST, 16 * ks, 96, lane);
              raw_wait6(rx0, rx1, rb0, rb1, rb2, rb3);
              xa[0] = join8(rx0); xa[1] = join8(rx1); bb[0] = join8(rb0); bb[1] = join8(rb1); bb[2] = join8(rb2); bb[3] = join8(rb3); }
#pragma unroll
            for (int pt = 0; pt < 2; ++pt) {
                v4u q = *reinterpret_cast<v4u*>(&xa[pt]);
                q.x = cvtpk(bflo(q.x) * w0[0], bfhi(q.x) * w0[1]); q.y = cvtpk(bflo(q.y) * w0[2], bfhi(q.y) * w0[3]);
                q.z = cvtpk(bflo(q.z) * w1[0], bfhi(q.z) * w1[1]); q.w = cvtpk(bflo(q.w) * w1[2], bfhi(q.w) * w1[3]);
                xa[pt] = *reinterpret_cast<bf16x8*>(&q); }
#pragma unroll
            for (int pt = 0; pt < 2; ++pt)
#pragma unroll
                for (int nt = 0; nt < 4; ++nt) acc[pt][nt] = __builtin_amdgcn_mfma_f32_32x32x16_bf16(xa[pt], bb[nt], acc[pt][nt], 0, 0, 0);
        }
        bf16* so = ST + ((size_t)((b * NCH + c) * 2 + dir) * 16 + h) * 8192;
#pragma unroll
        for (int pt = 0; pt < 2; ++pt)
#pragma unroll
            for (int nt = 0; nt < 4; ++nt)
#pragma unroll
                for (int r = 0; r < 16; r += 2) {
                    const float x0 = acc[pt][nt][r], x1 = acc[pt][nt][r + 1];
                    const float send = (lane & 1) ? x0 : x1, got = __shfl_xor(send, 1);
                    const unsigned w = (lane & 1) ? pk2(got, x1) : pk2(x0, got);
                    *(unsigned*)(so + (size_t)(pt * 32 + crow(r, hl) + (lane & 1)) * 128 + nt * 32 + ((lane & 31) & ~1)) = w; }
        __syncthreads();
    }
}

__device__ __forceinline__ void phase_scan(const Prm& p, int gtid, int ngt) {
    const bf16* ST = (const bf16*)(p.ws + WS_ST); bf16* HS = (bf16*)(p.ws + WS_HS); const float* DEC = (const float*)(p.ws + WS_DEC);
    for (int e = gtid; e < 2 * 2 * 16 * 2048; e += ngt) {
        const int q = e & 2047, h = (e >> 11) & 15, dir = (e >> 15) & 1, b = e >> 16;
        f32x4 hs = {0.f, 0.f, 0.f, 0.f};
#pragma unroll 6
        for (int i = 0; i < NCH; ++i) {
            const int c = dir == 0 ? i : (i < 2 ? 1 - i : NCH + 1 - i);
            const size_t off = ((size_t)((b * NCH + c) * 2 + dir) * 16 + h) * 8192 + q * 4;
            const v2u sv = *(const v2u*)(ST + off); const float dc = DEC[((b * NCH + c) * 2 + dir) * 16 + h];
            v2u o; o.x = pk2(hs[0], hs[1]); o.y = pk2(hs[2], hs[3]); *(v2u*)(HS + off) = o;
            hs[0] = dc * hs[0] + bflo(sv.x); hs[1] = dc * hs[1] + bfhi(sv.x); hs[2] = dc * hs[2] + bflo(sv.y); hs[3] = dc * hs[3] + bfhi(sv.y);
        }
    }
}

constexpr int CST = 272, XSS = 80;
constexpr size_t WS_Y = WS_XG;
constexpr int S4_B = 0, S4_C = 128 * CST, S4_X = 2 * 128 * CST, S4_ARR = 3 * 128 * CST, S4_YX = S4_ARR + 8 * 2 * 128 * 4, S4_END = S4_YX + 4 * 16 * 64 * 4;
static_assert(S4_END <= RING_BYTES && S2_END <= RING_BYTES && 8 * 32 * XSS <= 128 * CST, "ssd LDS");
__device__ __forceinline__ void phase_ssd_out(const Prm& p, int l, LAS unsigned char* lds, int wg, int nwg, int tid) {
    const bf16* XA = (const bf16*)(p.ws + WS_XBC); const float* DT = (const float*)(p.ws + WS_DT); const bf16* HS = (const bf16*)(p.ws + WS_HS);
    bf16* Y = (bf16*)(p.ws + WS_Y);
    const int wid = __builtin_amdgcn_readfirstlane(tid >> 6), lane = tid & 63, hl = lane >> 5, l31 = lane & 31, pt = (wid >> 1) & 1, dir = wid >> 2;
    const int c_lo = (l == 0) ? 0 : 2, ncu = NCH - c_lo;
    for (int it = wg; it < 2 * ncu * 8; it += nwg) {
        const int b = it / (ncu * 8), rem = it % (ncu * 8), c = c_lo + (rem >> 3), g = (rem >> 2) & 1, hp = rem & 3, h = 8 * g + 2 * hp + (wid & 1);
        const int row0 = chunk_row0(b, c);
        { v4u tb[4], tc[4];
#pragma unroll
          for (int i = 0; i < 4; ++i) { const int id = tid + 512 * i, r = id >> 4, ch = id & 15; const bf16* src = XA + (size_t)(row0 + r) * XBCW + g * 128 + ch * 8; tb[i] = *(const v4u*)(src + 1024); tc[i] = *(const v4u*)(src + 1280); }
#pragma unroll
          for (int i = 0; i < 4; ++i) { const int id = tid + 512 * i, r = id >> 4, ch = id & 15; *(LAS v4u*)(lds + S4_B + r * CST + ch * 16) = tb[i]; *(LAS v4u*)(lds + S4_C + r * CST + ch * 16) = tc[i]; } }
        v4u tx[4];
#pragma unroll
        for (int i = 0; i < 4; ++i) { const int id = tid + 512 * i, r = id >> 4, ch = id & 15; tx[i] = *(const v4u*)(XA + (size_t)(row0 + r) * XBCW + (8 * g + 2 * hp) * 64 + ch * 8); }
        bf16x8 hs[8];
        { const bf16* hp_ = HS + ((size_t)((b * NCH + c) * 2 + dir) * 16 + h) * 8192 + (size_t)(pt * 32 + l31) * 128 + 8 * hl;
#pragma unroll
          for (int ks = 0; ks < 8; ++ks) hs[ks] = *(const bf16x8*)(hp_ + 16 * ks); }
        LAS float* QL = (LAS float*)(lds + S4_ARR) + wid * 256; LAS float* DL = QL + 128;
        float ebase;
        { const float a = -__expf(p.a_log[l * 32 + dir * 16 + h]);
          const float d0 = DT[(size_t)(row0 + lane) * 32 + dir * 16 + h], d1 = DT[(size_t)(row0 + 64 + lane) * 32 + dir * 16 + h];
          float q0 = a * d0, q1 = a * d1; scan128(q0, q1, lane); const float tot = lane63(q1);
          QL[lane] = dir == 0 ? q0 : a * d0 - q0; QL[64 + lane] = dir == 0 ? q1 : a * d1 - q1; DL[lane] = d0; DL[64 + lane] = d1; ebase = dir == 0 ? 0.f : tot; }
        __syncthreads();
#pragma unroll
        for (int j = 0; j < 2; ++j) { const int id = wid * 2 + j, st = id >> 2, tt = id & 3; f32x16 X = f32x16{};
#pragma unroll
            for (int ks = 0; ks < 8; ++ks) { const bf16x8 bfr = *(const LAS bf16x8*)(lds + S4_B + (st * 32 + l31) * CST + (16 * ks + 8 * hl) * 2), cfr = *(const LAS bf16x8*)(lds + S4_C + (tt * 32 + l31) * CST + (16 * ks + 8 * hl) * 2);
                X = __builtin_amdgcn_mfma_f32_32x32x16_bf16(bfr, cfr, X, 0, 0, 0); }
#pragma unroll
            for (int i = 0; i < 4; ++i) { v2u w; w.x = pk2(X[4 * i], X[4 * i + 1]); w.y = pk2(X[4 * i + 2], X[4 * i + 3]);
                *(LAS v2u*)(lds + S4_X + (tt * 32 + l31) * CST + (st * 32 + 8 * i + 4 * hl) * 2) = w; } }
        __syncthreads();
        bf16x8 xf[8];
        {
#pragma unroll
          for (int i = 0; i < 4; ++i) { const int id = tid + 512 * i, r = id >> 4, ch = id & 15; *(LAS v4u*)(lds + S4_B + r * CST + ch * 16) = tx[i]; }
          __syncthreads();
          const unsigned bXs = (unsigned)(uintptr_t)(lds + S4_B); const int c0 = (wid & 1) * 64 + pt * 32;
#pragma unroll
          for (int q = 0; q < 4; ++q) { Raw r0 = raw_tr_acc(bXs, CST, 32 * q, c0, lane), r1 = raw_tr_acc(bXs, CST, 32 * q + 16, c0, lane); raw_wait2(r0, r1); xf[2 * q] = join8(r0); xf[2 * q + 1] = join8(r1); }
        }
        const float dsum = p.d_skip[l * 32 + h] + p.d_skip[l * 32 + 16 + h];
        LAS float* YX = (LAS float*)(lds + S4_YX) + (wid & 3) * 1024;
#pragma unroll 1
        for (int tt = 0; tt < 4; ++tt) {
            const int tl = tt * 32 + l31;
            const float Qt = QL[tl];
            f32x16 yacc = f32x16{};
#pragma unroll
            for (int st = 0; st < 4; ++st) {
                if (dir == 0 ? (st > tt) : (st < tt)) continue;
                __builtin_amdgcn_sched_barrier(0);
                float mv[16];
#pragma unroll
                for (int i = 0; i < 4; ++i) { const v2u w = *(const LAS v2u*)(lds + S4_X + tl * CST + (st * 32 + 8 * i + 4 * hl) * 2);
                    const f32x4 qv = *(const LAS f32x4*)(QL + st * 32 + 8 * i + 4 * hl), dv = *(const LAS f32x4*)(DL + st * 32 + 8 * i + 4 * hl);
                    const float xv[4] = {bflo(w.x), bfhi(w.x), bflo(w.y), bfhi(w.y)};
#pragma unroll
                    for (int j = 0; j < 4; ++j) { const int s = st * 32 + 8 * i + 4 * hl + j; const bool ok = dir == 0 ? (s <= tl) : (s >= tl);
                        mv[4 * i + j] = ok ? __expf(Qt - qv[j]) * dv[j] * xv[j] : 0.f; } }
#pragma unroll
                for (int s2 = 0; s2 < 2; ++s2) { v4u q; q.x = cvtpk(mv[8 * s2 + 0], mv[8 * s2 + 1]); q.y = cvtpk(mv[8 * s2 + 2], mv[8 * s2 + 3]); q.z = cvtpk(mv[8 * s2 + 4], mv[8 * s2 + 5]); q.w = cvtpk(mv[8 * s2 + 6], mv[8 * s2 + 7]);
                    yacc = __builtin_amdgcn_mfma_f32_32x32x16_bf16(xf[2 * st + s2], *reinterpret_cast<bf16x8*>(&q), yacc, 0, 0, 0); }
            }
            __builtin_amdgcn_sched_barrier(0);
            { const LAS unsigned char* cfp = lds + S4_C + tl * CST + 16 * hl; f32x16 G = f32x16{};
#pragma unroll
              for (int ks = 0; ks < 8; ++ks) G = __builtin_amdgcn_mfma_f32_32x32x16_bf16(hs[ks], *(const LAS bf16x8*)(cfp + 32 * ks), G, 0, 0, 0);
              const float e = __expf(ebase + Qt);
#pragma unroll
              for (int r = 0; r < 16; ++r) yacc[r] += e * G[r]; }
            if (dir == 1) {
#pragma unroll
                for (int r = 0; r < 16; ++r) YX[r * 64 + lane] = yacc[r]; }
            __syncthreads();
            if (dir == 0) {
                const size_t trow = (size_t)(row0 + tl);
#pragma unroll
                for (int i = 0; i < 4; ++i) { const int pc = h * 64 + pt * 32 + 8 * i + 4 * hl; const v2u xw = *(const v2u*)(XA + trow * XBCW + pc);
                    f32x4 o; o[0] = yacc[4 * i] + YX[(4 * i) * 64 + lane] + dsum * bflo(xw.x); o[1] = yacc[4 * i + 1] + YX[(4 * i + 1) * 64 + lane] + dsum * bfhi(xw.x);
                    o[2] = yacc[4 * i + 2] + YX[(4 * i + 2) * 64 + lane] + dsum * bflo(xw.y); o[3] = yacc[4 * i + 3] + YX[(4 * i + 3) * 64 + lane] + dsum * bfhi(xw.y);
                    v2u w; w.x = pk2(o[0], o[1]); w.y = pk2(o[2], o[3]); *(v2u*)(Y + trow * 1024 + pc) = w; } }
            __syncthreads();
        }
    }
}
}
__device__ __forceinline__ void phase_norm2_router(const Prm& p, int l, LAS unsigned char* lds, int wg, int nwg, int tid, int wave, int lane) {
    bf16* H = (bf16*)(p.ws + WS_H); const bf16* WR = (const bf16*)(p.ws + WS_WRT);
    const int ntok = (l == 0) ? T_ALL : T_LAT;
    constexpr int HROW = 4096 + 16;
    LAS unsigned char* hfL = lds; LAS float* part = (LAS float*)(lds + 66048); LAS float* affL = (LAS float*)(lds + 66048 + 16384);
    int* tok_e = (int*)(p.ws + WS_TOK); int* tok_pos = (int*)(p.ws + WS_TOK + TOKTAB); float* tok_gate = (float*)(p.ws + WS_TOK + 2 * TOKTAB);
    unsigned* cnt = (unsigned*)(p.ws + OFF_CNT) + l * 32 * 16;
    for (int it = wg; it < ntok / 16; it += nwg) {
        const int m0 = it * 16;
#pragma unroll
        for (int rr = 0; rr < 2; ++rr) {
            const int r = wave * 2 + rr, m = m0 + r;
            f32x4 v[8]; load_row(p, 1, -1, m, lane, v);
            const float rstd = row_rstd(v);
            const int vs = m >= T_LAT ? 2 : (m >> 13);
            const float* md = (const float*)(p.ws + OFF_MOD) + (size_t)(l * 3 + vs) * MODW;
#pragma unroll
            for (int j = 0; j < 8; ++j) { const int col = 256 * j + 4 * lane; const f32x4 o = modulate4f(v[j], rstd, p.norm_ffn + l * DM, md + 4 * DM, md + 3 * DM, col);
                v2u w; w.x = pk2(o[0], o[1]); w.y = pk2(o[2], o[3]);
                *(unsigned*)((unsigned char*)H + (size_t)m * DM + col) = pack4f8(o[0], o[1], o[2], o[3]);
                *(LAS v2u*)(hfL + r * HROW + col * 2) = w; }
        }
        __syncthreads();
        {
            f32x4 a0 = {0.f, 0.f, 0.f, 0.f}, a1 = a0; const int fr = lane & 15, fq = lane >> 4;
#pragma unroll
            for (int ks = 0; ks < 8; ++ks) { const int k0 = wave * 256 + ks * 32 + 8 * fq;
                const bf16x8 af = *(const LAS bf16x8*)(hfL + fr * HROW + k0 * 2);
                const bf16x8 b0 = *(const bf16x8*)(WR + (size_t)fr * DM + k0), b1 = *(const bf16x8*)(WR + (size_t)(16 + fr) * DM + k0);
                a0 = __builtin_amdgcn_mfma_f32_16x16x32_bf16(af, b0, a0, 0, 0, 0); a1 = __builtin_amdgcn_mfma_f32_16x16x32_bf16(af, b1, a1, 0, 0, 0); }
#pragma unroll
            for (int i = 0; i < 4; ++i) { part[(wave * 16 + 4 * fq + i) * 32 + fr] = a0[i]; part[(wave * 16 + 4 * fq + i) * 32 + 16 + fr] = a1[i]; }
        }
        __syncthreads();
        { float s = 0.f;
#pragma unroll
          for (int w = 0; w < 8; ++w) s += part[w * 512 + tid];
          affL[tid] = sigmoid_f(s); }
        __syncthreads();
        if (tid < 16) {
            const LAS float* af = affL + tid * 32; const int m = m0 + tid;
            int bg = 0; float bs = -INFINITY;
#pragma unroll
            for (int g = 0; g < 4; ++g) { float t1 = -INFINITY, t2 = -INFINITY;
#pragma unroll
                for (int j = 0; j < 8; ++j) { const float s = af[8 * g + j] + p.router_bias[8 * g + j]; if (s > t1) { t2 = t1; t1 = s; } else if (s > t2) t2 = s; }
                const float gs = t1 + t2; if (gs > bs) { bs = gs; bg = g; } }
            float t1 = -INFINITY, t2 = -INFINITY; int i1 = 0, i2 = 0;
#pragma unroll
            for (int j = 0; j < 8; ++j) { const float s = af[8 * bg + j] + p.router_bias[8 * bg + j]; if (s > t1) { t2 = t1; i2 = i1; t1 = s; i1 = j; } else if (s > t2) { t2 = s; i2 = j; } }
            const int e0 = 8 * bg + i1, e1 = 8 * bg + i2; const float f0 = af[e0], f1 = af[e1], inv = 1.f / (f0 + f1);
            const unsigned p0 = atomicAdd(cnt + e0 * 16, 1u), p1 = atomicAdd(cnt + e1 * 16, 1u);
            int* list = (int*)(p.ws + WS_LIST); list[(size_t)e0 * LCAP + p0] = m; list[(size_t)e1 * LCAP + p1] = m;
            tok_e[2 * m] = e0; tok_e[2 * m + 1] = e1; tok_pos[2 * m] = (int)p0; tok_pos[2 * m + 1] = (int)p1; tok_gate[2 * m] = f0 * inv; tok_gate[2 * m + 1] = f1 * inv;
        }
        __syncthreads();
    }
}
__device__ __forceinline__ void build_seg_tables(const Prm& p, int l, LAS unsigned char* lds, int tid) {
    LAS int* seg = (LAS int*)(lds + L_SEG); LAS int* cntL = (LAS int*)(lds + L_CNT); LAS int* blke = (LAS int*)(lds + L_BLKE); LAS int* nblkp = (LAS int*)(lds + L_NBLK);
    LAS int* incl = (LAS int*)(lds + L_INCL);
    const unsigned* cnt = (const unsigned*)(p.ws + OFF_CNT) + l * 32 * 16;
    __syncthreads();
    LAS int* pbL = (LAS int*)(lds + L_PB);
    if (tid < 32) { const int c = (int)cnt[tid * 16]; cntL[tid] = c; pbL[tid] = (c + 255) >> 8; }
    __syncthreads();
    if (tid < 32) { int inc = 0;
#pragma unroll
        for (int k = 0; k < 32; ++k) inc += (k <= tid) ? pbL[k] : 0;
        seg[tid] = (inc - pbL[tid]) * 256; incl[tid] = inc; if (tid == 31) { seg[32] = inc * 256; *nblkp = inc; } }
    __syncthreads();
    if (tid < MAXBLK + 3) { int e = 0;
#pragma unroll
        for (int k = 0; k < 32; ++k) e += (incl[k] <= tid) ? 1 : 0;
        e = e < 31 ? e : 31; blke[tid] = e; ((LAS int*)(lds + L_BLKH))[tid] = (cntL[e] - 256 * (tid - (seg[e] >> 8)) <= 128) ? 1 : 0; }
    __syncthreads();
}
template <class Sched>
__device__ __forceinline__ void build_row_table(const Prm& p, const Sched& S, LAS unsigned char* lds, int tid) {
    const LAS int* seg = (const LAS int*)(lds + L_SEG); const LAS int* cntL = (const LAS int*)(lds + L_CNT); const LAS int* blke = (const LAS int*)(lds + L_BLKE);
    LAS unsigned* T = (LAS unsigned*)(lds + L_ROWT); const int* list = (const int*)(p.ws + WS_LIST);
#pragma unroll 1
    for (int i = 0; i < 8; ++i) { pg8::Unit u; if (!S.next(i, u)) break;
        const int e = blke[u.pm], base = (u.pm - (seg[e] >> 8)) * 256;
        if (tid < 256) { const int pos = base + tid; T[i * 256 + tid] = pos < cntL[e] ? (unsigned)WS_H + (unsigned)list[(size_t)e * LCAP + pos] * 2048u : ZERO_OFF; } }
    __syncthreads();
}
#ifndef SKIP_GU
#define SKIP_GU true
#endif
#ifndef SKIP_DN
#define SKIP_DN true
#endif
#ifndef NCONV
#define NCONV 16
#endif
constexpr int N_PHASES = 24;
__global__ void __launch_bounds__(NWAVES * 64, 2) mk_fwd(Prm p) {
    extern __shared__ __attribute__((aligned(16))) unsigned char lds_raw[];
    LAS unsigned char* lds = (LAS unsigned char*)lds_raw;
    const int tid0 = threadIdx.x, wave = __builtin_amdgcn_readfirstlane(tid0 >> 6);
#define OPQ int tid = tid0; asm volatile("" : "+v"(tid)); const int lane = tid & 63;
    const int G = gridDim.x, bx = blockIdx.x, vcu = (G % 8 == 0) ? (bx % 8) * (G / 8) + bx / 8 : bx;
    const int gw = vcu * NWAVES + wave, ngw = G * NWAVES;
    unsigned char* ws = p.ws;
    for (int u = tid0; u < (LDS_BYTES - LDSCTL_OFF) / 4; u += NWAVES * 64) ((LAS unsigned*)(lds + LDSCTL_OFF))[u] = 0u;
    __syncthreads();
#if MK_ONE_LAUNCH
    XcdBarrier bar = xcd_barrier_post((unsigned*)ws + CW_BAR, (volatile LAS unsigned*)(lds + L_BARW));
#define GRID_BAR() xcd_barrier(bar)
#define GRID_BAR_W() do { if (CONV_QUEUE) xcd_barrier_work(bar, p, lds, tid0); else xcd_barrier(bar); } while (0)
#else
#define GRID_BAR() do {} while (0)
#define GRID_BAR_W() do {} while (0)
#endif
    const int Gc = (CONV_QUEUE && MK_ONE_LAUNCH && G > 4 * NCONV) ? G - NCONV : G;
    const int lo = p.ph_lo, hi = p.ph_hi;
#define IN(k) (lo <= (k) && (k) < hi)
#ifndef DUPMASK
#define DUPMASK 0
#endif
#define REPS(kind) for (int rep_ = 0; rep_ < (((DUPMASK) >> (kind)) & 1) + 1; ++rep_)
    if (IN(0)) REPS(0) { OPQ phase_prologue(p, lds, gw, ngw, wave, lane, rep_ == 0); GRID_BAR(); }
    for (int l = 0; l < 2; ++l) {
        const int pb = 1 + 11 * l;
        if (IN(pb + 0)) { OPQ if (l > 0) { if (CONV_QUEUE) queue_drain(p, lds, tid, (unsigned)NP_PROJ);     build_seg_tables(p, l - 1, lds, tid); row_stream<true, false, false>(p, l, l - 1, T_ALL, gw, ngw, tid, lane, lds, (const LAS int*)(lds + L_SEG)); } else row_stream<false, false, true>(p, l, 0, T_ALL, gw, ngw, tid, lane, lds, (const LAS int*)(lds + L_SEG)); GRID_BAR_W(); }
        if (IN(pb + 1)) REPS(2) {
            pg8::Gemm g{(const pg8::bf16_t*)(ws + WS_H), (const pg8::bf16_t*)(ws + WS_WIN + (size_t)l * NINP * DM * (F8_INPROJ ? 1 : 2)), T_ALL, NINP, F8_INPROJ ? DM / 2 : DM};
            const int Ge = (l == 0) ? Gc : G;
            pg8::StaticOrder S; S.init(T_ALL, NINP, Ge, bx);
            pg8::EpiInProj E{(pg8::bf16_t*)(ws + WS_U), NINP, (const float*)(ws + WS_ROPE), C_QB / 256, C_VB / 256, T_LAT, F8_INPROJ ? 1.f / W8_SCALE : 1.f};
            if (bx < Ge) pg8::gemm_phase<pg8::EpiInProj, pg8::StaticOrder, true, true, F8_INPROJ != 0>(lds, g, S, E);
            GRID_BAR_W();
        }
        if (IN(pb + 2)) REPS(3) { OPQ
            if ((bx >> 3) & 1) { att::phase_attn(p, l, lds, bx, G, tid); phase_conv(p, l, gw, ngw, lane); } else { phase_conv(p, l, gw, ngw, lane); att::phase_attn(p, l, lds, bx, G, tid); } GRID_BAR_W(); }
        if (IN(pb + 3)) REPS(4) { OPQ { const int Ge = (l == 0) ? Gc : G; if (bx < Ge) ssd::phase_states(p, l, lds, bx, Ge, tid); } GRID_BAR_W(); }
        if (IN(pb + 4)) REPS(5) { OPQ ssd::phase_scan(p, bx * (NWAVES * 64) + tid, G * NWAVES * 64); GRID_BAR_W(); }
        if (IN(pb + 5)) REPS(6) { OPQ { const int Ge = (l == 0) ? Gc : G; if (bx < Ge) ssd::phase_ssd_out(p, l, lds, bx, Ge, tid); } GRID_BAR_W(); }
        if (IN(pb + 6)) REPS(7) { OPQ phase_gnorm(p, l, gw, ngw, lane); GRID_BAR_W(); }
        if (IN(pb + 7)) {
            const int M = (l == 0) ? T_ALL : T_LAT;
            pg8::Gemm g{(const pg8::bf16_t*)(ws + WS_H), (const pg8::bf16_t*)(ws + WS_WOUT + (size_t)l * DM * DM * (F8_OUTPROJ ? 1 : 2)), M, DM, F8_OUTPROJ ? DM / 2 : DM};
            const int Ge = (l == 0) ? Gc : G;
            pg8::StaticOrder S; S.init(M, DM, Ge, bx);
            pg8::EpiRes E{(l == 0) ? (const void*)p.x : (const void*)(ws + WS_X), (pg8::bf16_t*)(ws + WS_X), (l == 0) ? (const void*)p.ctx : (const void*)(ws + WS_XC), (pg8::bf16_t*)(ws + WS_XC),
                          (const float*)(ws + OFF_MOD) + (size_t)l * 3 * MODW + 2 * DM, DM, T_LAT, MODW, F8_OUTPROJ ? 1.f / (W8_SCALE * MIX_SCALE) : 1.f, l == 0 ? 1 : 0};
            if (bx < Ge) pg8::gemm_phase<pg8::EpiRes, pg8::StaticOrder, true, true, F8_OUTPROJ != 0>(lds, g, S, E);
            GRID_BAR_W();
        }
        if (IN(pb + 8)) { OPQ phase_norm2_router(p, l, lds, bx, G, tid, wave, lane); GRID_BAR_W(); }
        if (IN(pb + 9) && CONV_QUEUE && l == 1) { OPQ queue_drain(p, lds, tid, (unsigned)Q_TOTAL); GRID_BAR(); }
        if (IN(pb + 9)) REPS(11) {
            OPQ build_seg_tables(p, l, lds, tid);
            const int nblk = __builtin_amdgcn_readfirstlane(*(const LAS int*)(lds + L_NBLK));
            pg8::Gemm g{(const pg8::bf16_t*)ws, (const pg8::bf16_t*)(ws + WS_WGU + (size_t)l * 32 * 2048 * 2048), nblk * 256, 2048, DM / 2};
            pg8::GroupedOrderT<SKIP_GU, true> S{G, vcu, nblk, (const LAS int*)(lds + L_BLKE), (const LAS int*)(lds + L_BLKH), (long)2048 * 2048, (const LAS unsigned*)(lds + L_ROWT)};
            build_row_table(p, S, lds, tid);
            pg8::EpiGateUp E{ws + WS_ACT, DFF, 1.f / W8_SCALE};
            pg8::gemm_phase<pg8::EpiGateUp, pg8::GroupedOrderT<SKIP_GU, true>, true, true, true>(lds, g, S, E);
            GRID_BAR_W();
        }
        if (IN(pb + 10)) REPS(12) {
            OPQ build_seg_tables(p, l, lds, tid);
            const int nblk = __builtin_amdgcn_readfirstlane(*(const LAS int*)(lds + L_NBLK));
            pg8::Gemm g{(const pg8::bf16_t*)(ws + WS_ACT), (const pg8::bf16_t*)(ws + WS_WDN + (size_t)l * 32 * 2048 * 1024), nblk * 256, DM, DFF / 2};
            pg8::GroupedOrderT<SKIP_DN> S{G, vcu, nblk, (const LAS int*)(lds + L_BLKE), (const LAS int*)(lds + L_BLKH), (long)2048 * 1024, nullptr};
            pg8::EpiF8 E{ws + WS_YB, DM, Y8_SCALE / W8_SCALE};
            pg8::gemm_phase<pg8::EpiF8, pg8::GroupedOrderT<SKIP_DN>, true, true, true>(lds, g, S, E);
            GRID_BAR_W();
        }
    }
    if (IN(23)) { OPQ build_seg_tables(p, 1, lds, tid); row_stream<true, true, false>(p, 1, 1, T_LAT, gw, ngw, tid, lane, lds, (const LAS int*)(lds + L_SEG)); }
#undef IN
}

extern "C" void kernel_launch(void* const* d_in, const int* in_sizes, int n_in, void* d_out, int out_size, void* d_ws, size_t ws_size, hipStream_t stream) {
    static int grid = 0;
    if (grid == 0) {
        if (n_in != 24 || in_sizes[0] != T_LAT * DM || out_size != T_LAT * DM || ws_size < WS_END) {
            fprintf(stderr, "kernel_launch: unexpected shapes: n_in %d in0 %d out %d ws %zu (need %zu)\n", n_in, n_in > 0 ? in_sizes[0] : -1, out_size, ws_size, (size_t)WS_END); grid = -1; return; }
        int dev = 0, cus = 0, per_cu = 0;
        if (hipGetDevice(&dev) != hipSuccess || hipDeviceGetAttribute(&cus, hipDeviceAttributeMultiprocessorCount, dev) != hipSuccess) { grid = -1; return; }
        if (hipFuncSetAttribute((const void*)mk_fwd, hipFuncAttributeMaxDynamicSharedMemorySize, LDS_BYTES) != hipSuccess) { fprintf(stderr, "kernel_launch: hipFuncSetAttribute failed\n"); grid = -1; return; }
        if (hipOccupancyMaxActiveBlocksPerMultiprocessor(&per_cu, (const void*)mk_fwd, NWAVES * 64, LDS_BYTES) != hipSuccess || per_cu < 1) {
            fprintf(stderr, "kernel_launch: occupancy query reports %d blocks per CU\n", per_cu); }
        (void)hipGetLastError();
        grid = cus;
    }
    if (grid < 0) return;
    if (hipMemsetAsync((char*)d_ws + WS_CTL, 0, CTL_ZERO_BYTES, stream) != hipSuccess) { fprintf(stderr, "kernel_launch: memset failed\n"); return; }
    Prm p{};
    p.x = (const float*)d_in[0]; p.c = (const float*)d_in[1]; p.ctx = (const float*)d_in[2]; p.c_ctx = (const float*)d_in[3]; p.w_ada = (const float*)d_in[4]; p.b_ada = (const float*)d_in[5];
    p.norm_mix = (const float*)d_in[6]; p.norm_ffn = (const float*)d_in[7]; p.norm_final = (const float*)d_in[8]; p.w_in = (const float*)d_in[9]; p.w_out = (const float*)d_in[10];
    p.na_rpb = (const float*)d_in[11]; p.wa_sink = (const float*)d_in[12]; p.conv_w = (const float*)d_in[13]; p.conv_b = (const float*)d_in[14]; p.a_log = (const float*)d_in[15];
    p.dt_bias = (const float*)d_in[16]; p.d_skip = (const float*)d_in[17]; p.ssd_norm = (const float*)d_in[18]; p.w_router = (const float*)d_in[19]; p.router_bias = (const float*)d_in[20];
    p.w_gate = (const float*)d_in[21]; p.w_up = (const float*)d_in[22]; p.w_down = (const float*)d_in[23];
    p.out = (float*)d_out; p.ws = (unsigned char*)d_ws;
#if MK_ONE_LAUNCH
    p.ph_lo = 0; p.ph_hi = N_PHASES;
    hipLaunchKernelGGL(mk_fwd, dim3(grid), dim3(NWAVES * 64), LDS_BYTES, stream, p);
#else
    for (int ph = 0; ph < N_PHASES; ++ph) { p.ph_lo = ph; p.ph_hi = ph + 1; hipLaunchKernelGGL(mk_fwd, dim3(grid), dim3(NWAVES * 64), LDS_BYTES, stream, p); }
#endif
    const hipError_t le = hipPeekAtLastError();
    if (le != hipSuccess) fprintf(stderr, "kernel_launch: launch failed: %s\n", hipGetErrorName(le));
}
```

```cpp
#include <hip/hip_runtime.h>
#include <cstdio>
#include <cstdint>

#ifndef MK_ONE_LAUNCH
#define MK_ONE_LAUNCH 1
#endif

#ifndef F8_INPROJ
#define F8_INPROJ 1
#endif
#ifndef F8_OUTPROJ
#define F8_OUTPROJ 1
#endif

namespace pg8 {
#define PG8_LAS __attribute__((address_space(3)))
typedef unsigned short bf16_t;
typedef short bf16x8 __attribute__((ext_vector_type(8)));
typedef float f32x4 __attribute__((ext_vector_type(4)));
typedef unsigned u32x4 __attribute__((ext_vector_type(4)));
constexpr int BM = 256, BK = 64, HALF = 128, HTB = HALF * BK * 2  , STAGE_BYTES = 8 * HTB, NXCD = 8, WGM = 8;

__host__ __device__ __forceinline__ int lds_byte(int r, int c) { const int st = (r >> 4) * 2 + (c >> 5), rr = r & 15, cc = c & 31, ob = rr * 64 + cc * 2; return st * 1024 + (ob ^ (((ob >> 9) & 1) << 5)); }
__host__ __device__ __forceinline__ void stage_rc(int b, int& R, int& C) { const int st = b / 1024, sb = b % 1024, swz = sb ^ (((sb >> 9) & 1) << 5); R = (st >> 1) * 16 + swz / 64; C = (st & 1) * 32 + (swz % 64) / 2; }
__host__ __device__ __forceinline__ int perm32(int rho) { const int n = rho >> 4, i = rho & 15; return 8 * (i >> 2) + 4 * n + (i & 3); }

typedef int i32x4v __attribute__((ext_vector_type(4)));
typedef int i32x8v __attribute__((ext_vector_type(8)));
__device__ __forceinline__ i32x8v cat8(bf16x8 a, bf16x8 b) { const i32x4v x = __builtin_bit_cast(i32x4v, a), y = __builtin_bit_cast(i32x4v, b); return __builtin_shufflevector(x, y, 0, 1, 2, 3, 4, 5, 6, 7); }
struct Unit { int pm, pn; long boff; int lo_only; };
struct Gemm { const bf16_t* A; const bf16_t* Bt; int M, N, K; };

struct StaticOrder {
    static constexpr bool SKIP_HI = false, GATHER = false; const PG8_LAS unsigned* rowtab;
    int nM, nN, nwg, G, c;
    __host__ __device__ void init(int M, int N, int G_, int c_) { nM = M / BM; nN = N / BM; nwg = nM * nN; G = G_; c = c_; }
    __host__ __device__ bool next(int i, Unit& u) const {
        const long L = (long)i * G + c; if (L >= nwg) return false;
        int wgid = (int)L; { const int q = nwg / NXCD, r = nwg % NXCD, xcd = wgid % NXCD, off = wgid / NXCD; wgid = (xcd < r ? xcd * (q + 1) : r * (q + 1) + (xcd - r) * q) + off; }
        const int nig = WGM * nN, gid = wgid / nig, fm = gid * WGM, gsz = (nM - fm) < WGM ? (nM - fm) : WGM;
        u.pm = fm + ((wgid % nig) % gsz); u.pn = (wgid % nig) / gsz; u.boff = 0; u.lo_only = 0; return true;
    }
    __device__ __forceinline__ void a_ready(const Unit&) const {}
    __device__ __forceinline__ void done(const Unit&) const {}
};

__device__ __forceinline__ unsigned cvt_pk_bf16(float lo, float hi) { unsigned r; asm volatile("v_cvt_pk_bf16_f32 %0, %1, %2" : "=v"(r) : "v"(lo), "v"(hi)); return r; }
typedef float f32x2 __attribute__((ext_vector_type(2)));
__device__ __forceinline__ f32x2 gelu_pk(f32x2 v) {
    const f32x2 av = __builtin_elementwise_abs(v), d = av * 0.2316418882f + 1.0f;
    f32x2 t; t.x = __builtin_amdgcn_rcpf(d.x); t.y = __builtin_amdgcn_rcpf(d.y);
    f32x2 q = t * 0.5307027145f + (-0.7265760135f); q = q * t + 0.7107068705f; q = q * t + (-0.142248368f); q = q * t + 0.127414796f; q = q * t;
    const f32x2 s = (v * v) * (-0.72134752044f);
    f32x2 e; e.x = __builtin_amdgcn_exp2f(s.x); e.y = __builtin_amdgcn_exp2f(s.y);
    const f32x2 m = v * (q * e), r = v - m;
    f32x2 o; o.x = v.x < 0.f ? m.x : r.x; o.y = v.y < 0.f ? m.y : r.y; return o;
}

template <class Epi, class Sched, bool ALIGN_EPI = false, bool SP2 = false, bool F8 = false>
__device__ __forceinline__ void gemm_phase(PG8_LAS unsigned char* lds, const Gemm g, const Sched& S, const Epi& E) {
    int tid_o = threadIdx.x; asm volatile("" : "+v"(tid_o));
    const int tid = tid_o, wid = __builtin_amdgcn_readfirstlane(tid >> 6), lane = tid & 63, wr = wid >> 2, wc = wid & 3, fr = lane & 15, fq = lane >> 4;
    const int K = g.K, nt = K / BK;
    unsigned voffA[2], voffB[2];
#pragma unroll
    for (int i = 0; i < 2; ++i) { int R, C; stage_rc(tid * 16 + i * 8192, R, C); const int Rb = Epi::PERM ? ((R & ~31) + perm32(R & 31)) : R;
        voffA[i] = (unsigned)(R * K + C) * 2u; voffB[i] = (unsigned)(Rb * K + C) * 2u; }
    int gR[2]; unsigned gC[2];
#pragma unroll
    for (int i = 0; i < 2; ++i) { int R, C; stage_rc(tid * 16 + i * 8192, R, C); gR[i] = R; gC[i] = (unsigned)C * 2u; }
    unsigned gc[2][2] = {{0u, 0u}, {0u, 0u}}, gn[2][2] = {{0u, 0u}, {0u, 0u}};
#define PG8_GROWS(dst, u) do { if constexpr (Sched::GATHER) { _Pragma("unroll") for (int h_ = 0; h_ < 2; ++h_) _Pragma("unroll") for (int i_ = 0; i_ < 2; ++i_) dst[h_][i_] = S.rowtab[(u) * 256 + h_ * 128 + gR[i_]] + gC[i_]; } } while (0)
#define PG8_STAGE_A(bufoff, kbase, h, nx) do { if constexpr (Sched::GATHER) { _Pragma("unroll") for (int _i = 0; _i < 2; ++_i) \
        __builtin_amdgcn_global_load_lds((const unsigned*)((const char*)(kbase) + ((nx) ? gn[h][_i] : gc[h][_i])), (PG8_LAS unsigned*)(lds + (bufoff) + ldsw + _i * 8192), 16, 0, 0); } \
        else PG8_STAGE(bufoff, (kbase) + ((h) ? hstep : 0), voffA); } while (0)
    const size_t kstep = (size_t)(BK * 2);
    const size_t hstep = (size_t)HALF * K * 2;
    const size_t tstep = 2 * hstep;
    const unsigned ldsw = (unsigned)wid * 1024u;
    const int aoff = lds_byte(wr * 64 + fr, fq * 8), boff = lds_byte(wc * 32 + fr, fq * 8);
    const int aoff8 = lds_byte(wr * 64 + fr, (fq & 1) * 16) + (fq >> 1) * 1024, boff8 = lds_byte(wc * 32 + fr, (fq & 1) * 16) + (fq >> 1) * 1024;
#define PG8_SA(b, h) (((b) * 2 + (h)) * HTB)
#define PG8_SB(b, h) ((4 + (b) * 2 + (h)) * HTB)
#define PG8_STAGE(bufoff, gbase, voff) do { _Pragma("unroll") for (int _i = 0; _i < 2; ++_i) \
        __builtin_amdgcn_global_load_lds((const unsigned*)((const char*)(gbase) + (voff)[_i]), (PG8_LAS unsigned*)(lds + (bufoff) + ldsw + _i * 8192), 16, 0, 0); } while (0)
#define PG8_LDA(dst, b, h) do { if constexpr (F8) { _Pragma("unroll") for (int m = 0; m < 4; ++m) dst##8[m] = cat8(*(const PG8_LAS bf16x8*)(lds + PG8_SA(b, h) + aoff8 + m * 2048), *(const PG8_LAS bf16x8*)(lds + PG8_SA(b, h) + aoff8 + m * 2048 + 16)); } else { \
        _Pragma("unroll") for (int m = 0; m < 4; ++m) _Pragma("unroll") for (int k = 0; k < 2; ++k) dst[m][k] = *(const PG8_LAS bf16x8*)(lds + PG8_SA(b, h) + aoff + m * 2048 + k * 1024); } } while (0)
#define PG8_LDB(dst, b, h) do { if constexpr (F8) { _Pragma("unroll") for (int n = 0; n < 2; ++n) dst##8[n] = cat8(*(const PG8_LAS bf16x8*)(lds + PG8_SB(b, h) + boff8 + n * 2048), *(const PG8_LAS bf16x8*)(lds + PG8_SB(b, h) + boff8 + n * 2048 + 16)); } else { \
        _Pragma("unroll") for (int n = 0; n < 2; ++n) _Pragma("unroll") for (int k = 0; k < 2; ++k) dst[n][k] = *(const PG8_LAS bf16x8*)(lds + PG8_SB(b, h) + boff + n * 2048 + k * 1024); } } while (0)
#define PG8_MMA(ai, bj, At, Bt) do { __builtin_amdgcn_s_setprio(1); if constexpr (F8) { _Pragma("unroll") for (int m = 0; m < 4; ++m) _Pragma("unroll") for (int n = 0; n < 2; ++n) \
        asm volatile("v_mfma_scale_f32_16x16x128_f8f6f4 %0, %1, %2, %0, %3, %3 op_sel_hi:[0,0,0]" : "+v"(acc[ai][bj][m][n]) : "v"(Bt##8[n]), "v"(At##8[m]), "v"(sc1)); } else { \
        _Pragma("unroll") for (int m = 0; m < 4; ++m) _Pragma("unroll") for (int n = 0; n < 2; ++n) _Pragma("unroll") for (int k = 0; k < 2; ++k) \
        acc[ai][bj][m][n] = __builtin_amdgcn_mfma_f32_16x16x32_bf16(Bt[n][k], At[m][k], acc[ai][bj][m][n], 0, 0, 0); } __builtin_amdgcn_s_setprio(0); } while (0)
#define PG8_WAIT_V(n) asm volatile("s_waitcnt vmcnt(" #n ")" ::: "memory")
#define PG8_WAIT_L(n) asm volatile("s_waitcnt lgkmcnt(" #n ")" ::: "memory")
#define PG8_BAR __builtin_amdgcn_s_barrier()
#define PG8_SCHED __builtin_amdgcn_sched_barrier(0)
    Unit cur, nxt; int ui = 0;
    if (!S.next(0, cur)) return;
    f32x4 acc[2][2][4][2];
#pragma unroll
    for (int a = 0; a < 2; ++a)
#pragma unroll
        for (int b = 0; b < 2; ++b)
#pragma unroll
            for (int m = 0; m < 4; ++m)
#pragma unroll
                for (int n = 0; n < 2; ++n) acc[a][b][m][n] = (f32x4){0.f, 0.f, 0.f, 0.f};
    const int sc1 = 0x7F7F7F7F;
    bf16x8 At[4][2], B0[2][2], B1[2][2]; i32x8v At8[4], B08[2], B18[2];
    const char* cA = (const char*)g.A + (Sched::GATHER ? (size_t)0 : (size_t)cur.pm * tstep); PG8_GROWS(gc, 0); const char* cB = (const char*)g.Bt + (size_t)cur.pn * tstep + cur.boff;
    S.a_ready(cur);
    if constexpr (SP2) {
        PG8_STAGE(PG8_SB(0, 0), cB, voffB); PG8_STAGE(PG8_SB(0, 1), cB + hstep, voffB); PG8_STAGE_A(PG8_SA(0, 0), cA, 0, false); PG8_STAGE_A(PG8_SA(0, 1), cA, 1, false);
        if (wr == 1) PG8_BAR;
        PG8_WAIT_V(2); PG8_BAR;
        PG8_STAGE(PG8_SB(1, 0), cB + kstep, voffB); PG8_STAGE_A(PG8_SA(1, 0), cA + kstep, 0, false); PG8_STAGE(PG8_SB(1, 1), cB + hstep + kstep, voffB);
        PG8_WAIT_V(6); PG8_BAR;
    } else {
        PG8_STAGE(PG8_SB(0, 0), cB, voffB); PG8_STAGE_A(PG8_SA(0, 0), cA, 0, false); PG8_STAGE(PG8_SB(0, 1), cB + hstep, voffB); PG8_STAGE_A(PG8_SA(0, 1), cA, 1, false);
        if (wr == 1) PG8_BAR;
        PG8_WAIT_V(4); PG8_BAR;
        PG8_STAGE(PG8_SB(1, 0), cB + kstep, voffB); PG8_STAGE_A(PG8_SA(1, 0), cA + kstep, 0, false); PG8_STAGE(PG8_SB(1, 1), cB + hstep + kstep, voffB);
        PG8_WAIT_V(6); PG8_BAR;
    }
    for (;;) {
        const bool has_next = S.next(ui + 1, nxt);
        const char* nA = has_next ? (const char*)g.A + (Sched::GATHER ? (size_t)0 : (size_t)nxt.pm * tstep) : cA; if (has_next) PG8_GROWS(gn, ui + 1); const char* nB = has_next ? (const char*)g.Bt + (size_t)nxt.pn * tstep + nxt.boff : cB;
        const bool hi_on = !Sched::SKIP_HI || cur.lo_only == 0;
#pragma unroll 1
        for (int t = 0; t < nt; t += 2) {
            const bool last = (t == nt - 2);
            const char* a1 = cA + (size_t)(t + 1) * kstep;
            const char* a2 = last ? nA : cA + (size_t)(t + 2) * kstep; const char* b2 = last ? nB : cB + (size_t)(t + 2) * kstep;
            const char* a3 = a2 + kstep; const char* b3 = b2 + kstep;
            const bool nx_ = last && has_next;
            if (last && has_next) S.a_ready(nxt);
            if constexpr (SP2) {
            PG8_LDB(B0, 0, 0); PG8_LDB(B1, 0, 1); PG8_SCHED; PG8_LDA(At, 0, 0); PG8_STAGE_A(PG8_SA(1, 1), a1, 1, false);
            PG8_WAIT_V(8); PG8_WAIT_L(0); PG8_BAR; PG8_MMA(0, 0, At, B0); PG8_MMA(0, 1, At, B1); PG8_BAR; PG8_SCHED;
            PG8_LDA(At, 0, 1); PG8_STAGE(PG8_SB(0, 0), b2, voffB); PG8_STAGE(PG8_SB(0, 1), b2 + hstep, voffB); PG8_STAGE_A(PG8_SA(0, 0), a2, 0, nx_);
            PG8_WAIT_V(8); PG8_WAIT_L(0); PG8_BAR; if (__builtin_expect(hi_on, 1)) { PG8_MMA(1, 0, At, B0); PG8_MMA(1, 1, At, B1); } PG8_BAR; PG8_SCHED;
            PG8_LDB(B0, 1, 0); PG8_LDB(B1, 1, 1); PG8_SCHED; PG8_LDA(At, 1, 0); PG8_STAGE_A(PG8_SA(0, 1), a2, 1, nx_);
            PG8_WAIT_V(8); PG8_WAIT_L(0); PG8_BAR; PG8_MMA(0, 0, At, B0); PG8_MMA(0, 1, At, B1); PG8_BAR; PG8_SCHED;
            PG8_LDA(At, 1, 1); PG8_STAGE(PG8_SB(1, 0), b3, voffB); PG8_STAGE(PG8_SB(1, 1), b3 + hstep, voffB); PG8_STAGE_A(PG8_SA(1, 0), a3, 0, nx_);
            PG8_WAIT_V(8); PG8_WAIT_L(0); PG8_BAR; if (__builtin_expect(hi_on, 1)) { PG8_MMA(1, 0, At, B0); PG8_MMA(1, 1, At, B1); } PG8_BAR; PG8_SCHED;
            } else {
            PG8_LDB(B0, 0, 0); PG8_SCHED; PG8_LDA(At, 0, 0); PG8_STAGE_A(PG8_SA(1, 1), a1, 1, false);
            PG8_WAIT_L(8); PG8_BAR; PG8_WAIT_L(0); PG8_MMA(0, 0, At, B0); PG8_BAR; PG8_SCHED;
            PG8_LDB(B1, 0, 1); PG8_STAGE(PG8_SB(0, 0), b2, voffB);
            PG8_BAR; PG8_WAIT_L(0); PG8_MMA(0, 1, At, B1); PG8_BAR;
            PG8_LDA(At, 0, 1); PG8_STAGE_A(PG8_SA(0, 0), a2, 0, nx_);
            PG8_BAR; PG8_WAIT_L(0); PG8_MMA(1, 0, At, B0); PG8_BAR; PG8_SCHED;
            PG8_STAGE(PG8_SB(0, 1), b2 + hstep, voffB);
            PG8_WAIT_V(6); PG8_BAR; PG8_MMA(1, 1, At, B1); PG8_BAR;
            PG8_LDB(B0, 1, 0); PG8_SCHED; PG8_LDA(At, 1, 0); PG8_STAGE_A(PG8_SA(0, 1), a2, 1, nx_);
            PG8_WAIT_L(8); PG8_BAR; PG8_WAIT_L(0); PG8_MMA(0, 0, At, B0); PG8_BAR; PG8_SCHED;
            PG8_LDB(B1, 1, 1); PG8_STAGE(PG8_SB(1, 0), b3, voffB);
            PG8_BAR; PG8_WAIT_L(0); PG8_MMA(0, 1, At, B1); PG8_BAR;
            PG8_LDA(At, 1, 1); PG8_STAGE_A(PG8_SA(1, 0), a3, 0, nx_);
            PG8_BAR; PG8_WAIT_L(0); PG8_MMA(1, 0, At, B0); PG8_BAR; PG8_SCHED;
            PG8_STAGE(PG8_SB(1, 1), b3 + hstep, voffB);
            PG8_WAIT_V(6); PG8_BAR; PG8_MMA(1, 1, At, B1); PG8_BAR;
            }
        }
        if constexpr (F8) asm volatile("s_nop 15\n\ts_nop 15" ::: "memory");
        if constexpr (ALIGN_EPI) { if (wr == 0) PG8_BAR; }
        if constexpr (!Epi::AFTER_DRAIN) { E(acc, cur, wr, wc, fr, fq); S.done(cur); }
        if (!has_next) break;
#pragma unroll
        for (int a = 0; a < 2; ++a)
#pragma unroll
            for (int b = 0; b < 2; ++b)
#pragma unroll
                for (int m = 0; m < 4; ++m)
#pragma unroll
                    for (int n = 0; n < 2; ++n) acc[a][b][m][n] = (f32x4){0.f, 0.f, 0.f, 0.f};
        cur = nxt; cA = nA; cB = nB; ++ui;
        if constexpr (Sched::GATHER) { gc[0][0] = gn[0][0]; gc[0][1] = gn[0][1]; gc[1][0] = gn[1][0]; gc[1][1] = gn[1][1]; }
        if constexpr (ALIGN_EPI) { if (wr == 1) PG8_BAR; }
    }
    PG8_WAIT_V(0);
    if constexpr (!ALIGN_EPI) { if (wr == 0) PG8_BAR; }
    PG8_BAR;
    if constexpr (Epi::AFTER_DRAIN) { E.fused(acc, cur, wr, wc, fr, fq, lds, wid, lane); S.done(cur); }
#undef PG8_SA
#undef PG8_SB
#undef PG8_STAGE
#undef PG8_STAGE_A
#undef PG8_GROWS
#undef PG8_LDA
#undef PG8_LDB
#undef PG8_MMA
#undef PG8_WAIT_V
#undef PG8_WAIT_L
#undef PG8_BAR
#undef PG8_SCHED
}
typedef unsigned u32x2e __attribute__((ext_vector_type(2)));
struct EpiPlain {
    static constexpr bool PERM = true, AFTER_DRAIN = false;
    bf16_t* O; int ldc; float scale;
    __device__ __forceinline__ void operator()(const f32x4 (&acc)[2][2][4][2], const Unit& u, int wr, int wc, int fr, int fq) const {
        const int row0 = u.pm * BM + wr * 64 + fr, col0 = u.pn * BM + wc * 32 + 8 * fq;
        float one = scale; asm volatile("" : "+v"(one));
#pragma unroll
        for (int ai = 0; ai < 2; ++ai)
#pragma unroll
            for (int m = 0; m < 4; ++m) { bf16_t* rowp = O + (size_t)(row0 + ai * HALF + m * 16) * ldc + col0;
#pragma unroll
                for (int bj = 0; bj < 2; ++bj) { const f32x4 v0 = acc[ai][bj][m][0] * one, v1 = acc[ai][bj][m][1] * one;
                    u32x4 w; w.x = cvt_pk_bf16(v0[0], v0[1]); w.y = cvt_pk_bf16(v0[2], v0[3]); w.z = cvt_pk_bf16(v1[0], v1[1]); w.w = cvt_pk_bf16(v1[2], v1[3]);
                    *(u32x4*)(rowp + bj * HALF) = w; } }
    }
};
struct EpiF8 {
    static constexpr bool PERM = true, AFTER_DRAIN = false;
    unsigned char* O; int ldc; float scale;
    __device__ __forceinline__ void operator()(const f32x4 (&acc)[2][2][4][2], const Unit& u, int wr, int wc, int fr, int fq) const {
        const int row0 = u.pm * BM + wr * 64 + fr, col0 = u.pn * BM + wc * 32 + 8 * fq;
        float one = scale; asm volatile("" : "+v"(one));
#pragma unroll
        for (int ai = 0; ai < 2; ++ai)
#pragma unroll
            for (int m = 0; m < 4; ++m) { unsigned char* rowp = O + (size_t)(row0 + ai * HALF + m * 16) * ldc + col0;
#pragma unroll
                for (int bj = 0; bj < 2; ++bj) { const f32x4 v0 = acc[ai][bj][m][0] * one, v1 = acc[ai][bj][m][1] * one;
                    u32x2e w; { int t = __builtin_amdgcn_cvt_pk_fp8_f32(v0[0], v0[1], 0, false); t = __builtin_amdgcn_cvt_pk_fp8_f32(v0[2], v0[3], t, true); w.x = (unsigned)t; }
                    { int t = __builtin_amdgcn_cvt_pk_fp8_f32(v1[0], v1[1], 0, false); t = __builtin_amdgcn_cvt_pk_fp8_f32(v1[2], v1[3], t, true); w.y = (unsigned)t; }
                    *(u32x2e*)(rowp + bj * HALF) = w; } }
    }
};
struct EpiInProj {
    static constexpr bool PERM = true, AFTER_DRAIN = false;
    bf16_t* O; int ldc; const float* rope; int rope_lo, rope_hi, lat_rows; float scale;
    __device__ __forceinline__ void operator()(const f32x4 (&acc)[2][2][4][2], const Unit& u, int wr, int wc, int fr, int fq) const {
        const int row0 = u.pm * BM + wr * 64 + fr, col0 = u.pn * BM + wc * 32 + 8 * fq;
        const bool do_rope = (u.pn >= rope_lo) && (u.pn < rope_hi) && (u.pm * BM < lat_rows);
        const int i0 = 16 * (wc & 1) + 4 * fq, half = wc >> 1;
        float one = scale; asm volatile("" : "+v"(one));
#pragma unroll
        for (int ai = 0; ai < 2; ++ai)
#pragma unroll
            for (int m = 0; m < 4; ++m) { const int row = row0 + ai * HALF + m * 16; bf16_t* rowp = O + (size_t)row * ldc + col0;
                f32x4 cs0 = {1.f, 0.f, 1.f, 0.f}, cs1 = {1.f, 0.f, 1.f, 0.f};
                if (do_rope) { const int s = row & 8191, pos = half ? (s & 63) : (s >> 6); const f32x4* tp = (const f32x4*)(rope + (size_t)(pos * 32 + i0) * 2); cs0 = tp[0]; cs1 = tp[1]; }
#pragma unroll
                for (int bj = 0; bj < 2; ++bj) { f32x4 v0 = acc[ai][bj][m][0] * one, v1 = acc[ai][bj][m][1] * one;
                    if (do_rope) {
                        const f32x4 a = v0, b = v1;
                        v0[0] = a[0] * cs0[0] - a[1] * cs0[1]; v0[1] = a[1] * cs0[0] + a[0] * cs0[1];
                        v0[2] = a[2] * cs0[2] - a[3] * cs0[3]; v0[3] = a[3] * cs0[2] + a[2] * cs0[3];
                        v1[0] = b[0] * cs1[0] - b[1] * cs1[1]; v1[1] = b[1] * cs1[0] + b[0] * cs1[1];
                        v1[2] = b[2] * cs1[2] - b[3] * cs1[3]; v1[3] = b[3] * cs1[2] + b[2] * cs1[3];
                    }
                    u32x4 w; w.x = cvt_pk_bf16(v0[0], v0[1]); w.y = cvt_pk_bf16(v0[2], v0[3]); w.z = cvt_pk_bf16(v1[0], v1[1]); w.w = cvt_pk_bf16(v1[2], v1[3]);
                    *(u32x4*)(rowp + bj * HALF) = w; } }
    }
};
struct EpiRes {
    static constexpr bool PERM = true, AFTER_DRAIN = false;
    const void* xin; bf16_t* xout; const void* cin; bf16_t* cout; const float* gate;
    int ldc, lat_rows, gstride; float scale; int in_f32;
    __device__ __forceinline__ void operator()(const f32x4 (&acc)[2][2][4][2], const Unit& u, int wr, int wc, int fr, int fq) const {
        const int row0 = u.pm * BM + wr * 64 + fr, col0 = u.pn * BM + wc * 32 + 8 * fq;
        const bool isc = u.pm * BM >= lat_rows;
        const int vs = isc ? 2 : ((u.pm * BM) >> 13), rsub = isc ? lat_rows : 0;
        const void* bp = isc ? cin : xin; bf16_t* op = isc ? cout : xout;
        f32x4 gv[2][2];
#pragma unroll
        for (int bj = 0; bj < 2; ++bj)
#pragma unroll
            for (int n = 0; n < 2; ++n) { typedef int i32x4 __attribute__((ext_vector_type(4))); const i32x4 q = *(const i32x4*)(gate + (size_t)vs * gstride + col0 + bj * HALF + 4 * n);
                gv[bj][n] = (f32x4){(float)q[0], (float)q[1], (float)q[2], (float)q[3]} * (scale * (1.f / 16777216.f)); }
#pragma unroll
        for (int ai = 0; ai < 2; ++ai)
#pragma unroll
        for (int mh = 0; mh < 2; ++mh) {
            if (in_f32) {
                f32x4 bb[2][2][2];
#pragma unroll
                for (int mm = 0; mm < 2; ++mm)
#pragma unroll
                    for (int bj = 0; bj < 2; ++bj) { const float* q = (const float*)bp + (size_t)(row0 - rsub + ai * HALF + (2 * mh + mm) * 16) * ldc + col0 + bj * HALF; bb[mm][bj][0] = *(const f32x4*)q; bb[mm][bj][1] = *(const f32x4*)(q + 4); }
#pragma unroll
                for (int mm = 0; mm < 2; ++mm)
#pragma unroll
                    for (int bj = 0; bj < 2; ++bj) { const int m = 2 * mh + mm; const size_t off = (size_t)(row0 - rsub + ai * HALF + m * 16) * ldc + col0 + bj * HALF;
                        const f32x4 o0 = bb[mm][bj][0] + gv[bj][0] * acc[ai][bj][m][0], o1 = bb[mm][bj][1] + gv[bj][1] * acc[ai][bj][m][1];
                        u32x4 w; w.x = cvt_pk_bf16(o0[0], o0[1]); w.y = cvt_pk_bf16(o0[2], o0[3]); w.z = cvt_pk_bf16(o1[0], o1[1]); w.w = cvt_pk_bf16(o1[2], o1[3]);
                        *(u32x4*)(op + off) = w; }
            } else {
                u32x4 bw[2][2];
#pragma unroll
                for (int mm = 0; mm < 2; ++mm)
#pragma unroll
                    for (int bj = 0; bj < 2; ++bj) bw[mm][bj] = *(const u32x4*)((const bf16_t*)bp + (size_t)(row0 - rsub + ai * HALF + (2 * mh + mm) * 16) * ldc + col0 + bj * HALF);
#pragma unroll
                for (int mm = 0; mm < 2; ++mm)
#pragma unroll
                    for (int bj = 0; bj < 2; ++bj) { const int m = 2 * mh + mm; const size_t off = (size_t)(row0 - rsub + ai * HALF + m * 16) * ldc + col0 + bj * HALF; const u32x4 w0 = bw[mm][bj];
                        const f32x4 b0 = (f32x4){__builtin_bit_cast(float, w0.x << 16), __builtin_bit_cast(float, w0.x & 0xffff0000u), __builtin_bit_cast(float, w0.y << 16), __builtin_bit_cast(float, w0.y & 0xffff0000u)};
                        const f32x4 b1 = (f32x4){__builtin_bit_cast(float, w0.z << 16), __builtin_bit_cast(float, w0.z & 0xffff0000u), __builtin_bit_cast(float, w0.w << 16), __builtin_bit_cast(float, w0.w & 0xffff0000u)};
                        const f32x4 o0 = b0 + gv[bj][0] * acc[ai][bj][m][0], o1 = b1 + gv[bj][1] * acc[ai][bj][m][1];
                        u32x4 w; w.x = cvt_pk_bf16(o0[0], o0[1]); w.y = cvt_pk_bf16(o0[2], o0[3]); w.z = cvt_pk_bf16(o1[0], o1[1]); w.w = cvt_pk_bf16(o1[2], o1[3]);
                        *(u32x4*)(op + off) = w; }
            }
        }
    }
};
__device__ __forceinline__ unsigned pack4_fp8(float a, float b, float c, float d) { int w = __builtin_amdgcn_cvt_pk_fp8_f32(a, b, 0, false); w = __builtin_amdgcn_cvt_pk_fp8_f32(c, d, w, true); return (unsigned)w; }
struct EpiGateUp {
    static constexpr bool PERM = true, AFTER_DRAIN = false;
    unsigned char* O; int ldc; float wscale;
    __device__ __forceinline__ void operator()(const f32x4 (&acc)[2][2][4][2], const Unit& u, int wr, int wc, int fr, int fq) const {
        const int row0 = u.pm * BM + wr * 64 + fr, col0 = (u.pn * BM + wc * 32 + 8 * fq) >> 1;
        float ws = wscale; asm volatile("" : "+v"(ws));
#pragma unroll
        for (int ai = 0; ai < 2; ++ai)
#pragma unroll
            for (int m = 0; m < 4; ++m) { unsigned char* rowp = O + (size_t)(row0 + ai * HALF + m * 16) * ldc + col0;
#pragma unroll
                for (int bj = 0; bj < 2; ++bj) { const f32x4 g = acc[ai][bj][m][0] * ws, up = acc[ai][bj][m][1] * ws; f32x4 a;
#pragma unroll
                    for (int i = 0; i < 4; ++i) a[i] = g[i] * __builtin_amdgcn_rcpf(1.f + __expf(-g[i])) * up[i];
                    *(unsigned*)(rowp + bj * (HALF / 2)) = pack4_fp8(a[0], a[1], a[2], a[3]); } }
    }
};
template <bool SKIP, bool GATH = false> struct GroupedOrderT {
    static constexpr bool SKIP_HI = SKIP, GATHER = GATH;
    static constexpr int nN = 8;
    int G, c, nblk; const PG8_LAS int* blk_e; const PG8_LAS int* blk_h; long estride; const PG8_LAS unsigned* rowtab;
    __device__ __forceinline__ bool next(int i, Unit& u) const {
        const int L = i * G + c; if (L >= nblk * nN) return false;
        u.pm = L >> 3; u.pn = L & 7; u.boff = (long)__builtin_amdgcn_readfirstlane(blk_e[u.pm]) * estride; u.lo_only = __builtin_amdgcn_readfirstlane(blk_h[u.pm]); return true;
    }
    __device__ __forceinline__ void a_ready(const Unit&) const {}
    __device__ __forceinline__ void done(const Unit&) const {}
};
}
constexpr int DM = 2048, T_LAT = 16384, T_CTX = 512, T_ALL = 16896, SEQL = 8192, CTXL = 256;
constexpr int NIN = 5152, NINP = 5376;
constexpr int C_QA = 0, C_KA = 512, C_VA = 1024, C_QB = 1536, C_KB = 2048, C_VB = 2304, C_Z = 2560, C_XBC = 3584, C_DT = 5120;
constexpr int XBCW = 1536, DFF = 1024, NEXP = 32, MODW = 12288;
constexpr float EPS = 1e-6f, ATT_SCALE = 0.088388347648318440f;
constexpr int MAXBLK = 165, MAXSLOT = MAXBLK * 256;
constexpr int NWAVES = 8;

constexpr size_t MiB = 1u << 20;
constexpr size_t WS_CTL = 0, CTL_ZERO_BYTES = 2 * MiB;
constexpr int CW_BAR = 4096;
constexpr size_t OFF_Q = 32768;
constexpr size_t OFF_CNT = 65536;
constexpr size_t OFF_MOD = 1 * MiB;
constexpr size_t WS_ROPE = 2 * MiB;
constexpr size_t WS_WRT = 3 * MiB;
constexpr size_t WS_WIN = 8 * MiB;
constexpr size_t WS_WOUT = 50 * MiB;
constexpr size_t WS_WGU = 66 * MiB;
constexpr size_t WS_WDN = 578 * MiB;
constexpr size_t WS_H = 834 * MiB;
constexpr size_t WS_U = 900 * MiB;
constexpr size_t WS_X = 1074 * MiB;
constexpr size_t WS_XC = 1202 * MiB;
constexpr size_t WS_XBC = 1206 * MiB;
constexpr size_t WS_DT = 1256 * MiB;
constexpr size_t WS_YD = 1260 * MiB;
constexpr size_t WS_XG = 1392 * MiB;
constexpr size_t WS_ACT = 1557 * MiB;
constexpr size_t WS_YB = 1640 * MiB;
constexpr size_t WS_TOK = 1805 * MiB;
constexpr size_t WS_END = 1808 * MiB;
constexpr size_t WS_LIST = WS_XG + 64 * MiB;
constexpr int LCAP = 2 * T_ALL;
constexpr unsigned ZERO_OFF = 1536u * 1024u;
constexpr size_t TOKTAB = (size_t)T_ALL * 2 * 4;
static_assert(WS_WIN + (size_t)2 * NINP * DM * 2 <= WS_WOUT && WS_WGU + (size_t)2 * 32 * 2048 * 2048 * 2 <= WS_WDN && WS_WDN + (size_t)2 * 32 * 2048 * 1024 * 2 <= WS_H, "ws map 1");
static_assert(WS_H + (size_t)T_ALL * DM * 2 <= WS_U && WS_U + (size_t)T_ALL * NINP * 2 <= WS_X && WS_X + (size_t)T_LAT * DM * 4 <= WS_XC && WS_XBC + (size_t)T_ALL * XBCW * 2 <= WS_DT, "ws map 2");
static_assert(WS_DT + (size_t)T_ALL * 32 * 4 <= WS_YD && WS_YD + (size_t)2 * T_ALL * 1024 * 4 <= WS_XG && WS_XG + (size_t)MAXSLOT * DM * 2 <= WS_ACT && WS_ACT + (size_t)MAXSLOT * DFF * 2 <= WS_YB && WS_YB + (size_t)MAXSLOT * DM * 2 <= WS_TOK && WS_TOK + 4 * TOKTAB <= WS_END, "ws map 3");

constexpr int RING_BYTES = 131072, LDSCTL_OFF = RING_BYTES, LDS_BYTES = 147456;
constexpr int L_BARW = LDSCTL_OFF;
constexpr int L_BWORK = LDSCTL_OFF + 32;
constexpr int L_SEG = LDSCTL_OFF + 64;
constexpr int L_CNT = LDSCTL_OFF + 256;
constexpr int L_BLKE = LDSCTL_OFF + 512;
constexpr int L_NBLK = LDSCTL_OFF + 1536;
constexpr int L_INCL = LDSCTL_OFF + 1600;
constexpr int L_PB = LDSCTL_OFF + 1792;
constexpr int L_ROWT = LDSCTL_OFF + 4096;
constexpr int L_BLKH = LDSCTL_OFF + 2048;

#define GAS __attribute__((address_space(1)))
#define LAS __attribute__((address_space(3)))
typedef unsigned short bf16;
typedef unsigned v4u __attribute__((ext_vector_type(4)));
typedef unsigned v2u __attribute__((ext_vector_type(2)));
typedef float f32x4 __attribute__((ext_vector_type(4)));
typedef float f32x2 __attribute__((ext_vector_type(2)));
typedef short bf16x8 __attribute__((ext_vector_type(8)));
#define LDS_WAIT() asm volatile("s_waitcnt lgkmcnt(0)" ::: "memory")
#define VM_WAIT() asm volatile("s_waitcnt vmcnt(0)" ::: "memory")
__device__ __forceinline__ unsigned f2bf(float f) { unsigned u = __builtin_bit_cast(unsigned, f); return (u + 0x7fffu + ((u >> 16) & 1u)) >> 16; }
__device__ __forceinline__ unsigned pk2(float lo, float hi) { return f2bf(lo) | (f2bf(hi) << 16); }
__device__ __forceinline__ float bflo(unsigned w) { return __builtin_bit_cast(float, w << 16); }
__device__ __forceinline__ float bfhi(unsigned w) { return __builtin_bit_cast(float, w & 0xffff0000u); }
__device__ __forceinline__ float bf2f(bf16 b) { return __builtin_bit_cast(float, (unsigned)b << 16); }
__device__ __forceinline__ float wave_sum(float v) {
#pragma unroll
    for (int o = 1; o < 64; o <<= 1) v += __shfl_xor(v, o);
    return v;
}
__device__ __forceinline__ float wave_max(float v) {
#pragma unroll
    for (int o = 1; o < 64; o <<= 1) v = fmaxf(v, __shfl_xor(v, o));
    return v;
}
__device__ __forceinline__ float silu_f(float x) { return x / (1.f + __expf(-x)); }
__device__ __forceinline__ float sigmoid_f(float x) { return 1.f / (1.f + __expf(-x)); }
__device__ __forceinline__ float softplus_f(float x) { return x > 20.f ? x : log1pf(__expf(x)); }

#define XB_TMO      128
#define XB_XCNT(j)  (256  + 64 * (j))
#define XB_XSUB(j)  (1280 + 64 * (j))
#define XB_XGEN(j)  (2304 + 64 * (j))
#define XB_TOP      3328
#define XB_TOPGEN   3392
#define XCD_BAR_WORDS 3456
#define XB_SPIN_CAP (1u << 18)


__device__ __forceinline__ unsigned xb_ld(unsigned* p)              { return __hip_atomic_load(p, __ATOMIC_RELAXED, __HIP_MEMORY_SCOPE_AGENT); }
__device__ __forceinline__ unsigned xb_add(unsigned* p, unsigned v) { return __hip_atomic_fetch_add(p, v, __ATOMIC_RELAXED, __HIP_MEMORY_SCOPE_AGENT); }
__device__ __forceinline__ unsigned xb_xcc_id() { return (unsigned)__builtin_amdgcn_s_getreg((3 << 11) | 20) & 0xFu; }
#define XB_SPIN(cond, bar) do { unsigned _sp = 0; while (cond) { __builtin_amdgcn_s_sleep(1); \
    if ((++_sp & 255u) == 0u) { if (xb_ld(&(bar)[XB_TMO])) break; if (_sp > XB_SPIN_CAP) { atomicAdd(&(bar)[XB_TMO], 1u); break; } } } } while (0)

struct XcdBarrier {
    unsigned* bar; unsigned x;
    volatile LAS unsigned* st;
};

__device__ __forceinline__ XcdBarrier xcd_barrier_post(unsigned* bar, volatile LAS unsigned* st) {
    XcdBarrier b; b.bar = bar; b.x = xb_xcc_id(); b.st = st;
    if (threadIdx.x == 0) (void)xb_add(&bar[XB_XCNT(b.x)], 1u);
    return b;
}
__device__ __forceinline__ void xcd_barrier_complete(unsigned* bar, unsigned x, unsigned& nloc, unsigned& nx) {
    const unsigned G = gridDim.x * gridDim.y * gridDim.z;
    unsigned sum, cnt, mine, sp = 0u;
    for (;;) {
        sum = 0u; cnt = 0u; mine = 0u;
#pragma unroll
        for (unsigned j = 0; j < 16; ++j) { const unsigned c = xb_ld(&bar[XB_XCNT(j)]); sum += c; cnt += (c > 0u) ? 1u : 0u; mine = (j == x) ? c : mine; }
        if (sum == G) break;
        __builtin_amdgcn_s_sleep(1);
        if ((++sp & 255u) == 0u) { if (xb_ld(&bar[XB_TMO])) break; if (sp > XB_SPIN_CAP) { atomicAdd(&bar[XB_TMO], 1u); break; } }
    }
    nloc = mine > 0u ? mine : 1u; nx = cnt > 0u ? cnt : 1u;
}

__device__ __forceinline__ void xcd_barrier(const XcdBarrier& b) {
    asm volatile("s_waitcnt vmcnt(0)" ::: "memory");
    __syncthreads();
    if (threadIdx.x == 0) {
        unsigned* bar = b.bar;
        __builtin_amdgcn_s_waitcnt(0);
        unsigned nloc = b.st[0], nx = b.st[1];
        if (nloc == 0u) { xcd_barrier_complete(bar, b.x, nloc, nx); b.st[0] = nloc; b.st[1] = nx; }
        const unsigned old = xb_add(&bar[XB_XSUB(b.x)], 1u);
        const unsigned gen = old / nloc;
        if (old + 1u == (gen + 1u) * nloc) {
            __builtin_amdgcn_fence(__ATOMIC_RELEASE, "agent");
            asm volatile("s_waitcnt vmcnt(0)" ::: "memory");
            const unsigned og = xb_add(&bar[XB_TOP], 1u);
            const unsigned tg = og / nx;
            if (og + 1u == (tg + 1u) * nx) xb_add(&bar[XB_TOPGEN], 1u);
            else XB_SPIN(xb_ld(&bar[XB_TOPGEN]) == tg, bar);
            __builtin_amdgcn_fence(__ATOMIC_ACQUIRE, "agent");
            xb_add(&bar[XB_XGEN(b.x)], 1u);
            asm volatile("s_waitcnt vmcnt(0)" ::: "memory");
        } else {
            XB_SPIN(xb_ld(&bar[XB_XGEN(b.x)]) == gen, bar);
            __builtin_amdgcn_fence(__ATOMIC_ACQUIRE, "agent");
            asm volatile("s_waitcnt vmcnt(0)" ::: "memory");
        }
    }
    __syncthreads();
}
struct Prm {
    const float *x, *c, *ctx, *c_ctx, *w_ada, *b_ada, *norm_mix, *norm_ffn, *norm_final, *w_in, *w_out, *na_rpb, *wa_sink,
                *conv_w, *conv_b, *a_log, *dt_bias, *d_skip, *ssd_norm, *w_router, *router_bias, *w_gate, *w_up, *w_down;
    float* out; unsigned char* ws; int ph_lo, ph_hi;
};

__device__ __forceinline__ int perm_in(int n) {
    if (n >= C_QB && n < C_VB) { const int p = (n - C_QB) & 127, hb = n - p, half = p >> 6, pp = p & 63; return hb + half * 64 + (pp >> 1) + 32 * (pp & 1); }
    return n;
}
__device__ __forceinline__ unsigned pack4f8(float a, float b, float c, float d) { int w = __builtin_amdgcn_cvt_pk_fp8_f32(a, b, 0, false); w = __builtin_amdgcn_cvt_pk_fp8_f32(c, d, w, true); return (unsigned)w; }
#ifndef CONV_QUEUE
#define CONV_QUEUE 1
#endif
constexpr float W8_SCALE = 64.f, MIX_SCALE = 8.f, Y8_SCALE = 8.f;
struct TDesc { const float* colp; size_t ld; unsigned char* wt; int ok, k0, K, n0; };
constexpr int TK_IN = 2 * 32 * (NINP / 32), TK_OUT = 2 * 32 * 64, TK_GU = 2 * 32 * 32 * 64, TK_DN = 2 * 32 * 16 * 64, TK_RT = 32;
template <bool F8SEL> __device__ __forceinline__ constexpr int t_count() {
    return ((F8_INPROJ != 0) == F8SEL ? TK_IN : 0) + ((F8_OUTPROJ != 0) == F8SEL ? TK_OUT : 0) + (F8SEL ? TK_GU + TK_DN : TK_RT);
}
template <bool F8SEL> __device__ __forceinline__ TDesc t_decode(const Prm& p, int it, int lane) {
    unsigned char* ws = p.ws; TDesc d; int r = it;
    if ((F8_INPROJ != 0) == F8SEL) { if (r < TK_IN) { const int sub = r & 1, r2 = r >> 1, l = r2 / (TK_IN / 4), q = r2 % (TK_IN / 4), kb = 2 * (q / (NINP / 32)) + sub, nb = q % (NINP / 32), nn = 32 * nb + (lane & 31); const bool ok = nn < NIN;
            d.colp = p.w_in + (size_t)l * DM * NIN + (ok ? perm_in(nn) : 0); d.ld = NIN; d.ok = ok; d.K = 2048; d.wt = ws + WS_WIN + (size_t)l * NINP * DM * (F8_INPROJ ? 1 : 2); d.n0 = 32 * nb; d.k0 = 64 * kb; return d; } r -= TK_IN; }
    if ((F8_OUTPROJ != 0) == F8SEL) { if (r < TK_OUT) { const int sub = r & 1, r2 = r >> 1, l = r2 / (TK_OUT / 4), q = r2 % (TK_OUT / 4), kb = 2 * (q / 64) + sub, nb = q % 64, nn = 32 * nb + (lane & 31);
            d.colp = p.w_out + (size_t)l * DM * DM + nn; d.ld = DM; d.ok = 1; d.K = 2048; d.wt = ws + WS_WOUT + (size_t)l * DM * DM * (F8_OUTPROJ ? 1 : 2); d.n0 = 32 * nb; d.k0 = 64 * kb; return d; } r -= TK_OUT; }
    if (F8SEL) {
        if (r < TK_GU) { const int sub = r & 1, r2 = r >> 1, le = r2 / 1024, q = r2 % 1024, kb = 2 * (q / 64) + sub, nb = q % 64, nn = 32 * nb + (lane & 31), j = nn >> 3, t = nn & 7;
            d.colp = (t < 4 ? p.w_gate : p.w_up) + (size_t)le * 2048 * 1024 + 4 * j + (t & 3); d.ld = 1024; d.ok = 1; d.K = 2048; d.wt = ws + WS_WGU + (size_t)le * 2048 * 2048; d.n0 = 32 * nb; d.k0 = 64 * kb; return d; }
        r -= TK_GU;
        { const int sub = r & 1, r2 = r >> 1, le = r2 / 512, q = r2 % 512, kb = 2 * (q / 64) + sub, nb = q % 64, nn = 32 * nb + (lane & 31);
            d.colp = p.w_down + (size_t)le * 1024 * 2048 + nn; d.ld = 2048; d.ok = 1; d.K = 1024; d.wt = ws + WS_WDN + (size_t)le * 2048 * 1024; d.n0 = 32 * nb; d.k0 = 64 * kb; return d; }
    } else { const int kb = r; d.colp = p.w_router + (lane & 31); d.ld = 32; d.ok = 1; d.K = 2048; d.wt = ws + WS_WRT; d.n0 = 0; d.k0 = 64 * kb; return d; }
}
__device__ __forceinline__ void t_load(const TDesc& d, float (&tv)[32], int lane) {
#pragma unroll
    for (int i = 0; i < 32; ++i) tv[i] = d.colp[(size_t)(d.k0 + 2 * i + (lane >> 5)) * d.ld];
}
template <bool F8> __device__ __forceinline__ void t_lds_in(const TDesc& d, const float (&tv)[32], LAS float* scr, int lane) {
#pragma unroll
    for (int i = 0; i < 32; ++i) scr[(2 * i + (lane >> 5)) * 33 + (lane & 31)] = d.ok ? tv[i] : 0.f;
    LDS_WAIT(); asm volatile("" ::: "memory");
}
template <bool F8> __device__ __forceinline__ void t_out(const TDesc& d, LAS float* scr, int lane) {
    const int c = lane & 7;
#pragma unroll
    for (int j = 0; j < 4; ++j) { const int n = (lane >> 3) + 8 * j; const LAS float* s = scr + (8 * c) * 33 + n;
        if constexpr (F8) { v2u o; o.x = pack4f8(s[0 * 33] * W8_SCALE, s[1 * 33] * W8_SCALE, s[2 * 33] * W8_SCALE, s[3 * 33] * W8_SCALE); o.y = pack4f8(s[4 * 33] * W8_SCALE, s[5 * 33] * W8_SCALE, s[6 * 33] * W8_SCALE, s[7 * 33] * W8_SCALE);
            *(v2u*)(d.wt + (size_t)(d.n0 + n) * d.K + d.k0 + 8 * c) = o; }
        else { v4u o; o.x = pk2(s[0 * 33], s[1 * 33]); o.y = pk2(s[2 * 33], s[3 * 33]); o.z = pk2(s[4 * 33], s[5 * 33]); o.w = pk2(s[6 * 33], s[7 * 33]);
            *(v4u*)((bf16*)d.wt + (size_t)(d.n0 + n) * d.K + d.k0 + 8 * c) = o; } }
    LDS_WAIT(); asm volatile("" ::: "memory");
}
__device__ __forceinline__ void t_cvt8(LAS float* scr, int lane, v2u (&o)[4]) {
    const int c = lane & 7;
#pragma unroll
    for (int j = 0; j < 4; ++j) { const int n = (lane >> 3) + 8 * j; const LAS float* s = scr + (8 * c) * 33 + n;
        o[j].x = pack4f8(s[0 * 33] * W8_SCALE, s[1 * 33] * W8_SCALE, s[2 * 33] * W8_SCALE, s[3 * 33] * W8_SCALE); o[j].y = pack4f8(s[4 * 33] * W8_SCALE, s[5 * 33] * W8_SCALE, s[6 * 33] * W8_SCALE, s[7 * 33] * W8_SCALE); }
    LDS_WAIT(); asm volatile("" ::: "memory");
}
constexpr int TL_IN = 32 * (NINP / 32), TL_OUT = 32 * 64, TL_GU = 32 * 32 * 64, TL_DN = 32 * 16 * 64, TL_ALL = TL_IN + TL_OUT + TL_GU + TL_DN, NPL = TL_ALL / 2;
static_assert(F8_INPROJ && F8_OUTPROJ, "the per-layer conversion queue assumes fp8 copies of every GEMM weight");
__device__ __forceinline__ TDesc t_decode_layer(const Prm& p, int l, int it, int lane) {
    unsigned char* ws = p.ws; TDesc d; int r = it; const int sub = r & 1;
    if (r < TL_IN) { const int q = r >> 1, kb = 2 * (q / (NINP / 32)) + sub, nb = q % (NINP / 32), nn = 32 * nb + (lane & 31); const bool ok = nn < NIN;
        d.colp = p.w_in + (size_t)l * DM * NIN + (ok ? perm_in(nn) : 0); d.ld = NIN; d.ok = ok; d.K = 2048; d.wt = ws + WS_WIN + (size_t)l * NINP * DM; d.n0 = 32 * nb; d.k0 = 64 * kb; return d; }
    r -= TL_IN;
    if (r < TL_OUT) { const int q = r >> 1, kb = 2 * (q / 64) + sub, nb = q % 64, nn = 32 * nb + (lane & 31);
        d.colp = p.w_out + (size_t)l * DM * DM + nn; d.ld = DM; d.ok = 1; d.K = 2048; d.wt = ws + WS_WOUT + (size_t)l * DM * DM; d.n0 = 32 * nb; d.k0 = 64 * kb; return d; }
    r -= TL_OUT;
    if (r < TL_GU) { const int r2 = r >> 1, le = l * 32 + r2 / 1024, q = r2 % 1024, kb = 2 * (q / 64) + sub, nb = q % 64, nn = 32 * nb + (lane & 31), j = nn >> 3, t = nn & 7;
        d.colp = (t < 4 ? p.w_gate : p.w_up) + (size_t)le * 2048 * 1024 + 4 * j + (t & 3); d.ld = 1024; d.ok = 1; d.K = 2048; d.wt = ws + WS_WGU + (size_t)le * 2048 * 2048; d.n0 = 32 * nb; d.k0 = 64 * kb; return d; }
    r -= TL_GU;
    { const int r2 = r >> 1, le = l * 32 + r2 / 512, q = r2 % 512, kb = 2 * (q / 64) + sub, nb = q % 64, nn = 32 * nb + (lane & 31);
        d.colp = p.w_down + (size_t)le * 1024 * 2048 + nn; d.ld = 2048; d.ok = 1; d.K = 1024; d.wt = ws + WS_WDN + (size_t)le * 2048 * 1024; d.n0 = 32 * nb; d.k0 = 64 * kb; return d; }
}
__device__ __forceinline__ void t_pair_store(const TDesc& dS, const v2u (&oa)[4], const v2u (&ob)[4], int lane) {
    const int c = lane & 7, odd = c & 1;
#pragma unroll
    for (int j = 0; j < 4; ++j) { const int n = (lane >> 3) + 8 * j;
        const v2u snd = odd ? oa[j] : ob[j]; v2u got; got.x = (unsigned)__builtin_amdgcn_update_dpp(0, (int)snd.x, 0xB1, 0xF, 0xF, false); got.y = (unsigned)__builtin_amdgcn_update_dpp(0, (int)snd.y, 0xB1, 0xF, 0xF, false);
        v4u w; if (odd) { w.x = got.x; w.y = got.y; w.z = ob[j].x; w.w = ob[j].y; } else { w.x = oa[j].x; w.y = oa[j].y; w.z = got.x; w.w = got.y; }
        *(v4u*)(dS.wt + (size_t)(dS.n0 + n) * dS.K + dS.k0 + (odd ? 64 : 0) + 16 * (c >> 1)) = w; }
}
constexpr int NP_PROJ = (TL_IN + TL_OUT) / 2, NP_EXP = (TL_GU + TL_DN) / 2;
__device__ __forceinline__ void t_convert_pairs(const Prm& p, int l, int npairs, LAS float* scr, int gw, int ngw, int lane) {
    if (gw >= npairs) return;
    TDesc dA = t_decode_layer(p, l, 2 * gw, lane), dB = t_decode_layer(p, l, 2 * gw + 1, lane); float ta[32], tb[32]; t_load(dA, ta, lane); t_load(dB, tb, lane);
#pragma unroll 1
    for (int pi = gw; pi < npairs; pi += ngw) {
        v2u oa[4], ob[4];
        t_lds_in<true>(dA, ta, scr, lane); t_cvt8(scr, lane, oa);
        t_lds_in<true>(dB, tb, scr, lane);
        const TDesc dS = dA; const int pn = pi + ngw;
        if (pn < npairs) { dA = t_decode_layer(p, l, 2 * pn, lane); dB = t_decode_layer(p, l, 2 * pn + 1, lane); t_load(dA, ta, lane); t_load(dB, tb, lane); }
        t_cvt8(scr, lane, ob);
        t_pair_store(dS, oa, ob, lane);
    }
}
__device__ __forceinline__ void t_convert_two(const Prm& p, int l, int pi0, int pi1, bool has1, LAS float* scr, int lane) {
    const TDesc dA = t_decode_layer(p, l, 2 * pi0, lane), dB = t_decode_layer(p, l, 2 * pi0 + 1, lane), dC = t_decode_layer(p, l, 2 * pi1, lane), dD = t_decode_layer(p, l, 2 * pi1 + 1, lane);
    float ta[32], tb[32], tc[32], td[32]; t_load(dA, ta, lane); t_load(dB, tb, lane); t_load(dC, tc, lane); t_load(dD, td, lane);
    v2u oa[4], ob[4];
    t_lds_in<true>(dA, ta, scr, lane); t_cvt8(scr, lane, oa);
    t_lds_in<true>(dB, tb, scr, lane); t_cvt8(scr, lane, ob);
    t_pair_store(dA, oa, ob, lane);
    if (has1) {
        t_lds_in<true>(dC, tc, scr, lane); t_cvt8(scr, lane, oa);
        t_lds_in<true>(dD, td, scr, lane); t_cvt8(scr, lane, ob);
        t_pair_store(dC, oa, ob, lane);
    }
}
__device__ __forceinline__ void t_convert_one(const Prm& p, int l, int pi, LAS float* scr, int lane) {
    const TDesc dA = t_decode_layer(p, l, 2 * pi, lane), dB = t_decode_layer(p, l, 2 * pi + 1, lane); float ta[32], tb[32]; t_load(dA, ta, lane); t_load(dB, tb, lane);
    v2u oa[4], ob[4];
    t_lds_in<true>(dA, ta, scr, lane); t_cvt8(scr, lane, oa);
    t_lds_in<true>(dB, tb, scr, lane); t_cvt8(scr, lane, ob);
    t_pair_store(dA, oa, ob, lane);
}
template <bool F8SEL> __device__ __forceinline__ void t_convert_all(const Prm& p, LAS float* scr, int gw, int ngw, int lane) {
    constexpr int N = t_count<F8SEL>();
    if (2 * gw >= N) return;
    TDesc d0 = t_decode<F8SEL>(p, 2 * gw, lane); float tv[32]; t_load(d0, tv, lane);
#pragma unroll 1
    for (int it = 2 * gw; it < N; ) {
        t_lds_in<F8SEL>(d0, tv, scr, lane);
        const int itn = (it & 1) ? it - 1 + 2 * ngw : it + 1; TDesc d1 = d0;
        if (itn < N) { d1 = t_decode<F8SEL>(p, itn, lane); t_load(d1, tv, lane); }
        t_out<F8SEL>(d0, scr, lane);
        d0 = d1; it = itn;
    }
}
__device__ __forceinline__ void phase_prologue(const Prm& p, LAS unsigned char* lds, int gw, int ngw, int wave, int lane, bool first) {
    LAS float* scr = (LAS float*)(lds + wave * 16384);
    unsigned char* ws = p.ws;
    t_convert_pairs(p, 0, NPL, scr, gw, ngw, lane);
    if (!CONV_QUEUE) t_convert_pairs(p, 1, NPL, scr, gw, ngw, lane);
    t_convert_all<false>(p, scr, gw, ngw, lane);
    int* mod = (int*)(ws + OFF_MOD);
    for (int it = gw; first && it < 2 * 32 * 48; it += ngw) {
        const int l = it / (32 * 48), q = it % (32 * 48), kc = q / 48, nc = q % 48, k0 = 64 * kc, n0 = 256 * nc + 4 * lane;
        scr[lane] = silu_f(p.c[k0 + lane]); scr[64 + lane] = silu_f(p.c[DM + k0 + lane]); scr[128 + lane] = silu_f(p.c_ctx[k0 + lane]);
        LDS_WAIT(); asm volatile("" ::: "memory");
        f32x4 a0 = {0.f, 0.f, 0.f, 0.f}, a1 = a0, a2 = a0;
        const float* wp = p.w_ada + ((size_t)l * DM + k0) * MODW + n0;
#pragma unroll 8
        for (int kk = 0; kk < 64; ++kk) { const f32x4 w = *(const f32x4*)(wp + (size_t)kk * MODW); a0 += w * scr[kk]; a1 += w * scr[64 + kk]; a2 += w * scr[128 + kk]; }
        if (kc == 0) { const f32x4 bb = *(const f32x4*)(p.b_ada + (size_t)l * MODW + n0); a0 += bb; a1 += bb; a2 += bb; }
        int* m0 = mod + (size_t)(l * 3) * MODW + n0;
#pragma unroll
        for (int i = 0; i < 4; ++i) { atomicAdd(m0 + i, (int)rintf(a0[i] * 16777216.f)); atomicAdd(m0 + MODW + i, (int)rintf(a1[i] * 16777216.f)); atomicAdd(m0 + 2 * MODW + i, (int)rintf(a2[i] * 16777216.f)); }
        LDS_WAIT(); asm volatile("" ::: "memory");
    }
    for (int it = gw * 64 + lane; it < 128 * 32; it += ngw * 64) { const int pos = it >> 5, i = it & 31; const float inv = powf(10000.f, -(float)i / 32.f), ang = (float)pos * inv;
        ((float*)(ws + WS_ROPE))[2 * it] = cosf(ang); ((float*)(ws + WS_ROPE))[2 * it + 1] = sinf(ang); }
}

__device__ __forceinline__ f32x4 modv4(const float* p) {
    typedef int i32x4 __attribute__((ext_vector_type(4)));
    const i32x4 v = *(const i32x4*)p; return (f32x4){(float)v[0], (float)v[1], (float)v[2], (float)v[3]} * (1.f / 16777216.f);
}
__device__ __forceinline__ f32x4 bf4(v2u w) { return (f32x4){bflo(w.x), bfhi(w.x), bflo(w.y), bfhi(w.y)}; }
__device__ __forceinline__ void load_row(const Prm& p, int l, int lcomb, int m, int lane, f32x4 (&v)[8], bool wb = true, const LAS int* segL = nullptr) {
    const bool isc = m >= T_LAT;
    const bf16* wsrow = isc ? (const bf16*)(p.ws + WS_XC) + (size_t)(m - T_LAT) * DM : (const bf16*)(p.ws + WS_X) + (size_t)m * DM;
#pragma unroll
    for (int j = 0; j < 8; ++j) v[j] = bf4(*(const v2u*)(wsrow + 256 * j + 4 * lane));
}
__device__ __forceinline__ float row_rstd(const f32x4 (&v)[8]) {
    float s = 0.f;
#pragma unroll
    for (int j = 0; j < 8; ++j) s += (v[j][0] * v[j][0] + v[j][1] * v[j][1]) + (v[j][2] * v[j][2] + v[j][3] * v[j][3]);
    return rsqrtf(wave_sum(s) * (1.f / DM) + EPS);
}
__device__ __forceinline__ f32x4 modulate4f(const f32x4 v, float rstd, const float* gain, const float* sc, const float* sh, int col) {
    const f32x4 g = *(const f32x4*)(gain + col), s1 = modv4(sc + col), s0 = modv4(sh + col);
    return (v * rstd * g) * (s1 + 1.f) + s0;
}
__device__ __forceinline__ v2u modulate4(const f32x4 v, float rstd, const float* gain, const float* sc, const float* sh, int col) {
    const f32x4 g = *(const f32x4*)(gain + col), s1 = modv4(sc + col), s0 = modv4(sh + col);
    const f32x4 o = (v * rstd * g) * (s1 + 1.f) + s0;
    v2u w; w.x = pk2(o[0], o[1]); w.y = pk2(o[2], o[3]); return w;
}
constexpr int RS_A = 0, RS_SH = 3 * 8192, RS_GF = 6 * 8192, RS_END = 9 * 8192;
struct RowX { f32x4 x[8]; v2u xb[8]; unsigned ya[8], yb[8]; };
struct RowI { int s; float g; };
template <bool COMB> __device__ __forceinline__ RowI rs_idx_issue(const Prm& p, int m, int lane, int& e_out, int& pos_out) {
    RowI r; r.s = 0; r.g = 0.f; e_out = 0; pos_out = 0;
    if constexpr (COMB) { const int k = lane & 1; const int* te = (const int*)(p.ws + WS_TOK); const int* tp = (const int*)(p.ws + WS_TOK + TOKTAB); const float* tg = (const float*)(p.ws + WS_TOK + 2 * TOKTAB);
        e_out = te[2 * m + k]; pos_out = tp[2 * m + k]; r.g = tg[2 * m + k]; }
    return r;
}
template <bool COMB, bool SRC32> __device__ __forceinline__ void rs_issue(const Prm& p, int m, int s0, int s1, int lane, RowX& b) {
    const bool isc = m >= T_LAT;
    if constexpr (SRC32) { const float* src = isc ? p.ctx + (size_t)(m - T_LAT) * DM : p.x + (size_t)m * DM;
#pragma unroll
        for (int j = 0; j < 8; ++j) b.x[j] = *(const f32x4*)(src + 256 * j + 4 * lane); }
    else { const bf16* src = isc ? (const bf16*)(p.ws + WS_XC) + (size_t)(m - T_LAT) * DM : (const bf16*)(p.ws + WS_X) + (size_t)m * DM;
#pragma unroll
        for (int j = 0; j < 8; ++j) b.xb[j] = *(const v2u*)(src + 256 * j + 4 * lane); }
    if constexpr (COMB) { const unsigned char* y0 = p.ws + WS_YB + (size_t)s0 * DM; const unsigned char* y1 = p.ws + WS_YB + (size_t)s1 * DM;
#pragma unroll
        for (int j = 0; j < 8; ++j) { b.ya[j] = *(const unsigned*)(y0 + 256 * j + 4 * lane); b.yb[j] = *(const unsigned*)(y1 + 256 * j + 4 * lane); } }
}
template <bool COMB, bool FINAL, bool SRC32> __device__ __forceinline__ void rs_finish(const Prm& p, int l, int m, float g0, float g1, int lane, RowX& b, const LAS unsigned char* vl, bool live) {
    const bool isc = m >= T_LAT; const int vs = isc ? 2 : (m >> 13);
    const LAS float* A = (const LAS float*)(vl + RS_A) + vs * 2048; const LAS float* SH = (const LAS float*)(vl + RS_SH) + vs * 2048; const LAS float* GF = (const LAS float*)(vl + RS_GF) + vs * 2048;
    if constexpr (!SRC32) {
#pragma unroll
        for (int j = 0; j < 8; ++j) b.x[j] = bf4(b.xb[j]); }
    if constexpr (COMB) {
        bf16* wsrow = isc ? (bf16*)(p.ws + WS_XC) + (size_t)(m - T_LAT) * DM : (bf16*)(p.ws + WS_X) + (size_t)m * DM;
#pragma unroll
        for (int j = 0; j < 8; ++j) { const int col = 256 * j + 4 * lane; const unsigned a = b.ya[j], c = b.yb[j]; const f32x4 gq = *(const LAS f32x4*)(GF + col);
            const f32x2 a01 = __builtin_amdgcn_cvt_pk_f32_fp8(a, false), a23 = __builtin_amdgcn_cvt_pk_f32_fp8(a, true), c01 = __builtin_amdgcn_cvt_pk_f32_fp8(c, false), c23 = __builtin_amdgcn_cvt_pk_f32_fp8(c, true);
            b.x[j][0] += gq[0] * (g0 * a01[0] + g1 * c01[0]); b.x[j][1] += gq[1] * (g0 * a01[1] + g1 * c01[1]);
            b.x[j][2] += gq[2] * (g0 * a23[0] + g1 * c23[0]); b.x[j][3] += gq[3] * (g0 * a23[1] + g1 * c23[1]);
            if (!FINAL && live) { v2u w; w.x = pk2(b.x[j][0], b.x[j][1]); w.y = pk2(b.x[j][2], b.x[j][3]); *(v2u*)(wsrow + col) = w; } } }
    const float rstd = row_rstd(b.x);
    if (!live) return;
#pragma unroll
    for (int j = 0; j < 8; ++j) { const int col = 256 * j + 4 * lane; const f32x4 av = *(const LAS f32x4*)(A + col);
        if constexpr (FINAL) { *(f32x4*)(p.out + (size_t)m * DM + col) = b.x[j] * rstd * av; }
        else { const f32x4 o = b.x[j] * rstd * av + *(const LAS f32x4*)(SH + col);
            if (F8_INPROJ) *(unsigned*)(p.ws + WS_H + (size_t)m * DM + col) = pack4f8(o[0], o[1], o[2], o[3]);
            else { v2u w; w.x = pk2(o[0], o[1]); w.y = pk2(o[2], o[3]); *(v2u*)((bf16*)(p.ws + WS_H) + (size_t)m * DM + col) = w; } } }
}
template <bool COMB, bool FINAL, bool SRC32> __device__ __forceinline__ void row_stream(const Prm& p, int l, int lc, int nrows, int gw, int ngw, int tid, int lane, LAS unsigned char* vl, const LAS int* segL) {
    { const float* md = (const float*)(p.ws + OFF_MOD);
      for (int q = tid; q < 3 * 512; q += NWAVES * 64) { const int vs = q >> 9, c4 = (q & 511) * 4;
          if (FINAL) { if (vs == 0) *(LAS f32x4*)(vl + RS_A + (size_t)c4 * 4) = *(const f32x4*)(p.norm_final + c4); }
          else { const f32x4 gn = *(const f32x4*)(p.norm_mix + l * DM + c4), sc = modv4(md + (size_t)(l * 3 + vs) * MODW + DM + c4), sh = modv4(md + (size_t)(l * 3 + vs) * MODW + c4);
              *(LAS f32x4*)(vl + RS_A + ((size_t)vs * 2048 + c4) * 4) = gn * (sc + 1.f); *(LAS f32x4*)(vl + RS_SH + ((size_t)vs * 2048 + c4) * 4) = sh; }
          if (COMB) *(LAS f32x4*)(vl + RS_GF + ((size_t)vs * 2048 + c4) * 4) = modv4(md + (size_t)(lc * 3 + vs) * MODW + 5 * DM + c4) * (1.f / Y8_SCALE); }
      if (FINAL) { for (int q = tid; q < 2 * 512; q += NWAVES * 64) { const int c4 = (q & 511) * 4; *(LAS f32x4*)(vl + RS_A + ((size_t)(1 + (q >> 9)) * 2048 + c4) * 4) = *(const f32x4*)(p.norm_final + c4); } }
      __syncthreads(); }
    const int nit = gw < nrows ? (nrows - gw + ngw - 1) / ngw : 0;
    if (nit == 0) return;
    const int last = gw + (nit - 1) * ngw;
#define RS_ROW(i) min(gw + (i) * ngw, last)
    RowX bA, bB; int e0, p0, e1, p1; RowI i0 = rs_idx_issue<COMB>(p, RS_ROW(0), lane, e0, p0), i1 = rs_idx_issue<COMB>(p, RS_ROW(1), lane, e1, p1);
    { int s = COMB ? segL[e0] + p0 : 0; rs_issue<COMB, SRC32>(p, RS_ROW(0), __shfl(s, 0), __shfl(s, 1), lane, bA); }
#pragma unroll 1
    for (int i = 0; i < nit; i += 2) {
        int e2, p2, e3, p3;
        const RowI i2 = rs_idx_issue<COMB>(p, RS_ROW(i + 2), lane, e2, p2);
        { int s = COMB ? segL[e1] + p1 : 0; rs_issue<COMB, SRC32>(p, RS_ROW(i + 1), __shfl(s, 0), __shfl(s, 1), lane, bB); }
        rs_finish<COMB, FINAL, SRC32>(p, l, RS_ROW(i), __shfl(i0.g, 0), __shfl(i0.g, 1), lane, bA, vl, true);
        const RowI i3 = rs_idx_issue<COMB>(p, RS_ROW(i + 3), lane, e3, p3);
        { int s = COMB ? segL[e2] + p2 : 0; rs_issue<COMB, SRC32>(p, RS_ROW(i + 2), __shfl(s, 0), __shfl(s, 1), lane, bA); }
        rs_finish<COMB, FINAL, SRC32>(p, l, RS_ROW(i + 1), __shfl(i1.g, 0), __shfl(i1.g, 1), lane, bB, vl, i + 1 < nit);
        i0 = i2; i1 = i3; e1 = e3; p1 = p3;
    }
#undef RS_ROW
}
constexpr int Q_TOTAL = NPL;
__device__ __forceinline__ void queue_convert8(const Prm& p, unsigned base, LAS unsigned char* lds, int tid_in) {
    int tid = tid_in;
    asm volatile("" : "+v"(tid));
    const int wave = __builtin_amdgcn_readfirstlane(tid >> 6), lane = tid & 63; const unsigned pi = base + (unsigned)wave, pj = pi + 8u;
    if (pi < (unsigned)Q_TOTAL) { const bool h1 = pj < (unsigned)Q_TOTAL; t_convert_two(p, 1, (int)pi, h1 ? (int)pj : (int)pi, h1, (LAS float*)(lds + wave * 16384), lane); }
}
__device__ __forceinline__ void xcd_barrier_work(const XcdBarrier& b, const Prm& p, LAS unsigned char* lds, int tid) {
    asm volatile("s_waitcnt vmcnt(0)" ::: "memory");
    __syncthreads();
    volatile LAS unsigned* bw = (volatile LAS unsigned*)(lds + L_BWORK);
    unsigned* bar = b.bar; unsigned* q = (unsigned*)(p.ws + OFF_Q);
    if (threadIdx.x == 0) {
        __builtin_amdgcn_s_waitcnt(0);
        unsigned nloc = b.st[0], nx = b.st[1];
        if (nloc == 0u) { xcd_barrier_complete(bar, b.x, nloc, nx); b.st[0] = nloc; b.st[1] = nx; }
        const unsigned old = xb_add(&bar[XB_XSUB(b.x)], 1u);
        const unsigned gen = old / nloc;
        if (old + 1u == (gen + 1u) * nloc) {
            __builtin_amdgcn_fence(__ATOMIC_RELEASE, "agent");
            asm volatile("s_waitcnt vmcnt(0)" ::: "memory");
            const unsigned og = xb_add(&bar[XB_TOP], 1u);
            const unsigned tg = og / nx;
            if (og + 1u == (tg + 1u) * nx) xb_add(&bar[XB_TOPGEN], 1u);
            else XB_SPIN(xb_ld(&bar[XB_TOPGEN]) == tg, bar);
            __builtin_amdgcn_fence(__ATOMIC_ACQUIRE, "agent");
            xb_add(&bar[XB_XGEN(b.x)], 1u);
            asm volatile("s_waitcnt vmcnt(0)" ::: "memory");
            bw[0] = 1u;
        } else { bw[0] = 0u; bw[2] = gen; }
    }
    __syncthreads();
    if (bw[0] == 0u) {
        unsigned sp = 0u;
        for (;;) {
            if (threadIdx.x == 0) {
                const unsigned gen = bw[2];
                bool rel = xb_ld(&bar[XB_XGEN(b.x)]) != gen;
                if (!rel && ((++sp & 63u) == 0u)) { if (xb_ld(&bar[XB_TMO])) rel = true; else if (sp > XB_SPIN_CAP) { atomicAdd(&bar[XB_TMO], 1u); rel = true; } }
                if (rel) { __builtin_amdgcn_fence(__ATOMIC_ACQUIRE, "agent"); asm volatile("s_waitcnt vmcnt(0)" ::: "memory"); bw[0] = 1u; }
                else { unsigned base = 0xffffffffu; if (xb_ld(q) < (unsigned)Q_TOTAL) { base = xb_add(q, 16u); if (base >= (unsigned)Q_TOTAL) base = 0xffffffffu; } bw[1] = base; }
            }
            __syncthreads();
            if (bw[0]) break;
            const unsigned base = bw[1];
            if (base != 0xffffffffu) queue_convert8(p, base, lds, tid); else __builtin_amdgcn_s_sleep(4);
            __syncthreads();
        }
    }
    __syncthreads();
}
__device__ __forceinline__ void queue_drain(const Prm& p, LAS unsigned char* lds, int tid, unsigned target) {
    volatile LAS unsigned* bw = (volatile LAS unsigned*)(lds + L_BWORK); unsigned* q = (unsigned*)(p.ws + OFF_Q);
    __syncthreads();
    for (;;) {
        if (threadIdx.x == 0) bw[1] = (xb_ld(q) < target) ? xb_add(q, 16u) : 0xffffffffu;
        __syncthreads();
        const unsigned base = bw[1];
        if (base >= target) break;
        queue_convert8(p, base, lds, tid);
        __syncthreads();
    }
    __syncthreads();
}
__device__ __forceinline__ void phase_conv(const Prm& p, int l, int gw, int ngw, int lane) {
    const bf16* U = (const bf16*)(p.ws + WS_U); bf16* XA = (bf16*)(p.ws + WS_XBC); float* DT = (float*)(p.ws + WS_DT);
    constexpr int NRUN = T_ALL / 16;
    for (int it = gw; it < NRUN * 3; it += ngw) {
        const int run = it / 3, cb = it % 3, t0 = run * 16, ch = cb * 512 + lane * 8;
        int seq0, seq1; if (t0 < T_LAT) { seq0 = t0 & ~(SEQL - 1); seq1 = seq0 + SEQL; } else { seq0 = T_LAT + ((t0 - T_LAT) & ~(CTXL - 1)); seq1 = seq0 + CTXL; }
        float w[5][8], bias[8];
#pragma unroll
        for (int j = 0; j < 5; ++j) { const f32x4 a = *(const f32x4*)(p.conv_w + ((size_t)l * 5 + j) * XBCW + ch), b = *(const f32x4*)(p.conv_w + ((size_t)l * 5 + j) * XBCW + ch + 4);
            w[j][0] = a[0]; w[j][1] = a[1]; w[j][2] = a[2]; w[j][3] = a[3]; w[j][4] = b[0]; w[j][5] = b[1]; w[j][6] = b[2]; w[j][7] = b[3]; }
        { const f32x4 a = *(const f32x4*)(p.conv_b + (size_t)l * XBCW + ch), b = *(const f32x4*)(p.conv_b + (size_t)l * XBCW + ch + 4);
            bias[0] = a[0]; bias[1] = a[1]; bias[2] = a[2]; bias[3] = a[3]; bias[4] = b[0]; bias[5] = b[1]; bias[6] = b[2]; bias[7] = b[3]; }
        v4u rows[20];
#pragma unroll
        for (int j = 0; j < 20; ++j) { const int t = t0 - 2 + j, tc = min(max(t, seq0), seq1 - 1); rows[j] = *(const v4u*)(U + (size_t)tc * NINP + C_XBC + ch); }
#pragma unroll
        for (int j = 0; j < 20; ++j) { const int t = t0 - 2 + j; if (t < seq0 || t >= seq1) rows[j] = (v4u){0u, 0u, 0u, 0u}; }
#pragma unroll
        for (int i = 0; i < 16; ++i) {
            const int t = t0 + i;
            float o[8];
#pragma unroll
            for (int c = 0; c < 8; ++c) o[c] = bias[c];
#pragma unroll
            for (int j = 0; j < 5; ++j) { const v4u wv = rows[i + j];
                o[0] += w[j][0] * bflo(wv.x); o[1] += w[j][1] * bfhi(wv.x); o[2] += w[j][2] * bflo(wv.y); o[3] += w[j][3] * bfhi(wv.y);
                o[4] += w[j][4] * bflo(wv.z); o[5] += w[j][5] * bfhi(wv.z); o[6] += w[j][6] * bflo(wv.w); o[7] += w[j][7] * bfhi(wv.w); }
            v4u r; r.x = pk2(silu_f(o[0]), silu_f(o[1])); r.y = pk2(silu_f(o[2]), silu_f(o[3])); r.z = pk2(silu_f(o[4]), silu_f(o[5])); r.w = pk2(silu_f(o[6]), silu_f(o[7]));
            *(v4u*)(XA + (size_t)t * XBCW + ch) = r;
        }
    }
    for (int it = gw * 64 + lane; it < T_ALL * 32; it += ngw * 64) { const int m = it >> 5, j = it & 31;
        DT[it] = softplus_f(bf2f(U[(size_t)m * NINP + C_DT + j]) + p.dt_bias[l * 32 + j]); }
}

__device__ __forceinline__ void naive_attn_item(const Prm& p, int l, int type, int m, int hh, LAS float* qs, LAS float* sc, int lane) {
    const bf16* U = (const bf16*)(p.ws + WS_U); bf16* MIX = (bf16*)(p.ws + WS_H);
    int qcol, kcol, vcol, ocol;
    if (type == 0 || type == 2) { qcol = C_QA + hh * 128; kcol = C_KA + hh * 128; vcol = C_VA + hh * 128; ocol = hh * 128; }
    else { const int kvh = hh >> 1; qcol = C_QB + hh * 128; kcol = C_KB + kvh * 128; vcol = C_VB + kvh * 128; ocol = 512 + hh * 128; }
    { const unsigned w = *(const unsigned*)(U + (size_t)m * NINP + qcol + 2 * lane); qs[2 * lane] = bflo(w); qs[2 * lane + 1] = bfhi(w); }
    int b, s = 0, qr = 0, qc = 0, krow0 = 0, kpos0 = 0;
    if (type < 2) { b = m >> 13; s = m & 8191; qr = s >> 6; qc = s & 63; } else { b = (m - T_LAT) >> 8; }
    const int nloc = type == 0 ? 512 : (type == 1 ? 384 : 0), nk = nloc + 256;
    if (type == 0) krow0 = min(max(qr - 4, 0), 120);
    if (type == 1) kpos0 = (s >> 7) * 128 - 128;
    const float* rpb = p.na_rpb + (size_t)(l * 4 + hh) * 15 * 31;
    LDS_WAIT(); __builtin_amdgcn_wave_barrier(); asm volatile("" ::: "memory");
    float mx = -INFINITY;
    for (int k0 = 0; k0 < nk; k0 += 64) {
        const int kidx = k0 + lane; int row; float bias = 0.f; bool valid = true;
        if (kidx < nloc) {
            if (type == 0) { const int kr = krow0 + (kidx >> 6), kc = kidx & 63; row = b * SEQL + kr * 64 + kc; const int c0 = min(max(qc - 8, 0), 48); valid = (kc >= c0) && (kc < c0 + 16);
                const int dr = kr - qr + 7, dc = min(max(kc - qc + 15, 0), 30); bias = rpb[dr * 31 + dc]; }
            else { const int kpos = kpos0 + kidx; valid = (kpos >= 0) && (kpos < SEQL) && (abs(s - kpos) <= 128); row = b * SEQL + min(max(kpos, 0), SEQL - 1); }
        } else row = T_LAT + b * CTXL + (kidx - nloc);
        const bf16* kp = U + (size_t)row * NINP + kcol; float d = 0.f;
#pragma unroll 4
        for (int c = 0; c < 16; ++c) { const v4u w = *(const v4u*)(kp + 8 * c); const LAS float* q = qs + 8 * c;
            d += bflo(w.x) * q[0] + bfhi(w.x) * q[1] + bflo(w.y) * q[2] + bfhi(w.y) * q[3] + bflo(w.z) * q[4] + bfhi(w.z) * q[5] + bflo(w.w) * q[6] + bfhi(w.w) * q[7]; }
        const float sv = valid ? d * ATT_SCALE + bias : -INFINITY;
        sc[kidx] = sv; mx = fmaxf(mx, sv);
    }
    mx = wave_max(mx);
    float sum = 0.f;
    for (int k0 = 0; k0 < nk; k0 += 64) { const float e = __expf(sc[k0 + lane] - mx); sc[k0 + lane] = e; sum += e; }
    sum = wave_sum(sum);
    if (type == 1 || type == 3) sum += __expf(p.wa_sink[l * 4 + hh] - mx);
    LDS_WAIT(); __builtin_amdgcn_wave_barrier(); asm volatile("" ::: "memory");
    float o0 = 0.f, o1 = 0.f;
    for (int kidx = 0; kidx < nk; ++kidx) {
        int row;
        if (kidx < nloc) { if (type == 0) row = b * SEQL + (krow0 + (kidx >> 6)) * 64 + (kidx & 63); else row = b * SEQL + min(max(kpos0 + kidx, 0), SEQL - 1); }
        else row = T_LAT + b * CTXL + (kidx - nloc);
        const float pv = sc[kidx]; const unsigned w = *(const unsigned*)(U + (size_t)row * NINP + vcol + 2 * lane);
        o0 += pv * bflo(w); o1 += pv * bfhi(w);
    }
    const float inv = 1.f / sum;
    *(unsigned*)(MIX + (size_t)m * DM + ocol + 2 * lane) = pk2(o0 * inv, o1 * inv);
    LDS_WAIT(); __builtin_amdgcn_wave_barrier(); asm volatile("" ::: "memory");
}
__device__ __forceinline__ void phase_attn_naive(const Prm& p, int l, LAS unsigned char* lds, int gw, int ngw, int wave, int lane) {
    LAS float* qs = (LAS float*)(lds + wave * 4096); LAS float* sc = qs + 128;
    const int nlat = T_LAT * 8, nctx = (l == 0) ? T_CTX * 8 : 0;
    for (int it = gw; it < nlat + nctx; it += ngw) {
        if (it < nlat) { const int m = it >> 3, h8 = it & 7; naive_attn_item(p, l, h8 >> 2, m, h8 & 3, qs, sc, lane); }
        else { const int r = it - nlat, m = T_LAT + (r >> 3), h8 = r & 7; naive_attn_item(p, l, 2 + (h8 >> 2), m, h8 & 3, qs, sc, lane); }
    }
}

__device__ __forceinline__ void phase_ssd_naive(const Prm& p, int l, int wg, int nwg, int tid) {
    const bf16* XA = (const bf16*)(p.ws + WS_XBC); const float* DT = (const float*)(p.ws + WS_DT); float* YD = (float*)(p.ws + WS_YD);
    for (int it = wg; it < 64; it += nwg) {
        const int b = it >> 5, dir = (it >> 4) & 1, h = it & 15, g = h >> 3;
        const int pp = tid >> 3, nq = tid & 7;
        const float a = -__expf(p.a_log[l * 32 + dir * 16 + h]), dsk = p.d_skip[l * 32 + dir * 16 + h];
        float hs[16];
#pragma unroll
        for (int i = 0; i < 16; ++i) hs[i] = 0.f;
#pragma unroll 4
        for (int st = 0; st < CTXL + SEQL; ++st) {
            int m; if (st < CTXL) m = T_LAT + b * CTXL + (dir ? CTXL - 1 - st : st); else { const int s = st - CTXL; m = b * SEQL + (dir ? SEQL - 1 - s : s); }
            const float dtv = DT[(size_t)m * 32 + dir * 16 + h];
            const bf16* row = XA + (size_t)m * XBCW;
            const float xv = bf2f(row[h * 64 + pp]);
            const v4u b0 = *(const v4u*)(row + 1024 + g * 128 + 16 * nq), b1 = *(const v4u*)(row + 1024 + g * 128 + 16 * nq + 8);
            const v4u c0 = *(const v4u*)(row + 1280 + g * 128 + 16 * nq), c1 = *(const v4u*)(row + 1280 + g * 128 + 16 * nq + 8);
            const float dA = __expf(a * dtv), dx = dtv * xv;
            float bv[16], cv[16];
            bv[0] = bflo(b0.x); bv[1] = bfhi(b0.x); bv[2] = bflo(b0.y); bv[3] = bfhi(b0.y); bv[4] = bflo(b0.z); bv[5] = bfhi(b0.z); bv[6] = bflo(b0.w); bv[7] = bfhi(b0.w);
            bv[8] = bflo(b1.x); bv[9] = bfhi(b1.x); bv[10] = bflo(b1.y); bv[11] = bfhi(b1.y); bv[12] = bflo(b1.z); bv[13] = bfhi(b1.z); bv[14] = bflo(b1.w); bv[15] = bfhi(b1.w);
            cv[0] = bflo(c0.x); cv[1] = bfhi(c0.x); cv[2] = bflo(c0.y); cv[3] = bfhi(c0.y); cv[4] = bflo(c0.z); cv[5] = bfhi(c0.z); cv[6] = bflo(c0.w); cv[7] = bfhi(c0.w);
            cv[8] = bflo(c1.x); cv[9] = bfhi(c1.x); cv[10] = bflo(c1.y); cv[11] = bfhi(c1.y); cv[12] = bflo(c1.z); cv[13] = bfhi(c1.z); cv[14] = bflo(c1.w); cv[15] = bfhi(c1.w);
            float part = 0.f;
#pragma unroll
            for (int i = 0; i < 16; ++i) { hs[i] = dA * hs[i] + dx * bv[i]; part += cv[i] * hs[i]; }
            part += __shfl_xor(part, 1); part += __shfl_xor(part, 2); part += __shfl_xor(part, 4);
            if (nq == 0) YD[((size_t)dir * T_ALL + m) * 1024 + h * 64 + pp] = part + dsk * xv;
        }
    }
}
__device__ __forceinline__ void phase_gnorm(const Prm& p, int l, int gw, int ngw, int lane) {
    const bf16* U = (const bf16*)(p.ws + WS_U); const bf16* YD = (const bf16*)(p.ws + WS_XG); bf16* MIX = (bf16*)(p.ws + WS_H);
    const int nrow = (l == 0) ? T_ALL : T_LAT;
    for (int m0 = gw; m0 < nrow; m0 += 2 * ngw) {
        const int m1 = (m0 + ngw < nrow) ? m0 + ngw : m0;
        v2u yv[2][4], zv[2][4];
#pragma unroll
        for (int q = 0; q < 2; ++q) { const int m = q ? m1 : m0;
#pragma unroll
            for (int j = 0; j < 4; ++j) { const int col = 256 * j + 4 * lane; yv[q][j] = *(const v2u*)(YD + (size_t)m * 1024 + col); zv[q][j] = *(const v2u*)(U + (size_t)m * NINP + C_Z + col); } }
#pragma unroll
        for (int q = 0; q < 2; ++q) { const int m = q ? m1 : m0;
            f32x4 u[4]; float ss[2] = {0.f, 0.f};
#pragma unroll
            for (int j = 0; j < 4; ++j) { const v2u yy = yv[q][j], zz = zv[q][j];
                u[j][0] = bflo(yy.x) * silu_f(bflo(zz.x)); u[j][1] = bfhi(yy.x) * silu_f(bfhi(zz.x)); u[j][2] = bflo(yy.y) * silu_f(bflo(zz.y)); u[j][3] = bfhi(yy.y) * silu_f(bfhi(zz.y));
                ss[j >> 1] += (u[j][0] * u[j][0] + u[j][1] * u[j][1]) + (u[j][2] * u[j][2] + u[j][3] * u[j][3]); }
            const float r0 = rsqrtf(wave_sum(ss[0]) * (1.f / 512.f) + EPS), r1 = rsqrtf(wave_sum(ss[1]) * (1.f / 512.f) + EPS);
            if (q == 1 && m1 == m0) continue;
#pragma unroll
            for (int j = 0; j < 4; ++j) { const int col = 256 * j + 4 * lane; const f32x4 g = *(const f32x4*)(p.ssd_norm + l * 1024 + col); const f32x4 o = u[j] * (j < 2 ? r0 : r1) * g;
                if (F8_OUTPROJ) *(unsigned*)((unsigned char*)MIX + (size_t)m * DM + 1024 + col) = pack4f8(o[0] * MIX_SCALE, o[1] * MIX_SCALE, o[2] * MIX_SCALE, o[3] * MIX_SCALE);
                else { v2u w; w.x = pk2(o[0], o[1]); w.y = pk2(o[2], o[3]); *(v2u*)(MIX + (size_t)m * DM + 1024 + col) = w; } }
        }
    }
}
namespace att {
typedef short s16x4 __attribute__((ext_vector_type(4)));
typedef float f32x16 __attribute__((ext_vector_type(16)));
constexpr int KVBLK = 64;
constexpr float THR = 8.f;
#ifndef ATT_SDEPTH
#define ATT_SDEPTH 1
#endif
constexpr int SDEPTH = ATT_SDEPTH;
constexpr int SHM_V = KVBLK * 128 * 2, SHM_K = KVBLK * 128 * 2;
constexpr int OFF_V = 0, OFF_K = 2 * SHM_V, OFF_WS = 2 * SHM_V + 2 * SHM_K, OFF_RPB = OFF_WS + 8 * 64 * 4, ATT_LDS = OFF_RPB + 576 * 4;
#define KSWZ(row, colB) ((row) * 256 + ((colB) ^ (((row) & 7) << 4)))
#define SBAR() __builtin_amdgcn_sched_barrier(0)
__device__ __forceinline__ int crow(int r, int hi) { return (r & 3) + 8 * (r >> 2) + 4 * hi; }
__device__ __forceinline__ unsigned cvtpk(float lo, float hi) { unsigned r; asm volatile("v_cvt_pk_bf16_f32 %0, %1, %2" : "=v"(r) : "v"(lo), "v"(hi)); return r; }
__device__ __forceinline__ void partialSM(f32x16& p0, f32x16& p1, float& m_reg, float& mn, float& alpha) {
  constexpr float C = ATT_SCALE * 1.4426950408889634f;
  float pmax = p0[0];
#pragma unroll
  for (int r = 1; r < 16; ++r) pmax = fmaxf(pmax, p0[r]);
#pragma unroll
  for (int r = 0; r < 16; ++r) pmax = fmaxf(pmax, p1[r]);
  { auto rr = __builtin_amdgcn_permlane32_swap(__float_as_uint(pmax), __float_as_uint(pmax), false, false);
    pmax = fmaxf(__uint_as_float(rr[0]), __uint_as_float(rr[1])); }
  if (__builtin_expect(__all(pmax - m_reg <= THR / ATT_SCALE), 1)) { mn = m_reg; alpha = 1.f; }
  else { mn = fmaxf(m_reg, pmax); alpha = __builtin_amdgcn_exp2f((m_reg - mn) * C); m_reg = mn; }
  float mnC = -mn * C;
#pragma unroll
  for (int r = 0; r < 16; ++r) p0[r] = fmaf(p0[r], C, mnC);
#pragma unroll
  for (int r = 0; r < 16; ++r) p1[r] = fmaf(p1[r], C, mnC);
#pragma unroll
  for (int r = 0; r < 16; ++r) p0[r] = __builtin_amdgcn_exp2f(p0[r]);
}
__device__ __forceinline__ void finishSM(f32x16& p0, f32x16& p1, float alpha, float& l_reg, bf16x8& pa0, bf16x8& pa1, bf16x8& pa2, bf16x8& pa3) {
#pragma unroll
  for (int r = 0; r < 16; ++r) p1[r] = __builtin_amdgcn_exp2f(p1[r]);
  float ps = 0;
#pragma unroll
  for (int r = 0; r < 16; ++r) ps += p0[r];
#pragma unroll
  for (int r = 0; r < 16; ++r) ps += p1[r];
  { auto rr = __builtin_amdgcn_permlane32_swap(__float_as_uint(ps), __float_as_uint(ps), false, false);
    ps = __uint_as_float(rr[0]) + __uint_as_float(rr[1]); }
  l_reg = l_reg * alpha + ps;
#define PK4(P, BASE, OUT) do { unsigned a0 = cvtpk(P[BASE + 0], P[BASE + 1]), a1 = cvtpk(P[BASE + 2], P[BASE + 3]);   \
    unsigned b0 = cvtpk(P[BASE + 4], P[BASE + 5]), b1 = cvtpk(P[BASE + 6], P[BASE + 7]);                              \
    auto r0 = __builtin_amdgcn_permlane32_swap(a0, b0, false, false); auto r1 = __builtin_amdgcn_permlane32_swap(a1, b1, false, false); \
    v4u w = {r0[0], r1[0], r0[1], r1[1]}; OUT = *reinterpret_cast<bf16x8*>(&w); } while (0)
  PK4(p0, 0, pa0); PK4(p0, 8, pa1); PK4(p1, 0, pa2); PK4(p1, 8, pa3);
#undef PK4
}
__device__ __forceinline__ void qkt(f32x16& p0, f32x16& p1, const LAS unsigned char* Ks, const bf16x8* qr, int r32, int hi) {
  p0 = f32x16{}; p1 = f32x16{};
#pragma unroll
  for (int d0 = 0; d0 < 8; ++d0) { int cb = (d0 * 16 + hi * 8) * 2;
    bf16x8 b0 = *reinterpret_cast<const LAS bf16x8*>(Ks + KSWZ(r32, cb));
    bf16x8 b1 = *reinterpret_cast<const LAS bf16x8*>(Ks + KSWZ(32 + r32, cb));
    p0 = __builtin_amdgcn_mfma_f32_32x32x16_bf16(b0, qr[d0], p0, 0, 0, 0);
    p1 = __builtin_amdgcn_mfma_f32_32x32x16_bf16(b1, qr[d0], p1, 0, 0, 0); }
}
__device__ __forceinline__ int v_st(int k, int c) { const int kk = (k & ~0xC) | ((k & 4) << 1) | ((k & 8) >> 1); return ((kk >> 3) * 4 + (c >> 5)) * 512 + ((kk & 7) * 32 + (c & 31)) * 2; }
__device__ __forceinline__ int v_rd_base(int lane) { return ((lane & 3) << 3) | (((lane >> 2) & 3) << 6) | (((lane >> 4) & 1) << 5) | (((lane >> 5) & 1) << 8); }
constexpr int v_rd_off(int d0, int ks, int half) { return d0 * 512 + ks * 4096 + half * 2048; }
template <int OFF> __device__ __forceinline__ s16x4 tr_read(int vb) {
  s16x4 r; asm volatile("ds_read_b64_tr_b16 %0, %1 offset:%2" : "=&v"(r) : "v"(vb), "i"(OFF) : "memory"); return r;
}
template <int D0> __device__ __forceinline__ void pv_one(f32x16& od, int vb, bf16x8 pa0, bf16x8 pa1, bf16x8 pa2, bf16x8 pa3) {
  const s16x4 l0 = tr_read<v_rd_off(D0, 0, 0)>(vb), h0 = tr_read<v_rd_off(D0, 0, 1)>(vb), l1 = tr_read<v_rd_off(D0, 1, 0)>(vb), h1 = tr_read<v_rd_off(D0, 1, 1)>(vb);
  const s16x4 l2 = tr_read<v_rd_off(D0, 2, 0)>(vb), h2 = tr_read<v_rd_off(D0, 2, 1)>(vb), l3 = tr_read<v_rd_off(D0, 3, 0)>(vb), h3 = tr_read<v_rd_off(D0, 3, 1)>(vb);
  asm volatile("s_waitcnt lgkmcnt(0)" ::: "memory"); SBAR();
#define PK(L, H) (bf16x8){L[0], L[1], L[2], L[3], H[0], H[1], H[2], H[3]}
  od = __builtin_amdgcn_mfma_f32_32x32x16_bf16(pa0, PK(l0, h0), od, 0, 0, 0);
  od = __builtin_amdgcn_mfma_f32_32x32x16_bf16(pa1, PK(l1, h1), od, 0, 0, 0);
  od = __builtin_amdgcn_mfma_f32_32x32x16_bf16(pa2, PK(l2, h2), od, 0, 0, 0);
  od = __builtin_amdgcn_mfma_f32_32x32x16_bf16(pa3, PK(l3, h3), od, 0, 0, 0);
#undef PK
}
__device__ __forceinline__ void pv_d0(f32x16* o, int vb, bf16x8 pa0, bf16x8 pa1, bf16x8 pa2, bf16x8 pa3) {
  pv_one<0>(o[0], vb, pa0, pa1, pa2, pa3); pv_one<1>(o[1], vb, pa0, pa1, pa2, pa3); pv_one<2>(o[2], vb, pa0, pa1, pa2, pa3); pv_one<3>(o[3], vb, pa0, pa1, pa2, pa3);
}
struct UnitD { int type, b, hh, q0  , nloc  , kbase  ; };
__device__ __forceinline__ int tile_row(const UnitD& u, int j) {
    if (j >= u.nloc) return T_LAT + u.b * CTXL + (j - u.nloc) * 64;
    if (u.type == 0) return u.b * SEQL + (u.kbase + j) * 64;
    const int kp = u.kbase + j * 64; return u.b * SEQL + min(max(kp, 0), SEQL - 64);
}
__device__ __forceinline__ bool tile_active(const UnitD& u, int j, int wid) {
    if (j >= u.nloc) return true;
    if (u.type == 0) { const int qr = (u.q0 >> 6) + (wid >> 1), kr = u.kbase + j, start = min(max(qr - 4, 0), 120); return kr >= start && kr < start + 8; }
    const int qw = u.q0 + 32 * wid, kp0 = u.kbase + j * 64;
    return (kp0 >= 0) && (kp0 < SEQL) && (kp0 - (qw + 31) <= 128) && (qw - (kp0 + 63) <= 128);
}
__device__ __forceinline__ void apply_mask(f32x16& p0, f32x16& p1, const UnitD& u, int j, int wid, int r32, int hi, const LAS float* rpbL) {
    if (j >= u.nloc) return;
    if (u.type == 0) {
        const int qr = (u.q0 >> 6) + (wid >> 1), qc = (wid & 1) * 32 + r32, kr = u.kbase + j;
        const int c0 = min(max(qc - 8, 0), 48), cb = 4 * hi - c0;
        const LAS float* rp = rpbL + (kr - qr + 7) * 31 + 4 * hi - qc + 15 + 32;
#pragma unroll
        for (int r = 0; r < 16; ++r) {
            const int k0 = (r & 3) + 8 * (r >> 2);
            p0[r] = ((unsigned)(k0 + cb) < 16u) ? p0[r] + rp[k0] : -INFINITY;
            p1[r] = ((unsigned)(k0 + 32 + cb) < 16u) ? p1[r] + rp[k0 + 32] : -INFINITY;
            if ((r & 3) == 3) SBAR(); }
    } else {
        const int qw = u.q0 + 32 * wid, kp0 = u.kbase + j * 64;
        if ((kp0 + 63 - qw <= 128) && (qw + 31 - kp0 <= 128)) return;
        const int cb = kp0 + 4 * hi - (qw + r32) + 128;
#pragma unroll
        for (int r = 0; r < 16; ++r) {
            const int k0 = (r & 3) + 8 * (r >> 2);
            p0[r] = ((unsigned)(k0 + cb) <= 256u) ? p0[r] : -INFINITY;
            p1[r] = ((unsigned)(k0 + 32 + cb) <= 256u) ? p1[r] : -INFINITY; }
    }
}
__device__ __forceinline__ void fill_ninf(f32x16& p0, f32x16& p1) {
#pragma unroll
    for (int r = 0; r < 16; ++r) { p0[r] = -INFINITY; p1[r] = -INFINITY; }
}
__device__ __forceinline__ void attn_unit(const Prm& p, int l, const UnitD u, LAS unsigned char* lds, int tid) {
  const bf16* U = (const bf16*)(p.ws + WS_U); bf16* MIX = (bf16*)(p.ws + WS_H);
  const int wid = __builtin_amdgcn_readfirstlane(tid >> 6), lane = tid & 63, r32 = lane & 31, hi = lane >> 5;
  int qcol, kcol, vcol, ocol;
  if (u.type == 0 || u.type == 2) { qcol = C_QA + u.hh * 128; kcol = C_KA + u.hh * 128; vcol = C_VA + u.hh * 128; ocol = u.hh * 128; }
  else { const int kvh = u.hh >> 1; qcol = C_QB + u.hh * 128; kcol = C_KB + kvh * 128; vcol = C_VB + kvh * 128; ocol = 512 + u.hh * 128; }
  const int qrow0 = (u.type < 2 ? u.b * SEQL : T_LAT + u.b * CTXL) + u.q0;
  LAS unsigned char* V_lds = lds + OFF_V; LAS unsigned char* K_lds = lds + OFF_K;
  LAS float* wsl = (LAS float*)(lds + OFF_WS) + wid * 64; LAS float* li_l = wsl; LAS float* al_l = wsl + 32;
  LAS float* rpbL = (LAS float*)(lds + OFF_RPB);
  if (u.type == 0 && tid < 465) rpbL[32 + tid] = p.na_rpb[(size_t)(l * 4 + u.hh) * 465 + tid] * (1.f / ATT_SCALE);
  float m_reg = -1e30f, l_reg = 0; f32x16 o[4] = {}; bf16x8 qr[8];
  const bf16* Qw = U + (size_t)(qrow0 + wid * 32 + r32) * NINP + qcol + hi * 8;
#pragma unroll
  for (int d0 = 0; d0 < 8; ++d0) qr[d0] = *reinterpret_cast<const bf16x8*>(Qw + d0 * 16);
  const int sr = tid >> 4, sc = (tid & 15) * 8, vst0 = v_st(sr, sc), vst1 = v_st(32 + sr, sc);
  const int vb0 = (int)(uintptr_t)V_lds + v_rd_base(lane);
  struct { bf16x8 vs0, vs1, ks0, ks1; } sr_[SDEPTH];
#define SLOAD(i, jt) do { const bf16* rb_ = U + (size_t)(tile_row(u, (jt)) + sr) * NINP + sc; \
    sr_[i].vs0 = *reinterpret_cast<const bf16x8*>(rb_ + vcol); sr_[i].vs1 = *reinterpret_cast<const bf16x8*>(rb_ + (size_t)32 * NINP + vcol); \
    sr_[i].ks0 = *reinterpret_cast<const bf16x8*>(rb_ + kcol); sr_[i].ks1 = *reinterpret_cast<const bf16x8*>(rb_ + (size_t)32 * NINP + kcol); } while (0)
#define SWRITE(b, i) do { *(LAS bf16x8*)(V_lds + (b) * SHM_V + vst0) = sr_[i].vs0;          \
    *(LAS bf16x8*)(V_lds + (b) * SHM_V + vst1) = sr_[i].vs1; int kc = sc * 2;               \
    *(LAS bf16x8*)(K_lds + (b) * SHM_K + KSWZ(sr, kc)) = sr_[i].ks0;                       \
    *(LAS bf16x8*)(K_lds + (b) * SHM_K + KSWZ(32 + sr, kc)) = sr_[i].ks1; } while (0)
#define SWAIT() do { if constexpr (SDEPTH == 2) asm volatile("s_waitcnt vmcnt(4)" ::: "memory"); else asm volatile("s_waitcnt vmcnt(0)" ::: "memory"); } while (0)
#define RESC(a) do { if (__any((a) < 1.f)) { if (hi == 0) al_l[r32] = (a); asm volatile("s_waitcnt lgkmcnt(0)" ::: "memory"); \
    _Pragma("unroll") for (int d = 0; d < 4; ++d) _Pragma("unroll") for (int r = 0; r < 16; ++r) o[d][r] *= al_l[crow(r, hi)]; } } while (0)
  f32x16 pA0, pA1, pB0, pB1; float mnA, mnB, alA, alB; bf16x8 pa0, pa1, pa2, pa3; const int NT = u.nloc + 4;
  constexpr int SE = 0, SO = SDEPTH - 1;
  SLOAD(SE, 0); asm volatile("s_waitcnt vmcnt(0)" ::: "memory"); SWRITE(0, SE); __syncthreads();
#define SCORE(P0, P1, KB, jt, ACT) do { ACT = tile_active(u, (jt), wid); if (ACT) { qkt(P0, P1, KB, qr, r32, hi); apply_mask(P0, P1, u, (jt), wid, r32, hi, rpbL); } else fill_ninf(P0, P1); } while (0)
  bool actA, actB;
  SCORE(pA0, pA1, K_lds, 0, actA); partialSM(pA0, pA1, m_reg, mnA, alA);
  SLOAD(SO, 1); if constexpr (SDEPTH == 2) { if (2 < NT) SLOAD(SE, 2); }
  SWAIT(); SWRITE(1, SO); __syncthreads();
  for (int j = 1; j + 1 < NT; j += 2) {
    SBAR(); SCORE(pB0, pB1, K_lds + SHM_K, j, actB);
    finishSM(pA0, pA1, alA, l_reg, pa0, pa1, pa2, pa3); SBAR();
    SLOAD(SO, j + SDEPTH); SBAR();
    if (actA) pv_d0(o, vb0, pa0, pa1, pa2, pa3); partialSM(pB0, pB1, m_reg, mnB, alB);
    __syncthreads(); SWAIT(); SWRITE(0, SE);
    RESC(alB); __syncthreads();
    SBAR(); SCORE(pA0, pA1, K_lds, j + 1, actA);
    finishSM(pB0, pB1, alB, l_reg, pa0, pa1, pa2, pa3); SBAR();
    if (SDEPTH == 1 || j + 3 < NT) SLOAD(SE, j + 1 + SDEPTH); SBAR();
    if (actB) pv_d0(o, vb0 + SHM_V, pa0, pa1, pa2, pa3); partialSM(pA0, pA1, m_reg, mnA, alA);
    __syncthreads(); SWAIT(); SWRITE(1, SO);
    RESC(alA); __syncthreads();
  }
  SBAR(); SCORE(pB0, pB1, K_lds + SHM_K, NT - 1, actB);
  finishSM(pA0, pA1, alA, l_reg, pa0, pa1, pa2, pa3); SBAR();
  if (actA) pv_d0(o, vb0, pa0, pa1, pa2, pa3); partialSM(pB0, pB1, m_reg, mnB, alB);
  __syncthreads(); RESC(alB);
  finishSM(pB0, pB1, alB, l_reg, pa0, pa1, pa2, pa3); SBAR();
  if (actB) pv_d0(o, vb0 + SHM_V, pa0, pa1, pa2, pa3);
  if (u.type & 1) { constexpr float C = ATT_SCALE * 1.4426950408889634f; l_reg += __builtin_amdgcn_exp2f((p.wa_sink[l * 4 + u.hh] * (1.f / ATT_SCALE) - m_reg) * C); }
  if (hi == 0) li_l[r32] = l_reg; asm volatile("s_waitcnt lgkmcnt(0)" ::: "memory");
  float rli[16];
#pragma unroll
  for (int r = 0; r < 16; ++r) rli[r] = __builtin_amdgcn_rcpf(li_l[crow(r, hi)]);
  bf16* Ow = MIX + (size_t)(qrow0 + wid * 32) * DM + ocol;
#pragma unroll
  for (int r = 0; r < 16; r += 2) {
#pragma unroll
    for (int d0 = 0; d0 < 4; ++d0) {
      const float a = o[d0][r] * rli[r], b = o[d0][r + 1] * rli[r + 1];
      const float send = (lane & 1) ? a : b, got = __shfl_xor(send, 1);
      const int orow = crow(r, hi) + (lane & 1), ocl = d0 * 32 + (r32 & ~1);
      if (F8_OUTPROJ) { const float lo = ((lane & 1) ? got : a) * MIX_SCALE, hi2 = ((lane & 1) ? b : got) * MIX_SCALE;
        *(unsigned short*)((unsigned char*)MIX + (size_t)(qrow0 + wid * 32 + orow) * DM + ocol + ocl) = (unsigned short)pack4f8(lo, hi2, 0.f, 0.f); }
      else { const unsigned w = (lane & 1) ? pk2(got, b) : pk2(a, got); *(unsigned*)(Ow + (size_t)orow * DM + ocl) = w; } } }
  __syncthreads();
#undef SCORE
#undef SLOAD
#undef SWRITE
#undef SWAIT
#undef RESC
}
constexpr int NSLOT = 3;
constexpr int OFFD_K = 0, OFFD_V = NSLOT * SHM_K, OFFD_WS = NSLOT * (SHM_K + SHM_V), OFFD_RPB = OFFD_WS + 8 * 64 * 4, ATT_LDS_D = OFFD_RPB + 576 * 4;
static_assert(ATT_LDS_D <= RING_BYTES, "attention LDS");
__device__ __forceinline__ void attn_unit_dma(const Prm& p, int l, const UnitD u, LAS unsigned char* lds, int tid) {
  const bf16* U = (const bf16*)(p.ws + WS_U); bf16* MIX = (bf16*)(p.ws + WS_H);
  const int wid = __builtin_amdgcn_readfirstlane(tid >> 6), lane = tid & 63, r32 = lane & 31, hi = lane >> 5;
  int qcol, kcol, vcol, ocol;
  if (u.type == 0 || u.type == 2) { qcol = C_QA + u.hh * 128; kcol = C_KA + u.hh * 128; vcol = C_VA + u.hh * 128; ocol = u.hh * 128; }
  else { const int kvh = u.hh >> 1; qcol = C_QB + u.hh * 128; kcol = C_KB + kvh * 128; vcol = C_VB + kvh * 128; ocol = 512 + u.hh * 128; }
  const int qrow0 = (u.type < 2 ? u.b * SEQL : T_LAT + u.b * CTXL) + u.q0;
  LAS unsigned char* K_lds = lds + OFFD_K; LAS unsigned char* V_lds = lds + OFFD_V;
  LAS float* wsl = (LAS float*)(lds + OFFD_WS) + wid * 64; LAS float* li_l = wsl; LAS float* al_l = wsl + 32;
  LAS float* rpbL = (LAS float*)(lds + OFFD_RPB);
  if (u.type == 0 && tid < 465) rpbL[32 + tid] = p.na_rpb[(size_t)(l * 4 + u.hh) * 465 + tid] * (1.f / ATT_SCALE);
  float m_reg = -1e30f, l_reg = 0; f32x16 o[4] = {}; bf16x8 qr[8];
  const bf16* Qw = U + (size_t)(qrow0 + wid * 32 + r32) * NINP + qcol + hi * 8;
#pragma unroll
  for (int d0 = 0; d0 < 8; ++d0) qr[d0] = *reinterpret_cast<const bf16x8*>(Qw + d0 * 16);
  unsigned koff[2], voff[2];
#pragma unroll
  for (int i = 0; i < 2; ++i) { const int pch = (wid * 2 + i) * 64 + lane;
    { const int row = pch >> 4, c = (pch & 15) ^ (row & 7); koff[i] = (unsigned)(row * NINP + kcol + c * 8); }
    { const int sidx = pch >> 5, q = pch & 31, kk = (sidx >> 2) * 8 + (q >> 2), k = (kk & ~0xC) | ((kk & 4) << 1) | ((kk & 8) >> 1);
      voff[i] = (unsigned)(k * NINP + vcol + (sidx & 3) * 32 + (q & 3) * 8); } }
  const int vb0 = (int)(uintptr_t)V_lds + v_rd_base(lane);
#define DMA_K(jt) do { const bf16* tb_ = U + (size_t)tile_row(u, (jt)) * NINP; LAS unsigned char* dst_ = K_lds + ((jt) % NSLOT) * SHM_K + wid * 2048; \
    _Pragma("unroll") for (int i_ = 0; i_ < 2; ++i_) __builtin_amdgcn_global_load_lds((const unsigned*)(tb_ + koff[i_]), (LAS unsigned*)(dst_ + i_ * 1024), 16, 0, 0); } while (0)
#define DMA_V(jt) do { const bf16* tb_ = U + (size_t)tile_row(u, (jt)) * NINP; LAS unsigned char* dst_ = V_lds + ((jt) % NSLOT) * SHM_V + wid * 2048; \
    _Pragma("unroll") for (int i_ = 0; i_ < 2; ++i_) __builtin_amdgcn_global_load_lds((const unsigned*)(tb_ + voff[i_]), (LAS unsigned*)(dst_ + i_ * 1024), 16, 0, 0); } while (0)
#define STEP_SYNC4() asm volatile("s_waitcnt vmcnt(4) lgkmcnt(0)\n\ts_barrier" ::: "memory")
#define STEP_SYNC0() asm volatile("s_waitcnt vmcnt(0) lgkmcnt(0)\n\ts_barrier" ::: "memory")
#define RESC(a) do { if (__any((a) < 1.f)) { if (hi == 0) al_l[r32] = (a); asm volatile("s_waitcnt lgkmcnt(0)" ::: "memory"); \
    _Pragma("unroll") for (int d = 0; d < 4; ++d) _Pragma("unroll") for (int r = 0; r < 16; ++r) o[d][r] *= al_l[crow(r, hi)]; } } while (0)
#define SCORE(P0, P1, jt, ACT) do { ACT = tile_active(u, (jt), wid); if (ACT) { qkt(P0, P1, K_lds + ((jt) % NSLOT) * SHM_K, qr, r32, hi); apply_mask(P0, P1, u, (jt), wid, r32, hi, rpbL); } else fill_ninf(P0, P1); } while (0)
  f32x16 pA0, pA1, pB0, pB1; float mnA, mnB, alA, alB; bf16x8 pa0, pa1, pa2, pa3; const int NT = u.nloc + 4; bool actA, actB;
  DMA_K(0); DMA_K(1); DMA_V(0);
  STEP_SYNC4();
  DMA_K(2); DMA_V(1);
  SCORE(pA0, pA1, 0, actA); partialSM(pA0, pA1, m_reg, mnA, alA);
#pragma unroll 1
  for (int s = 1; s + 1 < NT; s += 2) {
    STEP_SYNC4();
    DMA_K(s + 2); DMA_V(s + 1);
    SBAR(); SCORE(pB0, pB1, s, actB);
    finishSM(pA0, pA1, alA, l_reg, pa0, pa1, pa2, pa3); SBAR();
    if (actA) pv_d0(o, vb0 + ((s - 1) % NSLOT) * SHM_V, pa0, pa1, pa2, pa3); partialSM(pB0, pB1, m_reg, mnB, alB);
    RESC(alB);
    STEP_SYNC4();
    if (s + 3 < NT) DMA_K(s + 3); DMA_V(s + 2);
    SBAR(); SCORE(pA0, pA1, s + 1, actA);
    finishSM(pB0, pB1, alB, l_reg, pa0, pa1, pa2, pa3); SBAR();
    if (actB) pv_d0(o, vb0 + (s % NSLOT) * SHM_V, pa0, pa1, pa2, pa3); partialSM(pA0, pA1, m_reg, mnA, alA);
    RESC(alA);
  }
  STEP_SYNC0();
  SBAR(); SCORE(pB0, pB1, NT - 1, actB);
  finishSM(pA0, pA1, alA, l_reg, pa0, pa1, pa2, pa3); SBAR();
  if (actA) pv_d0(o, vb0 + ((NT - 2) % NSLOT) * SHM_V, pa0, pa1, pa2, pa3); partialSM(pB0, pB1, m_reg, mnB, alB);
  RESC(alB);
  finishSM(pB0, pB1, alB, l_reg, pa0, pa1, pa2, pa3); SBAR();
  if (actB) pv_d0(o, vb0 + ((NT - 1) % NSLOT) * SHM_V, pa0, pa1, pa2, pa3);
  if (u.type & 1) { constexpr float C = ATT_SCALE * 1.4426950408889634f; l_reg += __builtin_amdgcn_exp2f((p.wa_sink[l * 4 + u.hh] * (1.f / ATT_SCALE) - m_reg) * C); }
  if (hi == 0) li_l[r32] = l_reg; asm volatile("s_waitcnt lgkmcnt(0)" ::: "memory");
  float rli[16];
#pragma unroll
  for (int r = 0; r < 16; ++r) rli[r] = __builtin_amdgcn_rcpf(li_l[crow(r, hi)]);
  bf16* Ow = MIX + (size_t)(qrow0 + wid * 32) * DM + ocol;
#pragma unroll
  for (int r = 0; r < 16; r += 2) {
#pragma unroll
    for (int d0 = 0; d0 < 4; ++d0) {
      const float a = o[d0][r] * rli[r], b = o[d0][r + 1] * rli[r + 1];
      const float send = (lane & 1) ? a : b, got = __shfl_xor(send, 1);
      const int orow = crow(r, hi) + (lane & 1), ocl = d0 * 32 + (r32 & ~1);
      if (F8_OUTPROJ) { const float lo = ((lane & 1) ? got : a) * MIX_SCALE, hi2 = ((lane & 1) ? b : got) * MIX_SCALE;
        *(unsigned short*)((unsigned char*)MIX + (size_t)(qrow0 + wid * 32 + orow) * DM + ocol + ocl) = (unsigned short)pack4f8(lo, hi2, 0.f, 0.f); }
      else { const unsigned w = (lane & 1) ? pk2(got, b) : pk2(a, got); *(unsigned*)(Ow + (size_t)orow * DM + ocl) = w; } } }
  asm volatile("s_waitcnt lgkmcnt(0)\n\ts_barrier" ::: "memory");
#undef DMA_K
#undef DMA_V
#undef STEP_SYNC4
#undef STEP_SYNC0
#undef RESC
#undef SCORE
}
#ifndef ATT_DMA
#define ATT_DMA 1
#endif
__device__ __forceinline__ void phase_attn(const Prm& p, int l, LAS unsigned char* lds, int wg, int nwg, int tid) {
    const int nu = 512 + (l == 0 ? 16 : 0);
    for (int it = wg; it < nu; it += nwg) {
        UnitD u;
        if (it < 256) { u.type = 0; u.b = it >> 7; u.hh = (it >> 5) & 3; const int blk = it & 31; u.q0 = blk * 256; u.nloc = 12; u.kbase = min(max(blk * 4 - 4, 0), 116); }
        else if (it < 512) { const int r = it - 256; u.type = 1; u.b = r >> 7; u.hh = (r >> 5) & 3; const int blk = r & 31; u.q0 = blk * 256; u.nloc = 8; u.kbase = blk * 256 - 128; }
        else { const int r = it - 512; u.type = 2 + (r >> 3); u.b = (r >> 2) & 1; u.hh = r & 3; u.q0 = 0; u.nloc = 0; u.kbase = 0; }
        if (ATT_DMA) attn_unit_dma(p, l, u, lds, tid); else attn_unit(p, l, u, lds, tid);
    }
}
}
namespace ssd {
typedef short s16x4 __attribute__((ext_vector_type(4)));
typedef float f32x16 __attribute__((ext_vector_type(16)));
constexpr int NCH = 66;
constexpr size_t WS_ST = WS_YD, WS_HS = WS_YD + 66 * MiB, WS_DEC = 1259 * MiB;
__device__ __forceinline__ int crow(int r, int hi) { return (r & 3) + 8 * (r >> 2) + 4 * hi; }
__device__ __forceinline__ int chunk_row0(int b, int c) { return c < 2 ? T_LAT + b * CTXL + c * 128 : b * SEQL + (c - 2) * 128; }
__device__ __forceinline__ s16x4 ds_tr(unsigned addr) { s16x4 r; asm volatile("ds_read_b64_tr_b16 %0, %1" : "=&v"(r) : "v"(addr) : "memory"); return r; }
struct Raw { s16x4 lo, hi; };
__device__ __forceinline__ Raw raw_tr_nat(unsigned base, int stride, int k0, int idx0, int lane) {
    const int i16 = lane & 15, g16 = (lane >> 4) & 1, hl = lane >> 5;
    const unsigned a = base + (unsigned)((k0 + 8 * hl + (i16 >> 2)) * stride + (idx0 + 16 * g16 + 4 * (i16 & 3)) * 2);
    Raw r; r.lo = ds_tr(a); r.hi = ds_tr(a + 4 * stride); return r;
}
__device__ __forceinline__ Raw raw_tr_acc(unsigned base, int stride, int k0, int idx0, int lane) {
    const int i16 = lane & 15, g16 = (lane >> 4) & 1, hl = lane >> 5;
    const unsigned a = base + (unsigned)((k0 + 4 * hl + (i16 >> 2)) * stride + (idx0 + 16 * g16 + 4 * (i16 & 3)) * 2);
    Raw r; r.lo = ds_tr(a); r.hi = ds_tr(a + 8 * stride); return r;
}
__device__ __forceinline__ void raw_wait2(Raw& a, Raw& b) { asm volatile("s_waitcnt lgkmcnt(0)" : "+v"(a.lo), "+v"(a.hi), "+v"(b.lo), "+v"(b.hi) :: "memory"); }
__device__ __forceinline__ void raw_wait6(Raw& a, Raw& b, Raw& c, Raw& d, Raw& e, Raw& f) {
    asm volatile("s_waitcnt lgkmcnt(0)" : "+v"(a.lo), "+v"(a.hi), "+v"(b.lo), "+v"(b.hi), "+v"(c.lo), "+v"(c.hi), "+v"(d.lo), "+v"(d.hi), "+v"(e.lo), "+v"(e.hi), "+v"(f.lo), "+v"(f.hi) :: "memory"); }
__device__ __forceinline__ bf16x8 join8(const Raw& r) { return (bf16x8){r.lo[0], r.lo[1], r.lo[2], r.lo[3], r.hi[0], r.hi[1], r.hi[2], r.hi[3]}; }
__device__ __forceinline__ unsigned cvtpk(float lo, float hi) { unsigned r; asm volatile("v_cvt_pk_bf16_f32 %0, %1, %2\n\ts_nop 1" : "=v"(r) : "v"(lo), "v"(hi)); return r; }
__device__ __forceinline__ void scan128(float& v0, float& v1, int lane) {
#pragma unroll
    for (int o = 1; o < 64; o <<= 1) { const int src = (lane >= o ? lane - o : lane) << 2;
        const float t0 = __builtin_bit_cast(float, __builtin_amdgcn_ds_bpermute(src, __builtin_bit_cast(int, v0))), t1 = __builtin_bit_cast(float, __builtin_amdgcn_ds_bpermute(src, __builtin_bit_cast(int, v1)));
        if (lane >= o) { v0 += t0; v1 += t1; } }
    v1 += __builtin_bit_cast(float, __builtin_amdgcn_ds_bpermute(63 << 2, __builtin_bit_cast(int, v0)));
}
__device__ __forceinline__ float lane63(float v) { return __builtin_bit_cast(float, __builtin_amdgcn_ds_bpermute(63 << 2, __builtin_bit_cast(int, v))); }

constexpr int BST = 272, XST = 528;
constexpr int S2_B = 0, S2_X = 128 * BST, S2_W = S2_X + 128 * XST, S2_END = S2_W + 8 * 128 * 4;
__device__ __forceinline__ void phase_states(const Prm& p, int l, LAS unsigned char* lds, int wg, int nwg, int tid) {
    const bf16* XA = (const bf16*)(p.ws + WS_XBC); const float* DT = (const float*)(p.ws + WS_DT);
    bf16* ST = (bf16*)(p.ws + WS_ST); float* DEC = (float*)(p.ws + WS_DEC);
    const int wid = __builtin_amdgcn_readfirstlane(tid >> 6), lane = tid & 63, hl = lane >> 5;
    for (int it = wg; it < 2 * NCH * 4; it += nwg) {
        const int b = it / (NCH * 4), rem = it % (NCH * 4), c = rem >> 2, g = (rem >> 1) & 1, hq = rem & 1;
        const int row0 = chunk_row0(b, c), h = 8 * g + 4 * hq + (wid & 3), dir = wid >> 2;
        { v4u tb[4], tx[8];
#pragma unroll
          for (int i = 0; i < 4; ++i) { const int id = tid + 512 * i, r = id >> 4, ch = id & 15; tb[i] = *(const v4u*)(XA + (size_t)(row0 + r) * XBCW + 1024 + g * 128 + ch * 8); }
#pragma unroll
          for (int i = 0; i < 8; ++i) { const int id = tid + 512 * i, r = id >> 5, ch = id & 31; tx[i] = *(const v4u*)(XA + (size_t)(row0 + r) * XBCW + (8 * g + 4 * hq) * 64 + ch * 8); }
#pragma unroll
          for (int i = 0; i < 4; ++i) { const int id = tid + 512 * i, r = id >> 4, ch = id & 15; *(LAS v4u*)(lds + S2_B + r * BST + ch * 16) = tb[i]; }
#pragma unroll
          for (int i = 0; i < 8; ++i) { const int id = tid + 512 * i, r = id >> 5, ch = id & 31; *(LAS v4u*)(lds + S2_X + r * XST + ch * 16) = tx[i]; } }
        const float a = -__expf(p.a_log[l * 32 + dir * 16 + h]);
        const float d0 = DT[(size_t)(row0 + lane) * 32 + dir * 16 + h], d1 = DT[(size_t)(row0 + 64 + lane) * 32 + dir * 16 + h];
        float P0 = a * d0, P1 = a * d1; scan128(P0, P1, lane);
        const float tot = lane63(P1);
        LAS float* wL = (LAS float*)(lds + S2_W) + wid * 128;
        wL[lane] = (dir == 0 ? __expf(tot - P0) : __expf(P0 - a * d0)) * d0;
        wL[64 + lane] = (dir == 0 ? __expf(tot - P1) : __expf(P1 - a * d1)) * d1;
        if (lane == 0) DEC[((b * NCH + c) * 2 + dir) * 16 + h] = __expf(tot);
        __syncthreads();
        f32x16 acc[2][4];
#pragma unroll
        for (int i = 0; i < 2; ++i)
#pragma unroll
            for (int j = 0; j < 4; ++j) acc[i][j] = f32x16{};
        const unsigned bB = (unsigned)(uintptr_t)(lds + S2_B), bX = (unsigned)(uintptr_t)(lds + S2_X);
#pragma unroll 1
        for (int ks = 0; ks < 8; ++ks) {
            const f32x4 w0 = *(const LAS f32x4*)(wL + 16 * ks + 8 * hl), w1 = *(const LAS f32x4*)(wL + 16 * ks + 8 * hl + 4);
            bf16x8 xa[2], bb[4];
            { Raw rx0 = raw_tr_nat(bX, XST, 16 * ks, (wid & 3) * 64, lane), rx1 = raw_tr_nat(bX, XST, 16 * ks, (wid & 3) * 64 + 32, lane);
              Raw rb0 = raw_tr_nat(bB, BST, 16 * ks, 0, lane), rb1 = raw_tr_nat(bB, BST, 16 * ks, 32, lane), rb2 = raw_tr_nat(bB, BST, 16 * ks, 64, lane), rb3 = raw_tr_nat(bB, BST, 16 * ks, 96, lane);
              raw_wait6(rx0, rx1, rb0, rb1, rb2, rb3);
              xa[0] = join8(rx0); xa[1] = join8(rx1); bb[0] = join8(rb0); bb[1] = join8(rb1); bb[2] = join8(rb2); bb[3] = join8(rb3); }
#pragma unroll
            for (int pt = 0; pt < 2; ++pt) {
                v4u q = *reinterpret_cast<v4u*>(&xa[pt]);
                q.x = cvtpk(bflo(q.x) * w0[0], bfhi(q.x) * w0[1]); q.y = cvtpk(bflo(q.y) * w0[2], bfhi(q.y) * w0[3]);
                q.z = cvtpk(bflo(q.z) * w1[0], bfhi(q.z) * w1[1]); q.w = cvtpk(bflo(q.w) * w1[2], bfhi(q.w) * w1[3]);
                xa[pt] = *reinterpret_cast<bf16x8*>(&q); }
#pragma unroll
            for (int pt = 0; pt < 2; ++pt)
#pragma unroll
                for (int nt = 0; nt < 4; ++nt) acc[pt][nt] = __builtin_amdgcn_mfma_f32_32x32x16_bf16(xa[pt], bb[nt], acc[pt][nt], 0, 0, 0);
        }
        bf16* so = ST + ((size_t)((b * NCH + c) * 2 + dir) * 16 + h) * 8192;
#pragma unroll
        for (int pt = 0; pt < 2; ++pt)
#pragma unroll
            for (int nt = 0; nt < 4; ++nt)
#pragma unroll
                for (int r = 0; r < 16; r += 2) {
                    const float x0 = acc[pt][nt][r], x1 = acc[pt][nt][r + 1];
                    const float send = (lane & 1) ? x0 : x1, got = __shfl_xor(send, 1);
                    const unsigned w = (lane & 1) ? pk2(got, x1) : pk2(x0, got);
                    *(unsigned*)(so + (size_t)(pt * 32 + crow(r, hl) + (lane & 1)) * 128 + nt * 32 + ((lane & 31) & ~1)) = w; }
        __syncthreads();
    }
}

__device__ __forceinline__ void phase_scan(const Prm& p, int gtid, int ngt) {
    const bf16* ST = (const bf16*)(p.ws + WS_ST); bf16* HS = (bf16*)(p.ws + WS_HS); const float* DEC = (const float*)(p.ws + WS_DEC);
    for (int e = gtid; e < 2 * 2 * 16 * 2048; e += ngt) {
        const int q = e & 2047, h = (e >> 11) & 15, dir = (e >> 15) & 1, b = e >> 16;
        f32x4 hs = {0.f, 0.f, 0.f, 0.f};
#pragma unroll 6
        for (int i = 0; i < NCH; ++i) {
            const int c = dir == 0 ? i : (i < 2 ? 1 - i : NCH + 1 - i);
            const size_t off = ((size_t)((b * NCH + c) * 2 + dir) * 16 + h) * 8192 + q * 4;
            const v2u sv = *(const v2u*)(ST + off); const float dc = DEC[((b * NCH + c) * 2 + dir) * 16 + h];
            v2u o; o.x = pk2(hs[0], hs[1]); o.y = pk2(hs[2], hs[3]); *(v2u*)(HS + off) = o;
            hs[0] = dc * hs[0] + bflo(sv.x); hs[1] = dc * hs[1] + bfhi(sv.x); hs[2] = dc * hs[2] + bflo(sv.y); hs[3] = dc * hs[3] + bfhi(sv.y);
        }
    }
}

constexpr int CST = 272, XSS = 80;
constexpr size_t WS_Y = WS_XG;
constexpr int S4_B = 0, S4_C = 128 * CST, S4_X = 2 * 128 * CST, S4_ARR = 3 * 128 * CST, S4_YX = S4_ARR + 8 * 2 * 128 * 4, S4_END = S4_YX + 4 * 16 * 64 * 4;
static_assert(S4_END <= RING_BYTES && S2_END <= RING_BYTES && 8 * 32 * XSS <= 128 * CST, "ssd LDS");
__device__ __forceinline__ void phase_ssd_out(const Prm& p, int l, LAS unsigned char* lds, int wg, int nwg, int tid) {
    const bf16* XA = (const bf16*)(p.ws + WS_XBC); const float* DT = (const float*)(p.ws + WS_DT); const bf16* HS = (const bf16*)(p.ws + WS_HS);
    bf16* Y = (bf16*)(p.ws + WS_Y);
    const int wid = __builtin_amdgcn_readfirstlane(tid >> 6), lane = tid & 63, hl = lane >> 5, l31 = lane & 31, pt = (wid >> 1) & 1, dir = wid >> 2;
    const int c_lo = (l == 0) ? 0 : 2, ncu = NCH - c_lo;
    for (int it = wg; it < 2 * ncu * 8; it += nwg) {
        const int b = it / (ncu * 8), rem = it % (ncu * 8), c = c_lo + (rem >> 3), g = (rem >> 2) & 1, hp = rem & 3, h = 8 * g + 2 * hp + (wid & 1);
        const int row0 = chunk_row0(b, c);
        { v4u tb[4], tc[4];
#pragma unroll
          for (int i = 0; i < 4; ++i) { const int id = tid + 512 * i, r = id >> 4, ch = id & 15; const bf16* src = XA + (size_t)(row0 + r) * XBCW + g * 128 + ch * 8; tb[i] = *(const v4u*)(src + 1024); tc[i] = *(const v4u*)(src + 1280); }
#pragma unroll
          for (int i = 0; i < 4; ++i) { const int id = tid + 512 * i, r = id >> 4, ch = id & 15; *(LAS v4u*)(lds + S4_B + r * CST + ch * 16) = tb[i]; *(LAS v4u*)(lds + S4_C + r * CST + ch * 16) = tc[i]; } }
        v4u tx[4];
#pragma unroll
        for (int i = 0; i < 4; ++i) { const int id = tid + 512 * i, r = id >> 4, ch = id & 15; tx[i] = *(const v4u*)(XA + (size_t)(row0 + r) * XBCW + (8 * g + 2 * hp) * 64 + ch * 8); }
        bf16x8 hs[8];
        { const bf16* hp_ = HS + ((size_t)((b * NCH + c) * 2 + dir) * 16 + h) * 8192 + (size_t)(pt * 32 + l31) * 128 + 8 * hl;
#pragma unroll
          for (int ks = 0; ks < 8; ++ks) hs[ks] = *(const bf16x8*)(hp_ + 16 * ks); }
        LAS float* QL = (LAS float*)(lds + S4_ARR) + wid * 256; LAS float* DL = QL + 128;
        float ebase;
        { const float a = -__expf(p.a_log[l * 32 + dir * 16 + h]);
          const float d0 = DT[(size_t)(row0 + lane) * 32 + dir * 16 + h], d1 = DT[(size_t)(row0 + 64 + lane) * 32 + dir * 16 + h];
          float q0 = a * d0, q1 = a * d1; scan128(q0, q1, lane); const float tot = lane63(q1);
          QL[lane] = dir == 0 ? q0 : a * d0 - q0; QL[64 + lane] = dir == 0 ? q1 : a * d1 - q1; DL[lane] = d0; DL[64 + lane] = d1; ebase = dir == 0 ? 0.f : tot; }
        __syncthreads();
#pragma unroll
        for (int j = 0; j < 2; ++j) { const int id = wid * 2 + j, st = id >> 2, tt = id & 3; f32x16 X = f32x16{};
#pragma unroll
            for (int ks = 0; ks < 8; ++ks) { const bf16x8 bfr = *(const LAS bf16x8*)(lds + S4_B + (st * 32 + l31) * CST + (16 * ks + 8 * hl) * 2), cfr = *(const LAS bf16x8*)(lds + S4_C + (tt * 32 + l31) * CST + (16 * ks + 8 * hl) * 2);
                X = __builtin_amdgcn_mfma_f32_32x32x16_bf16(bfr, cfr, X, 0, 0, 0); }
#pragma unroll
            for (int i = 0; i < 4; ++i) { v2u w; w.x = pk2(X[4 * i], X[4 * i + 1]); w.y = pk2(X[4 * i + 2], X[4 * i + 3]);
                *(LAS v2u*)(lds + S4_X + (tt * 32 + l31) * CST + (st * 32 + 8 * i + 4 * hl) * 2) = w; } }
        __syncthreads();
        bf16x8 xf[8];
        {
#pragma unroll
          for (int i = 0; i < 4; ++i) { const int id = tid + 512 * i, r = id >> 4, ch = id & 15; *(LAS v4u*)(lds + S4_B + r * CST + ch * 16) = tx[i]; }
          __syncthreads();
          const unsigned bXs = (unsigned)(uintptr_t)(lds + S4_B); const int c0 = (wid & 1) * 64 + pt * 32;
#pragma unroll
          for (int q = 0; q < 4; ++q) { Raw r0 = raw_tr_acc(bXs, CST, 32 * q, c0, lane), r1 = raw_tr_acc(bXs, CST, 32 * q + 16, c0, lane); raw_wait2(r0, r1); xf[2 * q] = join8(r0); xf[2 * q + 1] = join8(r1); }
        }
        const float dsum = p.d_skip[l * 32 + h] + p.d_skip[l * 32 + 16 + h];
        LAS float* YX = (LAS float*)(lds + S4_YX) + (wid & 3) * 1024;
#pragma unroll 1
        for (int tt = 0; tt < 4; ++tt) {
            const int tl = tt * 32 + l31;
            const float Qt = QL[tl];
            f32x16 yacc = f32x16{};
#pragma unroll
            for (int st = 0; st < 4; ++st) {
                if (dir == 0 ? (st > tt) : (st < tt)) continue;
                __builtin_amdgcn_sched_barrier(0);
                float mv[16];
#pragma unroll
                for (int i = 0; i < 4; ++i) { const v2u w = *(const LAS v2u*)(lds + S4_X + tl * CST + (st * 32 + 8 * i + 4 * hl) * 2);
                    const f32x4 qv = *(const LAS f32x4*)(QL + st * 32 + 8 * i + 4 * hl), dv = *(const LAS f32x4*)(DL + st * 32 + 8 * i + 4 * hl);
                    const float xv[4] = {bflo(w.x), bfhi(w.x), bflo(w.y), bfhi(w.y)};
#pragma unroll
                    for (int j = 0; j < 4; ++j) { const int s = st * 32 + 8 * i + 4 * hl + j; const bool ok = dir == 0 ? (s <= tl) : (s >= tl);
                        mv[4 * i + j] = ok ? __expf(Qt - qv[j]) * dv[j] * xv[j] : 0.f; } }
#pragma unroll
                for (int s2 = 0; s2 < 2; ++s2) { v4u q; q.x = cvtpk(mv[8 * s2 + 0], mv[8 * s2 + 1]); q.y = cvtpk(mv[8 * s2 + 2], mv[8 * s2 + 3]); q.z = cvtpk(mv[8 * s2 + 4], mv[8 * s2 + 5]); q.w = cvtpk(mv[8 * s2 + 6], mv[8 * s2 + 7]);
                    yacc = __builtin_amdgcn_mfma_f32_32x32x16_bf16(xf[2 * st + s2], *reinterpret_cast<bf16x8*>(&q), yacc, 0, 0, 0); }
            }
            __builtin_amdgcn_sched_barrier(0);
            { const LAS unsigned char* cfp = lds + S4_C + tl * CST + 16 * hl; f32x16 G = f32x16{};
#pragma unroll
              for (int ks = 0; ks < 8; ++ks) G = __builtin_amdgcn_mfma_f32_32x32x16_bf16(hs[ks], *(const LAS bf16x8*)(cfp + 32 * ks), G, 0, 0, 0);
              const float e = __expf(ebase + Qt);
#pragma unroll
              for (int r = 0; r < 16; ++r) yacc[r] += e * G[r]; }
            if (dir == 1) {
#pragma unroll
                for (int r = 0; r < 16; ++r) YX[r * 64 + lane] = yacc[r]; }
            __syncthreads();
            if (dir == 0) {
                const size_t trow = (size_t)(row0 + tl);
#pragma unroll
                for (int i = 0; i < 4; ++i) { const int pc = h * 64 + pt * 32 + 8 * i + 4 * hl; const v2u xw = *(const v2u*)(XA + trow * XBCW + pc);
                    f32x4 o; o[0] = yacc[4 * i] + YX[(4 * i) * 64 + lane] + dsum * bflo(xw.x); o[1] = yacc[4 * i + 1] + YX[(4 * i + 1) * 64 + lane] + dsum * bfhi(xw.x);
                    o[2] = yacc[4 * i + 2] + YX[(4 * i + 2) * 64 + lane] + dsum * bflo(xw.y); o[3] = yacc[4 * i + 3] + YX[(4 * i + 3) * 64 + lane] + dsum * bfhi(xw.y);
                    v2u w; w.x = pk2(o[0], o[1]); w.y = pk2(o[2], o[3]); *(v2u*)(Y + trow * 1024 + pc) = w; } }
            __syncthreads();
        }
    }
}
}
__device__ __forceinline__ void phase_norm2_router(const Prm& p, int l, LAS unsigned char* lds, int wg, int nwg, int tid, int wave, int lane) {
    bf16* H = (bf16*)(p.ws + WS_H); const bf16* WR = (const bf16*)(p.ws + WS_WRT);
    const int ntok = (l == 0) ? T_ALL : T_LAT;
    constexpr int HROW = 4096 + 16;
    LAS unsigned char* hfL = lds; LAS float* part = (LAS float*)(lds + 66048); LAS float* affL = (LAS float*)(lds + 66048 + 16384);
    int* tok_e = (int*)(p.ws + WS_TOK); int* tok_pos = (int*)(p.ws + WS_TOK + TOKTAB); float* tok_gate = (float*)(p.ws + WS_TOK + 2 * TOKTAB);
    unsigned* cnt = (unsigned*)(p.ws + OFF_CNT) + l * 32 * 16;
    for (int it = wg; it < ntok / 16; it += nwg) {
        const int m0 = it * 16;
#pragma unroll
        for (int rr = 0; rr < 2; ++rr) {
            const int r = wave * 2 + rr, m = m0 + r;
            f32x4 v[8]; load_row(p, 1, -1, m, lane, v);
            const float rstd = row_rstd(v);
            const int vs = m >= T_LAT ? 2 : (m >> 13);
            const float* md = (const float*)(p.ws + OFF_MOD) + (size_t)(l * 3 + vs) * MODW;
#pragma unroll
            for (int j = 0; j < 8; ++j) { const int col = 256 * j + 4 * lane; const f32x4 o = modulate4f(v[j], rstd, p.norm_ffn + l * DM, md + 4 * DM, md + 3 * DM, col);
                v2u w; w.x = pk2(o[0], o[1]); w.y = pk2(o[2], o[3]);
                *(unsigned*)((unsigned char*)H + (size_t)m * DM + col) = pack4f8(o[0], o[1], o[2], o[3]);
                *(LAS v2u*)(hfL + r * HROW + col * 2) = w; }
        }
        __syncthreads();
        {
            f32x4 a0 = {0.f, 0.f, 0.f, 0.f}, a1 = a0; const int fr = lane & 15, fq = lane >> 4;
#pragma unroll
            for (int ks = 0; ks < 8; ++ks) { const int k0 = wave * 256 + ks * 32 + 8 * fq;
                const bf16x8 af = *(const LAS bf16x8*)(hfL + fr * HROW + k0 * 2);
                const bf16x8 b0 = *(const bf16x8*)(WR + (size_t)fr * DM + k0), b1 = *(const bf16x8*)(WR + (size_t)(16 + fr) * DM + k0);
                a0 = __builtin_amdgcn_mfma_f32_16x16x32_bf16(af, b0, a0, 0, 0, 0); a1 = __builtin_amdgcn_mfma_f32_16x16x32_bf16(af, b1, a1, 0, 0, 0); }
#pragma unroll
            for (int i = 0; i < 4; ++i) { part[(wave * 16 + 4 * fq + i) * 32 + fr] = a0[i]; part[(wave * 16 + 4 * fq + i) * 32 + 16 + fr] = a1[i]; }
        }
        __syncthreads();
        { float s = 0.f;
#pragma unroll
          for (int w = 0; w < 8; ++w) s += part[w * 512 + tid];
          affL[tid] = sigmoid_f(s); }
        __syncthreads();
        if (tid < 16) {
            const LAS float* af = affL + tid * 32; const int m = m0 + tid;
            int bg = 0; float bs = -INFINITY;
#pragma unroll
            for (int g = 0; g < 4; ++g) { float t1 = -INFINITY, t2 = -INFINITY;
#pragma unroll
                for (int j = 0; j < 8; ++j) { const float s = af[8 * g + j] + p.router_bias[8 * g + j]; if (s > t1) { t2 = t1; t1 = s; } else if (s > t2) t2 = s; }
                const float gs = t1 + t2; if (gs > bs) { bs = gs; bg = g; } }
            float t1 = -INFINITY, t2 = -INFINITY; int i1 = 0, i2 = 0;
#pragma unroll
            for (int j = 0; j < 8; ++j) { const float s = af[8 * bg + j] + p.router_bias[8 * bg + j]; if (s > t1) { t2 = t1; i2 = i1; t1 = s; i1 = j; } else if (s > t2) { t2 = s; i2 = j; } }
            const int e0 = 8 * bg + i1, e1 = 8 * bg + i2; const float f0 = af[e0], f1 = af[e1], inv = 1.f / (f0 + f1);
            const unsigned p0 = atomicAdd(cnt + e0 * 16, 1u), p1 = atomicAdd(cnt + e1 * 16, 1u);
            int* list = (int*)(p.ws + WS_LIST); list[(size_t)e0 * LCAP + p0] = m; list[(size_t)e1 * LCAP + p1] = m;
            tok_e[2 * m] = e0; tok_e[2 * m + 1] = e1; tok_pos[2 * m] = (int)p0; tok_pos[2 * m + 1] = (int)p1; tok_gate[2 * m] = f0 * inv; tok_gate[2 * m + 1] = f1 * inv;
        }
        __syncthreads();
    }
}
__device__ __forceinline__ void build_seg_tables(const Prm& p, int l, LAS unsigned char* lds, int tid) {
    LAS int* seg = (LAS int*)(lds + L_SEG); LAS int* cntL = (LAS int*)(lds + L_CNT); LAS int* blke = (LAS int*)(lds + L_BLKE); LAS int* nblkp = (LAS int*)(lds + L_NBLK);
    LAS int* incl = (LAS int*)(lds + L_INCL);
    const unsigned* cnt = (const unsigned*)(p.ws + OFF_CNT) + l * 32 * 16;
    __syncthreads();
    LAS int* pbL = (LAS int*)(lds + L_PB);
    if (tid < 32) { const int c = (int)cnt[tid * 16]; cntL[tid] = c; pbL[tid] = (c + 255) >> 8; }
    __syncthreads();
    if (tid < 32) { int inc = 0;
#pragma unroll
        for (int k = 0; k < 32; ++k) inc += (k <= tid) ? pbL[k] : 0;
        seg[tid] = (inc - pbL[tid]) * 256; incl[tid] = inc; if (tid == 31) { seg[32] = inc * 256; *nblkp = inc; } }
    __syncthreads();
    if (tid < MAXBLK + 3) { int e = 0;
#pragma unroll
        for (int k = 0; k < 32; ++k) e += (incl[k] <= tid) ? 1 : 0;
        e = e < 31 ? e : 31; blke[tid] = e; ((LAS int*)(lds + L_BLKH))[tid] = (cntL[e] - 256 * (tid - (seg[e] >> 8)) <= 128) ? 1 : 0; }
    __syncthreads();
}
template <class Sched>
__device__ __forceinline__ void build_row_table(const Prm& p, const Sched& S, LAS unsigned char* lds, int tid) {
    const LAS int* seg = (const LAS int*)(lds + L_SEG); const LAS int* cntL = (const LAS int*)(lds + L_CNT); const LAS int* blke = (const LAS int*)(lds + L_BLKE);
    LAS unsigned* T = (LAS unsigned*)(lds + L_ROWT); const int* list = (const int*)(p.ws + WS_LIST);
#pragma unroll 1
    for (int i = 0; i < 8; ++i) { pg8::Unit u; if (!S.next(i, u)) break;
        const int e = blke[u.pm], base = (u.pm - (seg[e] >> 8)) * 256;
        if (tid < 256) { const int pos = base + tid; T[i * 256 + tid] = pos < cntL[e] ? (unsigned)WS_H + (unsigned)list[(size_t)e * LCAP + pos] * 2048u : ZERO_OFF; } }
    __syncthreads();
}
#ifndef SKIP_GU
#define SKIP_GU true
#endif
#ifndef SKIP_DN
#define SKIP_DN true
#endif
#ifndef NCONV
#define NCONV 16
#endif
constexpr int N_PHASES = 24;
__global__ void __launch_bounds__(NWAVES * 64, 2) mk_fwd(Prm p) {
    extern __shared__ __attribute__((aligned(16))) unsigned char lds_raw[];
    LAS unsigned char* lds = (LAS unsigned char*)lds_raw;
    const int tid0 = threadIdx.x, wave = __builtin_amdgcn_readfirstlane(tid0 >> 6);
#define OPQ int tid = tid0; asm volatile("" : "+v"(tid)); const int lane = tid & 63;
    const int G = gridDim.x, bx = blockIdx.x, vcu = (G % 8 == 0) ? (bx % 8) * (G / 8) + bx / 8 : bx;
    const int gw = vcu * NWAVES + wave, ngw = G * NWAVES;
    unsigned char* ws = p.ws;
    for (int u = tid0; u < (LDS_BYTES - LDSCTL_OFF) / 4; u += NWAVES * 64) ((LAS unsigned*)(lds + LDSCTL_OFF))[u] = 0u;
    __syncthreads();
#if MK_ONE_LAUNCH
    XcdBarrier bar = xcd_barrier_post((unsigned*)ws + CW_BAR, (volatile LAS unsigned*)(lds + L_BARW));
#define GRID_BAR() xcd_barrier(bar)
#define GRID_BAR_W() do { if (CONV_QUEUE) xcd_barrier_work(bar, p, lds, tid0); else xcd_barrier(bar); } while (0)
#else
#define GRID_BAR() do {} while (0)
#define GRID_BAR_W() do {} while (0)
#endif
#define WORKERS(units) ((CONV_QUEUE && MK_ONE_LAUNCH) ? (((units) + (((units) + G - 1) / G) - 1) / (((units) + G - 1) / G)) : G)
    const int lo = p.ph_lo, hi = p.ph_hi;
#define IN(k) (lo <= (k) && (k) < hi)
#ifndef DUPMASK
#define DUPMASK 0
#endif
#define REPS(kind) for (int rep_ = 0; rep_ < (((DUPMASK) >> (kind)) & 1) + 1; ++rep_)
    if (IN(0)) REPS(0) { OPQ phase_prologue(p, lds, gw, ngw, wave, lane, rep_ == 0); GRID_BAR(); }
    for (int l = 0; l < 2; ++l) {
        const int pb = 1 + 11 * l;
        if (IN(pb + 0)) { OPQ if (l > 0) { if (CONV_QUEUE) queue_drain(p, lds, tid, (unsigned)NP_PROJ);     build_seg_tables(p, l - 1, lds, tid); row_stream<true, false, false>(p, l, l - 1, T_ALL, gw, ngw, tid, lane, lds, (const LAS int*)(lds + L_SEG)); } else row_stream<false, false, true>(p, l, 0, T_ALL, gw, ngw, tid, lane, lds, (const LAS int*)(lds + L_SEG)); GRID_BAR_W(); }
        if (IN(pb + 1)) REPS(2) {
            pg8::Gemm g{(const pg8::bf16_t*)(ws + WS_H), (const pg8::bf16_t*)(ws + WS_WIN + (size_t)l * NINP * DM * (F8_INPROJ ? 1 : 2)), T_ALL, NINP, F8_INPROJ ? DM / 2 : DM};
            const int Ge = WORKERS((T_ALL / 256) * (NINP / 256));
            pg8::StaticOrder S; S.init(T_ALL, NINP, Ge, bx);
            pg8::EpiInProj E{(pg8::bf16_t*)(ws + WS_U), NINP, (const float*)(ws + WS_ROPE), C_QB / 256, C_VB / 256, T_LAT, F8_INPROJ ? 1.f / W8_SCALE : 1.f};
            if (bx < Ge) pg8::gemm_phase<pg8::EpiInProj, pg8::StaticOrder, true, true, F8_INPROJ != 0>(lds, g, S, E);
            GRID_BAR_W();
        }
        if (IN(pb + 2)) REPS(3) { OPQ
            if ((bx >> 3) & 1) { att::phase_attn(p, l, lds, bx, G, tid); phase_conv(p, l, gw, ngw, lane); } else { phase_conv(p, l, gw, ngw, lane); att::phase_attn(p, l, lds, bx, G, tid); } GRID_BAR_W(); }
        if (IN(pb + 3)) REPS(4) { OPQ { const int Ge = WORKERS(2 * ssd::NCH * 4); if (bx < Ge) ssd::phase_states(p, l, lds, bx, Ge, tid); } GRID_BAR_W(); }
        if (IN(pb + 4)) REPS(5) { OPQ ssd::phase_scan(p, bx * (NWAVES * 64) + tid, G * NWAVES * 64); GRID_BAR_W(); }
        if (IN(pb + 5)) REPS(6) { OPQ { const int Ge = WORKERS(2 * (ssd::NCH - (l == 0 ? 0 : 2)) * 8); if (bx < Ge) ssd::phase_ssd_out(p, l, lds, bx, Ge, tid); } GRID_BAR_W(); }
        if (IN(pb + 6)) REPS(7) { OPQ phase_gnorm(p, l, gw, ngw, lane); GRID_BAR_W(); }
        if (IN(pb + 7)) {
            const int M = (l == 0) ? T_ALL : T_LAT;
            pg8::Gemm g{(const pg8::bf16_t*)(ws + WS_H), (const pg8::bf16_t*)(ws + WS_WOUT + (size_t)l * DM * DM * (F8_OUTPROJ ? 1 : 2)), M, DM, F8_OUTPROJ ? DM / 2 : DM};
            const int Ge = WORKERS((M / 256) * (DM / 256));
            pg8::StaticOrder S; S.init(M, DM, Ge, bx);
            pg8::EpiRes E{(l == 0) ? (const void*)p.x : (const void*)(ws + WS_X), (pg8::bf16_t*)(ws + WS_X), (l == 0) ? (const void*)p.ctx : (const void*)(ws + WS_XC), (pg8::bf16_t*)(ws + WS_XC),
                          (const float*)(ws + OFF_MOD) + (size_t)l * 3 * MODW + 2 * DM, DM, T_LAT, MODW, F8_OUTPROJ ? 1.f / (W8_SCALE * MIX_SCALE) : 1.f, l == 0 ? 1 : 0};
            if (bx < Ge) pg8::gemm_phase<pg8::EpiRes, pg8::StaticOrder, true, true, F8_OUTPROJ != 0>(lds, g, S, E);
            GRID_BAR_W();
        }
        if (IN(pb + 8)) { OPQ phase_norm2_router(p, l, lds, bx, G, tid, wave, lane); GRID_BAR_W(); }
        if (IN(pb + 9) && CONV_QUEUE && l == 1) { OPQ queue_drain(p, lds, tid, (unsigned)Q_TOTAL); GRID_BAR(); }
        if (IN(pb + 9)) REPS(11) {
            OPQ build_seg_tables(p, l, lds, tid);
            const int nblk = __builtin_amdgcn_readfirstlane(*(const LAS int*)(lds + L_NBLK));
            pg8::Gemm g{(const pg8::bf16_t*)ws, (const pg8::bf16_t*)(ws + WS_WGU + (size_t)l * 32 * 2048 * 2048), nblk * 256, 2048, DM / 2};
            pg8::GroupedOrderT<SKIP_GU, true> S{G, vcu, nblk, (const LAS int*)(lds + L_BLKE), (const LAS int*)(lds + L_BLKH), (long)2048 * 2048, (const LAS unsigned*)(lds + L_ROWT)};
            build_row_table(p, S, lds, tid);
            pg8::EpiGateUp E{ws + WS_ACT, DFF, 1.f / W8_SCALE};
            pg8::gemm_phase<pg8::EpiGateUp, pg8::GroupedOrderT<SKIP_GU, true>, true, true, true>(lds, g, S, E);
            GRID_BAR_W();
        }
        if (IN(pb + 10)) REPS(12) {
            OPQ build_seg_tables(p, l, lds, tid);
            const int nblk = __builtin_amdgcn_readfirstlane(*(const LAS int*)(lds + L_NBLK));
            pg8::Gemm g{(const pg8::bf16_t*)(ws + WS_ACT), (const pg8::bf16_t*)(ws + WS_WDN + (size_t)l * 32 * 2048 * 1024), nblk * 256, DM, DFF / 2};
            pg8::GroupedOrderT<SKIP_DN> S{G, vcu, nblk, (const LAS int*)(lds + L_BLKE), (const LAS int*)(lds + L_BLKH), (long)2048 * 1024, nullptr};
            pg8::EpiF8 E{ws + WS_YB, DM, Y8_SCALE / W8_SCALE};
            pg8::gemm_phase<pg8::EpiF8, pg8::GroupedOrderT<SKIP_DN>, true, true, true>(lds, g, S, E);
            GRID_BAR_W();
        }
    }
    if (IN(23)) { OPQ build_seg_tables(p, 1, lds, tid); row_stream<true, true, false>(p, 1, 1, T_LAT, gw, ngw, tid, lane, lds, (const LAS int*)(lds + L_SEG)); }
#undef IN
}

extern "C" void kernel_launch(void* const* d_in, const int* in_sizes, int n_in, void* d_out, int out_size, void* d_ws, size_t ws_size, hipStream_t stream) {
    static int grid = 0;
    if (grid == 0) {
        if (n_in != 24 || in_sizes[0] != T_LAT * DM || out_size != T_LAT * DM || ws_size < WS_END) {
            fprintf(stderr, "kernel_launch: unexpected shapes: n_in %d in0 %d out %d ws %zu (need %zu)\n", n_in, n_in > 0 ? in_sizes[0] : -1, out_size, ws_size, (size_t)WS_END); grid = -1; return; }
        int dev = 0, cus = 0, per_cu = 0;
        if (hipGetDevice(&dev) != hipSuccess || hipDeviceGetAttribute(&cus, hipDeviceAttributeMultiprocessorCount, dev) != hipSuccess) { grid = -1; return; }
        if (hipFuncSetAttribute((const void*)mk_fwd, hipFuncAttributeMaxDynamicSharedMemorySize, LDS_BYTES) != hipSuccess) { fprintf(stderr, "kernel_launch: hipFuncSetAttribute failed\n"); grid = -1; return; }
        if (hipOccupancyMaxActiveBlocksPerMultiprocessor(&per_cu, (const void*)mk_fwd, NWAVES * 64, LDS_BYTES) != hipSuccess || per_cu < 1) {
            fprintf(stderr, "kernel_launch: occupancy query reports %d blocks per CU\n", per_cu); }
        (void)hipGetLastError();
        grid = cus;
    }
    if (grid < 0) return;
    if (hipMemsetAsync((char*)d_ws + WS_CTL, 0, CTL_ZERO_BYTES, stream) != hipSuccess) { fprintf(stderr, "kernel_launch: memset failed\n"); return; }
    Prm p{};
    p.x = (const float*)d_in[0]; p.c = (const float*)d_in[1]; p.ctx = (const float*)d_in[2]; p.c_ctx = (const float*)d_in[3]; p.w_ada = (const float*)d_in[4]; p.b_ada = (const float*)d_in[5];
    p.norm_mix = (const float*)d_in[6]; p.norm_ffn = (const float*)d_in[7]; p.norm_final = (const float*)d_in[8]; p.w_in = (const float*)d_in[9]; p.w_out = (const float*)d_in[10];
    p.na_rpb = (const float*)d_in[11]; p.wa_sink = (const float*)d_in[12]; p.conv_w = (const float*)d_in[13]; p.conv_b = (const float*)d_in[14]; p.a_log = (const float*)d_in[15];
    p.dt_bias = (const float*)d_in[16]; p.d_skip = (const float*)d_in[17]; p.ssd_norm = (const float*)d_in[18]; p.w_router = (const float*)d_in[19]; p.router_bias = (const float*)d_in[20];
    p.w_gate = (const float*)d_in[21]; p.w_up = (const float*)d_in[22]; p.w_down = (const float*)d_in[23];
    p.out = (float*)d_out; p.ws = (unsigned char*)d_ws;
#if MK_ONE_LAUNCH
    p.ph_lo = 0; p.ph_hi = N_PHASES;
    hipLaunchKernelGGL(mk_fwd, dim3(grid), dim3(NWAVES * 64), LDS_BYTES, stream, p);
#else
    for (int ph = 0; ph < N_PHASES; ++ph) { p.ph_lo = ph; p.ph_hi = ph + 1; hipLaunchKernelGGL(mk_fwd, dim3(grid), dim3(NWAVES * 64), LDS_BYTES, stream, p); }
#endif
    const hipError_t le = hipPeekAtLastError();
    if (le != hipSuccess) fprintf(stderr, "kernel_launch: launch failed: %s\n", hipGetErrorName(le));
}
```

```cpp
#include <hip/hip_runtime.h>
#include <cstdio>
#include <cstdint>

#ifndef MK_ONE_LAUNCH
#define MK_ONE_LAUNCH 1
#endif

#ifndef F8_INPROJ
#define F8_INPROJ 1
#endif
#ifndef F8_OUTPROJ
#define F8_OUTPROJ 1
#endif

namespace pg8 {
#define PG8_LAS __attribute__((address_space(3)))
typedef unsigned short bf16_t;
typedef short bf16x8 __attribute__((ext_vector_type(8)));
typedef float f32x4 __attribute__((ext_vector_type(4)));
typedef unsigned u32x4 __attribute__((ext_vector_type(4)));
constexpr int BM = 256, BK = 64, HALF = 128, HTB = HALF * BK * 2  , STAGE_BYTES = 8 * HTB, NXCD = 8, WGM = 8;

__host__ __device__ __forceinline__ int lds_byte(int r, int c) { const int st = (r >> 4) * 2 + (c >> 5), rr = r & 15, cc = c & 31, ob = rr * 64 + cc * 2; return st * 1024 + (ob ^ (((ob >> 9) & 1) << 5)); }
__host__ __device__ __forceinline__ void stage_rc(int b, int& R, int& C) { const int st = b / 1024, sb = b % 1024, swz = sb ^ (((sb >> 9) & 1) << 5); R = (st >> 1) * 16 + swz / 64; C = (st & 1) * 32 + (swz % 64) / 2; }
__host__ __device__ __forceinline__ int perm32(int rho) { const int n = rho >> 4, i = rho & 15; return 8 * (i >> 2) + 4 * n + (i & 3); }

typedef int i32x4v __attribute__((ext_vector_type(4)));
typedef int i32x8v __attribute__((ext_vector_type(8)));
__device__ __forceinline__ i32x8v cat8(bf16x8 a, bf16x8 b) { const i32x4v x = __builtin_bit_cast(i32x4v, a), y = __builtin_bit_cast(i32x4v, b); return __builtin_shufflevector(x, y, 0, 1, 2, 3, 4, 5, 6, 7); }
struct Unit { int pm, pn; long boff; int lo_only; };
struct Gemm { const bf16_t* A; const bf16_t* Bt; int M, N, K; };

struct StaticOrder {
    static constexpr bool SKIP_HI = false, GATHER = false; const PG8_LAS unsigned* rowtab;
    int nM, nN, nwg, G, c;
    __host__ __device__ void init(int M, int N, int G_, int c_) { nM = M / BM; nN = N / BM; nwg = nM * nN; G = G_; c = c_; }
    __host__ __device__ bool next(int i, Unit& u) const {
        const long L = (long)i * G + c; if (L >= nwg) return false;
        int wgid = (int)L; { const int q = nwg / NXCD, r = nwg % NXCD, xcd = wgid % NXCD, off = wgid / NXCD; wgid = (xcd < r ? xcd * (q + 1) : r * (q + 1) + (xcd - r) * q) + off; }
        const int nig = WGM * nN, gid = wgid / nig, fm = gid * WGM, gsz = (nM - fm) < WGM ? (nM - fm) : WGM;
        u.pm = fm + ((wgid % nig) % gsz); u.pn = (wgid % nig) / gsz; u.boff = 0; u.lo_only = 0; return true;
    }
    __device__ __forceinline__ void a_ready(const Unit&) const {}
    __device__ __forceinline__ void done(const Unit&) const {}
};

__device__ __forceinline__ unsigned cvt_pk_bf16(float lo, float hi) { unsigned r; asm volatile("v_cvt_pk_bf16_f32 %0, %1, %2" : "=v"(r) : "v"(lo), "v"(hi)); return r; }
typedef float f32x2 __attribute__((ext_vector_type(2)));
__device__ __forceinline__ f32x2 gelu_pk(f32x2 v) {
    const f32x2 av = __builtin_elementwise_abs(v), d = av * 0.2316418882f + 1.0f;
    f32x2 t; t.x = __builtin_amdgcn_rcpf(d.x); t.y = __builtin_amdgcn_rcpf(d.y);
    f32x2 q = t * 0.5307027145f + (-0.7265760135f); q = q * t + 0.7107068705f; q = q * t + (-0.142248368f); q = q * t + 0.127414796f; q = q * t;
    const f32x2 s = (v * v) * (-0.72134752044f);
    f32x2 e; e.x = __builtin_amdgcn_exp2f(s.x); e.y = __builtin_amdgcn_exp2f(s.y);
    const f32x2 m = v * (q * e), r = v - m;
    f32x2 o; o.x = v.x < 0.f ? m.x : r.x; o.y = v.y < 0.f ? m.y : r.y; return o;
}

template <class Epi, class Sched, bool ALIGN_EPI = false, bool SP2 = false, bool F8 = false>
__device__ __forceinline__ void gemm_phase(PG8_LAS unsigned char* lds, const Gemm g, const Sched& S, const Epi& E) {
    int tid_o = threadIdx.x; asm volatile("" : "+v"(tid_o));
    const int tid = tid_o, wid = __builtin_amdgcn_readfirstlane(tid >> 6), lane = tid & 63, wr = wid >> 2, wc = wid & 3, fr = lane & 15, fq = lane >> 4;
    const int K = g.K, nt = K / BK;
    unsigned voffA[2], voffB[2];
#pragma unroll
    for (int i = 0; i < 2; ++i) { int R, C; stage_rc(tid * 16 + i * 8192, R, C); const int Rb = Epi::PERM ? ((R & ~31) + perm32(R & 31)) : R;
        voffA[i] = (unsigned)(R * K + C) * 2u; voffB[i] = (unsigned)(Rb * K + C) * 2u; }
    int gR[2]; unsigned gC[2];
#pragma unroll
    for (int i = 0; i < 2; ++i) { int R, C; stage_rc(tid * 16 + i * 8192, R, C); gR[i] = R; gC[i] = (unsigned)C * 2u; }
    unsigned gc[2][2] = {{0u, 0u}, {0u, 0u}}, gn[2][2] = {{0u, 0u}, {0u, 0u}};
#define PG8_GROWS(dst, u) do { if constexpr (Sched::GATHER) { _Pragma("unroll") for (int h_ = 0; h_ < 2; ++h_) _Pragma("unroll") for (int i_ = 0; i_ < 2; ++i_) dst[h_][i_] = S.rowtab[(u) * 256 + h_ * 128 + gR[i_]] + gC[i_]; } } while (0)
#define PG8_STAGE_A(bufoff, kbase, h, nx) do { if constexpr (Sched::GATHER) { _Pragma("unroll") for (int _i = 0; _i < 2; ++_i) \
        __builtin_amdgcn_global_load_lds((const unsigned*)((const char*)(kbase) + ((nx) ? gn[h][_i] : gc[h][_i])), (PG8_LAS unsigned*)(lds + (bufoff) + ldsw + _i * 8192), 16, 0, 0); } \
        else PG8_STAGE(bufoff, (kbase) + ((h) ? hstep : 0), voffA); } while (0)
    const size_t kstep = (size_t)(BK * 2);
    const size_t hstep = (size_t)HALF * K * 2;
    const size_t tstep = 2 * hstep;
    const unsigned ldsw = (unsigned)wid * 1024u;
    const int aoff = lds_byte(wr * 64 + fr, fq * 8), boff = lds_byte(wc * 32 + fr, fq * 8);
    const int aoff8 = lds_byte(wr * 64 + fr, (fq & 1) * 16) + (fq >> 1) * 1024, boff8 = lds_byte(wc * 32 + fr, (fq & 1) * 16) + (fq >> 1) * 1024;
#define PG8_SA(b, h) (((b) * 2 + (h)) * HTB)
#define PG8_SB(b, h) ((4 + (b) * 2 + (h)) * HTB)
#define PG8_STAGE(bufoff, gbase, voff) do { _Pragma("unroll") for (int _i = 0; _i < 2; ++_i) \
        __builtin_amdgcn_global_load_lds((const unsigned*)((const char*)(gbase) + (voff)[_i]), (PG8_LAS unsigned*)(lds + (bufoff) + ldsw + _i * 8192), 16, 0, 0); } while (0)
#define PG8_LDA(dst, b, h) do { if constexpr (F8) { _Pragma("unroll") for (int m = 0; m < 4; ++m) dst##8[m] = cat8(*(const PG8_LAS bf16x8*)(lds + PG8_SA(b, h) + aoff8 + m * 2048), *(const PG8_LAS bf16x8*)(lds + PG8_SA(b, h) + aoff8 + m * 2048 + 16)); } else { \
        _Pragma("unroll") for (int m = 0; m < 4; ++m) _Pragma("unroll") for (int k = 0; k < 2; ++k) dst[m][k] = *(const PG8_LAS bf16x8*)(lds + PG8_SA(b, h) + aoff + m * 2048 + k * 1024); } } while (0)
#define PG8_LDB(dst, b, h) do { if constexpr (F8) { _Pragma("unroll") for (int n = 0; n < 2; ++n) dst##8[n] = cat8(*(const PG8_LAS bf16x8*)(lds + PG8_SB(b, h) + boff8 + n * 2048), *(const PG8_LAS bf16x8*)(lds + PG8_SB(b, h) + boff8 + n * 2048 + 16)); } else { \
        _Pragma("unroll") for (int n = 0; n < 2; ++n) _Pragma("unroll") for (int k = 0; k < 2; ++k) dst[n][k] = *(const PG8_LAS bf16x8*)(lds + PG8_SB(b, h) + boff + n * 2048 + k * 1024); } } while (0)
#define PG8_MMA(ai, bj, At, Bt) do { __builtin_amdgcn_s_setprio(1); if constexpr (F8) { _Pragma("unroll") for (int m = 0; m < 4; ++m) _Pragma("unroll") for (int n = 0; n < 2; ++n) \
        asm volatile("v_mfma_scale_f32_16x16x128_f8f6f4 %0, %1, %2, %0, %3, %3 op_sel_hi:[0,0,0]" : "+v"(acc[ai][bj][m][n]) : "v"(Bt##8[n]), "v"(At##8[m]), "v"(sc1)); } else { \
        _Pragma("unroll") for (int m = 0; m < 4; ++m) _Pragma("unroll") for (int n = 0; n < 2; ++n) _Pragma("unroll") for (int k = 0; k < 2; ++k) \
        acc[ai][bj][m][n] = __builtin_amdgcn_mfma_f32_16x16x32_bf16(Bt[n][k], At[m][k], acc[ai][bj][m][n], 0, 0, 0); } __builtin_amdgcn_s_setprio(0); } while (0)
#define PG8_WAIT_V(n) asm volatile("s_waitcnt vmcnt(" #n ")" ::: "memory")
#define PG8_WAIT_L(n) asm volatile("s_waitcnt lgkmcnt(" #n ")" ::: "memory")
#define PG8_BAR __builtin_amdgcn_s_barrier()
#define PG8_SCHED __builtin_amdgcn_sched_barrier(0)
    Unit cur, nxt; int ui = 0;
    if (!S.next(0, cur)) return;
    f32x4 acc[2][2][4][2];
#pragma unroll
    for (int a = 0; a < 2; ++a)
#pragma unroll
        for (int b = 0; b < 2; ++b)
#pragma unroll
            for (int m = 0; m < 4; ++m)
#pragma unroll
                for (int n = 0; n < 2; ++n) acc[a][b][m][n] = (f32x4){0.f, 0.f, 0.f, 0.f};
    const int sc1 = 0x7F7F7F7F;
    bf16x8 At[4][2], B0[2][2], B1[2][2]; i32x8v At8[4], B08[2], B18[2];
    const char* cA = (const char*)g.A + (Sched::GATHER ? (size_t)0 : (size_t)cur.pm * tstep); PG8_GROWS(gc, 0); const char* cB = (const char*)g.Bt + (size_t)cur.pn * tstep + cur.boff;
    S.a_ready(cur);
    if constexpr (SP2) {
        PG8_STAGE(PG8_SB(0, 0), cB, voffB); PG8_STAGE(PG8_SB(0, 1), cB + hstep, voffB); PG8_STAGE_A(PG8_SA(0, 0), cA, 0, false); PG8_STAGE_A(PG8_SA(0, 1), cA, 1, false);
        if (wr == 1) PG8_BAR;
        PG8_WAIT_V(2); PG8_BAR;
        PG8_STAGE(PG8_SB(1, 0), cB + kstep, voffB); PG8_STAGE_A(PG8_SA(1, 0), cA + kstep, 0, false); PG8_STAGE(PG8_SB(1, 1), cB + hstep + kstep, voffB);
        PG8_WAIT_V(6); PG8_BAR;
    } else {
        PG8_STAGE(PG8_SB(0, 0), cB, voffB); PG8_STAGE_A(PG8_SA(0, 0), cA, 0, false); PG8_STAGE(PG8_SB(0, 1), cB + hstep, voffB); PG8_STAGE_A(PG8_SA(0, 1), cA, 1, false);
        if (wr == 1) PG8_BAR;
        PG8_WAIT_V(4); PG8_BAR;
        PG8_STAGE(PG8_SB(1, 0), cB + kstep, voffB); PG8_STAGE_A(PG8_SA(1, 0), cA + kstep, 0, false); PG8_STAGE(PG8_SB(1, 1), cB + hstep + kstep, voffB);
        PG8_WAIT_V(6); PG8_BAR;
    }
    for (;;) {
        const bool has_next = S.next(ui + 1, nxt);
        const char* nA = has_next ? (const char*)g.A + (Sched::GATHER ? (size_t)0 : (size_t)nxt.pm * tstep) : cA; if (has_next) PG8_GROWS(gn, ui + 1); const char* nB = has_next ? (const char*)g.Bt + (size_t)nxt.pn * tstep + nxt.boff : cB;
        const bool hi_on = !Sched::SKIP_HI || cur.lo_only == 0;
#pragma unroll 1
        for (int t = 0; t < nt; t += 2) {
            const bool last = (t == nt - 2);
            const char* a1 = cA + (size_t)(t + 1) * kstep;
            const char* a2 = last ? nA : cA + (size_t)(t + 2) * kstep; const char* b2 = last ? nB : cB + (size_t)(t + 2) * kstep;
            const char* a3 = a2 + kstep; const char* b3 = b2 + kstep;
            const bool nx_ = last && has_next;
            if (last && has_next) S.a_ready(nxt);
            if constexpr (SP2) {
            PG8_LDB(B0, 0, 0); PG8_LDB(B1, 0, 1); PG8_SCHED; PG8_LDA(At, 0, 0); PG8_STAGE_A(PG8_SA(1, 1), a1, 1, false);
            PG8_WAIT_V(8); PG8_WAIT_L(0); PG8_BAR; PG8_MMA(0, 0, At, B0); PG8_MMA(0, 1, At, B1); PG8_BAR; PG8_SCHED;
            PG8_LDA(At, 0, 1); PG8_STAGE(PG8_SB(0, 0), b2, voffB); PG8_STAGE(PG8_SB(0, 1), b2 + hstep, voffB); PG8_STAGE_A(PG8_SA(0, 0), a2, 0, nx_);
            PG8_WAIT_V(8); PG8_WAIT_L(0); PG8_BAR; if (__builtin_expect(hi_on, 1)) { PG8_MMA(1, 0, At, B0); PG8_MMA(1, 1, At, B1); } PG8_BAR; PG8_SCHED;
            PG8_LDB(B0, 1, 0); PG8_LDB(B1, 1, 1); PG8_SCHED; PG8_LDA(At, 1, 0); PG8_STAGE_A(PG8_SA(0, 1), a2, 1, nx_);
            PG8_WAIT_V(8); PG8_WAIT_L(0); PG8_BAR; PG8_MMA(0, 0, At, B0); PG8_MMA(0, 1, At, B1); PG8_BAR; PG8_SCHED;
            PG8_LDA(At, 1, 1); PG8_STAGE(PG8_SB(1, 0), b3, voffB); PG8_STAGE(PG8_SB(1, 1), b3 + hstep, voffB); PG8_STAGE_A(PG8_SA(1, 0), a3, 0, nx_);
            PG8_WAIT_V(8); PG8_WAIT_L(0); PG8_BAR; if (__builtin_expect(hi_on, 1)) { PG8_MMA(1, 0, At, B0); PG8_MMA(1, 1, At, B1); } PG8_BAR; PG8_SCHED;
            } else {
            PG8_LDB(B0, 0, 0); PG8_SCHED; PG8_LDA(At, 0, 0); PG8_STAGE_A(PG8_SA(1, 1), a1, 1, false);
            PG8_WAIT_L(8); PG8_BAR; PG8_WAIT_L(0); PG8_MMA(0, 0, At, B0); PG8_BAR; PG8_SCHED;
            PG8_LDB(B1, 0, 1); PG8_STAGE(PG8_SB(0, 0), b2, voffB);
            PG8_BAR; PG8_WAIT_L(0); PG8_MMA(0, 1, At, B1); PG8_BAR;
            PG8_LDA(At, 0, 1); PG8_STAGE_A(PG8_SA(0, 0), a2, 0, nx_);
            PG8_BAR; PG8_WAIT_L(0); PG8_MMA(1, 0, At, B0); PG8_BAR; PG8_SCHED;
            PG8_STAGE(PG8_SB(0, 1), b2 + hstep, voffB);
            PG8_WAIT_V(6); PG8_BAR; PG8_MMA(1, 1, At, B1); PG8_BAR;
            PG8_LDB(B0, 1, 0); PG8_SCHED; PG8_LDA(At, 1, 0); PG8_STAGE_A(PG8_SA(0, 1), a2, 1, nx_);
            PG8_WAIT_L(8); PG8_BAR; PG8_WAIT_L(0); PG8_MMA(0, 0, At, B0); PG8_BAR; PG8_SCHED;
            PG8_LDB(B1, 1, 1); PG8_STAGE(PG8_SB(1, 0), b3, voffB);
            PG8_BAR; PG8_WAIT_L(0); PG8_MMA(0, 1, At, B1); PG8_BAR;
            PG8_LDA(At, 1, 1); PG8_STAGE_A(PG8_SA(1, 0), a3, 0, nx_);
            PG8_BAR; PG8_WAIT_L(0); PG8_MMA(1, 0, At, B0); PG8_BAR; PG8_SCHED;
            PG8_STAGE(PG8_SB(1, 1), b3 + hstep, voffB);
            PG8_WAIT_V(6); PG8_BAR; PG8_MMA(1, 1, At, B1); PG8_BAR;
            }
        }
        if constexpr (F8) asm volatile("s_nop 15\n\ts_nop 15" ::: "memory");
        if constexpr (ALIGN_EPI) { if (wr == 0) PG8_BAR; }
        if constexpr (!Epi::AFTER_DRAIN) { E(acc, cur, wr, wc, fr, fq); S.done(cur); }
        if (!has_next) break;
#pragma unroll
        for (int a = 0; a < 2; ++a)
#pragma unroll
            for (int b = 0; b < 2; ++b)
#pragma unroll
                for (int m = 0; m < 4; ++m)
#pragma unroll
                    for (int n = 0; n < 2; ++n) acc[a][b][m][n] = (f32x4){0.f, 0.f, 0.f, 0.f};
        cur = nxt; cA = nA; cB = nB; ++ui;
        if constexpr (Sched::GATHER) { gc[0][0] = gn[0][0]; gc[0][1] = gn[0][1]; gc[1][0] = gn[1][0]; gc[1][1] = gn[1][1]; }
        if constexpr (ALIGN_EPI) { if (wr == 1) PG8_BAR; }
    }
    PG8_WAIT_V(0);
    if constexpr (!ALIGN_EPI) { if (wr == 0) PG8_BAR; }
    PG8_BAR;
    if constexpr (Epi::AFTER_DRAIN) { E.fused(acc, cur, wr, wc, fr, fq, lds, wid, lane); S.done(cur); }
#undef PG8_SA
#undef PG8_SB
#undef PG8_STAGE
#undef PG8_STAGE_A
#undef PG8_GROWS
#undef PG8_LDA
#undef PG8_LDB
#undef PG8_MMA
#undef PG8_WAIT_V
#undef PG8_WAIT_L
#undef PG8_BAR
#undef PG8_SCHED
}
typedef unsigned u32x2e __attribute__((ext_vector_type(2)));
struct EpiPlain {
    static constexpr bool PERM = true, AFTER_DRAIN = false;
    bf16_t* O; int ldc; float scale;
    __device__ __forceinline__ void operator()(const f32x4 (&acc)[2][2][4][2], const Unit& u, int wr, int wc, int fr, int fq) const {
        const int row0 = u.pm * BM + wr * 64 + fr, col0 = u.pn * BM + wc * 32 + 8 * fq;
        float one = scale; asm volatile("" : "+v"(one));
#pragma unroll
        for (int ai = 0; ai < 2; ++ai)
#pragma unroll
            for (int m = 0; m < 4; ++m) { bf16_t* rowp = O + (size_t)(row0 + ai * HALF + m * 16) * ldc + col0;
#pragma unroll
                for (int bj = 0; bj < 2; ++bj) { const f32x4 v0 = acc[ai][bj][m][0] * one, v1 = acc[ai][bj][m][1] * one;
                    u32x4 w; w.x = cvt_pk_bf16(v0[0], v0[1]); w.y = cvt_pk_bf16(v0[2], v0[3]); w.z = cvt_pk_bf16(v1[0], v1[1]); w.w = cvt_pk_bf16(v1[2], v1[3]);
                    *(u32x4*)(rowp + bj * HALF) = w; } }
    }
};
struct EpiF8 {
    static constexpr bool PERM = true, AFTER_DRAIN = false;
    unsigned char* O; int ldc; float scale;
    __device__ __forceinline__ void operator()(const f32x4 (&acc)[2][2][4][2], const Unit& u, int wr, int wc, int fr, int fq) const {
        const int row0 = u.pm * BM + wr * 64 + fr, col0 = u.pn * BM + wc * 32 + 8 * fq;
        float one = scale; asm volatile("" : "+v"(one));
#pragma unroll
        for (int ai = 0; ai < 2; ++ai)
#pragma unroll
            for (int m = 0; m < 4; ++m) { unsigned char* rowp = O + (size_t)(row0 + ai * HALF + m * 16) * ldc + col0;
#pragma unroll
                for (int bj = 0; bj < 2; ++bj) { const f32x4 v0 = acc[ai][bj][m][0] * one, v1 = acc[ai][bj][m][1] * one;
                    u32x2e w; { int t = __builtin_amdgcn_cvt_pk_fp8_f32(v0[0], v0[1], 0, false); t = __builtin_amdgcn_cvt_pk_fp8_f32(v0[2], v0[3], t, true); w.x = (unsigned)t; }
                    { int t = __builtin_amdgcn_cvt_pk_fp8_f32(v1[0], v1[1], 0, false); t = __builtin_amdgcn_cvt_pk_fp8_f32(v1[2], v1[3], t, true); w.y = (unsigned)t; }
                    *(u32x2e*)(rowp + bj * HALF) = w; } }
    }
};
struct EpiInProj {
    static constexpr bool PERM = true, AFTER_DRAIN = false;
    bf16_t* O; int ldc; const float* rope; int rope_lo, rope_hi, lat_rows; float scale;
    __device__ __forceinline__ void operator()(const f32x4 (&acc)[2][2][4][2], const Unit& u, int wr, int wc, int fr, int fq) const {
        const int row0 = u.pm * BM + wr * 64 + fr, col0 = u.pn * BM + wc * 32 + 8 * fq;
        const bool do_rope = (u.pn >= rope_lo) && (u.pn < rope_hi) && (u.pm * BM < lat_rows);
        const int i0 = 16 * (wc & 1) + 4 * fq, half = wc >> 1;
        float one = scale; asm volatile("" : "+v"(one));
#pragma unroll
        for (int ai = 0; ai < 2; ++ai)
#pragma unroll
            for (int m = 0; m < 4; ++m) { const int row = row0 + ai * HALF + m * 16; bf16_t* rowp = O + (size_t)row * ldc + col0;
                f32x4 cs0 = {1.f, 0.f, 1.f, 0.f}, cs1 = {1.f, 0.f, 1.f, 0.f};
                if (do_rope) { const int s = row & 8191, pos = half ? (s & 63) : (s >> 6); const f32x4* tp = (const f32x4*)(rope + (size_t)(pos * 32 + i0) * 2); cs0 = tp[0]; cs1 = tp[1]; }
#pragma unroll
                for (int bj = 0; bj < 2; ++bj) { f32x4 v0 = acc[ai][bj][m][0] * one, v1 = acc[ai][bj][m][1] * one;
                    if (do_rope) {
                        const f32x4 a = v0, b = v1;
                        v0[0] = a[0] * cs0[0] - a[1] * cs0[1]; v0[1] = a[1] * cs0[0] + a[0] * cs0[1];
                        v0[2] = a[2] * cs0[2] - a[3] * cs0[3]; v0[3] = a[3] * cs0[2] + a[2] * cs0[3];
                        v1[0] = b[0] * cs1[0] - b[1] * cs1[1]; v1[1] = b[1] * cs1[0] + b[0] * cs1[1];
                        v1[2] = b[2] * cs1[2] - b[3] * cs1[3]; v1[3] = b[3] * cs1[2] + b[2] * cs1[3];
                    }
                    u32x4 w; w.x = cvt_pk_bf16(v0[0], v0[1]); w.y = cvt_pk_bf16(v0[2], v0[3]); w.z = cvt_pk_bf16(v1[0], v1[1]); w.w = cvt_pk_bf16(v1[2], v1[3]);
                    *(u32x4*)(rowp + bj * HALF) = w; } }
    }
};
struct EpiRes {
    static constexpr bool PERM = true, AFTER_DRAIN = false;
    const void* xin; bf16_t* xout; const void* cin; bf16_t* cout; const float* gate;
    int ldc, lat_rows, gstride; float scale; int in_f32;
    __device__ __forceinline__ void operator()(const f32x4 (&acc)[2][2][4][2], const Unit& u, int wr, int wc, int fr, int fq) const {
        const int row0 = u.pm * BM + wr * 64 + fr, col0 = u.pn * BM + wc * 32 + 8 * fq;
        const bool isc = u.pm * BM >= lat_rows;
        const int vs = isc ? 2 : ((u.pm * BM) >> 13), rsub = isc ? lat_rows : 0;
        const void* bp = isc ? cin : xin; bf16_t* op = isc ? cout : xout;
        f32x4 gv[2][2];
#pragma unroll
        for (int bj = 0; bj < 2; ++bj)
#pragma unroll
            for (int n = 0; n < 2; ++n) { typedef int i32x4 __attribute__((ext_vector_type(4))); const i32x4 q = *(const i32x4*)(gate + (size_t)vs * gstride + col0 + bj * HALF + 4 * n);
                gv[bj][n] = (f32x4){(float)q[0], (float)q[1], (float)q[2], (float)q[3]} * (scale * (1.f / 16777216.f)); }
#pragma unroll
        for (int ai = 0; ai < 2; ++ai)
#pragma unroll
        for (int mh = 0; mh < 2; ++mh) {
            if (in_f32) {
                f32x4 bb[2][2][2];
#pragma unroll
                for (int mm = 0; mm < 2; ++mm)
#pragma unroll
                    for (int bj = 0; bj < 2; ++bj) { const float* q = (const float*)bp + (size_t)(row0 - rsub + ai * HALF + (2 * mh + mm) * 16) * ldc + col0 + bj * HALF; bb[mm][bj][0] = *(const f32x4*)q; bb[mm][bj][1] = *(const f32x4*)(q + 4); }
#pragma unroll
                for (int mm = 0; mm < 2; ++mm)
#pragma unroll
                    for (int bj = 0; bj < 2; ++bj) { const int m = 2 * mh + mm; const size_t off = (size_t)(row0 - rsub + ai * HALF + m * 16) * ldc + col0 + bj * HALF;
                        const f32x4 o0 = bb[mm][bj][0] + gv[bj][0] * acc[ai][bj][m][0], o1 = bb[mm][bj][1] + gv[bj][1] * acc[ai][bj][m][1];
                        u32x4 w; w.x = cvt_pk_bf16(o0[0], o0[1]); w.y = cvt_pk_bf16(o0[2], o0[3]); w.z = cvt_pk_bf16(o1[0], o1[1]); w.w = cvt_pk_bf16(o1[2], o1[3]);
                        *(u32x4*)(op + off) = w; }
            } else {
                u32x4 bw[2][2];
#pragma unroll
                for (int mm = 0; mm < 2; ++mm)
#pragma unroll
                    for (int bj = 0; bj < 2; ++bj) bw[mm][bj] = *(const u32x4*)((const bf16_t*)bp + (size_t)(row0 - rsub + ai * HALF + (2 * mh + mm) * 16) * ldc + col0 + bj * HALF);
#pragma unroll
                for (int mm = 0; mm < 2; ++mm)
#pragma unroll
                    for (int bj = 0; bj < 2; ++bj) { const int m = 2 * mh + mm; const size_t off = (size_t)(row0 - rsub + ai * HALF + m * 16) * ldc + col0 + bj * HALF; const u32x4 w0 = bw[mm][bj];
                        const f32x4 b0 = (f32x4){__builtin_bit_cast(float, w0.x << 16), __builtin_bit_cast(float, w0.x & 0xffff0000u), __builtin_bit_cast(float, w0.y << 16), __builtin_bit_cast(float, w0.y & 0xffff0000u)};
                        const f32x4 b1 = (f32x4){__builtin_bit_cast(float, w0.z << 16), __builtin_bit_cast(float, w0.z & 0xffff0000u), __builtin_bit_cast(float, w0.w << 16), __builtin_bit_cast(float, w0.w & 0xffff0000u)};
                        const f32x4 o0 = b0 + gv[bj][0] * acc[ai][bj][m][0], o1 = b1 + gv[bj][1] * acc[ai][bj][m][1];
                        u32x4 w; w.x = cvt_pk_bf16(o0[0], o0[1]); w.y = cvt_pk_bf16(o0[2], o0[3]); w.z = cvt_pk_bf16(o1[0], o1[1]); w.w = cvt_pk_bf16(o1[2], o1[3]);
                        *(u32x4*)(op + off) = w; }
            }
        }
    }
};
__device__ __forceinline__ unsigned pack4_fp8(float a, float b, float c, float d) { int w = __builtin_amdgcn_cvt_pk_fp8_f32(a, b, 0, false); w = __builtin_amdgcn_cvt_pk_fp8_f32(c, d, w, true); return (unsigned)w; }
struct EpiGateUp {
    static constexpr bool PERM = true, AFTER_DRAIN = false;
    unsigned char* O; int ldc; float wscale;
    __device__ __forceinline__ void operator()(const f32x4 (&acc)[2][2][4][2], const Unit& u, int wr, int wc, int fr, int fq) const {
        const int row0 = u.pm * BM + wr * 64 + fr, col0 = (u.pn * BM + wc * 32 + 8 * fq) >> 1;
        float ws = wscale; asm volatile("" : "+v"(ws));
#pragma unroll
        for (int ai = 0; ai < 2; ++ai)
#pragma unroll
            for (int m = 0; m < 4; ++m) { unsigned char* rowp = O + (size_t)(row0 + ai * HALF + m * 16) * ldc + col0;
#pragma unroll
                for (int bj = 0; bj < 2; ++bj) { const f32x4 g = acc[ai][bj][m][0] * ws, up = acc[ai][bj][m][1] * ws; f32x4 a;
#pragma unroll
                    for (int i = 0; i < 4; ++i) a[i] = g[i] * __builtin_amdgcn_rcpf(1.f + __expf(-g[i])) * up[i];
                    *(unsigned*)(rowp + bj * (HALF / 2)) = pack4_fp8(a[0], a[1], a[2], a[3]); } }
    }
};
template <bool SKIP, bool GATH = false> struct GroupedOrderT {
    static constexpr bool SKIP_HI = SKIP, GATHER = GATH;
    static constexpr int nN = 8;
    int G, c, nblk; const PG8_LAS int* blk_e; const PG8_LAS int* blk_h; long estride; const PG8_LAS unsigned* rowtab;
    __device__ __forceinline__ bool next(int i, Unit& u) const {
        const int L = i * G + c; if (L >= nblk * nN) return false;
        u.pm = L >> 3; u.pn = L & 7; u.boff = (long)__builtin_amdgcn_readfirstlane(blk_e[u.pm]) * estride; u.lo_only = __builtin_amdgcn_readfirstlane(blk_h[u.pm]); return true;
    }
    __device__ __forceinline__ void a_ready(const Unit&) const {}
    __device__ __forceinline__ void done(const Unit&) const {}
};
}
constexpr int DM = 2048, T_LAT = 16384, T_CTX = 512, T_ALL = 16896, SEQL = 8192, CTXL = 256;
constexpr int NIN = 5152, NINP = 5376;
constexpr int C_QA = 0, C_KA = 512, C_VA = 1024, C_QB = 1536, C_KB = 2048, C_VB = 2304, C_Z = 2560, C_XBC = 3584, C_DT = 5120;
constexpr int XBCW = 1536, DFF = 1024, NEXP = 32, MODW = 12288;
constexpr float EPS = 1e-6f, ATT_SCALE = 0.088388347648318440f;
constexpr int MAXBLK = 165, MAXSLOT = MAXBLK * 256;
constexpr int NWAVES = 8;

constexpr size_t MiB = 1u << 20;
constexpr size_t WS_CTL = 0, CTL_ZERO_BYTES = 2 * MiB;
constexpr int CW_BAR = 4096;
constexpr size_t OFF_Q = 32768;
constexpr size_t OFF_CNT = 65536;
constexpr size_t OFF_MOD = 1 * MiB;
constexpr size_t WS_ROPE = 2 * MiB;
constexpr size_t WS_WRT = 3 * MiB;
constexpr size_t WS_WIN = 8 * MiB;
constexpr size_t WS_WOUT = 50 * MiB;
constexpr size_t WS_WGU = 66 * MiB;
constexpr size_t WS_WDN = 578 * MiB;
constexpr size_t WS_H = 834 * MiB;
constexpr size_t WS_U = 900 * MiB;
constexpr size_t WS_X = 1074 * MiB;
constexpr size_t WS_XC = 1202 * MiB;
constexpr size_t WS_XBC = 1206 * MiB;
constexpr size_t WS_DT = 1256 * MiB;
constexpr size_t WS_YD = 1260 * MiB;
constexpr size_t WS_XG = 1392 * MiB;
constexpr size_t WS_ACT = 1557 * MiB;
constexpr size_t WS_YB = 1640 * MiB;
constexpr size_t WS_TOK = 1805 * MiB;
constexpr size_t WS_END = 1808 * MiB;
constexpr size_t WS_LIST = WS_XG + 64 * MiB;
constexpr int LCAP = 2 * T_ALL;
constexpr unsigned ZERO_OFF = 1536u * 1024u;
constexpr size_t TOKTAB = (size_t)T_ALL * 2 * 4;
static_assert(WS_WIN + (size_t)2 * NINP * DM * 2 <= WS_WOUT && WS_WGU + (size_t)2 * 32 * 2048 * 2048 * 2 <= WS_WDN && WS_WDN + (size_t)2 * 32 * 2048 * 1024 * 2 <= WS_H, "ws map 1");
static_assert(WS_H + (size_t)T_ALL * DM * 2 <= WS_U && WS_U + (size_t)T_ALL * NINP * 2 <= WS_X && WS_X + (size_t)T_LAT * DM * 4 <= WS_XC && WS_XBC + (size_t)T_ALL * XBCW * 2 <= WS_DT, "ws map 2");
static_assert(WS_DT + (size_t)T_ALL * 32 * 4 <= WS_YD && WS_YD + (size_t)2 * T_ALL * 1024 * 4 <= WS_XG && WS_XG + (size_t)MAXSLOT * DM * 2 <= WS_ACT && WS_ACT + (size_t)MAXSLOT * DFF * 2 <= WS_YB && WS_YB + (size_t)MAXSLOT * DM * 2 <= WS_TOK && WS_TOK + 4 * TOKTAB <= WS_END, "ws map 3");

constexpr int RING_BYTES = 131072, LDSCTL_OFF = RING_BYTES, LDS_BYTES = 147456;
constexpr int L_BARW = LDSCTL_OFF;
constexpr int L_BWORK = LDSCTL_OFF + 32;
constexpr int L_SEG = LDSCTL_OFF + 64;
constexpr int L_CNT = LDSCTL_OFF + 256;
constexpr int L_BLKE = LDSCTL_OFF + 512;
constexpr int L_NBLK = LDSCTL_OFF + 1536;
constexpr int L_INCL = LDSCTL_OFF + 1600;
constexpr int L_PB = LDSCTL_OFF + 1792;
constexpr int L_ROWT = LDSCTL_OFF + 4096;
constexpr int L_BLKH = LDSCTL_OFF + 2048;

#define GAS __attribute__((address_space(1)))
#define LAS __attribute__((address_space(3)))
typedef unsigned short bf16;
typedef unsigned v4u __attribute__((ext_vector_type(4)));
typedef unsigned v2u __attribute__((ext_vector_type(2)));
typedef float f32x4 __attribute__((ext_vector_type(4)));
typedef float f32x2 __attribute__((ext_vector_type(2)));
typedef short bf16x8 __attribute__((ext_vector_type(8)));
#define LDS_WAIT() asm volatile("s_waitcnt lgkmcnt(0)" ::: "memory")
#define VM_WAIT() asm volatile("s_waitcnt vmcnt(0)" ::: "memory")
__device__ __forceinline__ unsigned f2bf(float f) { unsigned u = __builtin_bit_cast(unsigned, f); return (u + 0x7fffu + ((u >> 16) & 1u)) >> 16; }
__device__ __forceinline__ unsigned pk2(float lo, float hi) { return f2bf(lo) | (f2bf(hi) << 16); }
__device__ __forceinline__ float bflo(unsigned w) { return __builtin_bit_cast(float, w << 16); }
__device__ __forceinline__ float bfhi(unsigned w) { return __builtin_bit_cast(float, w & 0xffff0000u); }
__device__ __forceinline__ float bf2f(bf16 b) { return __builtin_bit_cast(float, (unsigned)b << 16); }
__device__ __forceinline__ float wave_sum(float v) {
#pragma unroll
    for (int o = 1; o < 64; o <<= 1) v += __shfl_xor(v, o);
    return v;
}
__device__ __forceinline__ float wave_max(float v) {
#pragma unroll
    for (int o = 1; o < 64; o <<= 1) v = fmaxf(v, __shfl_xor(v, o));
    return v;
}
__device__ __forceinline__ float silu_f(float x) { return x / (1.f + __expf(-x)); }
__device__ __forceinline__ float sigmoid_f(float x) { return 1.f / (1.f + __expf(-x)); }
__device__ __forceinline__ float softplus_f(float x) { return x > 20.f ? x : log1pf(__expf(x)); }

#define XB_TMO      128
#define XB_XCNT(j)  (256  + 64 * (j))
#define XB_XSUB(j)  (1280 + 64 * (j))
#define XB_XGEN(j)  (2304 + 64 * (j))
#define XB_TOP      3328
#define XB_TOPGEN   3392
#define XCD_BAR_WORDS 3456
#define XB_SPIN_CAP (1u << 18)


__device__ __forceinline__ unsigned xb_ld(unsigned* p)              { return __hip_atomic_load(p, __ATOMIC_RELAXED, __HIP_MEMORY_SCOPE_AGENT); }
__device__ __forceinline__ unsigned xb_add(unsigned* p, unsigned v) { return __hip_atomic_fetch_add(p, v, __ATOMIC_RELAXED, __HIP_MEMORY_SCOPE_AGENT); }
__device__ __forceinline__ unsigned xb_xcc_id() { return (unsigned)__builtin_amdgcn_s_getreg((3 << 11) | 20) & 0xFu; }
#define XB_SPIN(cond, bar) do { unsigned _sp = 0; while (cond) { __builtin_amdgcn_s_sleep(1); \
    if ((++_sp & 255u) == 0u) { if (xb_ld(&(bar)[XB_TMO])) break; if (_sp > XB_SPIN_CAP) { atomicAdd(&(bar)[XB_TMO], 1u); break; } } } } while (0)

struct XcdBarrier {
    unsigned* bar; unsigned x;
    volatile LAS unsigned* st;
};

__device__ __forceinline__ XcdBarrier xcd_barrier_post(unsigned* bar, volatile LAS unsigned* st) {
    XcdBarrier b; b.bar = bar; b.x = xb_xcc_id(); b.st = st;
    if (threadIdx.x == 0) (void)xb_add(&bar[XB_XCNT(b.x)], 1u);
    return b;
}
__device__ __forceinline__ void xcd_barrier_complete(unsigned* bar, unsigned x, unsigned& nloc, unsigned& nx) {
    const unsigned G = gridDim.x * gridDim.y * gridDim.z;
    unsigned sum, cnt, mine, sp = 0u;
    for (;;) {
        sum = 0u; cnt = 0u; mine = 0u;
#pragma unroll
        for (unsigned j = 0; j < 16; ++j) { const unsigned c = xb_ld(&bar[XB_XCNT(j)]); sum += c; cnt += (c > 0u) ? 1u : 0u; mine = (j == x) ? c : mine; }
        if (sum == G) break;
        __builtin_amdgcn_s_sleep(1);
        if ((++sp & 255u) == 0u) { if (xb_ld(&bar[XB_TMO])) break; if (sp > XB_SPIN_CAP) { atomicAdd(&bar[XB_TMO], 1u); break; } }
    }
    nloc = mine > 0u ? mine : 1u; nx = cnt > 0u ? cnt : 1u;
}

__device__ __forceinline__ void xcd_barrier(const XcdBarrier& b) {
    asm volatile("s_waitcnt vmcnt(0)" ::: "memory");
    __syncthreads();
    if (threadIdx.x == 0) {
        unsigned* bar = b.bar;
        __builtin_amdgcn_s_waitcnt(0);
        unsigned nloc = b.st[0], nx = b.st[1];
        if (nloc == 0u) { xcd_barrier_complete(bar, b.x, nloc, nx); b.st[0] = nloc; b.st[1] = nx; }
        const unsigned old = xb_add(&bar[XB_XSUB(b.x)], 1u);
        const unsigned gen = old / nloc;
        if (old + 1u == (gen + 1u) * nloc) {
            __builtin_amdgcn_fence(__ATOMIC_RELEASE, "agent");
            asm volatile("s_waitcnt vmcnt(0)" ::: "memory");
            const unsigned og = xb_add(&bar[XB_TOP], 1u);
            const unsigned tg = og / nx;
            if (og + 1u == (tg + 1u) * nx) xb_add(&bar[XB_TOPGEN], 1u);
            else XB_SPIN(xb_ld(&bar[XB_TOPGEN]) == tg, bar);
            __builtin_amdgcn_fence(__ATOMIC_ACQUIRE, "agent");
            xb_add(&bar[XB_XGEN(b.x)], 1u);
            asm volatile("s_waitcnt vmcnt(0)" ::: "memory");
        } else {
            XB_SPIN(xb_ld(&bar[XB_XGEN(b.x)]) == gen, bar);
            __builtin_amdgcn_fence(__ATOMIC_ACQUIRE, "agent");
            asm volatile("s_waitcnt vmcnt(0)" ::: "memory");
        }
    }
    __syncthreads();
}
struct Prm {
    const float *x, *c, *ctx, *c_ctx, *w_ada, *b_ada, *norm_mix, *norm_ffn, *norm_final, *w_in, *w_out, *na_rpb, *wa_sink,
                *conv_w, *conv_b, *a_log, *dt_bias, *d_skip, *ssd_norm, *w_router, *router_bias, *w_gate, *w_up, *w_down;
    float* out; unsigned char* ws; int ph_lo, ph_hi;
};

__device__ __forceinline__ int perm_in(int n) {
    if (n >= C_QB && n < C_VB) { const int p = (n - C_QB) & 127, hb = n - p, half = p >> 6, pp = p & 63; return hb + half * 64 + (pp >> 1) + 32 * (pp & 1); }
    return n;
}
__device__ __forceinline__ unsigned pack4f8(float a, float b, float c, float d) { int w = __builtin_amdgcn_cvt_pk_fp8_f32(a, b, 0, false); w = __builtin_amdgcn_cvt_pk_fp8_f32(c, d, w, true); return (unsigned)w; }
#ifndef CONV_QUEUE
#define CONV_QUEUE 1
#endif
constexpr float W8_SCALE = 64.f, MIX_SCALE = 8.f, Y8_SCALE = 8.f;
struct TDesc { const float* colp; size_t ld; unsigned char* wt; int ok, k0, K, n0; };
constexpr int TK_IN = 2 * 32 * (NINP / 32), TK_OUT = 2 * 32 * 64, TK_GU = 2 * 32 * 32 * 64, TK_DN = 2 * 32 * 16 * 64, TK_RT = 32;
template <bool F8SEL> __device__ __forceinline__ constexpr int t_count() {
    return ((F8_INPROJ != 0) == F8SEL ? TK_IN : 0) + ((F8_OUTPROJ != 0) == F8SEL ? TK_OUT : 0) + (F8SEL ? TK_GU + TK_DN : TK_RT);
}
template <bool F8SEL> __device__ __forceinline__ TDesc t_decode(const Prm& p, int it, int lane) {
    unsigned char* ws = p.ws; TDesc d; int r = it;
    if ((F8_INPROJ != 0) == F8SEL) { if (r < TK_IN) { const int sub = r & 1, r2 = r >> 1, l = r2 / (TK_IN / 4), q = r2 % (TK_IN / 4), kb = 2 * (q / (NINP / 32)) + sub, nb = q % (NINP / 32), nn = 32 * nb + (lane & 31); const bool ok = nn < NIN;
            d.colp = p.w_in + (size_t)l * DM * NIN + (ok ? perm_in(nn) : 0); d.ld = NIN; d.ok = ok; d.K = 2048; d.wt = ws + WS_WIN + (size_t)l * NINP * DM * (F8_INPROJ ? 1 : 2); d.n0 = 32 * nb; d.k0 = 64 * kb; return d; } r -= TK_IN; }
    if ((F8_OUTPROJ != 0) == F8SEL) { if (r < TK_OUT) { const int sub = r & 1, r2 = r >> 1, l = r2 / (TK_OUT / 4), q = r2 % (TK_OUT / 4), kb = 2 * (q / 64) + sub, nb = q % 64, nn = 32 * nb + (lane & 31);
            d.colp = p.w_out + (size_t)l * DM * DM + nn; d.ld = DM; d.ok = 1; d.K = 2048; d.wt = ws + WS_WOUT + (size_t)l * DM * DM * (F8_OUTPROJ ? 1 : 2); d.n0 = 32 * nb; d.k0 = 64 * kb; return d; } r -= TK_OUT; }
    if (F8SEL) {
        if (r < TK_GU) { const int sub = r & 1, r2 = r >> 1, le = r2 / 1024, q = r2 % 1024, kb = 2 * (q / 64) + sub, nb = q % 64, nn = 32 * nb + (lane & 31), j = nn >> 3, t = nn & 7;
            d.colp = (t < 4 ? p.w_gate : p.w_up) + (size_t)le * 2048 * 1024 + 4 * j + (t & 3); d.ld = 1024; d.ok = 1; d.K = 2048; d.wt = ws + WS_WGU + (size_t)le * 2048 * 2048; d.n0 = 32 * nb; d.k0 = 64 * kb; return d; }
        r -= TK_GU;
        { const int sub = r & 1, r2 = r >> 1, le = r2 / 512, q = r2 % 512, kb = 2 * (q / 64) + sub, nb = q % 64, nn = 32 * nb + (lane & 31);
            d.colp = p.w_down + (size_t)le * 1024 * 2048 + nn; d.ld = 2048; d.ok = 1; d.K = 1024; d.wt = ws + WS_WDN + (size_t)le * 2048 * 1024; d.n0 = 32 * nb; d.k0 = 64 * kb; return d; }
    } else { const int kb = r; d.colp = p.w_router + (lane & 31); d.ld = 32; d.ok = 1; d.K = 2048; d.wt = ws + WS_WRT; d.n0 = 0; d.k0 = 64 * kb; return d; }
}
__device__ __forceinline__ void t_load(const TDesc& d, float (&tv)[32], int lane) {
#pragma unroll
    for (int i = 0; i < 32; ++i) tv[i] = d.colp[(size_t)(d.k0 + 2 * i + (lane >> 5)) * d.ld];
}
template <bool F8> __device__ __forceinline__ void t_lds_in(const TDesc& d, const float (&tv)[32], LAS float* scr, int lane) {
#pragma unroll
    for (int i = 0; i < 32; ++i) scr[(2 * i + (lane >> 5)) * 33 + (lane & 31)] = d.ok ? tv[i] : 0.f;
    LDS_WAIT(); asm volatile("" ::: "memory");
}
template <bool F8> __device__ __forceinline__ void t_out(const TDesc& d, LAS float* scr, int lane) {
    const int c = lane & 7;
#pragma unroll
    for (int j = 0; j < 4; ++j) { const int n = (lane >> 3) + 8 * j; const LAS float* s = scr + (8 * c) * 33 + n;
        if constexpr (F8) { v2u o; o.x = pack4f8(s[0 * 33] * W8_SCALE, s[1 * 33] * W8_SCALE, s[2 * 33] * W8_SCALE, s[3 * 33] * W8_SCALE); o.y = pack4f8(s[4 * 33] * W8_SCALE, s[5 * 33] * W8_SCALE, s[6 * 33] * W8_SCALE, s[7 * 33] * W8_SCALE);
            *(v2u*)(d.wt + (size_t)(d.n0 + n) * d.K + d.k0 + 8 * c) = o; }
        else { v4u o; o.x = pk2(s[0 * 33], s[1 * 33]); o.y = pk2(s[2 * 33], s[3 * 33]); o.z = pk2(s[4 * 33], s[5 * 33]); o.w = pk2(s[6 * 33], s[7 * 33]);
            *(v4u*)((bf16*)d.wt + (size_t)(d.n0 + n) * d.K + d.k0 + 8 * c) = o; } }
    LDS_WAIT(); asm volatile("" ::: "memory");
}
__device__ __forceinline__ void t_cvt8(LAS float* scr, int lane, v2u (&o)[4]) {
    const int c = lane & 7;
#pragma unroll
    for (int j = 0; j < 4; ++j) { const int n = (lane >> 3) + 8 * j; const LAS float* s = scr + (8 * c) * 33 + n;
        o[j].x = pack4f8(s[0 * 33] * W8_SCALE, s[1 * 33] * W8_SCALE, s[2 * 33] * W8_SCALE, s[3 * 33] * W8_SCALE); o[j].y = pack4f8(s[4 * 33] * W8_SCALE, s[5 * 33] * W8_SCALE, s[6 * 33] * W8_SCALE, s[7 * 33] * W8_SCALE); }
    LDS_WAIT(); asm volatile("" ::: "memory");
}
constexpr int TL_IN = 32 * (NINP / 32), TL_OUT = 32 * 64, TL_GU = 32 * 32 * 64, TL_DN = 32 * 16 * 64, TL_ALL = TL_IN + TL_OUT + TL_GU + TL_DN, NPL = TL_ALL / 2;
static_assert(F8_INPROJ && F8_OUTPROJ, "the per-layer conversion queue assumes fp8 copies of every GEMM weight");
__device__ __forceinline__ TDesc t_decode_layer(const Prm& p, int l, int it, int lane) {
    unsigned char* ws = p.ws; TDesc d; int r = it; const int sub = r & 1;
    if (r < TL_IN) { const int q = r >> 1, kb = 2 * (q / (NINP / 32)) + sub, nb = q % (NINP / 32), nn = 32 * nb + (lane & 31); const bool ok = nn < NIN;
        d.colp = p.w_in + (size_t)l * DM * NIN + (ok ? perm_in(nn) : 0); d.ld = NIN; d.ok = ok; d.K = 2048; d.wt = ws + WS_WIN + (size_t)l * NINP * DM; d.n0 = 32 * nb; d.k0 = 64 * kb; return d; }
    r -= TL_IN;
    if (r < TL_OUT) { const int q = r >> 1, kb = 2 * (q / 64) + sub, nb = q % 64, nn = 32 * nb + (lane & 31);
        d.colp = p.w_out + (size_t)l * DM * DM + nn; d.ld = DM; d.ok = 1; d.K = 2048; d.wt = ws + WS_WOUT + (size_t)l * DM * DM; d.n0 = 32 * nb; d.k0 = 64 * kb; return d; }
    r -= TL_OUT;
    if (r < TL_GU) { const int r2 = r >> 1, le = l * 32 + r2 / 1024, q = r2 % 1024, kb = 2 * (q / 64) + sub, nb = q % 64, nn = 32 * nb + (lane & 31), j = nn >> 3, t = nn & 7;
        d.colp = (t < 4 ? p.w_gate : p.w_up) + (size_t)le * 2048 * 1024 + 4 * j + (t & 3); d.ld = 1024; d.ok = 1; d.K = 2048; d.wt = ws + WS_WGU + (size_t)le * 2048 * 2048; d.n0 = 32 * nb; d.k0 = 64 * kb; return d; }
    r -= TL_GU;
    { const int r2 = r >> 1, le = l * 32 + r2 / 512, q = r2 % 512, kb = 2 * (q / 64) + sub, nb = q % 64, nn = 32 * nb + (lane & 31);
        d.colp = p.w_down + (size_t)le * 1024 * 2048 + nn; d.ld = 2048; d.ok = 1; d.K = 1024; d.wt = ws + WS_WDN + (size_t)le * 2048 * 1024; d.n0 = 32 * nb; d.k0 = 64 * kb; return d; }
}
__device__ __forceinline__ void t_pair_store(const TDesc& dS, const v2u (&oa)[4], const v2u (&ob)[4], int lane) {
    const int c = lane & 7, odd = c & 1;
#pragma unroll
    for (int j = 0; j < 4; ++j) { const int n = (lane >> 3) + 8 * j;
        const v2u snd = odd ? oa[j] : ob[j]; v2u got; got.x = (unsigned)__builtin_amdgcn_update_dpp(0, (int)snd.x, 0xB1, 0xF, 0xF, false); got.y = (unsigned)__builtin_amdgcn_update_dpp(0, (int)snd.y, 0xB1, 0xF, 0xF, false);
        v4u w; if (odd) { w.x = got.x; w.y = got.y; w.z = ob[j].x; w.w = ob[j].y; } else { w.x = oa[j].x; w.y = oa[j].y; w.z = got.x; w.w = got.y; }
        *(v4u*)(dS.wt + (size_t)(dS.n0 + n) * dS.K + dS.k0 + (odd ? 64 : 0) + 16 * (c >> 1)) = w; }
}
#ifndef Q_L0EXP
#define Q_L0EXP 1
#endif
constexpr int NP_PROJ = (TL_IN + TL_OUT) / 2, NP_EXP = (TL_GU + TL_DN) / 2;
__device__ __forceinline__ void t_convert_pairs(const Prm& p, int l, int npairs, LAS float* scr, int gw, int ngw, int lane) {
    if (gw >= npairs) return;
    TDesc dA = t_decode_layer(p, l, 2 * gw, lane), dB = t_decode_layer(p, l, 2 * gw + 1, lane); float ta[32], tb[32]; t_load(dA, ta, lane); t_load(dB, tb, lane);
#pragma unroll 1
    for (int pi = gw; pi < npairs; pi += ngw) {
        v2u oa[4], ob[4];
        t_lds_in<true>(dA, ta, scr, lane); t_cvt8(scr, lane, oa);
        t_lds_in<true>(dB, tb, scr, lane);
        const TDesc dS = dA; const int pn = pi + ngw;
        if (pn < npairs) { dA = t_decode_layer(p, l, 2 * pn, lane); dB = t_decode_layer(p, l, 2 * pn + 1, lane); t_load(dA, ta, lane); t_load(dB, tb, lane); }
        t_cvt8(scr, lane, ob);
        t_pair_store(dS, oa, ob, lane);
    }
}
__device__ __forceinline__ void t_convert_two(const Prm& p, int l, int pi0, int pi1, bool has1, LAS float* scr, int lane) {
    const TDesc dA = t_decode_layer(p, l, 2 * pi0, lane), dB = t_decode_layer(p, l, 2 * pi0 + 1, lane), dC = t_decode_layer(p, l, 2 * pi1, lane), dD = t_decode_layer(p, l, 2 * pi1 + 1, lane);
    float ta[32], tb[32], tc[32], td[32]; t_load(dA, ta, lane); t_load(dB, tb, lane); t_load(dC, tc, lane); t_load(dD, td, lane);
    v2u oa[4], ob[4];
    t_lds_in<true>(dA, ta, scr, lane); t_cvt8(scr, lane, oa);
    t_lds_in<true>(dB, tb, scr, lane); t_cvt8(scr, lane, ob);
    t_pair_store(dA, oa, ob, lane);
    if (has1) {
        t_lds_in<true>(dC, tc, scr, lane); t_cvt8(scr, lane, oa);
        t_lds_in<true>(dD, td, scr, lane); t_cvt8(scr, lane, ob);
        t_pair_store(dC, oa, ob, lane);
    }
}
__device__ __forceinline__ void t_convert_one(const Prm& p, int l, int pi, LAS float* scr, int lane) {
    const TDesc dA = t_decode_layer(p, l, 2 * pi, lane), dB = t_decode_layer(p, l, 2 * pi + 1, lane); float ta[32], tb[32]; t_load(dA, ta, lane); t_load(dB, tb, lane);
    v2u oa[4], ob[4];
    t_lds_in<true>(dA, ta, scr, lane); t_cvt8(scr, lane, oa);
    t_lds_in<true>(dB, tb, scr, lane); t_cvt8(scr, lane, ob);
    t_pair_store(dA, oa, ob, lane);
}
template <bool F8SEL> __device__ __forceinline__ void t_convert_all(const Prm& p, LAS float* scr, int gw, int ngw, int lane) {
    constexpr int N = t_count<F8SEL>();
    if (2 * gw >= N) return;
    TDesc d0 = t_decode<F8SEL>(p, 2 * gw, lane); float tv[32]; t_load(d0, tv, lane);
#pragma unroll 1
    for (int it = 2 * gw; it < N; ) {
        t_lds_in<F8SEL>(d0, tv, scr, lane);
        const int itn = (it & 1) ? it - 1 + 2 * ngw : it + 1; TDesc d1 = d0;
        if (itn < N) { d1 = t_decode<F8SEL>(p, itn, lane); t_load(d1, tv, lane); }
        t_out<F8SEL>(d0, scr, lane);
        d0 = d1; it = itn;
    }
}
__device__ __forceinline__ void phase_prologue(const Prm& p, LAS unsigned char* lds, int gw, int ngw, int wave, int lane, bool first) {
    LAS float* scr = (LAS float*)(lds + wave * 16384);
    unsigned char* ws = p.ws;
    t_convert_pairs(p, 0, (CONV_QUEUE && Q_L0EXP) ? NP_PROJ : NPL, scr, gw, ngw, lane);
    if (!CONV_QUEUE) t_convert_pairs(p, 1, NPL, scr, gw, ngw, lane);
    t_convert_all<false>(p, scr, gw, ngw, lane);
    int* mod = (int*)(ws + OFF_MOD);
    for (int it = gw; first && it < 2 * 32 * 48; it += ngw) {
        const int l = it / (32 * 48), q = it % (32 * 48), kc = q / 48, nc = q % 48, k0 = 64 * kc, n0 = 256 * nc + 4 * lane;
        scr[lane] = silu_f(p.c[k0 + lane]); scr[64 + lane] = silu_f(p.c[DM + k0 + lane]); scr[128 + lane] = silu_f(p.c_ctx[k0 + lane]);
        LDS_WAIT(); asm volatile("" ::: "memory");
        f32x4 a0 = {0.f, 0.f, 0.f, 0.f}, a1 = a0, a2 = a0;
        const float* wp = p.w_ada + ((size_t)l * DM + k0) * MODW + n0;
#pragma unroll 8
        for (int kk = 0; kk < 64; ++kk) { const f32x4 w = *(const f32x4*)(wp + (size_t)kk * MODW); a0 += w * scr[kk]; a1 += w * scr[64 + kk]; a2 += w * scr[128 + kk]; }
        if (kc == 0) { const f32x4 bb = *(const f32x4*)(p.b_ada + (size_t)l * MODW + n0); a0 += bb; a1 += bb; a2 += bb; }
        int* m0 = mod + (size_t)(l * 3) * MODW + n0;
#pragma unroll
        for (int i = 0; i < 4; ++i) { atomicAdd(m0 + i, (int)rintf(a0[i] * 16777216.f)); atomicAdd(m0 + MODW + i, (int)rintf(a1[i] * 16777216.f)); atomicAdd(m0 + 2 * MODW + i, (int)rintf(a2[i] * 16777216.f)); }
        LDS_WAIT(); asm volatile("" ::: "memory");
    }
    for (int it = gw * 64 + lane; it < 128 * 32; it += ngw * 64) { const int pos = it >> 5, i = it & 31; const float inv = powf(10000.f, -(float)i / 32.f), ang = (float)pos * inv;
        ((float*)(ws + WS_ROPE))[2 * it] = cosf(ang); ((float*)(ws + WS_ROPE))[2 * it + 1] = sinf(ang); }
}

__device__ __forceinline__ f32x4 modv4(const float* p) {
    typedef int i32x4 __attribute__((ext_vector_type(4)));
    const i32x4 v = *(const i32x4*)p; return (f32x4){(float)v[0], (float)v[1], (float)v[2], (float)v[3]} * (1.f / 16777216.f);
}
__device__ __forceinline__ f32x4 bf4(v2u w) { return (f32x4){bflo(w.x), bfhi(w.x), bflo(w.y), bfhi(w.y)}; }
__device__ __forceinline__ void load_row(const Prm& p, int l, int lcomb, int m, int lane, f32x4 (&v)[8], bool wb = true, const LAS int* segL = nullptr) {
    const bool isc = m >= T_LAT;
    const bf16* wsrow = isc ? (const bf16*)(p.ws + WS_XC) + (size_t)(m - T_LAT) * DM : (const bf16*)(p.ws + WS_X) + (size_t)m * DM;
#pragma unroll
    for (int j = 0; j < 8; ++j) v[j] = bf4(*(const v2u*)(wsrow + 256 * j + 4 * lane));
}
__device__ __forceinline__ float row_rstd(const f32x4 (&v)[8]) {
    float s = 0.f;
#pragma unroll
    for (int j = 0; j < 8; ++j) s += (v[j][0] * v[j][0] + v[j][1] * v[j][1]) + (v[j][2] * v[j][2] + v[j][3] * v[j][3]);
    return rsqrtf(wave_sum(s) * (1.f / DM) + EPS);
}
__device__ __forceinline__ f32x4 modulate4f(const f32x4 v, float rstd, const float* gain, const float* sc, const float* sh, int col) {
    const f32x4 g = *(const f32x4*)(gain + col), s1 = modv4(sc + col), s0 = modv4(sh + col);
    return (v * rstd * g) * (s1 + 1.f) + s0;
}
__device__ __forceinline__ v2u modulate4(const f32x4 v, float rstd, const float* gain, const float* sc, const float* sh, int col) {
    const f32x4 g = *(const f32x4*)(gain + col), s1 = modv4(sc + col), s0 = modv4(sh + col);
    const f32x4 o = (v * rstd * g) * (s1 + 1.f) + s0;
    v2u w; w.x = pk2(o[0], o[1]); w.y = pk2(o[2], o[3]); return w;
}
constexpr int RS_A = 0, RS_SH = 3 * 8192, RS_GF = 6 * 8192, RS_END = 9 * 8192;
struct RowX { f32x4 x[8]; v2u xb[8]; unsigned ya[8], yb[8]; };
struct RowI { int s; float g; };
template <bool COMB> __device__ __forceinline__ RowI rs_idx_issue(const Prm& p, int m, int lane, int& e_out, int& pos_out) {
    RowI r; r.s = 0; r.g = 0.f; e_out = 0; pos_out = 0;
    if constexpr (COMB) { const int k = lane & 1; const int* te = (const int*)(p.ws + WS_TOK); const int* tp = (const int*)(p.ws + WS_TOK + TOKTAB); const float* tg = (const float*)(p.ws + WS_TOK + 2 * TOKTAB);
        e_out = te[2 * m + k]; pos_out = tp[2 * m + k]; r.g = tg[2 * m + k]; }
    return r;
}
template <bool COMB, bool SRC32> __device__ __forceinline__ void rs_issue(const Prm& p, int m, int s0, int s1, int lane, RowX& b) {
    const bool isc = m >= T_LAT;
    if constexpr (SRC32) { const float* src = isc ? p.ctx + (size_t)(m - T_LAT) * DM : p.x + (size_t)m * DM;
#pragma unroll
        for (int j = 0; j < 8; ++j) b.x[j] = *(const f32x4*)(src + 256 * j + 4 * lane); }
    else { const bf16* src = isc ? (const bf16*)(p.ws + WS_XC) + (size_t)(m - T_LAT) * DM : (const bf16*)(p.ws + WS_X) + (size_t)m * DM;
#pragma unroll
        for (int j = 0; j < 8; ++j) b.xb[j] = *(const v2u*)(src + 256 * j + 4 * lane); }
    if constexpr (COMB) { const unsigned char* y0 = p.ws + WS_YB + (size_t)s0 * DM; const unsigned char* y1 = p.ws + WS_YB + (size_t)s1 * DM;
#pragma unroll
        for (int j = 0; j < 8; ++j) { b.ya[j] = *(const unsigned*)(y0 + 256 * j + 4 * lane); b.yb[j] = *(const unsigned*)(y1 + 256 * j + 4 * lane); } }
}
template <bool COMB, bool FINAL, bool SRC32> __device__ __forceinline__ void rs_finish(const Prm& p, int l, int m, float g0, float g1, int lane, RowX& b, const LAS unsigned char* vl, bool live) {
    const bool isc = m >= T_LAT; const int vs = isc ? 2 : (m >> 13);
    const LAS float* A = (const LAS float*)(vl + RS_A) + vs * 2048; const LAS float* SH = (const LAS float*)(vl + RS_SH) + vs * 2048; const LAS float* GF = (const LAS float*)(vl + RS_GF) + vs * 2048;
    if constexpr (!SRC32) {
#pragma unroll
        for (int j = 0; j < 8; ++j) b.x[j] = bf4(b.xb[j]); }
    if constexpr (COMB) {
        bf16* wsrow = isc ? (bf16*)(p.ws + WS_XC) + (size_t)(m - T_LAT) * DM : (bf16*)(p.ws + WS_X) + (size_t)m * DM;
#pragma unroll
        for (int j = 0; j < 8; ++j) { const int col = 256 * j + 4 * lane; const unsigned a = b.ya[j], c = b.yb[j]; const f32x4 gq = *(const LAS f32x4*)(GF + col);
            const f32x2 a01 = __builtin_amdgcn_cvt_pk_f32_fp8(a, false), a23 = __builtin_amdgcn_cvt_pk_f32_fp8(a, true), c01 = __builtin_amdgcn_cvt_pk_f32_fp8(c, false), c23 = __builtin_amdgcn_cvt_pk_f32_fp8(c, true);
            b.x[j][0] += gq[0] * (g0 * a01[0] + g1 * c01[0]); b.x[j][1] += gq[1] * (g0 * a01[1] + g1 * c01[1]);
            b.x[j][2] += gq[2] * (g0 * a23[0] + g1 * c23[0]); b.x[j][3] += gq[3] * (g0 * a23[1] + g1 * c23[1]);
            if (!FINAL && live) { v2u w; w.x = pk2(b.x[j][0], b.x[j][1]); w.y = pk2(b.x[j][2], b.x[j][3]); *(v2u*)(wsrow + col) = w; } } }
    const float rstd = row_rstd(b.x);
    if (!live) return;
#pragma unroll
    for (int j = 0; j < 8; ++j) { const int col = 256 * j + 4 * lane; const f32x4 av = *(const LAS f32x4*)(A + col);
        if constexpr (FINAL) { *(f32x4*)(p.out + (size_t)m * DM + col) = b.x[j] * rstd * av; }
        else { const f32x4 o = b.x[j] * rstd * av + *(const LAS f32x4*)(SH + col);
            if (F8_INPROJ) *(unsigned*)(p.ws + WS_H + (size_t)m * DM + col) = pack4f8(o[0], o[1], o[2], o[3]);
            else { v2u w; w.x = pk2(o[0], o[1]); w.y = pk2(o[2], o[3]); *(v2u*)((bf16*)(p.ws + WS_H) + (size_t)m * DM + col) = w; } } }
}
template <bool COMB, bool FINAL, bool SRC32> __device__ __forceinline__ void row_stream(const Prm& p, int l, int lc, int nrows, int gw, int ngw, int tid, int lane, LAS unsigned char* vl, const LAS int* segL) {
    { const float* md = (const float*)(p.ws + OFF_MOD);
      for (int q = tid; q < 3 * 512; q += NWAVES * 64) { const int vs = q >> 9, c4 = (q & 511) * 4;
          if (FINAL) { if (vs == 0) *(LAS f32x4*)(vl + RS_A + (size_t)c4 * 4) = *(const f32x4*)(p.norm_final + c4); }
          else { const f32x4 gn = *(const f32x4*)(p.norm_mix + l * DM + c4), sc = modv4(md + (size_t)(l * 3 + vs) * MODW + DM + c4), sh = modv4(md + (size_t)(l * 3 + vs) * MODW + c4);
              *(LAS f32x4*)(vl + RS_A + ((size_t)vs * 2048 + c4) * 4) = gn * (sc + 1.f); *(LAS f32x4*)(vl + RS_SH + ((size_t)vs * 2048 + c4) * 4) = sh; }
          if (COMB) *(LAS f32x4*)(vl + RS_GF + ((size_t)vs * 2048 + c4) * 4) = modv4(md + (size_t)(lc * 3 + vs) * MODW + 5 * DM + c4) * (1.f / Y8_SCALE); }
      if (FINAL) { for (int q = tid; q < 2 * 512; q += NWAVES * 64) { const int c4 = (q & 511) * 4; *(LAS f32x4*)(vl + RS_A + ((size_t)(1 + (q >> 9)) * 2048 + c4) * 4) = *(const f32x4*)(p.norm_final + c4); } }
      __syncthreads(); }
    const int nit = gw < nrows ? (nrows - gw + ngw - 1) / ngw : 0;
    if (nit == 0) return;
    const int last = gw + (nit - 1) * ngw;
#define RS_ROW(i) min(gw + (i) * ngw, last)
    RowX bA, bB; int e0, p0, e1, p1; RowI i0 = rs_idx_issue<COMB>(p, RS_ROW(0), lane, e0, p0), i1 = rs_idx_issue<COMB>(p, RS_ROW(1), lane, e1, p1);
    { int s = COMB ? segL[e0] + p0 : 0; rs_issue<COMB, SRC32>(p, RS_ROW(0), __shfl(s, 0), __shfl(s, 1), lane, bA); }
#pragma unroll 1
    for (int i = 0; i < nit; i += 2) {
        int e2, p2, e3, p3;
        const RowI i2 = rs_idx_issue<COMB>(p, RS_ROW(i + 2), lane, e2, p2);
        { int s = COMB ? segL[e1] + p1 : 0; rs_issue<COMB, SRC32>(p, RS_ROW(i + 1), __shfl(s, 0), __shfl(s, 1), lane, bB); }
        rs_finish<COMB, FINAL, SRC32>(p, l, RS_ROW(i), __shfl(i0.g, 0), __shfl(i0.g, 1), lane, bA, vl, true);
        const RowI i3 = rs_idx_issue<COMB>(p, RS_ROW(i + 3), lane, e3, p3);
        { int s = COMB ? segL[e2] + p2 : 0; rs_issue<COMB, SRC32>(p, RS_ROW(i + 2), __shfl(s, 0), __shfl(s, 1), lane, bA); }
        rs_finish<COMB, FINAL, SRC32>(p, l, RS_ROW(i + 1), __shfl(i1.g, 0), __shfl(i1.g, 1), lane, bB, vl, i + 1 < nit);
        i0 = i2; i1 = i3; e1 = e3; p1 = p3;
    }
#undef RS_ROW
}
#ifndef Q_L0EXP
#define Q_L0EXP 1
#endif
constexpr int Q_L0 = Q_L0EXP ? NP_EXP : 0;
constexpr int Q_TOTAL = Q_L0 + NPL;
static_assert(Q_L0 % 16 == 0 && (Q_L0 + NP_PROJ) % 16 == 0, "a grab of 16 pairs never straddles a layer or a drain target");
__device__ __forceinline__ void queue_convert8(const Prm& p, unsigned base, LAS unsigned char* lds, int tid_in) {
    int tid = tid_in;
    asm volatile("" : "+v"(tid));
    const int wave = __builtin_amdgcn_readfirstlane(tid >> 6), lane = tid & 63; const unsigned pi = base + (unsigned)wave, pj = pi + 8u;
    if (pi < (unsigned)Q_TOTAL) { const bool h1 = pj < (unsigned)Q_TOTAL; const int l = base < (unsigned)Q_L0 ? 0 : 1, off = l ? -Q_L0 : NP_PROJ;
        t_convert_two(p, l, (int)pi + off, (h1 ? (int)pj : (int)pi) + off, h1, (LAS float*)(lds + wave * 16384), lane); }
}
__device__ __forceinline__ void xcd_barrier_work(const XcdBarrier& b, const Prm& p, LAS unsigned char* lds, int tid) {
    asm volatile("s_waitcnt vmcnt(0)" ::: "memory");
    __syncthreads();
    volatile LAS unsigned* bw = (volatile LAS unsigned*)(lds + L_BWORK);
    unsigned* bar = b.bar; unsigned* q = (unsigned*)(p.ws + OFF_Q);
    if (threadIdx.x == 0) {
        __builtin_amdgcn_s_waitcnt(0);
        unsigned nloc = b.st[0], nx = b.st[1];
        if (nloc == 0u) { xcd_barrier_complete(bar, b.x, nloc, nx); b.st[0] = nloc; b.st[1] = nx; }
        const unsigned old = xb_add(&bar[XB_XSUB(b.x)], 1u);
        const unsigned gen = old / nloc;
        if (old + 1u == (gen + 1u) * nloc) {
            __builtin_amdgcn_fence(__ATOMIC_RELEASE, "agent");
            asm volatile("s_waitcnt vmcnt(0)" ::: "memory");
            const unsigned og = xb_add(&bar[XB_TOP], 1u);
            const unsigned tg = og / nx;
            if (og + 1u == (tg + 1u) * nx) xb_add(&bar[XB_TOPGEN], 1u);
            else XB_SPIN(xb_ld(&bar[XB_TOPGEN]) == tg, bar);
            __builtin_amdgcn_fence(__ATOMIC_ACQUIRE, "agent");
            xb_add(&bar[XB_XGEN(b.x)], 1u);
            asm volatile("s_waitcnt vmcnt(0)" ::: "memory");
            bw[0] = 1u;
        } else { bw[0] = 0u; bw[2] = gen; }
    }
    __syncthreads();
    if (bw[0] == 0u) {
        unsigned sp = 0u;
        for (;;) {
            if (threadIdx.x == 0) {
                const unsigned gen = bw[2];
                bool rel = xb_ld(&bar[XB_XGEN(b.x)]) != gen;
                if (!rel && ((++sp & 63u) == 0u)) { if (xb_ld(&bar[XB_TMO])) rel = true; else if (sp > XB_SPIN_CAP) { atomicAdd(&bar[XB_TMO], 1u); rel = true; } }
                if (rel) { __builtin_amdgcn_fence(__ATOMIC_ACQUIRE, "agent"); asm volatile("s_waitcnt vmcnt(0)" ::: "memory"); bw[0] = 1u; }
                else { unsigned base = 0xffffffffu; if (xb_ld(q) < (unsigned)Q_TOTAL) { base = xb_add(q, 16u); if (base >= (unsigned)Q_TOTAL) base = 0xffffffffu; } bw[1] = base; }
            }
            __syncthreads();
            if (bw[0]) break;
            const unsigned base = bw[1];
            if (base != 0xffffffffu) queue_convert8(p, base, lds, tid); else __builtin_amdgcn_s_sleep(4);
            __syncthreads();
        }
    }
    __syncthreads();
}
__device__ __forceinline__ void queue_drain(const Prm& p, LAS unsigned char* lds, int tid, unsigned target) {
    volatile LAS unsigned* bw = (volatile LAS unsigned*)(lds + L_BWORK); unsigned* q = (unsigned*)(p.ws + OFF_Q);
    __syncthreads();
    for (;;) {
        if (threadIdx.x == 0) bw[1] = (xb_ld(q) < target) ? xb_add(q, 16u) : 0xffffffffu;
        __syncthreads();
        const unsigned base = bw[1];
        if (base >= target) break;
        queue_convert8(p, base, lds, tid);
        __syncthreads();
    }
    __syncthreads();
}
__device__ __forceinline__ void phase_conv(const Prm& p, int l, int gw, int ngw, int lane) {
    const bf16* U = (const bf16*)(p.ws + WS_U); bf16* XA = (bf16*)(p.ws + WS_XBC); float* DT = (float*)(p.ws + WS_DT);
    constexpr int NRUN = T_ALL / 16;
    for (int it = gw; it < NRUN * 3; it += ngw) {
        const int run = it / 3, cb = it % 3, t0 = run * 16, ch = cb * 512 + lane * 8;
        int seq0, seq1; if (t0 < T_LAT) { seq0 = t0 & ~(SEQL - 1); seq1 = seq0 + SEQL; } else { seq0 = T_LAT + ((t0 - T_LAT) & ~(CTXL - 1)); seq1 = seq0 + CTXL; }
        float w[5][8], bias[8];
#pragma unroll
        for (int j = 0; j < 5; ++j) { const f32x4 a = *(const f32x4*)(p.conv_w + ((size_t)l * 5 + j) * XBCW + ch), b = *(const f32x4*)(p.conv_w + ((size_t)l * 5 + j) * XBCW + ch + 4);
            w[j][0] = a[0]; w[j][1] = a[1]; w[j][2] = a[2]; w[j][3] = a[3]; w[j][4] = b[0]; w[j][5] = b[1]; w[j][6] = b[2]; w[j][7] = b[3]; }
        { const f32x4 a = *(const f32x4*)(p.conv_b + (size_t)l * XBCW + ch), b = *(const f32x4*)(p.conv_b + (size_t)l * XBCW + ch + 4);
            bias[0] = a[0]; bias[1] = a[1]; bias[2] = a[2]; bias[3] = a[3]; bias[4] = b[0]; bias[5] = b[1]; bias[6] = b[2]; bias[7] = b[3]; }
        v4u rows[20];
#pragma unroll
        for (int j = 0; j < 20; ++j) { const int t = t0 - 2 + j, tc = min(max(t, seq0), seq1 - 1); rows[j] = *(const v4u*)(U + (size_t)tc * NINP + C_XBC + ch); }
#pragma unroll
        for (int j = 0; j < 20; ++j) { const int t = t0 - 2 + j; if (t < seq0 || t >= seq1) rows[j] = (v4u){0u, 0u, 0u, 0u}; }
#pragma unroll
        for (int i = 0; i < 16; ++i) {
            const int t = t0 + i;
            float o[8];
#pragma unroll
            for (int c = 0; c < 8; ++c) o[c] = bias[c];
#pragma unroll
            for (int j = 0; j < 5; ++j) { const v4u wv = rows[i + j];
                o[0] += w[j][0] * bflo(wv.x); o[1] += w[j][1] * bfhi(wv.x); o[2] += w[j][2] * bflo(wv.y); o[3] += w[j][3] * bfhi(wv.y);
                o[4] += w[j][4] * bflo(wv.z); o[5] += w[j][5] * bfhi(wv.z); o[6] += w[j][6] * bflo(wv.w); o[7] += w[j][7] * bfhi(wv.w); }
            v4u r; r.x = pk2(silu_f(o[0]), silu_f(o[1])); r.y = pk2(silu_f(o[2]), silu_f(o[3])); r.z = pk2(silu_f(o[4]), silu_f(o[5])); r.w = pk2(silu_f(o[6]), silu_f(o[7]));
            *(v4u*)(XA + (size_t)t * XBCW + ch) = r;
        }
    }
    for (int it = gw * 64 + lane; it < T_ALL * 32; it += ngw * 64) { const int m = it >> 5, j = it & 31;
        DT[it] = softplus_f(bf2f(U[(size_t)m * NINP + C_DT + j]) + p.dt_bias[l * 32 + j]); }
}

__device__ __forceinline__ void naive_attn_item(const Prm& p, int l, int type, int m, int hh, LAS float* qs, LAS float* sc, int lane) {
    const bf16* U = (const bf16*)(p.ws + WS_U); bf16* MIX = (bf16*)(p.ws + WS_H);
    int qcol, kcol, vcol, ocol;
    if (type == 0 || type == 2) { qcol = C_QA + hh * 128; kcol = C_KA + hh * 128; vcol = C_VA + hh * 128; ocol = hh * 128; }
    else { const int kvh = hh >> 1; qcol = C_QB + hh * 128; kcol = C_KB + kvh * 128; vcol = C_VB + kvh * 128; ocol = 512 + hh * 128; }
    { const unsigned w = *(const unsigned*)(U + (size_t)m * NINP + qcol + 2 * lane); qs[2 * lane] = bflo(w); qs[2 * lane + 1] = bfhi(w); }
    int b, s = 0, qr = 0, qc = 0, krow0 = 0, kpos0 = 0;
    if (type < 2) { b = m >> 13; s = m & 8191; qr = s >> 6; qc = s & 63; } else { b = (m - T_LAT) >> 8; }
    const int nloc = type == 0 ? 512 : (type == 1 ? 384 : 0), nk = nloc + 256;
    if (type == 0) krow0 = min(max(qr - 4, 0), 120);
    if (type == 1) kpos0 = (s >> 7) * 128 - 128;
    const float* rpb = p.na_rpb + (size_t)(l * 4 + hh) * 15 * 31;
    LDS_WAIT(); __builtin_amdgcn_wave_barrier(); asm volatile("" ::: "memory");
    float mx = -INFINITY;
    for (int k0 = 0; k0 < nk; k0 += 64) {
        const int kidx = k0 + lane; int row; float bias = 0.f; bool valid = true;
        if (kidx < nloc) {
            if (type == 0) { const int kr = krow0 + (kidx >> 6), kc = kidx & 63; row = b * SEQL + kr * 64 + kc; const int c0 = min(max(qc - 8, 0), 48); valid = (kc >= c0) && (kc < c0 + 16);
                const int dr = kr - qr + 7, dc = min(max(kc - qc + 15, 0), 30); bias = rpb[dr * 31 + dc]; }
            else { const int kpos = kpos0 + kidx; valid = (kpos >= 0) && (kpos < SEQL) && (abs(s - kpos) <= 128); row = b * SEQL + min(max(kpos, 0), SEQL - 1); }
        } else row = T_LAT + b * CTXL + (kidx - nloc);
        const bf16* kp = U + (size_t)row * NINP + kcol; float d = 0.f;
#pragma unroll 4
        for (int c = 0; c < 16; ++c) { const v4u w = *(const v4u*)(kp + 8 * c); const LAS float* q = qs + 8 * c;
            d += bflo(w.x) * q[0] + bfhi(w.x) * q[1] + bflo(w.y) * q[2] + bfhi(w.y) * q[3] + bflo(w.z) * q[4] + bfhi(w.z) * q[5] + bflo(w.w) * q[6] + bfhi(w.w) * q[7]; }
        const float sv = valid ? d * ATT_SCALE + bias : -INFINITY;
        sc[kidx] = sv; mx = fmaxf(mx, sv);
    }
    mx = wave_max(mx);
    float sum = 0.f;
    for (int k0 = 0; k0 < nk; k0 += 64) { const float e = __expf(sc[k0 + lane] - mx); sc[k0 + lane] = e; sum += e; }
    sum = wave_sum(sum);
    if (type == 1 || type == 3) sum += __expf(p.wa_sink[l * 4 + hh] - mx);
    LDS_WAIT(); __builtin_amdgcn_wave_barrier(); asm volatile("" ::: "memory");
    float o0 = 0.f, o1 = 0.f;
    for (int kidx = 0; kidx < nk; ++kidx) {
        int row;
        if (kidx < nloc) { if (type == 0) row = b * SEQL + (krow0 + (kidx >> 6)) * 64 + (kidx & 63); else row = b * SEQL + min(max(kpos0 + kidx, 0), SEQL - 1); }
        else row = T_LAT + b * CTXL + (kidx - nloc);
        const float pv = sc[kidx]; const unsigned w = *(const unsigned*)(U + (size_t)row * NINP + vcol + 2 * lane);
        o0 += pv * bflo(w); o1 += pv * bfhi(w);
    }
    const float inv = 1.f / sum;
    *(unsigned*)(MIX + (size_t)m * DM + ocol + 2 * lane) = pk2(o0 * inv, o1 * inv);
    LDS_WAIT(); __builtin_amdgcn_wave_barrier(); asm volatile("" ::: "memory");
}
__device__ __forceinline__ void phase_attn_naive(const Prm& p, int l, LAS unsigned char* lds, int gw, int ngw, int wave, int lane) {
    LAS float* qs = (LAS float*)(lds + wave * 4096); LAS float* sc = qs + 128;
    const int nlat = T_LAT * 8, nctx = (l == 0) ? T_CTX * 8 : 0;
    for (int it = gw; it < nlat + nctx; it += ngw) {
        if (it < nlat) { const int m = it >> 3, h8 = it & 7; naive_attn_item(p, l, h8 >> 2, m, h8 & 3, qs, sc, lane); }
        else { const int r = it - nlat, m = T_LAT + (r >> 3), h8 = r & 7; naive_attn_item(p, l, 2 + (h8 >> 2), m, h8 & 3, qs, sc, lane); }
    }
}

__device__ __forceinline__ void phase_ssd_naive(const Prm& p, int l, int wg, int nwg, int tid) {
    const bf16* XA = (const bf16*)(p.ws + WS_XBC); const float* DT = (const float*)(p.ws + WS_DT); float* YD = (float*)(p.ws + WS_YD);
    for (int it = wg; it < 64; it += nwg) {
        const int b = it >> 5, dir = (it >> 4) & 1, h = it & 15, g = h >> 3;
        const int pp = tid >> 3, nq = tid & 7;
        const float a = -__expf(p.a_log[l * 32 + dir * 16 + h]), dsk = p.d_skip[l * 32 + dir * 16 + h];
        float hs[16];
#pragma unroll
        for (int i = 0; i < 16; ++i) hs[i] = 0.f;
#pragma unroll 4
        for (int st = 0; st < CTXL + SEQL; ++st) {
            int m; if (st < CTXL) m = T_LAT + b * CTXL + (dir ? CTXL - 1 - st : st); else { const int s = st - CTXL; m = b * SEQL + (dir ? SEQL - 1 - s : s); }
            const float dtv = DT[(size_t)m * 32 + dir * 16 + h];
            const bf16* row = XA + (size_t)m * XBCW;
            const float xv = bf2f(row[h * 64 + pp]);
            const v4u b0 = *(const v4u*)(row + 1024 + g * 128 + 16 * nq), b1 = *(const v4u*)(row + 1024 + g * 128 + 16 * nq + 8);
            const v4u c0 = *(const v4u*)(row + 1280 + g * 128 + 16 * nq), c1 = *(const v4u*)(row + 1280 + g * 128 + 16 * nq + 8);
            const float dA = __expf(a * dtv), dx = dtv * xv;
            float bv[16], cv[16];
            bv[0] = bflo(b0.x); bv[1] = bfhi(b0.x); bv[2] = bflo(b0.y); bv[3] = bfhi(b0.y); bv[4] = bflo(b0.z); bv[5] = bfhi(b0.z); bv[6] = bflo(b0.w); bv[7] = bfhi(b0.w);
            bv[8] = bflo(b1.x); bv[9] = bfhi(b1.x); bv[10] = bflo(b1.y); bv[11] = bfhi(b1.y); bv[12] = bflo(b1.z); bv[13] = bfhi(b1.z); bv[14] = bflo(b1.w); bv[15] = bfhi(b1.w);
            cv[0] = bflo(c0.x); cv[1] = bfhi(c0.x); cv[2] = bflo(c0.y); cv[3] = bfhi(c0.y); cv[4] = bflo(c0.z); cv[5] = bfhi(c0.z); cv[6] = bflo(c0.w); cv[7] = bfhi(c0.w);
            cv[8] = bflo(c1.x); cv[9] = bfhi(c1.x); cv[10] = bflo(c1.y); cv[11] = bfhi(c1.y); cv[12] = bflo(c1.z); cv[13] = bfhi(c1.z); cv[14] = bflo(c1.w); cv[15] = bfhi(c1.w);
            float part = 0.f;
#pragma unroll
            for (int i = 0; i < 16; ++i) { hs[i] = dA * hs[i] + dx * bv[i]; part += cv[i] * hs[i]; }
            part += __shfl_xor(part, 1); part += __shfl_xor(part, 2); part += __shfl_xor(part, 4);
            if (nq == 0) YD[((size_t)dir * T_ALL + m) * 1024 + h * 64 + pp] = part + dsk * xv;
        }
    }
}
__device__ __forceinline__ void phase_gnorm(const Prm& p, int l, int gw, int ngw, int lane) {
    const bf16* U = (const bf16*)(p.ws + WS_U); const bf16* YD = (const bf16*)(p.ws + WS_XG); bf16* MIX = (bf16*)(p.ws + WS_H);
    const int nrow = (l == 0) ? T_ALL : T_LAT;
    for (int m0 = gw; m0 < nrow; m0 += 2 * ngw) {
        const int m1 = (m0 + ngw < nrow) ? m0 + ngw : m0;
        v2u yv[2][4], zv[2][4];
#pragma unroll
        for (int q = 0; q < 2; ++q) { const int m = q ? m1 : m0;
#pragma unroll
            for (int j = 0; j < 4; ++j) { const int col = 256 * j + 4 * lane; yv[q][j] = *(const v2u*)(YD + (size_t)m * 1024 + col); zv[q][j] = *(const v2u*)(U + (size_t)m * NINP + C_Z + col); } }
#pragma unroll
        for (int q = 0; q < 2; ++q) { const int m = q ? m1 : m0;
            f32x4 u[4]; float ss[2] = {0.f, 0.f};
#pragma unroll
            for (int j = 0; j < 4; ++j) { const v2u yy = yv[q][j], zz = zv[q][j];
                u[j][0] = bflo(yy.x) * silu_f(bflo(zz.x)); u[j][1] = bfhi(yy.x) * silu_f(bfhi(zz.x)); u[j][2] = bflo(yy.y) * silu_f(bflo(zz.y)); u[j][3] = bfhi(yy.y) * silu_f(bfhi(zz.y));
                ss[j >> 1] += (u[j][0] * u[j][0] + u[j][1] * u[j][1]) + (u[j][2] * u[j][2] + u[j][3] * u[j][3]); }
            const float r0 = rsqrtf(wave_sum(ss[0]) * (1.f / 512.f) + EPS), r1 = rsqrtf(wave_sum(ss[1]) * (1.f / 512.f) + EPS);
            if (q == 1 && m1 == m0) continue;
#pragma unroll
            for (int j = 0; j < 4; ++j) { const int col = 256 * j + 4 * lane; const f32x4 g = *(const f32x4*)(p.ssd_norm + l * 1024 + col); const f32x4 o = u[j] * (j < 2 ? r0 : r1) * g;
                if (F8_OUTPROJ) *(unsigned*)((unsigned char*)MIX + (size_t)m * DM + 1024 + col) = pack4f8(o[0] * MIX_SCALE, o[1] * MIX_SCALE, o[2] * MIX_SCALE, o[3] * MIX_SCALE);
                else { v2u w; w.x = pk2(o[0], o[1]); w.y = pk2(o[2], o[3]); *(v2u*)(MIX + (size_t)m * DM + 1024 + col) = w; } }
        }
    }
}
namespace att {
typedef short s16x4 __attribute__((ext_vector_type(4)));
typedef float f32x16 __attribute__((ext_vector_type(16)));
constexpr int KVBLK = 64;
constexpr float THR = 8.f;
#ifndef ATT_SDEPTH
#define ATT_SDEPTH 1
#endif
constexpr int SDEPTH = ATT_SDEPTH;
constexpr int SHM_V = KVBLK * 128 * 2, SHM_K = KVBLK * 128 * 2;
constexpr int OFF_V = 0, OFF_K = 2 * SHM_V, OFF_WS = 2 * SHM_V + 2 * SHM_K, OFF_RPB = OFF_WS + 8 * 64 * 4, ATT_LDS = OFF_RPB + 576 * 4;
#define KSWZ(row, colB) ((row) * 256 + ((colB) ^ (((row) & 7) << 4)))
#define SBAR() __builtin_amdgcn_sched_barrier(0)
__device__ __forceinline__ int crow(int r, int hi) { return (r & 3) + 8 * (r >> 2) + 4 * hi; }
__device__ __forceinline__ unsigned cvtpk(float lo, float hi) { unsigned r; asm volatile("v_cvt_pk_bf16_f32 %0, %1, %2" : "=v"(r) : "v"(lo), "v"(hi)); return r; }
__device__ __forceinline__ void partialSM(f32x16& p0, f32x16& p1, float& m_reg, float& mn, float& alpha) {
  constexpr float C = ATT_SCALE * 1.4426950408889634f;
  float pmax = p0[0];
#pragma unroll
  for (int r = 1; r < 16; ++r) pmax = fmaxf(pmax, p0[r]);
#pragma unroll
  for (int r = 0; r < 16; ++r) pmax = fmaxf(pmax, p1[r]);
  { auto rr = __builtin_amdgcn_permlane32_swap(__float_as_uint(pmax), __float_as_uint(pmax), false, false);
    pmax = fmaxf(__uint_as_float(rr[0]), __uint_as_float(rr[1])); }
  if (__builtin_expect(__all(pmax - m_reg <= THR / ATT_SCALE), 1)) { mn = m_reg; alpha = 1.f; }
  else { mn = fmaxf(m_reg, pmax); alpha = __builtin_amdgcn_exp2f((m_reg - mn) * C); m_reg = mn; }
  float mnC = -mn * C;
#pragma unroll
  for (int r = 0; r < 16; ++r) p0[r] = fmaf(p0[r], C, mnC);
#pragma unroll
  for (int r = 0; r < 16; ++r) p1[r] = fmaf(p1[r], C, mnC);
#pragma unroll
  for (int r = 0; r < 16; ++r) p0[r] = __builtin_amdgcn_exp2f(p0[r]);
}
__device__ __forceinline__ void finishSM(f32x16& p0, f32x16& p1, float alpha, float& l_reg, bf16x8& pa0, bf16x8& pa1, bf16x8& pa2, bf16x8& pa3) {
#pragma unroll
  for (int r = 0; r < 16; ++r) p1[r] = __builtin_amdgcn_exp2f(p1[r]);
  float ps = 0;
#pragma unroll
  for (int r = 0; r < 16; ++r) ps += p0[r];
#pragma unroll
  for (int r = 0; r < 16; ++r) ps += p1[r];
  { auto rr = __builtin_amdgcn_permlane32_swap(__float_as_uint(ps), __float_as_uint(ps), false, false);
    ps = __uint_as_float(rr[0]) + __uint_as_float(rr[1]); }
  l_reg = l_reg * alpha + ps;
#define PK4(P, BASE, OUT) do { unsigned a0 = cvtpk(P[BASE + 0], P[BASE + 1]), a1 = cvtpk(P[BASE + 2], P[BASE + 3]);   \
    unsigned b0 = cvtpk(P[BASE + 4], P[BASE + 5]), b1 = cvtpk(P[BASE + 6], P[BASE + 7]);                              \
    auto r0 = __builtin_amdgcn_permlane32_swap(a0, b0, false, false); auto r1 = __builtin_amdgcn_permlane32_swap(a1, b1, false, false); \
    v4u w = {r0[0], r1[0], r0[1], r1[1]}; OUT = *reinterpret_cast<bf16x8*>(&w); } while (0)
  PK4(p0, 0, pa0); PK4(p0, 8, pa1); PK4(p1, 0, pa2); PK4(p1, 8, pa3);
#undef PK4
}
__device__ __forceinline__ void qkt(f32x16& p0, f32x16& p1, const LAS unsigned char* Ks, const bf16x8* qr, int r32, int hi) {
  p0 = f32x16{}; p1 = f32x16{};
#pragma unroll
  for (int d0 = 0; d0 < 8; ++d0) { int cb = (d0 * 16 + hi * 8) * 2;
    bf16x8 b0 = *reinterpret_cast<const LAS bf16x8*>(Ks + KSWZ(r32, cb));
    bf16x8 b1 = *reinterpret_cast<const LAS bf16x8*>(Ks + KSWZ(32 + r32, cb));
    p0 = __builtin_amdgcn_mfma_f32_32x32x16_bf16(b0, qr[d0], p0, 0, 0, 0);
    p1 = __builtin_amdgcn_mfma_f32_32x32x16_bf16(b1, qr[d0], p1, 0, 0, 0); }
}
__device__ __forceinline__ int v_st(int k, int c) { const int kk = (k & ~0xC) | ((k & 4) << 1) | ((k & 8) >> 1); return ((kk >> 3) * 4 + (c >> 5)) * 512 + ((kk & 7) * 32 + (c & 31)) * 2; }
__device__ __forceinline__ int v_rd_base(int lane) { return ((lane & 3) << 3) | (((lane >> 2) & 3) << 6) | (((lane >> 4) & 1) << 5) | (((lane >> 5) & 1) << 8); }
constexpr int v_rd_off(int d0, int ks, int half) { return d0 * 512 + ks * 4096 + half * 2048; }
template <int OFF> __device__ __forceinline__ s16x4 tr_read(int vb) {
  s16x4 r; asm volatile("ds_read_b64_tr_b16 %0, %1 offset:%2" : "=&v"(r) : "v"(vb), "i"(OFF) : "memory"); return r;
}
template <int D0> __device__ __forceinline__ void pv_one(f32x16& od, int vb, bf16x8 pa0, bf16x8 pa1, bf16x8 pa2, bf16x8 pa3) {
  const s16x4 l0 = tr_read<v_rd_off(D0, 0, 0)>(vb), h0 = tr_read<v_rd_off(D0, 0, 1)>(vb), l1 = tr_read<v_rd_off(D0, 1, 0)>(vb), h1 = tr_read<v_rd_off(D0, 1, 1)>(vb);
  const s16x4 l2 = tr_read<v_rd_off(D0, 2, 0)>(vb), h2 = tr_read<v_rd_off(D0, 2, 1)>(vb), l3 = tr_read<v_rd_off(D0, 3, 0)>(vb), h3 = tr_read<v_rd_off(D0, 3, 1)>(vb);
  asm volatile("s_waitcnt lgkmcnt(0)" ::: "memory"); SBAR();
#define PK(L, H) (bf16x8){L[0], L[1], L[2], L[3], H[0], H[1], H[2], H[3]}
  od = __builtin_amdgcn_mfma_f32_32x32x16_bf16(pa0, PK(l0, h0), od, 0, 0, 0);
  od = __builtin_amdgcn_mfma_f32_32x32x16_bf16(pa1, PK(l1, h1), od, 0, 0, 0);
  od = __builtin_amdgcn_mfma_f32_32x32x16_bf16(pa2, PK(l2, h2), od, 0, 0, 0);
  od = __builtin_amdgcn_mfma_f32_32x32x16_bf16(pa3, PK(l3, h3), od, 0, 0, 0);
#undef PK
}
__device__ __forceinline__ void pv_d0(f32x16* o, int vb, bf16x8 pa0, bf16x8 pa1, bf16x8 pa2, bf16x8 pa3) {
  pv_one<0>(o[0], vb, pa0, pa1, pa2, pa3); pv_one<1>(o[1], vb, pa0, pa1, pa2, pa3); pv_one<2>(o[2], vb, pa0, pa1, pa2, pa3); pv_one<3>(o[3], vb, pa0, pa1, pa2, pa3);
}
struct UnitD { int type, b, hh, q0  , nloc  , kbase  ; };
__device__ __forceinline__ int tile_row(const UnitD& u, int j) {
    if (j >= u.nloc) return T_LAT + u.b * CTXL + (j - u.nloc) * 64;
    if (u.type == 0) return u.b * SEQL + (u.kbase + j) * 64;
    const int kp = u.kbase + j * 64; return u.b * SEQL + min(max(kp, 0), SEQL - 64);
}
__device__ __forceinline__ bool tile_active(const UnitD& u, int j, int wid) {
    if (j >= u.nloc) return true;
    if (u.type == 0) { const int qr = (u.q0 >> 6) + (wid >> 1), kr = u.kbase + j, start = min(max(qr - 4, 0), 120); return kr >= start && kr < start + 8; }
    const int qw = u.q0 + 32 * wid, kp0 = u.kbase + j * 64;
    return (kp0 >= 0) && (kp0 < SEQL) && (kp0 - (qw + 31) <= 128) && (qw - (kp0 + 63) <= 128);
}
__device__ __forceinline__ void apply_mask(f32x16& p0, f32x16& p1, const UnitD& u, int j, int wid, int r32, int hi, const LAS float* rpbL) {
    if (j >= u.nloc) return;
    if (u.type == 0) {
        const int qr = (u.q0 >> 6) + (wid >> 1), qc = (wid & 1) * 32 + r32, kr = u.kbase + j;
        const int c0 = min(max(qc - 8, 0), 48), cb = 4 * hi - c0;
        const LAS float* rp = rpbL + (kr - qr + 7) * 31 + 4 * hi - qc + 15 + 32;
#pragma unroll
        for (int r = 0; r < 16; ++r) {
            const int k0 = (r & 3) + 8 * (r >> 2);
            p0[r] = ((unsigned)(k0 + cb) < 16u) ? p0[r] + rp[k0] : -INFINITY;
            p1[r] = ((unsigned)(k0 + 32 + cb) < 16u) ? p1[r] + rp[k0 + 32] : -INFINITY;
            if ((r & 3) == 3) SBAR(); }
    } else {
        const int qw = u.q0 + 32 * wid, kp0 = u.kbase + j * 64;
        if ((kp0 + 63 - qw <= 128) && (qw + 31 - kp0 <= 128)) return;
        const int cb = kp0 + 4 * hi - (qw + r32) + 128;
#pragma unroll
        for (int r = 0; r < 16; ++r) {
            const int k0 = (r & 3) + 8 * (r >> 2);
            p0[r] = ((unsigned)(k0 + cb) <= 256u) ? p0[r] : -INFINITY;
            p1[r] = ((unsigned)(k0 + 32 + cb) <= 256u) ? p1[r] : -INFINITY; }
    }
}
__device__ __forceinline__ void fill_ninf(f32x16& p0, f32x16& p1) {
#pragma unroll
    for (int r = 0; r < 16; ++r) { p0[r] = -INFINITY; p1[r] = -INFINITY; }
}
__device__ __forceinline__ void attn_unit(const Prm& p, int l, const UnitD u, LAS unsigned char* lds, int tid) {
  const bf16* U = (const bf16*)(p.ws + WS_U); bf16* MIX = (bf16*)(p.ws + WS_H);
  const int wid = __builtin_amdgcn_readfirstlane(tid >> 6), lane = tid & 63, r32 = lane & 31, hi = lane >> 5;
  int qcol, kcol, vcol, ocol;
  if (u.type == 0 || u.type == 2) { qcol = C_QA + u.hh * 128; kcol = C_KA + u.hh * 128; vcol = C_VA + u.hh * 128; ocol = u.hh * 128; }
  else { const int kvh = u.hh >> 1; qcol = C_QB + u.hh * 128; kcol = C_KB + kvh * 128; vcol = C_VB + kvh * 128; ocol = 512 + u.hh * 128; }
  const int qrow0 = (u.type < 2 ? u.b * SEQL : T_LAT + u.b * CTXL) + u.q0;
  LAS unsigned char* V_lds = lds + OFF_V; LAS unsigned char* K_lds = lds + OFF_K;
  LAS float* wsl = (LAS float*)(lds + OFF_WS) + wid * 64; LAS float* li_l = wsl; LAS float* al_l = wsl + 32;
  LAS float* rpbL = (LAS float*)(lds + OFF_RPB);
  if (u.type == 0 && tid < 465) rpbL[32 + tid] = p.na_rpb[(size_t)(l * 4 + u.hh) * 465 + tid] * (1.f / ATT_SCALE);
  float m_reg = -1e30f, l_reg = 0; f32x16 o[4] = {}; bf16x8 qr[8];
  const bf16* Qw = U + (size_t)(qrow0 + wid * 32 + r32) * NINP + qcol + hi * 8;
#pragma unroll
  for (int d0 = 0; d0 < 8; ++d0) qr[d0] = *reinterpret_cast<const bf16x8*>(Qw + d0 * 16);
  const int sr = tid >> 4, sc = (tid & 15) * 8, vst0 = v_st(sr, sc), vst1 = v_st(32 + sr, sc);
  const int vb0 = (int)(uintptr_t)V_lds + v_rd_base(lane);
  struct { bf16x8 vs0, vs1, ks0, ks1; } sr_[SDEPTH];
#define SLOAD(i, jt) do { const bf16* rb_ = U + (size_t)(tile_row(u, (jt)) + sr) * NINP + sc; \
    sr_[i].vs0 = *reinterpret_cast<const bf16x8*>(rb_ + vcol); sr_[i].vs1 = *reinterpret_cast<const bf16x8*>(rb_ + (size_t)32 * NINP + vcol); \
    sr_[i].ks0 = *reinterpret_cast<const bf16x8*>(rb_ + kcol); sr_[i].ks1 = *reinterpret_cast<const bf16x8*>(rb_ + (size_t)32 * NINP + kcol); } while (0)
#define SWRITE(b, i) do { *(LAS bf16x8*)(V_lds + (b) * SHM_V + vst0) = sr_[i].vs0;          \
    *(LAS bf16x8*)(V_lds + (b) * SHM_V + vst1) = sr_[i].vs1; int kc = sc * 2;               \
    *(LAS bf16x8*)(K_lds + (b) * SHM_K + KSWZ(sr, kc)) = sr_[i].ks0;                       \
    *(LAS bf16x8*)(K_lds + (b) * SHM_K + KSWZ(32 + sr, kc)) = sr_[i].ks1; } while (0)
#define SWAIT() do { if constexpr (SDEPTH == 2) asm volatile("s_waitcnt vmcnt(4)" ::: "memory"); else asm volatile("s_waitcnt vmcnt(0)" ::: "memory"); } while (0)
#define RESC(a) do { if (__any((a) < 1.f)) { if (hi == 0) al_l[r32] = (a); asm volatile("s_waitcnt lgkmcnt(0)" ::: "memory"); \
    _Pragma("unroll") for (int d = 0; d < 4; ++d) _Pragma("unroll") for (int r = 0; r < 16; ++r) o[d][r] *= al_l[crow(r, hi)]; } } while (0)
  f32x16 pA0, pA1, pB0, pB1; float mnA, mnB, alA, alB; bf16x8 pa0, pa1, pa2, pa3; const int NT = u.nloc + 4;
  constexpr int SE = 0, SO = SDEPTH - 1;
  SLOAD(SE, 0); asm volatile("s_waitcnt vmcnt(0)" ::: "memory"); SWRITE(0, SE); __syncthreads();
#define SCORE(P0, P1, KB, jt, ACT) do { ACT = tile_active(u, (jt), wid); if (ACT) { qkt(P0, P1, KB, qr, r32, hi); apply_mask(P0, P1, u, (jt), wid, r32, hi, rpbL); } else fill_ninf(P0, P1); } while (0)
  bool actA, actB;
  SCORE(pA0, pA1, K_lds, 0, actA); partialSM(pA0, pA1, m_reg, mnA, alA);
  SLOAD(SO, 1); if constexpr (SDEPTH == 2) { if (2 < NT) SLOAD(SE, 2); }
  SWAIT(); SWRITE(1, SO); __syncthreads();
  for (int j = 1; j + 1 < NT; j += 2) {
    SBAR(); SCORE(pB0, pB1, K_lds + SHM_K, j, actB);
    finishSM(pA0, pA1, alA, l_reg, pa0, pa1, pa2, pa3); SBAR();
    SLOAD(SO, j + SDEPTH); SBAR();
    if (actA) pv_d0(o, vb0, pa0, pa1, pa2, pa3); partialSM(pB0, pB1, m_reg, mnB, alB);
    __syncthreads(); SWAIT(); SWRITE(0, SE);
    RESC(alB); __syncthreads();
    SBAR(); SCORE(pA0, pA1, K_lds, j + 1, actA);
    finishSM(pB0, pB1, alB, l_reg, pa0, pa1, pa2, pa3); SBAR();
    if (SDEPTH == 1 || j + 3 < NT) SLOAD(SE, j + 1 + SDEPTH); SBAR();
    if (actB) pv_d0(o, vb0 + SHM_V, pa0, pa1, pa2, pa3); partialSM(pA0, pA1, m_reg, mnA, alA);
    __syncthreads(); SWAIT(); SWRITE(1, SO);
    RESC(alA); __syncthreads();
  }
  SBAR(); SCORE(pB0, pB1, K_lds + SHM_K, NT - 1, actB);
  finishSM(pA0, pA1, alA, l_reg, pa0, pa1, pa2, pa3); SBAR();
  if (actA) pv_d0(o, vb0, pa0, pa1, pa2, pa3); partialSM(pB0, pB1, m_reg, mnB, alB);
  __syncthreads(); RESC(alB);
  finishSM(pB0, pB1, alB, l_reg, pa0, pa1, pa2, pa3); SBAR();
  if (actB) pv_d0(o, vb0 + SHM_V, pa0, pa1, pa2, pa3);
  if (u.type & 1) { constexpr float C = ATT_SCALE * 1.4426950408889634f; l_reg += __builtin_amdgcn_exp2f((p.wa_sink[l * 4 + u.hh] * (1.f / ATT_SCALE) - m_reg) * C); }
  if (hi == 0) li_l[r32] = l_reg; asm volatile("s_waitcnt lgkmcnt(0)" ::: "memory");
  float rli[16];
#pragma unroll
  for (int r = 0; r < 16; ++r) rli[r] = __builtin_amdgcn_rcpf(li_l[crow(r, hi)]);
  bf16* Ow = MIX + (size_t)(qrow0 + wid * 32) * DM + ocol;
#pragma unroll
  for (int r = 0; r < 16; r += 2) {
#pragma unroll
    for (int d0 = 0; d0 < 4; ++d0) {
      const float a = o[d0][r] * rli[r], b = o[d0][r + 1] * rli[r + 1];
      const float send = (lane & 1) ? a : b, got = __shfl_xor(send, 1);
      const int orow = crow(r, hi) + (lane & 1), ocl = d0 * 32 + (r32 & ~1);
      if (F8_OUTPROJ) { const float lo = ((lane & 1) ? got : a) * MIX_SCALE, hi2 = ((lane & 1) ? b : got) * MIX_SCALE;
        *(unsigned short*)((unsigned char*)MIX + (size_t)(qrow0 + wid * 32 + orow) * DM + ocol + ocl) = (unsigned short)pack4f8(lo, hi2, 0.f, 0.f); }
      else { const unsigned w = (lane & 1) ? pk2(got, b) : pk2(a, got); *(unsigned*)(Ow + (size_t)orow * DM + ocl) = w; } } }
  __syncthreads();
#undef SCORE
#undef SLOAD
#undef SWRITE
#undef SWAIT
#undef RESC
}
constexpr int NSLOT = 3;
constexpr int OFFD_K = 0, OFFD_V = NSLOT * SHM_K, OFFD_WS = NSLOT * (SHM_K + SHM_V), OFFD_RPB = OFFD_WS + 8 * 64 * 4, ATT_LDS_D = OFFD_RPB + 576 * 4;
static_assert(ATT_LDS_D <= RING_BYTES, "attention LDS");
__device__ __forceinline__ void attn_unit_dma(const Prm& p, int l, const UnitD u, LAS unsigned char* lds, int tid) {
  const bf16* U = (const bf16*)(p.ws + WS_U); bf16* MIX = (bf16*)(p.ws + WS_H);
  const int wid = __builtin_amdgcn_readfirstlane(tid >> 6), lane = tid & 63, r32 = lane & 31, hi = lane >> 5;
  int qcol, kcol, vcol, ocol;
  if (u.type == 0 || u.type == 2) { qcol = C_QA + u.hh * 128; kcol = C_KA + u.hh * 128; vcol = C_VA + u.hh * 128; ocol = u.hh * 128; }
  else { const int kvh = u.hh >> 1; qcol = C_QB + u.hh * 128; kcol = C_KB + kvh * 128; vcol = C_VB + kvh * 128; ocol = 512 + u.hh * 128; }
  const int qrow0 = (u.type < 2 ? u.b * SEQL : T_LAT + u.b * CTXL) + u.q0;
  LAS unsigned char* K_lds = lds + OFFD_K; LAS unsigned char* V_lds = lds + OFFD_V;
  LAS float* wsl = (LAS float*)(lds + OFFD_WS) + wid * 64; LAS float* li_l = wsl; LAS float* al_l = wsl + 32;
  LAS float* rpbL = (LAS float*)(lds + OFFD_RPB);
  if (u.type == 0 && tid < 465) rpbL[32 + tid] = p.na_rpb[(size_t)(l * 4 + u.hh) * 465 + tid] * (1.f / ATT_SCALE);
  float m_reg = -1e30f, l_reg = 0; f32x16 o[4] = {}; bf16x8 qr[8];
  const bf16* Qw = U + (size_t)(qrow0 + wid * 32 + r32) * NINP + qcol + hi * 8;
#pragma unroll
  for (int d0 = 0; d0 < 8; ++d0) qr[d0] = *reinterpret_cast<const bf16x8*>(Qw + d0 * 16);
  unsigned koff[2], voff[2];
#pragma unroll
  for (int i = 0; i < 2; ++i) { const int pch = (wid * 2 + i) * 64 + lane;
    { const int row = pch >> 4, c = (pch & 15) ^ (row & 7); koff[i] = (unsigned)(row * NINP + kcol + c * 8); }
    { const int sidx = pch >> 5, q = pch & 31, kk = (sidx >> 2) * 8 + (q >> 2), k = (kk & ~0xC) | ((kk & 4) << 1) | ((kk & 8) >> 1);
      voff[i] = (unsigned)(k * NINP + vcol + (sidx & 3) * 32 + (q & 3) * 8); } }
  const int vb0 = (int)(uintptr_t)V_lds + v_rd_base(lane);
#define DMA_K(jt) do { const bf16* tb_ = U + (size_t)tile_row(u, (jt)) * NINP; LAS unsigned char* dst_ = K_lds + ((jt) % NSLOT) * SHM_K + wid * 2048; \
    _Pragma("unroll") for (int i_ = 0; i_ < 2; ++i_) __builtin_amdgcn_global_load_lds((const unsigned*)(tb_ + koff[i_]), (LAS unsigned*)(dst_ + i_ * 1024), 16, 0, 0); } while (0)
#define DMA_V(jt) do { const bf16* tb_ = U + (size_t)tile_row(u, (jt)) * NINP; LAS unsigned char* dst_ = V_lds + ((jt) % NSLOT) * SHM_V + wid * 2048; \
    _Pragma("unroll") for (int i_ = 0; i_ < 2; ++i_) __builtin_amdgcn_global_load_lds((const unsigned*)(tb_ + voff[i_]), (LAS unsigned*)(dst_ + i_ * 1024), 16, 0, 0); } while (0)
#define STEP_SYNC4() asm volatile("s_waitcnt vmcnt(4) lgkmcnt(0)\n\ts_barrier" ::: "memory")
#define STEP_SYNC0() asm volatile("s_waitcnt vmcnt(0) lgkmcnt(0)\n\ts_barrier" ::: "memory")
#define RESC(a) do { if (__any((a) < 1.f)) { if (hi == 0) al_l[r32] = (a); asm volatile("s_waitcnt lgkmcnt(0)" ::: "memory"); \
    _Pragma("unroll") for (int d = 0; d < 4; ++d) _Pragma("unroll") for (int r = 0; r < 16; ++r) o[d][r] *= al_l[crow(r, hi)]; } } while (0)
#define SCORE(P0, P1, jt, ACT) do { ACT = tile_active(u, (jt), wid); if (ACT) { qkt(P0, P1, K_lds + ((jt) % NSLOT) * SHM_K, qr, r32, hi); apply_mask(P0, P1, u, (jt), wid, r32, hi, rpbL); } else fill_ninf(P0, P1); } while (0)
  f32x16 pA0, pA1, pB0, pB1; float mnA, mnB, alA, alB; bf16x8 pa0, pa1, pa2, pa3; const int NT = u.nloc + 4; bool actA, actB;
  DMA_K(0); DMA_K(1); DMA_V(0);
  STEP_SYNC4();
  DMA_K(2); DMA_V(1);
  SCORE(pA0, pA1, 0, actA); partialSM(pA0, pA1, m_reg, mnA, alA);
#pragma unroll 1
  for (int s = 1; s + 1 < NT; s += 2) {
    STEP_SYNC4();
    DMA_K(s + 2); DMA_V(s + 1);
    SBAR(); SCORE(pB0, pB1, s, actB);
    finishSM(pA0, pA1, alA, l_reg, pa0, pa1, pa2, pa3); SBAR();
    if (actA) pv_d0(o, vb0 + ((s - 1) % NSLOT) * SHM_V, pa0, pa1, pa2, pa3); partialSM(pB0, pB1, m_reg, mnB, alB);
    RESC(alB);
    STEP_SYNC4();
    if (s + 3 < NT) DMA_K(s + 3); DMA_V(s + 2);
    SBAR(); SCORE(pA0, pA1, s + 1, actA);
    finishSM(pB0, pB1, alB, l_reg, pa0, pa1, pa2, pa3); SBAR();
    if (actB) pv_d0(o, vb0 + (s % NSLOT) * SHM_V, pa0, pa1, pa2, pa3); partialSM(pA0, pA1, m_reg, mnA, alA);
    RESC(alA);
  }
  STEP_SYNC0();
  SBAR(); SCORE(pB0, pB1, NT - 1, actB);
  finishSM(pA0, pA1, alA, l_reg, pa0, pa1, pa2, pa3); SBAR();
  if (actA) pv_d0(o, vb0 + ((NT - 2) % NSLOT) * SHM_V, pa0, pa1, pa2, pa3); partialSM(pB0, pB1, m_reg, mnB, alB);
  RESC(alB);
  finishSM(pB0, pB1, alB, l_reg, pa0, pa1, pa2, pa3); SBAR();
  if (actB) pv_d0(o, vb0 + ((NT - 1) % NSLOT) * SHM_V, pa0, pa1, pa2, pa3);
  if (u.type & 1) { constexpr float C = ATT_SCALE * 1.4426950408889634f; l_reg += __builtin_amdgcn_exp2f((p.wa_sink[l * 4 + u.hh] * (1.f / ATT_SCALE) - m_reg) * C); }
  if (hi == 0) li_l[r32] = l_reg; asm volatile("s_waitcnt lgkmcnt(0)" ::: "memory");
  float rli[16];
#pragma unroll
  for (int r = 0; r < 16; ++r) rli[r] = __builtin_amdgcn_rcpf(li_l[crow(r, hi)]);
  bf16* Ow = MIX + (size_t)(qrow0 + wid * 32) * DM + ocol;
#pragma unroll
  for (int r = 0; r < 16; r += 2) {
#pragma unroll
    for (int d0 = 0; d0 < 4; ++d0) {
      const float a = o[d0][r] * rli[r], b = o[d0][r + 1] * rli[r + 1];
      const float send = (lane & 1) ? a : b, got = __shfl_xor(send, 1);
      const int orow = crow(r, hi) + (lane & 1), ocl = d0 * 32 + (r32 & ~1);
      if (F8_OUTPROJ) { const float lo = ((lane & 1) ? got : a) * MIX_SCALE, hi2 = ((lane & 1) ? b : got) * MIX_SCALE;
        *(unsigned short*)((unsigned char*)MIX + (size_t)(qrow0 + wid * 32 + orow) * DM + ocol + ocl) = (unsigned short)pack4f8(lo, hi2, 0.f, 0.f); }
      else { const unsigned w = (lane & 1) ? pk2(got, b) : pk2(a, got); *(unsigned*)(Ow + (size_t)orow * DM + ocl) = w; } } }
  asm volatile("s_waitcnt lgkmcnt(0)\n\ts_barrier" ::: "memory");
#undef DMA_K
#undef DMA_V
#undef STEP_SYNC4
#undef STEP_SYNC0
#undef RESC
#undef SCORE
}
#ifndef ATT_DMA
#define ATT_DMA 1
#endif
__device__ __forceinline__ void phase_attn(const Prm& p, int l, LAS unsigned char* lds, int wg, int nwg, int tid) {
    const int nu = 512 + (l == 0 ? 16 : 0);
    for (int it = wg; it < nu; it += nwg) {
        UnitD u;
        if (it < 256) { u.type = 0; u.b = it >> 7; u.hh = (it >> 5) & 3; const int blk = it & 31; u.q0 = blk * 256; u.nloc = 12; u.kbase = min(max(blk * 4 - 4, 0), 116); }
        else if (it < 512) { const int r = it - 256; u.type = 1; u.b = r >> 7; u.hh = (r >> 5) & 3; const int blk = r & 31; u.q0 = blk * 256; u.nloc = 8; u.kbase = blk * 256 - 128; }
        else { const int r = it - 512; u.type = 2 + (r >> 3); u.b = (r >> 2) & 1; u.hh = r & 3; u.q0 = 0; u.nloc = 0; u.kbase = 0; }
        if (ATT_DMA) attn_unit_dma(p, l, u, lds, tid); else attn_unit(p, l, u, lds, tid);
    }
}
}
namespace ssd {
typedef short s16x4 __attribute__((ext_vector_type(4)));
typedef float f32x16 __attribute__((ext_vector_type(16)));
constexpr int NCH = 66;
constexpr size_t WS_ST = WS_YD, WS_HS = WS_YD + 66 * MiB, WS_DEC = 1259 * MiB;
__device__ __forceinline__ int crow(int r, int hi) { return (r & 3) + 8 * (r >> 2) + 4 * hi; }
__device__ __forceinline__ int chunk_row0(int b, int c) { return c < 2 ? T_LAT + b * CTXL + c * 128 : b * SEQL + (c - 2) * 128; }
__device__ __forceinline__ s16x4 ds_tr(unsigned addr) { s16x4 r; asm volatile("ds_read_b64_tr_b16 %0, %1" : "=&v"(r) : "v"(addr) : "memory"); return r; }
struct Raw { s16x4 lo, hi; };
__device__ __forceinline__ Raw raw_tr_nat(unsigned base, int stride, int k0, int idx0, int lane) {
    const int i16 = lane & 15, g16 = (lane >> 4) & 1, hl = lane >> 5;
    const unsigned a = base + (unsigned)((k0 + 8 * hl + (i16 >> 2)) * stride + (idx0 + 16 * g16 + 4 * (i16 & 3)) * 2);
    Raw r; r.lo = ds_tr(a); r.hi = ds_tr(a + 4 * stride); return r;
}
__device__ __forceinline__ Raw raw_tr_acc(unsigned base, int stride, int k0, int idx0, int lane) {
    const int i16 = lane & 15, g16 = (lane >> 4) & 1, hl = lane >> 5;
    const unsigned a = base + (unsigned)((k0 + 4 * hl + (i16 >> 2)) * stride + (idx0 + 16 * g16 + 4 * (i16 & 3)) * 2);
    Raw r; r.lo = ds_tr(a); r.hi = ds_tr(a + 8 * stride); return r;
}
__device__ __forceinline__ void raw_wait2(Raw& a, Raw& b) { asm volatile("s_waitcnt lgkmcnt(0)" : "+v"(a.lo), "+v"(a.hi), "+v"(b.lo), "+v"(b.hi) :: "memory"); }
__device__ __forceinline__ void raw_wait6(Raw& a, Raw& b, Raw& c, Raw& d, Raw& e, Raw& f) {
    asm volatile("s_waitcnt lgkmcnt(0)" : "+v"(a.lo), "+v"(a.hi), "+v"(b.lo), "+v"(b.hi), "+v"(c.lo), "+v"(c.hi), "+v"(d.lo), "+v"(d.hi), "+v"(e.lo), "+v"(e.hi), "+v"(f.lo), "+v"(f.hi) :: "memory"); }
__device__ __forceinline__ bf16x8 join8(const Raw& r) { return (bf16x8){r.lo[0], r.lo[1], r.lo[2], r.lo[3], r.hi[0], r.hi[1], r.hi[2], r.hi[3]}; }
__device__ __forceinline__ unsigned cvtpk(float lo, float hi) { unsigned r; asm volatile("v_cvt_pk_bf16_f32 %0, %1, %2\n\ts_nop 1" : "=v"(r) : "v"(lo), "v"(hi)); return r; }
__device__ __forceinline__ void scan128(float& v0, float& v1, int lane) {
#pragma unroll
    for (int o = 1; o < 64; o <<= 1) { const int src = (lane >= o ? lane - o : lane) << 2;
        const float t0 = __builtin_bit_cast(float, __builtin_amdgcn_ds_bpermute(src, __builtin_bit_cast(int, v0))), t1 = __builtin_bit_cast(float, __builtin_amdgcn_ds_bpermute(src, __builtin_bit_cast(int, v1)));
        if (lane >= o) { v0 += t0; v1 += t1; } }
    v1 += __builtin_bit_cast(float, __builtin_amdgcn_ds_bpermute(63 << 2, __builtin_bit_cast(int, v0)));
}
__device__ __forceinline__ float lane63(float v) { return __builtin_bit_cast(float, __builtin_amdgcn_ds_bpermute(63 << 2, __builtin_bit_cast(int, v))); }

constexpr int BST = 272, XST = 528;
constexpr int S2_B = 0, S2_X = 128 * BST, S2_W = S2_X + 128 * XST, S2_END = S2_W + 8 * 128 * 4;
__device__ __forceinline__ void phase_states(const Prm& p, int l, LAS unsigned char* lds, int wg, int nwg, int tid) {
    const bf16* XA = (const bf16*)(p.ws + WS_XBC); const float* DT = (const float*)(p.ws + WS_DT);
    bf16* ST = (bf16*)(p.ws + WS_ST); float* DEC = (float*)(p.ws + WS_DEC);
    const int wid = __builtin_amdgcn_readfirstlane(tid >> 6), lane = tid & 63, hl = lane >> 5;
    for (int it = wg; it < 2 * NCH * 4; it += nwg) {
        const int b = it / (NCH * 4), rem = it % (NCH * 4), c = rem >> 2, g = (rem >> 1) & 1, hq = rem & 1;
        const int row0 = chunk_row0(b, c), h = 8 * g + 4 * hq + (wid & 3), dir = wid >> 2;
        { v4u tb[4], tx[8];
#pragma unroll
          for (int i = 0; i < 4; ++i) { const int id = tid + 512 * i, r = id >> 4, ch = id & 15; tb[i] = *(const v4u*)(XA + (size_t)(row0 + r) * XBCW + 1024 + g * 128 + ch * 8); }
#pragma unroll
          for (int i = 0; i < 8; ++i) { const int id = tid + 512 * i, r = id >> 5, ch = id & 31; tx[i] = *(const v4u*)(XA + (size_t)(row0 + r) * XBCW + (8 * g + 4 * hq) * 64 + ch * 8); }
#pragma unroll
          for (int i = 0; i < 4; ++i) { const int id = tid + 512 * i, r = id >> 4, ch = id & 15; *(LAS v4u*)(lds + S2_B + r * BST + ch * 16) = tb[i]; }
#pragma unroll
          for (int i = 0; i < 8; ++i) { const int id = tid + 512 * i, r = id >> 5, ch = id & 31; *(LAS v4u*)(lds + S2_X + r * XST + ch * 16) = tx[i]; } }
        const float a = -__expf(p.a_log[l * 32 + dir * 16 + h]);
        const float d0 = DT[(size_t)(row0 + lane) * 32 + dir * 16 + h], d1 = DT[(size_t)(row0 + 64 + lane) * 32 + dir * 16 + h];
        float P0 = a * d0, P1 = a * d1; scan128(P0, P1, lane);
        const float tot = lane63(P1);
        LAS float* wL = (LAS float*)(lds + S2_W) + wid * 128;
        wL[lane] = (dir == 0 ? __expf(tot - P0) : __expf(P0 - a * d0)) * d0;
        wL[64 + lane] = (dir == 0 ? __expf(tot - P1) : __expf(P1 - a * d1)) * d1;
        if (lane == 0) DEC[((b * NCH + c) * 2 + dir) * 16 + h] = __expf(tot);
        __syncthreads();
        f32x16 acc[2][4];
#pragma unroll
        for (int i = 0; i < 2; ++i)
#pragma unroll
            for (int j = 0; j < 4; ++j) acc[i][j] = f32x16{};
        const unsigned bB = (unsigned)(uintptr_t)(lds + S2_B), bX = (unsigned)(uintptr_t)(lds + S2_X);
#pragma unroll 1
        for (int ks = 0; ks < 8; ++ks) {
            const f32x4 w0 = *(const LAS f32x4*)(wL + 16 * ks + 8 * hl), w1 = *(const LAS f32x4*)(wL + 16 * ks + 8 * hl + 4);
            bf16x8 xa[2], bb[4];
            { Raw rx0 = raw_tr_nat(bX, XST, 16 * ks, (wid & 3) * 64, lane), rx1 = raw_tr_nat(bX, XST, 16 * ks, (wid & 3) * 64 + 32, lane);
              Raw rb0 = raw_tr_nat(bB, BST, 16 * ks, 0, lane), rb1 = raw_tr_nat(bB, BST, 16 * ks, 32, lane), rb2 = raw_tr_nat(bB, BST, 16 * ks, 64, lane), rb3 = raw_tr_nat(bB, BST, 16 * ks, 96, lane);
              raw_wait6(rx0, rx1, rb0, rb1, rb2, rb3);
              xa[0] = join8(rx0); xa[1] = join8(rx1); bb[0] = join8(rb0); bb[1] = join8(rb1); bb[2] = join8(rb2); bb[3] = join8(rb3); }
#pragma unroll
            for (int pt = 0; pt < 2; ++pt) {
                v4u q = *reinterpret_cast<v4u*>(&xa[pt]);
                q.x = cvtpk(bflo(q.x) * w0[0], bfhi(q.x) * w0[1]); q.y = cvtpk(bflo(q.y) * w0[2], bfhi(q.y) * w0[3]);
                q.z = cvtpk(bflo(q.z) * w1[0], bfhi(q.z) * w1[1]); q.w = cvtpk(bflo(q.w) * w1[2], bfhi(q.w) * w1[3]);
                xa[pt] = *reinterpret_cast<bf16x8*>(&q); }
#pragma unroll
            for (int pt = 0; pt < 2; ++pt)
#pragma unroll
                for (int nt = 0; nt < 4; ++nt) acc[pt][nt] = __builtin_amdgcn_mfma_f32_32x32x16_bf16(xa[pt], bb[nt], acc[pt][nt], 0, 0, 0);
        }
        bf16* so = ST + ((size_t)((b * NCH + c) * 2 + dir) * 16 + h) * 8192;
#pragma unroll
        for (int pt = 0; pt < 2; ++pt)
#pragma unroll
            for (int nt = 0; nt < 4; ++nt)
#pragma unroll
                for (int r = 0; r < 16; r += 2) {
                    const float x0 = acc[pt][nt][r], x1 = acc[pt][nt][r + 1];
                    const float send = (lane & 1) ? x0 : x1, got = __shfl_xor(send, 1);
                    const unsigned w = (lane & 1) ? pk2(got, x1) : pk2(x0, got);
                    *(unsigned*)(so + (size_t)(pt * 32 + crow(r, hl) + (lane & 1)) * 128 + nt * 32 + ((lane & 31) & ~1)) = w; }
        __syncthreads();
    }
}

__device__ __forceinline__ void phase_scan(const Prm& p, int gtid, int ngt) {
    const bf16* ST = (const bf16*)(p.ws + WS_ST); bf16* HS = (bf16*)(p.ws + WS_HS); const float* DEC = (const float*)(p.ws + WS_DEC);
    for (int e = gtid; e < 2 * 2 * 16 * 2048; e += ngt) {
        const int q = e & 2047, h = (e >> 11) & 15, dir = (e >> 15) & 1, b = e >> 16;
        f32x4 hs = {0.f, 0.f, 0.f, 0.f};
#pragma unroll 6
        for (int i = 0; i < NCH; ++i) {
            const int c = dir == 0 ? i : (i < 2 ? 1 - i : NCH + 1 - i);
            const size_t off = ((size_t)((b * NCH + c) * 2 + dir) * 16 + h) * 8192 + q * 4;
            const v2u sv = *(const v2u*)(ST + off); const float dc = DEC[((b * NCH + c) * 2 + dir) * 16 + h];
            v2u o; o.x = pk2(hs[0], hs[1]); o.y = pk2(hs[2], hs[3]); *(v2u*)(HS + off) = o;
            hs[0] = dc * hs[0] + bflo(sv.x); hs[1] = dc * hs[1] + bfhi(sv.x); hs[2] = dc * hs[2] + bflo(sv.y); hs[3] = dc * hs[3] + bfhi(sv.y);
        }
    }
}

constexpr int CST = 272, XSS = 80;
constexpr size_t WS_Y = WS_XG;
constexpr int S4_B = 0, S4_C = 128 * CST, S4_X = 2 * 128 * CST, S4_ARR = 3 * 128 * CST, S4_YX = S4_ARR + 8 * 2 * 128 * 4, S4_END = S4_YX + 4 * 16 * 64 * 4;
static_assert(S4_END <= RING_BYTES && S2_END <= RING_BYTES && 8 * 32 * XSS <= 128 * CST, "ssd LDS");
__device__ __forceinline__ void phase_ssd_out(const Prm& p, int l, LAS unsigned char* lds, int wg, int nwg, int tid) {
    const bf16* XA = (const bf16*)(p.ws + WS_XBC); const float* DT = (const float*)(p.ws + WS_DT); const bf16* HS = (const bf16*)(p.ws + WS_HS);
    bf16* Y = (bf16*)(p.ws + WS_Y);
    const int wid = __builtin_amdgcn_readfirstlane(tid >> 6), lane = tid & 63, hl = lane >> 5, l31 = lane & 31, pt = (wid >> 1) & 1, dir = wid >> 2;
    const int c_lo = (l == 0) ? 0 : 2, ncu = NCH - c_lo;
    for (int it = wg; it < 2 * ncu * 8; it += nwg) {
        const int b = it / (ncu * 8), rem = it % (ncu * 8), c = c_lo + (rem >> 3), g = (rem >> 2) & 1, hp = rem & 3, h = 8 * g + 2 * hp + (wid & 1);
        const int row0 = chunk_row0(b, c);
        { v4u tb[4], tc[4];
#pragma unroll
          for (int i = 0; i < 4; ++i) { const int id = tid + 512 * i, r = id >> 4, ch = id & 15; const bf16* src = XA + (size_t)(row0 + r) * XBCW + g * 128 + ch * 8; tb[i] = *(const v4u*)(src + 1024); tc[i] = *(const v4u*)(src + 1280); }
#pragma unroll
          for (int i = 0; i < 4; ++i) { const int id = tid + 512 * i, r = id >> 4, ch = id & 15; *(LAS v4u*)(lds + S4_B + r * CST + ch * 16) = tb[i]; *(LAS v4u*)(lds + S4_C + r * CST + ch * 16) = tc[i]; } }
        v4u tx[4];
#pragma unroll
        for (int i = 0; i < 4; ++i) { const int id = tid + 512 * i, r = id >> 4, ch = id & 15; tx[i] = *(const v4u*)(XA + (size_t)(row0 + r) * XBCW + (8 * g + 2 * hp) * 64 + ch * 8); }
        bf16x8 hs[8];
        { const bf16* hp_ = HS + ((size_t)((b * NCH + c) * 2 + dir) * 16 + h) * 8192 + (size_t)(pt * 32 + l31) * 128 + 8 * hl;
#pragma unroll
          for (int ks = 0; ks < 8; ++ks) hs[ks] = *(const bf16x8*)(hp_ + 16 * ks); }
        LAS float* QL = (LAS float*)(lds + S4_ARR) + wid * 256; LAS float* DL = QL + 128;
        float ebase;
        { const float a = -__expf(p.a_log[l * 32 + dir * 16 + h]);
          const float d0 = DT[(size_t)(row0 + lane) * 32 + dir * 16 + h], d1 = DT[(size_t)(row0 + 64 + lane) * 32 + dir * 16 + h];
          float q0 = a * d0, q1 = a * d1; scan128(q0, q1, lane); const float tot = lane63(q1);
          QL[lane] = dir == 0 ? q0 : a * d0 - q0; QL[64 + lane] = dir == 0 ? q1 : a * d1 - q1; DL[lane] = d0; DL[64 + lane] = d1; ebase = dir == 0 ? 0.f : tot; }
        __syncthreads();
#pragma unroll
        for (int j = 0; j < 2; ++j) { const int id = wid * 2 + j, st = id >> 2, tt = id & 3; f32x16 X = f32x16{};
#pragma unroll
            for (int ks = 0; ks < 8; ++ks) { const bf16x8 bfr = *(const LAS bf16x8*)(lds + S4_B + (st * 32 + l31) * CST + (16 * ks + 8 * hl) * 2), cfr = *(const LAS bf16x8*)(lds + S4_C + (tt * 32 + l31) * CST + (16 * ks + 8 * hl) * 2);
                X = __builtin_amdgcn_mfma_f32_32x32x16_bf16(bfr, cfr, X, 0, 0, 0); }
#pragma unroll
            for (int i = 0; i < 4; ++i) { v2u w; w.x = pk2(X[4 * i], X[4 * i + 1]); w.y = pk2(X[4 * i + 2], X[4 * i + 3]);
                *(LAS v2u*)(lds + S4_X + (tt * 32 + l31) * CST + (st * 32 + 8 * i + 4 * hl) * 2) = w; } }
        __syncthreads();
        bf16x8 xf[8];
        {
#pragma unroll
          for (int i = 0; i < 4; ++i) { const int id = tid + 512 * i, r = id >> 4, ch = id & 15; *(LAS v4u*)(lds + S4_B + r * CST + ch * 16) = tx[i]; }
          __syncthreads();
          const unsigned bXs = (unsigned)(uintptr_t)(lds + S4_B); const int c0 = (wid & 1) * 64 + pt * 32;
#pragma unroll
          for (int q = 0; q < 4; ++q) { Raw r0 = raw_tr_acc(bXs, CST, 32 * q, c0, lane), r1 = raw_tr_acc(bXs, CST, 32 * q + 16, c0, lane); raw_wait2(r0, r1); xf[2 * q] = join8(r0); xf[2 * q + 1] = join8(r1); }
        }
        const float dsum = p.d_skip[l * 32 + h] + p.d_skip[l * 32 + 16 + h];
        LAS float* YX = (LAS float*)(lds + S4_YX) + (wid & 3) * 1024;
#pragma unroll 1
        for (int tt = 0; tt < 4; ++tt) {
            const int tl = tt * 32 + l31;
            const float Qt = QL[tl];
            f32x16 yacc = f32x16{};
#pragma unroll
            for (int st = 0; st < 4; ++st) {
                if (dir == 0 ? (st > tt) : (st < tt)) continue;
                __builtin_amdgcn_sched_barrier(0);
                float mv[16];
#pragma unroll
                for (int i = 0; i < 4; ++i) { const v2u w = *(const LAS v2u*)(lds + S4_X + tl * CST + (st * 32 + 8 * i + 4 * hl) * 2);
                    const f32x4 qv = *(const LAS f32x4*)(QL + st * 32 + 8 * i + 4 * hl), dv = *(const LAS f32x4*)(DL + st * 32 + 8 * i + 4 * hl);
                    const float xv[4] = {bflo(w.x), bfhi(w.x), bflo(w.y), bfhi(w.y)};
#pragma unroll
                    for (int j = 0; j < 4; ++j) { const int s = st * 32 + 8 * i + 4 * hl + j; const bool ok = dir == 0 ? (s <= tl) : (s >= tl);
                        mv[4 * i + j] = ok ? __expf(Qt - qv[j]) * dv[j] * xv[j] : 0.f; } }
#pragma unroll
                for (int s2 = 0; s2 < 2; ++s2) { v4u q; q.x = cvtpk(mv[8 * s2 + 0], mv[8 * s2 + 1]); q.y = cvtpk(mv[8 * s2 + 2], mv[8 * s2 + 3]); q.z = cvtpk(mv[8 * s2 + 4], mv[8 * s2 + 5]); q.w = cvtpk(mv[8 * s2 + 6], mv[8 * s2 + 7]);
                    yacc = __builtin_amdgcn_mfma_f32_32x32x16_bf16(xf[2 * st + s2], *reinterpret_cast<bf16x8*>(&q), yacc, 0, 0, 0); }
            }
            __builtin_amdgcn_sched_barrier(0);
            { const LAS unsigned char* cfp = lds + S4_C + tl * CST + 16 * hl; f32x16 G = f32x16{};
#pragma unroll
              for (int ks = 0; ks < 8; ++ks) G = __builtin_amdgcn_mfma_f32_32x32x16_bf16(hs[ks], *(const LAS bf16x8*)(cfp + 32 * ks), G, 0, 0, 0);
              const float e = __expf(ebase + Qt);
#pragma unroll
              for (int r = 0; r < 16; ++r) yacc[r] += e * G[r]; }
            if (dir == 1) {
#pragma unroll
                for (int r = 0; r < 16; ++r) YX[r * 64 + lane] = yacc[r]; }
            __syncthreads();
            if (dir == 0) {
                const size_t trow = (size_t)(row0 + tl);
#pragma unroll
                for (int i = 0; i < 4; ++i) { const int pc = h * 64 + pt * 32 + 8 * i + 4 * hl; const v2u xw = *(const v2u*)(XA + trow * XBCW + pc);
                    f32x4 o; o[0] = yacc[4 * i] + YX[(4 * i) * 64 + lane] + dsum * bflo(xw.x); o[1] = yacc[4 * i + 1] + YX[(4 * i + 1) * 64 + lane] + dsum * bfhi(xw.x);
                    o[2] = yacc[4 * i + 2] + YX[(4 * i + 2) * 64 + lane] + dsum * bflo(xw.y); o[3] = yacc[4 * i + 3] + YX[(4 * i + 3) * 64 + lane] + dsum * bfhi(xw.y);
                    v2u w; w.x = pk2(o[0], o[1]); w.y = pk2(o[2], o[3]); *(v2u*)(Y + trow * 1024 + pc) = w; } }
            __syncthreads();
        }
    }
}
}
__device__ __forceinline__ void phase_norm2_router(const Prm& p, int l, LAS unsigned char* lds, int wg, int nwg, int tid, int wave, int lane) {
    bf16* H = (bf16*)(p.ws + WS_H); const bf16* WR = (const bf16*)(p.ws + WS_WRT);
    const int ntok = (l == 0) ? T_ALL : T_LAT;
    constexpr int HROW = 4096 + 16;
    LAS unsigned char* hfL = lds; LAS float* part = (LAS float*)(lds + 66048); LAS float* affL = (LAS float*)(lds + 66048 + 16384);
    int* tok_e = (int*)(p.ws + WS_TOK); int* tok_pos = (int*)(p.ws + WS_TOK + TOKTAB); float* tok_gate = (float*)(p.ws + WS_TOK + 2 * TOKTAB);
    unsigned* cnt = (unsigned*)(p.ws + OFF_CNT) + l * 32 * 16;
    for (int it = wg; it < ntok / 16; it += nwg) {
        const int m0 = it * 16;
#pragma unroll
        for (int rr = 0; rr < 2; ++rr) {
            const int r = wave * 2 + rr, m = m0 + r;
            f32x4 v[8]; load_row(p, 1, -1, m, lane, v);
            const float rstd = row_rstd(v);
            const int vs = m >= T_LAT ? 2 : (m >> 13);
            const float* md = (const float*)(p.ws + OFF_MOD) + (size_t)(l * 3 + vs) * MODW;
#pragma unroll
            for (int j = 0; j < 8; ++j) { const int col = 256 * j + 4 * lane; const f32x4 o = modulate4f(v[j], rstd, p.norm_ffn + l * DM, md + 4 * DM, md + 3 * DM, col);
                v2u w; w.x = pk2(o[0], o[1]); w.y = pk2(o[2], o[3]);
                *(unsigned*)((unsigned char*)H + (size_t)m * DM + col) = pack4f8(o[0], o[1], o[2], o[3]);
                *(LAS v2u*)(hfL + r * HROW + col * 2) = w; }
        }
        __syncthreads();
        {
            f32x4 a0 = {0.f, 0.f, 0.f, 0.f}, a1 = a0; const int fr = lane & 15, fq = lane >> 4;
#pragma unroll
            for (int ks = 0; ks < 8; ++ks) { const int k0 = wave * 256 + ks * 32 + 8 * fq;
                const bf16x8 af = *(const LAS bf16x8*)(hfL + fr * HROW + k0 * 2);
                const bf16x8 b0 = *(const bf16x8*)(WR + (size_t)fr * DM + k0), b1 = *(const bf16x8*)(WR + (size_t)(16 + fr) * DM + k0);
                a0 = __builtin_amdgcn_mfma_f32_16x16x32_bf16(af, b0, a0, 0, 0, 0); a1 = __builtin_amdgcn_mfma_f32_16x16x32_bf16(af, b1, a1, 0, 0, 0); }
#pragma unroll
            for (int i = 0; i < 4; ++i) { part[(wave * 16 + 4 * fq + i) * 32 + fr] = a0[i]; part[(wave * 16 + 4 * fq + i) * 32 + 16 + fr] = a1[i]; }
        }
        __syncthreads();
        { float s = 0.f;
#pragma unroll
          for (int w = 0; w < 8; ++w) s += part[w * 512 + tid];
          affL[tid] = sigmoid_f(s); }
        __syncthreads();
        if (tid < 16) {
            const LAS float* af = affL + tid * 32; const int m = m0 + tid;
            int bg = 0; float bs = -INFINITY;
#pragma unroll
            for (int g = 0; g < 4; ++g) { float t1 = -INFINITY, t2 = -INFINITY;
#pragma unroll
                for (int j = 0; j < 8; ++j) { const float s = af[8 * g + j] + p.router_bias[8 * g + j]; if (s > t1) { t2 = t1; t1 = s; } else if (s > t2) t2 = s; }
                const float gs = t1 + t2; if (gs > bs) { bs = gs; bg = g; } }
            float t1 = -INFINITY, t2 = -INFINITY; int i1 = 0, i2 = 0;
#pragma unroll
            for (int j = 0; j < 8; ++j) { const float s = af[8 * bg + j] + p.router_bias[8 * bg + j]; if (s > t1) { t2 = t1; i2 = i1; t1 = s; i1 = j; } else if (s > t2) { t2 = s; i2 = j; } }
            const int e0 = 8 * bg + i1, e1 = 8 * bg + i2; const float f0 = af[e0], f1 = af[e1], inv = 1.f / (f0 + f1);
            const unsigned p0 = atomicAdd(cnt + e0 * 16, 1u), p1 = atomicAdd(cnt + e1 * 16, 1u);
            int* list = (int*)(p.ws + WS_LIST); list[(size_t)e0 * LCAP + p0] = m; list[(size_t)e1 * LCAP + p1] = m;
            tok_e[2 * m] = e0; tok_e[2 * m + 1] = e1; tok_pos[2 * m] = (int)p0; tok_pos[2 * m + 1] = (int)p1; tok_gate[2 * m] = f0 * inv; tok_gate[2 * m + 1] = f1 * inv;
        }
        __syncthreads();
    }
}
__device__ __forceinline__ void build_seg_tables(const Prm& p, int l, LAS unsigned char* lds, int tid) {
    LAS int* seg = (LAS int*)(lds + L_SEG); LAS int* cntL = (LAS int*)(lds + L_CNT); LAS int* blke = (LAS int*)(lds + L_BLKE); LAS int* nblkp = (LAS int*)(lds + L_NBLK);
    LAS int* incl = (LAS int*)(lds + L_INCL);
    const unsigned* cnt = (const unsigned*)(p.ws + OFF_CNT) + l * 32 * 16;
    __syncthreads();
    LAS int* pbL = (LAS int*)(lds + L_PB);
    if (tid < 32) { const int c = (int)cnt[tid * 16]; cntL[tid] = c; pbL[tid] = (c + 255) >> 8; }
    __syncthreads();
    if (tid < 32) { int inc = 0;
#pragma unroll
        for (int k = 0; k < 32; ++k) inc += (k <= tid) ? pbL[k] : 0;
        seg[tid] = (inc - pbL[tid]) * 256; incl[tid] = inc; if (tid == 31) { seg[32] = inc * 256; *nblkp = inc; } }
    __syncthreads();
    if (tid < MAXBLK + 3) { int e = 0;
#pragma unroll
        for (int k = 0; k < 32; ++k) e += (incl[k] <= tid) ? 1 : 0;
        e = e < 31 ? e : 31; blke[tid] = e; ((LAS int*)(lds + L_BLKH))[tid] = (cntL[e] - 256 * (tid - (seg[e] >> 8)) <= 128) ? 1 : 0; }
    __syncthreads();
}
template <class Sched>
__device__ __forceinline__ void build_row_table(const Prm& p, const Sched& S, LAS unsigned char* lds, int tid) {
    const LAS int* seg = (const LAS int*)(lds + L_SEG); const LAS int* cntL = (const LAS int*)(lds + L_CNT); const LAS int* blke = (const LAS int*)(lds + L_BLKE);
    LAS unsigned* T = (LAS unsigned*)(lds + L_ROWT); const int* list = (const int*)(p.ws + WS_LIST);
#pragma unroll 1
    for (int i = 0; i < 8; ++i) { pg8::Unit u; if (!S.next(i, u)) break;
        const int e = blke[u.pm], base = (u.pm - (seg[e] >> 8)) * 256;
        if (tid < 256) { const int pos = base + tid; T[i * 256 + tid] = pos < cntL[e] ? (unsigned)WS_H + (unsigned)list[(size_t)e * LCAP + pos] * 2048u : ZERO_OFF; } }
    __syncthreads();
}
#ifndef SKIP_GU
#define SKIP_GU true
#endif
#ifndef SKIP_DN
#define SKIP_DN true
#endif
#ifndef NCONV
#define NCONV 16
#endif
constexpr int N_PHASES = 24;
__global__ void __launch_bounds__(NWAVES * 64, 2) mk_fwd(Prm p) {
    extern __shared__ __attribute__((aligned(16))) unsigned char lds_raw[];
    LAS unsigned char* lds = (LAS unsigned char*)lds_raw;
    const int tid0 = threadIdx.x, wave = __builtin_amdgcn_readfirstlane(tid0 >> 6);
#define OPQ int tid = tid0; asm volatile("" : "+v"(tid)); const int lane = tid & 63;
    const int G = gridDim.x, bx = blockIdx.x, vcu = (G % 8 == 0) ? (bx % 8) * (G / 8) + bx / 8 : bx;
    const int gw = vcu * NWAVES + wave, ngw = G * NWAVES;
    unsigned char* ws = p.ws;
    for (int u = tid0; u < (LDS_BYTES - LDSCTL_OFF) / 4; u += NWAVES * 64) ((LAS unsigned*)(lds + LDSCTL_OFF))[u] = 0u;
    __syncthreads();
#if MK_ONE_LAUNCH
    XcdBarrier bar = xcd_barrier_post((unsigned*)ws + CW_BAR, (volatile LAS unsigned*)(lds + L_BARW));
#define GRID_BAR() xcd_barrier(bar)
#define GRID_BAR_W() do { if (CONV_QUEUE) xcd_barrier_work(bar, p, lds, tid0); else xcd_barrier(bar); } while (0)
#else
#define GRID_BAR() do {} while (0)
#define GRID_BAR_W() do {} while (0)
#endif
#define WORKERS(units) ((CONV_QUEUE && MK_ONE_LAUNCH) ? (((units) + (((units) + G - 1) / G) - 1) / (((units) + G - 1) / G)) : G)
    const int lo = p.ph_lo, hi = p.ph_hi;
#define IN(k) (lo <= (k) && (k) < hi)
#ifndef DUPMASK
#define DUPMASK 0
#endif
#define REPS(kind) for (int rep_ = 0; rep_ < (((DUPMASK) >> (kind)) & 1) + 1; ++rep_)
    if (IN(0)) REPS(0) { OPQ phase_prologue(p, lds, gw, ngw, wave, lane, rep_ == 0); GRID_BAR(); }
    for (int l = 0; l < 2; ++l) {
        const int pb = 1 + 11 * l;
        if (IN(pb + 0)) { OPQ if (l > 0) { if (CONV_QUEUE) queue_drain(p, lds, tid, (unsigned)(Q_L0 + NP_PROJ));     build_seg_tables(p, l - 1, lds, tid); row_stream<true, false, false>(p, l, l - 1, T_ALL, gw, ngw, tid, lane, lds, (const LAS int*)(lds + L_SEG)); } else row_stream<false, false, true>(p, l, 0, T_ALL, gw, ngw, tid, lane, lds, (const LAS int*)(lds + L_SEG)); GRID_BAR_W(); }
        if (IN(pb + 1)) REPS(2) {
            pg8::Gemm g{(const pg8::bf16_t*)(ws + WS_H), (const pg8::bf16_t*)(ws + WS_WIN + (size_t)l * NINP * DM * (F8_INPROJ ? 1 : 2)), T_ALL, NINP, F8_INPROJ ? DM / 2 : DM};
            const int Ge = WORKERS((T_ALL / 256) * (NINP / 256));
            pg8::StaticOrder S; S.init(T_ALL, NINP, Ge, bx);
            pg8::EpiInProj E{(pg8::bf16_t*)(ws + WS_U), NINP, (const float*)(ws + WS_ROPE), C_QB / 256, C_VB / 256, T_LAT, F8_INPROJ ? 1.f / W8_SCALE : 1.f};
            if (bx < Ge) pg8::gemm_phase<pg8::EpiInProj, pg8::StaticOrder, true, true, F8_INPROJ != 0>(lds, g, S, E);
            GRID_BAR_W();
        }
        if (IN(pb + 2)) REPS(3) { OPQ
            if ((bx >> 3) & 1) { att::phase_attn(p, l, lds, bx, G, tid); phase_conv(p, l, gw, ngw, lane); } else { phase_conv(p, l, gw, ngw, lane); att::phase_attn(p, l, lds, bx, G, tid); } GRID_BAR_W(); }
        if (IN(pb + 3)) REPS(4) { OPQ { const int Ge = WORKERS(2 * ssd::NCH * 4); if (bx < Ge) ssd::phase_states(p, l, lds, bx, Ge, tid); } GRID_BAR_W(); }
        if (IN(pb + 4)) REPS(5) { OPQ ssd::phase_scan(p, bx * (NWAVES * 64) + tid, G * NWAVES * 64); GRID_BAR_W(); }
        if (IN(pb + 5)) REPS(6) { OPQ { const int Ge = WORKERS(2 * (ssd::NCH - (l == 0 ? 0 : 2)) * 8); if (bx < Ge) ssd::phase_ssd_out(p, l, lds, bx, Ge, tid); } GRID_BAR_W(); }
        if (IN(pb + 6)) REPS(7) { OPQ phase_gnorm(p, l, gw, ngw, lane); GRID_BAR_W(); }
        if (IN(pb + 7)) {
            const int M = (l == 0) ? T_ALL : T_LAT;
            pg8::Gemm g{(const pg8::bf16_t*)(ws + WS_H), (const pg8::bf16_t*)(ws + WS_WOUT + (size_t)l * DM * DM * (F8_OUTPROJ ? 1 : 2)), M, DM, F8_OUTPROJ ? DM / 2 : DM};
            const int Ge = WORKERS((M / 256) * (DM / 256));
            pg8::StaticOrder S; S.init(M, DM, Ge, bx);
            pg8::EpiRes E{(l == 0) ? (const void*)p.x : (const void*)(ws + WS_X), (pg8::bf16_t*)(ws + WS_X), (l == 0) ? (const void*)p.ctx : (const void*)(ws + WS_XC), (pg8::bf16_t*)(ws + WS_XC),
                          (const float*)(ws + OFF_MOD) + (size_t)l * 3 * MODW + 2 * DM, DM, T_LAT, MODW, F8_OUTPROJ ? 1.f / (W8_SCALE * MIX_SCALE) : 1.f, l == 0 ? 1 : 0};
            if (bx < Ge) pg8::gemm_phase<pg8::EpiRes, pg8::StaticOrder, true, true, F8_OUTPROJ != 0>(lds, g, S, E);
            GRID_BAR_W();
        }
        if (IN(pb + 8)) { OPQ phase_norm2_router(p, l, lds, bx, G, tid, wave, lane); GRID_BAR_W(); }
        if (IN(pb + 9) && CONV_QUEUE && (l == 1 || Q_L0EXP)) { OPQ queue_drain(p, lds, tid, (unsigned)(l == 1 ? Q_TOTAL : Q_L0)); GRID_BAR(); }
        if (IN(pb + 9)) REPS(11) {
            OPQ build_seg_tables(p, l, lds, tid);
            const int nblk = __builtin_amdgcn_readfirstlane(*(const LAS int*)(lds + L_NBLK));
            pg8::Gemm g{(const pg8::bf16_t*)ws, (const pg8::bf16_t*)(ws + WS_WGU + (size_t)l * 32 * 2048 * 2048), nblk * 256, 2048, DM / 2};
            pg8::GroupedOrderT<SKIP_GU, true> S{G, vcu, nblk, (const LAS int*)(lds + L_BLKE), (const LAS int*)(lds + L_BLKH), (long)2048 * 2048, (const LAS unsigned*)(lds + L_ROWT)};
            build_row_table(p, S, lds, tid);
            pg8::EpiGateUp E{ws + WS_ACT, DFF, 1.f / W8_SCALE};
            pg8::gemm_phase<pg8::EpiGateUp, pg8::GroupedOrderT<SKIP_GU, true>, true, true, true>(lds, g, S, E);
            GRID_BAR_W();
        }
        if (IN(pb + 10)) REPS(12) {
            OPQ build_seg_tables(p, l, lds, tid);
            const int nblk = __builtin_amdgcn_readfirstlane(*(const LAS int*)(lds + L_NBLK));
            pg8::Gemm g{(const pg8::bf16_t*)(ws + WS_ACT), (const pg8::bf16_t*)(ws + WS_WDN + (size_t)l * 32 * 2048 * 1024), nblk * 256, DM, DFF / 2};
            pg8::GroupedOrderT<SKIP_DN> S{G, vcu, nblk, (const LAS int*)(lds + L_BLKE), (const LAS int*)(lds + L_BLKH), (long)2048 * 1024, nullptr};
            pg8::EpiF8 E{ws + WS_YB, DM, Y8_SCALE / W8_SCALE};
            pg8::gemm_phase<pg8::EpiF8, pg8::GroupedOrderT<SKIP_DN>, true, true, true>(lds, g, S, E);
            GRID_BAR_W();
        }
    }
    if (IN(23)) { OPQ build_seg_tables(p, 1, lds, tid); row_stream<true, true, false>(p, 1, 1, T_LAT, gw, ngw, tid, lane, lds, (const LAS int*)(lds + L_SEG)); }
#undef IN
}

extern "C" void kernel_launch(void* const* d_in, const int* in_sizes, int n_in, void* d_out, int out_size, void* d_ws, size_t ws_size, hipStream_t stream) {
    static int grid = 0;
    if (grid == 0) {
        if (n_in != 24 || in_sizes[0] != T_LAT * DM || out_size != T_LAT * DM || ws_size < WS_END) {
            fprintf(stderr, "kernel_launch: unexpected shapes: n_in %d in0 %d out %d ws %zu (need %zu)\n", n_in, n_in > 0 ? in_sizes[0] : -1, out_size, ws_size, (size_t)WS_END); grid = -1; return; }
        int dev = 0, cus = 0, per_cu = 0;
        if (hipGetDevice(&dev) != hipSuccess || hipDeviceGetAttribute(&cus, hipDeviceAttributeMultiprocessorCount, dev) != hipSuccess) { grid = -1; return; }
        if (hipFuncSetAttribute((const void*)mk_fwd, hipFuncAttributeMaxDynamicSharedMemorySize, LDS_BYTES) != hipSuccess) { fprintf(stderr, "kernel_launch: hipFuncSetAttribute failed\n"); grid = -1; return; }
        if (hipOccupancyMaxActiveBlocksPerMultiprocessor(&per_cu, (const void*)mk_fwd, NWAVES * 64, LDS_BYTES) != hipSuccess || per_cu < 1) {
            fprintf(stderr, "kernel_launch: occupancy query reports %d blocks per CU\n", per_cu); }
        (void)hipGetLastError();
        grid = cus;
    }
    if (grid < 0) return;
    if (hipMemsetAsync((char*)d_ws + WS_CTL, 0, CTL_ZERO_BYTES, stream) != hipSuccess) { fprintf(stderr, "kernel_launch: memset failed\n"); return; }
    Prm p{};
    p.x = (const float*)d_in[0]; p.c = (const float*)d_in[1]; p.ctx = (const float*)d_in[2]; p.c_ctx = (const float*)d_in[3]; p.w_ada = (const float*)d_in[4]; p.b_ada = (const float*)d_in[5];
    p.norm_mix = (const float*)d_in[6]; p.norm_ffn = (const float*)d_in[7]; p.norm_final = (const float*)d_in[8]; p.w_in = (const float*)d_in[9]; p.w_out = (const float*)d_in[10];
    p.na_rpb = (const float*)d_in[11]; p.wa_sink = (const float*)d_in[12]; p.conv_w = (const float*)d_in[13]; p.conv_b = (const float*)d_in[14]; p.a_log = (const float*)d_in[15];
    p.dt_bias = (const float*)d_in[16]; p.d_skip = (const float*)d_in[17]; p.ssd_norm = (const float*)d_in[18]; p.w_router = (const float*)d_in[19]; p.router_bias = (const float*)d_in[20];
    p.w_gate = (const float*)d_in[21]; p.w_up = (const float*)d_in[22]; p.w_down = (const float*)d_in[23];
    p.out = (float*)d_out; p.ws = (unsigned char*)d_ws;
#if MK_ONE_LAUNCH
    p.ph_lo = 0; p.ph_hi = N_PHASES;
    hipLaunchKernelGGL(mk_fwd, dim3(grid), dim3(NWAVES * 64), LDS_BYTES, stream, p);
#else
    for (int ph = 0; ph < N_PHASES; ++ph) { p.ph_lo = ph; p.ph_hi = ph + 1; hipLaunchKernelGGL(mk_fwd, dim3(grid), dim3(NWAVES * 64), LDS_BYTES, stream, p); }
#endif
    const hipError_t le = hipPeekAtLastError();
    if (le != hipSuccess) fprintf(stderr, "kernel_launch: launch failed: %s\n", hipGetErrorName(le));
}
```

```cpp
#include <hip/hip_runtime.h>
#include <cstdio>
#include <cstdint>

#ifndef MK_ONE_LAUNCH
#define MK_ONE_LAUNCH 1
#endif

#ifndef F8_INPROJ
#define F8_INPROJ 1
#endif
#ifndef F8_OUTPROJ
#define F8_OUTPROJ 1
#endif

namespace pg8 {
#define PG8_LAS __attribute__((address_space(3)))
typedef unsigned short bf16_t;
typedef short bf16x8 __attribute__((ext_vector_type(8)));
typedef float f32x4 __attribute__((ext_vector_type(4)));
typedef unsigned u32x4 __attribute__((ext_vector_type(4)));
constexpr int BM = 256, BK = 64, HALF = 128, HTB = HALF * BK * 2  , STAGE_BYTES = 8 * HTB, NXCD = 8, WGM = 6;

__host__ __device__ __forceinline__ int lds_byte(int r, int c) { const int st = (r >> 4) * 2 + (c >> 5), rr = r & 15, cc = c & 31, ob = rr * 64 + cc * 2; return st * 1024 + (ob ^ (((ob >> 9) & 1) << 5)); }
__host__ __device__ __forceinline__ void stage_rc(int b, int& R, int& C) { const int st = b / 1024, sb = b % 1024, swz = sb ^ (((sb >> 9) & 1) << 5); R = (st >> 1) * 16 + swz / 64; C = (st & 1) * 32 + (swz % 64) / 2; }
__host__ __device__ __forceinline__ int perm32(int rho) { const int n = rho >> 4, i = rho & 15; return 8 * (i >> 2) + 4 * n + (i & 3); }

typedef int i32x4v __attribute__((ext_vector_type(4)));
typedef int i32x8v __attribute__((ext_vector_type(8)));
__device__ __forceinline__ i32x8v cat8(bf16x8 a, bf16x8 b) { const i32x4v x = __builtin_bit_cast(i32x4v, a), y = __builtin_bit_cast(i32x4v, b); return __builtin_shufflevector(x, y, 0, 1, 2, 3, 4, 5, 6, 7); }
struct Unit { int pm, pn; long boff; int lo_only; };
struct Gemm { const bf16_t* A; const bf16_t* Bt; int M, N, K; };

struct StaticOrder {
    static constexpr bool SKIP_HI = false, GATHER = false, B_NT = false; const PG8_LAS unsigned* rowtab;
    int nM, nN, nwg, G, c;
    __host__ __device__ void init(int M, int N, int G_, int c_) { nM = M / BM; nN = N / BM; nwg = nM * nN; G = G_; c = c_; }
    __host__ __device__ bool next(int i, Unit& u) const {
        const long L = (long)i * G + c; if (L >= nwg) return false;
        int wgid = (int)L; { const int q = nwg / NXCD, r = nwg % NXCD, xcd = wgid % NXCD, off = wgid / NXCD; wgid = (xcd < r ? xcd * (q + 1) : r * (q + 1) + (xcd - r) * q) + off; }
        const int nig = WGM * nN, gid = wgid / nig, fm = gid * WGM, gsz = (nM - fm) < WGM ? (nM - fm) : WGM;
        u.pm = fm + ((wgid % nig) % gsz); u.pn = (wgid % nig) / gsz; u.boff = 0; u.lo_only = 0; return true;
    }
    __device__ __forceinline__ void a_ready(const Unit&) const {}
    __device__ __forceinline__ void done(const Unit&) const {}
};

__device__ __forceinline__ unsigned cvt_pk_bf16(float lo, float hi) { unsigned r; asm volatile("v_cvt_pk_bf16_f32 %0, %1, %2" : "=v"(r) : "v"(lo), "v"(hi)); return r; }
typedef float f32x2 __attribute__((ext_vector_type(2)));
__device__ __forceinline__ f32x2 gelu_pk(f32x2 v) {
    const f32x2 av = __builtin_elementwise_abs(v), d = av * 0.2316418882f + 1.0f;
    f32x2 t; t.x = __builtin_amdgcn_rcpf(d.x); t.y = __builtin_amdgcn_rcpf(d.y);
    f32x2 q = t * 0.5307027145f + (-0.7265760135f); q = q * t + 0.7107068705f; q = q * t + (-0.142248368f); q = q * t + 0.127414796f; q = q * t;
    const f32x2 s = (v * v) * (-0.72134752044f);
    f32x2 e; e.x = __builtin_amdgcn_exp2f(s.x); e.y = __builtin_amdgcn_exp2f(s.y);
    const f32x2 m = v * (q * e), r = v - m;
    f32x2 o; o.x = v.x < 0.f ? m.x : r.x; o.y = v.y < 0.f ? m.y : r.y; return o;
}

template <class Epi, class Sched, bool ALIGN_EPI = false, bool SP2 = false, bool F8 = false>
__device__ __forceinline__ void gemm_phase(PG8_LAS unsigned char* lds, const Gemm g, const Sched& S, const Epi& E) {
    int tid_o = threadIdx.x; asm volatile("" : "+v"(tid_o));
    const int tid = tid_o, wid = __builtin_amdgcn_readfirstlane(tid >> 6), lane = tid & 63, wr = wid >> 2, wc = wid & 3, fr = lane & 15, fq = lane >> 4;
    const int K = g.K, nt = K / BK;
    unsigned voffA[2], voffB[2];
#pragma unroll
    for (int i = 0; i < 2; ++i) { int R, C; stage_rc(tid * 16 + i * 8192, R, C); const int r32_ = Epi::PERM ? perm32(R & 31) : (R & 31); const int Rb = Epi::ADJ ? ((R >> 5) * 64 + r32_) : ((R & ~31) + r32_);
        voffA[i] = (unsigned)(R * K + C) * 2u; voffB[i] = (unsigned)(Rb * K + C) * 2u; }
    int gR[2]; unsigned gC[2];
#pragma unroll
    for (int i = 0; i < 2; ++i) { int R, C; stage_rc(tid * 16 + i * 8192, R, C); gR[i] = R; gC[i] = (unsigned)C * 2u; }
    unsigned gc[2][2] = {{0u, 0u}, {0u, 0u}}, gn[2][2] = {{0u, 0u}, {0u, 0u}};
#define PG8_GROWS(dst, u) do { if constexpr (Sched::GATHER) { _Pragma("unroll") for (int h_ = 0; h_ < 2; ++h_) _Pragma("unroll") for (int i_ = 0; i_ < 2; ++i_) dst[h_][i_] = S.rowtab[(u) * 256 + h_ * 128 + gR[i_]] + gC[i_]; } } while (0)
#define PG8_STAGE_A(bufoff, kbase, h, nx) do { if constexpr (Sched::GATHER) { _Pragma("unroll") for (int _i = 0; _i < 2; ++_i) \
        __builtin_amdgcn_global_load_lds((const unsigned*)((const char*)(kbase) + ((nx) ? gn[h][_i] : gc[h][_i])), (PG8_LAS unsigned*)(lds + (bufoff) + ldsw + _i * 8192), 16, 0, 0); } \
        else PG8_STAGE(bufoff, (kbase) + ((h) ? hstep : 0), voffA); } while (0)
    const size_t kstep = (size_t)(BK * 2);
    const size_t hstep = (size_t)HALF * K * 2;
    const size_t hstepB = Epi::ADJ ? (size_t)32 * K * 2 : hstep;
    const size_t tstep = 2 * hstep;
    const unsigned ldsw = (unsigned)wid * 1024u;
    const int aoff = lds_byte(wr * 64 + fr, fq * 8), boff = lds_byte(wc * 32 + fr, fq * 8);
    const int aoff8 = lds_byte(wr * 64 + fr, (fq & 1) * 16) + (fq >> 1) * 1024, boff8 = lds_byte(wc * 32 + fr, (fq & 1) * 16) + (fq >> 1) * 1024;
    const int hsw8 = (fq & 1) * 16, aoff8a = aoff8 + hsw8, aoff8b = aoff8 + 16 - hsw8, boff8a = boff8 + hsw8, boff8b = boff8 + 16 - hsw8;
#define PG8_SA(b, h) (((b) * 2 + (h)) * HTB)
#define PG8_SB(b, h) ((4 + (b) * 2 + (h)) * HTB)
#define PG8_STAGE(bufoff, gbase, voff) do { _Pragma("unroll") for (int _i = 0; _i < 2; ++_i) \
        __builtin_amdgcn_global_load_lds((const unsigned*)((const char*)(gbase) + (voff)[_i]), (PG8_LAS unsigned*)(lds + (bufoff) + ldsw + _i * 8192), 16, 0, 0); } while (0)
#define PG8_STAGE_B(bufoff, gbase, voff) do { _Pragma("unroll") for (int _i = 0; _i < 2; ++_i) \
        __builtin_amdgcn_global_load_lds((const unsigned*)((const char*)(gbase) + (voff)[_i]), (PG8_LAS unsigned*)(lds + (bufoff) + ldsw + _i * 8192), 16, 0, Sched::B_NT ? 2 : 0); } while (0)
#define PG8_LDA(dst, b, h) do { if constexpr (F8) { _Pragma("unroll") for (int m = 0; m < 4; ++m) dst##8[m] = cat8(*(const PG8_LAS bf16x8*)(lds + PG8_SA(b, h) + aoff8a + m * 2048), *(const PG8_LAS bf16x8*)(lds + PG8_SA(b, h) + aoff8b + m * 2048)); } else { \
        _Pragma("unroll") for (int m = 0; m < 4; ++m) _Pragma("unroll") for (int k = 0; k < 2; ++k) dst[m][k] = *(const PG8_LAS bf16x8*)(lds + PG8_SA(b, h) + aoff + m * 2048 + k * 1024); } } while (0)
#define PG8_LDB(dst, b, h) do { if constexpr (F8) { _Pragma("unroll") for (int n = 0; n < 2; ++n) dst##8[n] = cat8(*(const PG8_LAS bf16x8*)(lds + PG8_SB(b, h) + boff8a + n * 2048), *(const PG8_LAS bf16x8*)(lds + PG8_SB(b, h) + boff8b + n * 2048)); } else { \
        _Pragma("unroll") for (int n = 0; n < 2; ++n) _Pragma("unroll") for (int k = 0; k < 2; ++k) dst[n][k] = *(const PG8_LAS bf16x8*)(lds + PG8_SB(b, h) + boff + n * 2048 + k * 1024); } } while (0)
#define PG8_MMA(ai, bj, At, Bt) do { __builtin_amdgcn_s_setprio(1); if constexpr (F8) { _Pragma("unroll") for (int m = 0; m < 4; ++m) _Pragma("unroll") for (int n = 0; n < 2; ++n) \
        asm volatile("v_mfma_scale_f32_16x16x128_f8f6f4 %0, %1, %2, %0, %3, %3 op_sel_hi:[0,0,0]" : "+v"(acc[ai][bj][m][n]) : "v"(Bt##8[n]), "v"(At##8[m]), "v"(sc1)); } else { \
        _Pragma("unroll") for (int m = 0; m < 4; ++m) _Pragma("unroll") for (int n = 0; n < 2; ++n) _Pragma("unroll") for (int k = 0; k < 2; ++k) \
        acc[ai][bj][m][n] = __builtin_amdgcn_mfma_f32_16x16x32_bf16(Bt[n][k], At[m][k], acc[ai][bj][m][n], 0, 0, 0); } __builtin_amdgcn_s_setprio(0); } while (0)
#define PG8_WAIT_V(n) asm volatile("s_waitcnt vmcnt(" #n ")" ::: "memory")
#define PG8_WAIT_L(n) asm volatile("s_waitcnt lgkmcnt(" #n ")" ::: "memory")
#define PG8_BAR __builtin_amdgcn_s_barrier()
#define PG8_SCHED __builtin_amdgcn_sched_barrier(0)
    Unit cur, nxt; int ui = 0;
    if (!S.next(0, cur)) return;
    f32x4 acc[2][2][4][2];
#pragma unroll
    for (int a = 0; a < 2; ++a)
#pragma unroll
        for (int b = 0; b < 2; ++b)
#pragma unroll
            for (int m = 0; m < 4; ++m)
#pragma unroll
                for (int n = 0; n < 2; ++n) acc[a][b][m][n] = (f32x4){0.f, 0.f, 0.f, 0.f};
    const int sc1 = 0x7F7F7F7F;
    bf16x8 At[4][2], B0[2][2], B1[2][2]; i32x8v At8[4], B08[2], B18[2];
    const char* cA = (const char*)g.A + (Sched::GATHER ? (size_t)0 : (size_t)cur.pm * tstep); PG8_GROWS(gc, 0); const char* cB = (const char*)g.Bt + (size_t)cur.pn * tstep + cur.boff;
    S.a_ready(cur);
    if constexpr (SP2) {
        PG8_STAGE_B(PG8_SB(0, 0), cB, voffB); PG8_STAGE_B(PG8_SB(0, 1), cB + hstepB, voffB); PG8_STAGE_A(PG8_SA(0, 0), cA, 0, false); PG8_STAGE_A(PG8_SA(0, 1), cA, 1, false);
        if (wr == 1) PG8_BAR;
        PG8_WAIT_V(2); PG8_BAR;
        PG8_STAGE_B(PG8_SB(1, 0), cB + kstep, voffB); PG8_STAGE_A(PG8_SA(1, 0), cA + kstep, 0, false); PG8_STAGE_B(PG8_SB(1, 1), cB + hstepB + kstep, voffB);
        PG8_WAIT_V(6); PG8_BAR;
    } else {
        PG8_STAGE_B(PG8_SB(0, 0), cB, voffB); PG8_STAGE_A(PG8_SA(0, 0), cA, 0, false); PG8_STAGE_B(PG8_SB(0, 1), cB + hstepB, voffB); PG8_STAGE_A(PG8_SA(0, 1), cA, 1, false);
        if (wr == 1) PG8_BAR;
        PG8_WAIT_V(4); PG8_BAR;
        PG8_STAGE_B(PG8_SB(1, 0), cB + kstep, voffB); PG8_STAGE_A(PG8_SA(1, 0), cA + kstep, 0, false); PG8_STAGE_B(PG8_SB(1, 1), cB + hstepB + kstep, voffB);
        PG8_WAIT_V(6); PG8_BAR;
    }
    for (;;) {
        const bool has_next = S.next(ui + 1, nxt);
        const char* nA = has_next ? (const char*)g.A + (Sched::GATHER ? (size_t)0 : (size_t)nxt.pm * tstep) : cA; if (has_next) PG8_GROWS(gn, ui + 1); const char* nB = has_next ? (const char*)g.Bt + (size_t)nxt.pn * tstep + nxt.boff : cB;
        const bool hi_on = !Sched::SKIP_HI || cur.lo_only == 0;
#pragma unroll 1
        for (int t = 0; t < nt; t += 2) {
            const bool last = (t == nt - 2);
            const char* a1 = cA + (size_t)(t + 1) * kstep;
            const char* a2 = last ? nA : cA + (size_t)(t + 2) * kstep; const char* b2 = last ? nB : cB + (size_t)(t + 2) * kstep;
            const char* a3 = a2 + kstep; const char* b3 = b2 + kstep;
            const bool nx_ = last && has_next;
            if (last && has_next) S.a_ready(nxt);
            if constexpr (SP2) {
            PG8_LDB(B0, 0, 0); PG8_LDB(B1, 0, 1); PG8_SCHED; PG8_LDA(At, 0, 0); PG8_STAGE_A(PG8_SA(1, 1), a1, 1, false);
            PG8_WAIT_V(8); PG8_WAIT_L(0); PG8_BAR; PG8_MMA(0, 0, At, B0); PG8_MMA(0, 1, At, B1); PG8_BAR; PG8_SCHED;
            PG8_LDA(At, 0, 1); PG8_STAGE_B(PG8_SB(0, 0), b2, voffB); PG8_STAGE_B(PG8_SB(0, 1), b2 + hstepB, voffB); PG8_STAGE_A(PG8_SA(0, 0), a2, 0, nx_);
            PG8_WAIT_V(8); PG8_WAIT_L(0); PG8_BAR; if (__builtin_expect(hi_on, 1)) { PG8_MMA(1, 0, At, B0); PG8_MMA(1, 1, At, B1); } PG8_BAR; PG8_SCHED;
            PG8_LDB(B0, 1, 0); PG8_LDB(B1, 1, 1); PG8_SCHED; PG8_LDA(At, 1, 0); PG8_STAGE_A(PG8_SA(0, 1), a2, 1, nx_);
            PG8_WAIT_V(8); PG8_WAIT_L(0); PG8_BAR; PG8_MMA(0, 0, At, B0); PG8_MMA(0, 1, At, B1); PG8_BAR; PG8_SCHED;
            PG8_LDA(At, 1, 1); PG8_STAGE_B(PG8_SB(1, 0), b3, voffB); PG8_STAGE_B(PG8_SB(1, 1), b3 + hstepB, voffB); PG8_STAGE_A(PG8_SA(1, 0), a3, 0, nx_);
            PG8_WAIT_V(8); PG8_WAIT_L(0); PG8_BAR; if (__builtin_expect(hi_on, 1)) { PG8_MMA(1, 0, At, B0); PG8_MMA(1, 1, At, B1); } PG8_BAR; PG8_SCHED;
            } else {
            PG8_LDB(B0, 0, 0); PG8_SCHED; PG8_LDA(At, 0, 0); PG8_STAGE_A(PG8_SA(1, 1), a1, 1, false);
            PG8_WAIT_L(8); PG8_BAR; PG8_WAIT_L(0); PG8_MMA(0, 0, At, B0); PG8_BAR; PG8_SCHED;
            PG8_LDB(B1, 0, 1); PG8_STAGE_B(PG8_SB(0, 0), b2, voffB);
            PG8_BAR; PG8_WAIT_L(0); PG8_MMA(0, 1, At, B1); PG8_BAR;
            PG8_LDA(At, 0, 1); PG8_STAGE_A(PG8_SA(0, 0), a2, 0, nx_);
            PG8_BAR; PG8_WAIT_L(0); PG8_MMA(1, 0, At, B0); PG8_BAR; PG8_SCHED;
            PG8_STAGE_B(PG8_SB(0, 1), b2 + hstepB, voffB);
            PG8_WAIT_V(6); PG8_BAR; PG8_MMA(1, 1, At, B1); PG8_BAR;
            PG8_LDB(B0, 1, 0); PG8_SCHED; PG8_LDA(At, 1, 0); PG8_STAGE_A(PG8_SA(0, 1), a2, 1, nx_);
            PG8_WAIT_L(8); PG8_BAR; PG8_WAIT_L(0); PG8_MMA(0, 0, At, B0); PG8_BAR; PG8_SCHED;
            PG8_LDB(B1, 1, 1); PG8_STAGE_B(PG8_SB(1, 0), b3, voffB);
            PG8_BAR; PG8_WAIT_L(0); PG8_MMA(0, 1, At, B1); PG8_BAR;
            PG8_LDA(At, 1, 1); PG8_STAGE_A(PG8_SA(1, 0), a3, 0, nx_);
            PG8_BAR; PG8_WAIT_L(0); PG8_MMA(1, 0, At, B0); PG8_BAR; PG8_SCHED;
            PG8_STAGE_B(PG8_SB(1, 1), b3 + hstepB, voffB);
            PG8_WAIT_V(6); PG8_BAR; PG8_MMA(1, 1, At, B1); PG8_BAR;
            }
        }
        if constexpr (F8) asm volatile("s_nop 15\n\ts_nop 15" ::: "memory");
        if constexpr (ALIGN_EPI) { if (wr == 0) PG8_BAR; }
        if constexpr (!Epi::AFTER_DRAIN) { E(acc, cur, wr, wc, fr, fq); S.done(cur); }
        if (!has_next) break;
#pragma unroll
        for (int a = 0; a < 2; ++a)
#pragma unroll
            for (int b = 0; b < 2; ++b)
#pragma unroll
                for (int m = 0; m < 4; ++m)
#pragma unroll
                    for (int n = 0; n < 2; ++n) acc[a][b][m][n] = (f32x4){0.f, 0.f, 0.f, 0.f};
        cur = nxt; cA = nA; cB = nB; ++ui;
        if constexpr (Sched::GATHER) { gc[0][0] = gn[0][0]; gc[0][1] = gn[0][1]; gc[1][0] = gn[1][0]; gc[1][1] = gn[1][1]; }
        if constexpr (ALIGN_EPI) { if (wr == 1) PG8_BAR; }
    }
    PG8_WAIT_V(0);
    if constexpr (!ALIGN_EPI) { if (wr == 0) PG8_BAR; }
    PG8_BAR;
    if constexpr (Epi::AFTER_DRAIN) { E.fused(acc, cur, wr, wc, fr, fq, lds, wid, lane); S.done(cur); }
#undef PG8_SA
#undef PG8_SB
#undef PG8_STAGE
#undef PG8_STAGE_A
#undef PG8_GROWS
#undef PG8_LDA
#undef PG8_LDB
#undef PG8_MMA
#undef PG8_WAIT_V
#undef PG8_WAIT_L
#undef PG8_BAR
#undef PG8_SCHED
}
typedef unsigned u32x2e __attribute__((ext_vector_type(2)));
struct EpiPlain {
    static constexpr bool PERM = true, AFTER_DRAIN = false, ADJ = false;
    bf16_t* O; int ldc; float scale;
    __device__ __forceinline__ void operator()(const f32x4 (&acc)[2][2][4][2], const Unit& u, int wr, int wc, int fr, int fq) const {
        const int row0 = u.pm * BM + wr * 64 + fr, col0 = u.pn * BM + wc * 32 + 8 * fq;
        float one = scale; asm volatile("" : "+v"(one));
#pragma unroll
        for (int ai = 0; ai < 2; ++ai)
#pragma unroll
            for (int m = 0; m < 4; ++m) { bf16_t* rowp = O + (size_t)(row0 + ai * HALF + m * 16) * ldc + col0;
#pragma unroll
                for (int bj = 0; bj < 2; ++bj) { const f32x4 v0 = acc[ai][bj][m][0] * one, v1 = acc[ai][bj][m][1] * one;
                    u32x4 w; w.x = cvt_pk_bf16(v0[0], v0[1]); w.y = cvt_pk_bf16(v0[2], v0[3]); w.z = cvt_pk_bf16(v1[0], v1[1]); w.w = cvt_pk_bf16(v1[2], v1[3]);
                    *(u32x4*)(rowp + bj * HALF) = w; } }
    }
};
struct EpiF8 {
    static constexpr bool PERM = true, AFTER_DRAIN = false, ADJ = false;
    unsigned char* O; int ldc; float scale;
    __device__ __forceinline__ void operator()(const f32x4 (&acc)[2][2][4][2], const Unit& u, int wr, int wc, int fr, int fq) const {
        const int row0 = u.pm * BM + wr * 64 + fr, col0 = u.pn * BM + wc * 32 + 8 * fq;
        float one = scale; asm volatile("" : "+v"(one));
#pragma unroll
        for (int ai = 0; ai < 2; ++ai)
#pragma unroll
            for (int m = 0; m < 4; ++m) { unsigned char* rowp = O + (size_t)(row0 + ai * HALF + m * 16) * ldc + col0;
#pragma unroll
                for (int bj = 0; bj < 2; ++bj) { const f32x4 v0 = acc[ai][bj][m][0] * one, v1 = acc[ai][bj][m][1] * one;
                    u32x2e w; { int t = __builtin_amdgcn_cvt_pk_fp8_f32(v0[0], v0[1], 0, false); t = __builtin_amdgcn_cvt_pk_fp8_f32(v0[2], v0[3], t, true); w.x = (unsigned)t; }
                    { int t = __builtin_amdgcn_cvt_pk_fp8_f32(v1[0], v1[1], 0, false); t = __builtin_amdgcn_cvt_pk_fp8_f32(v1[2], v1[3], t, true); w.y = (unsigned)t; }
                    *(u32x2e*)(rowp + bj * HALF) = w; } }
    }
};
struct EpiInProj {
    static constexpr bool PERM = true, AFTER_DRAIN = false, ADJ = true;
    bf16_t* O; int ldc; const float* rope; int rope_lo, rope_hi, lat_rows; float scale;
    __device__ __forceinline__ void operator()(const f32x4 (&acc)[2][2][4][2], const Unit& u, int wr, int wc, int fr, int fq) const {
        const int hi8 = fr >> 3;
        const int row0 = u.pm * BM + wr * 64 + (fr & 7), col0 = u.pn * BM + wc * 64 + hi8 * 32 + 8 * fq;
        const bool do_rope = (u.pn >= rope_lo) && (u.pn < rope_hi) && (u.pm * BM < lat_rows);
        const int half = wc & 1;
        float one = scale; asm volatile("" : "+v"(one));
#pragma unroll
        for (int ai = 0; ai < 2; ++ai)
#pragma unroll
            for (int m = 0; m < 4; ++m) { const int row = u.pm * BM + wr * 64 + fr + ai * HALF + m * 16;
                u32x4 w[2];
#pragma unroll
                for (int bj = 0; bj < 2; ++bj) { f32x4 v0 = acc[ai][bj][m][0] * one, v1 = acc[ai][bj][m][1] * one;
                    if (do_rope) { const int s = row & 8191, pos = half ? (s & 63) : (s >> 6); const f32x4* tp = (const f32x4*)(rope + (size_t)(pos * 32 + 16 * bj + 4 * fq) * 2); const f32x4 cs0 = tp[0], cs1 = tp[1];
                        const f32x4 a = v0, b = v1;
                        v0[0] = a[0] * cs0[0] - a[1] * cs0[1]; v0[1] = a[1] * cs0[0] + a[0] * cs0[1];
                        v0[2] = a[2] * cs0[2] - a[3] * cs0[3]; v0[3] = a[3] * cs0[2] + a[2] * cs0[3];
                        v1[0] = b[0] * cs1[0] - b[1] * cs1[1]; v1[1] = b[1] * cs1[0] + b[0] * cs1[1];
                        v1[2] = b[2] * cs1[2] - b[3] * cs1[3]; v1[3] = b[3] * cs1[2] + b[2] * cs1[3];
                    }
                    w[bj].x = cvt_pk_bf16(v0[0], v0[1]); w[bj].y = cvt_pk_bf16(v0[2], v0[3]); w[bj].z = cvt_pk_bf16(v1[0], v1[1]); w[bj].w = cvt_pk_bf16(v1[2], v1[3]); }
                const u32x4 snd = hi8 ? w[0] : w[1]; u32x4 got;
                got.x = (unsigned)__builtin_amdgcn_update_dpp(0, (int)snd.x, 0x128, 0xF, 0xF, false); got.y = (unsigned)__builtin_amdgcn_update_dpp(0, (int)snd.y, 0x128, 0xF, 0xF, false);
                got.z = (unsigned)__builtin_amdgcn_update_dpp(0, (int)snd.z, 0x128, 0xF, 0xF, false); got.w = (unsigned)__builtin_amdgcn_update_dpp(0, (int)snd.w, 0x128, 0xF, 0xF, false);
                bf16_t* rowp = O + (size_t)(row0 + ai * HALF + m * 16) * ldc + col0;
                *(u32x4*)rowp = hi8 ? got : w[0];
                *(u32x4*)(rowp + (size_t)8 * ldc) = hi8 ? w[1] : got; }
    }
};
struct EpiRes {
    static constexpr bool PERM = true, AFTER_DRAIN = false, ADJ = false;
    const void* xin; bf16_t* xout; const void* cin; bf16_t* cout; const float* gate;
    int ldc, lat_rows, gstride; float scale; int in_f32;
    __device__ __forceinline__ void operator()(const f32x4 (&acc)[2][2][4][2], const Unit& u, int wr, int wc, int fr, int fq) const {
        const int row0 = u.pm * BM + wr * 64 + fr, col0 = u.pn * BM + wc * 32 + 8 * fq;
        const bool isc = u.pm * BM >= lat_rows;
        const int vs = isc ? 2 : ((u.pm * BM) >> 13), rsub = isc ? lat_rows : 0;
        const void* bp = isc ? cin : xin; bf16_t* op = isc ? cout : xout;
        f32x4 gv[2][2];
#pragma unroll
        for (int bj = 0; bj < 2; ++bj)
#pragma unroll
            for (int n = 0; n < 2; ++n) { typedef int i32x4 __attribute__((ext_vector_type(4))); const i32x4 q = *(const i32x4*)(gate + (size_t)vs * gstride + col0 + bj * HALF + 4 * n);
                gv[bj][n] = (f32x4){(float)q[0], (float)q[1], (float)q[2], (float)q[3]} * (scale * (1.f / 16777216.f)); }
#pragma unroll
        for (int ai = 0; ai < 2; ++ai)
#pragma unroll
        for (int mh = 0; mh < 2; ++mh) {
            if (in_f32) {
                f32x4 bb[2][2][2];
#pragma unroll
                for (int mm = 0; mm < 2; ++mm)
#pragma unroll
                    for (int bj = 0; bj < 2; ++bj) { const float* q = (const float*)bp + (size_t)(row0 - rsub + ai * HALF + (2 * mh + mm) * 16) * ldc + col0 + bj * HALF; bb[mm][bj][0] = __builtin_nontemporal_load((const f32x4*)q); bb[mm][bj][1] = __builtin_nontemporal_load((const f32x4*)(q + 4)); }
#pragma unroll
                for (int mm = 0; mm < 2; ++mm)
#pragma unroll
                    for (int bj = 0; bj < 2; ++bj) { const int m = 2 * mh + mm; const size_t off = (size_t)(row0 - rsub + ai * HALF + m * 16) * ldc + col0 + bj * HALF;
                        const f32x4 o0 = bb[mm][bj][0] + gv[bj][0] * acc[ai][bj][m][0], o1 = bb[mm][bj][1] + gv[bj][1] * acc[ai][bj][m][1];
                        u32x4 w; w.x = cvt_pk_bf16(o0[0], o0[1]); w.y = cvt_pk_bf16(o0[2], o0[3]); w.z = cvt_pk_bf16(o1[0], o1[1]); w.w = cvt_pk_bf16(o1[2], o1[3]);
                        *(u32x4*)(op + off) = w; }
            } else {
                u32x4 bw[2][2];
#pragma unroll
                for (int mm = 0; mm < 2; ++mm)
#pragma unroll
                    for (int bj = 0; bj < 2; ++bj) bw[mm][bj] = *(const u32x4*)((const bf16_t*)bp + (size_t)(row0 - rsub + ai * HALF + (2 * mh + mm) * 16) * ldc + col0 + bj * HALF);
#pragma unroll
                for (int mm = 0; mm < 2; ++mm)
#pragma unroll
                    for (int bj = 0; bj < 2; ++bj) { const int m = 2 * mh + mm; const size_t off = (size_t)(row0 - rsub + ai * HALF + m * 16) * ldc + col0 + bj * HALF; const u32x4 w0 = bw[mm][bj];
                        const f32x4 b0 = (f32x4){__builtin_bit_cast(float, w0.x << 16), __builtin_bit_cast(float, w0.x & 0xffff0000u), __builtin_bit_cast(float, w0.y << 16), __builtin_bit_cast(float, w0.y & 0xffff0000u)};
                        const f32x4 b1 = (f32x4){__builtin_bit_cast(float, w0.z << 16), __builtin_bit_cast(float, w0.z & 0xffff0000u), __builtin_bit_cast(float, w0.w << 16), __builtin_bit_cast(float, w0.w & 0xffff0000u)};
                        const f32x4 o0 = b0 + gv[bj][0] * acc[ai][bj][m][0], o1 = b1 + gv[bj][1] * acc[ai][bj][m][1];
                        u32x4 w; w.x = cvt_pk_bf16(o0[0], o0[1]); w.y = cvt_pk_bf16(o0[2], o0[3]); w.z = cvt_pk_bf16(o1[0], o1[1]); w.w = cvt_pk_bf16(o1[2], o1[3]);
                        *(u32x4*)(op + off) = w; }
            }
        }
    }
};
__device__ __forceinline__ unsigned pack4_fp8(float a, float b, float c, float d) { int w = __builtin_amdgcn_cvt_pk_fp8_f32(a, b, 0, false); w = __builtin_amdgcn_cvt_pk_fp8_f32(c, d, w, true); return (unsigned)w; }
struct EpiGateUp {
    static constexpr bool PERM = true, AFTER_DRAIN = false, ADJ = false;
    unsigned char* O; int ldc; float wscale;
    __device__ __forceinline__ void operator()(const f32x4 (&acc)[2][2][4][2], const Unit& u, int wr, int wc, int fr, int fq) const {
        const int row0 = u.pm * BM + wr * 64 + fr, col0 = (u.pn * BM + wc * 32 + 8 * fq) >> 1;
        float ws = wscale; asm volatile("" : "+v"(ws));
#pragma unroll
        for (int ai = 0; ai < 2; ++ai)
#pragma unroll
            for (int m = 0; m < 4; ++m) { unsigned char* rowp = O + (size_t)(row0 + ai * HALF + m * 16) * ldc + col0;
#pragma unroll
                for (int bj = 0; bj < 2; ++bj) { const f32x4 g = acc[ai][bj][m][0] * ws, up = acc[ai][bj][m][1] * ws; f32x4 a;
#pragma unroll
                    for (int i = 0; i < 4; ++i) a[i] = g[i] * __builtin_amdgcn_rcpf(1.f + __expf(-g[i])) * up[i];
                    *(unsigned*)(rowp + bj * (HALF / 2)) = pack4_fp8(a[0], a[1], a[2], a[3]); } }
    }
};
template <bool SKIP, bool GATH = false> struct GroupedOrderT {
#ifndef MOE_TR
#define MOE_TR 0
#endif
#ifndef MOE_B_NT
#define MOE_B_NT 0
#endif
    static constexpr bool SKIP_HI = SKIP, GATHER = GATH, B_NT = MOE_B_NT != 0;
    static constexpr int nN = 8;
    int G, c, nblk; const PG8_LAS int* blk_e; const PG8_LAS int* blk_h; long estride; const PG8_LAS unsigned* rowtab;
    __device__ __forceinline__ bool next(int i, Unit& u) const {
        const int L = i * G + c; if (L >= nblk * nN) return false;
#if MOE_TR
        {
            const int full = (nblk >> 3) << 6; if (L < full) { const int j = L & 63; u.pm = ((L >> 6) << 3) + (j & 7); u.pn = j >> 3; } else { u.pm = L >> 3; u.pn = L & 7; } }
#else
        u.pm = L >> 3; u.pn = L & 7;
#endif
        u.boff = (long)__builtin_amdgcn_readfirstlane(blk_e[u.pm]) * estride; u.lo_only = __builtin_amdgcn_readfirstlane(blk_h[u.pm]); return true;
    }
    __device__ __forceinline__ void a_ready(const Unit&) const {}
    __device__ __forceinline__ void done(const Unit&) const {}
};
}
constexpr int DM = 2048, T_LAT = 16384, T_CTX = 512, T_ALL = 16896, SEQL = 8192, CTXL = 256;
constexpr int NIN = 5152, NINP = 5376;
constexpr int C_QA = 0, C_KA = 512, C_VA = 1024, C_QB = 1536, C_KB = 2048, C_VB = 2304, C_Z = 2560, C_XBC = 3584, C_DT = 5120;
constexpr int XBCW = 1536, DFF = 1024, NEXP = 32, MODW = 12288;
constexpr float EPS = 1e-6f, ATT_SCALE = 0.088388347648318440f;
constexpr int MAXBLK = 165, MAXSLOT = MAXBLK * 256;
constexpr int NWAVES = 8;

constexpr size_t MiB = 1u << 20;
constexpr size_t WS_CTL = 0, CTL_ZERO_BYTES = 2 * MiB;
constexpr int CW_BAR = 4096;
constexpr size_t OFF_Q = 32768;
constexpr size_t OFF_CNT = 65536;
constexpr size_t OFF_MOD = 1 * MiB;
constexpr size_t WS_ROPE = 2 * MiB;
constexpr size_t WS_WRT = 3 * MiB;
constexpr size_t WS_WIN = 8 * MiB;
constexpr size_t WS_WOUT = 50 * MiB;
constexpr size_t WS_WGU = 66 * MiB;
constexpr size_t WS_WDN = 578 * MiB;
constexpr size_t WS_H = 834 * MiB;
constexpr size_t WS_U = 900 * MiB;
constexpr size_t WS_X = 1074 * MiB;
constexpr size_t WS_XC = 1202 * MiB;
constexpr size_t WS_XBC = 1206 * MiB;
constexpr size_t WS_DT = 1256 * MiB;
constexpr size_t WS_YD = 1260 * MiB;
constexpr size_t WS_XG = 1392 * MiB;
constexpr size_t WS_ACT = 1557 * MiB;
constexpr size_t WS_YB = 1640 * MiB;
constexpr size_t WS_TOK = 1805 * MiB;
constexpr size_t WS_END = 1808 * MiB;
constexpr size_t WS_LIST = WS_XG + 64 * MiB;
constexpr int LCAP = 2 * T_ALL;
constexpr unsigned ZERO_OFF = 1536u * 1024u;
constexpr size_t TOKTAB = (size_t)T_ALL * 2 * 4;
static_assert(WS_WIN + (size_t)2 * NINP * DM * 2 <= WS_WOUT && WS_WGU + (size_t)2 * 32 * 2048 * 2048 * 2 <= WS_WDN && WS_WDN + (size_t)2 * 32 * 2048 * 1024 * 2 <= WS_H, "ws map 1");
static_assert(WS_H + (size_t)T_ALL * DM * 2 <= WS_U && WS_U + (size_t)T_ALL * NINP * 2 <= WS_X && WS_X + (size_t)T_LAT * DM * 4 <= WS_XC && WS_XBC + (size_t)T_ALL * XBCW * 2 <= WS_DT, "ws map 2");
static_assert(WS_DT + (size_t)T_ALL * 32 * 4 <= WS_YD && WS_YD + (size_t)2 * T_ALL * 1024 * 4 <= WS_XG && WS_XG + (size_t)MAXSLOT * DM * 2 <= WS_ACT && WS_ACT + (size_t)MAXSLOT * DFF * 2 <= WS_YB && WS_YB + (size_t)MAXSLOT * DM * 2 <= WS_TOK && WS_TOK + 4 * TOKTAB <= WS_END, "ws map 3");

constexpr int RING_BYTES = 131072, LDSCTL_OFF = RING_BYTES, LDS_BYTES = 147456;
constexpr int L_BARW = LDSCTL_OFF;
constexpr int L_BWORK = LDSCTL_OFF + 32;
constexpr int L_SEG = LDSCTL_OFF + 64;
constexpr int L_CNT = LDSCTL_OFF + 256;
constexpr int L_BLKE = LDSCTL_OFF + 512;
constexpr int L_NBLK = LDSCTL_OFF + 1536;
constexpr int L_INCL = LDSCTL_OFF + 1600;
constexpr int L_PB = LDSCTL_OFF + 1792;
constexpr int L_ROWT = LDSCTL_OFF + 4096;
constexpr int L_BLKH = LDSCTL_OFF + 2048;

#define GAS __attribute__((address_space(1)))
#define LAS __attribute__((address_space(3)))
typedef unsigned short bf16;
typedef unsigned v4u __attribute__((ext_vector_type(4)));
typedef unsigned v2u __attribute__((ext_vector_type(2)));
typedef float f32x4 __attribute__((ext_vector_type(4)));
typedef float f32x2 __attribute__((ext_vector_type(2)));
typedef short bf16x8 __attribute__((ext_vector_type(8)));
#define LDS_WAIT() asm volatile("s_waitcnt lgkmcnt(0)" ::: "memory")
#define VM_WAIT() asm volatile("s_waitcnt vmcnt(0)" ::: "memory")
__device__ __forceinline__ unsigned f2bf(float f) { unsigned u = __builtin_bit_cast(unsigned, f); return (u + 0x7fffu + ((u >> 16) & 1u)) >> 16; }
__device__ __forceinline__ unsigned pk2(float lo, float hi) { return f2bf(lo) | (f2bf(hi) << 16); }
__device__ __forceinline__ float bflo(unsigned w) { return __builtin_bit_cast(float, w << 16); }
__device__ __forceinline__ float bfhi(unsigned w) { return __builtin_bit_cast(float, w & 0xffff0000u); }
__device__ __forceinline__ float bf2f(bf16 b) { return __builtin_bit_cast(float, (unsigned)b << 16); }
__device__ __forceinline__ float wave_sum(float v) {
#pragma unroll
    for (int o = 1; o < 64; o <<= 1) v += __shfl_xor(v, o);
    return v;
}
__device__ __forceinline__ float wave_max(float v) {
#pragma unroll
    for (int o = 1; o < 64; o <<= 1) v = fmaxf(v, __shfl_xor(v, o));
    return v;
}
__device__ __forceinline__ float silu_f(float x) { return x / (1.f + __expf(-x)); }
__device__ __forceinline__ float sigmoid_f(float x) { return 1.f / (1.f + __expf(-x)); }
__device__ __forceinline__ float softplus_f(float x) { return x > 20.f ? x : log1pf(__expf(x)); }

#define XB_TMO      128
#define XB_XCNT(j)  (256  + 64 * (j))
#define XB_XSUB(j)  (1280 + 64 * (j))
#define XB_XGEN(j)  (2304 + 64 * (j))
#define XB_TOP      3328
#define XB_TOPGEN   3392
#define XCD_BAR_WORDS 3456
#define XB_SPIN_CAP (1u << 18)


__device__ __forceinline__ unsigned xb_ld(unsigned* p)              { return __hip_atomic_load(p, __ATOMIC_RELAXED, __HIP_MEMORY_SCOPE_AGENT); }
__device__ __forceinline__ unsigned xb_add(unsigned* p, unsigned v) { return __hip_atomic_fetch_add(p, v, __ATOMIC_RELAXED, __HIP_MEMORY_SCOPE_AGENT); }
__device__ __forceinline__ unsigned xb_xcc_id() { return (unsigned)__builtin_amdgcn_s_getreg((3 << 11) | 20) & 0xFu; }
#define XB_SPIN(cond, bar) do { unsigned _sp = 0; while (cond) { __builtin_amdgcn_s_sleep(1); \
    if ((++_sp & 255u) == 0u) { if (xb_ld(&(bar)[XB_TMO])) break; if (_sp > XB_SPIN_CAP) { atomicAdd(&(bar)[XB_TMO], 1u); break; } } } } while (0)

struct XcdBarrier {
    unsigned* bar; unsigned x;
    volatile LAS unsigned* st;
};

__device__ __forceinline__ XcdBarrier xcd_barrier_post(unsigned* bar, volatile LAS unsigned* st) {
    XcdBarrier b; b.bar = bar; b.x = xb_xcc_id(); b.st = st;
    if (threadIdx.x == 0) (void)xb_add(&bar[XB_XCNT(b.x)], 1u);
    return b;
}
__device__ __forceinline__ void xcd_barrier_complete(unsigned* bar, unsigned x, unsigned& nloc, unsigned& nx) {
    const unsigned G = gridDim.x * gridDim.y * gridDim.z;
    unsigned sum, cnt, mine, sp = 0u, cv[16];
    for (;;) {
        sum = 0u; cnt = 0u; mine = 0u;
#pragma unroll
        for (unsigned j = 0; j < 16; ++j) cv[j] = xb_ld(&bar[XB_XCNT(j)]);
#pragma unroll
        for (unsigned j = 0; j < 16; ++j) { const unsigned c = cv[j]; sum += c; cnt += (c > 0u) ? 1u : 0u; mine = (j == x) ? c : mine; }
        if (sum == G) break;
        __builtin_amdgcn_s_sleep(1);
        if ((++sp & 255u) == 0u) { if (xb_ld(&bar[XB_TMO])) break; if (sp > XB_SPIN_CAP) { atomicAdd(&bar[XB_TMO], 1u); break; } }
    }
    nloc = mine > 0u ? mine : 1u; nx = cnt > 0u ? cnt : 1u;
}

__device__ __forceinline__ void xcd_barrier(const XcdBarrier& b) {
    asm volatile("s_waitcnt vmcnt(0)" ::: "memory");
    __syncthreads();
    if (threadIdx.x == 0) {
        unsigned* bar = b.bar;
        __builtin_amdgcn_s_waitcnt(0);
        unsigned nloc = b.st[0], nx = b.st[1];
        if (nloc == 0u) { xcd_barrier_complete(bar, b.x, nloc, nx); b.st[0] = nloc; b.st[1] = nx; }
        const unsigned old = xb_add(&bar[XB_XSUB(b.x)], 1u);
        const unsigned gen = old / nloc;
        if (old + 1u == (gen + 1u) * nloc) {
            __builtin_amdgcn_fence(__ATOMIC_RELEASE, "agent");
            asm volatile("s_waitcnt vmcnt(0)" ::: "memory");
            const unsigned og = xb_add(&bar[XB_TOP], 1u);
            const unsigned tg = og / nx;
            if (og + 1u == (tg + 1u) * nx) xb_add(&bar[XB_TOPGEN], 1u);
            else XB_SPIN(xb_ld(&bar[XB_TOPGEN]) == tg, bar);
            __builtin_amdgcn_fence(__ATOMIC_ACQUIRE, "agent");
            xb_add(&bar[XB_XGEN(b.x)], 1u);
            asm volatile("s_waitcnt vmcnt(0)" ::: "memory");
        } else {
            XB_SPIN(xb_ld(&bar[XB_XGEN(b.x)]) == gen, bar);
            __builtin_amdgcn_fence(__ATOMIC_ACQUIRE, "agent");
            asm volatile("s_waitcnt vmcnt(0)" ::: "memory");
        }
    }
    __syncthreads();
}
struct Prm {
    const float *x, *c, *ctx, *c_ctx, *w_ada, *b_ada, *norm_mix, *norm_ffn, *norm_final, *w_in, *w_out, *na_rpb, *wa_sink,
                *conv_w, *conv_b, *a_log, *dt_bias, *d_skip, *ssd_norm, *w_router, *router_bias, *w_gate, *w_up, *w_down;
    float* out; unsigned char* ws; int ph_lo, ph_hi;
};

__device__ __forceinline__ int perm_in(int n) {
    if (n >= C_QB && n < C_VB) { const int p = (n - C_QB) & 127, hb = n - p, half = p >> 6, pp = p & 63; return hb + half * 64 + (pp >> 1) + 32 * (pp & 1); }
    return n;
}
__device__ __forceinline__ unsigned pack4f8(float a, float b, float c, float d) { int w = __builtin_amdgcn_cvt_pk_fp8_f32(a, b, 0, false); w = __builtin_amdgcn_cvt_pk_fp8_f32(c, d, w, true); return (unsigned)w; }
#ifndef CONV_QUEUE
#define CONV_QUEUE 1
#endif
constexpr float W8_SCALE = 64.f, MIX_SCALE = 8.f, Y8_SCALE = 8.f;
struct TDesc { const float* colp; size_t ld; unsigned char* wt; int ok, k0, K, n0; };
constexpr int TK_IN = 2 * 32 * (NINP / 32), TK_OUT = 2 * 32 * 64, TK_GU = 2 * 32 * 32 * 64, TK_DN = 2 * 32 * 16 * 64, TK_RT = 32;
template <bool F8SEL> __device__ __forceinline__ constexpr int t_count() {
    return ((F8_INPROJ != 0) == F8SEL ? TK_IN : 0) + ((F8_OUTPROJ != 0) == F8SEL ? TK_OUT : 0) + (F8SEL ? TK_GU + TK_DN : TK_RT);
}
template <bool F8SEL> __device__ __forceinline__ TDesc t_decode(const Prm& p, int it, int lane) {
    unsigned char* ws = p.ws; TDesc d; int r = it;
    if ((F8_INPROJ != 0) == F8SEL) { if (r < TK_IN) { const int sub = r & 1, r2 = r >> 1, l = r2 / (TK_IN / 4), q = r2 % (TK_IN / 4), kb = 2 * (q / (NINP / 32)) + sub, nb = q % (NINP / 32), nn = 32 * nb + (lane & 31); const bool ok = nn < NIN;
            d.colp = p.w_in + (size_t)l * DM * NIN + (ok ? perm_in(nn) : 0); d.ld = NIN; d.ok = ok; d.K = 2048; d.wt = ws + WS_WIN + (size_t)l * NINP * DM * (F8_INPROJ ? 1 : 2); d.n0 = 32 * nb; d.k0 = 64 * kb; return d; } r -= TK_IN; }
    if ((F8_OUTPROJ != 0) == F8SEL) { if (r < TK_OUT) { const int sub = r & 1, r2 = r >> 1, l = r2 / (TK_OUT / 4), q = r2 % (TK_OUT / 4), kb = 2 * (q / 64) + sub, nb = q % 64, nn = 32 * nb + (lane & 31);
            d.colp = p.w_out + (size_t)l * DM * DM + nn; d.ld = DM; d.ok = 1; d.K = 2048; d.wt = ws + WS_WOUT + (size_t)l * DM * DM * (F8_OUTPROJ ? 1 : 2); d.n0 = 32 * nb; d.k0 = 64 * kb; return d; } r -= TK_OUT; }
    if (F8SEL) {
        if (r < TK_GU) { const int sub = r & 1, r2 = r >> 1, le = r2 / 1024, q = r2 % 1024, kb = 2 * (q / 64) + sub, nb = q % 64, nn = 32 * nb + (lane & 31), j = nn >> 3, t = nn & 7;
            d.colp = (t < 4 ? p.w_gate : p.w_up) + (size_t)le * 2048 * 1024 + 4 * j + (t & 3); d.ld = 1024; d.ok = 1; d.K = 2048; d.wt = ws + WS_WGU + (size_t)le * 2048 * 2048; d.n0 = 32 * nb; d.k0 = 64 * kb; return d; }
        r -= TK_GU;
        { const int sub = r & 1, r2 = r >> 1, le = r2 / 512, q = r2 % 512, kb = 2 * (q / 64) + sub, nb = q % 64, nn = 32 * nb + (lane & 31);
            d.colp = p.w_down + (size_t)le * 1024 * 2048 + nn; d.ld = 2048; d.ok = 1; d.K = 1024; d.wt = ws + WS_WDN + (size_t)le * 2048 * 1024; d.n0 = 32 * nb; d.k0 = 64 * kb; return d; }
    } else { const int kb = r; d.colp = p.w_router + (lane & 31); d.ld = 32; d.ok = 1; d.K = 2048; d.wt = ws + WS_WRT; d.n0 = 0; d.k0 = 64 * kb; return d; }
}
__device__ __forceinline__ void t_load(const TDesc& d, float (&tv)[32], int lane) {
#pragma unroll
    for (int i = 0; i < 32; ++i) tv[i] = __builtin_nontemporal_load(d.colp + (size_t)(d.k0 + 2 * i + (lane >> 5)) * d.ld);
}
template <bool F8> __device__ __forceinline__ void t_lds_in(const TDesc& d, const float (&tv)[32], LAS float* scr, int lane) {
#pragma unroll
    for (int i = 0; i < 32; ++i) scr[(2 * i + (lane >> 5)) * 33 + (lane & 31)] = d.ok ? tv[i] : 0.f;
    LDS_WAIT(); asm volatile("" ::: "memory");
}
template <bool F8> __device__ __forceinline__ void t_out(const TDesc& d, LAS float* scr, int lane) {
    const int c = lane & 7;
#pragma unroll
    for (int j = 0; j < 4; ++j) { const int n = (lane >> 3) + 8 * j; const LAS float* s = scr + (8 * c) * 33 + n;
        if constexpr (F8) { v2u o; o.x = pack4f8(s[0 * 33] * W8_SCALE, s[1 * 33] * W8_SCALE, s[2 * 33] * W8_SCALE, s[3 * 33] * W8_SCALE); o.y = pack4f8(s[4 * 33] * W8_SCALE, s[5 * 33] * W8_SCALE, s[6 * 33] * W8_SCALE, s[7 * 33] * W8_SCALE);
            *(v2u*)(d.wt + (size_t)(d.n0 + n) * d.K + d.k0 + 8 * c) = o; }
        else { v4u o; o.x = pk2(s[0 * 33], s[1 * 33]); o.y = pk2(s[2 * 33], s[3 * 33]); o.z = pk2(s[4 * 33], s[5 * 33]); o.w = pk2(s[6 * 33], s[7 * 33]);
            *(v4u*)((bf16*)d.wt + (size_t)(d.n0 + n) * d.K + d.k0 + 8 * c) = o; } }
    LDS_WAIT(); asm volatile("" ::: "memory");
}
__device__ __forceinline__ void t_cvt8(LAS float* scr, int lane, v2u (&o)[4]) {
    const int c = lane & 7;
#pragma unroll
    for (int j = 0; j < 4; ++j) { const int n = (lane >> 3) + 8 * j; const LAS float* s = scr + (8 * c) * 33 + n;
        o[j].x = pack4f8(s[0 * 33] * W8_SCALE, s[1 * 33] * W8_SCALE, s[2 * 33] * W8_SCALE, s[3 * 33] * W8_SCALE); o[j].y = pack4f8(s[4 * 33] * W8_SCALE, s[5 * 33] * W8_SCALE, s[6 * 33] * W8_SCALE, s[7 * 33] * W8_SCALE); }
    LDS_WAIT(); asm volatile("" ::: "memory");
}
constexpr int TL_IN = 32 * (NINP / 32), TL_OUT = 32 * 64, TL_GU = 32 * 32 * 64, TL_DN = 32 * 16 * 64, TL_ALL = TL_IN + TL_OUT + TL_GU + TL_DN, NPL = TL_ALL / 2;
static_assert(F8_INPROJ && F8_OUTPROJ, "the per-layer conversion queue assumes fp8 copies of every GEMM weight");
__device__ __forceinline__ TDesc t_decode_layer(const Prm& p, int l, int it, int lane) {
    unsigned char* ws = p.ws; TDesc d; int r = it; const int sub = r & 1;
    if (r < TL_IN) { const int q = r >> 1, kb = 2 * (q / (NINP / 32)) + sub, nb = q % (NINP / 32), nn = 32 * nb + (lane & 31); const bool ok = nn < NIN;
        d.colp = p.w_in + (size_t)l * DM * NIN + (ok ? perm_in(nn) : 0); d.ld = NIN; d.ok = ok; d.K = 2048; d.wt = ws + WS_WIN + (size_t)l * NINP * DM; d.n0 = 32 * nb; d.k0 = 64 * kb; return d; }
    r -= TL_IN;
    if (r < TL_OUT) { const int q = r >> 1, kb = 2 * (q / 64) + sub, nb = q % 64, nn = 32 * nb + (lane & 31);
        d.colp = p.w_out + (size_t)l * DM * DM + nn; d.ld = DM; d.ok = 1; d.K = 2048; d.wt = ws + WS_WOUT + (size_t)l * DM * DM; d.n0 = 32 * nb; d.k0 = 64 * kb; return d; }
    r -= TL_OUT;
    if (r < TL_GU) { const int r2 = r >> 1, le = l * 32 + r2 / 1024, q = r2 % 1024, kb = 2 * (q / 64) + sub, nb = q % 64, nn = 32 * nb + (lane & 31), j = nn >> 3, t = nn & 7;
        d.colp = (t < 4 ? p.w_gate : p.w_up) + (size_t)le * 2048 * 1024 + 4 * j + (t & 3); d.ld = 1024; d.ok = 1; d.K = 2048; d.wt = ws + WS_WGU + (size_t)le * 2048 * 2048; d.n0 = 32 * nb; d.k0 = 64 * kb; return d; }
    r -= TL_GU;
    { const int r2 = r >> 1, le = l * 32 + r2 / 512, q = r2 % 512, kb = 2 * (q / 64) + sub, nb = q % 64, nn = 32 * nb + (lane & 31);
        d.colp = p.w_down + (size_t)le * 1024 * 2048 + nn; d.ld = 2048; d.ok = 1; d.K = 1024; d.wt = ws + WS_WDN + (size_t)le * 2048 * 1024; d.n0 = 32 * nb; d.k0 = 64 * kb; return d; }
}
__device__ __forceinline__ void t_pair_store(const TDesc& dS, const v2u (&oa)[4], const v2u (&ob)[4], int lane) {
    const int c = lane & 7, odd = c & 1;
#pragma unroll
    for (int j = 0; j < 4; ++j) { const int n = (lane >> 3) + 8 * j;
        const v2u snd = odd ? oa[j] : ob[j]; v2u got; got.x = (unsigned)__builtin_amdgcn_update_dpp(0, (int)snd.x, 0xB1, 0xF, 0xF, false); got.y = (unsigned)__builtin_amdgcn_update_dpp(0, (int)snd.y, 0xB1, 0xF, 0xF, false);
        v4u w; if (odd) { w.x = got.x; w.y = got.y; w.z = ob[j].x; w.w = ob[j].y; } else { w.x = oa[j].x; w.y = oa[j].y; w.z = got.x; w.w = got.y; }
        __builtin_nontemporal_store(w, (v4u*)(dS.wt + (size_t)(dS.n0 + n) * dS.K + dS.k0 + (odd ? 64 : 0) + 16 * (c >> 1))); }

}
#ifndef Q_L0EXP
#define Q_L0EXP 1
#endif
constexpr int NP_PROJ = (TL_IN + TL_OUT) / 2, NP_EXP = (TL_GU + TL_DN) / 2;
__device__ __forceinline__ void t_convert_pairs(const Prm& p, int l, int npairs, LAS float* scr, int gw, int ngw, int lane) {
    if (gw >= npairs) return;
    TDesc dA = t_decode_layer(p, l, 2 * gw, lane), dB = t_decode_layer(p, l, 2 * gw + 1, lane); float ta[32], tb[32]; t_load(dA, ta, lane); t_load(dB, tb, lane);
#pragma unroll 1
    for (int pi = gw; pi < npairs; pi += ngw) {
        v2u oa[4], ob[4];
        t_lds_in<true>(dA, ta, scr, lane); t_cvt8(scr, lane, oa);
        t_lds_in<true>(dB, tb, scr, lane);
        const TDesc dS = dA; const int pn = pi + ngw;
        if (pn < npairs) { dA = t_decode_layer(p, l, 2 * pn, lane); dB = t_decode_layer(p, l, 2 * pn + 1, lane); t_load(dA, ta, lane); t_load(dB, tb, lane); }
        t_cvt8(scr, lane, ob);
        t_pair_store(dS, oa, ob, lane);
    }
}
__device__ __forceinline__ void t_convert_two(const Prm& p, int l, int pi0, int l1, int pi1, bool has1, LAS float* scr, int lane) {
    const TDesc dA = t_decode_layer(p, l, 2 * pi0, lane), dB = t_decode_layer(p, l, 2 * pi0 + 1, lane), dC = t_decode_layer(p, l1, 2 * pi1, lane), dD = t_decode_layer(p, l1, 2 * pi1 + 1, lane);
    float ta[32], tb[32], tc[32], td[32]; t_load(dA, ta, lane); t_load(dB, tb, lane); t_load(dC, tc, lane); t_load(dD, td, lane);
    v2u oa[4], ob[4];
    t_lds_in<true>(dA, ta, scr, lane); t_cvt8(scr, lane, oa);
    t_lds_in<true>(dB, tb, scr, lane); t_cvt8(scr, lane, ob);
    t_pair_store(dA, oa, ob, lane);
    if (has1) {
        t_lds_in<true>(dC, tc, scr, lane); t_cvt8(scr, lane, oa);
        t_lds_in<true>(dD, td, scr, lane); t_cvt8(scr, lane, ob);
        t_pair_store(dC, oa, ob, lane);
    }
}
__device__ __forceinline__ void t_convert_one(const Prm& p, int l, int pi, LAS float* scr, int lane) {
    const TDesc dA = t_decode_layer(p, l, 2 * pi, lane), dB = t_decode_layer(p, l, 2 * pi + 1, lane); float ta[32], tb[32]; t_load(dA, ta, lane); t_load(dB, tb, lane);
    v2u oa[4], ob[4];
    t_lds_in<true>(dA, ta, scr, lane); t_cvt8(scr, lane, oa);
    t_lds_in<true>(dB, tb, scr, lane); t_cvt8(scr, lane, ob);
    t_pair_store(dA, oa, ob, lane);
}
template <bool F8SEL> __device__ __forceinline__ void t_convert_all(const Prm& p, LAS float* scr, int gw, int ngw, int lane) {
    constexpr int N = t_count<F8SEL>();
    if (2 * gw >= N) return;
    TDesc d0 = t_decode<F8SEL>(p, 2 * gw, lane); float tv[32]; t_load(d0, tv, lane);
#pragma unroll 1
    for (int it = 2 * gw; it < N; ) {
        t_lds_in<F8SEL>(d0, tv, scr, lane);
        const int itn = (it & 1) ? it - 1 + 2 * ngw : it + 1; TDesc d1 = d0;
        if (itn < N) { d1 = t_decode<F8SEL>(p, itn, lane); t_load(d1, tv, lane); }
        t_out<F8SEL>(d0, scr, lane);
        d0 = d1; it = itn;
    }
}
#ifndef MODP_NC0
#define MODP_NC0 48
#endif
#ifndef MODP_NC1
#define MODP_NC1 48
#endif
#ifndef MPK
#define MPK 64
#endif
constexpr int MODP_ITEMS0 = (DM / MPK) * MODP_NC0, MODP_ITEMS = MODP_ITEMS0 + (DM / MPK) * MODP_NC1;
constexpr int MQK = 32, MQ_PER = DM / MQK;
constexpr int MODQ0 = MQ_PER * (48 - MODP_NC0), MODQ = MODQ0 + MQ_PER * (48 - MODP_NC1);
static_assert(MODQ % 16 == 0, "mods queue items come in grabs of 16");
template <int NK> __device__ __forceinline__ void mods_item(const Prm& p, int l, int k0, int nc, LAS float* scr, int lane) {
    int* mod = (int*)(p.ws + OFF_MOD);
    const int n0 = 256 * nc + 4 * lane;
    for (int i = lane; i < NK; i += 64) { scr[i] = silu_f(p.c[k0 + i]); scr[NK + i] = silu_f(p.c[DM + k0 + i]); scr[2 * NK + i] = silu_f(p.c_ctx[k0 + i]); }
    LDS_WAIT(); asm volatile("" ::: "memory");
    f32x4 a0 = {0.f, 0.f, 0.f, 0.f}, a1 = a0, a2 = a0;
    const float* wp = p.w_ada + ((size_t)l * DM + k0) * MODW + n0;
    if constexpr (NK >= 64) {
#pragma unroll 8
    for (int kk = 0; kk < NK; ++kk) { const f32x4 w = __builtin_nontemporal_load((const f32x4*)(wp + (size_t)kk * MODW)); a0 += w * scr[kk]; a1 += w * scr[NK + kk]; a2 += w * scr[2 * NK + kk]; }
    } else {
#pragma unroll 16
    for (int kk = 0; kk < NK; ++kk) { const f32x4 w = __builtin_nontemporal_load((const f32x4*)(wp + (size_t)kk * MODW)); a0 += w * scr[kk]; a1 += w * scr[NK + kk]; a2 += w * scr[2 * NK + kk]; }
    }
    if (k0 == 0) { const f32x4 bb = *(const f32x4*)(p.b_ada + (size_t)l * MODW + n0); a0 += bb; a1 += bb; a2 += bb; }
    int* m0 = mod + (size_t)(l * 3) * MODW + n0;
#pragma unroll
    for (int i = 0; i < 4; ++i) { atomicAdd(m0 + i, (int)rintf(a0[i] * 16777216.f)); atomicAdd(m0 + MODW + i, (int)rintf(a1[i] * 16777216.f)); atomicAdd(m0 + 2 * MODW + i, (int)rintf(a2[i] * 16777216.f)); }
    LDS_WAIT(); asm volatile("" ::: "memory");
}
__device__ __forceinline__ void mods_queue_item(const Prm& p, int j, LAS float* scr, int lane) {
    constexpr int W0 = 48 - MODP_NC0 + (MODP_NC0 == 48), W1 = 48 - MODP_NC1 + (MODP_NC1 == 48);
    if (j < MODQ0) mods_item<MQK>(p, 0, MQK * (j / W0), MODP_NC0 + j % W0, scr, lane);
    else { const int q = j - MODQ0; mods_item<MQK>(p, 1, MQK * (q / W1), MODP_NC1 + q % W1, scr, lane); }
}
__device__ __forceinline__ void phase_prologue(const Prm& p, LAS unsigned char* lds, int gw, int ngw, int wave, int lane, bool first) {
    LAS float* scr = (LAS float*)(lds + wave * 16384);
    unsigned char* ws = p.ws;
    t_convert_pairs(p, 0, (CONV_QUEUE && Q_L0EXP) ? NP_PROJ : NPL, scr, gw, ngw, lane);
    if (!CONV_QUEUE) t_convert_pairs(p, 1, NPL, scr, gw, ngw, lane);
    t_convert_all<false>(p, scr, gw, ngw, lane);
    for (int it = gw; first && it < MODP_ITEMS; it += ngw) {
        if (it < MODP_ITEMS0) mods_item<MPK>(p, 0, MPK * (it / (MODP_NC0 + (MODP_NC0 == 0))), it % (MODP_NC0 + (MODP_NC0 == 0)), scr, lane);
        else { const int q = it - MODP_ITEMS0; mods_item<MPK>(p, 1, MPK * (q / (MODP_NC1 + (MODP_NC1 == 0))), q % (MODP_NC1 + (MODP_NC1 == 0)), scr, lane); } }
    for (int it = gw * 64 + lane; it < 128 * 32; it += ngw * 64) { const int pos = it >> 5, i = it & 31; const float inv = powf(10000.f, -(float)i / 32.f), ang = (float)pos * inv;
        ((float*)(ws + WS_ROPE))[2 * it] = cosf(ang); ((float*)(ws + WS_ROPE))[2 * it + 1] = sinf(ang); }
}

__device__ __forceinline__ f32x4 modv4(const float* p) {
    typedef int i32x4 __attribute__((ext_vector_type(4)));
    const i32x4 v = *(const i32x4*)p; return (f32x4){(float)v[0], (float)v[1], (float)v[2], (float)v[3]} * (1.f / 16777216.f);
}
__device__ __forceinline__ f32x4 bf4(v2u w) { return (f32x4){bflo(w.x), bfhi(w.x), bflo(w.y), bfhi(w.y)}; }
__device__ __forceinline__ void load_row(const Prm& p, int l, int lcomb, int m, int lane, f32x4 (&v)[8], bool wb = true, const LAS int* segL = nullptr) {
    const bool isc = m >= T_LAT;
    const bf16* wsrow = isc ? (const bf16*)(p.ws + WS_XC) + (size_t)(m - T_LAT) * DM : (const bf16*)(p.ws + WS_X) + (size_t)m * DM;
#pragma unroll
    for (int j = 0; j < 8; ++j) v[j] = bf4(*(const v2u*)(wsrow + 256 * j + 4 * lane));
}
__device__ __forceinline__ float row_rstd(const f32x4 (&v)[8]) {
    float s = 0.f;
#pragma unroll
    for (int j = 0; j < 8; ++j) s += (v[j][0] * v[j][0] + v[j][1] * v[j][1]) + (v[j][2] * v[j][2] + v[j][3] * v[j][3]);
    return rsqrtf(wave_sum(s) * (1.f / DM) + EPS);
}
__device__ __forceinline__ f32x4 modulate4f(const f32x4 v, float rstd, const float* gain, const float* sc, const float* sh, int col) {
    const f32x4 g = *(const f32x4*)(gain + col), s1 = modv4(sc + col), s0 = modv4(sh + col);
    return (v * rstd * g) * (s1 + 1.f) + s0;
}
__device__ __forceinline__ v2u modulate4(const f32x4 v, float rstd, const float* gain, const float* sc, const float* sh, int col) {
    const f32x4 g = *(const f32x4*)(gain + col), s1 = modv4(sc + col), s0 = modv4(sh + col);
    const f32x4 o = (v * rstd * g) * (s1 + 1.f) + s0;
    v2u w; w.x = pk2(o[0], o[1]); w.y = pk2(o[2], o[3]); return w;
}
constexpr int RS_A = 0, RS_SH = 3 * 8192, RS_GF = 6 * 8192, RS_END = 9 * 8192;
struct RowX { f32x4 x[8]; v2u xb[8]; unsigned ya[8], yb[8]; };
struct RowI { int s; float g; };
template <bool COMB> __device__ __forceinline__ RowI rs_idx_issue(const Prm& p, int m, int lane, int& e_out, int& pos_out) {
    RowI r; r.s = 0; r.g = 0.f; e_out = 0; pos_out = 0;
    if constexpr (COMB) { const int k = lane & 1; const int* te = (const int*)(p.ws + WS_TOK); const int* tp = (const int*)(p.ws + WS_TOK + TOKTAB); const float* tg = (const float*)(p.ws + WS_TOK + 2 * TOKTAB);
        e_out = te[2 * m + k]; pos_out = tp[2 * m + k]; r.g = tg[2 * m + k]; }
    return r;
}
template <bool COMB, bool SRC32> __device__ __forceinline__ void rs_issue(const Prm& p, int m, int s0, int s1, int lane, RowX& b) {
    const bool isc = m >= T_LAT;
    if constexpr (SRC32) { const float* src = isc ? p.ctx + (size_t)(m - T_LAT) * DM : p.x + (size_t)m * DM;
#pragma unroll
        for (int j = 0; j < 8; ++j) b.x[j] = __builtin_nontemporal_load((const f32x4*)(src + 256 * j + 4 * lane)); }
    else { const bf16* src = isc ? (const bf16*)(p.ws + WS_XC) + (size_t)(m - T_LAT) * DM : (const bf16*)(p.ws + WS_X) + (size_t)m * DM;
#pragma unroll
        for (int j = 0; j < 8; ++j) b.xb[j] = *(const v2u*)(src + 256 * j + 4 * lane); }
    if constexpr (COMB) { const unsigned char* y0 = p.ws + WS_YB + (size_t)s0 * DM; const unsigned char* y1 = p.ws + WS_YB + (size_t)s1 * DM;
#pragma unroll
        for (int j = 0; j < 8; ++j) { b.ya[j] = __builtin_nontemporal_load((const unsigned*)(y0 + 256 * j + 4 * lane)); b.yb[j] = __builtin_nontemporal_load((const unsigned*)(y1 + 256 * j + 4 * lane)); } }
}
template <bool COMB, bool FINAL, bool SRC32> __device__ __forceinline__ void rs_finish(const Prm& p, int l, int m, float g0, float g1, int lane, RowX& b, const LAS unsigned char* vl, bool live) {
    const bool isc = m >= T_LAT; const int vs = isc ? 2 : (m >> 13);
    const LAS float* A = (const LAS float*)(vl + RS_A) + vs * 2048; const LAS float* SH = (const LAS float*)(vl + RS_SH) + vs * 2048; const LAS float* GF = (const LAS float*)(vl + RS_GF) + vs * 2048;
    if constexpr (!SRC32) {
#pragma unroll
        for (int j = 0; j < 8; ++j) b.x[j] = bf4(b.xb[j]); }
    if constexpr (COMB) {
        bf16* wsrow = isc ? (bf16*)(p.ws + WS_XC) + (size_t)(m - T_LAT) * DM : (bf16*)(p.ws + WS_X) + (size_t)m * DM;
#pragma unroll
        for (int j = 0; j < 8; ++j) { const int col = 256 * j + 4 * lane; const unsigned a = b.ya[j], c = b.yb[j]; const f32x4 gq = *(const LAS f32x4*)(GF + col);
            const f32x2 a01 = __builtin_amdgcn_cvt_pk_f32_fp8(a, false), a23 = __builtin_amdgcn_cvt_pk_f32_fp8(a, true), c01 = __builtin_amdgcn_cvt_pk_f32_fp8(c, false), c23 = __builtin_amdgcn_cvt_pk_f32_fp8(c, true);
            b.x[j][0] += gq[0] * (g0 * a01[0] + g1 * c01[0]); b.x[j][1] += gq[1] * (g0 * a01[1] + g1 * c01[1]);
            b.x[j][2] += gq[2] * (g0 * a23[0] + g1 * c23[0]); b.x[j][3] += gq[3] * (g0 * a23[1] + g1 * c23[1]);
            if (!FINAL && live) { v2u w; w.x = pk2(b.x[j][0], b.x[j][1]); w.y = pk2(b.x[j][2], b.x[j][3]); *(v2u*)(wsrow + col) = w; } } }
    const float rstd = row_rstd(b.x);
    if (!live) return;
#pragma unroll
    for (int j = 0; j < 8; ++j) { const int col = 256 * j + 4 * lane; const f32x4 av = *(const LAS f32x4*)(A + col);
        if constexpr (FINAL) { __builtin_nontemporal_store(b.x[j] * rstd * av, (f32x4*)(p.out + (size_t)m * DM + col)); }
        else { const f32x4 o = b.x[j] * rstd * av + *(const LAS f32x4*)(SH + col);
            if (F8_INPROJ) *(unsigned*)(p.ws + WS_H + (size_t)m * DM + col) = pack4f8(o[0], o[1], o[2], o[3]);
            else { v2u w; w.x = pk2(o[0], o[1]); w.y = pk2(o[2], o[3]); *(v2u*)((bf16*)(p.ws + WS_H) + (size_t)m * DM + col) = w; } } }
}
template <bool COMB, bool FINAL, bool SRC32> __device__ __forceinline__ void row_stream(const Prm& p, int l, int lc, int nrows, int gw, int ngw, int tid, int lane, LAS unsigned char* vl, const LAS int* segL) {
    { const float* md = (const float*)(p.ws + OFF_MOD);
      for (int q = tid; q < 3 * 512; q += NWAVES * 64) { const int vs = q >> 9, c4 = (q & 511) * 4;
          if (FINAL) { if (vs == 0) *(LAS f32x4*)(vl + RS_A + (size_t)c4 * 4) = *(const f32x4*)(p.norm_final + c4); }
          else { const f32x4 gn = *(const f32x4*)(p.norm_mix + l * DM + c4), sc = modv4(md + (size_t)(l * 3 + vs) * MODW + DM + c4), sh = modv4(md + (size_t)(l * 3 + vs) * MODW + c4);
              *(LAS f32x4*)(vl + RS_A + ((size_t)vs * 2048 + c4) * 4) = gn * (sc + 1.f); *(LAS f32x4*)(vl + RS_SH + ((size_t)vs * 2048 + c4) * 4) = sh; }
          if (COMB) *(LAS f32x4*)(vl + RS_GF + ((size_t)vs * 2048 + c4) * 4) = modv4(md + (size_t)(lc * 3 + vs) * MODW + 5 * DM + c4) * (1.f / Y8_SCALE); }
      if (FINAL) { for (int q = tid; q < 2 * 512; q += NWAVES * 64) { const int c4 = (q & 511) * 4; *(LAS f32x4*)(vl + RS_A + ((size_t)(1 + (q >> 9)) * 2048 + c4) * 4) = *(const f32x4*)(p.norm_final + c4); } }
      __syncthreads(); }
    const int nit = gw < nrows ? (nrows - gw + ngw - 1) / ngw : 0;
    if (nit == 0) return;
    const int last = gw + (nit - 1) * ngw;
#define RS_ROW(i) min(gw + (i) * ngw, last)
    RowX bA, bB; int e0, p0, e1, p1; RowI i0 = rs_idx_issue<COMB>(p, RS_ROW(0), lane, e0, p0), i1 = rs_idx_issue<COMB>(p, RS_ROW(1), lane, e1, p1);
    { int s = COMB ? segL[e0] + p0 : 0; rs_issue<COMB, SRC32>(p, RS_ROW(0), __shfl(s, 0), __shfl(s, 1), lane, bA); }
#pragma unroll 1
    for (int i = 0; i < nit; i += 2) {
        int e2, p2, e3, p3;
        const RowI i2 = rs_idx_issue<COMB>(p, RS_ROW(i + 2), lane, e2, p2);
        { int s = COMB ? segL[e1] + p1 : 0; rs_issue<COMB, SRC32>(p, RS_ROW(i + 1), __shfl(s, 0), __shfl(s, 1), lane, bB); }
        rs_finish<COMB, FINAL, SRC32>(p, l, RS_ROW(i), __shfl(i0.g, 0), __shfl(i0.g, 1), lane, bA, vl, true);
        const RowI i3 = rs_idx_issue<COMB>(p, RS_ROW(i + 3), lane, e3, p3);
        { int s = COMB ? segL[e2] + p2 : 0; rs_issue<COMB, SRC32>(p, RS_ROW(i + 2), __shfl(s, 0), __shfl(s, 1), lane, bA); }
        rs_finish<COMB, FINAL, SRC32>(p, l, RS_ROW(i + 1), __shfl(i1.g, 0), __shfl(i1.g, 1), lane, bB, vl, i + 1 < nit);
        i0 = i2; i1 = i3; e1 = e3; p1 = p3;
    }
#undef RS_ROW
}
#ifndef Q_L0EXP
#define Q_L0EXP 1
#endif
constexpr int Q_L0 = Q_L0EXP ? NP_EXP : 0;
constexpr int Q_MOD = Q_L0EXP ? MODQ : 0;
constexpr int Q_L1 = Q_L0 + Q_MOD;
constexpr int Q_TOTAL = Q_L1 + NPL;
static_assert(Q_L0 % 16 == 0 && Q_L1 % 16 == 0 && (Q_L1 + NP_PROJ) % 16 == 0, "drain targets are multiples of the largest grab");
__device__ __forceinline__ void q_decode(unsigned q, int& kind, int& l, int& idx) {
    if (q < (unsigned)Q_L0) { kind = 0; l = 0; idx = (int)q + NP_PROJ; } else if (q < (unsigned)Q_L1) { kind = 1; l = 0; idx = (int)q - Q_L0; } else { kind = 0; l = 1; idx = (int)q - Q_L1; }
}
__device__ __forceinline__ void queue_convert8(const Prm& p, unsigned base, int n, LAS unsigned char* lds, int tid_in) {
    int tid = tid_in;
    asm volatile("" : "+v"(tid));
    const int wave = __builtin_amdgcn_readfirstlane(tid >> 6), lane = tid & 63; const unsigned q0 = base + (unsigned)wave, q1 = q0 + 8u;
    LAS float* scr = (LAS float*)(lds + wave * 16384);
    const bool h0 = q0 < (unsigned)Q_TOTAL, h1 = n == 16 && q1 < (unsigned)Q_TOTAL;
    int k0 = 0, l0 = 0, i0 = 0, k1 = 0, l1 = 0, i1 = 0; q_decode(q0, k0, l0, i0); q_decode(q1, k1, l1, i1);
    if (h0 && h1 && k0 == 0 && k1 == 0) { t_convert_two(p, l0, i0, l1, i1, true, scr, lane); return; }
    if (h0) { if (k0 == 0) t_convert_one(p, l0, i0, scr, lane); else mods_queue_item(p, i0, scr, lane); }
    if (h1) { if (k1 == 0) t_convert_one(p, l1, i1, scr, lane); else mods_queue_item(p, i1, scr, lane); }
}
__device__ __forceinline__ void xcd_barrier_work(const XcdBarrier& b, const Prm& p, LAS unsigned char* lds, int tid, int grab) {
    asm volatile("s_waitcnt vmcnt(0)" ::: "memory");
    __syncthreads();
    volatile LAS unsigned* bw = (volatile LAS unsigned*)(lds + L_BWORK);
    unsigned* bar = b.bar; unsigned* q = (unsigned*)(p.ws + OFF_Q);
    if (threadIdx.x == 0) {
        __builtin_amdgcn_s_waitcnt(0);
        unsigned nloc = b.st[0], nx = b.st[1];
        if (nloc == 0u) { xcd_barrier_complete(bar, b.x, nloc, nx); b.st[0] = nloc; b.st[1] = nx; }
        const unsigned old = xb_add(&bar[XB_XSUB(b.x)], 1u);
        const unsigned gen = old / nloc;
        if (old + 1u == (gen + 1u) * nloc) {
            __builtin_amdgcn_fence(__ATOMIC_RELEASE, "agent");
            asm volatile("s_waitcnt vmcnt(0)" ::: "memory");
            const unsigned og = xb_add(&bar[XB_TOP], 1u);
            const unsigned tg = og / nx;
            if (og + 1u == (tg + 1u) * nx) xb_add(&bar[XB_TOPGEN], 1u);
            else XB_SPIN(xb_ld(&bar[XB_TOPGEN]) == tg, bar);
            __builtin_amdgcn_fence(__ATOMIC_ACQUIRE, "agent");
            xb_add(&bar[XB_XGEN(b.x)], 1u);
            asm volatile("s_waitcnt vmcnt(0)" ::: "memory");
            bw[0] = 1u;
        } else { bw[0] = 0u; bw[2] = gen; }
    }
    __syncthreads();
    if (bw[0] == 0u) {
        unsigned sp = 0u;
        for (;;) {
            if (threadIdx.x == 0) {
                const unsigned gen = bw[2];
                bool rel = xb_ld(&bar[XB_XGEN(b.x)]) != gen;
                if (!rel && ((++sp & 63u) == 0u)) { if (xb_ld(&bar[XB_TMO])) rel = true; else if (sp > XB_SPIN_CAP) { atomicAdd(&bar[XB_TMO], 1u); rel = true; } }
                if (rel) { __builtin_amdgcn_fence(__ATOMIC_ACQUIRE, "agent"); asm volatile("s_waitcnt vmcnt(0)" ::: "memory"); bw[0] = 1u; }
                else { unsigned base = 0xffffffffu; if (xb_ld(q) < (unsigned)Q_TOTAL) { base = xb_add(q, (unsigned)grab); if (base >= (unsigned)Q_TOTAL) base = 0xffffffffu; } bw[1] = base; }
            }
            __syncthreads();
            if (bw[0]) break;
            const unsigned base = bw[1];
            if (base != 0xffffffffu) queue_convert8(p, base, grab, lds, tid); else __builtin_amdgcn_s_sleep(4);
            __syncthreads();
        }
    }
    __syncthreads();
}
__device__ __forceinline__ void queue_drain(const Prm& p, LAS unsigned char* lds, int tid, unsigned target) {
    volatile LAS unsigned* bw = (volatile LAS unsigned*)(lds + L_BWORK); unsigned* q = (unsigned*)(p.ws + OFF_Q);
    __syncthreads();
    for (;;) {
        if (threadIdx.x == 0) bw[1] = (xb_ld(q) < target) ? xb_add(q, 16u) : 0xffffffffu;
        __syncthreads();
        const unsigned base = bw[1];
        if (base >= target) break;
        queue_convert8(p, base, 16, lds, tid);
        __syncthreads();
    }
    __syncthreads();
}
__device__ __forceinline__ void phase_conv(const Prm& p, int l, int gw, int ngw, int lane) {
    const bf16* U = (const bf16*)(p.ws + WS_U); bf16* XA = (bf16*)(p.ws + WS_XBC); float* DT = (float*)(p.ws + WS_DT);
    constexpr int NRUN = T_ALL / 16;
    for (int it = gw; it < NRUN * 3; it += ngw) {
        const int run = it / 3, cb = it % 3, t0 = run * 16, ch = cb * 512 + lane * 8;
        int seq0, seq1; if (t0 < T_LAT) { seq0 = t0 & ~(SEQL - 1); seq1 = seq0 + SEQL; } else { seq0 = T_LAT + ((t0 - T_LAT) & ~(CTXL - 1)); seq1 = seq0 + CTXL; }
        float w[5][8], bias[8];
#pragma unroll
        for (int j = 0; j < 5; ++j) { const f32x4 a = *(const f32x4*)(p.conv_w + ((size_t)l * 5 + j) * XBCW + ch), b = *(const f32x4*)(p.conv_w + ((size_t)l * 5 + j) * XBCW + ch + 4);
            w[j][0] = a[0]; w[j][1] = a[1]; w[j][2] = a[2]; w[j][3] = a[3]; w[j][4] = b[0]; w[j][5] = b[1]; w[j][6] = b[2]; w[j][7] = b[3]; }
        { const f32x4 a = *(const f32x4*)(p.conv_b + (size_t)l * XBCW + ch), b = *(const f32x4*)(p.conv_b + (size_t)l * XBCW + ch + 4);
            bias[0] = a[0]; bias[1] = a[1]; bias[2] = a[2]; bias[3] = a[3]; bias[4] = b[0]; bias[5] = b[1]; bias[6] = b[2]; bias[7] = b[3]; }
        v4u rows[20];
#pragma unroll
        for (int j = 0; j < 20; ++j) { const int t = t0 - 2 + j, tc = min(max(t, seq0), seq1 - 1); rows[j] = __builtin_nontemporal_load((const v4u*)(U + (size_t)tc * NINP + C_XBC + ch)); }
#pragma unroll
        for (int j = 0; j < 20; ++j) { const int t = t0 - 2 + j; if (t < seq0 || t >= seq1) rows[j] = (v4u){0u, 0u, 0u, 0u}; }
#pragma unroll
        for (int i = 0; i < 16; ++i) {
            const int t = t0 + i;
            float o[8];
#pragma unroll
            for (int c = 0; c < 8; ++c) o[c] = bias[c];
#pragma unroll
            for (int j = 0; j < 5; ++j) { const v4u wv = rows[i + j];
                o[0] += w[j][0] * bflo(wv.x); o[1] += w[j][1] * bfhi(wv.x); o[2] += w[j][2] * bflo(wv.y); o[3] += w[j][3] * bfhi(wv.y);
                o[4] += w[j][4] * bflo(wv.z); o[5] += w[j][5] * bfhi(wv.z); o[6] += w[j][6] * bflo(wv.w); o[7] += w[j][7] * bfhi(wv.w); }
            v4u r; r.x = pk2(silu_f(o[0]), silu_f(o[1])); r.y = pk2(silu_f(o[2]), silu_f(o[3])); r.z = pk2(silu_f(o[4]), silu_f(o[5])); r.w = pk2(silu_f(o[6]), silu_f(o[7]));
            *(v4u*)(XA + (size_t)t * XBCW + ch) = r;
        }
    }
    for (int it = gw * 64 + lane; it < T_ALL * 32; it += ngw * 64) { const int m = it >> 5, j = it & 31;
        DT[it] = softplus_f(bf2f(U[(size_t)m * NINP + C_DT + j]) + p.dt_bias[l * 32 + j]); }
}

__device__ __forceinline__ void naive_attn_item(const Prm& p, int l, int type, int m, int hh, LAS float* qs, LAS float* sc, int lane) {
    const bf16* U = (const bf16*)(p.ws + WS_U); bf16* MIX = (bf16*)(p.ws + WS_H);
    int qcol, kcol, vcol, ocol;
    if (type == 0 || type == 2) { qcol = C_QA + hh * 128; kcol = C_KA + hh * 128; vcol = C_VA + hh * 128; ocol = hh * 128; }
    else { const int kvh = hh >> 1; qcol = C_QB + hh * 128; kcol = C_KB + kvh * 128; vcol = C_VB + kvh * 128; ocol = 512 + hh * 128; }
    { const unsigned w = *(const unsigned*)(U + (size_t)m * NINP + qcol + 2 * lane); qs[2 * lane] = bflo(w); qs[2 * lane + 1] = bfhi(w); }
    int b, s = 0, qr = 0, qc = 0, krow0 = 0, kpos0 = 0;
    if (type < 2) { b = m >> 13; s = m & 8191; qr = s >> 6; qc = s & 63; } else { b = (m - T_LAT) >> 8; }
    const int nloc = type == 0 ? 512 : (type == 1 ? 384 : 0), nk = nloc + 256;
    if (type == 0) krow0 = min(max(qr - 4, 0), 120);
    if (type == 1) kpos0 = (s >> 7) * 128 - 128;
    const float* rpb = p.na_rpb + (size_t)(l * 4 + hh) * 15 * 31;
    LDS_WAIT(); __builtin_amdgcn_wave_barrier(); asm volatile("" ::: "memory");
    float mx = -INFINITY;
    for (int k0 = 0; k0 < nk; k0 += 64) {
        const int kidx = k0 + lane; int row; float bias = 0.f; bool valid = true;
        if (kidx < nloc) {
            if (type == 0) { const int kr = krow0 + (kidx >> 6), kc = kidx & 63; row = b * SEQL + kr * 64 + kc; const int c0 = min(max(qc - 8, 0), 48); valid = (kc >= c0) && (kc < c0 + 16);
                const int dr = kr - qr + 7, dc = min(max(kc - qc + 15, 0), 30); bias = rpb[dr * 31 + dc]; }
            else { const int kpos = kpos0 + kidx; valid = (kpos >= 0) && (kpos < SEQL) && (abs(s - kpos) <= 128); row = b * SEQL + min(max(kpos, 0), SEQL - 1); }
        } else row = T_LAT + b * CTXL + (kidx - nloc);
        const bf16* kp = U + (size_t)row * NINP + kcol; float d = 0.f;
#pragma unroll 4
        for (int c = 0; c < 16; ++c) { const v4u w = *(const v4u*)(kp + 8 * c); const LAS float* q = qs + 8 * c;
            d += bflo(w.x) * q[0] + bfhi(w.x) * q[1] + bflo(w.y) * q[2] + bfhi(w.y) * q[3] + bflo(w.z) * q[4] + bfhi(w.z) * q[5] + bflo(w.w) * q[6] + bfhi(w.w) * q[7]; }
        const float sv = valid ? d * ATT_SCALE + bias : -INFINITY;
        sc[kidx] = sv; mx = fmaxf(mx, sv);
    }
    mx = wave_max(mx);
    float sum = 0.f;
    for (int k0 = 0; k0 < nk; k0 += 64) { const float e = __expf(sc[k0 + lane] - mx); sc[k0 + lane] = e; sum += e; }
    sum = wave_sum(sum);
    if (type == 1 || type == 3) sum += __expf(p.wa_sink[l * 4 + hh] - mx);
    LDS_WAIT(); __builtin_amdgcn_wave_barrier(); asm volatile("" ::: "memory");
    float o0 = 0.f, o1 = 0.f;
    for (int kidx = 0; kidx < nk; ++kidx) {
        int row;
        if (kidx < nloc) { if (type == 0) row = b * SEQL + (krow0 + (kidx >> 6)) * 64 + (kidx & 63); else row = b * SEQL + min(max(kpos0 + kidx, 0), SEQL - 1); }
        else row = T_LAT + b * CTXL + (kidx - nloc);
        const float pv = sc[kidx]; const unsigned w = *(const unsigned*)(U + (size_t)row * NINP + vcol + 2 * lane);
        o0 += pv * bflo(w); o1 += pv * bfhi(w);
    }
    const float inv = 1.f / sum;
    *(unsigned*)(MIX + (size_t)m * DM + ocol + 2 * lane) = pk2(o0 * inv, o1 * inv);
    LDS_WAIT(); __builtin_amdgcn_wave_barrier(); asm volatile("" ::: "memory");
}
__device__ __forceinline__ void phase_attn_naive(const Prm& p, int l, LAS unsigned char* lds, int gw, int ngw, int wave, int lane) {
    LAS float* qs = (LAS float*)(lds + wave * 4096); LAS float* sc = qs + 128;
    const int nlat = T_LAT * 8, nctx = (l == 0) ? T_CTX * 8 : 0;
    for (int it = gw; it < nlat + nctx; it += ngw) {
        if (it < nlat) { const int m = it >> 3, h8 = it & 7; naive_attn_item(p, l, h8 >> 2, m, h8 & 3, qs, sc, lane); }
        else { const int r = it - nlat, m = T_LAT + (r >> 3), h8 = r & 7; naive_attn_item(p, l, 2 + (h8 >> 2), m, h8 & 3, qs, sc, lane); }
    }
}

__device__ __forceinline__ void phase_ssd_naive(const Prm& p, int l, int wg, int nwg, int tid) {
    const bf16* XA = (const bf16*)(p.ws + WS_XBC); const float* DT = (const float*)(p.ws + WS_DT); float* YD = (float*)(p.ws + WS_YD);
    for (int it = wg; it < 64; it += nwg) {
        const int b = it >> 5, dir = (it >> 4) & 1, h = it & 15, g = h >> 3;
        const int pp = tid >> 3, nq = tid & 7;
        const float a = -__expf(p.a_log[l * 32 + dir * 16 + h]), dsk = p.d_skip[l * 32 + dir * 16 + h];
        float hs[16];
#pragma unroll
        for (int i = 0; i < 16; ++i) hs[i] = 0.f;
#pragma unroll 4
        for (int st = 0; st < CTXL + SEQL; ++st) {
            int m; if (st < CTXL) m = T_LAT + b * CTXL + (dir ? CTXL - 1 - st : st); else { const int s = st - CTXL; m = b * SEQL + (dir ? SEQL - 1 - s : s); }
            const float dtv = DT[(size_t)m * 32 + dir * 16 + h];
            const bf16* row = XA + (size_t)m * XBCW;
            const float xv = bf2f(row[h * 64 + pp]);
            const v4u b0 = *(const v4u*)(row + 1024 + g * 128 + 16 * nq), b1 = *(const v4u*)(row + 1024 + g * 128 + 16 * nq + 8);
            const v4u c0 = *(const v4u*)(row + 1280 + g * 128 + 16 * nq), c1 = *(const v4u*)(row + 1280 + g * 128 + 16 * nq + 8);
            const float dA = __expf(a * dtv), dx = dtv * xv;
            float bv[16], cv[16];
            bv[0] = bflo(b0.x); bv[1] = bfhi(b0.x); bv[2] = bflo(b0.y); bv[3] = bfhi(b0.y); bv[4] = bflo(b0.z); bv[5] = bfhi(b0.z); bv[6] = bflo(b0.w); bv[7] = bfhi(b0.w);
            bv[8] = bflo(b1.x); bv[9] = bfhi(b1.x); bv[10] = bflo(b1.y); bv[11] = bfhi(b1.y); bv[12] = bflo(b1.z); bv[13] = bfhi(b1.z); bv[14] = bflo(b1.w); bv[15] = bfhi(b1.w);
            cv[0] = bflo(c0.x); cv[1] = bfhi(c0.x); cv[2] = bflo(c0.y); cv[3] = bfhi(c0.y); cv[4] = bflo(c0.z); cv[5] = bfhi(c0.z); cv[6] = bflo(c0.w); cv[7] = bfhi(c0.w);
            cv[8] = bflo(c1.x); cv[9] = bfhi(c1.x); cv[10] = bflo(c1.y); cv[11] = bfhi(c1.y); cv[12] = bflo(c1.z); cv[13] = bfhi(c1.z); cv[14] = bflo(c1.w); cv[15] = bfhi(c1.w);
            float part = 0.f;
#pragma unroll
            for (int i = 0; i < 16; ++i) { hs[i] = dA * hs[i] + dx * bv[i]; part += cv[i] * hs[i]; }
            part += __shfl_xor(part, 1); part += __shfl_xor(part, 2); part += __shfl_xor(part, 4);
            if (nq == 0) YD[((size_t)dir * T_ALL + m) * 1024 + h * 64 + pp] = part + dsk * xv;
        }
    }
}
__device__ __forceinline__ void phase_gnorm(const Prm& p, int l, int gw, int ngw, int lane) {
    const bf16* U = (const bf16*)(p.ws + WS_U); const bf16* YD = (const bf16*)(p.ws + WS_XG); bf16* MIX = (bf16*)(p.ws + WS_H);
    const int nrow = (l == 0) ? T_ALL : T_LAT;
    for (int m0 = gw; m0 < nrow; m0 += 2 * ngw) {
        const int m1 = (m0 + ngw < nrow) ? m0 + ngw : m0;
        v2u yv[2][4], zv[2][4];
#pragma unroll
        for (int q = 0; q < 2; ++q) { const int m = q ? m1 : m0;
#pragma unroll
            for (int j = 0; j < 4; ++j) { const int col = 256 * j + 4 * lane; yv[q][j] = __builtin_nontemporal_load((const v2u*)(YD + (size_t)m * 1024 + col)); zv[q][j] = __builtin_nontemporal_load((const v2u*)(U + (size_t)m * NINP + C_Z + col)); } }
#pragma unroll
        for (int q = 0; q < 2; ++q) { const int m = q ? m1 : m0;
            f32x4 u[4]; float ss[2] = {0.f, 0.f};
#pragma unroll
            for (int j = 0; j < 4; ++j) { const v2u yy = yv[q][j], zz = zv[q][j];
                u[j][0] = bflo(yy.x) * silu_f(bflo(zz.x)); u[j][1] = bfhi(yy.x) * silu_f(bfhi(zz.x)); u[j][2] = bflo(yy.y) * silu_f(bflo(zz.y)); u[j][3] = bfhi(yy.y) * silu_f(bfhi(zz.y));
                ss[j >> 1] += (u[j][0] * u[j][0] + u[j][1] * u[j][1]) + (u[j][2] * u[j][2] + u[j][3] * u[j][3]); }
            const float r0 = rsqrtf(wave_sum(ss[0]) * (1.f / 512.f) + EPS), r1 = rsqrtf(wave_sum(ss[1]) * (1.f / 512.f) + EPS);
            if (q == 1 && m1 == m0) continue;
#pragma unroll
            for (int j = 0; j < 4; ++j) { const int col = 256 * j + 4 * lane; const f32x4 g = *(const f32x4*)(p.ssd_norm + l * 1024 + col); const f32x4 o = u[j] * (j < 2 ? r0 : r1) * g;
                if (F8_OUTPROJ) *(unsigned*)((unsigned char*)MIX + (size_t)m * DM + 1024 + col) = pack4f8(o[0] * MIX_SCALE, o[1] * MIX_SCALE, o[2] * MIX_SCALE, o[3] * MIX_SCALE);
                else { v2u w; w.x = pk2(o[0], o[1]); w.y = pk2(o[2], o[3]); *(v2u*)(MIX + (size_t)m * DM + 1024 + col) = w; } }
        }
    }
}
#ifdef PROBE_AT
#define PAT_SYNC(stmt) do { const long long pa_t0_ = wall_clock64(); stmt; if ((PROBE_AT) & 1) { const long long pa_t1_ = wall_clock64(), pa_d_ = (pa_t1_ - pa_t0_) * (PROBE_MULT); while (wall_clock64() - pa_t1_ < pa_d_) __builtin_amdgcn_s_sleep(2); } } while (0)
#else
#define PAT_SYNC(stmt) stmt
#endif
namespace att {
typedef short s16x4 __attribute__((ext_vector_type(4)));
typedef float f32x16 __attribute__((ext_vector_type(16)));
#ifndef ATT_PV2
#define ATT_PV2 1
#endif
constexpr int KVBLK = 64;
constexpr float THR = 8.f;
#ifndef ATT_SDEPTH
#define ATT_SDEPTH 1
#endif
constexpr int SDEPTH = ATT_SDEPTH;
constexpr int SHM_V = KVBLK * 128 * 2, SHM_K = KVBLK * 128 * 2;
constexpr int OFF_V = 0, OFF_K = 2 * SHM_V, OFF_WS = 2 * SHM_V + 2 * SHM_K, OFF_RPB = OFF_WS + 8 * 64 * 4, ATT_LDS = OFF_RPB + 576 * 4;
#define KSWZ(row, colB) ((row) * 256 + ((colB) ^ (((row) & 15) << 4)))
#define SBAR() __builtin_amdgcn_sched_barrier(0)
__device__ __forceinline__ int crow(int r, int hi) { return (r & 3) + 8 * (r >> 2) + 4 * hi; }
__device__ __forceinline__ unsigned cvtpk(float lo, float hi) { unsigned r; asm volatile("v_cvt_pk_bf16_f32 %0, %1, %2" : "=v"(r) : "v"(lo), "v"(hi)); return r; }
__device__ __forceinline__ void partialSM(f32x16& p0, f32x16& p1, float& m_reg, float& mn, float& alpha) {
  constexpr float C = ATT_SCALE * 1.4426950408889634f;
  float pmax = p0[0];
#pragma unroll
  for (int r = 1; r < 16; ++r) pmax = fmaxf(pmax, p0[r]);
#pragma unroll
  for (int r = 0; r < 16; ++r) pmax = fmaxf(pmax, p1[r]);
  { auto rr = __builtin_amdgcn_permlane32_swap(__float_as_uint(pmax), __float_as_uint(pmax), false, false);
    pmax = fmaxf(__uint_as_float(rr[0]), __uint_as_float(rr[1])); }
  if (__builtin_expect(__all(pmax - m_reg <= THR / ATT_SCALE), 1)) { mn = m_reg; alpha = 1.f; }
  else { mn = fmaxf(m_reg, pmax); alpha = __builtin_amdgcn_exp2f((m_reg - mn) * C); m_reg = mn; }
  float mnC = -mn * C;
#pragma unroll
  for (int r = 0; r < 16; ++r) p0[r] = fmaf(p0[r], C, mnC);
#pragma unroll
  for (int r = 0; r < 16; ++r) p1[r] = fmaf(p1[r], C, mnC);
#pragma unroll
  for (int r = 0; r < 16; ++r) p0[r] = __builtin_amdgcn_exp2f(p0[r]);
}
__device__ __forceinline__ void finishSM(f32x16& p0, f32x16& p1, float alpha, float& l_reg, bf16x8& pa0, bf16x8& pa1, bf16x8& pa2, bf16x8& pa3) {
#pragma unroll
  for (int r = 0; r < 16; ++r) p1[r] = __builtin_amdgcn_exp2f(p1[r]);
  float ps = 0;
#pragma unroll
  for (int r = 0; r < 16; ++r) ps += p0[r];
#pragma unroll
  for (int r = 0; r < 16; ++r) ps += p1[r];
  { auto rr = __builtin_amdgcn_permlane32_swap(__float_as_uint(ps), __float_as_uint(ps), false, false);
    ps = __uint_as_float(rr[0]) + __uint_as_float(rr[1]); }
  l_reg = l_reg * alpha + ps;
#define PK4(P, BASE, OUT) do { unsigned a0 = cvtpk(P[BASE + 0], P[BASE + 1]), a1 = cvtpk(P[BASE + 2], P[BASE + 3]);   \
    unsigned b0 = cvtpk(P[BASE + 4], P[BASE + 5]), b1 = cvtpk(P[BASE + 6], P[BASE + 7]);                              \
    auto r0 = __builtin_amdgcn_permlane32_swap(a0, b0, false, false); auto r1 = __builtin_amdgcn_permlane32_swap(a1, b1, false, false); \
    v4u w = {r0[0], r1[0], r0[1], r1[1]}; OUT = *reinterpret_cast<bf16x8*>(&w); } while (0)
  PK4(p0, 0, pa0); PK4(p0, 8, pa1); PK4(p1, 0, pa2); PK4(p1, 8, pa3);
#undef PK4
}
__device__ __forceinline__ void qkt(f32x16& p0, f32x16& p1, const LAS unsigned char* Ks, const bf16x8* qr, int r32, int hi) {
  p0 = f32x16{}; p1 = f32x16{};
  bf16x8 ka[2], kb[2];
#define KLD(d0, sl) do { const int cb_ = ((d0) * 16 + hi * 8) * 2; ka[sl] = *reinterpret_cast<const LAS bf16x8*>(Ks + KSWZ(r32, cb_)); kb[sl] = *reinterpret_cast<const LAS bf16x8*>(Ks + KSWZ(32 + r32, cb_)); } while (0)
  KLD(0, 0); KLD(1, 1);
#pragma unroll
  for (int d0 = 0; d0 < 8; ++d0) { const int sl = d0 & 1;
    p0 = __builtin_amdgcn_mfma_f32_32x32x16_bf16(ka[sl], qr[d0], p0, 0, 0, 0);
    p1 = __builtin_amdgcn_mfma_f32_32x32x16_bf16(kb[sl], qr[d0], p1, 0, 0, 0);
    if (d0 + 2 < 8) KLD(d0 + 2, sl);
    SBAR(); }
#undef KLD
}
__device__ __forceinline__ int v_st(int k, int c) { const int kk = (k & ~0xC) | ((k & 4) << 1) | ((k & 8) >> 1); return ((kk >> 3) * 4 + (c >> 5)) * 512 + ((kk & 7) * 32 + (c & 31)) * 2; }
__device__ __forceinline__ int v_rd_base(int lane) { return ((lane & 3) << 3) | (((lane >> 2) & 3) << 6) | (((lane >> 4) & 1) << 5) | (((lane >> 5) & 1) << 8); }
constexpr int v_rd_off(int d0, int ks, int half) { return d0 * 512 + ks * 4096 + half * 2048; }
template <int OFF> __device__ __forceinline__ s16x4 tr_read(int vb) {
  s16x4 r; asm volatile("ds_read_b64_tr_b16 %0, %1 offset:%2" : "=&v"(r) : "v"(vb), "i"(OFF) : "memory"); return r;
}
template <int D0> __device__ __forceinline__ void pv_one(f32x16& od, int vb, bf16x8 pa0, bf16x8 pa1, bf16x8 pa2, bf16x8 pa3) {
  const s16x4 l0 = tr_read<v_rd_off(D0, 0, 0)>(vb), h0 = tr_read<v_rd_off(D0, 0, 1)>(vb), l1 = tr_read<v_rd_off(D0, 1, 0)>(vb), h1 = tr_read<v_rd_off(D0, 1, 1)>(vb);
  const s16x4 l2 = tr_read<v_rd_off(D0, 2, 0)>(vb), h2 = tr_read<v_rd_off(D0, 2, 1)>(vb), l3 = tr_read<v_rd_off(D0, 3, 0)>(vb), h3 = tr_read<v_rd_off(D0, 3, 1)>(vb);
  asm volatile("s_waitcnt lgkmcnt(0)" ::: "memory"); SBAR();
#define PK(L, H) (bf16x8){L[0], L[1], L[2], L[3], H[0], H[1], H[2], H[3]}
  od = __builtin_amdgcn_mfma_f32_32x32x16_bf16(pa0, PK(l0, h0), od, 0, 0, 0);
  od = __builtin_amdgcn_mfma_f32_32x32x16_bf16(pa1, PK(l1, h1), od, 0, 0, 0);
  od = __builtin_amdgcn_mfma_f32_32x32x16_bf16(pa2, PK(l2, h2), od, 0, 0, 0);
  od = __builtin_amdgcn_mfma_f32_32x32x16_bf16(pa3, PK(l3, h3), od, 0, 0, 0);
#undef PK
}
template <int D0> __device__ __forceinline__ void pv_two(f32x16& oa, f32x16& ob, int vb, bf16x8 pa0, bf16x8 pa1, bf16x8 pa2, bf16x8 pa3) {
  const s16x4 l0 = tr_read<v_rd_off(D0, 0, 0)>(vb), h0 = tr_read<v_rd_off(D0, 0, 1)>(vb), l1 = tr_read<v_rd_off(D0, 1, 0)>(vb), h1 = tr_read<v_rd_off(D0, 1, 1)>(vb);
  const s16x4 l2 = tr_read<v_rd_off(D0, 2, 0)>(vb), h2 = tr_read<v_rd_off(D0, 2, 1)>(vb), l3 = tr_read<v_rd_off(D0, 3, 0)>(vb), h3 = tr_read<v_rd_off(D0, 3, 1)>(vb);
  const s16x4 m0 = tr_read<v_rd_off(D0 + 1, 0, 0)>(vb), g0 = tr_read<v_rd_off(D0 + 1, 0, 1)>(vb), m1 = tr_read<v_rd_off(D0 + 1, 1, 0)>(vb), g1 = tr_read<v_rd_off(D0 + 1, 1, 1)>(vb);
  const s16x4 m2 = tr_read<v_rd_off(D0 + 1, 2, 0)>(vb), g2 = tr_read<v_rd_off(D0 + 1, 2, 1)>(vb), m3 = tr_read<v_rd_off(D0 + 1, 3, 0)>(vb), g3 = tr_read<v_rd_off(D0 + 1, 3, 1)>(vb);
  asm volatile("s_waitcnt lgkmcnt(0)" ::: "memory"); SBAR();
#define PK(L, H) (bf16x8){L[0], L[1], L[2], L[3], H[0], H[1], H[2], H[3]}
  oa = __builtin_amdgcn_mfma_f32_32x32x16_bf16(pa0, PK(l0, h0), oa, 0, 0, 0);
  ob = __builtin_amdgcn_mfma_f32_32x32x16_bf16(pa0, PK(m0, g0), ob, 0, 0, 0);
  oa = __builtin_amdgcn_mfma_f32_32x32x16_bf16(pa1, PK(l1, h1), oa, 0, 0, 0);
  ob = __builtin_amdgcn_mfma_f32_32x32x16_bf16(pa1, PK(m1, g1), ob, 0, 0, 0);
  oa = __builtin_amdgcn_mfma_f32_32x32x16_bf16(pa2, PK(l2, h2), oa, 0, 0, 0);
  ob = __builtin_amdgcn_mfma_f32_32x32x16_bf16(pa2, PK(m2, g2), ob, 0, 0, 0);
  oa = __builtin_amdgcn_mfma_f32_32x32x16_bf16(pa3, PK(l3, h3), oa, 0, 0, 0);
  ob = __builtin_amdgcn_mfma_f32_32x32x16_bf16(pa3, PK(m3, g3), ob, 0, 0, 0);
#undef PK
}
__device__ __forceinline__ void pv_d0(f32x16* o, int vb, bf16x8 pa0, bf16x8 pa1, bf16x8 pa2, bf16x8 pa3) {
#if ATT_PV2
  pv_two<0>(o[0], o[1], vb, pa0, pa1, pa2, pa3); pv_two<2>(o[2], o[3], vb, pa0, pa1, pa2, pa3);
#else
  pv_one<0>(o[0], vb, pa0, pa1, pa2, pa3); pv_one<1>(o[1], vb, pa0, pa1, pa2, pa3); pv_one<2>(o[2], vb, pa0, pa1, pa2, pa3); pv_one<3>(o[3], vb, pa0, pa1, pa2, pa3);
#endif
}
struct UnitD { int type, b, hh, q0  , nloc  , kbase  ; };
__device__ __forceinline__ int tile_row(const UnitD& u, int j) {
    if (j >= u.nloc) return T_LAT + u.b * CTXL + (j - u.nloc) * 64;
    if (u.type == 0) return u.b * SEQL + (u.kbase + j) * 64;
    const int kp = u.kbase + j * 64; return u.b * SEQL + min(max(kp, 0), SEQL - 64);
}
__device__ __forceinline__ bool tile_active(const UnitD& u, int j, int wid) {
    if (j >= u.nloc) return true;
    if (u.type == 0) { const int qr = (u.q0 >> 6) + (wid >> 1), kr = u.kbase + j, start = min(max(qr - 4, 0), 120); return kr >= start && kr < start + 8; }
    const int qw = u.q0 + 32 * wid, kp0 = u.kbase + j * 64;
    return (kp0 >= 0) && (kp0 < SEQL) && (kp0 - (qw + 31) <= 128) && (qw - (kp0 + 63) <= 128);
}
__device__ __forceinline__ void apply_mask(f32x16& p0, f32x16& p1, const UnitD& u, int j, int wid, int r32, int hi, const LAS float* rpbL) {
    if (j >= u.nloc) return;
    if (u.type == 0) {
        const int qr = (u.q0 >> 6) + (wid >> 1), qc = (wid & 1) * 32 + r32, kr = u.kbase + j;
        const int c0 = min(max(qc - 8, 0), 48), cb = 4 * hi - c0;
        const LAS float* rp = rpbL + (kr - qr + 7) * 31 + 4 * hi - qc + 15 + 32;
#pragma unroll
        for (int g4 = 0; g4 < 4; ++g4) {
            float b0[4], b1[4];
#pragma unroll
            for (int i = 0; i < 4; ++i) { b0[i] = rp[8 * g4 + i]; b1[i] = rp[8 * g4 + i + 32]; }
            asm volatile("" : "+v"(b0[0]), "+v"(b0[1]), "+v"(b0[2]), "+v"(b0[3]), "+v"(b1[0]), "+v"(b1[1]), "+v"(b1[2]), "+v"(b1[3]));
#pragma unroll
            for (int i = 0; i < 4; ++i) { const int r = 4 * g4 + i, k0 = 8 * g4 + i;
                p0[r] = ((unsigned)(k0 + cb) < 16u) ? p0[r] + b0[i] : -INFINITY;
                p1[r] = ((unsigned)(k0 + 32 + cb) < 16u) ? p1[r] + b1[i] : -INFINITY; }
            SBAR(); }
    } else {
        const int qw = u.q0 + 32 * wid, kp0 = u.kbase + j * 64;
        if ((kp0 + 63 - qw <= 128) && (qw + 31 - kp0 <= 128)) return;
        const int cb = kp0 + 4 * hi - (qw + r32) + 128;
#pragma unroll
        for (int r = 0; r < 16; ++r) {
            const int k0 = (r & 3) + 8 * (r >> 2);
            p0[r] = ((unsigned)(k0 + cb) <= 256u) ? p0[r] : -INFINITY;
            p1[r] = ((unsigned)(k0 + 32 + cb) <= 256u) ? p1[r] : -INFINITY; }
    }
}
__device__ __forceinline__ void fill_ninf(f32x16& p0, f32x16& p1) {
#pragma unroll
    for (int r = 0; r < 16; ++r) { p0[r] = -INFINITY; p1[r] = -INFINITY; }
}
__device__ __forceinline__ void attn_unit(const Prm& p, int l, const UnitD u, LAS unsigned char* lds, int tid) {
  const bf16* U = (const bf16*)(p.ws + WS_U); bf16* MIX = (bf16*)(p.ws + WS_H);
  const int wid = __builtin_amdgcn_readfirstlane(tid >> 6), lane = tid & 63, r32 = lane & 31, hi = lane >> 5;
  int qcol, kcol, vcol, ocol;
  if (u.type == 0 || u.type == 2) { qcol = C_QA + u.hh * 128; kcol = C_KA + u.hh * 128; vcol = C_VA + u.hh * 128; ocol = u.hh * 128; }
  else { const int kvh = u.hh >> 1; qcol = C_QB + u.hh * 128; kcol = C_KB + kvh * 128; vcol = C_VB + kvh * 128; ocol = 512 + u.hh * 128; }
  const int qrow0 = (u.type < 2 ? u.b * SEQL : T_LAT + u.b * CTXL) + u.q0;
  LAS unsigned char* V_lds = lds + OFF_V; LAS unsigned char* K_lds = lds + OFF_K;
  LAS float* wsl = (LAS float*)(lds + OFF_WS) + wid * 64; LAS float* li_l = wsl; LAS float* al_l = wsl + 32;
  LAS float* rpbL = (LAS float*)(lds + OFF_RPB);
  if (u.type == 0 && tid < 465) rpbL[32 + tid] = p.na_rpb[(size_t)(l * 4 + u.hh) * 465 + tid] * (1.f / ATT_SCALE);
  float m_reg = -1e30f, l_reg = 0; f32x16 o[4] = {}; bf16x8 qr[8];
  const bf16* Qw = U + (size_t)(qrow0 + wid * 32 + r32) * NINP + qcol + hi * 8;
#pragma unroll
  for (int d0 = 0; d0 < 8; ++d0) qr[d0] = *reinterpret_cast<const bf16x8*>(Qw + d0 * 16);
  const int sr = tid >> 4, sc = (tid & 15) * 8, vst0 = v_st(sr, sc), vst1 = v_st(32 + sr, sc);
  const int vb0 = (int)(uintptr_t)V_lds + v_rd_base(lane);
  struct { bf16x8 vs0, vs1, ks0, ks1; } sr_[SDEPTH];
#define SLOAD(i, jt) do { const bf16* rb_ = U + (size_t)(tile_row(u, (jt)) + sr) * NINP + sc; \
    sr_[i].vs0 = *reinterpret_cast<const bf16x8*>(rb_ + vcol); sr_[i].vs1 = *reinterpret_cast<const bf16x8*>(rb_ + (size_t)32 * NINP + vcol); \
    sr_[i].ks0 = *reinterpret_cast<const bf16x8*>(rb_ + kcol); sr_[i].ks1 = *reinterpret_cast<const bf16x8*>(rb_ + (size_t)32 * NINP + kcol); } while (0)
#define SWRITE(b, i) do { *(LAS bf16x8*)(V_lds + (b) * SHM_V + vst0) = sr_[i].vs0;          \
    *(LAS bf16x8*)(V_lds + (b) * SHM_V + vst1) = sr_[i].vs1; int kc = sc * 2;               \
    *(LAS bf16x8*)(K_lds + (b) * SHM_K + KSWZ(sr, kc)) = sr_[i].ks0;                       \
    *(LAS bf16x8*)(K_lds + (b) * SHM_K + KSWZ(32 + sr, kc)) = sr_[i].ks1; } while (0)
#define SWAIT() do { if constexpr (SDEPTH == 2) asm volatile("s_waitcnt vmcnt(4)" ::: "memory"); else asm volatile("s_waitcnt vmcnt(0)" ::: "memory"); } while (0)
#define RESC(a) do { if (__any((a) < 1.f)) { if (hi == 0) al_l[r32] = (a); asm volatile("s_waitcnt lgkmcnt(0)" ::: "memory"); \
    _Pragma("unroll") for (int d = 0; d < 4; ++d) _Pragma("unroll") for (int r = 0; r < 16; ++r) o[d][r] *= al_l[crow(r, hi)]; } } while (0)
  f32x16 pA0, pA1, pB0, pB1; float mnA, mnB, alA, alB; bf16x8 pa0, pa1, pa2, pa3; const int NT = u.nloc + 4;
  constexpr int SE = 0, SO = SDEPTH - 1;
  SLOAD(SE, 0); asm volatile("s_waitcnt vmcnt(0)" ::: "memory"); SWRITE(0, SE); __syncthreads();
#define SCORE(P0, P1, KB, jt, ACT) do { ACT = tile_active(u, (jt), wid); if (ACT) { qkt(P0, P1, KB, qr, r32, hi); apply_mask(P0, P1, u, (jt), wid, r32, hi, rpbL); } else fill_ninf(P0, P1); } while (0)
  bool actA, actB;
  SCORE(pA0, pA1, K_lds, 0, actA); partialSM(pA0, pA1, m_reg, mnA, alA);
  SLOAD(SO, 1); if constexpr (SDEPTH == 2) { if (2 < NT) SLOAD(SE, 2); }
  SWAIT(); SWRITE(1, SO); __syncthreads();
  for (int j = 1; j + 1 < NT; j += 2) {
    SBAR(); SCORE(pB0, pB1, K_lds + SHM_K, j, actB);
    finishSM(pA0, pA1, alA, l_reg, pa0, pa1, pa2, pa3); SBAR();
    SLOAD(SO, j + SDEPTH); SBAR();
    if (actA) pv_d0(o, vb0, pa0, pa1, pa2, pa3); partialSM(pB0, pB1, m_reg, mnB, alB);
    __syncthreads(); SWAIT(); SWRITE(0, SE);
    RESC(alB); __syncthreads();
    SBAR(); SCORE(pA0, pA1, K_lds, j + 1, actA);
    finishSM(pB0, pB1, alB, l_reg, pa0, pa1, pa2, pa3); SBAR();
    if (SDEPTH == 1 || j + 3 < NT) SLOAD(SE, j + 1 + SDEPTH); SBAR();
    if (actB) pv_d0(o, vb0 + SHM_V, pa0, pa1, pa2, pa3); partialSM(pA0, pA1, m_reg, mnA, alA);
    __syncthreads(); SWAIT(); SWRITE(1, SO);
    RESC(alA); __syncthreads();
  }
  SBAR(); SCORE(pB0, pB1, K_lds + SHM_K, NT - 1, actB);
  finishSM(pA0, pA1, alA, l_reg, pa0, pa1, pa2, pa3); SBAR();
  if (actA) pv_d0(o, vb0, pa0, pa1, pa2, pa3); partialSM(pB0, pB1, m_reg, mnB, alB);
  __syncthreads(); RESC(alB);
  finishSM(pB0, pB1, alB, l_reg, pa0, pa1, pa2, pa3); SBAR();
  if (actB) pv_d0(o, vb0 + SHM_V, pa0, pa1, pa2, pa3);
  if (u.type & 1) { constexpr float C = ATT_SCALE * 1.4426950408889634f; l_reg += __builtin_amdgcn_exp2f((p.wa_sink[l * 4 + u.hh] * (1.f / ATT_SCALE) - m_reg) * C); }
  if (hi == 0) li_l[r32] = l_reg; asm volatile("s_waitcnt lgkmcnt(0)" ::: "memory");
  float rli[16];
#pragma unroll
  for (int r = 0; r < 16; ++r) rli[r] = __builtin_amdgcn_rcpf(li_l[crow(r, hi)]);
  bf16* Ow = MIX + (size_t)(qrow0 + wid * 32) * DM + ocol;
#pragma unroll
  for (int r = 0; r < 16; r += 2) {
#pragma unroll
    for (int d0 = 0; d0 < 4; ++d0) {
      const float a = o[d0][r] * rli[r], b = o[d0][r + 1] * rli[r + 1];
      const float send = (lane & 1) ? a : b, got = __shfl_xor(send, 1);
      const int orow = crow(r, hi) + (lane & 1), ocl = d0 * 32 + (r32 & ~1);
      if (F8_OUTPROJ) { const float lo = ((lane & 1) ? got : a) * MIX_SCALE, hi2 = ((lane & 1) ? b : got) * MIX_SCALE;
        *(unsigned short*)((unsigned char*)MIX + (size_t)(qrow0 + wid * 32 + orow) * DM + ocol + ocl) = (unsigned short)pack4f8(lo, hi2, 0.f, 0.f); }
      else { const unsigned w = (lane & 1) ? pk2(got, b) : pk2(a, got); *(unsigned*)(Ow + (size_t)orow * DM + ocl) = w; } } }
  __syncthreads();
#undef SCORE
#undef SLOAD
#undef SWRITE
#undef SWAIT
#undef RESC
}
constexpr int NSLOT = 3;
constexpr int OFFD_K = 0, OFFD_V = NSLOT * SHM_K, OFFD_WS = NSLOT * (SHM_K + SHM_V), OFFD_RPB = OFFD_WS + 8 * 64 * 4, ATT_LDS_D = OFFD_RPB + 576 * 4;
static_assert(ATT_LDS_D <= RING_BYTES, "attention LDS");
__device__ __forceinline__ void attn_unit_dma(const Prm& p, int l, const UnitD u, LAS unsigned char* lds, int tid) {
  const bf16* U = (const bf16*)(p.ws + WS_U); bf16* MIX = (bf16*)(p.ws + WS_H);
  const int wid = __builtin_amdgcn_readfirstlane(tid >> 6), lane = tid & 63, r32 = lane & 31, hi = lane >> 5;
  int qcol, kcol, vcol, ocol;
  if (u.type == 0 || u.type == 2) { qcol = C_QA + u.hh * 128; kcol = C_KA + u.hh * 128; vcol = C_VA + u.hh * 128; ocol = u.hh * 128; }
  else { const int kvh = u.hh >> 1; qcol = C_QB + u.hh * 128; kcol = C_KB + kvh * 128; vcol = C_VB + kvh * 128; ocol = 512 + u.hh * 128; }
  const int qrow0 = (u.type < 2 ? u.b * SEQL : T_LAT + u.b * CTXL) + u.q0;
  LAS unsigned char* K_lds = lds + OFFD_K; LAS unsigned char* V_lds = lds + OFFD_V;
  LAS float* wsl = (LAS float*)(lds + OFFD_WS) + wid * 64; LAS float* li_l = wsl; LAS float* al_l = wsl + 32;
  LAS float* rpbL = (LAS float*)(lds + OFFD_RPB);
  if (u.type == 0 && tid < 465) rpbL[32 + tid] = p.na_rpb[(size_t)(l * 4 + u.hh) * 465 + tid] * (1.f / ATT_SCALE);
  float m_reg = -1e30f, l_reg = 0; f32x16 o[4] = {}; bf16x8 qr[8];
  const bf16* Qw = U + (size_t)(qrow0 + wid * 32 + r32) * NINP + qcol + hi * 8;
#pragma unroll
  for (int d0 = 0; d0 < 8; ++d0) qr[d0] = *reinterpret_cast<const bf16x8*>(Qw + d0 * 16);
  unsigned koff[2], voff[2];
#pragma unroll
  for (int i = 0; i < 2; ++i) { const int pch = (wid * 2 + i) * 64 + lane;
    { const int row = pch >> 4, c = (pch & 15) ^ (row & 15); koff[i] = (unsigned)(row * NINP + kcol + c * 8); }
    { const int sidx = pch >> 5, q = pch & 31, kk = (sidx >> 2) * 8 + (q >> 2), k = (kk & ~0xC) | ((kk & 4) << 1) | ((kk & 8) >> 1);
      voff[i] = (unsigned)(k * NINP + vcol + (sidx & 3) * 32 + (q & 3) * 8); } }
  const int vb0 = (int)(uintptr_t)V_lds + v_rd_base(lane);
#define DMA_K(jt) do { const bf16* tb_ = U + (size_t)tile_row(u, (jt)) * NINP; LAS unsigned char* dst_ = K_lds + ((jt) % NSLOT) * SHM_K + wid * 2048; \
    _Pragma("unroll") for (int i_ = 0; i_ < 2; ++i_) __builtin_amdgcn_global_load_lds((const unsigned*)(tb_ + koff[i_]), (LAS unsigned*)(dst_ + i_ * 1024), 16, 0, 0); } while (0)
#define DMA_V(jt) do { const bf16* tb_ = U + (size_t)tile_row(u, (jt)) * NINP; LAS unsigned char* dst_ = V_lds + ((jt) % NSLOT) * SHM_V + wid * 2048; \
    _Pragma("unroll") for (int i_ = 0; i_ < 2; ++i_) __builtin_amdgcn_global_load_lds((const unsigned*)(tb_ + voff[i_]), (LAS unsigned*)(dst_ + i_ * 1024), 16, 0, 0); } while (0)
#define STEP_SYNC4() asm volatile("s_waitcnt vmcnt(4) lgkmcnt(0)\n\ts_barrier" ::: "memory")
#define STEP_SYNC0() asm volatile("s_waitcnt vmcnt(0) lgkmcnt(0)\n\ts_barrier" ::: "memory")
#define RESC(a) do { if (__any((a) < 1.f)) { if (hi == 0) al_l[r32] = (a); asm volatile("s_waitcnt lgkmcnt(0)" ::: "memory"); \
    _Pragma("unroll") for (int d = 0; d < 4; ++d) _Pragma("unroll") for (int r = 0; r < 16; ++r) o[d][r] *= al_l[crow(r, hi)]; } } while (0)
#define SCORE(P0, P1, jt, ACT) do { ACT = tile_active(u, (jt), wid); if (ACT) { qkt(P0, P1, K_lds + ((jt) % NSLOT) * SHM_K, qr, r32, hi); apply_mask(P0, P1, u, (jt), wid, r32, hi, rpbL); } else fill_ninf(P0, P1); } while (0)
  f32x16 pA0, pA1, pB0, pB1; float mnA, mnB, alA, alB; bf16x8 pa0, pa1, pa2, pa3; const int NT = u.nloc + 4; bool actA, actB;
  DMA_K(0); DMA_K(1); DMA_V(0);
  PAT_SYNC(STEP_SYNC4());
  DMA_K(2); DMA_V(1);
  SCORE(pA0, pA1, 0, actA); partialSM(pA0, pA1, m_reg, mnA, alA);
#pragma unroll 1
  for (int s = 1; s + 1 < NT; s += 2) {
    PAT_SYNC(STEP_SYNC4());
    DMA_K(s + 2); DMA_V(s + 1);
    SBAR(); SCORE(pB0, pB1, s, actB);
    finishSM(pA0, pA1, alA, l_reg, pa0, pa1, pa2, pa3); SBAR();
    if (actA) pv_d0(o, vb0 + ((s - 1) % NSLOT) * SHM_V, pa0, pa1, pa2, pa3); partialSM(pB0, pB1, m_reg, mnB, alB);
    RESC(alB);
    PAT_SYNC(STEP_SYNC4());
    if (s + 3 < NT) DMA_K(s + 3); DMA_V(s + 2);
    SBAR(); SCORE(pA0, pA1, s + 1, actA);
    finishSM(pB0, pB1, alB, l_reg, pa0, pa1, pa2, pa3); SBAR();
    if (actB) pv_d0(o, vb0 + (s % NSLOT) * SHM_V, pa0, pa1, pa2, pa3); partialSM(pA0, pA1, m_reg, mnA, alA);
    RESC(alA);
  }
  PAT_SYNC(STEP_SYNC0());
  SBAR(); SCORE(pB0, pB1, NT - 1, actB);
  finishSM(pA0, pA1, alA, l_reg, pa0, pa1, pa2, pa3); SBAR();
  if (actA) pv_d0(o, vb0 + ((NT - 2) % NSLOT) * SHM_V, pa0, pa1, pa2, pa3); partialSM(pB0, pB1, m_reg, mnB, alB);
  RESC(alB);
  finishSM(pB0, pB1, alB, l_reg, pa0, pa1, pa2, pa3); SBAR();
  if (actB) pv_d0(o, vb0 + ((NT - 1) % NSLOT) * SHM_V, pa0, pa1, pa2, pa3);
  if (u.type & 1) { constexpr float C = ATT_SCALE * 1.4426950408889634f; l_reg += __builtin_amdgcn_exp2f((p.wa_sink[l * 4 + u.hh] * (1.f / ATT_SCALE) - m_reg) * C); }
  if (hi == 0) li_l[r32] = l_reg; asm volatile("s_waitcnt lgkmcnt(0)" ::: "memory");
  float rli[16];
#pragma unroll
  for (int r = 0; r < 16; ++r) rli[r] = __builtin_amdgcn_rcpf(li_l[crow(r, hi)]);
  bf16* Ow = MIX + (size_t)(qrow0 + wid * 32) * DM + ocol;
#pragma unroll
  for (int r = 0; r < 16; r += 2) {
#pragma unroll
    for (int d0 = 0; d0 < 4; ++d0) {
      const float a = o[d0][r] * rli[r], b = o[d0][r + 1] * rli[r + 1];
      const float send = (lane & 1) ? a : b, got = __shfl_xor(send, 1);
      const int orow = crow(r, hi) + (lane & 1), ocl = d0 * 32 + (r32 & ~1);
      if (F8_OUTPROJ) { const float lo = ((lane & 1) ? got : a) * MIX_SCALE, hi2 = ((lane & 1) ? b : got) * MIX_SCALE;
        *(unsigned short*)((unsigned char*)MIX + (size_t)(qrow0 + wid * 32 + orow) * DM + ocol + ocl) = (unsigned short)pack4f8(lo, hi2, 0.f, 0.f); }
      else { const unsigned w = (lane & 1) ? pk2(got, b) : pk2(a, got); *(unsigned*)(Ow + (size_t)orow * DM + ocl) = w; } } }
  asm volatile("s_waitcnt lgkmcnt(0)\n\ts_barrier" ::: "memory");
#undef DMA_K
#undef DMA_V
#undef STEP_SYNC4
#undef STEP_SYNC0
#undef RESC
#undef SCORE
}
#ifndef ATT_DMA
#define ATT_DMA 1
#endif
__device__ __forceinline__ void phase_attn(const Prm& p, int l, LAS unsigned char* lds, int wg, int nwg, int tid) {
    const int nu = 512 + (l == 0 ? 16 : 0);
    for (int it = wg; it < nu; it += nwg) {
        UnitD u;
        if (it < 256) { u.type = 0; u.b = it >> 7; u.hh = (it >> 5) & 3; const int blk = it & 31; u.q0 = blk * 256; u.nloc = 12; u.kbase = min(max(blk * 4 - 4, 0), 116); }
        else if (it < 512) { const int r = it - 256; u.type = 1; u.b = r >> 7; u.hh = (r >> 5) & 3; const int blk = r & 31; u.q0 = blk * 256; u.nloc = 8; u.kbase = blk * 256 - 128; }
        else { const int r = it - 512; u.type = 2 + (r >> 3); u.b = (r >> 2) & 1; u.hh = r & 3; u.q0 = 0; u.nloc = 0; u.kbase = 0; }
        if (ATT_DMA) attn_unit_dma(p, l, u, lds, tid); else attn_unit(p, l, u, lds, tid);
    }
}
}
__device__ __forceinline__ void lds_barrier() { asm volatile("s_waitcnt lgkmcnt(0)\n\ts_barrier" ::: "memory"); }
namespace ssd {
typedef short s16x4 __attribute__((ext_vector_type(4)));
typedef float f32x16 __attribute__((ext_vector_type(16)));
constexpr int NCH = 66;
constexpr size_t WS_ST = WS_YD, WS_HS = WS_YD + 66 * MiB, WS_DEC = 1259 * MiB;
__device__ __forceinline__ int crow(int r, int hi) { return (r & 3) + 8 * (r >> 2) + 4 * hi; }
__device__ __forceinline__ int chunk_row0(int b, int c) { return c < 2 ? T_LAT + b * CTXL + c * 128 : b * SEQL + (c - 2) * 128; }
__device__ __forceinline__ s16x4 ds_tr(unsigned addr) { s16x4 r; asm volatile("ds_read_b64_tr_b16 %0, %1" : "=&v"(r) : "v"(addr) : "memory"); return r; }
struct Raw { s16x4 lo, hi; };
__device__ __forceinline__ Raw raw_tr_nat(unsigned base, int stride, int k0, int idx0, int lane) {
    const int i16 = lane & 15, g16 = (lane >> 4) & 1, hl = lane >> 5;
    const unsigned a = base + (unsigned)((k0 + 8 * hl + (i16 >> 2)) * stride + (idx0 + 16 * g16 + 4 * (i16 & 3)) * 2);
    Raw r; r.lo = ds_tr(a); r.hi = ds_tr(a + 4 * stride); return r;
}
__device__ __forceinline__ Raw raw_tr_acc(unsigned base, int stride, int k0, int idx0, int lane) {
    const int i16 = lane & 15, g16 = (lane >> 4) & 1, hl = lane >> 5;
    const unsigned a = base + (unsigned)((k0 + 4 * hl + (i16 >> 2)) * stride + (idx0 + 16 * g16 + 4 * (i16 & 3)) * 2);
    Raw r; r.lo = ds_tr(a); r.hi = ds_tr(a + 8 * stride); return r;
}
__device__ __forceinline__ void raw_wait2(Raw& a, Raw& b) { asm volatile("s_waitcnt lgkmcnt(0)" : "+v"(a.lo), "+v"(a.hi), "+v"(b.lo), "+v"(b.hi) :: "memory"); }
__device__ __forceinline__ void raw_wait6(Raw& a, Raw& b, Raw& c, Raw& d, Raw& e, Raw& f) {
    asm volatile("s_waitcnt lgkmcnt(0)" : "+v"(a.lo), "+v"(a.hi), "+v"(b.lo), "+v"(b.hi), "+v"(c.lo), "+v"(c.hi), "+v"(d.lo), "+v"(d.hi), "+v"(e.lo), "+v"(e.hi), "+v"(f.lo), "+v"(f.hi) :: "memory"); }
__device__ __forceinline__ bf16x8 join8(const Raw& r) { return (bf16x8){r.lo[0], r.lo[1], r.lo[2], r.lo[3], r.hi[0], r.hi[1], r.hi[2], r.hi[3]}; }
__device__ __forceinline__ unsigned cvtpk(float lo, float hi) { unsigned r; asm volatile("v_cvt_pk_bf16_f32 %0, %1, %2\n\ts_nop 1" : "=v"(r) : "v"(lo), "v"(hi)); return r; }
__device__ __forceinline__ void scan128(float& v0, float& v1, int lane) {
#pragma unroll
    for (int o = 1; o < 64; o <<= 1) { const int src = (lane >= o ? lane - o : lane) << 2;
        const float t0 = __builtin_bit_cast(float, __builtin_amdgcn_ds_bpermute(src, __builtin_bit_cast(int, v0))), t1 = __builtin_bit_cast(float, __builtin_amdgcn_ds_bpermute(src, __builtin_bit_cast(int, v1)));
        if (lane >= o) { v0 += t0; v1 += t1; } }
    v1 += __builtin_bit_cast(float, __builtin_amdgcn_ds_bpermute(63 << 2, __builtin_bit_cast(int, v0)));
}
__device__ __forceinline__ float lane63(float v) { return __builtin_bit_cast(float, __builtin_amdgcn_ds_bpermute(63 << 2, __builtin_bit_cast(int, v))); }

constexpr int BST = 320, XST = 576;
constexpr int S2_B = 0, S2_X = 128 * BST, S2_W = S2_X + 128 * XST, S2_END = S2_W + 8 * 128 * 4;
__device__ __forceinline__ void phase_states(const Prm& p, int l, LAS unsigned char* lds, int wg, int nwg, int tid) {
    const bf16* XA = (const bf16*)(p.ws + WS_XBC); const float* DT = (const float*)(p.ws + WS_DT);
    bf16* ST = (bf16*)(p.ws + WS_ST); float* DEC = (float*)(p.ws + WS_DEC);
    const int wid = __builtin_amdgcn_readfirstlane(tid >> 6), lane = tid & 63, hl = lane >> 5;
    for (int it = wg; it < 2 * NCH * 4; it += nwg) {
        const int b = it / (NCH * 4), rem = it % (NCH * 4), c = rem >> 2, g = (rem >> 1) & 1, hq = rem & 1;
        const int row0 = chunk_row0(b, c), h = 8 * g + 4 * hq + (wid & 3), dir = wid >> 2;
        { v4u tb[4], tx[8];
#pragma unroll
          for (int i = 0; i < 4; ++i) { const int id = tid + 512 * i, r = id >> 4, ch = id & 15; tb[i] = *(const v4u*)(XA + (size_t)(row0 + r) * XBCW + 1024 + g * 128 + ch * 8); }
#pragma unroll
          for (int i = 0; i < 8; ++i) { const int id = tid + 512 * i, r = id >> 5, ch = id & 31; tx[i] = *(const v4u*)(XA + (size_t)(row0 + r) * XBCW + (8 * g + 4 * hq) * 64 + ch * 8); }
#pragma unroll
          for (int i = 0; i < 4; ++i) { const int id = tid + 512 * i, r = id >> 4, ch = id & 15; *(LAS v4u*)(lds + S2_B + r * BST + ch * 16) = tb[i]; }
#pragma unroll
          for (int i = 0; i < 8; ++i) { const int id = tid + 512 * i, r = id >> 5, ch = id & 31; *(LAS v4u*)(lds + S2_X + r * XST + ch * 16) = tx[i]; } }
        const float a = -__expf(p.a_log[l * 32 + dir * 16 + h]);
        const float d0 = DT[(size_t)(row0 + lane) * 32 + dir * 16 + h], d1 = DT[(size_t)(row0 + 64 + lane) * 32 + dir * 16 + h];
        float P0 = a * d0, P1 = a * d1; scan128(P0, P1, lane);
        const float tot = lane63(P1);
        LAS float* wL = (LAS float*)(lds + S2_W) + wid * 128;
        wL[lane] = (dir == 0 ? __expf(tot - P0) : __expf(P0 - a * d0)) * d0;
        wL[64 + lane] = (dir == 0 ? __expf(tot - P1) : __expf(P1 - a * d1)) * d1;
        if (lane == 0) DEC[((b * NCH + c) * 2 + dir) * 16 + h] = __expf(tot);
        __syncthreads();
        f32x16 acc[2][4];
#pragma unroll
        for (int i = 0; i < 2; ++i)
#pragma unroll
            for (int j = 0; j < 4; ++j) acc[i][j] = f32x16{};
        const unsigned bB = (unsigned)(uintptr_t)(lds + S2_B), bX = (unsigned)(uintptr_t)(lds + S2_X);
#pragma unroll 1
        for (int ks = 0; ks < 8; ++ks) {
            const f32x4 w0 = *(const LAS f32x4*)(wL + 16 * ks + 8 * hl), w1 = *(const LAS f32x4*)(wL + 16 * ks + 8 * hl + 4);
            bf16x8 xa[2], bb[4];
            { Raw rx0 = raw_tr_nat(bX, XST, 16 * ks, (wid & 3) * 64, lane), rx1 = raw_tr_nat(bX, XST, 16 * ks, (wid & 3) * 64 + 32, lane);
              Raw rb0 = raw_tr_nat(bB, BST, 16 * ks, 0, lane), rb1 = raw_tr_nat(bB, BST, 16 * ks, 32, lane), rb2 = raw_tr_nat(bB, BST, 16 * ks, 64, lane), rb3 = raw_tr_nat(bB, BST, 16 * ks, 96, lane);
              raw_wait6(rx0, rx1, rb0, rb1, rb2, rb3);
              xa[0] = join8(rx0); xa[1] = join8(rx1); bb[0] = join8(rb0); bb[1] = join8(rb1); bb[2] = join8(rb2); bb[3] = join8(rb3); }
#pragma unroll
            for (int pt = 0; pt < 2; ++pt) {
                v4u q = *reinterpret_cast<v4u*>(&xa[pt]);
                q.x = cvtpk(bflo(q.x) * w0[0], bfhi(q.x) * w0[1]); q.y = cvtpk(bflo(q.y) * w0[2], bfhi(q.y) * w0[3]);
                q.z = cvtpk(bflo(q.z) * w1[0], bfhi(q.z) * w1[1]); q.w = cvtpk(bflo(q.w) * w1[2], bfhi(q.w) * w1[3]);
                xa[pt] = *reinterpret_cast<bf16x8*>(&q); }
#pragma unroll
            for (int pt = 0; pt < 2; ++pt)
#pragma unroll
                for (int nt = 0; nt < 4; ++nt) acc[pt][nt] = __builtin_amdgcn_mfma_f32_32x32x16_bf16(xa[pt], bb[nt], acc[pt][nt], 0, 0, 0);
        }
        lds_barrier();
        { LAS unsigned char* tile = lds + wid * 16384;
          const int swz = (lane & 1) | (hl << 1);
          LAS unsigned char* wbase = tile + ((lane & 1) + 4 * hl) * 256 + (((lane & 31) >> 1) << 2);
#pragma unroll
          for (int nt = 0; nt < 4; ++nt) { LAS unsigned char* wb = wbase + ((nt ^ swz) << 6);
#pragma unroll
            for (int pt = 0; pt < 2; ++pt)
#pragma unroll
                for (int r = 0; r < 16; r += 2) {
                    const float x0 = acc[pt][nt][r], x1 = acc[pt][nt][r + 1];
                    const float send = (lane & 1) ? x0 : x1, got = __builtin_bit_cast(float, __builtin_amdgcn_update_dpp(0, __builtin_bit_cast(int, send), 0xB1, 0xF, 0xF, false));
                    const unsigned w = (lane & 1) ? pk2(got, x1) : pk2(x0, got);
                    *(LAS unsigned*)(wb + (pt * 32 + crow(r, 0)) * 256) = w; } }
          LDS_WAIT(); asm volatile("" ::: "memory");
          bf16* so = ST + ((size_t)((b * NCH + c) * 2 + dir) * 16 + h) * 8192 + (size_t)(lane >> 4) * 128 + (lane & 15) * 8;
          const LAS unsigned char* rb0 = tile + (lane >> 4) * 256 + (((lane & 15) ^ (((lane >> 4) & 1) << 2)) << 4);
          const LAS unsigned char* rb1 = tile + (lane >> 4) * 256 + (((lane & 15) ^ (((lane >> 4) & 1) << 2) ^ 8) << 4);
#pragma unroll
          for (int ps = 0; ps < 16; ++ps) { const v4u w = *(const LAS v4u*)(((ps & 1) ? rb1 : rb0) + ps * 1024);
              *(v4u*)(so + ps * 512) = w; } }
        lds_barrier();
    }
}

__device__ __forceinline__ void phase_scan(const Prm& p, int gtid, int ngt) {
    const bf16* ST = (const bf16*)(p.ws + WS_ST); bf16* HS = (bf16*)(p.ws + WS_HS); const float* DEC = (const float*)(p.ws + WS_DEC);
    constexpr int NB = 33; static_assert(NCH % NB == 0, "scan batches");
    for (int e = gtid; e < 2 * 2 * 16 * 2048; e += ngt) {
        const int q = e & 2047, hu = __builtin_amdgcn_readfirstlane(e >> 11), h = hu & 15, dir = (hu >> 4) & 1, b = hu >> 5;
        f32x4 hs = {0.f, 0.f, 0.f, 0.f};
#pragma unroll 1
        for (int i0 = 0; i0 < NCH; i0 += NB) {
            v2u sv[NB]; float dc[NB];
#pragma unroll
            for (int k = 0; k < NB; ++k) { const int i = i0 + k, c = dir == 0 ? i : (i < 2 ? 1 - i : NCH + 1 - i);
                sv[k] = __builtin_nontemporal_load((const v2u*)(ST + ((size_t)((b * NCH + c) * 2 + dir) * 16 + h) * 8192 + q * 4)); dc[k] = DEC[((b * NCH + c) * 2 + dir) * 16 + h]; }
#pragma unroll
            for (int k = 0; k < NB; ++k) { const int i = i0 + k, c = dir == 0 ? i : (i < 2 ? 1 - i : NCH + 1 - i);
                v2u o; o.x = pk2(hs[0], hs[1]); o.y = pk2(hs[2], hs[3]); *(v2u*)(HS + ((size_t)((b * NCH + c) * 2 + dir) * 16 + h) * 8192 + q * 4) = o;
                hs[0] = dc[k] * hs[0] + bflo(sv[k].x); hs[1] = dc[k] * hs[1] + bfhi(sv[k].x); hs[2] = dc[k] * hs[2] + bflo(sv[k].y); hs[3] = dc[k] * hs[3] + bfhi(sv[k].y); }
        }
    }
}

constexpr int CST = 272, XSS = 80;
constexpr size_t WS_Y = WS_XG;
constexpr int S4_B = 0, S4_C = 128 * CST, S4_X = 2 * 128 * CST, S4_ARR = 3 * 128 * CST, S4_YX = S4_ARR + 8 * 2 * 128 * 4, S4_END = S4_YX + 4 * 16 * 64 * 4;
static_assert(S4_END <= RING_BYTES && S2_END <= RING_BYTES && 8 * 32 * XSS <= 128 * CST, "ssd LDS");
__device__ __forceinline__ void phase_ssd_out(const Prm& p, int l, LAS unsigned char* lds, int wg, int nwg, int tid) {
    const bf16* XA = (const bf16*)(p.ws + WS_XBC); const float* DT = (const float*)(p.ws + WS_DT); const bf16* HS = (const bf16*)(p.ws + WS_HS);
    bf16* Y = (bf16*)(p.ws + WS_Y);
    const int wid = __builtin_amdgcn_readfirstlane(tid >> 6), lane = tid & 63, hl = lane >> 5, l31 = lane & 31, pt = (wid >> 1) & 1, dir = wid >> 2;
    const int c_lo = (l == 0) ? 0 : 2, ncu = NCH - c_lo;
    for (int it = wg; it < 2 * ncu * 8; it += nwg) {
        const int b = it / (ncu * 8), rem = it % (ncu * 8), c = c_lo + (rem >> 3), g = (rem >> 2) & 1, hp = rem & 3, h = 8 * g + 2 * hp + (wid & 1);
        const int row0 = chunk_row0(b, c);
        { v4u tb[4], tc[4];
#pragma unroll
          for (int i = 0; i < 4; ++i) { const int id = tid + 512 * i, r = id >> 4, ch = id & 15; const bf16* src = XA + (size_t)(row0 + r) * XBCW + g * 128 + ch * 8; tb[i] = *(const v4u*)(src + 1024); tc[i] = *(const v4u*)(src + 1280); }
#pragma unroll
          for (int i = 0; i < 4; ++i) { const int id = tid + 512 * i, r = id >> 4, ch = id & 15; *(LAS v4u*)(lds + S4_B + r * CST + ch * 16) = tb[i]; *(LAS v4u*)(lds + S4_C + r * CST + ch * 16) = tc[i]; } }
        v4u tx[4];
#pragma unroll
        for (int i = 0; i < 4; ++i) { const int id = tid + 512 * i, r = id >> 4, ch = id & 15; tx[i] = *(const v4u*)(XA + (size_t)(row0 + r) * XBCW + (8 * g + 2 * hp) * 64 + ch * 8); }
        bf16x8 hs[8];
        { const bf16* hp_ = HS + ((size_t)((b * NCH + c) * 2 + dir) * 16 + h) * 8192 + (size_t)(pt * 32 + l31) * 128 + 8 * hl;
#pragma unroll
          for (int ks = 0; ks < 8; ++ks) hs[ks] = __builtin_nontemporal_load((const bf16x8*)(hp_ + 16 * ks)); }
        LAS float* QL = (LAS float*)(lds + S4_ARR) + wid * 256; LAS float* DL = QL + 128;
        float ebase;
        { const float a = -__expf(p.a_log[l * 32 + dir * 16 + h]);
          const float d0 = DT[(size_t)(row0 + lane) * 32 + dir * 16 + h], d1 = DT[(size_t)(row0 + 64 + lane) * 32 + dir * 16 + h];
          float q0 = a * d0, q1 = a * d1; scan128(q0, q1, lane); const float tot = lane63(q1);
          QL[lane] = dir == 0 ? q0 : a * d0 - q0; QL[64 + lane] = dir == 0 ? q1 : a * d1 - q1; DL[lane] = d0; DL[64 + lane] = d1; ebase = dir == 0 ? 0.f : tot; }
        lds_barrier();
#pragma unroll
        for (int j = 0; j < 2; ++j) { const int id = wid * 2 + j, st = id >> 2, tt = id & 3; f32x16 X = f32x16{};
#pragma unroll
            for (int ks = 0; ks < 8; ++ks) { const bf16x8 bfr = *(const LAS bf16x8*)(lds + S4_B + (st * 32 + l31) * CST + (16 * ks + 8 * hl) * 2), cfr = *(const LAS bf16x8*)(lds + S4_C + (tt * 32 + l31) * CST + (16 * ks + 8 * hl) * 2);
                X = __builtin_amdgcn_mfma_f32_32x32x16_bf16(bfr, cfr, X, 0, 0, 0); }
#pragma unroll
            for (int i = 0; i < 4; ++i) { v2u w; w.x = pk2(X[4 * i], X[4 * i + 1]); w.y = pk2(X[4 * i + 2], X[4 * i + 3]);
                *(LAS v2u*)(lds + S4_X + (tt * 32 + l31) * CST + (st * 32 + 8 * i + 4 * hl) * 2) = w; } }
        lds_barrier();
        bf16x8 xf[8];
        {
#pragma unroll
          for (int i = 0; i < 4; ++i) { const int id = tid + 512 * i, r = id >> 4, ch = id & 15; *(LAS v4u*)(lds + S4_B + r * CST + ch * 16) = tx[i]; }
          lds_barrier();
          const unsigned bXs = (unsigned)(uintptr_t)(lds + S4_B); const int c0 = (wid & 1) * 64 + pt * 32;
#pragma unroll
          for (int q = 0; q < 4; ++q) { Raw r0 = raw_tr_acc(bXs, CST, 32 * q, c0, lane), r1 = raw_tr_acc(bXs, CST, 32 * q + 16, c0, lane); raw_wait2(r0, r1); xf[2 * q] = join8(r0); xf[2 * q + 1] = join8(r1); }
        }
        const float dsum = p.d_skip[l * 32 + h] + p.d_skip[l * 32 + 16 + h];
        LAS float* YX = (LAS float*)(lds + S4_YX) + (wid & 3) * 1024;
#pragma unroll 1
        for (int tt = 0; tt < 4; ++tt) {
            const int tl = tt * 32 + l31;
            const float Qt = QL[tl];
            f32x16 yacc = f32x16{};
#pragma unroll
            for (int st = 0; st < 4; ++st) {
                if (dir == 0 ? (st > tt) : (st < tt)) continue;
                __builtin_amdgcn_sched_barrier(0);
                float mv[16];
#define SSD_BLK(OK) _Pragma("unroll") for (int i = 0; i < 4; ++i) { const v2u w = *(const LAS v2u*)(lds + S4_X + tl * CST + (st * 32 + 8 * i + 4 * hl) * 2); \
                    const f32x4 qv = *(const LAS f32x4*)(QL + st * 32 + 8 * i + 4 * hl), dv = *(const LAS f32x4*)(DL + st * 32 + 8 * i + 4 * hl); \
                    const float xv[4] = {bflo(w.x), bfhi(w.x), bflo(w.y), bfhi(w.y)}; \
                    _Pragma("unroll") for (int j = 0; j < 4; ++j) { const int s = st * 32 + 8 * i + 4 * hl + j; (void)s; mv[4 * i + j] = (OK) ? __expf(Qt - qv[j]) * dv[j] * xv[j] : 0.f; } }
                if (st != tt) { SSD_BLK(true) } else { SSD_BLK(dir == 0 ? (s <= tl) : (s >= tl)) }
#undef SSD_BLK
#pragma unroll
                for (int s2 = 0; s2 < 2; ++s2) { v4u q; q.x = cvtpk(mv[8 * s2 + 0], mv[8 * s2 + 1]); q.y = cvtpk(mv[8 * s2 + 2], mv[8 * s2 + 3]); q.z = cvtpk(mv[8 * s2 + 4], mv[8 * s2 + 5]); q.w = cvtpk(mv[8 * s2 + 6], mv[8 * s2 + 7]);
                    yacc = __builtin_amdgcn_mfma_f32_32x32x16_bf16(xf[2 * st + s2], *reinterpret_cast<bf16x8*>(&q), yacc, 0, 0, 0); }
            }
            __builtin_amdgcn_sched_barrier(0);
            { const LAS unsigned char* cfp = lds + S4_C + tl * CST + 16 * hl; f32x16 G = f32x16{};
#pragma unroll
              for (int ks = 0; ks < 8; ++ks) G = __builtin_amdgcn_mfma_f32_32x32x16_bf16(hs[ks], *(const LAS bf16x8*)(cfp + 32 * ks), G, 0, 0, 0);
              const float e = __expf(ebase + Qt);
#pragma unroll
              for (int r = 0; r < 16; ++r) yacc[r] += e * G[r]; }
            if (dir == 1) {
#pragma unroll
                for (int r = 0; r < 16; ++r) YX[r * 64 + lane] = yacc[r]; }
            lds_barrier();
            if (dir == 0) {
                v2u ow[4];
#pragma unroll
                for (int i = 0; i < 4; ++i) { const v2u xw = *(const LAS v2u*)(lds + S4_B + tl * CST + ((wid & 1) * 64 + pt * 32 + 8 * i + 4 * hl) * 2);
                    f32x4 o; o[0] = yacc[4 * i] + YX[(4 * i) * 64 + lane] + dsum * bflo(xw.x); o[1] = yacc[4 * i + 1] + YX[(4 * i + 1) * 64 + lane] + dsum * bfhi(xw.x);
                    o[2] = yacc[4 * i + 2] + YX[(4 * i + 2) * 64 + lane] + dsum * bflo(xw.y); o[3] = yacc[4 * i + 3] + YX[(4 * i + 3) * 64 + lane] + dsum * bfhi(xw.y);
                    ow[i].x = pk2(o[0], o[1]); ow[i].y = pk2(o[2], o[3]); }
                LDS_WAIT(); asm volatile("" ::: "memory");
#pragma unroll
                for (int i = 0; i < 4; ++i) *(LAS v2u*)((LAS unsigned char*)YX + l31 * XSS + (8 * i + 4 * hl) * 2) = ow[i]; }
            lds_barrier();
            { const int t = tid >> 4, k = tid & 15, piece = (k >> 3) + 2 * ((k >> 2) & 1);
              const v4u w = *(const LAS v4u*)(lds + S4_YX + piece * 4096 + t * XSS + (k & 3) * 16);
              *(v4u*)(Y + (size_t)(row0 + tt * 32 + t) * 1024 + (8 * g + 2 * hp) * 64 + k * 8) = w; }
            lds_barrier();
        }
    }
}
}
#ifdef PROBE_IN
#define PIN_T0(bit) const bool pin_on_ = ((PROBE_IN) & (bit)) != 0; const long long pin_t0_ = wall_clock64();
#define PIN_T1(bit) if (pin_on_) { const long long pin_t1_ = wall_clock64(), pin_d_ = (pin_t1_ - pin_t0_) * (PROBE_MULT); while (wall_clock64() - pin_t1_ < pin_d_) __builtin_amdgcn_s_sleep(16); }
#else
#define PIN_T0(bit)
#define PIN_T1(bit)
#endif
__device__ __forceinline__ void phase_norm2_router(const Prm& p, int l, LAS unsigned char* lds, int wg, int nwg, int tid, int wave, int lane) {
    unsigned char* H = p.ws + WS_H; const bf16* WR = (const bf16*)(p.ws + WS_WRT);
    const int ntok = (l == 0) ? T_ALL : T_LAT;
    constexpr int HROW = 4096 + 16, CAP = 96, AST = 33;
    LAS unsigned char* hfL = lds; LAS float* part = (LAS float*)(lds + 66048); LAS float* tabL = (LAS float*)(lds + 66048 + 16384); LAS float* affL = (LAS float*)(lds + 66048 + 16384 + 32768);
    LAS int* lcnt = (LAS int*)(lds + 66048 + 16384 + 32768 + CAP * AST * 4);
    static_assert(66048 + 16384 + 32768 + CAP * AST * 4 + 256 <= LDSCTL_OFF, "norm2 LDS map");
    int* tok_e = (int*)(p.ws + WS_TOK); int* tok_pos = (int*)(p.ws + WS_TOK + TOKTAB); float* tok_gate = (float*)(p.ws + WS_TOK + 2 * TOKTAB);
    unsigned* cnt = (unsigned*)(p.ws + OFF_CNT) + l * 32 * 16;
    const int tpw = (ntok + nwg - 1) / nwg, t0 = wg * tpw, t1 = (t0 + tpw < ntok) ? t0 + tpw : ntok;
    if (t0 >= t1) return;
    const int vsA = t0 >= T_LAT ? 2 : (t0 >> 13);
    PIN_T0(1)
    {
        const int vsB = (t1 - 1) >= T_LAT ? 2 : ((t1 - 1) >> 13);
        for (int u = tid; u < 2 * 512; u += NWAVES * 64) { const int s = u >> 9, col = 4 * (u & 511); const float* md = (const float*)(p.ws + OFF_MOD) + (size_t)(l * 3 + (s ? vsB : vsA)) * MODW;
            const f32x4 g = *(const f32x4*)(p.norm_ffn + l * DM + col), s1 = modv4(md + 4 * DM + col), s0 = modv4(md + 3 * DM + col);
            *(LAS f32x4*)(tabL + s * 4096 + col) = g * (s1 + 1.f); *(LAS f32x4*)(tabL + s * 4096 + 2048 + col) = s0; }
    }
    lds_barrier();
    const int fr = lane & 15, fq = lane >> 4;
    bf16x8 b0[8], b1[8];
#pragma unroll
    for (int ks = 0; ks < 8; ++ks) { const int k0 = wave * 256 + ks * 32 + 8 * fq; b0[ks] = *(const bf16x8*)(WR + (size_t)fr * DM + k0); b1[ks] = *(const bf16x8*)(WR + (size_t)(16 + fr) * DM + k0); }
    PIN_T1(1)
#pragma unroll 1
    for (int c0 = t0; c0 < t1; c0 += CAP) {
        const int cend = (c0 + CAP < t1) ? c0 + CAP : t1, nn = cend - c0, ng = (nn + 15) >> 4;
        if (tid < 32) lcnt[tid] = 0;
        v2u rawA[2][8], rawB[2][8];
#define N2_ISSUE(buf, gi) do { _Pragma("unroll") for (int rr = 0; rr < 2; ++rr) { const int m_ = c0 + 16 * (gi) + wave * 2 + rr; \
            if ((gi) < ng && m_ < cend) { const bf16* wsrow = (m_ >= T_LAT) ? (const bf16*)(p.ws + WS_XC) + (size_t)(m_ - T_LAT) * DM : (const bf16*)(p.ws + WS_X) + (size_t)m_ * DM; \
                _Pragma("unroll") for (int j = 0; j < 8; ++j) buf[rr][j] = *(const v2u*)(wsrow + 256 * j + 4 * lane); } } } while (0)
#define N2_GROUP(buf, g, gnext) do { \
            f32x4 v[2][8]; \
            _Pragma("unroll") for (int rr = 0; rr < 2; ++rr) _Pragma("unroll") for (int j = 0; j < 8; ++j) v[rr][j] = bf4(buf[rr][j]); \
            N2_ISSUE(buf, gnext); \
            _Pragma("unroll") for (int rr = 0; rr < 2; ++rr) { const int r = wave * 2 + rr, m = c0 + 16 * (g) + r; \
                if (m < cend) { \
                    const float rstd = row_rstd(v[rr]); \
                    const int vs = m >= T_LAT ? 2 : (m >> 13); const LAS float* tab = tabL + (vs == vsA ? 0 : 4096); \
                    _Pragma("unroll") for (int j = 0; j < 8; ++j) { const int col = 256 * j + 4 * lane; const f32x4 A = *(const LAS f32x4*)(tab + col), S0 = *(const LAS f32x4*)(tab + 2048 + col); \
                        const f32x4 o = (v[rr][j] * rstd) * A + S0; \
                        v2u w; w.x = pk2(o[0], o[1]); w.y = pk2(o[2], o[3]); \
                        *(unsigned*)(H + (size_t)m * DM + col) = pack4f8(o[0], o[1], o[2], o[3]);     \
                        *(LAS v2u*)(hfL + r * HROW + col * 2) = w; } \
                } } \
            lds_barrier(); \
            {     \
                f32x4 a0 = {0.f, 0.f, 0.f, 0.f}, a1 = a0; \
                _Pragma("unroll") for (int ks = 0; ks < 8; ++ks) { const int k0 = wave * 256 + ks * 32 + 8 * fq; \
                    const bf16x8 af = *(const LAS bf16x8*)(hfL + fr * HROW + k0 * 2); \
                    a0 = __builtin_amdgcn_mfma_f32_16x16x32_bf16(af, b0[ks], a0, 0, 0, 0); a1 = __builtin_amdgcn_mfma_f32_16x16x32_bf16(af, b1[ks], a1, 0, 0, 0); } \
                _Pragma("unroll") for (int i = 0; i < 4; ++i) { part[(wave * 16 + 4 * fq + i) * 32 + fr] = a0[i]; part[(wave * 16 + 4 * fq + i) * 32 + 16 + fr] = a1[i]; } \
            } \
            lds_barrier(); \
            { float s_ = 0.f; \
              _Pragma("unroll") for (int w = 0; w < 8; ++w) s_ += part[w * 512 + tid]; \
              affL[(16 * (g) + (tid >> 5)) * AST + (tid & 31)] = sigmoid_f(s_); } \
        } while (0)
#pragma unroll
        for (int rr = 0; rr < 2; ++rr)
#pragma unroll
            for (int j = 0; j < 8; ++j) { rawA[rr][j] = (v2u){0u, 0u}; rawB[rr][j] = (v2u){0u, 0u}; }
        N2_ISSUE(rawA, 0); N2_ISSUE(rawB, 1);
        { PIN_T0(2)
#pragma unroll 1
        for (int g = 0; g < ng; g += 2) {
            N2_GROUP(rawA, g, g + 2);
            if (g + 1 < ng) N2_GROUP(rawB, g + 1, g + 3);
        }
        lds_barrier();
        PIN_T1(2) }
#undef N2_ISSUE
#undef N2_GROUP
        PIN_T0(4)
        const bool act = tid < nn; int e0 = 0, e1 = 0, r0 = 0, r1 = 0; float g0 = 0.f, g1 = 0.f;
        if (act) {
            const LAS float* af = affL + tid * AST;
            int bg = 0; float bs = -INFINITY;
#pragma unroll
            for (int g = 0; g < 4; ++g) { float t1_ = -INFINITY, t2_ = -INFINITY;
#pragma unroll
                for (int j = 0; j < 8; ++j) { const float s = af[8 * g + j] + p.router_bias[8 * g + j]; if (s > t1_) { t2_ = t1_; t1_ = s; } else if (s > t2_) t2_ = s; }
                const float gs = t1_ + t2_; if (gs > bs) { bs = gs; bg = g; } }
            float t1_ = -INFINITY, t2_ = -INFINITY; int i1 = 0, i2 = 0;
#pragma unroll
            for (int j = 0; j < 8; ++j) { const float s = af[8 * bg + j] + p.router_bias[8 * bg + j]; if (s > t1_) { t2_ = t1_; i2 = i1; t1_ = s; i1 = j; } else if (s > t2_) { t2_ = s; i2 = j; } }
            e0 = 8 * bg + i1; e1 = 8 * bg + i2; const float f0 = af[e0], f1 = af[e1], inv = 1.f / (f0 + f1); g0 = f0 * inv; g1 = f1 * inv;
            r0 = __hip_atomic_fetch_add(lcnt + e0, 1, __ATOMIC_RELAXED, __HIP_MEMORY_SCOPE_WORKGROUP); r1 = __hip_atomic_fetch_add(lcnt + e1, 1, __ATOMIC_RELAXED, __HIP_MEMORY_SCOPE_WORKGROUP);
        }
        lds_barrier();
        if (tid < 32) { const int c = lcnt[tid]; lcnt[32 + tid] = c ? (int)atomicAdd(cnt + tid * 16, (unsigned)c) : 0; }
        lds_barrier();
        if (act) { const int m = c0 + tid, p0 = lcnt[32 + e0] + r0, p1 = lcnt[32 + e1] + r1;
            int* list = (int*)(p.ws + WS_LIST); list[(size_t)e0 * LCAP + p0] = m; list[(size_t)e1 * LCAP + p1] = m;
            tok_e[2 * m] = e0; tok_e[2 * m + 1] = e1; tok_pos[2 * m] = p0; tok_pos[2 * m + 1] = p1; tok_gate[2 * m] = g0; tok_gate[2 * m + 1] = g1; }
        lds_barrier();
        PIN_T1(4)
    }
}
__device__ __forceinline__ void build_seg_tables(const Prm& p, int l, LAS unsigned char* lds, int tid) {
    LAS int* seg = (LAS int*)(lds + L_SEG); LAS int* cntL = (LAS int*)(lds + L_CNT); LAS int* blke = (LAS int*)(lds + L_BLKE); LAS int* nblkp = (LAS int*)(lds + L_NBLK);
    LAS int* incl = (LAS int*)(lds + L_INCL);
    const unsigned* cnt = (const unsigned*)(p.ws + OFF_CNT) + l * 32 * 16;
    __syncthreads();
    LAS int* pbL = (LAS int*)(lds + L_PB);
    if (tid < 32) { const int c = (int)cnt[tid * 16]; cntL[tid] = c; pbL[tid] = (c + 255) >> 8; }
    __syncthreads();
    if (tid < 32) { int inc = 0;
#pragma unroll
        for (int k = 0; k < 32; ++k) { int v = pbL[k]; asm volatile("" : "+v"(v)); inc += (k <= tid) ? v : 0; }
        seg[tid] = (inc - pbL[tid]) * 256; incl[tid] = inc; if (tid == 31) { seg[32] = inc * 256; *nblkp = inc; } }
    __syncthreads();
    if (tid < MAXBLK + 3) { int e = 0;
#pragma unroll
        for (int k = 0; k < 32; ++k) e += (incl[k] <= tid) ? 1 : 0;
        e = e < 31 ? e : 31; blke[tid] = e; ((LAS int*)(lds + L_BLKH))[tid] = (cntL[e] - 256 * (tid - (seg[e] >> 8)) <= 128) ? 1 : 0; }
    __syncthreads();
}
template <class Sched>
__device__ __forceinline__ void build_row_table(const Prm& p, const Sched& S, LAS unsigned char* lds, int tid) {
    const LAS int* seg = (const LAS int*)(lds + L_SEG); const LAS int* cntL = (const LAS int*)(lds + L_CNT); const LAS int* blke = (const LAS int*)(lds + L_BLKE);
    LAS unsigned* T = (LAS unsigned*)(lds + L_ROWT); const int* list = (const int*)(p.ws + WS_LIST);
#pragma unroll 1
    for (int i = 0; i < 8; ++i) { pg8::Unit u; if (!S.next(i, u)) break;
        const int e = blke[u.pm], base = (u.pm - (seg[e] >> 8)) * 256;
        if (tid < 256) { const int pos = base + tid; T[i * 256 + tid] = pos < cntL[e] ? (unsigned)WS_H + (unsigned)list[(size_t)e * LCAP + pos] * 2048u : ZERO_OFF; } }
    __syncthreads();
}
#ifndef SKIP_GU
#define SKIP_GU true
#endif
#ifndef SKIP_DN
#define SKIP_DN true
#endif
#ifndef STATES_ALL
#define STATES_ALL 1
#endif
#ifndef GRAB_WAIT
#define GRAB_WAIT 16
#endif
#ifndef NCONV
#define NCONV 16
#endif
constexpr int N_PHASES = 24;
__global__ void __launch_bounds__(NWAVES * 64, 2) mk_fwd(Prm p) {
    extern __shared__ __attribute__((aligned(16))) unsigned char lds_raw[];
    LAS unsigned char* lds = (LAS unsigned char*)lds_raw;
    const int tid0 = threadIdx.x, wave = __builtin_amdgcn_readfirstlane(tid0 >> 6);
#define OPQ int tid = tid0; asm volatile("" : "+v"(tid)); const int lane = tid & 63;
    const int G = gridDim.x, bx = blockIdx.x, vcu = (G % 8 == 0) ? (bx % 8) * (G / 8) + bx / 8 : bx;
    const int gw = vcu * NWAVES + wave, ngw = G * NWAVES;
    unsigned char* ws = p.ws;
    for (int u = tid0; u < (LDS_BYTES - LDSCTL_OFF) / 4; u += NWAVES * 64) ((LAS unsigned*)(lds + LDSCTL_OFF))[u] = 0u;
    __syncthreads();
#if MK_ONE_LAUNCH
    XcdBarrier bar = xcd_barrier_post((unsigned*)ws + CW_BAR, (volatile LAS unsigned*)(lds + L_BARW));
#define GRID_BAR() xcd_barrier(bar)
#define GRID_BAR_WD(ded) do { if (CONV_QUEUE) xcd_barrier_work(bar, p, lds, tid0, (ded) ? 16 : GRAB_WAIT); else xcd_barrier(bar); } while (0)
#define GRID_BAR_W() GRID_BAR_WD(false)
#else
#define GRID_BAR() do {} while (0)
#define GRID_BAR_W() do {} while (0)
#define GRID_BAR_WD(ded) do {} while (0)
#endif
#define WORKERS_(units) (((units) + (((units) + G - 1) / G) - 1) / (((units) + G - 1) / G))
#define WORKERS(units) ((CONV_QUEUE && MK_ONE_LAUNCH) ? ((WORKERS_(units) + 7) / 8 * 8 < G ? (WORKERS_(units) + 7) / 8 * 8 : G) : G)
#ifdef PROBE_SITES
#define PROBE_T0(bit) const bool pr_on_ = ((PROBE_SITES) & (bit)) != 0; const long long pr_t0_ = wall_clock64();
#define PROBE_T1(bit) if (pr_on_) { const long long pr_t1_ = wall_clock64(), pr_d_ = (pr_t1_ - pr_t0_) * (PROBE_MULT); while (wall_clock64() - pr_t1_ < pr_d_) __builtin_amdgcn_s_sleep(16); }
#else
#define PROBE_T0(bit)
#define PROBE_T1(bit)
#endif
    const int lo = p.ph_lo, hi = p.ph_hi;
#define IN(k) (lo <= (k) && (k) < hi)
#ifndef DUPMASK
#define DUPMASK 0
#endif
#define REPS(kind) for (int rep_ = 0; rep_ < (((DUPMASK) >> (kind)) & 1) + 1; ++rep_)
    if (IN(0)) REPS(0) { PROBE_T0(1 << (0)) OPQ phase_prologue(p, lds, gw, ngw, wave, lane, rep_ == 0); GRID_BAR(); PROBE_T1(1 << (0)) }
    for (int l = 0; l < 2; ++l) {
        const int pb = 1 + 11 * l;
        if (IN(pb + 0)) { PROBE_T0(1 << (pb + 0)) OPQ if (l > 0) { if (CONV_QUEUE) { PROBE_T0(1 << 25) queue_drain(p, lds, tid, (unsigned)(Q_L1 + NP_PROJ)); PROBE_T1(1 << 25) }     build_seg_tables(p, l - 1, lds, tid); row_stream<true, false, false>(p, l, l - 1, T_ALL, gw, ngw, tid, lane, lds, (const LAS int*)(lds + L_SEG)); } else row_stream<false, false, true>(p, l, 0, T_ALL, gw, ngw, tid, lane, lds, (const LAS int*)(lds + L_SEG)); GRID_BAR_W(); PROBE_T1(1 << (pb + 0)) }
        if (IN(pb + 1)) REPS(2) { PROBE_T0(1 << (pb + 1))
            pg8::Gemm g{(const pg8::bf16_t*)(ws + WS_H), (const pg8::bf16_t*)(ws + WS_WIN + (size_t)l * NINP * DM * (F8_INPROJ ? 1 : 2)), T_ALL, NINP, F8_INPROJ ? DM / 2 : DM};
            const int Ge = WORKERS((T_ALL / 256) * (NINP / 256));
            pg8::StaticOrder S; S.init(T_ALL, NINP, Ge, bx);
            pg8::EpiInProj E{(pg8::bf16_t*)(ws + WS_U), NINP, (const float*)(ws + WS_ROPE), C_QB / 256, C_VB / 256, T_LAT, F8_INPROJ ? 1.f / W8_SCALE : 1.f};
            if (bx < Ge) pg8::gemm_phase<pg8::EpiInProj, pg8::StaticOrder, true, true, F8_INPROJ != 0>(lds, g, S, E);
            GRID_BAR_WD(bx >= Ge);
            PROBE_T1(1 << (pb + 1))
        }
        if (IN(pb + 2)) REPS(3) { PROBE_T0(1 << (pb + 2)) OPQ
            const bool cx = (l == 0) && G > 64; const int cgw = cx ? (bx < 16 ? (1 << 30) : (bx - 16) * NWAVES + wave) : gw, cngw = cx ? (G - 16) * NWAVES : ngw;
            if ((bx >> 3) & 1) { att::phase_attn(p, l, lds, bx, G, tid); phase_conv(p, l, cgw, cngw, lane); } else { phase_conv(p, l, cgw, cngw, lane); att::phase_attn(p, l, lds, bx, G, tid); } GRID_BAR_W(); PROBE_T1(1 << (pb + 2)) }
        if (IN(pb + 3)) REPS(4) { PROBE_T0(1 << (pb + 3)) OPQ const int Ge = STATES_ALL ? G : WORKERS(2 * ssd::NCH * 4); if (vcu < Ge) ssd::phase_states(p, l, lds, vcu, Ge, tid); GRID_BAR_WD(vcu >= Ge);       PROBE_T1(1 << (pb + 3)) }
        if (IN(pb + 4)) REPS(5) { PROBE_T0(1 << (pb + 4)) OPQ ssd::phase_scan(p, bx * (NWAVES * 64) + tid, G * NWAVES * 64); GRID_BAR_W(); PROBE_T1(1 << (pb + 4)) }
        if (IN(pb + 5)) REPS(6) { PROBE_T0(1 << (pb + 5)) OPQ const int Ge = WORKERS(2 * (ssd::NCH - (l == 0 ? 0 : 2)) * 8); if (vcu < Ge) ssd::phase_ssd_out(p, l, lds, vcu, Ge, tid); GRID_BAR_WD(vcu >= Ge); PROBE_T1(1 << (pb + 5)) }
        if (IN(pb + 6)) REPS(7) { PROBE_T0(1 << (pb + 6)) OPQ phase_gnorm(p, l, gw, ngw, lane); GRID_BAR_W(); PROBE_T1(1 << (pb + 6)) }
        if (IN(pb + 7)) { PROBE_T0(1 << (pb + 7))
            const int M = (l == 0) ? T_ALL : T_LAT;
            pg8::Gemm g{(const pg8::bf16_t*)(ws + WS_H), (const pg8::bf16_t*)(ws + WS_WOUT + (size_t)l * DM * DM * (F8_OUTPROJ ? 1 : 2)), M, DM, F8_OUTPROJ ? DM / 2 : DM};
            const int Ge = WORKERS((M / 256) * (DM / 256));
            pg8::StaticOrder S; S.init(M, DM, Ge, bx);
            pg8::EpiRes E{(l == 0) ? (const void*)p.x : (const void*)(ws + WS_X), (pg8::bf16_t*)(ws + WS_X), (l == 0) ? (const void*)p.ctx : (const void*)(ws + WS_XC), (pg8::bf16_t*)(ws + WS_XC),
                          (const float*)(ws + OFF_MOD) + (size_t)l * 3 * MODW + 2 * DM, DM, T_LAT, MODW, F8_OUTPROJ ? 1.f / (W8_SCALE * MIX_SCALE) : 1.f, l == 0 ? 1 : 0};
            if (bx < Ge) pg8::gemm_phase<pg8::EpiRes, pg8::StaticOrder, true, true, F8_OUTPROJ != 0>(lds, g, S, E);
            GRID_BAR_WD(bx >= Ge);
            PROBE_T1(1 << (pb + 7))
        }
        if (IN(pb + 8)) { PROBE_T0(1 << (pb + 8)) OPQ phase_norm2_router(p, l, lds, bx, G, tid, wave, lane); GRID_BAR_W(); PROBE_T1(1 << (pb + 8)) }
        if (IN(pb + 9) && CONV_QUEUE && (l == 1 || Q_L0EXP)) { OPQ PROBE_T0(l == 1 ? (1 << 26) : (1 << 24)) queue_drain(p, lds, tid, (unsigned)(l == 1 ? Q_TOTAL : Q_L0)); GRID_BAR(); PROBE_T1(l == 1 ? (1 << 26) : (1 << 24)) }
        if (IN(pb + 9)) REPS(11) { PROBE_T0(1 << (pb + 9))
            OPQ build_seg_tables(p, l, lds, tid);
            const int nblk = __builtin_amdgcn_readfirstlane(*(const LAS int*)(lds + L_NBLK));
            pg8::Gemm g{(const pg8::bf16_t*)ws, (const pg8::bf16_t*)(ws + WS_WGU + (size_t)l * 32 * 2048 * 2048), nblk * 256, 2048, DM / 2};
            pg8::GroupedOrderT<SKIP_GU, true> S{G, vcu, nblk, (const LAS int*)(lds + L_BLKE), (const LAS int*)(lds + L_BLKH), (long)2048 * 2048, (const LAS unsigned*)(lds + L_ROWT)};
            build_row_table(p, S, lds, tid);
            pg8::EpiGateUp E{ws + WS_ACT, DFF, 1.f / W8_SCALE};
            pg8::gemm_phase<pg8::EpiGateUp, pg8::GroupedOrderT<SKIP_GU, true>, true, true, true>(lds, g, S, E);
            GRID_BAR_W();
            PROBE_T1(1 << (pb + 9))
        }
        if (IN(pb + 10)) REPS(12) { PROBE_T0(1 << (pb + 10))
            OPQ if (CONV_QUEUE && Q_L0EXP && l == 0) queue_drain(p, lds, tid, (unsigned)Q_L1);
            build_seg_tables(p, l, lds, tid);
            const int nblk = __builtin_amdgcn_readfirstlane(*(const LAS int*)(lds + L_NBLK));
            pg8::Gemm g{(const pg8::bf16_t*)(ws + WS_ACT), (const pg8::bf16_t*)(ws + WS_WDN + (size_t)l * 32 * 2048 * 1024), nblk * 256, DM, DFF / 2};
            pg8::GroupedOrderT<SKIP_DN> S{G, vcu, nblk, (const LAS int*)(lds + L_BLKE), (const LAS int*)(lds + L_BLKH), (long)2048 * 1024, nullptr};
            pg8::EpiF8 E{ws + WS_YB, DM, Y8_SCALE / W8_SCALE};
            pg8::gemm_phase<pg8::EpiF8, pg8::GroupedOrderT<SKIP_DN>, true, true, true>(lds, g, S, E);
            GRID_BAR_W();
            PROBE_T1(1 << (pb + 10))
        }
    }
    if (IN(23)) { PROBE_T0(1 << (23)) OPQ build_seg_tables(p, 1, lds, tid); row_stream<true, true, false>(p, 1, 1, T_LAT, gw, ngw, tid, lane, lds, (const LAS int*)(lds + L_SEG)); PROBE_T1(1 << (23)) }
#undef IN
}

extern "C" void kernel_launch(void* const* d_in, const int* in_sizes, int n_in, void* d_out, int out_size, void* d_ws, size_t ws_size, hipStream_t stream) {
    static int grid = 0;
    if (grid == 0) {
        if (n_in != 24 || in_sizes[0] != T_LAT * DM || out_size != T_LAT * DM || ws_size < WS_END) {
            fprintf(stderr, "kernel_launch: unexpected shapes: n_in %d in0 %d out %d ws %zu (need %zu)\n", n_in, n_in > 0 ? in_sizes[0] : -1, out_size, ws_size, (size_t)WS_END); grid = -1; return; }
        int dev = 0, cus = 0, per_cu = 0;
        if (hipGetDevice(&dev) != hipSuccess || hipDeviceGetAttribute(&cus, hipDeviceAttributeMultiprocessorCount, dev) != hipSuccess) { grid = -1; return; }
        if (hipFuncSetAttribute((const void*)mk_fwd, hipFuncAttributeMaxDynamicSharedMemorySize, LDS_BYTES) != hipSuccess) { fprintf(stderr, "kernel_launch: hipFuncSetAttribute failed\n"); grid = -1; return; }
        if (hipOccupancyMaxActiveBlocksPerMultiprocessor(&per_cu, (const void*)mk_fwd, NWAVES * 64, LDS_BYTES) != hipSuccess || per_cu < 1) {
            fprintf(stderr, "kernel_launch: occupancy query reports %d blocks per CU\n", per_cu); }
        (void)hipGetLastError();
        grid = cus;
    }
    if (grid < 0) return;
    if (hipMemsetAsync((char*)d_ws + WS_CTL, 0, CTL_ZERO_BYTES, stream) != hipSuccess) { fprintf(stderr, "kernel_launch: memset failed\n"); return; }
    Prm p{};
    p.x = (const float*)d_in[0]; p.c = (const float*)d_in[1]; p.ctx = (const float*)d_in[2]; p.c_ctx = (const float*)d_in[3]; p.w_ada = (const float*)d_in[4]; p.b_ada = (const float*)d_in[5];
    p.norm_mix = (const float*)d_in[6]; p.norm_ffn = (const float*)d_in[7]; p.norm_final = (const float*)d_in[8]; p.w_in = (const float*)d_in[9]; p.w_out = (const float*)d_in[10];
    p.na_rpb = (const float*)d_in[11]; p.wa_sink = (const float*)d_in[12]; p.conv_w = (const float*)d_in[13]; p.conv_b = (const float*)d_in[14]; p.a_log = (const float*)d_in[15];
    p.dt_bias = (const float*)d_in[16]; p.d_skip = (const float*)d_in[17]; p.ssd_norm = (const float*)d_in[18]; p.w_router = (const float*)d_in[19]; p.router_bias = (const float*)d_in[20];
    p.w_gate = (const float*)d_in[21]; p.w_up = (const float*)d_in[22]; p.w_down = (const float*)d_in[23];
    p.out = (float*)d_out; p.ws = (unsigned char*)d_ws;
#if MK_ONE_LAUNCH
    p.ph_lo = 0; p.ph_hi = N_PHASES;
    hipLaunchKernelGGL(mk_fwd, dim3(grid), dim3(NWAVES * 64), LDS_BYTES, stream, p);
#else
    for (int ph = 0; ph < N_PHASES; ++ph) { p.ph_lo = ph; p.ph_hi = ph + 1; hipLaunchKernelGGL(mk_fwd, dim3(grid), dim3(NWAVES * 64), LDS_BYTES, stream, p); }
#endif
    const hipError_t le = hipPeekAtLastError();
    if (le != hipSuccess) fprintf(stderr, "kernel_launch: launch failed: %s\n", hipGetErrorName(le));
}
```

```cpp
#include <hip/hip_runtime.h>
#include <cstdio>
#include <cstdint>

#ifndef MK_ONE_LAUNCH
#define MK_ONE_LAUNCH 1
#endif

#ifndef F8_INPROJ
#define F8_INPROJ 1
#endif
#ifndef F8_OUTPROJ
#define F8_OUTPROJ 1
#endif

namespace pg8 {
#define PG8_LAS __attribute__((address_space(3)))
typedef unsigned short bf16_t;
typedef short bf16x8 __attribute__((ext_vector_type(8)));
typedef float f32x4 __attribute__((ext_vector_type(4)));
typedef unsigned u32x4 __attribute__((ext_vector_type(4)));
constexpr int BM = 256, BK = 64, HALF = 128, HTB = HALF * BK * 2  , STAGE_BYTES = 8 * HTB, NXCD = 8, WGM = 6;

__host__ __device__ __forceinline__ int lds_byte(int r, int c) { const int st = (r >> 4) * 2 + (c >> 5), rr = r & 15, cc = c & 31, ob = rr * 64 + cc * 2; return st * 1024 + (ob ^ (((ob >> 9) & 1) << 5)); }
__host__ __device__ __forceinline__ void stage_rc(int b, int& R, int& C) { const int st = b / 1024, sb = b % 1024, swz = sb ^ (((sb >> 9) & 1) << 5); R = (st >> 1) * 16 + swz / 64; C = (st & 1) * 32 + (swz % 64) / 2; }
__host__ __device__ __forceinline__ int perm32(int rho) { const int n = rho >> 4, i = rho & 15; return 8 * (i >> 2) + 4 * n + (i & 3); }

typedef int i32x4v __attribute__((ext_vector_type(4)));
typedef int i32x8v __attribute__((ext_vector_type(8)));
__device__ __forceinline__ i32x8v cat8(bf16x8 a, bf16x8 b) { const i32x4v x = __builtin_bit_cast(i32x4v, a), y = __builtin_bit_cast(i32x4v, b); return __builtin_shufflevector(x, y, 0, 1, 2, 3, 4, 5, 6, 7); }
struct Unit { int pm, pn; long boff; int lo_only; };
struct Gemm { const bf16_t* A; const bf16_t* Bt; int M, N, K; };

struct StaticOrder {
    static constexpr bool SKIP_HI = false, GATHER = false, B_NT = false; const PG8_LAS unsigned* rowtab;
    int nM, nN, nwg, G, c;
    __host__ __device__ void init(int M, int N, int G_, int c_) { nM = M / BM; nN = N / BM; nwg = nM * nN; G = G_; c = c_; }
    __host__ __device__ bool next(int i, Unit& u) const {
        const long L = (long)i * G + c; if (L >= nwg) return false;
        int wgid = (int)L; { const int q = nwg / NXCD, r = nwg % NXCD, xcd = wgid % NXCD, off = wgid / NXCD; wgid = (xcd < r ? xcd * (q + 1) : r * (q + 1) + (xcd - r) * q) + off; }
        const int nig = WGM * nN, gid = wgid / nig, fm = gid * WGM, gsz = (nM - fm) < WGM ? (nM - fm) : WGM;
        u.pm = fm + ((wgid % nig) % gsz); u.pn = (wgid % nig) / gsz; u.boff = 0; u.lo_only = 0; return true;
    }
    __device__ __forceinline__ void a_ready(const Unit&) const {}
    __device__ __forceinline__ void done(const Unit&) const {}
};

__device__ __forceinline__ unsigned cvt_pk_bf16(float lo, float hi) { unsigned r; asm volatile("v_cvt_pk_bf16_f32 %0, %1, %2" : "=v"(r) : "v"(lo), "v"(hi)); return r; }
typedef float f32x2 __attribute__((ext_vector_type(2)));
__device__ __forceinline__ f32x2 gelu_pk(f32x2 v) {
    const f32x2 av = __builtin_elementwise_abs(v), d = av * 0.2316418882f + 1.0f;
    f32x2 t; t.x = __builtin_amdgcn_rcpf(d.x); t.y = __builtin_amdgcn_rcpf(d.y);
    f32x2 q = t * 0.5307027145f + (-0.7265760135f); q = q * t + 0.7107068705f; q = q * t + (-0.142248368f); q = q * t + 0.127414796f; q = q * t;
    const f32x2 s = (v * v) * (-0.72134752044f);
    f32x2 e; e.x = __builtin_amdgcn_exp2f(s.x); e.y = __builtin_amdgcn_exp2f(s.y);
    const f32x2 m = v * (q * e), r = v - m;
    f32x2 o; o.x = v.x < 0.f ? m.x : r.x; o.y = v.y < 0.f ? m.y : r.y; return o;
}

template <class Epi, class Sched, bool ALIGN_EPI = false, bool SP2 = false, bool F8 = false>
__device__ __forceinline__ void gemm_phase(PG8_LAS unsigned char* lds, const Gemm g, const Sched& S, const Epi& E) {
    int tid_o = threadIdx.x; asm volatile("" : "+v"(tid_o));
    const int tid = tid_o, wid = __builtin_amdgcn_readfirstlane(tid >> 6), lane = tid & 63, wr = wid >> 2, wc = wid & 3, fr = lane & 15, fq = lane >> 4;
    const int K = g.K, nt = K / BK;
    unsigned voffA[2], voffB[2];
#pragma unroll
    for (int i = 0; i < 2; ++i) { int R, C; stage_rc(tid * 16 + i * 8192, R, C); const int r32_ = Epi::PERM ? perm32(R & 31) : (R & 31); const int Rb = Epi::ADJ ? ((R >> 5) * 64 + r32_) : ((R & ~31) + r32_);
        voffA[i] = (unsigned)(R * K + C) * 2u; voffB[i] = (unsigned)(Rb * K + C) * 2u; }
    int gR[2]; unsigned gC[2];
#pragma unroll
    for (int i = 0; i < 2; ++i) { int R, C; stage_rc(tid * 16 + i * 8192, R, C); gR[i] = R; gC[i] = (unsigned)C * 2u; }
    unsigned gc[2][2] = {{0u, 0u}, {0u, 0u}}, gn[2][2] = {{0u, 0u}, {0u, 0u}};
#define PG8_GROWS(dst, u) do { if constexpr (Sched::GATHER) { _Pragma("unroll") for (int h_ = 0; h_ < 2; ++h_) _Pragma("unroll") for (int i_ = 0; i_ < 2; ++i_) dst[h_][i_] = S.rowtab[(u) * 256 + h_ * 128 + gR[i_]] + gC[i_]; } } while (0)
#define PG8_STAGE_A(bufoff, kbase, h, nx) do { if constexpr (Sched::GATHER) { _Pragma("unroll") for (int _i = 0; _i < 2; ++_i) \
        __builtin_amdgcn_global_load_lds((const unsigned*)((const char*)(kbase) + ((nx) ? gn[h][_i] : gc[h][_i])), (PG8_LAS unsigned*)(lds + (bufoff) + ldsw + _i * 8192), 16, 0, 0); } \
        else PG8_STAGE(bufoff, (kbase) + ((h) ? hstep : 0), voffA); } while (0)
    const size_t kstep = (size_t)(BK * 2);
    const size_t hstep = (size_t)HALF * K * 2;
    const size_t hstepB = Epi::ADJ ? (size_t)32 * K * 2 : hstep;
    const size_t tstep = 2 * hstep;
    const unsigned ldsw = (unsigned)wid * 1024u;
    const int aoff = lds_byte(wr * 64 + fr, fq * 8), boff = lds_byte(wc * 32 + fr, fq * 8);
    const int aoff8 = lds_byte(wr * 64 + fr, (fq & 1) * 16) + (fq >> 1) * 1024, boff8 = lds_byte(wc * 32 + fr, (fq & 1) * 16) + (fq >> 1) * 1024;
    const int hsw8 = (fq & 1) * 16, aoff8a = aoff8 + hsw8, aoff8b = aoff8 + 16 - hsw8, boff8a = boff8 + hsw8, boff8b = boff8 + 16 - hsw8;
#define PG8_SA(b, h) (((b) * 2 + (h)) * HTB)
#define PG8_SB(b, h) ((4 + (b) * 2 + (h)) * HTB)
#define PG8_STAGE(bufoff, gbase, voff) do { _Pragma("unroll") for (int _i = 0; _i < 2; ++_i) \
        __builtin_amdgcn_global_load_lds((const unsigned*)((const char*)(gbase) + (voff)[_i]), (PG8_LAS unsigned*)(lds + (bufoff) + ldsw + _i * 8192), 16, 0, 0); } while (0)
#define PG8_STAGE_B(bufoff, gbase, voff) do { _Pragma("unroll") for (int _i = 0; _i < 2; ++_i) \
        __builtin_amdgcn_global_load_lds((const unsigned*)((const char*)(gbase) + (voff)[_i]), (PG8_LAS unsigned*)(lds + (bufoff) + ldsw + _i * 8192), 16, 0, Sched::B_NT ? 2 : 0); } while (0)
#define PG8_LDA(dst, b, h) do { if constexpr (F8) { _Pragma("unroll") for (int m = 0; m < 4; ++m) dst##8[m] = cat8(*(const PG8_LAS bf16x8*)(lds + PG8_SA(b, h) + aoff8a + m * 2048), *(const PG8_LAS bf16x8*)(lds + PG8_SA(b, h) + aoff8b + m * 2048)); } else { \
        _Pragma("unroll") for (int m = 0; m < 4; ++m) _Pragma("unroll") for (int k = 0; k < 2; ++k) dst[m][k] = *(const PG8_LAS bf16x8*)(lds + PG8_SA(b, h) + aoff + m * 2048 + k * 1024); } } while (0)
#define PG8_LDB(dst, b, h) do { if constexpr (F8) { _Pragma("unroll") for (int n = 0; n < 2; ++n) dst##8[n] = cat8(*(const PG8_LAS bf16x8*)(lds + PG8_SB(b, h) + boff8a + n * 2048), *(const PG8_LAS bf16x8*)(lds + PG8_SB(b, h) + boff8b + n * 2048)); } else { \
        _Pragma("unroll") for (int n = 0; n < 2; ++n) _Pragma("unroll") for (int k = 0; k < 2; ++k) dst[n][k] = *(const PG8_LAS bf16x8*)(lds + PG8_SB(b, h) + boff + n * 2048 + k * 1024); } } while (0)
#define PG8_MMA(ai, bj, At, Bt) do { __builtin_amdgcn_s_setprio(1); if constexpr (F8) { _Pragma("unroll") for (int m = 0; m < 4; ++m) _Pragma("unroll") for (int n = 0; n < 2; ++n) \
        asm volatile("v_mfma_scale_f32_16x16x128_f8f6f4 %0, %1, %2, %0, %3, %3 op_sel_hi:[0,0,0]" : "+v"(acc[ai][bj][m][n]) : "v"(Bt##8[n]), "v"(At##8[m]), "v"(sc1)); } else { \
        _Pragma("unroll") for (int m = 0; m < 4; ++m) _Pragma("unroll") for (int n = 0; n < 2; ++n) _Pragma("unroll") for (int k = 0; k < 2; ++k) \
        acc[ai][bj][m][n] = __builtin_amdgcn_mfma_f32_16x16x32_bf16(Bt[n][k], At[m][k], acc[ai][bj][m][n], 0, 0, 0); } __builtin_amdgcn_s_setprio(0); } while (0)
#define PG8_WAIT_V(n) asm volatile("s_waitcnt vmcnt(" #n ")" ::: "memory")
#define PG8_WAIT_L(n) asm volatile("s_waitcnt lgkmcnt(" #n ")" ::: "memory")
#define PG8_BAR __builtin_amdgcn_s_barrier()
#define PG8_SCHED __builtin_amdgcn_sched_barrier(0)
    Unit cur, nxt; int ui = 0;
    if (!S.next(0, cur)) return;
    f32x4 acc[2][2][4][2];
#pragma unroll
    for (int a = 0; a < 2; ++a)
#pragma unroll
        for (int b = 0; b < 2; ++b)
#pragma unroll
            for (int m = 0; m < 4; ++m)
#pragma unroll
                for (int n = 0; n < 2; ++n) acc[a][b][m][n] = (f32x4){0.f, 0.f, 0.f, 0.f};
    const int sc1 = 0x7F7F7F7F;
    bf16x8 At[4][2], B0[2][2], B1[2][2]; i32x8v At8[4], B08[2], B18[2];
    const char* cA = (const char*)g.A + (Sched::GATHER ? (size_t)0 : (size_t)cur.pm * tstep); PG8_GROWS(gc, 0); const char* cB = (const char*)g.Bt + (size_t)cur.pn * tstep + cur.boff;
    S.a_ready(cur);
    if constexpr (SP2) {
        PG8_STAGE_B(PG8_SB(0, 0), cB, voffB); PG8_STAGE_B(PG8_SB(0, 1), cB + hstepB, voffB); PG8_STAGE_A(PG8_SA(0, 0), cA, 0, false); PG8_STAGE_A(PG8_SA(0, 1), cA, 1, false);
        if (wr == 1) PG8_BAR;
        PG8_WAIT_V(2); PG8_BAR;
        PG8_STAGE_B(PG8_SB(1, 0), cB + kstep, voffB); PG8_STAGE_A(PG8_SA(1, 0), cA + kstep, 0, false); PG8_STAGE_B(PG8_SB(1, 1), cB + hstepB + kstep, voffB);
        PG8_WAIT_V(6); PG8_BAR;
    } else {
        PG8_STAGE_B(PG8_SB(0, 0), cB, voffB); PG8_STAGE_A(PG8_SA(0, 0), cA, 0, false); PG8_STAGE_B(PG8_SB(0, 1), cB + hstepB, voffB); PG8_STAGE_A(PG8_SA(0, 1), cA, 1, false);
        if (wr == 1) PG8_BAR;
        PG8_WAIT_V(4); PG8_BAR;
        PG8_STAGE_B(PG8_SB(1, 0), cB + kstep, voffB); PG8_STAGE_A(PG8_SA(1, 0), cA + kstep, 0, false); PG8_STAGE_B(PG8_SB(1, 1), cB + hstepB + kstep, voffB);
        PG8_WAIT_V(6); PG8_BAR;
    }
    for (;;) {
        const bool has_next = S.next(ui + 1, nxt);
        const char* nA = has_next ? (const char*)g.A + (Sched::GATHER ? (size_t)0 : (size_t)nxt.pm * tstep) : cA; if (has_next) PG8_GROWS(gn, ui + 1); const char* nB = has_next ? (const char*)g.Bt + (size_t)nxt.pn * tstep + nxt.boff : cB;
        const bool hi_on = !Sched::SKIP_HI || cur.lo_only == 0;
#pragma unroll 1
        for (int t = 0; t < nt; t += 2) {
            const bool last = (t == nt - 2);
            const char* a1 = cA + (size_t)(t + 1) * kstep;
            const char* a2 = last ? nA : cA + (size_t)(t + 2) * kstep; const char* b2 = last ? nB : cB + (size_t)(t + 2) * kstep;
            const char* a3 = a2 + kstep; const char* b3 = b2 + kstep;
            const bool nx_ = last && has_next;
            if (last && has_next) S.a_ready(nxt);
            if constexpr (SP2) {
            PG8_LDB(B0, 0, 0); PG8_LDB(B1, 0, 1); PG8_SCHED; PG8_LDA(At, 0, 0); PG8_STAGE_A(PG8_SA(1, 1), a1, 1, false);
            PG8_WAIT_V(8); PG8_WAIT_L(0); PG8_BAR; PG8_MMA(0, 0, At, B0); PG8_MMA(0, 1, At, B1); PG8_BAR; PG8_SCHED;
            PG8_LDA(At, 0, 1); PG8_STAGE_B(PG8_SB(0, 0), b2, voffB); PG8_STAGE_B(PG8_SB(0, 1), b2 + hstepB, voffB); PG8_STAGE_A(PG8_SA(0, 0), a2, 0, nx_);
            PG8_WAIT_V(8); PG8_WAIT_L(0); PG8_BAR; if (__builtin_expect(hi_on, 1)) { PG8_MMA(1, 0, At, B0); PG8_MMA(1, 1, At, B1); } PG8_BAR; PG8_SCHED;
            PG8_LDB(B0, 1, 0); PG8_LDB(B1, 1, 1); PG8_SCHED; PG8_LDA(At, 1, 0); PG8_STAGE_A(PG8_SA(0, 1), a2, 1, nx_);
            PG8_WAIT_V(8); PG8_WAIT_L(0); PG8_BAR; PG8_MMA(0, 0, At, B0); PG8_MMA(0, 1, At, B1); PG8_BAR; PG8_SCHED;
            PG8_LDA(At, 1, 1); PG8_STAGE_B(PG8_SB(1, 0), b3, voffB); PG8_STAGE_B(PG8_SB(1, 1), b3 + hstepB, voffB); PG8_STAGE_A(PG8_SA(1, 0), a3, 0, nx_);
            PG8_WAIT_V(8); PG8_WAIT_L(0); PG8_BAR; if (__builtin_expect(hi_on, 1)) { PG8_MMA(1, 0, At, B0); PG8_MMA(1, 1, At, B1); } PG8_BAR; PG8_SCHED;
            } else {
            PG8_LDB(B0, 0, 0); PG8_SCHED; PG8_LDA(At, 0, 0); PG8_STAGE_A(PG8_SA(1, 1), a1, 1, false);
            PG8_WAIT_L(8); PG8_BAR; PG8_WAIT_L(0); PG8_MMA(0, 0, At, B0); PG8_BAR; PG8_SCHED;
            PG8_LDB(B1, 0, 1); PG8_STAGE_B(PG8_SB(0, 0), b2, voffB);
            PG8_BAR; PG8_WAIT_L(0); PG8_MMA(0, 1, At, B1); PG8_BAR;
            PG8_LDA(At, 0, 1); PG8_STAGE_A(PG8_SA(0, 0), a2, 0, nx_);
            PG8_BAR; PG8_WAIT_L(0); PG8_MMA(1, 0, At, B0); PG8_BAR; PG8_SCHED;
            PG8_STAGE_B(PG8_SB(0, 1), b2 + hstepB, voffB);
            PG8_WAIT_V(6); PG8_BAR; PG8_MMA(1, 1, At, B1); PG8_BAR;
            PG8_LDB(B0, 1, 0); PG8_SCHED; PG8_LDA(At, 1, 0); PG8_STAGE_A(PG8_SA(0, 1), a2, 1, nx_);
            PG8_WAIT_L(8); PG8_BAR; PG8_WAIT_L(0); PG8_MMA(0, 0, At, B0); PG8_BAR; PG8_SCHED;
            PG8_LDB(B1, 1, 1); PG8_STAGE_B(PG8_SB(1, 0), b3, voffB);
            PG8_BAR; PG8_WAIT_L(0); PG8_MMA(0, 1, At, B1); PG8_BAR;
            PG8_LDA(At, 1, 1); PG8_STAGE_A(PG8_SA(1, 0), a3, 0, nx_);
            PG8_BAR; PG8_WAIT_L(0); PG8_MMA(1, 0, At, B0); PG8_BAR; PG8_SCHED;
            PG8_STAGE_B(PG8_SB(1, 1), b3 + hstepB, voffB);
            PG8_WAIT_V(6); PG8_BAR; PG8_MMA(1, 1, At, B1); PG8_BAR;
            }
        }
        if constexpr (F8) asm volatile("s_nop 15\n\ts_nop 15" ::: "memory");
        if constexpr (ALIGN_EPI) { if (wr == 0) PG8_BAR; }
        if constexpr (!Epi::AFTER_DRAIN) { E(acc, cur, wr, wc, fr, fq); S.done(cur); }
        if (!has_next) break;
#pragma unroll
        for (int a = 0; a < 2; ++a)
#pragma unroll
            for (int b = 0; b < 2; ++b)
#pragma unroll
                for (int m = 0; m < 4; ++m)
#pragma unroll
                    for (int n = 0; n < 2; ++n) acc[a][b][m][n] = (f32x4){0.f, 0.f, 0.f, 0.f};
        cur = nxt; cA = nA; cB = nB; ++ui;
        if constexpr (Sched::GATHER) { gc[0][0] = gn[0][0]; gc[0][1] = gn[0][1]; gc[1][0] = gn[1][0]; gc[1][1] = gn[1][1]; }
        if constexpr (ALIGN_EPI) { if (wr == 1) PG8_BAR; }
    }
    PG8_WAIT_V(0);
    if constexpr (!ALIGN_EPI) { if (wr == 0) PG8_BAR; }
    PG8_BAR;
    if constexpr (Epi::AFTER_DRAIN) { E.fused(acc, cur, wr, wc, fr, fq, lds, wid, lane); S.done(cur); }
#undef PG8_SA
#undef PG8_SB
#undef PG8_STAGE
#undef PG8_STAGE_A
#undef PG8_GROWS
#undef PG8_LDA
#undef PG8_LDB
#undef PG8_MMA
#undef PG8_WAIT_V
#undef PG8_WAIT_L
#undef PG8_BAR
#undef PG8_SCHED
}
typedef unsigned u32x2e __attribute__((ext_vector_type(2)));
struct EpiPlain {
    static constexpr bool PERM = true, AFTER_DRAIN = false, ADJ = false;
    bf16_t* O; int ldc; float scale;
    __device__ __forceinline__ void operator()(const f32x4 (&acc)[2][2][4][2], const Unit& u, int wr, int wc, int fr, int fq) const {
        const int row0 = u.pm * BM + wr * 64 + fr, col0 = u.pn * BM + wc * 32 + 8 * fq;
        float one = scale; asm volatile("" : "+v"(one));
#pragma unroll
        for (int ai = 0; ai < 2; ++ai)
#pragma unroll
            for (int m = 0; m < 4; ++m) { bf16_t* rowp = O + (size_t)(row0 + ai * HALF + m * 16) * ldc + col0;
#pragma unroll
                for (int bj = 0; bj < 2; ++bj) { const f32x4 v0 = acc[ai][bj][m][0] * one, v1 = acc[ai][bj][m][1] * one;
                    u32x4 w; w.x = cvt_pk_bf16(v0[0], v0[1]); w.y = cvt_pk_bf16(v0[2], v0[3]); w.z = cvt_pk_bf16(v1[0], v1[1]); w.w = cvt_pk_bf16(v1[2], v1[3]);
                    *(u32x4*)(rowp + bj * HALF) = w; } }
    }
};
struct EpiF8 {
    static constexpr bool PERM = true, AFTER_DRAIN = false, ADJ = false;
    unsigned char* O; int ldc; float scale;
    __device__ __forceinline__ void operator()(const f32x4 (&acc)[2][2][4][2], const Unit& u, int wr, int wc, int fr, int fq) const {
        const int row0 = u.pm * BM + wr * 64 + fr, col0 = u.pn * BM + wc * 32 + 8 * fq;
        float one = scale; asm volatile("" : "+v"(one));
#pragma unroll
        for (int ai = 0; ai < 2; ++ai)
#pragma unroll
            for (int m = 0; m < 4; ++m) { unsigned char* rowp = O + (size_t)(row0 + ai * HALF + m * 16) * ldc + col0;
#pragma unroll
                for (int bj = 0; bj < 2; ++bj) { const f32x4 v0 = acc[ai][bj][m][0] * one, v1 = acc[ai][bj][m][1] * one;
                    u32x2e w; { int t = __builtin_amdgcn_cvt_pk_fp8_f32(v0[0], v0[1], 0, false); t = __builtin_amdgcn_cvt_pk_fp8_f32(v0[2], v0[3], t, true); w.x = (unsigned)t; }
                    { int t = __builtin_amdgcn_cvt_pk_fp8_f32(v1[0], v1[1], 0, false); t = __builtin_amdgcn_cvt_pk_fp8_f32(v1[2], v1[3], t, true); w.y = (unsigned)t; }
                    *(u32x2e*)(rowp + bj * HALF) = w; } }
    }
};
struct EpiInProj {
    static constexpr bool PERM = true, AFTER_DRAIN = false, ADJ = true;
    bf16_t* O; int ldc; const float* rope; int rope_lo, rope_hi, lat_rows; float scale;
    __device__ __forceinline__ void operator()(const f32x4 (&acc)[2][2][4][2], const Unit& u, int wr, int wc, int fr, int fq) const {
        const int hi8 = fr >> 3;
        const int row0 = u.pm * BM + wr * 64 + (fr & 7), col0 = u.pn * BM + wc * 64 + hi8 * 32 + 8 * fq;
        const bool do_rope = (u.pn >= rope_lo) && (u.pn < rope_hi) && (u.pm * BM < lat_rows);
        const int half = wc & 1;
        float one = scale; asm volatile("" : "+v"(one));
#pragma unroll
        for (int ai = 0; ai < 2; ++ai)
#pragma unroll
            for (int m = 0; m < 4; ++m) { const int row = u.pm * BM + wr * 64 + fr + ai * HALF + m * 16;
                u32x4 w[2];
#pragma unroll
                for (int bj = 0; bj < 2; ++bj) { f32x4 v0 = acc[ai][bj][m][0] * one, v1 = acc[ai][bj][m][1] * one;
                    if (do_rope) { const int s = row & 8191, pos = half ? (s & 63) : (s >> 6); const f32x4* tp = (const f32x4*)(rope + (size_t)(pos * 32 + 16 * bj + 4 * fq) * 2); const f32x4 cs0 = tp[0], cs1 = tp[1];
                        const f32x4 a = v0, b = v1;
                        v0[0] = a[0] * cs0[0] - a[1] * cs0[1]; v0[1] = a[1] * cs0[0] + a[0] * cs0[1];
                        v0[2] = a[2] * cs0[2] - a[3] * cs0[3]; v0[3] = a[3] * cs0[2] + a[2] * cs0[3];
                        v1[0] = b[0] * cs1[0] - b[1] * cs1[1]; v1[1] = b[1] * cs1[0] + b[0] * cs1[1];
                        v1[2] = b[2] * cs1[2] - b[3] * cs1[3]; v1[3] = b[3] * cs1[2] + b[2] * cs1[3];
                    }
                    w[bj].x = cvt_pk_bf16(v0[0], v0[1]); w[bj].y = cvt_pk_bf16(v0[2], v0[3]); w[bj].z = cvt_pk_bf16(v1[0], v1[1]); w[bj].w = cvt_pk_bf16(v1[2], v1[3]); }
                const u32x4 snd = hi8 ? w[0] : w[1]; u32x4 got;
                got.x = (unsigned)__builtin_amdgcn_update_dpp(0, (int)snd.x, 0x128, 0xF, 0xF, false); got.y = (unsigned)__builtin_amdgcn_update_dpp(0, (int)snd.y, 0x128, 0xF, 0xF, false);
                got.z = (unsigned)__builtin_amdgcn_update_dpp(0, (int)snd.z, 0x128, 0xF, 0xF, false); got.w = (unsigned)__builtin_amdgcn_update_dpp(0, (int)snd.w, 0x128, 0xF, 0xF, false);
                bf16_t* rowp = O + (size_t)(row0 + ai * HALF + m * 16) * ldc + col0;
                *(u32x4*)rowp = hi8 ? got : w[0];
                *(u32x4*)(rowp + (size_t)8 * ldc) = hi8 ? w[1] : got; }
    }
};
struct EpiRes {
    static constexpr bool PERM = true, AFTER_DRAIN = false, ADJ = false;
    const void* xin; bf16_t* xout; const void* cin; bf16_t* cout; const float* gate;
    int ldc, lat_rows, gstride; float scale; int in_f32;
    __device__ __forceinline__ void operator()(const f32x4 (&acc)[2][2][4][2], const Unit& u, int wr, int wc, int fr, int fq) const {
        const int row0 = u.pm * BM + wr * 64 + fr, col0 = u.pn * BM + wc * 32 + 8 * fq;
        const bool isc = u.pm * BM >= lat_rows;
        const int vs = isc ? 2 : ((u.pm * BM) >> 13), rsub = isc ? lat_rows : 0;
        const void* bp = isc ? cin : xin; bf16_t* op = isc ? cout : xout;
        f32x4 gv[2][2];
#pragma unroll
        for (int bj = 0; bj < 2; ++bj)
#pragma unroll
            for (int n = 0; n < 2; ++n) { typedef int i32x4 __attribute__((ext_vector_type(4))); const i32x4 q = *(const i32x4*)(gate + (size_t)vs * gstride + col0 + bj * HALF + 4 * n);
                gv[bj][n] = (f32x4){(float)q[0], (float)q[1], (float)q[2], (float)q[3]} * (scale * (1.f / 16777216.f)); }
#pragma unroll
        for (int ai = 0; ai < 2; ++ai)
#pragma unroll
        for (int mh = 0; mh < 2; ++mh) {
            if (in_f32) {
                f32x4 bb[2][2][2];
#pragma unroll
                for (int mm = 0; mm < 2; ++mm)
#pragma unroll
                    for (int bj = 0; bj < 2; ++bj) { const float* q = (const float*)bp + (size_t)(row0 - rsub + ai * HALF + (2 * mh + mm) * 16) * ldc + col0 + bj * HALF; bb[mm][bj][0] = __builtin_nontemporal_load((const f32x4*)q); bb[mm][bj][1] = __builtin_nontemporal_load((const f32x4*)(q + 4)); }
#pragma unroll
                for (int mm = 0; mm < 2; ++mm)
#pragma unroll
                    for (int bj = 0; bj < 2; ++bj) { const int m = 2 * mh + mm; const size_t off = (size_t)(row0 - rsub + ai * HALF + m * 16) * ldc + col0 + bj * HALF;
                        const f32x4 o0 = bb[mm][bj][0] + gv[bj][0] * acc[ai][bj][m][0], o1 = bb[mm][bj][1] + gv[bj][1] * acc[ai][bj][m][1];
                        u32x4 w; w.x = cvt_pk_bf16(o0[0], o0[1]); w.y = cvt_pk_bf16(o0[2], o0[3]); w.z = cvt_pk_bf16(o1[0], o1[1]); w.w = cvt_pk_bf16(o1[2], o1[3]);
                        *(u32x4*)(op + off) = w; }
            } else {
                u32x4 bw[2][2];
#pragma unroll
                for (int mm = 0; mm < 2; ++mm)
#pragma unroll
                    for (int bj = 0; bj < 2; ++bj) bw[mm][bj] = *(const u32x4*)((const bf16_t*)bp + (size_t)(row0 - rsub + ai * HALF + (2 * mh + mm) * 16) * ldc + col0 + bj * HALF);
#pragma unroll
                for (int mm = 0; mm < 2; ++mm)
#pragma unroll
                    for (int bj = 0; bj < 2; ++bj) { const int m = 2 * mh + mm; const size_t off = (size_t)(row0 - rsub + ai * HALF + m * 16) * ldc + col0 + bj * HALF; const u32x4 w0 = bw[mm][bj];
                        const f32x4 b0 = (f32x4){__builtin_bit_cast(float, w0.x << 16), __builtin_bit_cast(float, w0.x & 0xffff0000u), __builtin_bit_cast(float, w0.y << 16), __builtin_bit_cast(float, w0.y & 0xffff0000u)};
                        const f32x4 b1 = (f32x4){__builtin_bit_cast(float, w0.z << 16), __builtin_bit_cast(float, w0.z & 0xffff0000u), __builtin_bit_cast(float, w0.w << 16), __builtin_bit_cast(float, w0.w & 0xffff0000u)};
                        const f32x4 o0 = b0 + gv[bj][0] * acc[ai][bj][m][0], o1 = b1 + gv[bj][1] * acc[ai][bj][m][1];
                        u32x4 w; w.x = cvt_pk_bf16(o0[0], o0[1]); w.y = cvt_pk_bf16(o0[2], o0[3]); w.z = cvt_pk_bf16(o1[0], o1[1]); w.w = cvt_pk_bf16(o1[2], o1[3]);
                        *(u32x4*)(op + off) = w; }
            }
        }
    }
};
__device__ __forceinline__ unsigned pack4_fp8(float a, float b, float c, float d) { int w = __builtin_amdgcn_cvt_pk_fp8_f32(a, b, 0, false); w = __builtin_amdgcn_cvt_pk_fp8_f32(c, d, w, true); return (unsigned)w; }
struct EpiGateUp {
    static constexpr bool PERM = true, AFTER_DRAIN = false, ADJ = false;
    unsigned char* O; int ldc; float wscale;
    __device__ __forceinline__ void operator()(const f32x4 (&acc)[2][2][4][2], const Unit& u, int wr, int wc, int fr, int fq) const {
        const int row0 = u.pm * BM + wr * 64 + fr, col0 = (u.pn * BM + wc * 32 + 8 * fq) >> 1;
        float ws = wscale; asm volatile("" : "+v"(ws));
#pragma unroll
        for (int ai = 0; ai < 2; ++ai)
#pragma unroll
            for (int m = 0; m < 4; ++m) { unsigned char* rowp = O + (size_t)(row0 + ai * HALF + m * 16) * ldc + col0;
#pragma unroll
                for (int bj = 0; bj < 2; ++bj) { const f32x4 g = acc[ai][bj][m][0] * ws, up = acc[ai][bj][m][1] * ws; f32x4 a;
#pragma unroll
                    for (int i = 0; i < 4; ++i) a[i] = g[i] * __builtin_amdgcn_rcpf(1.f + __expf(-g[i])) * up[i];
                    *(unsigned*)(rowp + bj * (HALF / 2)) = pack4_fp8(a[0], a[1], a[2], a[3]); } }
    }
};
template <bool SKIP, bool GATH = false> struct GroupedOrderT {
#ifndef MOE_TR
#define MOE_TR 0
#endif
#ifndef MOE_B_NT
#define MOE_B_NT 0
#endif
    static constexpr bool SKIP_HI = SKIP, GATHER = GATH, B_NT = MOE_B_NT != 0;
    static constexpr int nN = 8;
    int G, c, nblk; const PG8_LAS int* blk_e; const PG8_LAS int* blk_h; long estride; const PG8_LAS unsigned* rowtab;
    __device__ __forceinline__ bool next(int i, Unit& u) const {
        const int L = i * G + c; if (L >= nblk * nN) return false;
#if MOE_TR
        {
            const int full = (nblk >> 3) << 6; if (L < full) { const int j = L & 63; u.pm = ((L >> 6) << 3) + (j & 7); u.pn = j >> 3; } else { u.pm = L >> 3; u.pn = L & 7; } }
#else
        u.pm = L >> 3; u.pn = L & 7;
#endif
        u.boff = (long)__builtin_amdgcn_readfirstlane(blk_e[u.pm]) * estride; u.lo_only = __builtin_amdgcn_readfirstlane(blk_h[u.pm]); return true;
    }
    __device__ __forceinline__ void a_ready(const Unit&) const {}
    __device__ __forceinline__ void done(const Unit&) const {}
};
}
constexpr int DM = 2048, T_LAT = 16384, T_CTX = 512, T_ALL = 16896, SEQL = 8192, CTXL = 256;
constexpr int NIN = 5152, NINP = 5376;
constexpr int C_QA = 0, C_KA = 512, C_VA = 1024, C_QB = 1536, C_KB = 2048, C_VB = 2304, C_Z = 2560, C_XBC = 3584, C_DT = 5120;
constexpr int XBCW = 1536, DFF = 1024, NEXP = 32, MODW = 12288;
constexpr float EPS = 1e-6f, ATT_SCALE = 0.088388347648318440f;
constexpr int MAXBLK = 165, MAXSLOT = MAXBLK * 256;
constexpr int NWAVES = 8;

constexpr size_t MiB = 1u << 20;
constexpr size_t WS_CTL = 0, CTL_ZERO_BYTES = 2 * MiB;
constexpr int CW_BAR = 4096;
constexpr size_t OFF_Q = 32768;
constexpr size_t OFF_CNT = 65536;
constexpr size_t OFF_MOD = 1 * MiB;
constexpr size_t WS_ROPE = 2 * MiB;
constexpr size_t WS_WRT = 3 * MiB;
constexpr size_t WS_WIN = 8 * MiB;
constexpr size_t WS_WOUT = 50 * MiB;
constexpr size_t WS_WGU = 66 * MiB;
constexpr size_t WS_WDN = 578 * MiB;
constexpr size_t WS_H = 834 * MiB;
constexpr size_t WS_U = 900 * MiB;
constexpr size_t WS_X = 1074 * MiB;
constexpr size_t WS_XC = 1202 * MiB;
constexpr size_t WS_XBC = 1206 * MiB;
constexpr size_t WS_DT = 1256 * MiB;
constexpr size_t WS_YD = 1260 * MiB;
constexpr size_t WS_XG = 1392 * MiB;
constexpr size_t WS_ACT = 1557 * MiB;
constexpr size_t WS_YB = 1640 * MiB;
constexpr size_t WS_TOK = 1805 * MiB;
constexpr size_t WS_END = 1808 * MiB;
constexpr size_t WS_LIST = WS_XG + 64 * MiB;
constexpr int LCAP = 2 * T_ALL;
constexpr unsigned ZERO_OFF = 1536u * 1024u;
constexpr size_t TOKTAB = (size_t)T_ALL * 2 * 4;
static_assert(WS_WIN + (size_t)2 * NINP * DM * 2 <= WS_WOUT && WS_WGU + (size_t)2 * 32 * 2048 * 2048 * 2 <= WS_WDN && WS_WDN + (size_t)2 * 32 * 2048 * 1024 * 2 <= WS_H, "ws map 1");
static_assert(WS_H + (size_t)T_ALL * DM * 2 <= WS_U && WS_U + (size_t)T_ALL * NINP * 2 <= WS_X && WS_X + (size_t)T_LAT * DM * 4 <= WS_XC && WS_XBC + (size_t)T_ALL * XBCW * 2 <= WS_DT, "ws map 2");
static_assert(WS_DT + (size_t)T_ALL * 32 * 4 <= WS_YD && WS_YD + (size_t)2 * T_ALL * 1024 * 4 <= WS_XG && WS_XG + (size_t)MAXSLOT * DM * 2 <= WS_ACT && WS_ACT + (size_t)MAXSLOT * DFF * 2 <= WS_YB && WS_YB + (size_t)MAXSLOT * DM * 2 <= WS_TOK && WS_TOK + 4 * TOKTAB <= WS_END, "ws map 3");

constexpr int RING_BYTES = 131072, LDSCTL_OFF = RING_BYTES, LDS_BYTES = 147456;
constexpr int L_BARW = LDSCTL_OFF;
constexpr int L_BWORK = LDSCTL_OFF + 32;
constexpr int L_SEG = LDSCTL_OFF + 64;
constexpr int L_CNT = LDSCTL_OFF + 256;
constexpr int L_BLKE = LDSCTL_OFF + 512;
constexpr int L_NBLK = LDSCTL_OFF + 1536;
constexpr int L_INCL = LDSCTL_OFF + 1600;
constexpr int L_PB = LDSCTL_OFF + 1792;
constexpr int L_ROWT = LDSCTL_OFF + 4096;
constexpr int L_BLKH = LDSCTL_OFF + 2048;

#define GAS __attribute__((address_space(1)))
#define LAS __attribute__((address_space(3)))
typedef unsigned short bf16;
typedef unsigned v4u __attribute__((ext_vector_type(4)));
typedef unsigned v2u __attribute__((ext_vector_type(2)));
typedef float f32x4 __attribute__((ext_vector_type(4)));
typedef float f32x2 __attribute__((ext_vector_type(2)));
typedef short bf16x8 __attribute__((ext_vector_type(8)));
#define LDS_WAIT() asm volatile("s_waitcnt lgkmcnt(0)" ::: "memory")
#define VM_WAIT() asm volatile("s_waitcnt vmcnt(0)" ::: "memory")
__device__ __forceinline__ unsigned f2bf(float f) { unsigned u = __builtin_bit_cast(unsigned, f); return (u + 0x7fffu + ((u >> 16) & 1u)) >> 16; }
__device__ __forceinline__ unsigned pk2(float lo, float hi) { return f2bf(lo) | (f2bf(hi) << 16); }
__device__ __forceinline__ float bflo(unsigned w) { return __builtin_bit_cast(float, w << 16); }
__device__ __forceinline__ float bfhi(unsigned w) { return __builtin_bit_cast(float, w & 0xffff0000u); }
__device__ __forceinline__ float bf2f(bf16 b) { return __builtin_bit_cast(float, (unsigned)b << 16); }
__device__ __forceinline__ float wave_sum(float v) {
#pragma unroll
    for (int o = 1; o < 64; o <<= 1) v += __shfl_xor(v, o);
    return v;
}
__device__ __forceinline__ float wave_max(float v) {
#pragma unroll
    for (int o = 1; o < 64; o <<= 1) v = fmaxf(v, __shfl_xor(v, o));
    return v;
}
__device__ __forceinline__ float silu_f(float x) { return x / (1.f + __expf(-x)); }
__device__ __forceinline__ float sigmoid_f(float x) { return 1.f / (1.f + __expf(-x)); }
__device__ __forceinline__ float softplus_f(float x) { return x > 20.f ? x : log1pf(__expf(x)); }

#define XB_TMO      128
#define XB_XCNT(j)  (256  + 64 * (j))
#define XB_XSUB(j)  (1280 + 64 * (j))
#define XB_XGEN(j)  (2304 + 64 * (j))
#define XB_TOP      3328
#define XB_TOPGEN   3392
#define XCD_BAR_WORDS 3456
#define XB_SPIN_CAP (1u << 18)


__device__ __forceinline__ unsigned xb_ld(unsigned* p)              { return __hip_atomic_load(p, __ATOMIC_RELAXED, __HIP_MEMORY_SCOPE_AGENT); }
__device__ __forceinline__ unsigned xb_add(unsigned* p, unsigned v) { return __hip_atomic_fetch_add(p, v, __ATOMIC_RELAXED, __HIP_MEMORY_SCOPE_AGENT); }
__device__ __forceinline__ unsigned xb_xcc_id() { return (unsigned)__builtin_amdgcn_s_getreg((3 << 11) | 20) & 0xFu; }
#define XB_SPIN(cond, bar) do { unsigned _sp = 0; while (cond) { __builtin_amdgcn_s_sleep(1); \
    if ((++_sp & 255u) == 0u) { if (xb_ld(&(bar)[XB_TMO])) break; if (_sp > XB_SPIN_CAP) { atomicAdd(&(bar)[XB_TMO], 1u); break; } } } } while (0)

struct XcdBarrier {
    unsigned* bar; unsigned x;
    volatile LAS unsigned* st;
};

__device__ __forceinline__ XcdBarrier xcd_barrier_post(unsigned* bar, volatile LAS unsigned* st) {
    XcdBarrier b; b.bar = bar; b.x = xb_xcc_id(); b.st = st;
    if (threadIdx.x == 0) (void)xb_add(&bar[XB_XCNT(b.x)], 1u);
    return b;
}
__device__ __forceinline__ void xcd_barrier_complete(unsigned* bar, unsigned x, unsigned& nloc, unsigned& nx) {
    const unsigned G = gridDim.x * gridDim.y * gridDim.z;
    unsigned sum, cnt, mine, sp = 0u, cv[16];
    for (;;) {
        sum = 0u; cnt = 0u; mine = 0u;
#pragma unroll
        for (unsigned j = 0; j < 16; ++j) cv[j] = xb_ld(&bar[XB_XCNT(j)]);
#pragma unroll
        for (unsigned j = 0; j < 16; ++j) { const unsigned c = cv[j]; sum += c; cnt += (c > 0u) ? 1u : 0u; mine = (j == x) ? c : mine; }
        if (sum == G) break;
        __builtin_amdgcn_s_sleep(1);
        if ((++sp & 255u) == 0u) { if (xb_ld(&bar[XB_TMO])) break; if (sp > XB_SPIN_CAP) { atomicAdd(&bar[XB_TMO], 1u); break; } }
    }
    nloc = mine > 0u ? mine : 1u; nx = cnt > 0u ? cnt : 1u;
}

__device__ __forceinline__ void xcd_barrier(const XcdBarrier& b) {
    asm volatile("s_waitcnt vmcnt(0)" ::: "memory");
    __syncthreads();
    if (threadIdx.x == 0) {
        unsigned* bar = b.bar;
        __builtin_amdgcn_s_waitcnt(0);
        unsigned nloc = b.st[0], nx = b.st[1];
        if (nloc == 0u) { xcd_barrier_complete(bar, b.x, nloc, nx); b.st[0] = nloc; b.st[1] = nx; }
        const unsigned old = xb_add(&bar[XB_XSUB(b.x)], 1u);
        const unsigned gen = old / nloc;
        if (old + 1u == (gen + 1u) * nloc) {
            __builtin_amdgcn_fence(__ATOMIC_RELEASE, "agent");
            asm volatile("s_waitcnt vmcnt(0)" ::: "memory");
            const unsigned og = xb_add(&bar[XB_TOP], 1u);
            const unsigned tg = og / nx;
            if (og + 1u == (tg + 1u) * nx) xb_add(&bar[XB_TOPGEN], 1u);
            else XB_SPIN(xb_ld(&bar[XB_TOPGEN]) == tg, bar);
            __builtin_amdgcn_fence(__ATOMIC_ACQUIRE, "agent");
            xb_add(&bar[XB_XGEN(b.x)], 1u);
            asm volatile("s_waitcnt vmcnt(0)" ::: "memory");
        } else {
            XB_SPIN(xb_ld(&bar[XB_XGEN(b.x)]) == gen, bar);
            __builtin_amdgcn_fence(__ATOMIC_ACQUIRE, "agent");
            asm volatile("s_waitcnt vmcnt(0)" ::: "memory");
        }
    }
    __syncthreads();
}
struct Prm {
    const float *x, *c, *ctx, *c_ctx, *w_ada, *b_ada, *norm_mix, *norm_ffn, *norm_final, *w_in, *w_out, *na_rpb, *wa_sink,
                *conv_w, *conv_b, *a_log, *dt_bias, *d_skip, *ssd_norm, *w_router, *router_bias, *w_gate, *w_up, *w_down;
    float* out; unsigned char* ws; int ph_lo, ph_hi;
};

__device__ __forceinline__ int perm_in(int n) {
    if (n >= C_QB && n < C_VB) { const int p = (n - C_QB) & 127, hb = n - p, half = p >> 6, pp = p & 63; return hb + half * 64 + (pp >> 1) + 32 * (pp & 1); }
    return n;
}
__device__ __forceinline__ unsigned pack4f8(float a, float b, float c, float d) { int w = __builtin_amdgcn_cvt_pk_fp8_f32(a, b, 0, false); w = __builtin_amdgcn_cvt_pk_fp8_f32(c, d, w, true); return (unsigned)w; }
#ifndef CONV_QUEUE
#define CONV_QUEUE 1
#endif
constexpr float W8_SCALE = 64.f, MIX_SCALE = 8.f, Y8_SCALE = 8.f;
struct TDesc { const float* colp; size_t ld; unsigned char* wt; int ok, k0, K, n0; };
constexpr int TK_IN = 2 * 32 * (NINP / 32), TK_OUT = 2 * 32 * 64, TK_GU = 2 * 32 * 32 * 64, TK_DN = 2 * 32 * 16 * 64, TK_RT = 32;
template <bool F8SEL> __device__ __forceinline__ constexpr int t_count() {
    return ((F8_INPROJ != 0) == F8SEL ? TK_IN : 0) + ((F8_OUTPROJ != 0) == F8SEL ? TK_OUT : 0) + (F8SEL ? TK_GU + TK_DN : TK_RT);
}
template <bool F8SEL> __device__ __forceinline__ TDesc t_decode(const Prm& p, int it, int lane) {
    unsigned char* ws = p.ws; TDesc d; int r = it;
    if ((F8_INPROJ != 0) == F8SEL) { if (r < TK_IN) { const int sub = r & 1, r2 = r >> 1, l = r2 / (TK_IN / 4), q = r2 % (TK_IN / 4), kb = 2 * (q / (NINP / 32)) + sub, nb = q % (NINP / 32), nn = 32 * nb + (lane & 31); const bool ok = nn < NIN;
            d.colp = p.w_in + (size_t)l * DM * NIN + (ok ? perm_in(nn) : 0); d.ld = NIN; d.ok = ok; d.K = 2048; d.wt = ws + WS_WIN + (size_t)l * NINP * DM * (F8_INPROJ ? 1 : 2); d.n0 = 32 * nb; d.k0 = 64 * kb; return d; } r -= TK_IN; }
    if ((F8_OUTPROJ != 0) == F8SEL) { if (r < TK_OUT) { const int sub = r & 1, r2 = r >> 1, l = r2 / (TK_OUT / 4), q = r2 % (TK_OUT / 4), kb = 2 * (q / 64) + sub, nb = q % 64, nn = 32 * nb + (lane & 31);
            d.colp = p.w_out + (size_t)l * DM * DM + nn; d.ld = DM; d.ok = 1; d.K = 2048; d.wt = ws + WS_WOUT + (size_t)l * DM * DM * (F8_OUTPROJ ? 1 : 2); d.n0 = 32 * nb; d.k0 = 64 * kb; return d; } r -= TK_OUT; }
    if (F8SEL) {
        if (r < TK_GU) { const int sub = r & 1, r2 = r >> 1, le = r2 / 1024, q = r2 % 1024, kb = 2 * (q / 64) + sub, nb = q % 64, nn = 32 * nb + (lane & 31), j = nn >> 3, t = nn & 7;
            d.colp = (t < 4 ? p.w_gate : p.w_up) + (size_t)le * 2048 * 1024 + 4 * j + (t & 3); d.ld = 1024; d.ok = 1; d.K = 2048; d.wt = ws + WS_WGU + (size_t)le * 2048 * 2048; d.n0 = 32 * nb; d.k0 = 64 * kb; return d; }
        r -= TK_GU;
        { const int sub = r & 1, r2 = r >> 1, le = r2 / 512, q = r2 % 512, kb = 2 * (q / 64) + sub, nb = q % 64, nn = 32 * nb + (lane & 31);
            d.colp = p.w_down + (size_t)le * 1024 * 2048 + nn; d.ld = 2048; d.ok = 1; d.K = 1024; d.wt = ws + WS_WDN + (size_t)le * 2048 * 1024; d.n0 = 32 * nb; d.k0 = 64 * kb; return d; }
    } else { const int kb = r; d.colp = p.w_router + (lane & 31); d.ld = 32; d.ok = 1; d.K = 2048; d.wt = ws + WS_WRT; d.n0 = 0; d.k0 = 64 * kb; return d; }
}
__device__ __forceinline__ void t_load(const TDesc& d, float (&tv)[32], int lane) {
#pragma unroll
    for (int i = 0; i < 32; ++i) tv[i] = __builtin_nontemporal_load(d.colp + (size_t)(d.k0 + 2 * i + (lane >> 5)) * d.ld);
}
template <bool F8> __device__ __forceinline__ void t_lds_in(const TDesc& d, const float (&tv)[32], LAS float* scr, int lane) {
#pragma unroll
    for (int i = 0; i < 32; ++i) scr[(2 * i + (lane >> 5)) * 33 + (lane & 31)] = d.ok ? tv[i] : 0.f;
    LDS_WAIT(); asm volatile("" ::: "memory");
}
template <bool F8> __device__ __forceinline__ void t_out(const TDesc& d, LAS float* scr, int lane) {
    const int c = lane & 7;
#pragma unroll
    for (int j = 0; j < 4; ++j) { const int n = (lane >> 3) + 8 * j; const LAS float* s = scr + (8 * c) * 33 + n;
        if constexpr (F8) { v2u o; o.x = pack4f8(s[0 * 33] * W8_SCALE, s[1 * 33] * W8_SCALE, s[2 * 33] * W8_SCALE, s[3 * 33] * W8_SCALE); o.y = pack4f8(s[4 * 33] * W8_SCALE, s[5 * 33] * W8_SCALE, s[6 * 33] * W8_SCALE, s[7 * 33] * W8_SCALE);
            *(v2u*)(d.wt + (size_t)(d.n0 + n) * d.K + d.k0 + 8 * c) = o; }
        else { v4u o; o.x = pk2(s[0 * 33], s[1 * 33]); o.y = pk2(s[2 * 33], s[3 * 33]); o.z = pk2(s[4 * 33], s[5 * 33]); o.w = pk2(s[6 * 33], s[7 * 33]);
            *(v4u*)((bf16*)d.wt + (size_t)(d.n0 + n) * d.K + d.k0 + 8 * c) = o; } }
    LDS_WAIT(); asm volatile("" ::: "memory");
}
__device__ __forceinline__ void t_cvt8(LAS float* scr, int lane, v2u (&o)[4]) {
    const int c = lane & 7;
#pragma unroll
    for (int j = 0; j < 4; ++j) { const int n = (lane >> 3) + 8 * j; const LAS float* s = scr + (8 * c) * 33 + n;
        o[j].x = pack4f8(s[0 * 33] * W8_SCALE, s[1 * 33] * W8_SCALE, s[2 * 33] * W8_SCALE, s[3 * 33] * W8_SCALE); o[j].y = pack4f8(s[4 * 33] * W8_SCALE, s[5 * 33] * W8_SCALE, s[6 * 33] * W8_SCALE, s[7 * 33] * W8_SCALE); }
    LDS_WAIT(); asm volatile("" ::: "memory");
}
constexpr int TL_IN = 32 * (NINP / 32), TL_OUT = 32 * 64, TL_GU = 32 * 32 * 64, TL_DN = 32 * 16 * 64, TL_ALL = TL_IN + TL_OUT + TL_GU + TL_DN, NPL = TL_ALL / 2;
static_assert(F8_INPROJ && F8_OUTPROJ, "the per-layer conversion queue assumes fp8 copies of every GEMM weight");
__device__ __forceinline__ TDesc t_decode_layer(const Prm& p, int l, int it, int lane) {
    unsigned char* ws = p.ws; TDesc d; int r = it; const int sub = r & 1;
    if (r < TL_IN) { const int q = r >> 1, kb = 2 * (q / (NINP / 32)) + sub, nb = q % (NINP / 32), nn = 32 * nb + (lane & 31); const bool ok = nn < NIN;
        d.colp = p.w_in + (size_t)l * DM * NIN + (ok ? perm_in(nn) : 0); d.ld = NIN; d.ok = ok; d.K = 2048; d.wt = ws + WS_WIN + (size_t)l * NINP * DM; d.n0 = 32 * nb; d.k0 = 64 * kb; return d; }
    r -= TL_IN;
    if (r < TL_OUT) { const int q = r >> 1, kb = 2 * (q / 64) + sub, nb = q % 64, nn = 32 * nb + (lane & 31);
        d.colp = p.w_out + (size_t)l * DM * DM + nn; d.ld = DM; d.ok = 1; d.K = 2048; d.wt = ws + WS_WOUT + (size_t)l * DM * DM; d.n0 = 32 * nb; d.k0 = 64 * kb; return d; }
    r -= TL_OUT;
    if (r < TL_GU) { const int r2 = r >> 1, le = l * 32 + r2 / 1024, q = r2 % 1024, kb = 2 * (q / 64) + sub, nb = q % 64, nn = 32 * nb + (lane & 31), j = nn >> 3, t = nn & 7;
        d.colp = (t < 4 ? p.w_gate : p.w_up) + (size_t)le * 2048 * 1024 + 4 * j + (t & 3); d.ld = 1024; d.ok = 1; d.K = 2048; d.wt = ws + WS_WGU + (size_t)le * 2048 * 2048; d.n0 = 32 * nb; d.k0 = 64 * kb; return d; }
    r -= TL_GU;
    { const int r2 = r >> 1, le = l * 32 + r2 / 512, q = r2 % 512, kb = 2 * (q / 64) + sub, nb = q % 64, nn = 32 * nb + (lane & 31);
        d.colp = p.w_down + (size_t)le * 1024 * 2048 + nn; d.ld = 2048; d.ok = 1; d.K = 1024; d.wt = ws + WS_WDN + (size_t)le * 2048 * 1024; d.n0 = 32 * nb; d.k0 = 64 * kb; return d; }
}
__device__ __forceinline__ void t_pair_store(const TDesc& dS, const v2u (&oa)[4], const v2u (&ob)[4], int lane) {
    const int c = lane & 7, odd = c & 1;
#pragma unroll
    for (int j = 0; j < 4; ++j) { const int n = (lane >> 3) + 8 * j;
        const v2u snd = odd ? oa[j] : ob[j]; v2u got; got.x = (unsigned)__builtin_amdgcn_update_dpp(0, (int)snd.x, 0xB1, 0xF, 0xF, false); got.y = (unsigned)__builtin_amdgcn_update_dpp(0, (int)snd.y, 0xB1, 0xF, 0xF, false);
        v4u w; if (odd) { w.x = got.x; w.y = got.y; w.z = ob[j].x; w.w = ob[j].y; } else { w.x = oa[j].x; w.y = oa[j].y; w.z = got.x; w.w = got.y; }
        __builtin_nontemporal_store(w, (v4u*)(dS.wt + (size_t)(dS.n0 + n) * dS.K + dS.k0 + (odd ? 64 : 0) + 16 * (c >> 1))); }

}
#ifndef Q_L0EXP
#define Q_L0EXP 1
#endif
constexpr int NP_PROJ = (TL_IN + TL_OUT) / 2, NP_EXP = (TL_GU + TL_DN) / 2;
__device__ __forceinline__ void t_convert_pairs(const Prm& p, int l, int npairs, LAS float* scr, int gw, int ngw, int lane) {
    if (gw >= npairs) return;
    TDesc dA = t_decode_layer(p, l, 2 * gw, lane), dB = t_decode_layer(p, l, 2 * gw + 1, lane); float ta[32], tb[32]; t_load(dA, ta, lane); t_load(dB, tb, lane);
#pragma unroll 1
    for (int pi = gw; pi < npairs; pi += ngw) {
        v2u oa[4], ob[4];
        t_lds_in<true>(dA, ta, scr, lane); t_cvt8(scr, lane, oa);
        t_lds_in<true>(dB, tb, scr, lane);
        const TDesc dS = dA; const int pn = pi + ngw;
        if (pn < npairs) { dA = t_decode_layer(p, l, 2 * pn, lane); dB = t_decode_layer(p, l, 2 * pn + 1, lane); t_load(dA, ta, lane); t_load(dB, tb, lane); }
        t_cvt8(scr, lane, ob);
        t_pair_store(dS, oa, ob, lane);
    }
}
__device__ __forceinline__ void t_convert_two(const Prm& p, int l, int pi0, int l1, int pi1, bool has1, LAS float* scr, int lane) {
    const TDesc dA = t_decode_layer(p, l, 2 * pi0, lane), dB = t_decode_layer(p, l, 2 * pi0 + 1, lane), dC = t_decode_layer(p, l1, 2 * pi1, lane), dD = t_decode_layer(p, l1, 2 * pi1 + 1, lane);
    float ta[32], tb[32], tc[32], td[32]; t_load(dA, ta, lane); t_load(dB, tb, lane); t_load(dC, tc, lane); t_load(dD, td, lane);
    v2u oa[4], ob[4];
    t_lds_in<true>(dA, ta, scr, lane); t_cvt8(scr, lane, oa);
    t_lds_in<true>(dB, tb, scr, lane); t_cvt8(scr, lane, ob);
    t_pair_store(dA, oa, ob, lane);
    if (has1) {
        t_lds_in<true>(dC, tc, scr, lane); t_cvt8(scr, lane, oa);
        t_lds_in<true>(dD, td, scr, lane); t_cvt8(scr, lane, ob);
        t_pair_store(dC, oa, ob, lane);
    }
}
__device__ __forceinline__ void t_convert_one(const Prm& p, int l, int pi, LAS float* scr, int lane) {
    const TDesc dA = t_decode_layer(p, l, 2 * pi, lane), dB = t_decode_layer(p, l, 2 * pi + 1, lane); float ta[32], tb[32]; t_load(dA, ta, lane); t_load(dB, tb, lane);
    v2u oa[4], ob[4];
    t_lds_in<true>(dA, ta, scr, lane); t_cvt8(scr, lane, oa);
    t_lds_in<true>(dB, tb, scr, lane); t_cvt8(scr, lane, ob);
    t_pair_store(dA, oa, ob, lane);
}
template <bool F8SEL> __device__ __forceinline__ void t_convert_all(const Prm& p, LAS float* scr, int gw, int ngw, int lane) {
    constexpr int N = t_count<F8SEL>();
    if (2 * gw >= N) return;
    TDesc d0 = t_decode<F8SEL>(p, 2 * gw, lane); float tv[32]; t_load(d0, tv, lane);
#pragma unroll 1
    for (int it = 2 * gw; it < N; ) {
        t_lds_in<F8SEL>(d0, tv, scr, lane);
        const int itn = (it & 1) ? it - 1 + 2 * ngw : it + 1; TDesc d1 = d0;
        if (itn < N) { d1 = t_decode<F8SEL>(p, itn, lane); t_load(d1, tv, lane); }
        t_out<F8SEL>(d0, scr, lane);
        d0 = d1; it = itn;
    }
}
#ifndef MODP_NC0
#define MODP_NC0 48
#endif
#ifndef MODP_NC1
#define MODP_NC1 48
#endif
#ifndef MPK
#define MPK 64
#endif
constexpr int MODP_ITEMS0 = (DM / MPK) * MODP_NC0, MODP_ITEMS = MODP_ITEMS0 + (DM / MPK) * MODP_NC1;
constexpr int MQK = 32, MQ_PER = DM / MQK;
constexpr int MODQ0 = MQ_PER * (48 - MODP_NC0), MODQ = MODQ0 + MQ_PER * (48 - MODP_NC1);
static_assert(MODQ % 16 == 0, "mods queue items come in grabs of 16");
template <int NK> __device__ __forceinline__ void mods_item(const Prm& p, int l, int k0, int nc, LAS float* scr, int lane) {
    int* mod = (int*)(p.ws + OFF_MOD);
    const int n0 = 256 * nc + 4 * lane;
    for (int i = lane; i < NK; i += 64) { scr[i] = silu_f(p.c[k0 + i]); scr[NK + i] = silu_f(p.c[DM + k0 + i]); scr[2 * NK + i] = silu_f(p.c_ctx[k0 + i]); }
    LDS_WAIT(); asm volatile("" ::: "memory");
    f32x4 a0 = {0.f, 0.f, 0.f, 0.f}, a1 = a0, a2 = a0;
    const float* wp = p.w_ada + ((size_t)l * DM + k0) * MODW + n0;
    if constexpr (NK >= 64) {
#pragma unroll 8
    for (int kk = 0; kk < NK; ++kk) { const f32x4 w = __builtin_nontemporal_load((const f32x4*)(wp + (size_t)kk * MODW)); a0 += w * scr[kk]; a1 += w * scr[NK + kk]; a2 += w * scr[2 * NK + kk]; }
    } else {
#pragma unroll 16
    for (int kk = 0; kk < NK; ++kk) { const f32x4 w = __builtin_nontemporal_load((const f32x4*)(wp + (size_t)kk * MODW)); a0 += w * scr[kk]; a1 += w * scr[NK + kk]; a2 += w * scr[2 * NK + kk]; }
    }
    if (k0 == 0) { const f32x4 bb = *(const f32x4*)(p.b_ada + (size_t)l * MODW + n0); a0 += bb; a1 += bb; a2 += bb; }
    int* m0 = mod + (size_t)(l * 3) * MODW + n0;
#pragma unroll
    for (int i = 0; i < 4; ++i) { atomicAdd(m0 + i, (int)rintf(a0[i] * 16777216.f)); atomicAdd(m0 + MODW + i, (int)rintf(a1[i] * 16777216.f)); atomicAdd(m0 + 2 * MODW + i, (int)rintf(a2[i] * 16777216.f)); }
    LDS_WAIT(); asm volatile("" ::: "memory");
}
__device__ __forceinline__ void mods_queue_item(const Prm& p, int j, LAS float* scr, int lane) {
    constexpr int W0 = 48 - MODP_NC0 + (MODP_NC0 == 48), W1 = 48 - MODP_NC1 + (MODP_NC1 == 48);
    if (j < MODQ0) mods_item<MQK>(p, 0, MQK * (j / W0), MODP_NC0 + j % W0, scr, lane);
    else { const int q = j - MODQ0; mods_item<MQK>(p, 1, MQK * (q / W1), MODP_NC1 + q % W1, scr, lane); }
}
__device__ __forceinline__ void phase_prologue(const Prm& p, LAS unsigned char* lds, int gw, int ngw, int wave, int lane, bool first) {
    LAS float* scr = (LAS float*)(lds + wave * 16384);
    unsigned char* ws = p.ws;
    t_convert_pairs(p, 0, (CONV_QUEUE && Q_L0EXP) ? NP_PROJ : NPL, scr, gw, ngw, lane);
    if (!CONV_QUEUE) t_convert_pairs(p, 1, NPL, scr, gw, ngw, lane);
    t_convert_all<false>(p, scr, gw, ngw, lane);
    for (int it = gw; first && it < MODP_ITEMS; it += ngw) {
        if (it < MODP_ITEMS0) mods_item<MPK>(p, 0, MPK * (it / (MODP_NC0 + (MODP_NC0 == 0))), it % (MODP_NC0 + (MODP_NC0 == 0)), scr, lane);
        else { const int q = it - MODP_ITEMS0; mods_item<MPK>(p, 1, MPK * (q / (MODP_NC1 + (MODP_NC1 == 0))), q % (MODP_NC1 + (MODP_NC1 == 0)), scr, lane); } }
    for (int it = gw * 64 + lane; it < 128 * 32; it += ngw * 64) { const int pos = it >> 5, i = it & 31; const float inv = powf(10000.f, -(float)i / 32.f), ang = (float)pos * inv;
        ((float*)(ws + WS_ROPE))[2 * it] = cosf(ang); ((float*)(ws + WS_ROPE))[2 * it + 1] = sinf(ang); }
}

__device__ __forceinline__ f32x4 modv4(const float* p) {
    typedef int i32x4 __attribute__((ext_vector_type(4)));
    const i32x4 v = *(const i32x4*)p; return (f32x4){(float)v[0], (float)v[1], (float)v[2], (float)v[3]} * (1.f / 16777216.f);
}
__device__ __forceinline__ f32x4 bf4(v2u w) { return (f32x4){bflo(w.x), bfhi(w.x), bflo(w.y), bfhi(w.y)}; }
__device__ __forceinline__ void load_row(const Prm& p, int l, int lcomb, int m, int lane, f32x4 (&v)[8], bool wb = true, const LAS int* segL = nullptr) {
    const bool isc = m >= T_LAT;
    const bf16* wsrow = isc ? (const bf16*)(p.ws + WS_XC) + (size_t)(m - T_LAT) * DM : (const bf16*)(p.ws + WS_X) + (size_t)m * DM;
#pragma unroll
    for (int j = 0; j < 8; ++j) v[j] = bf4(*(const v2u*)(wsrow + 256 * j + 4 * lane));
}
__device__ __forceinline__ float row_rstd(const f32x4 (&v)[8]) {
    float s = 0.f;
#pragma unroll
    for (int j = 0; j < 8; ++j) s += (v[j][0] * v[j][0] + v[j][1] * v[j][1]) + (v[j][2] * v[j][2] + v[j][3] * v[j][3]);
    return rsqrtf(wave_sum(s) * (1.f / DM) + EPS);
}
__device__ __forceinline__ f32x4 modulate4f(const f32x4 v, float rstd, const float* gain, const float* sc, const float* sh, int col) {
    const f32x4 g = *(const f32x4*)(gain + col), s1 = modv4(sc + col), s0 = modv4(sh + col);
    return (v * rstd * g) * (s1 + 1.f) + s0;
}
__device__ __forceinline__ v2u modulate4(const f32x4 v, float rstd, const float* gain, const float* sc, const float* sh, int col) {
    const f32x4 g = *(const f32x4*)(gain + col), s1 = modv4(sc + col), s0 = modv4(sh + col);
    const f32x4 o = (v * rstd * g) * (s1 + 1.f) + s0;
    v2u w; w.x = pk2(o[0], o[1]); w.y = pk2(o[2], o[3]); return w;
}
constexpr int RS_A = 0, RS_SH = 3 * 8192, RS_GF = 6 * 8192, RS_END = 9 * 8192;
struct RowX { f32x4 x[8]; v2u xb[8]; unsigned ya[8], yb[8]; };
struct RowI { int s; float g; };
template <bool COMB> __device__ __forceinline__ RowI rs_idx_issue(const Prm& p, int m, int lane, int& e_out, int& pos_out) {
    RowI r; r.s = 0; r.g = 0.f; e_out = 0; pos_out = 0;
    if constexpr (COMB) { const int k = lane & 1; const int* te = (const int*)(p.ws + WS_TOK); const int* tp = (const int*)(p.ws + WS_TOK + TOKTAB); const float* tg = (const float*)(p.ws + WS_TOK + 2 * TOKTAB);
        e_out = te[2 * m + k]; pos_out = tp[2 * m + k]; r.g = tg[2 * m + k]; }
    return r;
}
template <bool COMB, bool SRC32> __device__ __forceinline__ void rs_issue(const Prm& p, int m, int s0, int s1, int lane, RowX& b) {
    const bool isc = m >= T_LAT;
    if constexpr (SRC32) { const float* src = isc ? p.ctx + (size_t)(m - T_LAT) * DM : p.x + (size_t)m * DM;
#pragma unroll
        for (int j = 0; j < 8; ++j) b.x[j] = __builtin_nontemporal_load((const f32x4*)(src + 256 * j + 4 * lane)); }
    else { const bf16* src = isc ? (const bf16*)(p.ws + WS_XC) + (size_t)(m - T_LAT) * DM : (const bf16*)(p.ws + WS_X) + (size_t)m * DM;
#pragma unroll
        for (int j = 0; j < 8; ++j) b.xb[j] = *(const v2u*)(src + 256 * j + 4 * lane); }
    if constexpr (COMB) { const unsigned char* y0 = p.ws + WS_YB + (size_t)s0 * DM; const unsigned char* y1 = p.ws + WS_YB + (size_t)s1 * DM;
#pragma unroll
        for (int j = 0; j < 8; ++j) { b.ya[j] = __builtin_nontemporal_load((const unsigned*)(y0 + 256 * j + 4 * lane)); b.yb[j] = __builtin_nontemporal_load((const unsigned*)(y1 + 256 * j + 4 * lane)); } }
}
template <bool COMB, bool FINAL, bool SRC32> __device__ __forceinline__ void rs_finish(const Prm& p, int l, int m, float g0, float g1, int lane, RowX& b, const LAS unsigned char* vl, bool live) {
    const bool isc = m >= T_LAT; const int vs = isc ? 2 : (m >> 13);
    const LAS float* A = (const LAS float*)(vl + RS_A) + vs * 2048; const LAS float* SH = (const LAS float*)(vl + RS_SH) + vs * 2048; const LAS float* GF = (const LAS float*)(vl + RS_GF) + vs * 2048;
    if constexpr (!SRC32) {
#pragma unroll
        for (int j = 0; j < 8; ++j) b.x[j] = bf4(b.xb[j]); }
    if constexpr (COMB) {
        bf16* wsrow = isc ? (bf16*)(p.ws + WS_XC) + (size_t)(m - T_LAT) * DM : (bf16*)(p.ws + WS_X) + (size_t)m * DM;
#pragma unroll
        for (int j = 0; j < 8; ++j) { const int col = 256 * j + 4 * lane; const unsigned a = b.ya[j], c = b.yb[j]; const f32x4 gq = *(const LAS f32x4*)(GF + col);
            const f32x2 a01 = __builtin_amdgcn_cvt_pk_f32_fp8(a, false), a23 = __builtin_amdgcn_cvt_pk_f32_fp8(a, true), c01 = __builtin_amdgcn_cvt_pk_f32_fp8(c, false), c23 = __builtin_amdgcn_cvt_pk_f32_fp8(c, true);
            b.x[j][0] += gq[0] * (g0 * a01[0] + g1 * c01[0]); b.x[j][1] += gq[1] * (g0 * a01[1] + g1 * c01[1]);
            b.x[j][2] += gq[2] * (g0 * a23[0] + g1 * c23[0]); b.x[j][3] += gq[3] * (g0 * a23[1] + g1 * c23[1]);
            if (!FINAL && live) { v2u w; w.x = pk2(b.x[j][0], b.x[j][1]); w.y = pk2(b.x[j][2], b.x[j][3]); *(v2u*)(wsrow + col) = w; } } }
    const float rstd = row_rstd(b.x);
    if (!live) return;
#pragma unroll
    for (int j = 0; j < 8; ++j) { const int col = 256 * j + 4 * lane; const f32x4 av = *(const LAS f32x4*)(A + col);
        if constexpr (FINAL) { __builtin_nontemporal_store(b.x[j] * rstd * av, (f32x4*)(p.out + (size_t)m * DM + col)); }
        else { const f32x4 o = b.x[j] * rstd * av + *(const LAS f32x4*)(SH + col);
            if (F8_INPROJ) *(unsigned*)(p.ws + WS_H + (size_t)m * DM + col) = pack4f8(o[0], o[1], o[2], o[3]);
            else { v2u w; w.x = pk2(o[0], o[1]); w.y = pk2(o[2], o[3]); *(v2u*)((bf16*)(p.ws + WS_H) + (size_t)m * DM + col) = w; } } }
}
template <bool COMB, bool FINAL, bool SRC32> __device__ __forceinline__ void row_stream(const Prm& p, int l, int lc, int nrows, int gw, int ngw, int tid, int lane, LAS unsigned char* vl, const LAS int* segL) {
    { const float* md = (const float*)(p.ws + OFF_MOD);
      for (int q = tid; q < 3 * 512; q += NWAVES * 64) { const int vs = q >> 9, c4 = (q & 511) * 4;
          if (FINAL) { if (vs == 0) *(LAS f32x4*)(vl + RS_A + (size_t)c4 * 4) = *(const f32x4*)(p.norm_final + c4); }
          else { const f32x4 gn = *(const f32x4*)(p.norm_mix + l * DM + c4), sc = modv4(md + (size_t)(l * 3 + vs) * MODW + DM + c4), sh = modv4(md + (size_t)(l * 3 + vs) * MODW + c4);
              *(LAS f32x4*)(vl + RS_A + ((size_t)vs * 2048 + c4) * 4) = gn * (sc + 1.f); *(LAS f32x4*)(vl + RS_SH + ((size_t)vs * 2048 + c4) * 4) = sh; }
          if (COMB) *(LAS f32x4*)(vl + RS_GF + ((size_t)vs * 2048 + c4) * 4) = modv4(md + (size_t)(lc * 3 + vs) * MODW + 5 * DM + c4) * (1.f / Y8_SCALE); }
      if (FINAL) { for (int q = tid; q < 2 * 512; q += NWAVES * 64) { const int c4 = (q & 511) * 4; *(LAS f32x4*)(vl + RS_A + ((size_t)(1 + (q >> 9)) * 2048 + c4) * 4) = *(const f32x4*)(p.norm_final + c4); } }
      __syncthreads(); }
    const int nit = gw < nrows ? (nrows - gw + ngw - 1) / ngw : 0;
    if (nit == 0) return;
    const int last = gw + (nit - 1) * ngw;
#define RS_ROW(i) min(gw + (i) * ngw, last)
    RowX bA, bB; int e0, p0, e1, p1; RowI i0 = rs_idx_issue<COMB>(p, RS_ROW(0), lane, e0, p0), i1 = rs_idx_issue<COMB>(p, RS_ROW(1), lane, e1, p1);
    { int s = COMB ? segL[e0] + p0 : 0; rs_issue<COMB, SRC32>(p, RS_ROW(0), __shfl(s, 0), __shfl(s, 1), lane, bA); }
#pragma unroll 1
    for (int i = 0; i < nit; i += 2) {
        int e2, p2, e3, p3;
        const RowI i2 = rs_idx_issue<COMB>(p, RS_ROW(i + 2), lane, e2, p2);
        { int s = COMB ? segL[e1] + p1 : 0; rs_issue<COMB, SRC32>(p, RS_ROW(i + 1), __shfl(s, 0), __shfl(s, 1), lane, bB); }
        rs_finish<COMB, FINAL, SRC32>(p, l, RS_ROW(i), __shfl(i0.g, 0), __shfl(i0.g, 1), lane, bA, vl, true);
        const RowI i3 = rs_idx_issue<COMB>(p, RS_ROW(i + 3), lane, e3, p3);
        { int s = COMB ? segL[e2] + p2 : 0; rs_issue<COMB, SRC32>(p, RS_ROW(i + 2), __shfl(s, 0), __shfl(s, 1), lane, bA); }
        rs_finish<COMB, FINAL, SRC32>(p, l, RS_ROW(i + 1), __shfl(i1.g, 0), __shfl(i1.g, 1), lane, bB, vl, i + 1 < nit);
        i0 = i2; i1 = i3; e1 = e3; p1 = p3;
    }
#undef RS_ROW
}
#ifndef Q_L0EXP
#define Q_L0EXP 1
#endif
constexpr int Q_L0 = Q_L0EXP ? NP_EXP : 0;
constexpr int Q_MOD = Q_L0EXP ? MODQ : 0;
constexpr int Q_L1 = Q_L0 + Q_MOD;
constexpr int Q_TOTAL = Q_L1 + NPL;
static_assert(Q_L0 % 16 == 0 && Q_L1 % 16 == 0 && (Q_L1 + NP_PROJ) % 16 == 0, "drain targets are multiples of the largest grab");
__device__ __forceinline__ void q_decode(unsigned q, int& kind, int& l, int& idx) {
    if (q < (unsigned)Q_L0) { kind = 0; l = 0; idx = (int)q + NP_PROJ; } else if (q < (unsigned)Q_L1) { kind = 1; l = 0; idx = (int)q - Q_L0; } else { kind = 0; l = 1; idx = (int)q - Q_L1; }
}
__device__ __forceinline__ void queue_convert8(const Prm& p, unsigned base, int n, LAS unsigned char* lds, int tid_in) {
    int tid = tid_in;
    asm volatile("" : "+v"(tid));
    const int wave = __builtin_amdgcn_readfirstlane(tid >> 6), lane = tid & 63; const unsigned q0 = base + (unsigned)wave, q1 = q0 + 8u;
    LAS float* scr = (LAS float*)(lds + wave * 16384);
    const bool h0 = q0 < (unsigned)Q_TOTAL, h1 = n == 16 && q1 < (unsigned)Q_TOTAL;
    int k0 = 0, l0 = 0, i0 = 0, k1 = 0, l1 = 0, i1 = 0; q_decode(q0, k0, l0, i0); q_decode(q1, k1, l1, i1);
    if (h0 && h1 && k0 == 0 && k1 == 0) { t_convert_two(p, l0, i0, l1, i1, true, scr, lane); return; }
    if (h0) { if (k0 == 0) t_convert_one(p, l0, i0, scr, lane); else mods_queue_item(p, i0, scr, lane); }
    if (h1) { if (k1 == 0) t_convert_one(p, l1, i1, scr, lane); else mods_queue_item(p, i1, scr, lane); }
}
__device__ __forceinline__ void xcd_barrier_work(const XcdBarrier& b, const Prm& p, LAS unsigned char* lds, int tid, int grab) {
    asm volatile("s_waitcnt vmcnt(0)" ::: "memory");
    __syncthreads();
    volatile LAS unsigned* bw = (volatile LAS unsigned*)(lds + L_BWORK);
    unsigned* bar = b.bar; unsigned* q = (unsigned*)(p.ws + OFF_Q);
    if (threadIdx.x == 0) {
        __builtin_amdgcn_s_waitcnt(0);
        unsigned nloc = b.st[0], nx = b.st[1];
        if (nloc == 0u) { xcd_barrier_complete(bar, b.x, nloc, nx); b.st[0] = nloc; b.st[1] = nx; }
        const unsigned old = xb_add(&bar[XB_XSUB(b.x)], 1u);
        const unsigned gen = old / nloc;
        if (old + 1u == (gen + 1u) * nloc) {
            __builtin_amdgcn_fence(__ATOMIC_RELEASE, "agent");
            asm volatile("s_waitcnt vmcnt(0)" ::: "memory");
            const unsigned og = xb_add(&bar[XB_TOP], 1u);
            const unsigned tg = og / nx;
            if (og + 1u == (tg + 1u) * nx) xb_add(&bar[XB_TOPGEN], 1u);
            else XB_SPIN(xb_ld(&bar[XB_TOPGEN]) == tg, bar);
            __builtin_amdgcn_fence(__ATOMIC_ACQUIRE, "agent");
            xb_add(&bar[XB_XGEN(b.x)], 1u);
            asm volatile("s_waitcnt vmcnt(0)" ::: "memory");
            bw[0] = 1u;
        } else { bw[0] = 0u; bw[2] = gen; }
    }
    __syncthreads();
    if (bw[0] == 0u) {
        unsigned sp = 0u;
        for (;;) {
            if (threadIdx.x == 0) {
                const unsigned gen = bw[2];
                bool rel = xb_ld(&bar[XB_XGEN(b.x)]) != gen;
                if (!rel && ((++sp & 63u) == 0u)) { if (xb_ld(&bar[XB_TMO])) rel = true; else if (sp > XB_SPIN_CAP) { atomicAdd(&bar[XB_TMO], 1u); rel = true; } }
                if (rel) { __builtin_amdgcn_fence(__ATOMIC_ACQUIRE, "agent"); asm volatile("s_waitcnt vmcnt(0)" ::: "memory"); bw[0] = 1u; }
                else { unsigned base = 0xffffffffu; if (xb_ld(q) < (unsigned)Q_TOTAL) { base = xb_add(q, (unsigned)grab); if (base >= (unsigned)Q_TOTAL) base = 0xffffffffu; } bw[1] = base; }
            }
            __syncthreads();
            if (bw[0]) break;
            const unsigned base = bw[1];
            if (base != 0xffffffffu) queue_convert8(p, base, grab, lds, tid); else __builtin_amdgcn_s_sleep(4);
            __syncthreads();
        }
    }
    __syncthreads();
}
__device__ __forceinline__ void queue_drain(const Prm& p, LAS unsigned char* lds, int tid, unsigned target) {
    volatile LAS unsigned* bw = (volatile LAS unsigned*)(lds + L_BWORK); unsigned* q = (unsigned*)(p.ws + OFF_Q);
    __syncthreads();
    for (;;) {
        if (threadIdx.x == 0) bw[1] = (xb_ld(q) < target) ? xb_add(q, 16u) : 0xffffffffu;
        __syncthreads();
        const unsigned base = bw[1];
        if (base >= target) break;
        queue_convert8(p, base, 16, lds, tid);
        __syncthreads();
    }
    __syncthreads();
}
__device__ __forceinline__ void phase_conv(const Prm& p, int l, int gw, int ngw, int lane) {
    const bf16* U = (const bf16*)(p.ws + WS_U); bf16* XA = (bf16*)(p.ws + WS_XBC); float* DT = (float*)(p.ws + WS_DT);
    constexpr int NRUN = T_ALL / 16;
    for (int it = gw; it < NRUN * 3; it += ngw) {
        const int run = it / 3, cb = it % 3, t0 = run * 16, ch = cb * 512 + lane * 8;
        int seq0, seq1; if (t0 < T_LAT) { seq0 = t0 & ~(SEQL - 1); seq1 = seq0 + SEQL; } else { seq0 = T_LAT + ((t0 - T_LAT) & ~(CTXL - 1)); seq1 = seq0 + CTXL; }
        float w[5][8], bias[8];
#pragma unroll
        for (int j = 0; j < 5; ++j) { const f32x4 a = *(const f32x4*)(p.conv_w + ((size_t)l * 5 + j) * XBCW + ch), b = *(const f32x4*)(p.conv_w + ((size_t)l * 5 + j) * XBCW + ch + 4);
            w[j][0] = a[0]; w[j][1] = a[1]; w[j][2] = a[2]; w[j][3] = a[3]; w[j][4] = b[0]; w[j][5] = b[1]; w[j][6] = b[2]; w[j][7] = b[3]; }
        { const f32x4 a = *(const f32x4*)(p.conv_b + (size_t)l * XBCW + ch), b = *(const f32x4*)(p.conv_b + (size_t)l * XBCW + ch + 4);
            bias[0] = a[0]; bias[1] = a[1]; bias[2] = a[2]; bias[3] = a[3]; bias[4] = b[0]; bias[5] = b[1]; bias[6] = b[2]; bias[7] = b[3]; }
        v4u rows[20];
#pragma unroll
        for (int j = 0; j < 20; ++j) { const int t = t0 - 2 + j, tc = min(max(t, seq0), seq1 - 1); rows[j] = __builtin_nontemporal_load((const v4u*)(U + (size_t)tc * NINP + C_XBC + ch)); }
#pragma unroll
        for (int j = 0; j < 20; ++j) { const int t = t0 - 2 + j; if (t < seq0 || t >= seq1) rows[j] = (v4u){0u, 0u, 0u, 0u}; }
#pragma unroll
        for (int i = 0; i < 16; ++i) {
            const int t = t0 + i;
            float o[8];
#pragma unroll
            for (int c = 0; c < 8; ++c) o[c] = bias[c];
#pragma unroll
            for (int j = 0; j < 5; ++j) { const v4u wv = rows[i + j];
                o[0] += w[j][0] * bflo(wv.x); o[1] += w[j][1] * bfhi(wv.x); o[2] += w[j][2] * bflo(wv.y); o[3] += w[j][3] * bfhi(wv.y);
                o[4] += w[j][4] * bflo(wv.z); o[5] += w[j][5] * bfhi(wv.z); o[6] += w[j][6] * bflo(wv.w); o[7] += w[j][7] * bfhi(wv.w); }
            v4u r; r.x = pk2(silu_f(o[0]), silu_f(o[1])); r.y = pk2(silu_f(o[2]), silu_f(o[3])); r.z = pk2(silu_f(o[4]), silu_f(o[5])); r.w = pk2(silu_f(o[6]), silu_f(o[7]));
            *(v4u*)(XA + (size_t)t * XBCW + ch) = r;
        }
    }
    for (int it = gw * 64 + lane; it < T_ALL * 32; it += ngw * 64) { const int m = it >> 5, j = it & 31;
        DT[it] = softplus_f(bf2f(U[(size_t)m * NINP + C_DT + j]) + p.dt_bias[l * 32 + j]); }
}

__device__ __forceinline__ void naive_attn_item(const Prm& p, int l, int type, int m, int hh, LAS float* qs, LAS float* sc, int lane) {
    const bf16* U = (const bf16*)(p.ws + WS_U); bf16* MIX = (bf16*)(p.ws + WS_H);
    int qcol, kcol, vcol, ocol;
    if (type == 0 || type == 2) { qcol = C_QA + hh * 128; kcol = C_KA + hh * 128; vcol = C_VA + hh * 128; ocol = hh * 128; }
    else { const int kvh = hh >> 1; qcol = C_QB + hh * 128; kcol = C_KB + kvh * 128; vcol = C_VB + kvh * 128; ocol = 512 + hh * 128; }
    { const unsigned w = *(const unsigned*)(U + (size_t)m * NINP + qcol + 2 * lane); qs[2 * lane] = bflo(w); qs[2 * lane + 1] = bfhi(w); }
    int b, s = 0, qr = 0, qc = 0, krow0 = 0, kpos0 = 0;
    if (type < 2) { b = m >> 13; s = m & 8191; qr = s >> 6; qc = s & 63; } else { b = (m - T_LAT) >> 8; }
    const int nloc = type == 0 ? 512 : (type == 1 ? 384 : 0), nk = nloc + 256;
    if (type == 0) krow0 = min(max(qr - 4, 0), 120);
    if (type == 1) kpos0 = (s >> 7) * 128 - 128;
    const float* rpb = p.na_rpb + (size_t)(l * 4 + hh) * 15 * 31;
    LDS_WAIT(); __builtin_amdgcn_wave_barrier(); asm volatile("" ::: "memory");
    float mx = -INFINITY;
    for (int k0 = 0; k0 < nk; k0 += 64) {
        const int kidx = k0 + lane; int row; float bias = 0.f; bool valid = true;
        if (kidx < nloc) {
            if (type == 0) { const int kr = krow0 + (kidx >> 6), kc = kidx & 63; row = b * SEQL + kr * 64 + kc; const int c0 = min(max(qc - 8, 0), 48); valid = (kc >= c0) && (kc < c0 + 16);
                const int dr = kr - qr + 7, dc = min(max(kc - qc + 15, 0), 30); bias = rpb[dr * 31 + dc]; }
            else { const int kpos = kpos0 + kidx; valid = (kpos >= 0) && (kpos < SEQL) && (abs(s - kpos) <= 128); row = b * SEQL + min(max(kpos, 0), SEQL - 1); }
        } else row = T_LAT + b * CTXL + (kidx - nloc);
        const bf16* kp = U + (size_t)row * NINP + kcol; float d = 0.f;
#pragma unroll 4
        for (int c = 0; c < 16; ++c) { const v4u w = *(const v4u*)(kp + 8 * c); const LAS float* q = qs + 8 * c;
            d += bflo(w.x) * q[0] + bfhi(w.x) * q[1] + bflo(w.y) * q[2] + bfhi(w.y) * q[3] + bflo(w.z) * q[4] + bfhi(w.z) * q[5] + bflo(w.w) * q[6] + bfhi(w.w) * q[7]; }
        const float sv = valid ? d * ATT_SCALE + bias : -INFINITY;
        sc[kidx] = sv; mx = fmaxf(mx, sv);
    }
    mx = wave_max(mx);
    float sum = 0.f;
    for (int k0 = 0; k0 < nk; k0 += 64) { const float e = __expf(sc[k0 + lane] - mx); sc[k0 + lane] = e; sum += e; }
    sum = wave_sum(sum);
    if (type == 1 || type == 3) sum += __expf(p.wa_sink[l * 4 + hh] - mx);
    LDS_WAIT(); __builtin_amdgcn_wave_barrier(); asm volatile("" ::: "memory");
    float o0 = 0.f, o1 = 0.f;
    for (int kidx = 0; kidx < nk; ++kidx) {
        int row;
        if (kidx < nloc) { if (type == 0) row = b * SEQL + (krow0 + (kidx >> 6)) * 64 + (kidx & 63); else row = b * SEQL + min(max(kpos0 + kidx, 0), SEQL - 1); }
        else row = T_LAT + b * CTXL + (kidx - nloc);
        const float pv = sc[kidx]; const unsigned w = *(const unsigned*)(U + (size_t)row * NINP + vcol + 2 * lane);
        o0 += pv * bflo(w); o1 += pv * bfhi(w);
    }
    const float inv = 1.f / sum;
    *(unsigned*)(MIX + (size_t)m * DM + ocol + 2 * lane) = pk2(o0 * inv, o1 * inv);
    LDS_WAIT(); __builtin_amdgcn_wave_barrier(); asm volatile("" ::: "memory");
}
__device__ __forceinline__ void phase_attn_naive(const Prm& p, int l, LAS unsigned char* lds, int gw, int ngw, int wave, int lane) {
    LAS float* qs = (LAS float*)(lds + wave * 4096); LAS float* sc = qs + 128;
    const int nlat = T_LAT * 8, nctx = (l == 0) ? T_CTX * 8 : 0;
    for (int it = gw; it < nlat + nctx; it += ngw) {
        if (it < nlat) { const int m = it >> 3, h8 = it & 7; naive_attn_item(p, l, h8 >> 2, m, h8 & 3, qs, sc, lane); }
        else { const int r = it - nlat, m = T_LAT + (r >> 3), h8 = r & 7; naive_attn_item(p, l, 2 + (h8 >> 2), m, h8 & 3, qs, sc, lane); }
    }
}

__device__ __forceinline__ void phase_ssd_naive(const Prm& p, int l, int wg, int nwg, int tid) {
    const bf16* XA = (const bf16*)(p.ws + WS_XBC); const float* DT = (const float*)(p.ws + WS_DT); float* YD = (float*)(p.ws + WS_YD);
    for (int it = wg; it < 64; it += nwg) {
        const int b = it >> 5, dir = (it >> 4) & 1, h = it & 15, g = h >> 3;
        const int pp = tid >> 3, nq = tid & 7;
        const float a = -__expf(p.a_log[l * 32 + dir * 16 + h]), dsk = p.d_skip[l * 32 + dir * 16 + h];
        float hs[16];
#pragma unroll
        for (int i = 0; i < 16; ++i) hs[i] = 0.f;
#pragma unroll 4
        for (int st = 0; st < CTXL + SEQL; ++st) {
            int m; if (st < CTXL) m = T_LAT + b * CTXL + (dir ? CTXL - 1 - st : st); else { const int s = st - CTXL; m = b * SEQL + (dir ? SEQL - 1 - s : s); }
            const float dtv = DT[(size_t)m * 32 + dir * 16 + h];
            const bf16* row = XA + (size_t)m * XBCW;
            const float xv = bf2f(row[h * 64 + pp]);
            const v4u b0 = *(const v4u*)(row + 1024 + g * 128 + 16 * nq), b1 = *(const v4u*)(row + 1024 + g * 128 + 16 * nq + 8);
            const v4u c0 = *(const v4u*)(row + 1280 + g * 128 + 16 * nq), c1 = *(const v4u*)(row + 1280 + g * 128 + 16 * nq + 8);
            const float dA = __expf(a * dtv), dx = dtv * xv;
            float bv[16], cv[16];
            bv[0] = bflo(b0.x); bv[1] = bfhi(b0.x); bv[2] = bflo(b0.y); bv[3] = bfhi(b0.y); bv[4] = bflo(b0.z); bv[5] = bfhi(b0.z); bv[6] = bflo(b0.w); bv[7] = bfhi(b0.w);
            bv[8] = bflo(b1.x); bv[9] = bfhi(b1.x); bv[10] = bflo(b1.y); bv[11] = bfhi(b1.y); bv[12] = bflo(b1.z); bv[13] = bfhi(b1.z); bv[14] = bflo(b1.w); bv[15] = bfhi(b1.w);
            cv[0] = bflo(c0.x); cv[1] = bfhi(c0.x); cv[2] = bflo(c0.y); cv[3] = bfhi(c0.y); cv[4] = bflo(c0.z); cv[5] = bfhi(c0.z); cv[6] = bflo(c0.w); cv[7] = bfhi(c0.w);
            cv[8] = bflo(c1.x); cv[9] = bfhi(c1.x); cv[10] = bflo(c1.y); cv[11] = bfhi(c1.y); cv[12] = bflo(c1.z); cv[13] = bfhi(c1.z); cv[14] = bflo(c1.w); cv[15] = bfhi(c1.w);
            float part = 0.f;
#pragma unroll
            for (int i = 0; i < 16; ++i) { hs[i] = dA * hs[i] + dx * bv[i]; part += cv[i] * hs[i]; }
            part += __shfl_xor(part, 1); part += __shfl_xor(part, 2); part += __shfl_xor(part, 4);
            if (nq == 0) YD[((size_t)dir * T_ALL + m) * 1024 + h * 64 + pp] = part + dsk * xv;
        }
    }
}
__device__ __forceinline__ void phase_gnorm(const Prm& p, int l, int gw, int ngw, int lane) {
    const bf16* U = (const bf16*)(p.ws + WS_U); const bf16* YD = (const bf16*)(p.ws + WS_XG); bf16* MIX = (bf16*)(p.ws + WS_H);
    const int nrow = (l == 0) ? T_ALL : T_LAT;
    for (int m0 = gw; m0 < nrow; m0 += 2 * ngw) {
        const int m1 = (m0 + ngw < nrow) ? m0 + ngw : m0;
        v2u yv[2][4], zv[2][4];
#pragma unroll
        for (int q = 0; q < 2; ++q) { const int m = q ? m1 : m0;
#pragma unroll
            for (int j = 0; j < 4; ++j) { const int col = 256 * j + 4 * lane; yv[q][j] = __builtin_nontemporal_load((const v2u*)(YD + (size_t)m * 1024 + col)); zv[q][j] = __builtin_nontemporal_load((const v2u*)(U + (size_t)m * NINP + C_Z + col)); } }
#pragma unroll
        for (int q = 0; q < 2; ++q) { const int m = q ? m1 : m0;
            f32x4 u[4]; float ss[2] = {0.f, 0.f};
#pragma unroll
            for (int j = 0; j < 4; ++j) { const v2u yy = yv[q][j], zz = zv[q][j];
                u[j][0] = bflo(yy.x) * silu_f(bflo(zz.x)); u[j][1] = bfhi(yy.x) * silu_f(bfhi(zz.x)); u[j][2] = bflo(yy.y) * silu_f(bflo(zz.y)); u[j][3] = bfhi(yy.y) * silu_f(bfhi(zz.y));
                ss[j >> 1] += (u[j][0] * u[j][0] + u[j][1] * u[j][1]) + (u[j][2] * u[j][2] + u[j][3] * u[j][3]); }
            const float r0 = rsqrtf(wave_sum(ss[0]) * (1.f / 512.f) + EPS), r1 = rsqrtf(wave_sum(ss[1]) * (1.f / 512.f) + EPS);
            if (q == 1 && m1 == m0) continue;
#pragma unroll
            for (int j = 0; j < 4; ++j) { const int col = 256 * j + 4 * lane; const f32x4 g = *(const f32x4*)(p.ssd_norm + l * 1024 + col); const f32x4 o = u[j] * (j < 2 ? r0 : r1) * g;
                if (F8_OUTPROJ) *(unsigned*)((unsigned char*)MIX + (size_t)m * DM + 1024 + col) = pack4f8(o[0] * MIX_SCALE, o[1] * MIX_SCALE, o[2] * MIX_SCALE, o[3] * MIX_SCALE);
                else { v2u w; w.x = pk2(o[0], o[1]); w.y = pk2(o[2], o[3]); *(v2u*)(MIX + (size_t)m * DM + 1024 + col) = w; } }
        }
    }
}
#ifdef PROBE_AT
#define PAT_SYNC(stmt) do { const long long pa_t0_ = wall_clock64(); stmt; if ((PROBE_AT) & 1) { const long long pa_t1_ = wall_clock64(), pa_d_ = (pa_t1_ - pa_t0_) * (PROBE_MULT); while (wall_clock64() - pa_t1_ < pa_d_) __builtin_amdgcn_s_sleep(2); } } while (0)
#else
#define PAT_SYNC(stmt) stmt
#endif
namespace att {
typedef short s16x4 __attribute__((ext_vector_type(4)));
typedef float f32x16 __attribute__((ext_vector_type(16)));
#ifndef ATT_PV2
#define ATT_PV2 1
#endif
constexpr int KVBLK = 64;
constexpr float THR = 8.f;
#ifndef ATT_SDEPTH
#define ATT_SDEPTH 1
#endif
constexpr int SDEPTH = ATT_SDEPTH;
constexpr int SHM_V = KVBLK * 128 * 2, SHM_K = KVBLK * 128 * 2;
constexpr int OFF_V = 0, OFF_K = 2 * SHM_V, OFF_WS = 2 * SHM_V + 2 * SHM_K, OFF_RPB = OFF_WS + 8 * 64 * 4, ATT_LDS = OFF_RPB + 576 * 4;
#define KSWZ(row, colB) ((row) * 256 + ((colB) ^ (((row) & 15) << 4)))
#define SBAR() __builtin_amdgcn_sched_barrier(0)
__device__ __forceinline__ int crow(int r, int hi) { return (r & 3) + 8 * (r >> 2) + 4 * hi; }
__device__ __forceinline__ unsigned cvtpk(float lo, float hi) { unsigned r; asm volatile("v_cvt_pk_bf16_f32 %0, %1, %2" : "=v"(r) : "v"(lo), "v"(hi)); return r; }
__device__ __forceinline__ void partialSM(f32x16& p0, f32x16& p1, float& m_reg, float& mn, float& alpha) {
  constexpr float C = ATT_SCALE * 1.4426950408889634f;
  float pmax = p0[0];
#pragma unroll
  for (int r = 1; r < 16; ++r) pmax = fmaxf(pmax, p0[r]);
#pragma unroll
  for (int r = 0; r < 16; ++r) pmax = fmaxf(pmax, p1[r]);
  { auto rr = __builtin_amdgcn_permlane32_swap(__float_as_uint(pmax), __float_as_uint(pmax), false, false);
    pmax = fmaxf(__uint_as_float(rr[0]), __uint_as_float(rr[1])); }
  if (__builtin_expect(__all(pmax - m_reg <= THR / ATT_SCALE), 1)) { mn = m_reg; alpha = 1.f; }
  else { mn = fmaxf(m_reg, pmax); alpha = __builtin_amdgcn_exp2f((m_reg - mn) * C); m_reg = mn; }
  float mnC = -mn * C;
#pragma unroll
  for (int r = 0; r < 16; ++r) p0[r] = fmaf(p0[r], C, mnC);
#pragma unroll
  for (int r = 0; r < 16; ++r) p1[r] = fmaf(p1[r], C, mnC);
#pragma unroll
  for (int r = 0; r < 16; ++r) p0[r] = __builtin_amdgcn_exp2f(p0[r]);
}
__device__ __forceinline__ void finishSM(f32x16& p0, f32x16& p1, float alpha, float& l_reg, bf16x8& pa0, bf16x8& pa1, bf16x8& pa2, bf16x8& pa3) {
#pragma unroll
  for (int r = 0; r < 16; ++r) p1[r] = __builtin_amdgcn_exp2f(p1[r]);
  float ps = 0;
#pragma unroll
  for (int r = 0; r < 16; ++r) ps += p0[r];
#pragma unroll
  for (int r = 0; r < 16; ++r) ps += p1[r];
  { auto rr = __builtin_amdgcn_permlane32_swap(__float_as_uint(ps), __float_as_uint(ps), false, false);
    ps = __uint_as_float(rr[0]) + __uint_as_float(rr[1]); }
  l_reg = l_reg * alpha + ps;
#define PK4(P, BASE, OUT) do { unsigned a0 = cvtpk(P[BASE + 0], P[BASE + 1]), a1 = cvtpk(P[BASE + 2], P[BASE + 3]);   \
    unsigned b0 = cvtpk(P[BASE + 4], P[BASE + 5]), b1 = cvtpk(P[BASE + 6], P[BASE + 7]);                              \
    auto r0 = __builtin_amdgcn_permlane32_swap(a0, b0, false, false); auto r1 = __builtin_amdgcn_permlane32_swap(a1, b1, false, false); \
    v4u w = {r0[0], r1[0], r0[1], r1[1]}; OUT = *reinterpret_cast<bf16x8*>(&w); } while (0)
  PK4(p0, 0, pa0); PK4(p0, 8, pa1); PK4(p1, 0, pa2); PK4(p1, 8, pa3);
#undef PK4
}
__device__ __forceinline__ void qkt(f32x16& p0, f32x16& p1, const LAS unsigned char* Ks, const bf16x8* qr, int r32, int hi) {
  p0 = f32x16{}; p1 = f32x16{};
  bf16x8 ka[2], kb[2];
#define KLD(d0, sl) do { const int cb_ = ((d0) * 16 + hi * 8) * 2; ka[sl] = *reinterpret_cast<const LAS bf16x8*>(Ks + KSWZ(r32, cb_)); kb[sl] = *reinterpret_cast<const LAS bf16x8*>(Ks + KSWZ(32 + r32, cb_)); } while (0)
  KLD(0, 0); KLD(1, 1);
#pragma unroll
  for (int d0 = 0; d0 < 8; ++d0) { const int sl = d0 & 1;
    p0 = __builtin_amdgcn_mfma_f32_32x32x16_bf16(ka[sl], qr[d0], p0, 0, 0, 0);
    p1 = __builtin_amdgcn_mfma_f32_32x32x16_bf16(kb[sl], qr[d0], p1, 0, 0, 0);
    if (d0 + 2 < 8) KLD(d0 + 2, sl);
    SBAR(); }
#undef KLD
}
__device__ __forceinline__ int v_st(int k, int c) { const int kk = (k & ~0xC) | ((k & 4) << 1) | ((k & 8) >> 1); return ((kk >> 3) * 4 + (c >> 5)) * 512 + ((kk & 7) * 32 + (c & 31)) * 2; }
__device__ __forceinline__ int v_rd_base(int lane) { return ((lane & 3) << 3) | (((lane >> 2) & 3) << 6) | (((lane >> 4) & 1) << 5) | (((lane >> 5) & 1) << 8); }
constexpr int v_rd_off(int d0, int ks, int half) { return d0 * 512 + ks * 4096 + half * 2048; }
template <int OFF> __device__ __forceinline__ s16x4 tr_read(int vb) {
  s16x4 r; asm volatile("ds_read_b64_tr_b16 %0, %1 offset:%2" : "=&v"(r) : "v"(vb), "i"(OFF) : "memory"); return r;
}
template <int D0> __device__ __forceinline__ void pv_one(f32x16& od, int vb, bf16x8 pa0, bf16x8 pa1, bf16x8 pa2, bf16x8 pa3) {
  const s16x4 l0 = tr_read<v_rd_off(D0, 0, 0)>(vb), h0 = tr_read<v_rd_off(D0, 0, 1)>(vb), l1 = tr_read<v_rd_off(D0, 1, 0)>(vb), h1 = tr_read<v_rd_off(D0, 1, 1)>(vb);
  const s16x4 l2 = tr_read<v_rd_off(D0, 2, 0)>(vb), h2 = tr_read<v_rd_off(D0, 2, 1)>(vb), l3 = tr_read<v_rd_off(D0, 3, 0)>(vb), h3 = tr_read<v_rd_off(D0, 3, 1)>(vb);
  asm volatile("s_waitcnt lgkmcnt(0)" ::: "memory"); SBAR();
#define PK(L, H) (bf16x8){L[0], L[1], L[2], L[3], H[0], H[1], H[2], H[3]}
  od = __builtin_amdgcn_mfma_f32_32x32x16_bf16(pa0, PK(l0, h0), od, 0, 0, 0);
  od = __builtin_amdgcn_mfma_f32_32x32x16_bf16(pa1, PK(l1, h1), od, 0, 0, 0);
  od = __builtin_amdgcn_mfma_f32_32x32x16_bf16(pa2, PK(l2, h2), od, 0, 0, 0);
  od = __builtin_amdgcn_mfma_f32_32x32x16_bf16(pa3, PK(l3, h3), od, 0, 0, 0);
#undef PK
}
template <int D0> __device__ __forceinline__ void pv_two(f32x16& oa, f32x16& ob, int vb, bf16x8 pa0, bf16x8 pa1, bf16x8 pa2, bf16x8 pa3) {
  const s16x4 l0 = tr_read<v_rd_off(D0, 0, 0)>(vb), h0 = tr_read<v_rd_off(D0, 0, 1)>(vb), l1 = tr_read<v_rd_off(D0, 1, 0)>(vb), h1 = tr_read<v_rd_off(D0, 1, 1)>(vb);
  const s16x4 l2 = tr_read<v_rd_off(D0, 2, 0)>(vb), h2 = tr_read<v_rd_off(D0, 2, 1)>(vb), l3 = tr_read<v_rd_off(D0, 3, 0)>(vb), h3 = tr_read<v_rd_off(D0, 3, 1)>(vb);
  const s16x4 m0 = tr_read<v_rd_off(D0 + 1, 0, 0)>(vb), g0 = tr_read<v_rd_off(D0 + 1, 0, 1)>(vb), m1 = tr_read<v_rd_off(D0 + 1, 1, 0)>(vb), g1 = tr_read<v_rd_off(D0 + 1, 1, 1)>(vb);
  const s16x4 m2 = tr_read<v_rd_off(D0 + 1, 2, 0)>(vb), g2 = tr_read<v_rd_off(D0 + 1, 2, 1)>(vb), m3 = tr_read<v_rd_off(D0 + 1, 3, 0)>(vb), g3 = tr_read<v_rd_off(D0 + 1, 3, 1)>(vb);
  asm volatile("s_waitcnt lgkmcnt(0)" ::: "memory"); SBAR();
#define PK(L, H) (bf16x8){L[0], L[1], L[2], L[3], H[0], H[1], H[2], H[3]}
  oa = __builtin_amdgcn_mfma_f32_32x32x16_bf16(pa0, PK(l0, h0), oa, 0, 0, 0);
  ob = __builtin_amdgcn_mfma_f32_32x32x16_bf16(pa0, PK(m0, g0), ob, 0, 0, 0);
  oa = __builtin_amdgcn_mfma_f32_32x32x16_bf16(pa1, PK(l1, h1), oa, 0, 0, 0);
  ob = __builtin_amdgcn_mfma_f32_32x32x16_bf16(pa1, PK(m1, g1), ob, 0, 0, 0);
  oa = __builtin_amdgcn_mfma_f32_32x32x16_bf16(pa2, PK(l2, h2), oa, 0, 0, 0);
  ob = __builtin_amdgcn_mfma_f32_32x32x16_bf16(pa2, PK(m2, g2), ob, 0, 0, 0);
  oa = __builtin_amdgcn_mfma_f32_32x32x16_bf16(pa3, PK(l3, h3), oa, 0, 0, 0);
  ob = __builtin_amdgcn_mfma_f32_32x32x16_bf16(pa3, PK(m3, g3), ob, 0, 0, 0);
#undef PK
}
__device__ __forceinline__ void pv_d0(f32x16* o, int vb, bf16x8 pa0, bf16x8 pa1, bf16x8 pa2, bf16x8 pa3) {
#if ATT_PV2
  pv_two<0>(o[0], o[1], vb, pa0, pa1, pa2, pa3); pv_two<2>(o[2], o[3], vb, pa0, pa1, pa2, pa3);
#else
  pv_one<0>(o[0], vb, pa0, pa1, pa2, pa3); pv_one<1>(o[1], vb, pa0, pa1, pa2, pa3); pv_one<2>(o[2], vb, pa0, pa1, pa2, pa3); pv_one<3>(o[3], vb, pa0, pa1, pa2, pa3);
#endif
}
struct UnitD { int type, b, hh, q0  , nloc  , kbase  ; };
__device__ __forceinline__ int tile_row(const UnitD& u, int j) {
    if (j >= u.nloc) return T_LAT + u.b * CTXL + (j - u.nloc) * 64;
    if (u.type == 0) return u.b * SEQL + (u.kbase + j) * 64;
    const int kp = u.kbase + j * 64; return u.b * SEQL + min(max(kp, 0), SEQL - 64);
}
__device__ __forceinline__ bool tile_active(const UnitD& u, int j, int wid) {
    if (j >= u.nloc) return true;
    if (u.type == 0) { const int qr = (u.q0 >> 6) + (wid >> 1), kr = u.kbase + j, start = min(max(qr - 4, 0), 120); return kr >= start && kr < start + 8; }
    const int qw = u.q0 + 32 * wid, kp0 = u.kbase + j * 64;
    return (kp0 >= 0) && (kp0 < SEQL) && (kp0 - (qw + 31) <= 128) && (qw - (kp0 + 63) <= 128);
}
__device__ __forceinline__ void apply_mask(f32x16& p0, f32x16& p1, const UnitD& u, int j, int wid, int r32, int hi, const LAS float* rpbL) {
    if (j >= u.nloc) return;
    if (u.type == 0) {
        const int qr = (u.q0 >> 6) + (wid >> 1), qc = (wid & 1) * 32 + r32, kr = u.kbase + j;
        const int c0 = min(max(qc - 8, 0), 48), cb = 4 * hi - c0;
        const LAS float* rp = rpbL + (kr - qr + 7) * 31 + 4 * hi - qc + 15 + 32;
#pragma unroll
        for (int g4 = 0; g4 < 4; ++g4) {
            float b0[4], b1[4];
#pragma unroll
            for (int i = 0; i < 4; ++i) { b0[i] = rp[8 * g4 + i]; b1[i] = rp[8 * g4 + i + 32]; }
            asm volatile("" : "+v"(b0[0]), "+v"(b0[1]), "+v"(b0[2]), "+v"(b0[3]), "+v"(b1[0]), "+v"(b1[1]), "+v"(b1[2]), "+v"(b1[3]));
#pragma unroll
            for (int i = 0; i < 4; ++i) { const int r = 4 * g4 + i, k0 = 8 * g4 + i;
                p0[r] = ((unsigned)(k0 + cb) < 16u) ? p0[r] + b0[i] : -INFINITY;
                p1[r] = ((unsigned)(k0 + 32 + cb) < 16u) ? p1[r] + b1[i] : -INFINITY; }
            SBAR(); }
    } else {
        const int qw = u.q0 + 32 * wid, kp0 = u.kbase + j * 64;
        if ((kp0 + 63 - qw <= 128) && (qw + 31 - kp0 <= 128)) return;
        const int cb = kp0 + 4 * hi - (qw + r32) + 128;
#pragma unroll
        for (int r = 0; r < 16; ++r) {
            const int k0 = (r & 3) + 8 * (r >> 2);
            p0[r] = ((unsigned)(k0 + cb) <= 256u) ? p0[r] : -INFINITY;
            p1[r] = ((unsigned)(k0 + 32 + cb) <= 256u) ? p1[r] : -INFINITY; }
    }
}
__device__ __forceinline__ void fill_ninf(f32x16& p0, f32x16& p1) {
#pragma unroll
    for (int r = 0; r < 16; ++r) { p0[r] = -INFINITY; p1[r] = -INFINITY; }
}
__device__ __forceinline__ void attn_unit(const Prm& p, int l, const UnitD u, LAS unsigned char* lds, int tid) {
  const bf16* U = (const bf16*)(p.ws + WS_U); bf16* MIX = (bf16*)(p.ws + WS_H);
  const int wid = __builtin_amdgcn_readfirstlane(tid >> 6), lane = tid & 63, r32 = lane & 31, hi = lane >> 5;
  int qcol, kcol, vcol, ocol;
  if (u.type == 0 || u.type == 2) { qcol = C_QA + u.hh * 128; kcol = C_KA + u.hh * 128; vcol = C_VA + u.hh * 128; ocol = u.hh * 128; }
  else { const int kvh = u.hh >> 1; qcol = C_QB + u.hh * 128; kcol = C_KB + kvh * 128; vcol = C_VB + kvh * 128; ocol = 512 + u.hh * 128; }
  const int qrow0 = (u.type < 2 ? u.b * SEQL : T_LAT + u.b * CTXL) + u.q0;
  LAS unsigned char* V_lds = lds + OFF_V; LAS unsigned char* K_lds = lds + OFF_K;
  LAS float* wsl = (LAS float*)(lds + OFF_WS) + wid * 64; LAS float* li_l = wsl; LAS float* al_l = wsl + 32;
  LAS float* rpbL = (LAS float*)(lds + OFF_RPB);
  if (u.type == 0 && tid < 465) rpbL[32 + tid] = p.na_rpb[(size_t)(l * 4 + u.hh) * 465 + tid] * (1.f / ATT_SCALE);
  float m_reg = -1e30f, l_reg = 0; f32x16 o[4] = {}; bf16x8 qr[8];
  const bf16* Qw = U + (size_t)(qrow0 + wid * 32 + r32) * NINP + qcol + hi * 8;
#pragma unroll
  for (int d0 = 0; d0 < 8; ++d0) qr[d0] = *reinterpret_cast<const bf16x8*>(Qw + d0 * 16);
  const int sr = tid >> 4, sc = (tid & 15) * 8, vst0 = v_st(sr, sc), vst1 = v_st(32 + sr, sc);
  const int vb0 = (int)(uintptr_t)V_lds + v_rd_base(lane);
  struct { bf16x8 vs0, vs1, ks0, ks1; } sr_[SDEPTH];
#define SLOAD(i, jt) do { const bf16* rb_ = U + (size_t)(tile_row(u, (jt)) + sr) * NINP + sc; \
    sr_[i].vs0 = *reinterpret_cast<const bf16x8*>(rb_ + vcol); sr_[i].vs1 = *reinterpret_cast<const bf16x8*>(rb_ + (size_t)32 * NINP + vcol); \
    sr_[i].ks0 = *reinterpret_cast<const bf16x8*>(rb_ + kcol); sr_[i].ks1 = *reinterpret_cast<const bf16x8*>(rb_ + (size_t)32 * NINP + kcol); } while (0)
#define SWRITE(b, i) do { *(LAS bf16x8*)(V_lds + (b) * SHM_V + vst0) = sr_[i].vs0;          \
    *(LAS bf16x8*)(V_lds + (b) * SHM_V + vst1) = sr_[i].vs1; int kc = sc * 2;               \
    *(LAS bf16x8*)(K_lds + (b) * SHM_K + KSWZ(sr, kc)) = sr_[i].ks0;                       \
    *(LAS bf16x8*)(K_lds + (b) * SHM_K + KSWZ(32 + sr, kc)) = sr_[i].ks1; } while (0)
#define SWAIT() do { if constexpr (SDEPTH == 2) asm volatile("s_waitcnt vmcnt(4)" ::: "memory"); else asm volatile("s_waitcnt vmcnt(0)" ::: "memory"); } while (0)
#define RESC(a) do { if (__any((a) < 1.f)) { if (hi == 0) al_l[r32] = (a); asm volatile("s_waitcnt lgkmcnt(0)" ::: "memory"); \
    _Pragma("unroll") for (int d = 0; d < 4; ++d) _Pragma("unroll") for (int r = 0; r < 16; ++r) o[d][r] *= al_l[crow(r, hi)]; } } while (0)
  f32x16 pA0, pA1, pB0, pB1; float mnA, mnB, alA, alB; bf16x8 pa0, pa1, pa2, pa3; const int NT = u.nloc + 4;
  constexpr int SE = 0, SO = SDEPTH - 1;
  SLOAD(SE, 0); asm volatile("s_waitcnt vmcnt(0)" ::: "memory"); SWRITE(0, SE); __syncthreads();
#define SCORE(P0, P1, KB, jt, ACT) do { ACT = tile_active(u, (jt), wid); if (ACT) { qkt(P0, P1, KB, qr, r32, hi); apply_mask(P0, P1, u, (jt), wid, r32, hi, rpbL); } else fill_ninf(P0, P1); } while (0)
  bool actA, actB;
  SCORE(pA0, pA1, K_lds, 0, actA); partialSM(pA0, pA1, m_reg, mnA, alA);
  SLOAD(SO, 1); if constexpr (SDEPTH == 2) { if (2 < NT) SLOAD(SE, 2); }
  SWAIT(); SWRITE(1, SO); __syncthreads();
  for (int j = 1; j + 1 < NT; j += 2) {
    SBAR(); SCORE(pB0, pB1, K_lds + SHM_K, j, actB);
    finishSM(pA0, pA1, alA, l_reg, pa0, pa1, pa2, pa3); SBAR();
    SLOAD(SO, j + SDEPTH); SBAR();
    if (actA) pv_d0(o, vb0, pa0, pa1, pa2, pa3); partialSM(pB0, pB1, m_reg, mnB, alB);
    __syncthreads(); SWAIT(); SWRITE(0, SE);
    RESC(alB); __syncthreads();
    SBAR(); SCORE(pA0, pA1, K_lds, j + 1, actA);
    finishSM(pB0, pB1, alB, l_reg, pa0, pa1, pa2, pa3); SBAR();
    if (SDEPTH == 1 || j + 3 < NT) SLOAD(SE, j + 1 + SDEPTH); SBAR();
    if (actB) pv_d0(o, vb0 + SHM_V, pa0, pa1, pa2, pa3); partialSM(pA0, pA1, m_reg, mnA, alA);
    __syncthreads(); SWAIT(); SWRITE(1, SO);
    RESC(alA); __syncthreads();
  }
  SBAR(); SCORE(pB0, pB1, K_lds + SHM_K, NT - 1, actB);
  finishSM(pA0, pA1, alA, l_reg, pa0, pa1, pa2, pa3); SBAR();
  if (actA) pv_d0(o, vb0, pa0, pa1, pa2, pa3); partialSM(pB0, pB1, m_reg, mnB, alB);
  __syncthreads(); RESC(alB);
  finishSM(pB0, pB1, alB, l_reg, pa0, pa1, pa2, pa3); SBAR();
  if (actB) pv_d0(o, vb0 + SHM_V, pa0, pa1, pa2, pa3);
  if (u.type & 1) { constexpr float C = ATT_SCALE * 1.4426950408889634f; l_reg += __builtin_amdgcn_exp2f((p.wa_sink[l * 4 + u.hh] * (1.f / ATT_SCALE) - m_reg) * C); }
  if (hi == 0) li_l[r32] = l_reg; asm volatile("s_waitcnt lgkmcnt(0)" ::: "memory");
  float rli[16];
#pragma unroll
  for (int r = 0; r < 16; ++r) rli[r] = __builtin_amdgcn_rcpf(li_l[crow(r, hi)]);
  bf16* Ow = MIX + (size_t)(qrow0 + wid * 32) * DM + ocol;
#pragma unroll
  for (int r = 0; r < 16; r += 2) {
#pragma unroll
    for (int d0 = 0; d0 < 4; ++d0) {
      const float a = o[d0][r] * rli[r], b = o[d0][r + 1] * rli[r + 1];
      const float send = (lane & 1) ? a : b, got = __shfl_xor(send, 1);
      const int orow = crow(r, hi) + (lane & 1), ocl = d0 * 32 + (r32 & ~1);
      if (F8_OUTPROJ) { const float lo = ((lane & 1) ? got : a) * MIX_SCALE, hi2 = ((lane & 1) ? b : got) * MIX_SCALE;
        *(unsigned short*)((unsigned char*)MIX + (size_t)(qrow0 + wid * 32 + orow) * DM + ocol + ocl) = (unsigned short)pack4f8(lo, hi2, 0.f, 0.f); }
      else { const unsigned w = (lane & 1) ? pk2(got, b) : pk2(a, got); *(unsigned*)(Ow + (size_t)orow * DM + ocl) = w; } } }
  __syncthreads();
#undef SCORE
#undef SLOAD
#undef SWRITE
#undef SWAIT
#undef RESC
}
constexpr int NSLOT = 3;
constexpr int OFFD_K = 0, OFFD_V = NSLOT * SHM_K, OFFD_WS = NSLOT * (SHM_K + SHM_V), OFFD_RPB = OFFD_WS + 8 * 64 * 4, ATT_LDS_D = OFFD_RPB + 576 * 4;
static_assert(ATT_LDS_D <= RING_BYTES, "attention LDS");
__device__ __forceinline__ void attn_unit_dma(const Prm& p, int l, const UnitD u, LAS unsigned char* lds, int tid) {
  const bf16* U = (const bf16*)(p.ws + WS_U); bf16* MIX = (bf16*)(p.ws + WS_H);
  const int wid = __builtin_amdgcn_readfirstlane(tid >> 6), lane = tid & 63, r32 = lane & 31, hi = lane >> 5;
  int qcol, kcol, vcol, ocol;
  if (u.type == 0 || u.type == 2) { qcol = C_QA + u.hh * 128; kcol = C_KA + u.hh * 128; vcol = C_VA + u.hh * 128; ocol = u.hh * 128; }
  else { const int kvh = u.hh >> 1; qcol = C_QB + u.hh * 128; kcol = C_KB + kvh * 128; vcol = C_VB + kvh * 128; ocol = 512 + u.hh * 128; }
  const int qrow0 = (u.type < 2 ? u.b * SEQL : T_LAT + u.b * CTXL) + u.q0;
  LAS unsigned char* K_lds = lds + OFFD_K; LAS unsigned char* V_lds = lds + OFFD_V;
  LAS float* wsl = (LAS float*)(lds + OFFD_WS) + wid * 64; LAS float* li_l = wsl; LAS float* al_l = wsl + 32;
  LAS float* rpbL = (LAS float*)(lds + OFFD_RPB);
  if (u.type == 0 && tid < 465) rpbL[32 + tid] = p.na_rpb[(size_t)(l * 4 + u.hh) * 465 + tid] * (1.f / ATT_SCALE);
  float m_reg = -1e30f, l_reg = 0; f32x16 o[4] = {}; bf16x8 qr[8];
  const bf16* Qw = U + (size_t)(qrow0 + wid * 32 + r32) * NINP + qcol + hi * 8;
#pragma unroll
  for (int d0 = 0; d0 < 8; ++d0) qr[d0] = *reinterpret_cast<const bf16x8*>(Qw + d0 * 16);
  unsigned koff[2], voff[2];
#pragma unroll
  for (int i = 0; i < 2; ++i) { const int pch = (wid * 2 + i) * 64 + lane;
    { const int row = pch >> 4, c = (pch & 15) ^ (row & 15); koff[i] = (unsigned)(row * NINP + kcol + c * 8); }
    { const int sidx = pch >> 5, q = pch & 31, kk = (sidx >> 2) * 8 + (q >> 2), k = (kk & ~0xC) | ((kk & 4) << 1) | ((kk & 8) >> 1);
      voff[i] = (unsigned)(k * NINP + vcol + (sidx & 3) * 32 + (q & 3) * 8); } }
  const int vb0 = (int)(uintptr_t)V_lds + v_rd_base(lane);
#define DMA_K(jt) do { const bf16* tb_ = U + (size_t)tile_row(u, (jt)) * NINP; LAS unsigned char* dst_ = K_lds + ((jt) % NSLOT) * SHM_K + wid * 2048; \
    _Pragma("unroll") for (int i_ = 0; i_ < 2; ++i_) __builtin_amdgcn_global_load_lds((const unsigned*)(tb_ + koff[i_]), (LAS unsigned*)(dst_ + i_ * 1024), 16, 0, 0); } while (0)
#define DMA_V(jt) do { const bf16* tb_ = U + (size_t)tile_row(u, (jt)) * NINP; LAS unsigned char* dst_ = V_lds + ((jt) % NSLOT) * SHM_V + wid * 2048; \
    _Pragma("unroll") for (int i_ = 0; i_ < 2; ++i_) __builtin_amdgcn_global_load_lds((const unsigned*)(tb_ + voff[i_]), (LAS unsigned*)(dst_ + i_ * 1024), 16, 0, 0); } while (0)
#define STEP_SYNC4() asm volatile("s_waitcnt vmcnt(4) lgkmcnt(0)\n\ts_barrier" ::: "memory")
#define STEP_SYNC0() asm volatile("s_waitcnt vmcnt(0) lgkmcnt(0)\n\ts_barrier" ::: "memory")
#define RESC(a) do { if (__any((a) < 1.f)) { if (hi == 0) al_l[r32] = (a); asm volatile("s_waitcnt lgkmcnt(0)" ::: "memory"); \
    _Pragma("unroll") for (int d = 0; d < 4; ++d) _Pragma("unroll") for (int r = 0; r < 16; ++r) o[d][r] *= al_l[crow(r, hi)]; } } while (0)
#define SCORE(P0, P1, jt, ACT) do { ACT = tile_active(u, (jt), wid); if (ACT) { qkt(P0, P1, K_lds + ((jt) % NSLOT) * SHM_K, qr, r32, hi); apply_mask(P0, P1, u, (jt), wid, r32, hi, rpbL); } else fill_ninf(P0, P1); } while (0)
  f32x16 pA0, pA1, pB0, pB1; float mnA, mnB, alA, alB; bf16x8 pa0, pa1, pa2, pa3; const int NT = u.nloc + 4; bool actA, actB;
  DMA_K(0); DMA_K(1); DMA_V(0);
  PAT_SYNC(STEP_SYNC4());
  DMA_K(2); DMA_V(1);
  SCORE(pA0, pA1, 0, actA); partialSM(pA0, pA1, m_reg, mnA, alA);
#pragma unroll 1
  for (int s = 1; s + 1 < NT; s += 2) {
    PAT_SYNC(STEP_SYNC4());
    DMA_K(s + 2); DMA_V(s + 1);
    SBAR(); SCORE(pB0, pB1, s, actB);
    finishSM(pA0, pA1, alA, l_reg, pa0, pa1, pa2, pa3); SBAR();
    if (actA) pv_d0(o, vb0 + ((s - 1) % NSLOT) * SHM_V, pa0, pa1, pa2, pa3); partialSM(pB0, pB1, m_reg, mnB, alB);
    RESC(alB);
    PAT_SYNC(STEP_SYNC4());
    if (s + 3 < NT) DMA_K(s + 3); DMA_V(s + 2);
    SBAR(); SCORE(pA0, pA1, s + 1, actA);
    finishSM(pB0, pB1, alB, l_reg, pa0, pa1, pa2, pa3); SBAR();
    if (actB) pv_d0(o, vb0 + (s % NSLOT) * SHM_V, pa0, pa1, pa2, pa3); partialSM(pA0, pA1, m_reg, mnA, alA);
    RESC(alA);
  }
  PAT_SYNC(STEP_SYNC0());
  SBAR(); SCORE(pB0, pB1, NT - 1, actB);
  finishSM(pA0, pA1, alA, l_reg, pa0, pa1, pa2, pa3); SBAR();
  if (actA) pv_d0(o, vb0 + ((NT - 2) % NSLOT) * SHM_V, pa0, pa1, pa2, pa3); partialSM(pB0, pB1, m_reg, mnB, alB);
  RESC(alB);
  finishSM(pB0, pB1, alB, l_reg, pa0, pa1, pa2, pa3); SBAR();
  if (actB) pv_d0(o, vb0 + ((NT - 1) % NSLOT) * SHM_V, pa0, pa1, pa2, pa3);
  if (u.type & 1) { constexpr float C = ATT_SCALE * 1.4426950408889634f; l_reg += __builtin_amdgcn_exp2f((p.wa_sink[l * 4 + u.hh] * (1.f / ATT_SCALE) - m_reg) * C); }
  if (hi == 0) li_l[r32] = l_reg; asm volatile("s_waitcnt lgkmcnt(0)" ::: "memory");
  float rli[16];
#pragma unroll
  for (int r = 0; r < 16; ++r) rli[r] = __builtin_amdgcn_rcpf(li_l[crow(r, hi)]);
  bf16* Ow = MIX + (size_t)(qrow0 + wid * 32) * DM + ocol;
#pragma unroll
  for (int r = 0; r < 16; r += 2) {
#pragma unroll
    for (int d0 = 0; d0 < 4; ++d0) {
      const float a = o[d0][r] * rli[r], b = o[d0][r + 1] * rli[r + 1];
      const float send = (lane & 1) ? a : b, got = __shfl_xor(send, 1);
      const int orow = crow(r, hi) + (lane & 1), ocl = d0 * 32 + (r32 & ~1);
      if (F8_OUTPROJ) { const float lo = ((lane & 1) ? got : a) * MIX_SCALE, hi2 = ((lane & 1) ? b : got) * MIX_SCALE;
        *(unsigned short*)((unsigned char*)MIX + (size_t)(qrow0 + wid * 32 + orow) * DM + ocol + ocl) = (unsigned short)pack4f8(lo, hi2, 0.f, 0.f); }
      else { const unsigned w = (lane & 1) ? pk2(got, b) : pk2(a, got); *(unsigned*)(Ow + (size_t)orow * DM + ocl) = w; } } }
  asm volatile("s_waitcnt lgkmcnt(0)\n\ts_barrier" ::: "memory");
#undef DMA_K
#undef DMA_V
#undef STEP_SYNC4
#undef STEP_SYNC0
#undef RESC
#undef SCORE
}
#ifndef ATT_DMA
#define ATT_DMA 1
#endif
__device__ __forceinline__ void phase_attn(const Prm& p, int l, LAS unsigned char* lds, int wg, int nwg, int tid) {
    const int nu = 512 + (l == 0 ? 16 : 0);
    for (int it = wg; it < nu; it += nwg) {
        UnitD u;
        if (it < 256) { u.type = 0; u.b = it >> 7; u.hh = (it >> 5) & 3; const int blk = it & 31; u.q0 = blk * 256; u.nloc = 12; u.kbase = min(max(blk * 4 - 4, 0), 116); }
        else if (it < 512) { const int r = it - 256; u.type = 1; u.b = r >> 7; u.hh = (r >> 5) & 3; const int blk = r & 31; u.q0 = blk * 256; u.nloc = 8; u.kbase = blk * 256 - 128; }
        else { const int r = it - 512; u.type = 2 + (r >> 3); u.b = (r >> 2) & 1; u.hh = r & 3; u.q0 = 0; u.nloc = 0; u.kbase = 0; }
        if (ATT_DMA) attn_unit_dma(p, l, u, lds, tid); else attn_unit(p, l, u, lds, tid);
    }
}
}
__device__ __forceinline__ void lds_barrier() { asm volatile("s_waitcnt lgkmcnt(0)\n\ts_barrier" ::: "memory"); }
namespace ssd {
typedef short s16x4 __attribute__((ext_vector_type(4)));
typedef float f32x16 __attribute__((ext_vector_type(16)));
constexpr int NCH = 66;
constexpr size_t WS_ST = WS_YD, WS_HS = WS_YD + 66 * MiB, WS_DEC = 1259 * MiB;
__device__ __forceinline__ int crow(int r, int hi) { return (r & 3) + 8 * (r >> 2) + 4 * hi; }
__device__ __forceinline__ int chunk_row0(int b, int c) { return c < 2 ? T_LAT + b * CTXL + c * 128 : b * SEQL + (c - 2) * 128; }
__device__ __forceinline__ s16x4 ds_tr(unsigned addr) { s16x4 r; asm volatile("ds_read_b64_tr_b16 %0, %1" : "=&v"(r) : "v"(addr) : "memory"); return r; }
struct Raw { s16x4 lo, hi; };
__device__ __forceinline__ Raw raw_tr_nat(unsigned base, int stride, int k0, int idx0, int lane) {
    const int i16 = lane & 15, g16 = (lane >> 4) & 1, hl = lane >> 5;
    const unsigned a = base + (unsigned)((k0 + 8 * hl + (i16 >> 2)) * stride + (idx0 + 16 * g16 + 4 * (i16 & 3)) * 2);
    Raw r; r.lo = ds_tr(a); r.hi = ds_tr(a + 4 * stride); return r;
}
__device__ __forceinline__ Raw raw_tr_acc(unsigned base, int stride, int k0, int idx0, int lane) {
    const int i16 = lane & 15, g16 = (lane >> 4) & 1, hl = lane >> 5;
    const unsigned a = base + (unsigned)((k0 + 4 * hl + (i16 >> 2)) * stride + (idx0 + 16 * g16 + 4 * (i16 & 3)) * 2);
    Raw r; r.lo = ds_tr(a); r.hi = ds_tr(a + 8 * stride); return r;
}
__device__ __forceinline__ void raw_wait2(Raw& a, Raw& b) { asm volatile("s_waitcnt lgkmcnt(0)" : "+v"(a.lo), "+v"(a.hi), "+v"(b.lo), "+v"(b.hi) :: "memory"); }
__device__ __forceinline__ void raw_wait6(Raw& a, Raw& b, Raw& c, Raw& d, Raw& e, Raw& f) {
    asm volatile("s_waitcnt lgkmcnt(0)" : "+v"(a.lo), "+v"(a.hi), "+v"(b.lo), "+v"(b.hi), "+v"(c.lo), "+v"(c.hi), "+v"(d.lo), "+v"(d.hi), "+v"(e.lo), "+v"(e.hi), "+v"(f.lo), "+v"(f.hi) :: "memory"); }
__device__ __forceinline__ bf16x8 join8(const Raw& r) { return (bf16x8){r.lo[0], r.lo[1], r.lo[2], r.lo[3], r.hi[0], r.hi[1], r.hi[2], r.hi[3]}; }
__device__ __forceinline__ unsigned cvtpk(float lo, float hi) { unsigned r; asm volatile("v_cvt_pk_bf16_f32 %0, %1, %2\n\ts_nop 1" : "=v"(r) : "v"(lo), "v"(hi)); return r; }
__device__ __forceinline__ void scan128(float& v0, float& v1, int lane) {
#pragma unroll
    for (int o = 1; o < 64; o <<= 1) { const int src = (lane >= o ? lane - o : lane) << 2;
        const float t0 = __builtin_bit_cast(float, __builtin_amdgcn_ds_bpermute(src, __builtin_bit_cast(int, v0))), t1 = __builtin_bit_cast(float, __builtin_amdgcn_ds_bpermute(src, __builtin_bit_cast(int, v1)));
        if (lane >= o) { v0 += t0; v1 += t1; } }
    v1 += __builtin_bit_cast(float, __builtin_amdgcn_ds_bpermute(63 << 2, __builtin_bit_cast(int, v0)));
}
__device__ __forceinline__ float lane63(float v) { return __builtin_bit_cast(float, __builtin_amdgcn_ds_bpermute(63 << 2, __builtin_bit_cast(int, v))); }

constexpr int BST = 320, XST = 576;
constexpr int S2_B = 0, S2_X = 128 * BST, S2_W = S2_X + 128 * XST, S2_END = S2_W + 8 * 128 * 4;
__device__ __forceinline__ void phase_states(const Prm& p, int l, LAS unsigned char* lds, int wg, int nwg, int tid) {
    const bf16* XA = (const bf16*)(p.ws + WS_XBC); const float* DT = (const float*)(p.ws + WS_DT);
    bf16* ST = (bf16*)(p.ws + WS_ST); float* DEC = (float*)(p.ws + WS_DEC);
    const int wid = __builtin_amdgcn_readfirstlane(tid >> 6), lane = tid & 63, hl = lane >> 5;
    for (int it = wg; it < 2 * NCH * 4; it += nwg) {
        const int b = it / (NCH * 4), rem = it % (NCH * 4), c = rem >> 2, g = (rem >> 1) & 1, hq = rem & 1;
        const int row0 = chunk_row0(b, c), h = 8 * g + 4 * hq + (wid & 3), dir = wid >> 2;
        { v4u tb[4], tx[8];
#pragma unroll
          for (int i = 0; i < 4; ++i) { const int id = tid + 512 * i, r = id >> 4, ch = id & 15; tb[i] = *(const v4u*)(XA + (size_t)(row0 + r) * XBCW + 1024 + g * 128 + ch * 8); }
#pragma unroll
          for (int i = 0; i < 8; ++i) { const int id = tid + 512 * i, r = id >> 5, ch = id & 31; tx[i] = *(const v4u*)(XA + (size_t)(row0 + r) * XBCW + (8 * g + 4 * hq) * 64 + ch * 8); }
#pragma unroll
          for (int i = 0; i < 4; ++i) { const int id = tid + 512 * i, r = id >> 4, ch = id & 15; *(LAS v4u*)(lds + S2_B + r * BST + ch * 16) = tb[i]; }
#pragma unroll
          for (int i = 0; i < 8; ++i) { const int id = tid + 512 * i, r = id >> 5, ch = id & 31; *(LAS v4u*)(lds + S2_X + r * XST + ch * 16) = tx[i]; } }
        const float a = -__expf(p.a_log[l * 32 + dir * 16 + h]);
        const float d0 = DT[(size_t)(row0 + lane) * 32 + dir * 16 + h], d1 = DT[(size_t)(row0 + 64 + lane) * 32 + dir * 16 + h];
        float P0 = a * d0, P1 = a * d1; scan128(P0, P1, lane);
        const float tot = lane63(P1);
        LAS float* wL = (LAS float*)(lds + S2_W) + wid * 128;
        wL[lane] = (dir == 0 ? __expf(tot - P0) : __expf(P0 - a * d0)) * d0;
        wL[64 + lane] = (dir == 0 ? __expf(tot - P1) : __expf(P1 - a * d1)) * d1;
        if (lane == 0) DEC[((b * NCH + c) * 2 + dir) * 16 + h] = __expf(tot);
        __syncthreads();
        f32x16 acc[2][4];
#pragma unroll
        for (int i = 0; i < 2; ++i)
#pragma unroll
            for (int j = 0; j < 4; ++j) acc[i][j] = f32x16{};
        const unsigned bB = (unsigned)(uintptr_t)(lds + S2_B), bX = (unsigned)(uintptr_t)(lds + S2_X);
#pragma unroll 1
        for (int ks = 0; ks < 8; ++ks) {
            const f32x4 w0 = *(const LAS f32x4*)(wL + 16 * ks + 8 * hl), w1 = *(const LAS f32x4*)(wL + 16 * ks + 8 * hl + 4);
            bf16x8 xa[2], bb[4];
            { Raw rx0 = raw_tr_nat(bX, XST, 16 * ks, (wid & 3) * 64, lane), rx1 = raw_tr_nat(bX, XST, 16 * ks, (wid & 3) * 64 + 32, lane);
              Raw rb0 = raw_tr_nat(bB, BST, 16 * ks, 0, lane), rb1 = raw_tr_nat(bB, BST, 16 * ks, 32, lane), rb2 = raw_tr_nat(bB, BST, 16 * ks, 64, lane), rb3 = raw_tr_nat(bB, BST, 16 * ks, 96, lane);
              raw_wait6(rx0, rx1, rb0, rb1, rb2, rb3);
              xa[0] = join8(rx0); xa[1] = join8(rx1); bb[0] = join8(rb0); bb[1] = join8(rb1); bb[2] = join8(rb2); bb[3] = join8(rb3); }
#pragma unroll
            for (int pt = 0; pt < 2; ++pt) {
                v4u q = *reinterpret_cast<v4u*>(&xa[pt]);
                q.x = cvtpk(bflo(q.x) * w0[0], bfhi(q.x) * w0[1]); q.y = cvtpk(bflo(q.y) * w0[2], bfhi(q.y) * w0[3]);
                q.z = cvtpk(bflo(q.z) * w1[0], bfhi(q.z) * w1[1]); q.w = cvtpk(bflo(q.w) * w1[2], bfhi(q.w) * w1[3]);
                xa[pt] = *reinterpret_cast<bf16x8*>(&q); }
#pragma unroll
            for (int pt = 0; pt < 2; ++pt)
#pragma unroll
                for (int nt = 0; nt < 4; ++nt) acc[pt][nt] = __builtin_amdgcn_mfma_f32_32x32x16_bf16(xa[pt], bb[nt], acc[pt][nt], 0, 0, 0);
        }
        lds_barrier();
        { LAS unsigned char* tile = lds + wid * 16384;
          const int swz = (lane & 1) | (hl << 1);
          LAS unsigned char* wbase = tile + ((lane & 1) + 4 * hl) * 256 + (((lane & 31) >> 1) << 2);
#pragma unroll
          for (int nt = 0; nt < 4; ++nt) { LAS unsigned char* wb = wbase + ((nt ^ swz) << 6);
#pragma unroll
            for (int pt = 0; pt < 2; ++pt)
#pragma unroll
                for (int r = 0; r < 16; r += 2) {
                    const float x0 = acc[pt][nt][r], x1 = acc[pt][nt][r + 1];
                    const float send = (lane & 1) ? x0 : x1, got = __builtin_bit_cast(float, __builtin_amdgcn_update_dpp(0, __builtin_bit_cast(int, send), 0xB1, 0xF, 0xF, false));
                    const unsigned w = (lane & 1) ? pk2(got, x1) : pk2(x0, got);
                    *(LAS unsigned*)(wb + (pt * 32 + crow(r, 0)) * 256) = w; } }
          LDS_WAIT(); asm volatile("" ::: "memory");
          bf16* so = ST + ((size_t)((b * NCH + c) * 2 + dir) * 16 + h) * 8192 + (size_t)(lane >> 4) * 128 + (lane & 15) * 8;
          const LAS unsigned char* rb0 = tile + (lane >> 4) * 256 + (((lane & 15) ^ (((lane >> 4) & 1) << 2)) << 4);
          const LAS unsigned char* rb1 = tile + (lane >> 4) * 256 + (((lane & 15) ^ (((lane >> 4) & 1) << 2) ^ 8) << 4);
#pragma unroll
          for (int ps = 0; ps < 16; ++ps) { const v4u w = *(const LAS v4u*)(((ps & 1) ? rb1 : rb0) + ps * 1024);
              *(v4u*)(so + ps * 512) = w; } }
        lds_barrier();
    }
}

__device__ __forceinline__ void phase_scan(const Prm& p, int gtid, int ngt) {
    const bf16* ST = (const bf16*)(p.ws + WS_ST); bf16* HS = (bf16*)(p.ws + WS_HS); const float* DEC = (const float*)(p.ws + WS_DEC);
    constexpr int NB = 11; static_assert(NCH % NB == 0, "scan batches");
    for (int e = gtid; e < 2 * 2 * 16 * 2048; e += ngt) {
        const int q = e & 2047, hu = __builtin_amdgcn_readfirstlane(e >> 11), h = hu & 15, dir = (hu >> 4) & 1, b = hu >> 5;
        f32x4 hs = {0.f, 0.f, 0.f, 0.f};
#pragma unroll 1
        for (int i0 = 0; i0 < NCH; i0 += NB) {
            v2u sv[NB]; float dc[NB];
#pragma unroll
            for (int k = 0; k < NB; ++k) { const int i = i0 + k, c = dir == 0 ? i : (i < 2 ? 1 - i : NCH + 1 - i);
                sv[k] = __builtin_nontemporal_load((const v2u*)(ST + ((size_t)((b * NCH + c) * 2 + dir) * 16 + h) * 8192 + q * 4)); dc[k] = DEC[((b * NCH + c) * 2 + dir) * 16 + h]; }
#pragma unroll
            for (int k = 0; k < NB; ++k) { const int i = i0 + k, c = dir == 0 ? i : (i < 2 ? 1 - i : NCH + 1 - i);
                v2u o; o.x = pk2(hs[0], hs[1]); o.y = pk2(hs[2], hs[3]); *(v2u*)(HS + ((size_t)((b * NCH + c) * 2 + dir) * 16 + h) * 8192 + q * 4) = o;
                hs[0] = dc[k] * hs[0] + bflo(sv[k].x); hs[1] = dc[k] * hs[1] + bfhi(sv[k].x); hs[2] = dc[k] * hs[2] + bflo(sv[k].y); hs[3] = dc[k] * hs[3] + bfhi(sv[k].y); }
        }
    }
}

constexpr int CST = 272, XSS = 80;
constexpr size_t WS_Y = WS_XG;
constexpr int S4_B = 0, S4_C = 128 * CST, S4_X = 2 * 128 * CST, S4_ARR = 3 * 128 * CST, S4_YX = S4_ARR + 8 * 2 * 128 * 4, S4_END = S4_YX + 4 * 16 * 64 * 4;
static_assert(S4_END <= RING_BYTES && S2_END <= RING_BYTES && 8 * 32 * XSS <= 128 * CST, "ssd LDS");
__device__ __forceinline__ void phase_ssd_out(const Prm& p, int l, LAS unsigned char* lds, int wg, int nwg, int tid) {
    const bf16* XA = (const bf16*)(p.ws + WS_XBC); const float* DT = (const float*)(p.ws + WS_DT); const bf16* HS = (const bf16*)(p.ws + WS_HS);
    bf16* Y = (bf16*)(p.ws + WS_Y);
    const int wid = __builtin_amdgcn_readfirstlane(tid >> 6), lane = tid & 63, hl = lane >> 5, l31 = lane & 31, pt = (wid >> 1) & 1, dir = wid >> 2;
    const int c_lo = (l == 0) ? 0 : 2, ncu = NCH - c_lo;
    for (int it = wg; it < 2 * ncu * 8; it += nwg) {
        const int b = it / (ncu * 8), rem = it % (ncu * 8), c = c_lo + (rem >> 3), g = (rem >> 2) & 1, hp = rem & 3, h = 8 * g + 2 * hp + (wid & 1);
        const int row0 = chunk_row0(b, c);
        { v4u tb[4], tc[4];
#pragma unroll
          for (int i = 0; i < 4; ++i) { const int id = tid + 512 * i, r = id >> 4, ch = id & 15; const bf16* src = XA + (size_t)(row0 + r) * XBCW + g * 128 + ch * 8; tb[i] = *(const v4u*)(src + 1024); tc[i] = *(const v4u*)(src + 1280); }
#pragma unroll
          for (int i = 0; i < 4; ++i) { const int id = tid + 512 * i, r = id >> 4, ch = id & 15; *(LAS v4u*)(lds + S4_B + r * CST + ch * 16) = tb[i]; *(LAS v4u*)(lds + S4_C + r * CST + ch * 16) = tc[i]; } }
        v4u tx[4];
#pragma unroll
        for (int i = 0; i < 4; ++i) { const int id = tid + 512 * i, r = id >> 4, ch = id & 15; tx[i] = *(const v4u*)(XA + (size_t)(row0 + r) * XBCW + (8 * g + 2 * hp) * 64 + ch * 8); }
        bf16x8 hs[8];
        { const bf16* hp_ = HS + ((size_t)((b * NCH + c) * 2 + dir) * 16 + h) * 8192 + (size_t)(pt * 32 + l31) * 128 + 8 * hl;
#pragma unroll
          for (int ks = 0; ks < 8; ++ks) hs[ks] = __builtin_nontemporal_load((const bf16x8*)(hp_ + 16 * ks)); }
        LAS float* QL = (LAS float*)(lds + S4_ARR) + wid * 256; LAS float* DL = QL + 128;
        float ebase;
        { const float a = -__expf(p.a_log[l * 32 + dir * 16 + h]);
          const float d0 = DT[(size_t)(row0 + lane) * 32 + dir * 16 + h], d1 = DT[(size_t)(row0 + 64 + lane) * 32 + dir * 16 + h];
          float q0 = a * d0, q1 = a * d1; scan128(q0, q1, lane); const float tot = lane63(q1);
          QL[lane] = dir == 0 ? q0 : a * d0 - q0; QL[64 + lane] = dir == 0 ? q1 : a * d1 - q1; DL[lane] = d0; DL[64 + lane] = d1; ebase = dir == 0 ? 0.f : tot; }
        lds_barrier();
#pragma unroll
        for (int j = 0; j < 2; ++j) { const int id = wid * 2 + j, st = id >> 2, tt = id & 3; f32x16 X = f32x16{};
#pragma unroll
            for (int ks = 0; ks < 8; ++ks) { const bf16x8 bfr = *(const LAS bf16x8*)(lds + S4_B + (st * 32 + l31) * CST + (16 * ks + 8 * hl) * 2), cfr = *(const LAS bf16x8*)(lds + S4_C + (tt * 32 + l31) * CST + (16 * ks + 8 * hl) * 2);
                X = __builtin_amdgcn_mfma_f32_32x32x16_bf16(bfr, cfr, X, 0, 0, 0); }
#pragma unroll
            for (int i = 0; i < 4; ++i) { v2u w; w.x = pk2(X[4 * i], X[4 * i + 1]); w.y = pk2(X[4 * i + 2], X[4 * i + 3]);
                *(LAS v2u*)(lds + S4_X + (tt * 32 + l31) * CST + (st * 32 + 8 * i + 4 * hl) * 2) = w; } }
        lds_barrier();
        bf16x8 xf[8];
        {
#pragma unroll
          for (int i = 0; i < 4; ++i) { const int id = tid + 512 * i, r = id >> 4, ch = id & 15; *(LAS v4u*)(lds + S4_B + r * CST + ch * 16) = tx[i]; }
          lds_barrier();
          const unsigned bXs = (unsigned)(uintptr_t)(lds + S4_B); const int c0 = (wid & 1) * 64 + pt * 32;
#pragma unroll
          for (int q = 0; q < 4; ++q) { Raw r0 = raw_tr_acc(bXs, CST, 32 * q, c0, lane), r1 = raw_tr_acc(bXs, CST, 32 * q + 16, c0, lane); raw_wait2(r0, r1); xf[2 * q] = join8(r0); xf[2 * q + 1] = join8(r1); }
        }
        const float dsum = p.d_skip[l * 32 + h] + p.d_skip[l * 32 + 16 + h];
        LAS float* YX = (LAS float*)(lds + S4_YX) + (wid & 3) * 1024;
#pragma unroll 1
        for (int tt = 0; tt < 4; ++tt) {
            const int tl = tt * 32 + l31;
            const float Qt = QL[tl];
            f32x16 yacc = f32x16{};
#pragma unroll
            for (int st = 0; st < 4; ++st) {
                if (dir == 0 ? (st > tt) : (st < tt)) continue;
                __builtin_amdgcn_sched_barrier(0);
                float mv[16];
#define SSD_BLK(OK) _Pragma("unroll") for (int i = 0; i < 4; ++i) { const v2u w = *(const LAS v2u*)(lds + S4_X + tl * CST + (st * 32 + 8 * i + 4 * hl) * 2); \
                    const f32x4 qv = *(const LAS f32x4*)(QL + st * 32 + 8 * i + 4 * hl), dv = *(const LAS f32x4*)(DL + st * 32 + 8 * i + 4 * hl); \
                    const float xv[4] = {bflo(w.x), bfhi(w.x), bflo(w.y), bfhi(w.y)}; \
                    _Pragma("unroll") for (int j = 0; j < 4; ++j) { const int s = st * 32 + 8 * i + 4 * hl + j; (void)s; mv[4 * i + j] = (OK) ? __expf(Qt - qv[j]) * dv[j] * xv[j] : 0.f; } }
                if (st != tt) { SSD_BLK(true) } else { SSD_BLK(dir == 0 ? (s <= tl) : (s >= tl)) }
#undef SSD_BLK
#pragma unroll
                for (int s2 = 0; s2 < 2; ++s2) { v4u q; q.x = cvtpk(mv[8 * s2 + 0], mv[8 * s2 + 1]); q.y = cvtpk(mv[8 * s2 + 2], mv[8 * s2 + 3]); q.z = cvtpk(mv[8 * s2 + 4], mv[8 * s2 + 5]); q.w = cvtpk(mv[8 * s2 + 6], mv[8 * s2 + 7]);
                    yacc = __builtin_amdgcn_mfma_f32_32x32x16_bf16(xf[2 * st + s2], *reinterpret_cast<bf16x8*>(&q), yacc, 0, 0, 0); }
            }
            __builtin_amdgcn_sched_barrier(0);
            { const LAS unsigned char* cfp = lds + S4_C + tl * CST + 16 * hl; f32x16 G = f32x16{};
#pragma unroll
              for (int ks = 0; ks < 8; ++ks) G = __builtin_amdgcn_mfma_f32_32x32x16_bf16(hs[ks], *(const LAS bf16x8*)(cfp + 32 * ks), G, 0, 0, 0);
              const float e = __expf(ebase + Qt);
#pragma unroll
              for (int r = 0; r < 16; ++r) yacc[r] += e * G[r]; }
            if (dir == 1) {
#pragma unroll
                for (int r = 0; r < 16; ++r) YX[r * 64 + lane] = yacc[r]; }
            lds_barrier();
            if (dir == 0) {
                v2u ow[4];
#pragma unroll
                for (int i = 0; i < 4; ++i) { const v2u xw = *(const LAS v2u*)(lds + S4_B + tl * CST + ((wid & 1) * 64 + pt * 32 + 8 * i + 4 * hl) * 2);
                    f32x4 o; o[0] = yacc[4 * i] + YX[(4 * i) * 64 + lane] + dsum * bflo(xw.x); o[1] = yacc[4 * i + 1] + YX[(4 * i + 1) * 64 + lane] + dsum * bfhi(xw.x);
                    o[2] = yacc[4 * i + 2] + YX[(4 * i + 2) * 64 + lane] + dsum * bflo(xw.y); o[3] = yacc[4 * i + 3] + YX[(4 * i + 3) * 64 + lane] + dsum * bfhi(xw.y);
                    ow[i].x = pk2(o[0], o[1]); ow[i].y = pk2(o[2], o[3]); }
                LDS_WAIT(); asm volatile("" ::: "memory");
#pragma unroll
                for (int i = 0; i < 4; ++i) *(LAS v2u*)((LAS unsigned char*)YX + l31 * XSS + (8 * i + 4 * hl) * 2) = ow[i]; }
            lds_barrier();
            { const int t = tid >> 4, k = tid & 15, piece = (k >> 3) + 2 * ((k >> 2) & 1);
              const v4u w = *(const LAS v4u*)(lds + S4_YX + piece * 4096 + t * XSS + (k & 3) * 16);
              *(v4u*)(Y + (size_t)(row0 + tt * 32 + t) * 1024 + (8 * g + 2 * hp) * 64 + k * 8) = w; }
            lds_barrier();
        }
    }
}
}
#ifdef PROBE_IN
#define PIN_T0(bit) const bool pin_on_ = ((PROBE_IN) & (bit)) != 0; const long long pin_t0_ = wall_clock64();
#define PIN_T1(bit) if (pin_on_) { const long long pin_t1_ = wall_clock64(), pin_d_ = (pin_t1_ - pin_t0_) * (PROBE_MULT); while (wall_clock64() - pin_t1_ < pin_d_) __builtin_amdgcn_s_sleep(16); }
#else
#define PIN_T0(bit)
#define PIN_T1(bit)
#endif
__device__ __forceinline__ void phase_norm2_router(const Prm& p, int l, LAS unsigned char* lds, int wg, int nwg, int tid, int wave, int lane) {
    unsigned char* H = p.ws + WS_H; const bf16* WR = (const bf16*)(p.ws + WS_WRT);
    const int ntok = (l == 0) ? T_ALL : T_LAT;
    constexpr int HROW = 4096 + 16, CAP = 96, AST = 33;
    LAS unsigned char* hfL = lds; LAS float* part = (LAS float*)(lds + 66048); LAS float* tabL = (LAS float*)(lds + 66048 + 16384); LAS float* affL = (LAS float*)(lds + 66048 + 16384 + 32768);
    LAS int* lcnt = (LAS int*)(lds + 66048 + 16384 + 32768 + CAP * AST * 4);
    static_assert(66048 + 16384 + 32768 + CAP * AST * 4 + 256 <= LDSCTL_OFF, "norm2 LDS map");
    int* tok_e = (int*)(p.ws + WS_TOK); int* tok_pos = (int*)(p.ws + WS_TOK + TOKTAB); float* tok_gate = (float*)(p.ws + WS_TOK + 2 * TOKTAB);
    unsigned* cnt = (unsigned*)(p.ws + OFF_CNT) + l * 32 * 16;
    const int tpw = (ntok + nwg - 1) / nwg, t0 = wg * tpw, t1 = (t0 + tpw < ntok) ? t0 + tpw : ntok;
    if (t0 >= t1) return;
    const int vsA = t0 >= T_LAT ? 2 : (t0 >> 13);
    PIN_T0(1)
    {
        const int vsB = (t1 - 1) >= T_LAT ? 2 : ((t1 - 1) >> 13);
        for (int u = tid; u < 2 * 512; u += NWAVES * 64) { const int s = u >> 9, col = 4 * (u & 511); const float* md = (const float*)(p.ws + OFF_MOD) + (size_t)(l * 3 + (s ? vsB : vsA)) * MODW;
            const f32x4 g = *(const f32x4*)(p.norm_ffn + l * DM + col), s1 = modv4(md + 4 * DM + col), s0 = modv4(md + 3 * DM + col);
            *(LAS f32x4*)(tabL + s * 4096 + col) = g * (s1 + 1.f); *(LAS f32x4*)(tabL + s * 4096 + 2048 + col) = s0; }
    }
    lds_barrier();
    const int fr = lane & 15, fq = lane >> 4;
    bf16x8 b0[8], b1[8];
#pragma unroll
    for (int ks = 0; ks < 8; ++ks) { const int k0 = wave * 256 + ks * 32 + 8 * fq; b0[ks] = *(const bf16x8*)(WR + (size_t)fr * DM + k0); b1[ks] = *(const bf16x8*)(WR + (size_t)(16 + fr) * DM + k0); }
    PIN_T1(1)
#pragma unroll 1
    for (int c0 = t0; c0 < t1; c0 += CAP) {
        const int cend = (c0 + CAP < t1) ? c0 + CAP : t1, nn = cend - c0, ng = (nn + 15) >> 4;
        if (tid < 32) lcnt[tid] = 0;
        v2u rawA[2][8], rawB[2][8];
#define N2_ISSUE(buf, gi) do { _Pragma("unroll") for (int rr = 0; rr < 2; ++rr) { const int m_ = c0 + 16 * (gi) + wave * 2 + rr; \
            if ((gi) < ng && m_ < cend) { const bf16* wsrow = (m_ >= T_LAT) ? (const bf16*)(p.ws + WS_XC) + (size_t)(m_ - T_LAT) * DM : (const bf16*)(p.ws + WS_X) + (size_t)m_ * DM; \
                _Pragma("unroll") for (int j = 0; j < 8; ++j) buf[rr][j] = *(const v2u*)(wsrow + 256 * j + 4 * lane); } } } while (0)
#define N2_GROUP(buf, g, gnext) do { \
            f32x4 v[2][8]; \
            _Pragma("unroll") for (int rr = 0; rr < 2; ++rr) _Pragma("unroll") for (int j = 0; j < 8; ++j) v[rr][j] = bf4(buf[rr][j]); \
            N2_ISSUE(buf, gnext); \
            _Pragma("unroll") for (int rr = 0; rr < 2; ++rr) { const int r = wave * 2 + rr, m = c0 + 16 * (g) + r; \
                if (m < cend) { \
                    const float rstd = row_rstd(v[rr]); \
                    const int vs = m >= T_LAT ? 2 : (m >> 13); const LAS float* tab = tabL + (vs == vsA ? 0 : 4096); \
                    _Pragma("unroll") for (int j = 0; j < 8; ++j) { const int col = 256 * j + 4 * lane; const f32x4 A = *(const LAS f32x4*)(tab + col), S0 = *(const LAS f32x4*)(tab + 2048 + col); \
                        const f32x4 o = (v[rr][j] * rstd) * A + S0; \
                        v2u w; w.x = pk2(o[0], o[1]); w.y = pk2(o[2], o[3]); \
                        *(unsigned*)(H + (size_t)m * DM + col) = pack4f8(o[0], o[1], o[2], o[3]);     \
                        *(LAS v2u*)(hfL + r * HROW + col * 2) = w; } \
                } } \
            lds_barrier(); \
            {     \
                f32x4 a0 = {0.f, 0.f, 0.f, 0.f}, a1 = a0; \
                _Pragma("unroll") for (int ks = 0; ks < 8; ++ks) { const int k0 = wave * 256 + ks * 32 + 8 * fq; \
                    const bf16x8 af = *(const LAS bf16x8*)(hfL + fr * HROW + k0 * 2); \
                    a0 = __builtin_amdgcn_mfma_f32_16x16x32_bf16(af, b0[ks], a0, 0, 0, 0); a1 = __builtin_amdgcn_mfma_f32_16x16x32_bf16(af, b1[ks], a1, 0, 0, 0); } \
                _Pragma("unroll") for (int i = 0; i < 4; ++i) { part[(wave * 16 + 4 * fq + i) * 32 + fr] = a0[i]; part[(wave * 16 + 4 * fq + i) * 32 + 16 + fr] = a1[i]; } \
            } \
            lds_barrier(); \
            { float s_ = 0.f; \
              _Pragma("unroll") for (int w = 0; w < 8; ++w) s_ += part[w * 512 + tid]; \
              affL[(16 * (g) + (tid >> 5)) * AST + (tid & 31)] = sigmoid_f(s_); } \
        } while (0)
#pragma unroll
        for (int rr = 0; rr < 2; ++rr)
#pragma unroll
            for (int j = 0; j < 8; ++j) { rawA[rr][j] = (v2u){0u, 0u}; rawB[rr][j] = (v2u){0u, 0u}; }
        N2_ISSUE(rawA, 0); N2_ISSUE(rawB, 1);
        { PIN_T0(2)
#pragma unroll 1
        for (int g = 0; g < ng; g += 2) {
            N2_GROUP(rawA, g, g + 2);
            if (g + 1 < ng) N2_GROUP(rawB, g + 1, g + 3);
        }
        lds_barrier();
        PIN_T1(2) }
#undef N2_ISSUE
#undef N2_GROUP
        PIN_T0(4)
        const bool act = tid < nn; int e0 = 0, e1 = 0, r0 = 0, r1 = 0; float g0 = 0.f, g1 = 0.f;
        if (act) {
            const LAS float* af = affL + tid * AST;
            int bg = 0; float bs = -INFINITY;
#pragma unroll
            for (int g = 0; g < 4; ++g) { float t1_ = -INFINITY, t2_ = -INFINITY;
#pragma unroll
                for (int j = 0; j < 8; ++j) { const float s = af[8 * g + j] + p.router_bias[8 * g + j]; if (s > t1_) { t2_ = t1_; t1_ = s; } else if (s > t2_) t2_ = s; }
                const float gs = t1_ + t2_; if (gs > bs) { bs = gs; bg = g; } }
            float t1_ = -INFINITY, t2_ = -INFINITY; int i1 = 0, i2 = 0;
#pragma unroll
            for (int j = 0; j < 8; ++j) { const float s = af[8 * bg + j] + p.router_bias[8 * bg + j]; if (s > t1_) { t2_ = t1_; i2 = i1; t1_ = s; i1 = j; } else if (s > t2_) { t2_ = s; i2 = j; } }
            e0 = 8 * bg + i1; e1 = 8 * bg + i2; const float f0 = af[e0], f1 = af[e1], inv = 1.f / (f0 + f1); g0 = f0 * inv; g1 = f1 * inv;
            r0 = __hip_atomic_fetch_add(lcnt + e0, 1, __ATOMIC_RELAXED, __HIP_MEMORY_SCOPE_WORKGROUP); r1 = __hip_atomic_fetch_add(lcnt + e1, 1, __ATOMIC_RELAXED, __HIP_MEMORY_SCOPE_WORKGROUP);
        }
        lds_barrier();
        if (tid < 32) { const int c = lcnt[tid]; lcnt[32 + tid] = c ? (int)atomicAdd(cnt + tid * 16, (unsigned)c) : 0; }
        lds_barrier();
        if (act) { const int m = c0 + tid, p0 = lcnt[32 + e0] + r0, p1 = lcnt[32 + e1] + r1;
            int* list = (int*)(p.ws + WS_LIST); list[(size_t)e0 * LCAP + p0] = m; list[(size_t)e1 * LCAP + p1] = m;
            tok_e[2 * m] = e0; tok_e[2 * m + 1] = e1; tok_pos[2 * m] = p0; tok_pos[2 * m + 1] = p1; tok_gate[2 * m] = g0; tok_gate[2 * m + 1] = g1; }
        lds_barrier();
        PIN_T1(4)
    }
}
__device__ __forceinline__ void build_seg_tables(const Prm& p, int l, LAS unsigned char* lds, int tid) {
    LAS int* seg = (LAS int*)(lds + L_SEG); LAS int* cntL = (LAS int*)(lds + L_CNT); LAS int* blke = (LAS int*)(lds + L_BLKE); LAS int* nblkp = (LAS int*)(lds + L_NBLK);
    LAS int* incl = (LAS int*)(lds + L_INCL);
    const unsigned* cnt = (const unsigned*)(p.ws + OFF_CNT) + l * 32 * 16;
    __syncthreads();
    LAS int* pbL = (LAS int*)(lds + L_PB);
    if (tid < 32) { const int c = (int)cnt[tid * 16]; cntL[tid] = c; pbL[tid] = (c + 255) >> 8; }
    __syncthreads();
    if (tid < 32) { int inc = 0;
#pragma unroll
        for (int k = 0; k < 32; ++k) { int v = pbL[k]; asm volatile("" : "+v"(v)); inc += (k <= tid) ? v : 0; }
        seg[tid] = (inc - pbL[tid]) * 256; incl[tid] = inc; if (tid == 31) { seg[32] = inc * 256; *nblkp = inc; } }
    __syncthreads();
    if (tid < MAXBLK + 3) { int e = 0;
#pragma unroll
        for (int k = 0; k < 32; ++k) e += (incl[k] <= tid) ? 1 : 0;
        e = e < 31 ? e : 31; blke[tid] = e; ((LAS int*)(lds + L_BLKH))[tid] = (cntL[e] - 256 * (tid - (seg[e] >> 8)) <= 128) ? 1 : 0; }
    __syncthreads();
}
template <class Sched>
__device__ __forceinline__ void build_row_table(const Prm& p, const Sched& S, LAS unsigned char* lds, int tid) {
    const LAS int* seg = (const LAS int*)(lds + L_SEG); const LAS int* cntL = (const LAS int*)(lds + L_CNT); const LAS int* blke = (const LAS int*)(lds + L_BLKE);
    LAS unsigned* T = (LAS unsigned*)(lds + L_ROWT); const int* list = (const int*)(p.ws + WS_LIST);
#pragma unroll 1
    for (int i = 0; i < 8; ++i) { pg8::Unit u; if (!S.next(i, u)) break;
        const int e = blke[u.pm], base = (u.pm - (seg[e] >> 8)) * 256;
        if (tid < 256) { const int pos = base + tid; T[i * 256 + tid] = pos < cntL[e] ? (unsigned)WS_H + (unsigned)list[(size_t)e * LCAP + pos] * 2048u : ZERO_OFF; } }
    __syncthreads();
}
#ifndef SKIP_GU
#define SKIP_GU true
#endif
#ifndef SKIP_DN
#define SKIP_DN true
#endif
#ifndef STATES_ALL
#define STATES_ALL 1
#endif
#ifndef GRAB_WAIT
#define GRAB_WAIT 16
#endif
#ifndef NCONV
#define NCONV 16
#endif
constexpr int N_PHASES = 24;
__global__ void __launch_bounds__(NWAVES * 64, 2) mk_fwd(Prm p) {
    extern __shared__ __attribute__((aligned(16))) unsigned char lds_raw[];
    LAS unsigned char* lds = (LAS unsigned char*)lds_raw;
    const int tid0 = threadIdx.x, wave = __builtin_amdgcn_readfirstlane(tid0 >> 6);
#define OPQ int tid = tid0; asm volatile("" : "+v"(tid)); const int lane = tid & 63;
    const int G = gridDim.x, bx = blockIdx.x, vcu = (G % 8 == 0) ? (bx % 8) * (G / 8) + bx / 8 : bx;
    const int gw = vcu * NWAVES + wave, ngw = G * NWAVES;
    unsigned char* ws = p.ws;
    for (int u = tid0; u < (LDS_BYTES - LDSCTL_OFF) / 4; u += NWAVES * 64) ((LAS unsigned*)(lds + LDSCTL_OFF))[u] = 0u;
    __syncthreads();
#if MK_ONE_LAUNCH
    XcdBarrier bar = xcd_barrier_post((unsigned*)ws + CW_BAR, (volatile LAS unsigned*)(lds + L_BARW));
#define GRID_BAR() xcd_barrier(bar)
#define GRID_BAR_WD(ded) do { if (CONV_QUEUE) xcd_barrier_work(bar, p, lds, tid0, (ded) ? 16 : GRAB_WAIT); else xcd_barrier(bar); } while (0)
#define GRID_BAR_W() GRID_BAR_WD(false)
#else
#define GRID_BAR() do {} while (0)
#define GRID_BAR_W() do {} while (0)
#define GRID_BAR_WD(ded) do {} while (0)
#endif
#define WORKERS_(units) (((units) + (((units) + G - 1) / G) - 1) / (((units) + G - 1) / G))
#define WORKERS(units) ((CONV_QUEUE && MK_ONE_LAUNCH) ? ((WORKERS_(units) + 7) / 8 * 8 < G ? (WORKERS_(units) + 7) / 8 * 8 : G) : G)
#ifdef PROBE_SITES
#define PROBE_T0(bit) const bool pr_on_ = ((PROBE_SITES) & (bit)) != 0; const long long pr_t0_ = wall_clock64();
#define PROBE_T1(bit) if (pr_on_) { const long long pr_t1_ = wall_clock64(), pr_d_ = (pr_t1_ - pr_t0_) * (PROBE_MULT); while (wall_clock64() - pr_t1_ < pr_d_) __builtin_amdgcn_s_sleep(16); }
#else
#define PROBE_T0(bit)
#define PROBE_T1(bit)
#endif
    const int lo = p.ph_lo, hi = p.ph_hi;
#define IN(k) (lo <= (k) && (k) < hi)
#ifndef DUPMASK
#define DUPMASK 0
#endif
#define REPS(kind) for (int rep_ = 0; rep_ < (((DUPMASK) >> (kind)) & 1) + 1; ++rep_)
    if (IN(0)) REPS(0) { PROBE_T0(1 << (0)) OPQ phase_prologue(p, lds, gw, ngw, wave, lane, rep_ == 0); GRID_BAR(); PROBE_T1(1 << (0)) }
    for (int l = 0; l < 2; ++l) {
        const int pb = 1 + 11 * l;
        if (IN(pb + 0)) { PROBE_T0(1 << (pb + 0)) OPQ if (l > 0) { if (CONV_QUEUE) { PROBE_T0(1 << 25) queue_drain(p, lds, tid, (unsigned)(Q_L1 + NP_PROJ)); PROBE_T1(1 << 25) }     build_seg_tables(p, l - 1, lds, tid); row_stream<true, false, false>(p, l, l - 1, T_ALL, gw, ngw, tid, lane, lds, (const LAS int*)(lds + L_SEG)); } else row_stream<false, false, true>(p, l, 0, T_ALL, gw, ngw, tid, lane, lds, (const LAS int*)(lds + L_SEG)); GRID_BAR_W(); PROBE_T1(1 << (pb + 0)) }
        if (IN(pb + 1)) REPS(2) { PROBE_T0(1 << (pb + 1))
            pg8::Gemm g{(const pg8::bf16_t*)(ws + WS_H), (const pg8::bf16_t*)(ws + WS_WIN + (size_t)l * NINP * DM * (F8_INPROJ ? 1 : 2)), T_ALL, NINP, F8_INPROJ ? DM / 2 : DM};
            const int Ge = WORKERS((T_ALL / 256) * (NINP / 256));
            pg8::StaticOrder S; S.init(T_ALL, NINP, Ge, bx);
            pg8::EpiInProj E{(pg8::bf16_t*)(ws + WS_U), NINP, (const float*)(ws + WS_ROPE), C_QB / 256, C_VB / 256, T_LAT, F8_INPROJ ? 1.f / W8_SCALE : 1.f};
            if (bx < Ge) pg8::gemm_phase<pg8::EpiInProj, pg8::StaticOrder, true, true, F8_INPROJ != 0>(lds, g, S, E);
            GRID_BAR_WD(bx >= Ge);
            PROBE_T1(1 << (pb + 1))
        }
        if (IN(pb + 2)) REPS(3) { PROBE_T0(1 << (pb + 2)) OPQ
            const bool cx = (l == 0) && G > 64; const int cgw = cx ? (bx < 16 ? (1 << 30) : (bx - 16) * NWAVES + wave) : gw, cngw = cx ? (G - 16) * NWAVES : ngw;
            if ((bx >> 3) & 1) { att::phase_attn(p, l, lds, bx, G, tid); phase_conv(p, l, cgw, cngw, lane); } else { phase_conv(p, l, cgw, cngw, lane); att::phase_attn(p, l, lds, bx, G, tid); } GRID_BAR_W(); PROBE_T1(1 << (pb + 2)) }
        if (IN(pb + 3)) REPS(4) { PROBE_T0(1 << (pb + 3)) OPQ const int Ge = STATES_ALL ? G : WORKERS(2 * ssd::NCH * 4); if (vcu < Ge) ssd::phase_states(p, l, lds, vcu, Ge, tid); GRID_BAR_WD(vcu >= Ge);       PROBE_T1(1 << (pb + 3)) }
        if (IN(pb + 4)) REPS(5) { PROBE_T0(1 << (pb + 4)) OPQ ssd::phase_scan(p, bx * (NWAVES * 64) + tid, G * NWAVES * 64); GRID_BAR_W(); PROBE_T1(1 << (pb + 4)) }
        if (IN(pb + 5)) REPS(6) { PROBE_T0(1 << (pb + 5)) OPQ const int Ge = WORKERS(2 * (ssd::NCH - (l == 0 ? 0 : 2)) * 8); if (vcu < Ge) ssd::phase_ssd_out(p, l, lds, vcu, Ge, tid); GRID_BAR_WD(vcu >= Ge); PROBE_T1(1 << (pb + 5)) }
        if (IN(pb + 6)) REPS(7) { PROBE_T0(1 << (pb + 6)) OPQ phase_gnorm(p, l, gw, ngw, lane); GRID_BAR_W(); PROBE_T1(1 << (pb + 6)) }
        if (IN(pb + 7)) { PROBE_T0(1 << (pb + 7))
            const int M = (l == 0) ? T_ALL : T_LAT;
            pg8::Gemm g{(const pg8::bf16_t*)(ws + WS_H), (const pg8::bf16_t*)(ws + WS_WOUT + (size_t)l * DM * DM * (F8_OUTPROJ ? 1 : 2)), M, DM, F8_OUTPROJ ? DM / 2 : DM};
            const int Ge = WORKERS((M / 256) * (DM / 256));
            pg8::StaticOrder S; S.init(M, DM, Ge, bx);
            pg8::EpiRes E{(l == 0) ? (const void*)p.x : (const void*)(ws + WS_X), (pg8::bf16_t*)(ws + WS_X), (l == 0) ? (const void*)p.ctx : (const void*)(ws + WS_XC), (pg8::bf16_t*)(ws + WS_XC),
                          (const float*)(ws + OFF_MOD) + (size_t)l * 3 * MODW + 2 * DM, DM, T_LAT, MODW, F8_OUTPROJ ? 1.f / (W8_SCALE * MIX_SCALE) : 1.f, l == 0 ? 1 : 0};
            if (bx < Ge) pg8::gemm_phase<pg8::EpiRes, pg8::StaticOrder, true, true, F8_OUTPROJ != 0>(lds, g, S, E);
            GRID_BAR_WD(bx >= Ge);
            PROBE_T1(1 << (pb + 7))
        }
        if (IN(pb + 8)) { PROBE_T0(1 << (pb + 8)) OPQ phase_norm2_router(p, l, lds, bx, G, tid, wave, lane); GRID_BAR_W(); PROBE_T1(1 << (pb + 8)) }
        if (IN(pb + 9) && CONV_QUEUE && (l == 1 || Q_L0EXP)) { OPQ PROBE_T0(l == 1 ? (1 << 26) : (1 << 24)) queue_drain(p, lds, tid, (unsigned)(l == 1 ? Q_TOTAL : Q_L0)); GRID_BAR(); PROBE_T1(l == 1 ? (1 << 26) : (1 << 24)) }
        if (IN(pb + 9)) REPS(11) { PROBE_T0(1 << (pb + 9))
            OPQ build_seg_tables(p, l, lds, tid);
            const int nblk = __builtin_amdgcn_readfirstlane(*(const LAS int*)(lds + L_NBLK));
            pg8::Gemm g{(const pg8::bf16_t*)ws, (const pg8::bf16_t*)(ws + WS_WGU + (size_t)l * 32 * 2048 * 2048), nblk * 256, 2048, DM / 2};
            pg8::GroupedOrderT<SKIP_GU, true> S{G, vcu, nblk, (const LAS int*)(lds + L_BLKE), (const LAS int*)(lds + L_BLKH), (long)2048 * 2048, (const LAS unsigned*)(lds + L_ROWT)};
            build_row_table(p, S, lds, tid);
            pg8::EpiGateUp E{ws + WS_ACT, DFF, 1.f / W8_SCALE};
            pg8::gemm_phase<pg8::EpiGateUp, pg8::GroupedOrderT<SKIP_GU, true>, true, true, true>(lds, g, S, E);
            GRID_BAR_W();
            PROBE_T1(1 << (pb + 9))
        }
        if (IN(pb + 10)) REPS(12) { PROBE_T0(1 << (pb + 10))
            OPQ if (CONV_QUEUE && Q_L0EXP && l == 0) queue_drain(p, lds, tid, (unsigned)Q_L1);
            build_seg_tables(p, l, lds, tid);
            const int nblk = __builtin_amdgcn_readfirstlane(*(const LAS int*)(lds + L_NBLK));
            pg8::Gemm g{(const pg8::bf16_t*)(ws + WS_ACT), (const pg8::bf16_t*)(ws + WS_WDN + (size_t)l * 32 * 2048 * 1024), nblk * 256, DM, DFF / 2};
            pg8::GroupedOrderT<SKIP_DN> S{G, vcu, nblk, (const LAS int*)(lds + L_BLKE), (const LAS int*)(lds + L_BLKH), (long)2048 * 1024, nullptr};
            pg8::EpiF8 E{ws + WS_YB, DM, Y8_SCALE / W8_SCALE};
            pg8::gemm_phase<pg8::EpiF8, pg8::GroupedOrderT<SKIP_DN>, true, true, true>(lds, g, S, E);
            GRID_BAR_W();
            PROBE_T1(1 << (pb + 10))
        }
    }
    if (IN(23)) { PROBE_T0(1 << (23)) OPQ build_seg_tables(p, 1, lds, tid); row_stream<true, true, false>(p, 1, 1, T_LAT, gw, ngw, tid, lane, lds, (const LAS int*)(lds + L_SEG)); PROBE_T1(1 << (23)) }
#undef IN
}

extern "C" void kernel_launch(void* const* d_in, const int* in_sizes, int n_in, void* d_out, int out_size, void* d_ws, size_t ws_size, hipStream_t stream) {
    static int grid = 0;
    if (grid == 0) {
        if (n_in != 24 || in_sizes[0] != T_LAT * DM || out_size != T_LAT * DM || ws_size < WS_END) {
            fprintf(stderr, "kernel_launch: unexpected shapes: n_in %d in0 %d out %d ws %zu (need %zu)\n", n_in, n_in > 0 ? in_sizes[0] : -1, out_size, ws_size, (size_t)WS_END); grid = -1; return; }
        int dev = 0, cus = 0, per_cu = 0;
        if (hipGetDevice(&dev) != hipSuccess || hipDeviceGetAttribute(&cus, hipDeviceAttributeMultiprocessorCount, dev) != hipSuccess) { grid = -1; return; }
        if (hipFuncSetAttribute((const void*)mk_fwd, hipFuncAttributeMaxDynamicSharedMemorySize, LDS_BYTES) != hipSuccess) { fprintf(stderr, "kernel_launch: hipFuncSetAttribute failed\n"); grid = -1; return; }
        if (hipOccupancyMaxActiveBlocksPerMultiprocessor(&per_cu, (const void*)mk_fwd, NWAVES * 64, LDS_BYTES) != hipSuccess || per_cu < 1) {
            fprintf(stderr, "kernel_launch: occupancy query reports %d blocks per CU\n", per_cu); }
        (void)hipGetLastError();
        grid = cus;
    }
    if (grid < 0) return;
    if (hipMemsetAsync((char*)d_ws + WS_CTL, 0, CTL_ZERO_BYTES, stream) != hipSuccess) { fprintf(stderr, "kernel_launch: memset failed\n"); return; }
    Prm p{};
    p.x = (const float*)d_in[0]; p.c = (const float*)d_in[1]; p.ctx = (const float*)d_in[2]; p.c_ctx = (const float*)d_in[3]; p.w_ada = (const float*)d_in[4]; p.b_ada = (const float*)d_in[5];
    p.norm_mix = (const float*)d_in[6]; p.norm_ffn = (const float*)d_in[7]; p.norm_final = (const float*)d_in[8]; p.w_in = (const float*)d_in[9]; p.w_out = (const float*)d_in[10];
    p.na_rpb = (const float*)d_in[11]; p.wa_sink = (const float*)d_in[12]; p.conv_w = (const float*)d_in[13]; p.conv_b = (const float*)d_in[14]; p.a_log = (const float*)d_in[15];
    p.dt_bias = (const float*)d_in[16]; p.d_skip = (const float*)d_in[17]; p.ssd_norm = (const float*)d_in[18]; p.w_router = (const float*)d_in[19]; p.router_bias = (const float*)d_in[20];
    p.w_gate = (const float*)d_in[21]; p.w_up = (const float*)d_in[22]; p.w_down = (const float*)d_in[23];
    p.out = (float*)d_out; p.ws = (unsigned char*)d_ws;
#if MK_ONE_LAUNCH
    p.ph_lo = 0; p.ph_hi = N_PHASES;
    hipLaunchKernelGGL(mk_fwd, dim3(grid), dim3(NWAVES * 64), LDS_BYTES, stream, p);
#else
    for (int ph = 0; ph < N_PHASES; ++ph) { p.ph_lo = ph; p.ph_hi = ph + 1; hipLaunchKernelGGL(mk_fwd, dim3(grid), dim3(NWAVES * 64), LDS_BYTES, stream, p); }
#endif
    const hipError_t le = hipPeekAtLastError();
    if (le != hipSuccess) fprintf(stderr, "kernel_launch: launch failed: %s\n", hipGetErrorName(le));
}
```

```cpp
#include <hip/hip_runtime.h>
#include <cstdio>
#include <cstdint>

#ifndef MK_ONE_LAUNCH
#define MK_ONE_LAUNCH 1
#endif

#ifndef F8_INPROJ
#define F8_INPROJ 1
#endif
#ifndef F8_OUTPROJ
#define F8_OUTPROJ 1
#endif

namespace pg8 {
#define PG8_LAS __attribute__((address_space(3)))
typedef unsigned short bf16_t;
typedef short bf16x8 __attribute__((ext_vector_type(8)));
typedef float f32x4 __attribute__((ext_vector_type(4)));
typedef unsigned u32x4 __attribute__((ext_vector_type(4)));
constexpr int BM = 256, BK = 64, HALF = 128, HTB = HALF * BK * 2  , STAGE_BYTES = 8 * HTB, NXCD = 8, WGM = 5;

__host__ __device__ __forceinline__ int lds_byte(int r, int c) { const int st = (r >> 4) * 2 + (c >> 5), rr = r & 15, cc = c & 31, ob = rr * 64 + cc * 2; return st * 1024 + (ob ^ (((ob >> 9) & 1) << 5)); }
__host__ __device__ __forceinline__ void stage_rc(int b, int& R, int& C) { const int st = b / 1024, sb = b % 1024, swz = sb ^ (((sb >> 9) & 1) << 5); R = (st >> 1) * 16 + swz / 64; C = (st & 1) * 32 + (swz % 64) / 2; }
__host__ __device__ __forceinline__ int perm32(int rho) { const int n = rho >> 4, i = rho & 15; return 8 * (i >> 2) + 4 * n + (i & 3); }

typedef int i32x4v __attribute__((ext_vector_type(4)));
typedef int i32x8v __attribute__((ext_vector_type(8)));
__device__ __forceinline__ i32x8v cat8(bf16x8 a, bf16x8 b) { const i32x4v x = __builtin_bit_cast(i32x4v, a), y = __builtin_bit_cast(i32x4v, b); return __builtin_shufflevector(x, y, 0, 1, 2, 3, 4, 5, 6, 7); }
struct Unit { int pm, pn; long boff; int lo_only; };
struct Gemm { const bf16_t* A; const bf16_t* Bt; int M, N, K; };

struct StaticOrder {
    static constexpr bool SKIP_HI = false, GATHER = false, B_NT = false; const PG8_LAS unsigned* rowtab;
    int nM, nN, nwg, G, c;
    __host__ __device__ void init(int M, int N, int G_, int c_) { nM = M / BM; nN = N / BM; nwg = nM * nN; G = G_; c = c_; }
    __host__ __device__ bool next(int i, Unit& u) const {
        const long L = (long)i * G + c; if (L >= nwg) return false;
        int wgid = (int)L; { const int q = nwg / NXCD, r = nwg % NXCD, xcd = wgid % NXCD, off = wgid / NXCD; wgid = (xcd < r ? xcd * (q + 1) : r * (q + 1) + (xcd - r) * q) + off; }
        const int nig = WGM * nN, gid = wgid / nig, fm = gid * WGM, gsz = (nM - fm) < WGM ? (nM - fm) : WGM;
        u.pm = fm + ((wgid % nig) % gsz); u.pn = (wgid % nig) / gsz; u.boff = 0; u.lo_only = 0; return true;
    }
    __device__ __forceinline__ void a_ready(const Unit&) const {}
    __device__ __forceinline__ void done(const Unit&) const {}
};

__device__ __forceinline__ unsigned cvt_pk_bf16(float lo, float hi) { unsigned r; asm volatile("v_cvt_pk_bf16_f32 %0, %1, %2" : "=v"(r) : "v"(lo), "v"(hi)); return r; }
typedef float f32x2 __attribute__((ext_vector_type(2)));
__device__ __forceinline__ f32x2 gelu_pk(f32x2 v) {
    const f32x2 av = __builtin_elementwise_abs(v), d = av * 0.2316418882f + 1.0f;
    f32x2 t; t.x = __builtin_amdgcn_rcpf(d.x); t.y = __builtin_amdgcn_rcpf(d.y);
    f32x2 q = t * 0.5307027145f + (-0.7265760135f); q = q * t + 0.7107068705f; q = q * t + (-0.142248368f); q = q * t + 0.127414796f; q = q * t;
    const f32x2 s = (v * v) * (-0.72134752044f);
    f32x2 e; e.x = __builtin_amdgcn_exp2f(s.x); e.y = __builtin_amdgcn_exp2f(s.y);
    const f32x2 m = v * (q * e), r = v - m;
    f32x2 o; o.x = v.x < 0.f ? m.x : r.x; o.y = v.y < 0.f ? m.y : r.y; return o;
}

template <class Epi, class Sched, bool ALIGN_EPI = false, bool SP2 = false, bool F8 = false>
__device__ __forceinline__ void gemm_phase(PG8_LAS unsigned char* lds, const Gemm g, const Sched& S, const Epi& E) {
    int tid_o = threadIdx.x; asm volatile("" : "+v"(tid_o));
    const int tid = tid_o, wid = __builtin_amdgcn_readfirstlane(tid >> 6), lane = tid & 63, wr = wid >> 2, wc = wid & 3, fr = lane & 15, fq = lane >> 4;
    const int K = g.K, nt = K / BK;
    unsigned voffA[2], voffB[2];
#pragma unroll
    for (int i = 0; i < 2; ++i) { int R, C; stage_rc(tid * 16 + i * 8192, R, C); const int r32_ = Epi::PERM ? perm32(R & 31) : (R & 31); const int Rb = Epi::ADJ ? ((R >> 5) * 64 + r32_) : ((R & ~31) + r32_);
        voffA[i] = (unsigned)(R * K + C) * 2u; voffB[i] = (unsigned)(Rb * K + C) * 2u; }
    int gR[2]; unsigned gC[2];
#pragma unroll
    for (int i = 0; i < 2; ++i) { int R, C; stage_rc(tid * 16 + i * 8192, R, C); gR[i] = R; gC[i] = (unsigned)C * 2u; }
    unsigned gc[2][2] = {{0u, 0u}, {0u, 0u}}, gn[2][2] = {{0u, 0u}, {0u, 0u}};
#define PG8_GROWS(dst, u) do { if constexpr (Sched::GATHER) { _Pragma("unroll") for (int h_ = 0; h_ < 2; ++h_) _Pragma("unroll") for (int i_ = 0; i_ < 2; ++i_) dst[h_][i_] = S.rowtab[(u) * 256 + h_ * 128 + gR[i_]] + gC[i_]; } } while (0)
#define PG8_STAGE_A(bufoff, kbase, h, nx) do { if constexpr (Sched::GATHER) { _Pragma("unroll") for (int _i = 0; _i < 2; ++_i) \
        __builtin_amdgcn_global_load_lds((const unsigned*)((const char*)(kbase) + ((nx) ? gn[h][_i] : gc[h][_i])), (PG8_LAS unsigned*)(lds + (bufoff) + ldsw + _i * 8192), 16, 0, 0); } \
        else PG8_STAGE(bufoff, (kbase) + ((h) ? hstep : 0), voffA); } while (0)
    const size_t kstep = (size_t)(BK * 2);
    const size_t hstep = (size_t)HALF * K * 2;
    const size_t hstepB = Epi::ADJ ? (size_t)32 * K * 2 : hstep;
    const size_t tstep = 2 * hstep;
    const unsigned ldsw = (unsigned)wid * 1024u;
    const int aoff = lds_byte(wr * 64 + fr, fq * 8), boff = lds_byte(wc * 32 + fr, fq * 8);
    const int aoff8 = lds_byte(wr * 64 + fr, (fq & 1) * 16) + (fq >> 1) * 1024, boff8 = lds_byte(wc * 32 + fr, (fq & 1) * 16) + (fq >> 1) * 1024;
    const int hsw8 = (fq & 1) * 16, aoff8a = aoff8 + hsw8, aoff8b = aoff8 + 16 - hsw8, boff8a = boff8 + hsw8, boff8b = boff8 + 16 - hsw8;
#define PG8_SA(b, h) (((b) * 2 + (h)) * HTB)
#define PG8_SB(b, h) ((4 + (b) * 2 + (h)) * HTB)
#define PG8_STAGE(bufoff, gbase, voff) do { _Pragma("unroll") for (int _i = 0; _i < 2; ++_i) \
        __builtin_amdgcn_global_load_lds((const unsigned*)((const char*)(gbase) + (voff)[_i]), (PG8_LAS unsigned*)(lds + (bufoff) + ldsw + _i * 8192), 16, 0, 0); } while (0)
#define PG8_STAGE_B(bufoff, gbase, voff) do { _Pragma("unroll") for (int _i = 0; _i < 2; ++_i) \
        __builtin_amdgcn_global_load_lds((const unsigned*)((const char*)(gbase) + (voff)[_i]), (PG8_LAS unsigned*)(lds + (bufoff) + ldsw + _i * 8192), 16, 0, Sched::B_NT ? 2 : 0); } while (0)
#define PG8_LDA(dst, b, h) do { if constexpr (F8) { _Pragma("unroll") for (int m = 0; m < 4; ++m) dst##8[m] = cat8(*(const PG8_LAS bf16x8*)(lds + PG8_SA(b, h) + aoff8a + m * 2048), *(const PG8_LAS bf16x8*)(lds + PG8_SA(b, h) + aoff8b + m * 2048)); } else { \
        _Pragma("unroll") for (int m = 0; m < 4; ++m) _Pragma("unroll") for (int k = 0; k < 2; ++k) dst[m][k] = *(const PG8_LAS bf16x8*)(lds + PG8_SA(b, h) + aoff + m * 2048 + k * 1024); } } while (0)
#define PG8_LDB(dst, b, h) do { if constexpr (F8) { _Pragma("unroll") for (int n = 0; n < 2; ++n) dst##8[n] = cat8(*(const PG8_LAS bf16x8*)(lds + PG8_SB(b, h) + boff8a + n * 2048), *(const PG8_LAS bf16x8*)(lds + PG8_SB(b, h) + boff8b + n * 2048)); } else { \
        _Pragma("unroll") for (int n = 0; n < 2; ++n) _Pragma("unroll") for (int k = 0; k < 2; ++k) dst[n][k] = *(const PG8_LAS bf16x8*)(lds + PG8_SB(b, h) + boff + n * 2048 + k * 1024); } } while (0)
#define PG8_MMA(ai, bj, At, Bt) do { __builtin_amdgcn_s_setprio(1); if constexpr (F8) { _Pragma("unroll") for (int m = 0; m < 4; ++m) _Pragma("unroll") for (int n = 0; n < 2; ++n) \
        asm volatile("v_mfma_scale_f32_16x16x128_f8f6f4 %0, %1, %2, %0, %3, %3 op_sel_hi:[0,0,0]" : "+v"(acc[ai][bj][m][n]) : "v"(Bt##8[n]), "v"(At##8[m]), "v"(sc1)); } else { \
        _Pragma("unroll") for (int m = 0; m < 4; ++m) _Pragma("unroll") for (int n = 0; n < 2; ++n) _Pragma("unroll") for (int k = 0; k < 2; ++k) \
        acc[ai][bj][m][n] = __builtin_amdgcn_mfma_f32_16x16x32_bf16(Bt[n][k], At[m][k], acc[ai][bj][m][n], 0, 0, 0); } __builtin_amdgcn_s_setprio(0); } while (0)
#define PG8_WAIT_V(n) asm volatile("s_waitcnt vmcnt(" #n ")" ::: "memory")
#define PG8_WAIT_L(n) asm volatile("s_waitcnt lgkmcnt(" #n ")" ::: "memory")
#define PG8_BAR __builtin_amdgcn_s_barrier()
#define PG8_SCHED __builtin_amdgcn_sched_barrier(0)
    Unit cur, nxt; int ui = 0;
    if (!S.next(0, cur)) return;
    f32x4 acc[2][2][4][2];
#pragma unroll
    for (int a = 0; a < 2; ++a)
#pragma unroll
        for (int b = 0; b < 2; ++b)
#pragma unroll
            for (int m = 0; m < 4; ++m)
#pragma unroll
                for (int n = 0; n < 2; ++n) acc[a][b][m][n] = (f32x4){0.f, 0.f, 0.f, 0.f};
    const int sc1 = 0x7F7F7F7F;
    bf16x8 At[4][2], B0[2][2], B1[2][2]; i32x8v At8[4], B08[2], B18[2];
    const char* cA = (const char*)g.A + (Sched::GATHER ? (size_t)0 : (size_t)cur.pm * tstep); PG8_GROWS(gc, 0); const char* cB = (const char*)g.Bt + (size_t)cur.pn * tstep + cur.boff;
    S.a_ready(cur);
    if constexpr (SP2) {
        PG8_STAGE_B(PG8_SB(0, 0), cB, voffB); PG8_STAGE_B(PG8_SB(0, 1), cB + hstepB, voffB); PG8_STAGE_A(PG8_SA(0, 0), cA, 0, false); PG8_STAGE_A(PG8_SA(0, 1), cA, 1, false);
        if (wr == 1) PG8_BAR;
        PG8_WAIT_V(2); PG8_BAR;
        PG8_STAGE_B(PG8_SB(1, 0), cB + kstep, voffB); PG8_STAGE_A(PG8_SA(1, 0), cA + kstep, 0, false); PG8_STAGE_B(PG8_SB(1, 1), cB + hstepB + kstep, voffB);
        PG8_WAIT_V(6); PG8_BAR;
    } else {
        PG8_STAGE_B(PG8_SB(0, 0), cB, voffB); PG8_STAGE_A(PG8_SA(0, 0), cA, 0, false); PG8_STAGE_B(PG8_SB(0, 1), cB + hstepB, voffB); PG8_STAGE_A(PG8_SA(0, 1), cA, 1, false);
        if (wr == 1) PG8_BAR;
        PG8_WAIT_V(4); PG8_BAR;
        PG8_STAGE_B(PG8_SB(1, 0), cB + kstep, voffB); PG8_STAGE_A(PG8_SA(1, 0), cA + kstep, 0, false); PG8_STAGE_B(PG8_SB(1, 1), cB + hstepB + kstep, voffB);
        PG8_WAIT_V(6); PG8_BAR;
    }
    for (;;) {
        const bool has_next = S.next(ui + 1, nxt);
        const char* nA = has_next ? (const char*)g.A + (Sched::GATHER ? (size_t)0 : (size_t)nxt.pm * tstep) : cA; if (has_next) PG8_GROWS(gn, ui + 1); const char* nB = has_next ? (const char*)g.Bt + (size_t)nxt.pn * tstep + nxt.boff : cB;
        const bool hi_on = !Sched::SKIP_HI || cur.lo_only == 0;
#pragma unroll 1
        for (int t = 0; t < nt; t += 2) {
            const bool last = (t == nt - 2);
            const char* a1 = cA + (size_t)(t + 1) * kstep;
            const char* a2 = last ? nA : cA + (size_t)(t + 2) * kstep; const char* b2 = last ? nB : cB + (size_t)(t + 2) * kstep;
            const char* a3 = a2 + kstep; const char* b3 = b2 + kstep;
            const bool nx_ = last && has_next;
            if (last && has_next) S.a_ready(nxt);
            if constexpr (SP2) {
            PG8_LDB(B0, 0, 0); PG8_LDB(B1, 0, 1); PG8_SCHED; PG8_LDA(At, 0, 0); PG8_STAGE_A(PG8_SA(1, 1), a1, 1, false);
            PG8_WAIT_V(8); PG8_WAIT_L(0); PG8_BAR; PG8_MMA(0, 0, At, B0); PG8_MMA(0, 1, At, B1); PG8_BAR; PG8_SCHED;
            PG8_LDA(At, 0, 1); PG8_STAGE_B(PG8_SB(0, 0), b2, voffB); PG8_STAGE_B(PG8_SB(0, 1), b2 + hstepB, voffB); PG8_STAGE_A(PG8_SA(0, 0), a2, 0, nx_);
            PG8_WAIT_V(8); PG8_WAIT_L(0); PG8_BAR; if (__builtin_expect(hi_on, 1)) { PG8_MMA(1, 0, At, B0); PG8_MMA(1, 1, At, B1); } PG8_BAR; PG8_SCHED;
            PG8_LDB(B0, 1, 0); PG8_LDB(B1, 1, 1); PG8_SCHED; PG8_LDA(At, 1, 0); PG8_STAGE_A(PG8_SA(0, 1), a2, 1, nx_);
            PG8_WAIT_V(8); PG8_WAIT_L(0); PG8_BAR; PG8_MMA(0, 0, At, B0); PG8_MMA(0, 1, At, B1); PG8_BAR; PG8_SCHED;
            PG8_LDA(At, 1, 1); PG8_STAGE_B(PG8_SB(1, 0), b3, voffB); PG8_STAGE_B(PG8_SB(1, 1), b3 + hstepB, voffB); PG8_STAGE_A(PG8_SA(1, 0), a3, 0, nx_);
            PG8_WAIT_V(8); PG8_WAIT_L(0); PG8_BAR; if (__builtin_expect(hi_on, 1)) { PG8_MMA(1, 0, At, B0); PG8_MMA(1, 1, At, B1); } PG8_BAR; PG8_SCHED;
            } else {
            PG8_LDB(B0, 0, 0); PG8_SCHED; PG8_LDA(At, 0, 0); PG8_STAGE_A(PG8_SA(1, 1), a1, 1, false);
            PG8_WAIT_L(8); PG8_BAR; PG8_WAIT_L(0); PG8_MMA(0, 0, At, B0); PG8_BAR; PG8_SCHED;
            PG8_LDB(B1, 0, 1); PG8_STAGE_B(PG8_SB(0, 0), b2, voffB);
            PG8_BAR; PG8_WAIT_L(0); PG8_MMA(0, 1, At, B1); PG8_BAR;
            PG8_LDA(At, 0, 1); PG8_STAGE_A(PG8_SA(0, 0), a2, 0, nx_);
            PG8_BAR; PG8_WAIT_L(0); PG8_MMA(1, 0, At, B0); PG8_BAR; PG8_SCHED;
            PG8_STAGE_B(PG8_SB(0, 1), b2 + hstepB, voffB);
            PG8_WAIT_V(6); PG8_BAR; PG8_MMA(1, 1, At, B1); PG8_BAR;
            PG8_LDB(B0, 1, 0); PG8_SCHED; PG8_LDA(At, 1, 0); PG8_STAGE_A(PG8_SA(0, 1), a2, 1, nx_);
            PG8_WAIT_L(8); PG8_BAR; PG8_WAIT_L(0); PG8_MMA(0, 0, At, B0); PG8_BAR; PG8_SCHED;
            PG8_LDB(B1, 1, 1); PG8_STAGE_B(PG8_SB(1, 0), b3, voffB);
            PG8_BAR; PG8_WAIT_L(0); PG8_MMA(0, 1, At, B1); PG8_BAR;
            PG8_LDA(At, 1, 1); PG8_STAGE_A(PG8_SA(1, 0), a3, 0, nx_);
            PG8_BAR; PG8_WAIT_L(0); PG8_MMA(1, 0, At, B0); PG8_BAR; PG8_SCHED;
            PG8_STAGE_B(PG8_SB(1, 1), b3 + hstepB, voffB);
            PG8_WAIT_V(6); PG8_BAR; PG8_MMA(1, 1, At, B1); PG8_BAR;
            }
        }
        if constexpr (F8) asm volatile("s_nop 15\n\ts_nop 15" ::: "memory");
        if constexpr (ALIGN_EPI) { if (wr == 0) PG8_BAR; }
        if constexpr (!Epi::AFTER_DRAIN) { E(acc, cur, wr, wc, fr, fq); S.done(cur); }
        if (!has_next) break;
#pragma unroll
        for (int a = 0; a < 2; ++a)
#pragma unroll
            for (int b = 0; b < 2; ++b)
#pragma unroll
                for (int m = 0; m < 4; ++m)
#pragma unroll
                    for (int n = 0; n < 2; ++n) acc[a][b][m][n] = (f32x4){0.f, 0.f, 0.f, 0.f};
        cur = nxt; cA = nA; cB = nB; ++ui;
        if constexpr (Sched::GATHER) { gc[0][0] = gn[0][0]; gc[0][1] = gn[0][1]; gc[1][0] = gn[1][0]; gc[1][1] = gn[1][1]; }
        if constexpr (ALIGN_EPI) { if (wr == 1) PG8_BAR; }
    }
    PG8_WAIT_V(0);
    if constexpr (!ALIGN_EPI) { if (wr == 0) PG8_BAR; }
    PG8_BAR;
    if constexpr (Epi::AFTER_DRAIN) { E.fused(acc, cur, wr, wc, fr, fq, lds, wid, lane); S.done(cur); }
#undef PG8_SA
#undef PG8_SB
#undef PG8_STAGE
#undef PG8_STAGE_A
#undef PG8_GROWS
#undef PG8_LDA
#undef PG8_LDB
#undef PG8_MMA
#undef PG8_WAIT_V
#undef PG8_WAIT_L
#undef PG8_BAR
#undef PG8_SCHED
}
typedef unsigned u32x2e __attribute__((ext_vector_type(2)));
struct EpiPlain {
    static constexpr bool PERM = true, AFTER_DRAIN = false, ADJ = false;
    bf16_t* O; int ldc; float scale;
    __device__ __forceinline__ void operator()(const f32x4 (&acc)[2][2][4][2], const Unit& u, int wr, int wc, int fr, int fq) const {
        const int row0 = u.pm * BM + wr * 64 + fr, col0 = u.pn * BM + wc * 32 + 8 * fq;
        float one = scale; asm volatile("" : "+v"(one));
#pragma unroll
        for (int ai = 0; ai < 2; ++ai)
#pragma unroll
            for (int m = 0; m < 4; ++m) { bf16_t* rowp = O + (size_t)(row0 + ai * HALF + m * 16) * ldc + col0;
#pragma unroll
                for (int bj = 0; bj < 2; ++bj) { const f32x4 v0 = acc[ai][bj][m][0] * one, v1 = acc[ai][bj][m][1] * one;
                    u32x4 w; w.x = cvt_pk_bf16(v0[0], v0[1]); w.y = cvt_pk_bf16(v0[2], v0[3]); w.z = cvt_pk_bf16(v1[0], v1[1]); w.w = cvt_pk_bf16(v1[2], v1[3]);
                    *(u32x4*)(rowp + bj * HALF) = w; } }
    }
};
struct EpiF8 {
    static constexpr bool PERM = true, AFTER_DRAIN = false, ADJ = false;
    unsigned char* O; int ldc; float scale;
    __device__ __forceinline__ void operator()(const f32x4 (&acc)[2][2][4][2], const Unit& u, int wr, int wc, int fr, int fq) const {
        const int row0 = u.pm * BM + wr * 64 + fr, col0 = u.pn * BM + wc * 32 + 8 * fq;
        float one = scale; asm volatile("" : "+v"(one));
#pragma unroll
        for (int ai = 0; ai < 2; ++ai)
#pragma unroll
            for (int m = 0; m < 4; ++m) { unsigned char* rowp = O + (size_t)(row0 + ai * HALF + m * 16) * ldc + col0;
#pragma unroll
                for (int bj = 0; bj < 2; ++bj) { const f32x4 v0 = acc[ai][bj][m][0] * one, v1 = acc[ai][bj][m][1] * one;
                    u32x2e w; { int t = __builtin_amdgcn_cvt_pk_fp8_f32(v0[0], v0[1], 0, false); t = __builtin_amdgcn_cvt_pk_fp8_f32(v0[2], v0[3], t, true); w.x = (unsigned)t; }
                    { int t = __builtin_amdgcn_cvt_pk_fp8_f32(v1[0], v1[1], 0, false); t = __builtin_amdgcn_cvt_pk_fp8_f32(v1[2], v1[3], t, true); w.y = (unsigned)t; }
                    *(u32x2e*)(rowp + bj * HALF) = w; } }
    }
};
struct EpiInProj {
    static constexpr bool PERM = true, AFTER_DRAIN = false, ADJ = true;
    bf16_t* O; int ldc; const float* rope; int rope_lo, rope_hi, lat_rows; float scale;
    __device__ __forceinline__ void operator()(const f32x4 (&acc)[2][2][4][2], const Unit& u, int wr, int wc, int fr, int fq) const {
        const int hi8 = fr >> 3;
        const int row0 = u.pm * BM + wr * 64 + (fr & 7), col0 = u.pn * BM + wc * 64 + hi8 * 32 + 8 * fq;
        const bool do_rope = (u.pn >= rope_lo) && (u.pn < rope_hi) && (u.pm * BM < lat_rows);
        const int half = wc & 1;
        float one = scale; asm volatile("" : "+v"(one));
#pragma unroll
        for (int ai = 0; ai < 2; ++ai)
#pragma unroll
            for (int m = 0; m < 4; ++m) { const int row = u.pm * BM + wr * 64 + fr + ai * HALF + m * 16;
                u32x4 w[2];
#pragma unroll
                for (int bj = 0; bj < 2; ++bj) { f32x4 v0 = acc[ai][bj][m][0] * one, v1 = acc[ai][bj][m][1] * one;
                    if (do_rope) { const int s = row & 8191, pos = half ? (s & 63) : (s >> 6); const f32x4* tp = (const f32x4*)(rope + (size_t)(pos * 32 + 16 * bj + 4 * fq) * 2); const f32x4 cs0 = tp[0], cs1 = tp[1];
                        const f32x4 a = v0, b = v1;
                        v0[0] = a[0] * cs0[0] - a[1] * cs0[1]; v0[1] = a[1] * cs0[0] + a[0] * cs0[1];
                        v0[2] = a[2] * cs0[2] - a[3] * cs0[3]; v0[3] = a[3] * cs0[2] + a[2] * cs0[3];
                        v1[0] = b[0] * cs1[0] - b[1] * cs1[1]; v1[1] = b[1] * cs1[0] + b[0] * cs1[1];
                        v1[2] = b[2] * cs1[2] - b[3] * cs1[3]; v1[3] = b[3] * cs1[2] + b[2] * cs1[3];
                    }
                    w[bj].x = cvt_pk_bf16(v0[0], v0[1]); w[bj].y = cvt_pk_bf16(v0[2], v0[3]); w[bj].z = cvt_pk_bf16(v1[0], v1[1]); w[bj].w = cvt_pk_bf16(v1[2], v1[3]); }
                const u32x4 snd = hi8 ? w[0] : w[1]; u32x4 got;
                got.x = (unsigned)__builtin_amdgcn_update_dpp(0, (int)snd.x, 0x128, 0xF, 0xF, false); got.y = (unsigned)__builtin_amdgcn_update_dpp(0, (int)snd.y, 0x128, 0xF, 0xF, false);
                got.z = (unsigned)__builtin_amdgcn_update_dpp(0, (int)snd.z, 0x128, 0xF, 0xF, false); got.w = (unsigned)__builtin_amdgcn_update_dpp(0, (int)snd.w, 0x128, 0xF, 0xF, false);
                bf16_t* rowp = O + (size_t)(row0 + ai * HALF + m * 16) * ldc + col0;
                *(u32x4*)rowp = hi8 ? got : w[0];
                *(u32x4*)(rowp + (size_t)8 * ldc) = hi8 ? w[1] : got; }
    }
};
struct EpiRes {
    static constexpr bool PERM = true, AFTER_DRAIN = false, ADJ = false;
    const void* xin; bf16_t* xout; const void* cin; bf16_t* cout; const float* gate;
    int ldc, lat_rows, gstride; float scale; int in_f32;
    __device__ __forceinline__ void operator()(const f32x4 (&acc)[2][2][4][2], const Unit& u, int wr, int wc, int fr, int fq) const {
        const int row0 = u.pm * BM + wr * 64 + fr, col0 = u.pn * BM + wc * 32 + 8 * fq;
        const bool isc = u.pm * BM >= lat_rows;
        const int vs = isc ? 2 : ((u.pm * BM) >> 13), rsub = isc ? lat_rows : 0;
        const void* bp = isc ? cin : xin; bf16_t* op = isc ? cout : xout;
        f32x4 gv[2][2];
#pragma unroll
        for (int bj = 0; bj < 2; ++bj)
#pragma unroll
            for (int n = 0; n < 2; ++n) { typedef int i32x4 __attribute__((ext_vector_type(4))); const i32x4 q = *(const i32x4*)(gate + (size_t)vs * gstride + col0 + bj * HALF + 4 * n);
                gv[bj][n] = (f32x4){(float)q[0], (float)q[1], (float)q[2], (float)q[3]} * (scale * (1.f / 16777216.f)); }
#pragma unroll
        for (int ai = 0; ai < 2; ++ai)
#pragma unroll
        for (int mh = 0; mh < 2; ++mh) {
            if (in_f32) {
                f32x4 bb[2][2][2];
#pragma unroll
                for (int mm = 0; mm < 2; ++mm)
#pragma unroll
                    for (int bj = 0; bj < 2; ++bj) { const float* q = (const float*)bp + (size_t)(row0 - rsub + ai * HALF + (2 * mh + mm) * 16) * ldc + col0 + bj * HALF; bb[mm][bj][0] = __builtin_nontemporal_load((const f32x4*)q); bb[mm][bj][1] = __builtin_nontemporal_load((const f32x4*)(q + 4)); }
#pragma unroll
                for (int mm = 0; mm < 2; ++mm)
#pragma unroll
                    for (int bj = 0; bj < 2; ++bj) { const int m = 2 * mh + mm; const size_t off = (size_t)(row0 - rsub + ai * HALF + m * 16) * ldc + col0 + bj * HALF;
                        const f32x4 o0 = bb[mm][bj][0] + gv[bj][0] * acc[ai][bj][m][0], o1 = bb[mm][bj][1] + gv[bj][1] * acc[ai][bj][m][1];
                        u32x4 w; w.x = cvt_pk_bf16(o0[0], o0[1]); w.y = cvt_pk_bf16(o0[2], o0[3]); w.z = cvt_pk_bf16(o1[0], o1[1]); w.w = cvt_pk_bf16(o1[2], o1[3]);
                        *(u32x4*)(op + off) = w; }
            } else {
                u32x4 bw[2][2];
#pragma unroll
                for (int mm = 0; mm < 2; ++mm)
#pragma unroll
                    for (int bj = 0; bj < 2; ++bj) bw[mm][bj] = *(const u32x4*)((const bf16_t*)bp + (size_t)(row0 - rsub + ai * HALF + (2 * mh + mm) * 16) * ldc + col0 + bj * HALF);
#pragma unroll
                for (int mm = 0; mm < 2; ++mm)
#pragma unroll
                    for (int bj = 0; bj < 2; ++bj) { const int m = 2 * mh + mm; const size_t off = (size_t)(row0 - rsub + ai * HALF + m * 16) * ldc + col0 + bj * HALF; const u32x4 w0 = bw[mm][bj];
                        const f32x4 b0 = (f32x4){__builtin_bit_cast(float, w0.x << 16), __builtin_bit_cast(float, w0.x & 0xffff0000u), __builtin_bit_cast(float, w0.y << 16), __builtin_bit_cast(float, w0.y & 0xffff0000u)};
                        const f32x4 b1 = (f32x4){__builtin_bit_cast(float, w0.z << 16), __builtin_bit_cast(float, w0.z & 0xffff0000u), __builtin_bit_cast(float, w0.w << 16), __builtin_bit_cast(float, w0.w & 0xffff0000u)};
                        const f32x4 o0 = b0 + gv[bj][0] * acc[ai][bj][m][0], o1 = b1 + gv[bj][1] * acc[ai][bj][m][1];
                        u32x4 w; w.x = cvt_pk_bf16(o0[0], o0[1]); w.y = cvt_pk_bf16(o0[2], o0[3]); w.z = cvt_pk_bf16(o1[0], o1[1]); w.w = cvt_pk_bf16(o1[2], o1[3]);
                        *(u32x4*)(op + off) = w; }
            }
        }
    }
};
__device__ __forceinline__ unsigned pack4_fp8(float a, float b, float c, float d) { int w = __builtin_amdgcn_cvt_pk_fp8_f32(a, b, 0, false); w = __builtin_amdgcn_cvt_pk_fp8_f32(c, d, w, true); return (unsigned)w; }
struct EpiGateUp {
    static constexpr bool PERM = true, AFTER_DRAIN = false, ADJ = false;
    unsigned char* O; int ldc; float wscale;
    __device__ __forceinline__ void operator()(const f32x4 (&acc)[2][2][4][2], const Unit& u, int wr, int wc, int fr, int fq) const {
        const int row0 = u.pm * BM + wr * 64 + fr, col0 = (u.pn * BM + wc * 32 + 8 * fq) >> 1;
        float ws = wscale; asm volatile("" : "+v"(ws));
#pragma unroll
        for (int ai = 0; ai < 2; ++ai)
#pragma unroll
            for (int m = 0; m < 4; ++m) { unsigned char* rowp = O + (size_t)(row0 + ai * HALF + m * 16) * ldc + col0;
#pragma unroll
                for (int bj = 0; bj < 2; ++bj) { const f32x4 g = acc[ai][bj][m][0] * ws, up = acc[ai][bj][m][1] * ws; f32x4 a;
#pragma unroll
                    for (int i = 0; i < 4; ++i) a[i] = g[i] * __builtin_amdgcn_rcpf(1.f + __expf(-g[i])) * up[i];
                    *(unsigned*)(rowp + bj * (HALF / 2)) = pack4_fp8(a[0], a[1], a[2], a[3]); } }
    }
};
template <bool SKIP, bool GATH = false> struct GroupedOrderT {
#ifndef MOE_TR
#define MOE_TR 0
#endif
#ifndef MOE_B_NT
#define MOE_B_NT 0
#endif
    static constexpr bool SKIP_HI = SKIP, GATHER = GATH, B_NT = MOE_B_NT != 0;
    static constexpr int nN = 8;
    int G, c, nblk; const PG8_LAS int* blk_e; const PG8_LAS int* blk_h; long estride; const PG8_LAS unsigned* rowtab;
    __device__ __forceinline__ bool next(int i, Unit& u) const {
        const int L = i * G + c; if (L >= nblk * nN) return false;
#if MOE_TR
        {
            const int full = (nblk >> 3) << 6; if (L < full) { const int j = L & 63; u.pm = ((L >> 6) << 3) + (j & 7); u.pn = j >> 3; } else { u.pm = L >> 3; u.pn = L & 7; } }
#else
        u.pm = L >> 3; u.pn = L & 7;
#endif
        u.boff = (long)__builtin_amdgcn_readfirstlane(blk_e[u.pm]) * estride; u.lo_only = __builtin_amdgcn_readfirstlane(blk_h[u.pm]); return true;
    }
    __device__ __forceinline__ void a_ready(const Unit&) const {}
    __device__ __forceinline__ void done(const Unit&) const {}
};
}
constexpr int DM = 2048, T_LAT = 16384, T_CTX = 512, T_ALL = 16896, SEQL = 8192, CTXL = 256;
constexpr int NIN = 5152, NINP = 5376;
constexpr int C_QA = 0, C_KA = 512, C_VA = 1024, C_QB = 1536, C_KB = 2048, C_VB = 2304, C_Z = 2560, C_XBC = 3584, C_DT = 5120;
constexpr int XBCW = 1536, DFF = 1024, NEXP = 32, MODW = 12288;
constexpr float EPS = 1e-6f, ATT_SCALE = 0.088388347648318440f;
constexpr int MAXBLK = 165, MAXSLOT = MAXBLK * 256;
constexpr int NWAVES = 8;

constexpr size_t MiB = 1u << 20;
constexpr size_t WS_CTL = 0, CTL_ZERO_BYTES = 2 * MiB;
constexpr int CW_BAR = 4096;
constexpr size_t OFF_Q = 32768;
constexpr size_t OFF_CNT = 65536;
constexpr size_t OFF_MOD = 1 * MiB;
constexpr size_t WS_ROPE = 2 * MiB;
constexpr size_t WS_WRT = 3 * MiB;
constexpr size_t WS_WIN = 8 * MiB;
constexpr size_t WS_WOUT = 50 * MiB;
constexpr size_t WS_WGU = 66 * MiB;
constexpr size_t WS_WDN = 578 * MiB;
constexpr size_t WS_H = 834 * MiB;
constexpr size_t WS_U = 900 * MiB;
constexpr size_t WS_X = 1074 * MiB;
constexpr size_t WS_XC = 1202 * MiB;
constexpr size_t WS_XBC = 1206 * MiB;
constexpr size_t WS_DT = 1256 * MiB;
constexpr size_t WS_YD = 1260 * MiB;
constexpr size_t WS_XG = 1392 * MiB;
constexpr size_t WS_ACT = 1557 * MiB;
constexpr size_t WS_YB = 1640 * MiB;
constexpr size_t WS_TOK = 1805 * MiB;
constexpr size_t WS_END = 1808 * MiB;
constexpr size_t WS_LIST = WS_XG + 64 * MiB;
constexpr int LCAP = 2 * T_ALL;
constexpr unsigned ZERO_OFF = 1536u * 1024u;
constexpr size_t TOKTAB = (size_t)T_ALL * 2 * 4;
static_assert(WS_WIN + (size_t)2 * NINP * DM * 2 <= WS_WOUT && WS_WGU + (size_t)2 * 32 * 2048 * 2048 * 2 <= WS_WDN && WS_WDN + (size_t)2 * 32 * 2048 * 1024 * 2 <= WS_H, "ws map 1");
static_assert(WS_H + (size_t)T_ALL * DM * 2 <= WS_U && WS_U + (size_t)T_ALL * NINP * 2 <= WS_X && WS_X + (size_t)T_LAT * DM * 4 <= WS_XC && WS_XBC + (size_t)T_ALL * XBCW * 2 <= WS_DT, "ws map 2");
static_assert(WS_DT + (size_t)T_ALL * 32 * 4 <= WS_YD && WS_YD + (size_t)2 * T_ALL * 1024 * 4 <= WS_XG && WS_XG + (size_t)MAXSLOT * DM * 2 <= WS_ACT && WS_ACT + (size_t)MAXSLOT * DFF * 2 <= WS_YB && WS_YB + (size_t)MAXSLOT * DM * 2 <= WS_TOK && WS_TOK + 4 * TOKTAB <= WS_END, "ws map 3");

constexpr int RING_BYTES = 131072, LDSCTL_OFF = RING_BYTES, LDS_BYTES = 147456;
constexpr int L_BARW = LDSCTL_OFF;
constexpr int L_BWORK = LDSCTL_OFF + 32;
constexpr int L_SEG = LDSCTL_OFF + 64;
constexpr int L_CNT = LDSCTL_OFF + 256;
constexpr int L_BLKE = LDSCTL_OFF + 512;
constexpr int L_NBLK = LDSCTL_OFF + 1536;
constexpr int L_INCL = LDSCTL_OFF + 1600;
constexpr int L_PB = LDSCTL_OFF + 1792;
constexpr int L_ROWT = LDSCTL_OFF + 4096;
constexpr int L_BLKH = LDSCTL_OFF + 2048;

#define GAS __attribute__((address_space(1)))
#define LAS __attribute__((address_space(3)))
typedef unsigned short bf16;
typedef unsigned v4u __attribute__((ext_vector_type(4)));
typedef unsigned v2u __attribute__((ext_vector_type(2)));
typedef float f32x4 __attribute__((ext_vector_type(4)));
typedef float f32x2 __attribute__((ext_vector_type(2)));
typedef short bf16x8 __attribute__((ext_vector_type(8)));
#define LDS_WAIT() asm volatile("s_waitcnt lgkmcnt(0)" ::: "memory")
#define VM_WAIT() asm volatile("s_waitcnt vmcnt(0)" ::: "memory")
__device__ __forceinline__ unsigned f2bf(float f) { unsigned u = __builtin_bit_cast(unsigned, f); return (u + 0x7fffu + ((u >> 16) & 1u)) >> 16; }
__device__ __forceinline__ unsigned pk2(float lo, float hi) { return f2bf(lo) | (f2bf(hi) << 16); }
__device__ __forceinline__ float bflo(unsigned w) { return __builtin_bit_cast(float, w << 16); }
__device__ __forceinline__ float bfhi(unsigned w) { return __builtin_bit_cast(float, w & 0xffff0000u); }
__device__ __forceinline__ float bf2f(bf16 b) { return __builtin_bit_cast(float, (unsigned)b << 16); }
__device__ __forceinline__ float wave_sum(float v) {
#pragma unroll
    for (int o = 1; o < 64; o <<= 1) v += __shfl_xor(v, o);
    return v;
}
__device__ __forceinline__ float wave_max(float v) {
#pragma unroll
    for (int o = 1; o < 64; o <<= 1) v = fmaxf(v, __shfl_xor(v, o));
    return v;
}
__device__ __forceinline__ float silu_f(float x) { return x / (1.f + __expf(-x)); }
__device__ __forceinline__ float sigmoid_f(float x) { return 1.f / (1.f + __expf(-x)); }
__device__ __forceinline__ float softplus_f(float x) { return x > 20.f ? x : log1pf(__expf(x)); }

#define XB_TMO      128
#define XB_XCNT(j)  (256  + 64 * (j))
#define XB_XSUB(j)  (1280 + 64 * (j))
#define XB_XGEN(j)  (2304 + 64 * (j))
#define XB_TOP      3328
#define XB_TOPGEN   3392
#define XCD_BAR_WORDS 3456
#define XB_SPIN_CAP (1u << 18)


__device__ __forceinline__ unsigned xb_ld(unsigned* p)              { return __hip_atomic_load(p, __ATOMIC_RELAXED, __HIP_MEMORY_SCOPE_AGENT); }
__device__ __forceinline__ unsigned xb_add(unsigned* p, unsigned v) { return __hip_atomic_fetch_add(p, v, __ATOMIC_RELAXED, __HIP_MEMORY_SCOPE_AGENT); }
__device__ __forceinline__ unsigned xb_xcc_id() { return (unsigned)__builtin_amdgcn_s_getreg((3 << 11) | 20) & 0xFu; }
#define XB_SPIN(cond, bar) do { unsigned _sp = 0; while (cond) { __builtin_amdgcn_s_sleep(1); \
    if ((++_sp & 255u) == 0u) { if (xb_ld(&(bar)[XB_TMO])) break; if (_sp > XB_SPIN_CAP) { atomicAdd(&(bar)[XB_TMO], 1u); break; } } } } while (0)

struct XcdBarrier {
    unsigned* bar; unsigned x;
    volatile LAS unsigned* st;
};

__device__ __forceinline__ XcdBarrier xcd_barrier_post(unsigned* bar, volatile LAS unsigned* st) {
    XcdBarrier b; b.bar = bar; b.x = xb_xcc_id(); b.st = st;
    if (threadIdx.x == 0) (void)xb_add(&bar[XB_XCNT(b.x)], 1u);
    return b;
}
__device__ __forceinline__ void xcd_barrier_complete(unsigned* bar, unsigned x, unsigned& nloc, unsigned& nx) {
    const unsigned G = gridDim.x * gridDim.y * gridDim.z;
    unsigned sum, cnt, mine, sp = 0u, cv[16];
    for (;;) {
        sum = 0u; cnt = 0u; mine = 0u;
#pragma unroll
        for (unsigned j = 0; j < 16; ++j) cv[j] = xb_ld(&bar[XB_XCNT(j)]);
#pragma unroll
        for (unsigned j = 0; j < 16; ++j) { const unsigned c = cv[j]; sum += c; cnt += (c > 0u) ? 1u : 0u; mine = (j == x) ? c : mine; }
        if (sum == G) break;
        __builtin_amdgcn_s_sleep(1);
        if ((++sp & 255u) == 0u) { if (xb_ld(&bar[XB_TMO])) break; if (sp > XB_SPIN_CAP) { atomicAdd(&bar[XB_TMO], 1u); break; } }
    }
    nloc = mine > 0u ? mine : 1u; nx = cnt > 0u ? cnt : 1u;
}

__device__ __forceinline__ void xcd_barrier(const XcdBarrier& b) {
    asm volatile("s_waitcnt vmcnt(0)" ::: "memory");
    __syncthreads();
    if (threadIdx.x == 0) {
        unsigned* bar = b.bar;
        __builtin_amdgcn_s_waitcnt(0);
        unsigned nloc = b.st[0], nx = b.st[1];
        if (nloc == 0u) { xcd_barrier_complete(bar, b.x, nloc, nx); b.st[0] = nloc; b.st[1] = nx; }
        const unsigned old = xb_add(&bar[XB_XSUB(b.x)], 1u);
        const unsigned gen = old / nloc;
        if (old + 1u == (gen + 1u) * nloc) {
            __builtin_amdgcn_fence(__ATOMIC_RELEASE, "agent");
            asm volatile("s_waitcnt vmcnt(0)" ::: "memory");
            const unsigned og = xb_add(&bar[XB_TOP], 1u);
            const unsigned tg = og / nx;
            if (og + 1u == (tg + 1u) * nx) xb_add(&bar[XB_TOPGEN], 1u);
            else XB_SPIN(xb_ld(&bar[XB_TOPGEN]) == tg, bar);
            __builtin_amdgcn_fence(__ATOMIC_ACQUIRE, "agent");
            xb_add(&bar[XB_XGEN(b.x)], 1u);
            asm volatile("s_waitcnt vmcnt(0)" ::: "memory");
        } else {
            XB_SPIN(xb_ld(&bar[XB_XGEN(b.x)]) == gen, bar);
            __builtin_amdgcn_fence(__ATOMIC_ACQUIRE, "agent");
            asm volatile("s_waitcnt vmcnt(0)" ::: "memory");
        }
    }
    __syncthreads();
}
struct Prm {
    const float *x, *c, *ctx, *c_ctx, *w_ada, *b_ada, *norm_mix, *norm_ffn, *norm_final, *w_in, *w_out, *na_rpb, *wa_sink,
                *conv_w, *conv_b, *a_log, *dt_bias, *d_skip, *ssd_norm, *w_router, *router_bias, *w_gate, *w_up, *w_down;
    float* out; unsigned char* ws; int ph_lo, ph_hi;
};

__device__ __forceinline__ int perm_in(int n) {
    if (n >= C_QB && n < C_VB) { const int p = (n - C_QB) & 127, hb = n - p, half = p >> 6, pp = p & 63; return hb + half * 64 + (pp >> 1) + 32 * (pp & 1); }
    return n;
}
__device__ __forceinline__ unsigned pack4f8(float a, float b, float c, float d) { int w = __builtin_amdgcn_cvt_pk_fp8_f32(a, b, 0, false); w = __builtin_amdgcn_cvt_pk_fp8_f32(c, d, w, true); return (unsigned)w; }
#ifndef CONV_QUEUE
#define CONV_QUEUE 1
#endif
constexpr float W8_SCALE = 64.f, MIX_SCALE = 8.f, Y8_SCALE = 8.f;
struct TDesc { const float* colp; size_t ld; unsigned char* wt; int ok, k0, K, n0; };
constexpr int TK_IN = 2 * 32 * (NINP / 32), TK_OUT = 2 * 32 * 64, TK_GU = 2 * 32 * 32 * 64, TK_DN = 2 * 32 * 16 * 64, TK_RT = 32;
template <bool F8SEL> __device__ __forceinline__ constexpr int t_count() {
    return ((F8_INPROJ != 0) == F8SEL ? TK_IN : 0) + ((F8_OUTPROJ != 0) == F8SEL ? TK_OUT : 0) + (F8SEL ? TK_GU + TK_DN : TK_RT);
}
template <bool F8SEL> __device__ __forceinline__ TDesc t_decode(const Prm& p, int it, int lane) {
    unsigned char* ws = p.ws; TDesc d; int r = it;
    if ((F8_INPROJ != 0) == F8SEL) { if (r < TK_IN) { const int sub = r & 1, r2 = r >> 1, l = r2 / (TK_IN / 4), q = r2 % (TK_IN / 4), kb = 2 * (q / (NINP / 32)) + sub, nb = q % (NINP / 32), nn = 32 * nb + (lane & 31); const bool ok = nn < NIN;
            d.colp = p.w_in + (size_t)l * DM * NIN + (ok ? perm_in(nn) : 0); d.ld = NIN; d.ok = ok; d.K = 2048; d.wt = ws + WS_WIN + (size_t)l * NINP * DM * (F8_INPROJ ? 1 : 2); d.n0 = 32 * nb; d.k0 = 64 * kb; return d; } r -= TK_IN; }
    if ((F8_OUTPROJ != 0) == F8SEL) { if (r < TK_OUT) { const int sub = r & 1, r2 = r >> 1, l = r2 / (TK_OUT / 4), q = r2 % (TK_OUT / 4), kb = 2 * (q / 64) + sub, nb = q % 64, nn = 32 * nb + (lane & 31);
            d.colp = p.w_out + (size_t)l * DM * DM + nn; d.ld = DM; d.ok = 1; d.K = 2048; d.wt = ws + WS_WOUT + (size_t)l * DM * DM * (F8_OUTPROJ ? 1 : 2); d.n0 = 32 * nb; d.k0 = 64 * kb; return d; } r -= TK_OUT; }
    if (F8SEL) {
        if (r < TK_GU) { const int sub = r & 1, r2 = r >> 1, le = r2 / 1024, q = r2 % 1024, kb = 2 * (q / 64) + sub, nb = q % 64, nn = 32 * nb + (lane & 31), j = nn >> 3, t = nn & 7;
            d.colp = (t < 4 ? p.w_gate : p.w_up) + (size_t)le * 2048 * 1024 + 4 * j + (t & 3); d.ld = 1024; d.ok = 1; d.K = 2048; d.wt = ws + WS_WGU + (size_t)le * 2048 * 2048; d.n0 = 32 * nb; d.k0 = 64 * kb; return d; }
        r -= TK_GU;
        { const int sub = r & 1, r2 = r >> 1, le = r2 / 512, q = r2 % 512, kb = 2 * (q / 64) + sub, nb = q % 64, nn = 32 * nb + (lane & 31);
            d.colp = p.w_down + (size_t)le * 1024 * 2048 + nn; d.ld = 2048; d.ok = 1; d.K = 1024; d.wt = ws + WS_WDN + (size_t)le * 2048 * 1024; d.n0 = 32 * nb; d.k0 = 64 * kb; return d; }
    } else { const int kb = r; d.colp = p.w_router + (lane & 31); d.ld = 32; d.ok = 1; d.K = 2048; d.wt = ws + WS_WRT; d.n0 = 0; d.k0 = 64 * kb; return d; }
}
__device__ __forceinline__ void t_load(const TDesc& d, float (&tv)[32], int lane) {
#pragma unroll
    for (int i = 0; i < 32; ++i) tv[i] = __builtin_nontemporal_load(d.colp + (size_t)(d.k0 + 2 * i + (lane >> 5)) * d.ld);
}
template <bool F8> __device__ __forceinline__ void t_lds_in(const TDesc& d, const float (&tv)[32], LAS float* scr, int lane) {
#pragma unroll
    for (int i = 0; i < 32; ++i) scr[(2 * i + (lane >> 5)) * 33 + (lane & 31)] = d.ok ? tv[i] : 0.f;
    LDS_WAIT(); asm volatile("" ::: "memory");
}
template <bool F8> __device__ __forceinline__ void t_out(const TDesc& d, LAS float* scr, int lane) {
    const int c = lane & 7;
#pragma unroll
    for (int j = 0; j < 4; ++j) { const int n = (lane >> 3) + 8 * j; const LAS float* s = scr + (8 * c) * 33 + n;
        if constexpr (F8) { v2u o; o.x = pack4f8(s[0 * 33] * W8_SCALE, s[1 * 33] * W8_SCALE, s[2 * 33] * W8_SCALE, s[3 * 33] * W8_SCALE); o.y = pack4f8(s[4 * 33] * W8_SCALE, s[5 * 33] * W8_SCALE, s[6 * 33] * W8_SCALE, s[7 * 33] * W8_SCALE);
            *(v2u*)(d.wt + (size_t)(d.n0 + n) * d.K + d.k0 + 8 * c) = o; }
        else { v4u o; o.x = pk2(s[0 * 33], s[1 * 33]); o.y = pk2(s[2 * 33], s[3 * 33]); o.z = pk2(s[4 * 33], s[5 * 33]); o.w = pk2(s[6 * 33], s[7 * 33]);
            *(v4u*)((bf16*)d.wt + (size_t)(d.n0 + n) * d.K + d.k0 + 8 * c) = o; } }
    LDS_WAIT(); asm volatile("" ::: "memory");
}
__device__ __forceinline__ void t_cvt8(LAS float* scr, int lane, v2u (&o)[4]) {
    const int c = lane & 7;
#pragma unroll
    for (int j = 0; j < 4; ++j) { const int n = (lane >> 3) + 8 * j; const LAS float* s = scr + (8 * c) * 33 + n;
        o[j].x = pack4f8(s[0 * 33] * W8_SCALE, s[1 * 33] * W8_SCALE, s[2 * 33] * W8_SCALE, s[3 * 33] * W8_SCALE); o[j].y = pack4f8(s[4 * 33] * W8_SCALE, s[5 * 33] * W8_SCALE, s[6 * 33] * W8_SCALE, s[7 * 33] * W8_SCALE); }
    LDS_WAIT(); asm volatile("" ::: "memory");
}
constexpr int TL_IN = 32 * (NINP / 32), TL_OUT = 32 * 64, TL_GU = 32 * 32 * 64, TL_DN = 32 * 16 * 64, TL_ALL = TL_IN + TL_OUT + TL_GU + TL_DN, NPL = TL_ALL / 2;
static_assert(F8_INPROJ && F8_OUTPROJ, "the per-layer conversion queue assumes fp8 copies of every GEMM weight");
__device__ __forceinline__ TDesc t_decode_layer(const Prm& p, int l, int it, int lane) {
    unsigned char* ws = p.ws; TDesc d; int r = it; const int sub = r & 1;
    if (r < TL_IN) { const int q = r >> 1, kb = 2 * (q / (NINP / 32)) + sub, nb = q % (NINP / 32), nn = 32 * nb + (lane & 31); const bool ok = nn < NIN;
        d.colp = p.w_in + (size_t)l * DM * NIN + (ok ? perm_in(nn) : 0); d.ld = NIN; d.ok = ok; d.K = 2048; d.wt = ws + WS_WIN + (size_t)l * NINP * DM; d.n0 = 32 * nb; d.k0 = 64 * kb; return d; }
    r -= TL_IN;
    if (r < TL_OUT) { const int q = r >> 1, kb = 2 * (q / 64) + sub, nb = q % 64, nn = 32 * nb + (lane & 31);
        d.colp = p.w_out + (size_t)l * DM * DM + nn; d.ld = DM; d.ok = 1; d.K = 2048; d.wt = ws + WS_WOUT + (size_t)l * DM * DM; d.n0 = 32 * nb; d.k0 = 64 * kb; return d; }
    r -= TL_OUT;
    if (r < TL_GU) { const int r2 = r >> 1, le = l * 32 + r2 / 1024, q = r2 % 1024, kb = 2 * (q / 64) + sub, nb = q % 64, nn = 32 * nb + (lane & 31), j = nn >> 3, t = nn & 7;
        d.colp = (t < 4 ? p.w_gate : p.w_up) + (size_t)le * 2048 * 1024 + 4 * j + (t & 3); d.ld = 1024; d.ok = 1; d.K = 2048; d.wt = ws + WS_WGU + (size_t)le * 2048 * 2048; d.n0 = 32 * nb; d.k0 = 64 * kb; return d; }
    r -= TL_GU;
    { const int r2 = r >> 1, le = l * 32 + r2 / 512, q = r2 % 512, kb = 2 * (q / 64) + sub, nb = q % 64, nn = 32 * nb + (lane & 31);
        d.colp = p.w_down + (size_t)le * 1024 * 2048 + nn; d.ld = 2048; d.ok = 1; d.K = 1024; d.wt = ws + WS_WDN + (size_t)le * 2048 * 1024; d.n0 = 32 * nb; d.k0 = 64 * kb; return d; }
}
__device__ __forceinline__ void t_pair_store(const TDesc& dS, const v2u (&oa)[4], const v2u (&ob)[4], int lane) {
    const int c = lane & 7, odd = c & 1;
#pragma unroll
    for (int j = 0; j < 4; ++j) { const int n = (lane >> 3) + 8 * j;
        const v2u snd = odd ? oa[j] : ob[j]; v2u got; got.x = (unsigned)__builtin_amdgcn_update_dpp(0, (int)snd.x, 0xB1, 0xF, 0xF, false); got.y = (unsigned)__builtin_amdgcn_update_dpp(0, (int)snd.y, 0xB1, 0xF, 0xF, false);
        v4u w; if (odd) { w.x = got.x; w.y = got.y; w.z = ob[j].x; w.w = ob[j].y; } else { w.x = oa[j].x; w.y = oa[j].y; w.z = got.x; w.w = got.y; }
        __builtin_nontemporal_store(w, (v4u*)(dS.wt + (size_t)(dS.n0 + n) * dS.K + dS.k0 + (odd ? 64 : 0) + 16 * (c >> 1))); }

}
#ifndef Q_L0EXP
#define Q_L0EXP 1
#endif
constexpr int NP_PROJ = (TL_IN + TL_OUT) / 2, NP_EXP = (TL_GU + TL_DN) / 2;
__device__ __forceinline__ void t_convert_pairs(const Prm& p, int l, int npairs, LAS float* scr, int gw, int ngw, int lane) {
    if (gw >= npairs) return;
    TDesc dA = t_decode_layer(p, l, 2 * gw, lane), dB = t_decode_layer(p, l, 2 * gw + 1, lane); float ta[32], tb[32]; t_load(dA, ta, lane); t_load(dB, tb, lane);
#pragma unroll 1
    for (int pi = gw; pi < npairs; pi += ngw) {
        v2u oa[4], ob[4];
        t_lds_in<true>(dA, ta, scr, lane); t_cvt8(scr, lane, oa);
        t_lds_in<true>(dB, tb, scr, lane);
        const TDesc dS = dA; const int pn = pi + ngw;
        if (pn < npairs) { dA = t_decode_layer(p, l, 2 * pn, lane); dB = t_decode_layer(p, l, 2 * pn + 1, lane); t_load(dA, ta, lane); t_load(dB, tb, lane); }
        t_cvt8(scr, lane, ob);
        t_pair_store(dS, oa, ob, lane);
    }
}
__device__ __forceinline__ void t_convert_two(const Prm& p, int l, int pi0, int l1, int pi1, bool has1, LAS float* scr, int lane) {
    const TDesc dA = t_decode_layer(p, l, 2 * pi0, lane), dB = t_decode_layer(p, l, 2 * pi0 + 1, lane), dC = t_decode_layer(p, l1, 2 * pi1, lane), dD = t_decode_layer(p, l1, 2 * pi1 + 1, lane);
    float ta[32], tb[32], tc[32], td[32]; t_load(dA, ta, lane); t_load(dB, tb, lane); t_load(dC, tc, lane); t_load(dD, td, lane);
    v2u oa[4], ob[4];
    t_lds_in<true>(dA, ta, scr, lane); t_cvt8(scr, lane, oa);
    t_lds_in<true>(dB, tb, scr, lane); t_cvt8(scr, lane, ob);
    t_pair_store(dA, oa, ob, lane);
    if (has1) {
        t_lds_in<true>(dC, tc, scr, lane); t_cvt8(scr, lane, oa);
        t_lds_in<true>(dD, td, scr, lane); t_cvt8(scr, lane, ob);
        t_pair_store(dC, oa, ob, lane);
    }
}
__device__ __forceinline__ void t_convert_one(const Prm& p, int l, int pi, LAS float* scr, int lane) {
    const TDesc dA = t_decode_layer(p, l, 2 * pi, lane), dB = t_decode_layer(p, l, 2 * pi + 1, lane); float ta[32], tb[32]; t_load(dA, ta, lane); t_load(dB, tb, lane);
    v2u oa[4], ob[4];
    t_lds_in<true>(dA, ta, scr, lane); t_cvt8(scr, lane, oa);
    t_lds_in<true>(dB, tb, scr, lane); t_cvt8(scr, lane, ob);
    t_pair_store(dA, oa, ob, lane);
}
template <bool F8SEL> __device__ __forceinline__ void t_convert_all(const Prm& p, LAS float* scr, int gw, int ngw, int lane) {
    constexpr int N = t_count<F8SEL>();
    if (2 * gw >= N) return;
    TDesc d0 = t_decode<F8SEL>(p, 2 * gw, lane); float tv[32]; t_load(d0, tv, lane);
#pragma unroll 1
    for (int it = 2 * gw; it < N; ) {
        t_lds_in<F8SEL>(d0, tv, scr, lane);
        const int itn = (it & 1) ? it - 1 + 2 * ngw : it + 1; TDesc d1 = d0;
        if (itn < N) { d1 = t_decode<F8SEL>(p, itn, lane); t_load(d1, tv, lane); }
        t_out<F8SEL>(d0, scr, lane);
        d0 = d1; it = itn;
    }
}
#ifndef MODP_NC0
#define MODP_NC0 48
#endif
#ifndef MODP_NC1
#define MODP_NC1 48
#endif
#ifndef MPK
#define MPK 64
#endif
constexpr int MODP_ITEMS0 = (DM / MPK) * MODP_NC0, MODP_ITEMS = MODP_ITEMS0 + (DM / MPK) * MODP_NC1;
constexpr int MQK = 32, MQ_PER = DM / MQK;
constexpr int MODQ0 = MQ_PER * (48 - MODP_NC0), MODQ = MODQ0 + MQ_PER * (48 - MODP_NC1);
static_assert(MODQ % 16 == 0, "mods queue items come in grabs of 16");
template <int NK> __device__ __forceinline__ void mods_item(const Prm& p, int l, int k0, int nc, LAS float* scr, int lane) {
    int* mod = (int*)(p.ws + OFF_MOD);
    const int n0 = 256 * nc + 4 * lane;
    for (int i = lane; i < NK; i += 64) { scr[i] = silu_f(p.c[k0 + i]); scr[NK + i] = silu_f(p.c[DM + k0 + i]); scr[2 * NK + i] = silu_f(p.c_ctx[k0 + i]); }
    LDS_WAIT(); asm volatile("" ::: "memory");
    f32x4 a0 = {0.f, 0.f, 0.f, 0.f}, a1 = a0, a2 = a0;
    const float* wp = p.w_ada + ((size_t)l * DM + k0) * MODW + n0;
    if constexpr (NK >= 64) {
#pragma unroll 8
    for (int kk = 0; kk < NK; ++kk) { const f32x4 w = __builtin_nontemporal_load((const f32x4*)(wp + (size_t)kk * MODW)); a0 += w * scr[kk]; a1 += w * scr[NK + kk]; a2 += w * scr[2 * NK + kk]; }
    } else {
#pragma unroll 16
    for (int kk = 0; kk < NK; ++kk) { const f32x4 w = __builtin_nontemporal_load((const f32x4*)(wp + (size_t)kk * MODW)); a0 += w * scr[kk]; a1 += w * scr[NK + kk]; a2 += w * scr[2 * NK + kk]; }
    }
    if (k0 == 0) { const f32x4 bb = *(const f32x4*)(p.b_ada + (size_t)l * MODW + n0); a0 += bb; a1 += bb; a2 += bb; }
    int* m0 = mod + (size_t)(l * 3) * MODW + n0;
#pragma unroll
    for (int i = 0; i < 4; ++i) { atomicAdd(m0 + i, (int)rintf(a0[i] * 16777216.f)); atomicAdd(m0 + MODW + i, (int)rintf(a1[i] * 16777216.f)); atomicAdd(m0 + 2 * MODW + i, (int)rintf(a2[i] * 16777216.f)); }
    LDS_WAIT(); asm volatile("" ::: "memory");
}
__device__ __forceinline__ void mods_queue_item(const Prm& p, int j, LAS float* scr, int lane) {
    constexpr int W0 = 48 - MODP_NC0 + (MODP_NC0 == 48), W1 = 48 - MODP_NC1 + (MODP_NC1 == 48);
    if (j < MODQ0) mods_item<MQK>(p, 0, MQK * (j / W0), MODP_NC0 + j % W0, scr, lane);
    else { const int q = j - MODQ0; mods_item<MQK>(p, 1, MQK * (q / W1), MODP_NC1 + q % W1, scr, lane); }
}
__device__ __forceinline__ void phase_prologue(const Prm& p, LAS unsigned char* lds, int gw, int ngw, int wave, int lane, bool first) {
    LAS float* scr = (LAS float*)(lds + wave * 16384);
    unsigned char* ws = p.ws;
    t_convert_pairs(p, 0, (CONV_QUEUE && Q_L0EXP) ? NP_PROJ : NPL, scr, gw, ngw, lane);
    if (!CONV_QUEUE) t_convert_pairs(p, 1, NPL, scr, gw, ngw, lane);
    t_convert_all<false>(p, scr, gw, ngw, lane);
    for (int it = gw; first && it < MODP_ITEMS; it += ngw) {
        if (it < MODP_ITEMS0) mods_item<MPK>(p, 0, MPK * (it / (MODP_NC0 + (MODP_NC0 == 0))), it % (MODP_NC0 + (MODP_NC0 == 0)), scr, lane);
        else { const int q = it - MODP_ITEMS0; mods_item<MPK>(p, 1, MPK * (q / (MODP_NC1 + (MODP_NC1 == 0))), q % (MODP_NC1 + (MODP_NC1 == 0)), scr, lane); } }
    for (int it = gw * 64 + lane; it < 128 * 32; it += ngw * 64) { const int pos = it >> 5, i = it & 31; const float inv = powf(10000.f, -(float)i / 32.f), ang = (float)pos * inv;
        ((float*)(ws + WS_ROPE))[2 * it] = cosf(ang); ((float*)(ws + WS_ROPE))[2 * it + 1] = sinf(ang); }
}

__device__ __forceinline__ f32x4 modv4(const float* p) {
    typedef int i32x4 __attribute__((ext_vector_type(4)));
    const i32x4 v = *(const i32x4*)p; return (f32x4){(float)v[0], (float)v[1], (float)v[2], (float)v[3]} * (1.f / 16777216.f);
}
__device__ __forceinline__ f32x4 bf4(v2u w) { return (f32x4){bflo(w.x), bfhi(w.x), bflo(w.y), bfhi(w.y)}; }
__device__ __forceinline__ void load_row(const Prm& p, int l, int lcomb, int m, int lane, f32x4 (&v)[8], bool wb = true, const LAS int* segL = nullptr) {
    const bool isc = m >= T_LAT;
    const bf16* wsrow = isc ? (const bf16*)(p.ws + WS_XC) + (size_t)(m - T_LAT) * DM : (const bf16*)(p.ws + WS_X) + (size_t)m * DM;
#pragma unroll
    for (int j = 0; j < 8; ++j) v[j] = bf4(*(const v2u*)(wsrow + 256 * j + 4 * lane));
}
__device__ __forceinline__ float row_rstd(const f32x4 (&v)[8]) {
    float s = 0.f;
#pragma unroll
    for (int j = 0; j < 8; ++j) s += (v[j][0] * v[j][0] + v[j][1] * v[j][1]) + (v[j][2] * v[j][2] + v[j][3] * v[j][3]);
    return rsqrtf(wave_sum(s) * (1.f / DM) + EPS);
}
__device__ __forceinline__ f32x4 modulate4f(const f32x4 v, float rstd, const float* gain, const float* sc, const float* sh, int col) {
    const f32x4 g = *(const f32x4*)(gain + col), s1 = modv4(sc + col), s0 = modv4(sh + col);
    return (v * rstd * g) * (s1 + 1.f) + s0;
}
__device__ __forceinline__ v2u modulate4(const f32x4 v, float rstd, const float* gain, const float* sc, const float* sh, int col) {
    const f32x4 g = *(const f32x4*)(gain + col), s1 = modv4(sc + col), s0 = modv4(sh + col);
    const f32x4 o = (v * rstd * g) * (s1 + 1.f) + s0;
    v2u w; w.x = pk2(o[0], o[1]); w.y = pk2(o[2], o[3]); return w;
}
constexpr int RS_A = 0, RS_SH = 3 * 8192, RS_GF = 6 * 8192, RS_END = 9 * 8192;
struct RowX { f32x4 x[8]; v2u xb[8]; unsigned ya[8], yb[8]; };
struct RowI { int s; float g; };
template <bool COMB> __device__ __forceinline__ RowI rs_idx_issue(const Prm& p, int m, int lane, int& e_out, int& pos_out) {
    RowI r; r.s = 0; r.g = 0.f; e_out = 0; pos_out = 0;
    if constexpr (COMB) { const int k = lane & 1; const int* te = (const int*)(p.ws + WS_TOK); const int* tp = (const int*)(p.ws + WS_TOK + TOKTAB); const float* tg = (const float*)(p.ws + WS_TOK + 2 * TOKTAB);
        e_out = te[2 * m + k]; pos_out = tp[2 * m + k]; r.g = tg[2 * m + k]; }
    return r;
}
template <bool COMB, bool SRC32> __device__ __forceinline__ void rs_issue(const Prm& p, int m, int s0, int s1, int lane, RowX& b) {
    const bool isc = m >= T_LAT;
    if constexpr (SRC32) { const float* src = isc ? p.ctx + (size_t)(m - T_LAT) * DM : p.x + (size_t)m * DM;
#pragma unroll
        for (int j = 0; j < 8; ++j) b.x[j] = __builtin_nontemporal_load((const f32x4*)(src + 256 * j + 4 * lane)); }
    else { const bf16* src = isc ? (const bf16*)(p.ws + WS_XC) + (size_t)(m - T_LAT) * DM : (const bf16*)(p.ws + WS_X) + (size_t)m * DM;
#pragma unroll
        for (int j = 0; j < 8; ++j) b.xb[j] = *(const v2u*)(src + 256 * j + 4 * lane); }
    if constexpr (COMB) { const unsigned char* y0 = p.ws + WS_YB + (size_t)s0 * DM; const unsigned char* y1 = p.ws + WS_YB + (size_t)s1 * DM;
#pragma unroll
        for (int j = 0; j < 8; ++j) { b.ya[j] = __builtin_nontemporal_load((const unsigned*)(y0 + 256 * j + 4 * lane)); b.yb[j] = __builtin_nontemporal_load((const unsigned*)(y1 + 256 * j + 4 * lane)); } }
}
template <bool COMB, bool FINAL, bool SRC32> __device__ __forceinline__ void rs_finish(const Prm& p, int l, int m, float g0, float g1, int lane, RowX& b, const LAS unsigned char* vl, bool live) {
    const bool isc = m >= T_LAT; const int vs = isc ? 2 : (m >> 13);
    const LAS float* A = (const LAS float*)(vl + RS_A) + vs * 2048; const LAS float* SH = (const LAS float*)(vl + RS_SH) + vs * 2048; const LAS float* GF = (const LAS float*)(vl + RS_GF) + vs * 2048;
    if constexpr (!SRC32) {
#pragma unroll
        for (int j = 0; j < 8; ++j) b.x[j] = bf4(b.xb[j]); }
    if constexpr (COMB) {
        bf16* wsrow = isc ? (bf16*)(p.ws + WS_XC) + (size_t)(m - T_LAT) * DM : (bf16*)(p.ws + WS_X) + (size_t)m * DM;
#pragma unroll
        for (int j = 0; j < 8; ++j) { const int col = 256 * j + 4 * lane; const unsigned a = b.ya[j], c = b.yb[j]; const f32x4 gq = *(const LAS f32x4*)(GF + col);
            const f32x2 a01 = __builtin_amdgcn_cvt_pk_f32_fp8(a, false), a23 = __builtin_amdgcn_cvt_pk_f32_fp8(a, true), c01 = __builtin_amdgcn_cvt_pk_f32_fp8(c, false), c23 = __builtin_amdgcn_cvt_pk_f32_fp8(c, true);
            b.x[j][0] += gq[0] * (g0 * a01[0] + g1 * c01[0]); b.x[j][1] += gq[1] * (g0 * a01[1] + g1 * c01[1]);
            b.x[j][2] += gq[2] * (g0 * a23[0] + g1 * c23[0]); b.x[j][3] += gq[3] * (g0 * a23[1] + g1 * c23[1]);
            if (!FINAL && live) { v2u w; w.x = pk2(b.x[j][0], b.x[j][1]); w.y = pk2(b.x[j][2], b.x[j][3]); *(v2u*)(wsrow + col) = w; } } }
    const float rstd = row_rstd(b.x);
    if (!live) return;
#pragma unroll
    for (int j = 0; j < 8; ++j) { const int col = 256 * j + 4 * lane; const f32x4 av = *(const LAS f32x4*)(A + col);
        if constexpr (FINAL) { __builtin_nontemporal_store(b.x[j] * rstd * av, (f32x4*)(p.out + (size_t)m * DM + col)); }
        else { const f32x4 o = b.x[j] * rstd * av + *(const LAS f32x4*)(SH + col);
            if (F8_INPROJ) *(unsigned*)(p.ws + WS_H + (size_t)m * DM + col) = pack4f8(o[0], o[1], o[2], o[3]);
            else { v2u w; w.x = pk2(o[0], o[1]); w.y = pk2(o[2], o[3]); *(v2u*)((bf16*)(p.ws + WS_H) + (size_t)m * DM + col) = w; } } }
}
template <bool COMB, bool FINAL, bool SRC32> __device__ __forceinline__ void row_stream(const Prm& p, int l, int lc, int nrows, int gw, int ngw, int tid, int lane, LAS unsigned char* vl, const LAS int* segL) {
    { const float* md = (const float*)(p.ws + OFF_MOD);
      for (int q = tid; q < 3 * 512; q += NWAVES * 64) { const int vs = q >> 9, c4 = (q & 511) * 4;
          if (FINAL) { if (vs == 0) *(LAS f32x4*)(vl + RS_A + (size_t)c4 * 4) = *(const f32x4*)(p.norm_final + c4); }
          else { const f32x4 gn = *(const f32x4*)(p.norm_mix + l * DM + c4), sc = modv4(md + (size_t)(l * 3 + vs) * MODW + DM + c4), sh = modv4(md + (size_t)(l * 3 + vs) * MODW + c4);
              *(LAS f32x4*)(vl + RS_A + ((size_t)vs * 2048 + c4) * 4) = gn * (sc + 1.f); *(LAS f32x4*)(vl + RS_SH + ((size_t)vs * 2048 + c4) * 4) = sh; }
          if (COMB) *(LAS f32x4*)(vl + RS_GF + ((size_t)vs * 2048 + c4) * 4) = modv4(md + (size_t)(lc * 3 + vs) * MODW + 5 * DM + c4) * (1.f / Y8_SCALE); }
      if (FINAL) { for (int q = tid; q < 2 * 512; q += NWAVES * 64) { const int c4 = (q & 511) * 4; *(LAS f32x4*)(vl + RS_A + ((size_t)(1 + (q >> 9)) * 2048 + c4) * 4) = *(const f32x4*)(p.norm_final + c4); } }
      __syncthreads(); }
    const int nit = gw < nrows ? (nrows - gw + ngw - 1) / ngw : 0;
    if (nit == 0) return;
    const int last = gw + (nit - 1) * ngw;
#define RS_ROW(i) min(gw + (i) * ngw, last)
    RowX bA, bB; int e0, p0, e1, p1; RowI i0 = rs_idx_issue<COMB>(p, RS_ROW(0), lane, e0, p0), i1 = rs_idx_issue<COMB>(p, RS_ROW(1), lane, e1, p1);
    { int s = COMB ? segL[e0] + p0 : 0; rs_issue<COMB, SRC32>(p, RS_ROW(0), __shfl(s, 0), __shfl(s, 1), lane, bA); }
#pragma unroll 1
    for (int i = 0; i < nit; i += 2) {
        int e2, p2, e3, p3;
        const RowI i2 = rs_idx_issue<COMB>(p, RS_ROW(i + 2), lane, e2, p2);
        { int s = COMB ? segL[e1] + p1 : 0; rs_issue<COMB, SRC32>(p, RS_ROW(i + 1), __shfl(s, 0), __shfl(s, 1), lane, bB); }
        rs_finish<COMB, FINAL, SRC32>(p, l, RS_ROW(i), __shfl(i0.g, 0), __shfl(i0.g, 1), lane, bA, vl, true);
        const RowI i3 = rs_idx_issue<COMB>(p, RS_ROW(i + 3), lane, e3, p3);
        { int s = COMB ? segL[e2] + p2 : 0; rs_issue<COMB, SRC32>(p, RS_ROW(i + 2), __shfl(s, 0), __shfl(s, 1), lane, bA); }
        rs_finish<COMB, FINAL, SRC32>(p, l, RS_ROW(i + 1), __shfl(i1.g, 0), __shfl(i1.g, 1), lane, bB, vl, i + 1 < nit);
        i0 = i2; i1 = i3; e1 = e3; p1 = p3;
    }
#undef RS_ROW
}
#ifndef Q_L0EXP
#define Q_L0EXP 1
#endif
constexpr int Q_L0 = Q_L0EXP ? NP_EXP : 0;
constexpr int Q_MOD = Q_L0EXP ? MODQ : 0;
constexpr int Q_L1 = Q_L0 + Q_MOD;
constexpr int Q_TOTAL = Q_L1 + NPL;
static_assert(Q_L0 % 16 == 0 && Q_L1 % 16 == 0 && (Q_L1 + NP_PROJ) % 16 == 0, "drain targets are multiples of the largest grab");
__device__ __forceinline__ void q_decode(unsigned q, int& kind, int& l, int& idx) {
    if (q < (unsigned)Q_L0) { kind = 0; l = 0; idx = (int)q + NP_PROJ; } else if (q < (unsigned)Q_L1) { kind = 1; l = 0; idx = (int)q - Q_L0; } else { kind = 0; l = 1; idx = (int)q - Q_L1; }
}
__device__ __forceinline__ void queue_convert8(const Prm& p, unsigned base, int n, LAS unsigned char* lds, int tid_in) {
    int tid = tid_in;
    asm volatile("" : "+v"(tid));
    const int wave = __builtin_amdgcn_readfirstlane(tid >> 6), lane = tid & 63; const unsigned q0 = base + (unsigned)wave, q1 = q0 + 8u;
    LAS float* scr = (LAS float*)(lds + wave * 16384);
    const bool h0 = q0 < (unsigned)Q_TOTAL, h1 = n == 16 && q1 < (unsigned)Q_TOTAL;
    int k0 = 0, l0 = 0, i0 = 0, k1 = 0, l1 = 0, i1 = 0; q_decode(q0, k0, l0, i0); q_decode(q1, k1, l1, i1);
    if (h0 && h1 && k0 == 0 && k1 == 0) { t_convert_two(p, l0, i0, l1, i1, true, scr, lane); return; }
    if (h0) { if (k0 == 0) t_convert_one(p, l0, i0, scr, lane); else mods_queue_item(p, i0, scr, lane); }
    if (h1) { if (k1 == 0) t_convert_one(p, l1, i1, scr, lane); else mods_queue_item(p, i1, scr, lane); }
}
__device__ __forceinline__ void xcd_barrier_work(const XcdBarrier& b, const Prm& p, LAS unsigned char* lds, int tid, int grab) {
    asm volatile("s_waitcnt vmcnt(0)" ::: "memory");
    __syncthreads();
    volatile LAS unsigned* bw = (volatile LAS unsigned*)(lds + L_BWORK);
    unsigned* bar = b.bar; unsigned* q = (unsigned*)(p.ws + OFF_Q);
    if (threadIdx.x == 0) {
        __builtin_amdgcn_s_waitcnt(0);
        unsigned nloc = b.st[0], nx = b.st[1];
        if (nloc == 0u) { xcd_barrier_complete(bar, b.x, nloc, nx); b.st[0] = nloc; b.st[1] = nx; }
        const unsigned old = xb_add(&bar[XB_XSUB(b.x)], 1u);
        const unsigned gen = old / nloc;
        if (old + 1u == (gen + 1u) * nloc) {
            __builtin_amdgcn_fence(__ATOMIC_RELEASE, "agent");
            asm volatile("s_waitcnt vmcnt(0)" ::: "memory");
            const unsigned og = xb_add(&bar[XB_TOP], 1u);
            const unsigned tg = og / nx;
            if (og + 1u == (tg + 1u) * nx) xb_add(&bar[XB_TOPGEN], 1u);
            else XB_SPIN(xb_ld(&bar[XB_TOPGEN]) == tg, bar);
            __builtin_amdgcn_fence(__ATOMIC_ACQUIRE, "agent");
            xb_add(&bar[XB_XGEN(b.x)], 1u);
            asm volatile("s_waitcnt vmcnt(0)" ::: "memory");
            bw[0] = 1u;
        } else { bw[0] = 0u; bw[2] = gen; }
    }
    __syncthreads();
    if (bw[0] == 0u) {
        unsigned sp = 0u;
        for (;;) {
            if (threadIdx.x == 0) {
                const unsigned gen = bw[2];
                bool rel = xb_ld(&bar[XB_XGEN(b.x)]) != gen;
                if (!rel && ((++sp & 63u) == 0u)) { if (xb_ld(&bar[XB_TMO])) rel = true; else if (sp > XB_SPIN_CAP) { atomicAdd(&bar[XB_TMO], 1u); rel = true; } }
                if (rel) { __builtin_amdgcn_fence(__ATOMIC_ACQUIRE, "agent"); asm volatile("s_waitcnt vmcnt(0)" ::: "memory"); bw[0] = 1u; }
                else { unsigned base = 0xffffffffu; if (xb_ld(q) < (unsigned)Q_TOTAL) { base = xb_add(q, (unsigned)grab); if (base >= (unsigned)Q_TOTAL) base = 0xffffffffu; } bw[1] = base; }
            }
            __syncthreads();
            if (bw[0]) break;
            const unsigned base = bw[1];
            if (base != 0xffffffffu) queue_convert8(p, base, grab, lds, tid); else __builtin_amdgcn_s_sleep(4);
            __syncthreads();
        }
    }
    __syncthreads();
}
__device__ __forceinline__ void queue_drain(const Prm& p, LAS unsigned char* lds, int tid, unsigned target) {
    volatile LAS unsigned* bw = (volatile LAS unsigned*)(lds + L_BWORK); unsigned* q = (unsigned*)(p.ws + OFF_Q);
    __syncthreads();
    for (;;) {
        if (threadIdx.x == 0) bw[1] = (xb_ld(q) < target) ? xb_add(q, 16u) : 0xffffffffu;
        __syncthreads();
        const unsigned base = bw[1];
        if (base >= target) break;
        queue_convert8(p, base, 16, lds, tid);
        __syncthreads();
    }
    __syncthreads();
}
__device__ __forceinline__ void phase_conv(const Prm& p, int l, int gw, int ngw, int lane) {
    const bf16* U = (const bf16*)(p.ws + WS_U); bf16* XA = (bf16*)(p.ws + WS_XBC); float* DT = (float*)(p.ws + WS_DT);
    constexpr int NRUN = T_ALL / 16;
    for (int it = gw; it < NRUN * 3; it += ngw) {
        const int run = it / 3, cb = it % 3, t0 = run * 16, ch = cb * 512 + lane * 8;
        int seq0, seq1; if (t0 < T_LAT) { seq0 = t0 & ~(SEQL - 1); seq1 = seq0 + SEQL; } else { seq0 = T_LAT + ((t0 - T_LAT) & ~(CTXL - 1)); seq1 = seq0 + CTXL; }
        float w[5][8], bias[8];
#pragma unroll
        for (int j = 0; j < 5; ++j) { const f32x4 a = *(const f32x4*)(p.conv_w + ((size_t)l * 5 + j) * XBCW + ch), b = *(const f32x4*)(p.conv_w + ((size_t)l * 5 + j) * XBCW + ch + 4);
            w[j][0] = a[0]; w[j][1] = a[1]; w[j][2] = a[2]; w[j][3] = a[3]; w[j][4] = b[0]; w[j][5] = b[1]; w[j][6] = b[2]; w[j][7] = b[3]; }
        { const f32x4 a = *(const f32x4*)(p.conv_b + (size_t)l * XBCW + ch), b = *(const f32x4*)(p.conv_b + (size_t)l * XBCW + ch + 4);
            bias[0] = a[0]; bias[1] = a[1]; bias[2] = a[2]; bias[3] = a[3]; bias[4] = b[0]; bias[5] = b[1]; bias[6] = b[2]; bias[7] = b[3]; }
        v4u rows[20];
#pragma unroll
        for (int j = 0; j < 20; ++j) { const int t = t0 - 2 + j, tc = min(max(t, seq0), seq1 - 1); rows[j] = __builtin_nontemporal_load((const v4u*)(U + (size_t)tc * NINP + C_XBC + ch)); }
#pragma unroll
        for (int j = 0; j < 20; ++j) { const int t = t0 - 2 + j; if (t < seq0 || t >= seq1) rows[j] = (v4u){0u, 0u, 0u, 0u}; }
#pragma unroll
        for (int i = 0; i < 16; ++i) {
            const int t = t0 + i;
            float o[8];
#pragma unroll
            for (int c = 0; c < 8; ++c) o[c] = bias[c];
#pragma unroll
            for (int j = 0; j < 5; ++j) { const v4u wv = rows[i + j];
                o[0] += w[j][0] * bflo(wv.x); o[1] += w[j][1] * bfhi(wv.x); o[2] += w[j][2] * bflo(wv.y); o[3] += w[j][3] * bfhi(wv.y);
                o[4] += w[j][4] * bflo(wv.z); o[5] += w[j][5] * bfhi(wv.z); o[6] += w[j][6] * bflo(wv.w); o[7] += w[j][7] * bfhi(wv.w); }
            v4u r; r.x = pk2(silu_f(o[0]), silu_f(o[1])); r.y = pk2(silu_f(o[2]), silu_f(o[3])); r.z = pk2(silu_f(o[4]), silu_f(o[5])); r.w = pk2(silu_f(o[6]), silu_f(o[7]));
            *(v4u*)(XA + (size_t)t * XBCW + ch) = r;
        }
    }
    for (int it = gw * 64 + lane; it < T_ALL * 32; it += ngw * 64) { const int m = it >> 5, j = it & 31;
        DT[it] = softplus_f(bf2f(U[(size_t)m * NINP + C_DT + j]) + p.dt_bias[l * 32 + j]); }
}

__device__ __forceinline__ void naive_attn_item(const Prm& p, int l, int type, int m, int hh, LAS float* qs, LAS float* sc, int lane) {
    const bf16* U = (const bf16*)(p.ws + WS_U); bf16* MIX = (bf16*)(p.ws + WS_H);
    int qcol, kcol, vcol, ocol;
    if (type == 0 || type == 2) { qcol = C_QA + hh * 128; kcol = C_KA + hh * 128; vcol = C_VA + hh * 128; ocol = hh * 128; }
    else { const int kvh = hh >> 1; qcol = C_QB + hh * 128; kcol = C_KB + kvh * 128; vcol = C_VB + kvh * 128; ocol = 512 + hh * 128; }
    { const unsigned w = *(const unsigned*)(U + (size_t)m * NINP + qcol + 2 * lane); qs[2 * lane] = bflo(w); qs[2 * lane + 1] = bfhi(w); }
    int b, s = 0, qr = 0, qc = 0, krow0 = 0, kpos0 = 0;
    if (type < 2) { b = m >> 13; s = m & 8191; qr = s >> 6; qc = s & 63; } else { b = (m - T_LAT) >> 8; }
    const int nloc = type == 0 ? 512 : (type == 1 ? 384 : 0), nk = nloc + 256;
    if (type == 0) krow0 = min(max(qr - 4, 0), 120);
    if (type == 1) kpos0 = (s >> 7) * 128 - 128;
    const float* rpb = p.na_rpb + (size_t)(l * 4 + hh) * 15 * 31;
    LDS_WAIT(); __builtin_amdgcn_wave_barrier(); asm volatile("" ::: "memory");
    float mx = -INFINITY;
    for (int k0 = 0; k0 < nk; k0 += 64) {
        const int kidx = k0 + lane; int row; float bias = 0.f; bool valid = true;
        if (kidx < nloc) {
            if (type == 0) { const int kr = krow0 + (kidx >> 6), kc = kidx & 63; row = b * SEQL + kr * 64 + kc; const int c0 = min(max(qc - 8, 0), 48); valid = (kc >= c0) && (kc < c0 + 16);
                const int dr = kr - qr + 7, dc = min(max(kc - qc + 15, 0), 30); bias = rpb[dr * 31 + dc]; }
            else { const int kpos = kpos0 + kidx; valid = (kpos >= 0) && (kpos < SEQL) && (abs(s - kpos) <= 128); row = b * SEQL + min(max(kpos, 0), SEQL - 1); }
        } else row = T_LAT + b * CTXL + (kidx - nloc);
        const bf16* kp = U + (size_t)row * NINP + kcol; float d = 0.f;
#pragma unroll 4
        for (int c = 0; c < 16; ++c) { const v4u w = *(const v4u*)(kp + 8 * c); const LAS float* q = qs + 8 * c;
            d += bflo(w.x) * q[0] + bfhi(w.x) * q[1] + bflo(w.y) * q[2] + bfhi(w.y) * q[3] + bflo(w.z) * q[4] + bfhi(w.z) * q[5] + bflo(w.w) * q[6] + bfhi(w.w) * q[7]; }
        const float sv = valid ? d * ATT_SCALE + bias : -INFINITY;
        sc[kidx] = sv; mx = fmaxf(mx, sv);
    }
    mx = wave_max(mx);
    float sum = 0.f;
    for (int k0 = 0; k0 < nk; k0 += 64) { const float e = __expf(sc[k0 + lane] - mx); sc[k0 + lane] = e; sum += e; }
    sum = wave_sum(sum);
    if (type == 1 || type == 3) sum += __expf(p.wa_sink[l * 4 + hh] - mx);
    LDS_WAIT(); __builtin_amdgcn_wave_barrier(); asm volatile("" ::: "memory");
    float o0 = 0.f, o1 = 0.f;
    for (int kidx = 0; kidx < nk; ++kidx) {
        int row;
        if (kidx < nloc) { if (type == 0) row = b * SEQL + (krow0 + (kidx >> 6)) * 64 + (kidx & 63); else row = b * SEQL + min(max(kpos0 + kidx, 0), SEQL - 1); }
        else row = T_LAT + b * CTXL + (kidx - nloc);
        const float pv = sc[kidx]; const unsigned w = *(const unsigned*)(U + (size_t)row * NINP + vcol + 2 * lane);
        o0 += pv * bflo(w); o1 += pv * bfhi(w);
    }
    const float inv = 1.f / sum;
    *(unsigned*)(MIX + (size_t)m * DM + ocol + 2 * lane) = pk2(o0 * inv, o1 * inv);
    LDS_WAIT(); __builtin_amdgcn_wave_barrier(); asm volatile("" ::: "memory");
}
__device__ __forceinline__ void phase_attn_naive(const Prm& p, int l, LAS unsigned char* lds, int gw, int ngw, int wave, int lane) {
    LAS float* qs = (LAS float*)(lds + wave * 4096); LAS float* sc = qs + 128;
    const int nlat = T_LAT * 8, nctx = (l == 0) ? T_CTX * 8 : 0;
    for (int it = gw; it < nlat + nctx; it += ngw) {
        if (it < nlat) { const int m = it >> 3, h8 = it & 7; naive_attn_item(p, l, h8 >> 2, m, h8 & 3, qs, sc, lane); }
        else { const int r = it - nlat, m = T_LAT + (r >> 3), h8 = r & 7; naive_attn_item(p, l, 2 + (h8 >> 2), m, h8 & 3, qs, sc, lane); }
    }
}

__device__ __forceinline__ void phase_ssd_naive(const Prm& p, int l, int wg, int nwg, int tid) {
    const bf16* XA = (const bf16*)(p.ws + WS_XBC); const float* DT = (const float*)(p.ws + WS_DT); float* YD = (float*)(p.ws + WS_YD);
    for (int it = wg; it < 64; it += nwg) {
        const int b = it >> 5, dir = (it >> 4) & 1, h = it & 15, g = h >> 3;
        const int pp = tid >> 3, nq = tid & 7;
        const float a = -__expf(p.a_log[l * 32 + dir * 16 + h]), dsk = p.d_skip[l * 32 + dir * 16 + h];
        float hs[16];
#pragma unroll
        for (int i = 0; i < 16; ++i) hs[i] = 0.f;
#pragma unroll 4
        for (int st = 0; st < CTXL + SEQL; ++st) {
            int m; if (st < CTXL) m = T_LAT + b * CTXL + (dir ? CTXL - 1 - st : st); else { const int s = st - CTXL; m = b * SEQL + (dir ? SEQL - 1 - s : s); }
            const float dtv = DT[(size_t)m * 32 + dir * 16 + h];
            const bf16* row = XA + (size_t)m * XBCW;
            const float xv = bf2f(row[h * 64 + pp]);
            const v4u b0 = *(const v4u*)(row + 1024 + g * 128 + 16 * nq), b1 = *(const v4u*)(row + 1024 + g * 128 + 16 * nq + 8);
            const v4u c0 = *(const v4u*)(row + 1280 + g * 128 + 16 * nq), c1 = *(const v4u*)(row + 1280 + g * 128 + 16 * nq + 8);
            const float dA = __expf(a * dtv), dx = dtv * xv;
            float bv[16], cv[16];
            bv[0] = bflo(b0.x); bv[1] = bfhi(b0.x); bv[2] = bflo(b0.y); bv[3] = bfhi(b0.y); bv[4] = bflo(b0.z); bv[5] = bfhi(b0.z); bv[6] = bflo(b0.w); bv[7] = bfhi(b0.w);
            bv[8] = bflo(b1.x); bv[9] = bfhi(b1.x); bv[10] = bflo(b1.y); bv[11] = bfhi(b1.y); bv[12] = bflo(b1.z); bv[13] = bfhi(b1.z); bv[14] = bflo(b1.w); bv[15] = bfhi(b1.w);
            cv[0] = bflo(c0.x); cv[1] = bfhi(c0.x); cv[2] = bflo(c0.y); cv[3] = bfhi(c0.y); cv[4] = bflo(c0.z); cv[5] = bfhi(c0.z); cv[6] = bflo(c0.w); cv[7] = bfhi(c0.w);
            cv[8] = bflo(c1.x); cv[9] = bfhi(c1.x); cv[10] = bflo(c1.y); cv[11] = bfhi(c1.y); cv[12] = bflo(c1.z); cv[13] = bfhi(c1.z); cv[14] = bflo(c1.w); cv[15] = bfhi(c1.w);
            float part = 0.f;
#pragma unroll
            for (int i = 0; i < 16; ++i) { hs[i] = dA * hs[i] + dx * bv[i]; part += cv[i] * hs[i]; }
            part += __shfl_xor(part, 1); part += __shfl_xor(part, 2); part += __shfl_xor(part, 4);
            if (nq == 0) YD[((size_t)dir * T_ALL + m) * 1024 + h * 64 + pp] = part + dsk * xv;
        }
    }
}
__device__ __forceinline__ void phase_gnorm(const Prm& p, int l, int gw, int ngw, int lane) {
    const bf16* U = (const bf16*)(p.ws + WS_U); const bf16* YD = (const bf16*)(p.ws + WS_XG); bf16* MIX = (bf16*)(p.ws + WS_H);
    const int nrow = (l == 0) ? T_ALL : T_LAT;
    for (int m0 = gw; m0 < nrow; m0 += 2 * ngw) {
        const int m1 = (m0 + ngw < nrow) ? m0 + ngw : m0;
        v2u yv[2][4], zv[2][4];
#pragma unroll
        for (int q = 0; q < 2; ++q) { const int m = q ? m1 : m0;
#pragma unroll
            for (int j = 0; j < 4; ++j) { const int col = 256 * j + 4 * lane; yv[q][j] = __builtin_nontemporal_load((const v2u*)(YD + (size_t)m * 1024 + col)); zv[q][j] = __builtin_nontemporal_load((const v2u*)(U + (size_t)m * NINP + C_Z + col)); } }
#pragma unroll
        for (int q = 0; q < 2; ++q) { const int m = q ? m1 : m0;
            f32x4 u[4]; float ss[2] = {0.f, 0.f};
#pragma unroll
            for (int j = 0; j < 4; ++j) { const v2u yy = yv[q][j], zz = zv[q][j];
                u[j][0] = bflo(yy.x) * silu_f(bflo(zz.x)); u[j][1] = bfhi(yy.x) * silu_f(bfhi(zz.x)); u[j][2] = bflo(yy.y) * silu_f(bflo(zz.y)); u[j][3] = bfhi(yy.y) * silu_f(bfhi(zz.y));
                ss[j >> 1] += (u[j][0] * u[j][0] + u[j][1] * u[j][1]) + (u[j][2] * u[j][2] + u[j][3] * u[j][3]); }
            const float r0 = rsqrtf(wave_sum(ss[0]) * (1.f / 512.f) + EPS), r1 = rsqrtf(wave_sum(ss[1]) * (1.f / 512.f) + EPS);
            if (q == 1 && m1 == m0) continue;
#pragma unroll
            for (int j = 0; j < 4; ++j) { const int col = 256 * j + 4 * lane; const f32x4 g = *(const f32x4*)(p.ssd_norm + l * 1024 + col); const f32x4 o = u[j] * (j < 2 ? r0 : r1) * g;
                if (F8_OUTPROJ) *(unsigned*)((unsigned char*)MIX + (size_t)m * DM + 1024 + col) = pack4f8(o[0] * MIX_SCALE, o[1] * MIX_SCALE, o[2] * MIX_SCALE, o[3] * MIX_SCALE);
                else { v2u w; w.x = pk2(o[0], o[1]); w.y = pk2(o[2], o[3]); *(v2u*)(MIX + (size_t)m * DM + 1024 + col) = w; } }
        }
    }
}
#ifdef PROBE_AT
#define PAT_SYNC(stmt) do { const long long pa_t0_ = wall_clock64(); stmt; if ((PROBE_AT) & 1) { const long long pa_t1_ = wall_clock64(), pa_d_ = (pa_t1_ - pa_t0_) * (PROBE_MULT); while (wall_clock64() - pa_t1_ < pa_d_) __builtin_amdgcn_s_sleep(2); } } while (0)
#else
#define PAT_SYNC(stmt) stmt
#endif
namespace att {
typedef short s16x4 __attribute__((ext_vector_type(4)));
typedef float f32x16 __attribute__((ext_vector_type(16)));
#ifndef ATT_PV2
#define ATT_PV2 1
#endif
constexpr int KVBLK = 64;
constexpr float THR = 8.f;
#ifndef ATT_SDEPTH
#define ATT_SDEPTH 1
#endif
constexpr int SDEPTH = ATT_SDEPTH;
constexpr int SHM_V = KVBLK * 128 * 2, SHM_K = KVBLK * 128 * 2;
constexpr int OFF_V = 0, OFF_K = 2 * SHM_V, OFF_WS = 2 * SHM_V + 2 * SHM_K, OFF_RPB = OFF_WS + 8 * 64 * 4, ATT_LDS = OFF_RPB + 576 * 4;
#define KSWZ(row, colB) ((row) * 256 + ((colB) ^ (((row) & 15) << 4)))
#define SBAR() __builtin_amdgcn_sched_barrier(0)
__device__ __forceinline__ int crow(int r, int hi) { return (r & 3) + 8 * (r >> 2) + 4 * hi; }
__device__ __forceinline__ unsigned cvtpk(float lo, float hi) { unsigned r; asm volatile("v_cvt_pk_bf16_f32 %0, %1, %2" : "=v"(r) : "v"(lo), "v"(hi)); return r; }
__device__ __forceinline__ void partialSM(f32x16& p0, f32x16& p1, float& m_reg, float& mn, float& alpha) {
  constexpr float C = ATT_SCALE * 1.4426950408889634f;
  float pmax = p0[0];
#pragma unroll
  for (int r = 1; r < 16; ++r) pmax = fmaxf(pmax, p0[r]);
#pragma unroll
  for (int r = 0; r < 16; ++r) pmax = fmaxf(pmax, p1[r]);
  { auto rr = __builtin_amdgcn_permlane32_swap(__float_as_uint(pmax), __float_as_uint(pmax), false, false);
    pmax = fmaxf(__uint_as_float(rr[0]), __uint_as_float(rr[1])); }
  if (__builtin_expect(__all(pmax - m_reg <= THR / ATT_SCALE), 1)) { mn = m_reg; alpha = 1.f; }
  else { mn = fmaxf(m_reg, pmax); alpha = __builtin_amdgcn_exp2f((m_reg - mn) * C); m_reg = mn; }
  float mnC = -mn * C;
#pragma unroll
  for (int r = 0; r < 16; ++r) p0[r] = fmaf(p0[r], C, mnC);
#pragma unroll
  for (int r = 0; r < 16; ++r) p1[r] = fmaf(p1[r], C, mnC);
#pragma unroll
  for (int r = 0; r < 16; ++r) p0[r] = __builtin_amdgcn_exp2f(p0[r]);
}
__device__ __forceinline__ void finishSM(f32x16& p0, f32x16& p1, float alpha, float& l_reg, bf16x8& pa0, bf16x8& pa1, bf16x8& pa2, bf16x8& pa3) {
#pragma unroll
  for (int r = 0; r < 16; ++r) p1[r] = __builtin_amdgcn_exp2f(p1[r]);
  float ps = 0;
#pragma unroll
  for (int r = 0; r < 16; ++r) ps += p0[r];
#pragma unroll
  for (int r = 0; r < 16; ++r) ps += p1[r];
  { auto rr = __builtin_amdgcn_permlane32_swap(__float_as_uint(ps), __float_as_uint(ps), false, false);
    ps = __uint_as_float(rr[0]) + __uint_as_float(rr[1]); }
  l_reg = l_reg * alpha + ps;
#define PK4(P, BASE, OUT) do { unsigned a0 = cvtpk(P[BASE + 0], P[BASE + 1]), a1 = cvtpk(P[BASE + 2], P[BASE + 3]);   \
    unsigned b0 = cvtpk(P[BASE + 4], P[BASE + 5]), b1 = cvtpk(P[BASE + 6], P[BASE + 7]);                              \
    auto r0 = __builtin_amdgcn_permlane32_swap(a0, b0, false, false); auto r1 = __builtin_amdgcn_permlane32_swap(a1, b1, false, false); \
    v4u w = {r0[0], r1[0], r0[1], r1[1]}; OUT = *reinterpret_cast<bf16x8*>(&w); } while (0)
  PK4(p0, 0, pa0); PK4(p0, 8, pa1); PK4(p1, 0, pa2); PK4(p1, 8, pa3);
#undef PK4
}
__device__ __forceinline__ void qkt(f32x16& p0, f32x16& p1, const LAS unsigned char* Ks, const bf16x8* qr, int r32, int hi) {
  p0 = f32x16{}; p1 = f32x16{};
  bf16x8 ka[2], kb[2];
#define KLD(d0, sl) do { const int cb_ = ((d0) * 16 + hi * 8) * 2; ka[sl] = *reinterpret_cast<const LAS bf16x8*>(Ks + KSWZ(r32, cb_)); kb[sl] = *reinterpret_cast<const LAS bf16x8*>(Ks + KSWZ(32 + r32, cb_)); } while (0)
  KLD(0, 0); KLD(1, 1);
#pragma unroll
  for (int d0 = 0; d0 < 8; ++d0) { const int sl = d0 & 1;
    p0 = __builtin_amdgcn_mfma_f32_32x32x16_bf16(ka[sl], qr[d0], p0, 0, 0, 0);
    p1 = __builtin_amdgcn_mfma_f32_32x32x16_bf16(kb[sl], qr[d0], p1, 0, 0, 0);
    if (d0 + 2 < 8) KLD(d0 + 2, sl);
    SBAR(); }
#undef KLD
}
__device__ __forceinline__ int v_st(int k, int c) { const int kk = (k & ~0xC) | ((k & 4) << 1) | ((k & 8) >> 1); return ((kk >> 3) * 4 + (c >> 5)) * 512 + ((kk & 7) * 32 + (c & 31)) * 2; }
__device__ __forceinline__ int v_rd_base(int lane) { return ((lane & 3) << 3) | (((lane >> 2) & 3) << 6) | (((lane >> 4) & 1) << 5) | (((lane >> 5) & 1) << 8); }
constexpr int v_rd_off(int d0, int ks, int half) { return d0 * 512 + ks * 4096 + half * 2048; }
template <int OFF> __device__ __forceinline__ s16x4 tr_read(int vb) {
  s16x4 r; asm volatile("ds_read_b64_tr_b16 %0, %1 offset:%2" : "=&v"(r) : "v"(vb), "i"(OFF) : "memory"); return r;
}
template <int D0> __device__ __forceinline__ void pv_one(f32x16& od, int vb, bf16x8 pa0, bf16x8 pa1, bf16x8 pa2, bf16x8 pa3) {
  const s16x4 l0 = tr_read<v_rd_off(D0, 0, 0)>(vb), h0 = tr_read<v_rd_off(D0, 0, 1)>(vb), l1 = tr_read<v_rd_off(D0, 1, 0)>(vb), h1 = tr_read<v_rd_off(D0, 1, 1)>(vb);
  const s16x4 l2 = tr_read<v_rd_off(D0, 2, 0)>(vb), h2 = tr_read<v_rd_off(D0, 2, 1)>(vb), l3 = tr_read<v_rd_off(D0, 3, 0)>(vb), h3 = tr_read<v_rd_off(D0, 3, 1)>(vb);
  asm volatile("s_waitcnt lgkmcnt(0)" ::: "memory"); SBAR();
#define PK(L, H) (bf16x8){L[0], L[1], L[2], L[3], H[0], H[1], H[2], H[3]}
  od = __builtin_amdgcn_mfma_f32_32x32x16_bf16(pa0, PK(l0, h0), od, 0, 0, 0);
  od = __builtin_amdgcn_mfma_f32_32x32x16_bf16(pa1, PK(l1, h1), od, 0, 0, 0);
  od = __builtin_amdgcn_mfma_f32_32x32x16_bf16(pa2, PK(l2, h2), od, 0, 0, 0);
  od = __builtin_amdgcn_mfma_f32_32x32x16_bf16(pa3, PK(l3, h3), od, 0, 0, 0);
#undef PK
}
template <int D0> __device__ __forceinline__ void pv_two(f32x16& oa, f32x16& ob, int vb, bf16x8 pa0, bf16x8 pa1, bf16x8 pa2, bf16x8 pa3) {
  const s16x4 l0 = tr_read<v_rd_off(D0, 0, 0)>(vb), h0 = tr_read<v_rd_off(D0, 0, 1)>(vb), l1 = tr_read<v_rd_off(D0, 1, 0)>(vb), h1 = tr_read<v_rd_off(D0, 1, 1)>(vb);
  const s16x4 l2 = tr_read<v_rd_off(D0, 2, 0)>(vb), h2 = tr_read<v_rd_off(D0, 2, 1)>(vb), l3 = tr_read<v_rd_off(D0, 3, 0)>(vb), h3 = tr_read<v_rd_off(D0, 3, 1)>(vb);
  const s16x4 m0 = tr_read<v_rd_off(D0 + 1, 0, 0)>(vb), g0 = tr_read<v_rd_off(D0 + 1, 0, 1)>(vb), m1 = tr_read<v_rd_off(D0 + 1, 1, 0)>(vb), g1 = tr_read<v_rd_off(D0 + 1, 1, 1)>(vb);
  const s16x4 m2 = tr_read<v_rd_off(D0 + 1, 2, 0)>(vb), g2 = tr_read<v_rd_off(D0 + 1, 2, 1)>(vb), m3 = tr_read<v_rd_off(D0 + 1, 3, 0)>(vb), g3 = tr_read<v_rd_off(D0 + 1, 3, 1)>(vb);
  asm volatile("s_waitcnt lgkmcnt(0)" ::: "memory"); SBAR();
#define PK(L, H) (bf16x8){L[0], L[1], L[2], L[3], H[0], H[1], H[2], H[3]}
  oa = __builtin_amdgcn_mfma_f32_32x32x16_bf16(pa0, PK(l0, h0), oa, 0, 0, 0);
  ob = __builtin_amdgcn_mfma_f32_32x32x16_bf16(pa0, PK(m0, g0), ob, 0, 0, 0);
  oa = __builtin_amdgcn_mfma_f32_32x32x16_bf16(pa1, PK(l1, h1), oa, 0, 0, 0);
  ob = __builtin_amdgcn_mfma_f32_32x32x16_bf16(pa1, PK(m1, g1), ob, 0, 0, 0);
  oa = __builtin_amdgcn_mfma_f32_32x32x16_bf16(pa2, PK(l2, h2), oa, 0, 0, 0);
  ob = __builtin_amdgcn_mfma_f32_32x32x16_bf16(pa2, PK(m2, g2), ob, 0, 0, 0);
  oa = __builtin_amdgcn_mfma_f32_32x32x16_bf16(pa3, PK(l3, h3), oa, 0, 0, 0);
  ob = __builtin_amdgcn_mfma_f32_32x32x16_bf16(pa3, PK(m3, g3), ob, 0, 0, 0);
#undef PK
}
__device__ __forceinline__ void pv_d0(f32x16* o, int vb, bf16x8 pa0, bf16x8 pa1, bf16x8 pa2, bf16x8 pa3) {
#if ATT_PV2
  pv_two<0>(o[0], o[1], vb, pa0, pa1, pa2, pa3); pv_two<2>(o[2], o[3], vb, pa0, pa1, pa2, pa3);
#else
  pv_one<0>(o[0], vb, pa0, pa1, pa2, pa3); pv_one<1>(o[1], vb, pa0, pa1, pa2, pa3); pv_one<2>(o[2], vb, pa0, pa1, pa2, pa3); pv_one<3>(o[3], vb, pa0, pa1, pa2, pa3);
#endif
}
struct UnitD { int type, b, hh, q0  , nloc  , kbase  ; };
__device__ __forceinline__ int tile_row(const UnitD& u, int j) {
    if (j >= u.nloc) return T_LAT + u.b * CTXL + (j - u.nloc) * 64;
    if (u.type == 0) return u.b * SEQL + (u.kbase + j) * 64;
    const int kp = u.kbase + j * 64; return u.b * SEQL + min(max(kp, 0), SEQL - 64);
}
__device__ __forceinline__ bool tile_active(const UnitD& u, int j, int wid) {
    if (j >= u.nloc) return true;
    if (u.type == 0) { const int qr = (u.q0 >> 6) + (wid >> 1), kr = u.kbase + j, start = min(max(qr - 4, 0), 120); return kr >= start && kr < start + 8; }
    const int qw = u.q0 + 32 * wid, kp0 = u.kbase + j * 64;
    return (kp0 >= 0) && (kp0 < SEQL) && (kp0 - (qw + 31) <= 128) && (qw - (kp0 + 63) <= 128);
}
__device__ __forceinline__ void apply_mask(f32x16& p0, f32x16& p1, const UnitD& u, int j, int wid, int r32, int hi, const LAS float* rpbL) {
    if (j >= u.nloc) return;
    if (u.type == 0) {
        const int qr = (u.q0 >> 6) + (wid >> 1), qc = (wid & 1) * 32 + r32, kr = u.kbase + j;
        const int c0 = min(max(qc - 8, 0), 48), cb = 4 * hi - c0;
        const LAS float* rp = rpbL + (kr - qr + 7) * 31 + 4 * hi - qc + 15 + 32;
#pragma unroll
        for (int g4 = 0; g4 < 4; ++g4) {
            float b0[4], b1[4];
#pragma unroll
            for (int i = 0; i < 4; ++i) { b0[i] = rp[8 * g4 + i]; b1[i] = rp[8 * g4 + i + 32]; }
            asm volatile("" : "+v"(b0[0]), "+v"(b0[1]), "+v"(b0[2]), "+v"(b0[3]), "+v"(b1[0]), "+v"(b1[1]), "+v"(b1[2]), "+v"(b1[3]));
#pragma unroll
            for (int i = 0; i < 4; ++i) { const int r = 4 * g4 + i, k0 = 8 * g4 + i;
                p0[r] = ((unsigned)(k0 + cb) < 16u) ? p0[r] + b0[i] : -INFINITY;
                p1[r] = ((unsigned)(k0 + 32 + cb) < 16u) ? p1[r] + b1[i] : -INFINITY; }
            SBAR(); }
    } else {
        const int qw = u.q0 + 32 * wid, kp0 = u.kbase + j * 64;
        if ((kp0 + 63 - qw <= 128) && (qw + 31 - kp0 <= 128)) return;
        const int cb = kp0 + 4 * hi - (qw + r32) + 128;
#pragma unroll
        for (int r = 0; r < 16; ++r) {
            const int k0 = (r & 3) + 8 * (r >> 2);
            p0[r] = ((unsigned)(k0 + cb) <= 256u) ? p0[r] : -INFINITY;
            p1[r] = ((unsigned)(k0 + 32 + cb) <= 256u) ? p1[r] : -INFINITY; }
    }
}
__device__ __forceinline__ void fill_ninf(f32x16& p0, f32x16& p1) {
#pragma unroll
    for (int r = 0; r < 16; ++r) { p0[r] = -INFINITY; p1[r] = -INFINITY; }
}
__device__ __forceinline__ void attn_unit(const Prm& p, int l, const UnitD u, LAS unsigned char* lds, int tid) {
  const bf16* U = (const bf16*)(p.ws + WS_U); bf16* MIX = (bf16*)(p.ws + WS_H);
  const int wid = __builtin_amdgcn_readfirstlane(tid >> 6), lane = tid & 63, r32 = lane & 31, hi = lane >> 5;
  int qcol, kcol, vcol, ocol;
  if (u.type == 0 || u.type == 2) { qcol = C_QA + u.hh * 128; kcol = C_KA + u.hh * 128; vcol = C_VA + u.hh * 128; ocol = u.hh * 128; }
  else { const int kvh = u.hh >> 1; qcol = C_QB + u.hh * 128; kcol = C_KB + kvh * 128; vcol = C_VB + kvh * 128; ocol = 512 + u.hh * 128; }
  const int qrow0 = (u.type < 2 ? u.b * SEQL : T_LAT + u.b * CTXL) + u.q0;
  LAS unsigned char* V_lds = lds + OFF_V; LAS unsigned char* K_lds = lds + OFF_K;
  LAS float* wsl = (LAS float*)(lds + OFF_WS) + wid * 64; LAS float* li_l = wsl; LAS float* al_l = wsl + 32;
  LAS float* rpbL = (LAS float*)(lds + OFF_RPB);
  if (u.type == 0 && tid < 465) rpbL[32 + tid] = p.na_rpb[(size_t)(l * 4 + u.hh) * 465 + tid] * (1.f / ATT_SCALE);
  float m_reg = -1e30f, l_reg = 0; f32x16 o[4] = {}; bf16x8 qr[8];
  const bf16* Qw = U + (size_t)(qrow0 + wid * 32 + r32) * NINP + qcol + hi * 8;
#pragma unroll
  for (int d0 = 0; d0 < 8; ++d0) qr[d0] = *reinterpret_cast<const bf16x8*>(Qw + d0 * 16);
  const int sr = tid >> 4, sc = (tid & 15) * 8, vst0 = v_st(sr, sc), vst1 = v_st(32 + sr, sc);
  const int vb0 = (int)(uintptr_t)V_lds + v_rd_base(lane);
  struct { bf16x8 vs0, vs1, ks0, ks1; } sr_[SDEPTH];
#define SLOAD(i, jt) do { const bf16* rb_ = U + (size_t)(tile_row(u, (jt)) + sr) * NINP + sc; \
    sr_[i].vs0 = *reinterpret_cast<const bf16x8*>(rb_ + vcol); sr_[i].vs1 = *reinterpret_cast<const bf16x8*>(rb_ + (size_t)32 * NINP + vcol); \
    sr_[i].ks0 = *reinterpret_cast<const bf16x8*>(rb_ + kcol); sr_[i].ks1 = *reinterpret_cast<const bf16x8*>(rb_ + (size_t)32 * NINP + kcol); } while (0)
#define SWRITE(b, i) do { *(LAS bf16x8*)(V_lds + (b) * SHM_V + vst0) = sr_[i].vs0;          \
    *(LAS bf16x8*)(V_lds + (b) * SHM_V + vst1) = sr_[i].vs1; int kc = sc * 2;               \
    *(LAS bf16x8*)(K_lds + (b) * SHM_K + KSWZ(sr, kc)) = sr_[i].ks0;                       \
    *(LAS bf16x8*)(K_lds + (b) * SHM_K + KSWZ(32 + sr, kc)) = sr_[i].ks1; } while (0)
#define SWAIT() do { if constexpr (SDEPTH == 2) asm volatile("s_waitcnt vmcnt(4)" ::: "memory"); else asm volatile("s_waitcnt vmcnt(0)" ::: "memory"); } while (0)
#define RESC(a) do { if (__any((a) < 1.f)) { if (hi == 0) al_l[r32] = (a); asm volatile("s_waitcnt lgkmcnt(0)" ::: "memory"); \
    _Pragma("unroll") for (int d = 0; d < 4; ++d) _Pragma("unroll") for (int r = 0; r < 16; ++r) o[d][r] *= al_l[crow(r, hi)]; } } while (0)
  f32x16 pA0, pA1, pB0, pB1; float mnA, mnB, alA, alB; bf16x8 pa0, pa1, pa2, pa3; const int NT = u.nloc + 4;
  constexpr int SE = 0, SO = SDEPTH - 1;
  SLOAD(SE, 0); asm volatile("s_waitcnt vmcnt(0)" ::: "memory"); SWRITE(0, SE); __syncthreads();
#define SCORE(P0, P1, KB, jt, ACT) do { ACT = tile_active(u, (jt), wid); if (ACT) { qkt(P0, P1, KB, qr, r32, hi); apply_mask(P0, P1, u, (jt), wid, r32, hi, rpbL); } else fill_ninf(P0, P1); } while (0)
  bool actA, actB;
  SCORE(pA0, pA1, K_lds, 0, actA); partialSM(pA0, pA1, m_reg, mnA, alA);
  SLOAD(SO, 1); if constexpr (SDEPTH == 2) { if (2 < NT) SLOAD(SE, 2); }
  SWAIT(); SWRITE(1, SO); __syncthreads();
  for (int j = 1; j + 1 < NT; j += 2) {
    SBAR(); SCORE(pB0, pB1, K_lds + SHM_K, j, actB);
    finishSM(pA0, pA1, alA, l_reg, pa0, pa1, pa2, pa3); SBAR();
    SLOAD(SO, j + SDEPTH); SBAR();
    if (actA) pv_d0(o, vb0, pa0, pa1, pa2, pa3); partialSM(pB0, pB1, m_reg, mnB, alB);
    __syncthreads(); SWAIT(); SWRITE(0, SE);
    RESC(alB); __syncthreads();
    SBAR(); SCORE(pA0, pA1, K_lds, j + 1, actA);
    finishSM(pB0, pB1, alB, l_reg, pa0, pa1, pa2, pa3); SBAR();
    if (SDEPTH == 1 || j + 3 < NT) SLOAD(SE, j + 1 + SDEPTH); SBAR();
    if (actB) pv_d0(o, vb0 + SHM_V, pa0, pa1, pa2, pa3); partialSM(pA0, pA1, m_reg, mnA, alA);
    __syncthreads(); SWAIT(); SWRITE(1, SO);
    RESC(alA); __syncthreads();
  }
  SBAR(); SCORE(pB0, pB1, K_lds + SHM_K, NT - 1, actB);
  finishSM(pA0, pA1, alA, l_reg, pa0, pa1, pa2, pa3); SBAR();
  if (actA) pv_d0(o, vb0, pa0, pa1, pa2, pa3); partialSM(pB0, pB1, m_reg, mnB, alB);
  __syncthreads(); RESC(alB);
  finishSM(pB0, pB1, alB, l_reg, pa0, pa1, pa2, pa3); SBAR();
  if (actB) pv_d0(o, vb0 + SHM_V, pa0, pa1, pa2, pa3);
  if (u.type & 1) { constexpr float C = ATT_SCALE * 1.4426950408889634f; l_reg += __builtin_amdgcn_exp2f((p.wa_sink[l * 4 + u.hh] * (1.f / ATT_SCALE) - m_reg) * C); }
  if (hi == 0) li_l[r32] = l_reg; asm volatile("s_waitcnt lgkmcnt(0)" ::: "memory");
  float rli[16];
#pragma unroll
  for (int r = 0; r < 16; ++r) rli[r] = __builtin_amdgcn_rcpf(li_l[crow(r, hi)]);
  bf16* Ow = MIX + (size_t)(qrow0 + wid * 32) * DM + ocol;
#pragma unroll
  for (int r = 0; r < 16; r += 2) {
#pragma unroll
    for (int d0 = 0; d0 < 4; ++d0) {
      const float a = o[d0][r] * rli[r], b = o[d0][r + 1] * rli[r + 1];
      const float send = (lane & 1) ? a : b, got = __shfl_xor(send, 1);
      const int orow = crow(r, hi) + (lane & 1), ocl = d0 * 32 + (r32 & ~1);
      if (F8_OUTPROJ) { const float lo = ((lane & 1) ? got : a) * MIX_SCALE, hi2 = ((lane & 1) ? b : got) * MIX_SCALE;
        *(unsigned short*)((unsigned char*)MIX + (size_t)(qrow0 + wid * 32 + orow) * DM + ocol + ocl) = (unsigned short)pack4f8(lo, hi2, 0.f, 0.f); }
      else { const unsigned w = (lane & 1) ? pk2(got, b) : pk2(a, got); *(unsigned*)(Ow + (size_t)orow * DM + ocl) = w; } } }
  __syncthreads();
#undef SCORE
#undef SLOAD
#undef SWRITE
#undef SWAIT
#undef RESC
}
constexpr int NSLOT = 3;
constexpr int OFFD_K = 0, OFFD_V = NSLOT * SHM_K, OFFD_WS = NSLOT * (SHM_K + SHM_V), OFFD_RPB = OFFD_WS + 8 * 64 * 4, ATT_LDS_D = OFFD_RPB + 576 * 4;
static_assert(ATT_LDS_D <= RING_BYTES, "attention LDS");
__device__ __forceinline__ void attn_unit_dma(const Prm& p, int l, const UnitD u, LAS unsigned char* lds, int tid) {
  const bf16* U = (const bf16*)(p.ws + WS_U); bf16* MIX = (bf16*)(p.ws + WS_H);
  const int wid = __builtin_amdgcn_readfirstlane(tid >> 6), lane = tid & 63, r32 = lane & 31, hi = lane >> 5;
  int qcol, kcol, vcol, ocol;
  if (u.type == 0 || u.type == 2) { qcol = C_QA + u.hh * 128; kcol = C_KA + u.hh * 128; vcol = C_VA + u.hh * 128; ocol = u.hh * 128; }
  else { const int kvh = u.hh >> 1; qcol = C_QB + u.hh * 128; kcol = C_KB + kvh * 128; vcol = C_VB + kvh * 128; ocol = 512 + u.hh * 128; }
  const int qrow0 = (u.type < 2 ? u.b * SEQL : T_LAT + u.b * CTXL) + u.q0;
  LAS unsigned char* K_lds = lds + OFFD_K; LAS unsigned char* V_lds = lds + OFFD_V;
  LAS float* wsl = (LAS float*)(lds + OFFD_WS) + wid * 64; LAS float* li_l = wsl; LAS float* al_l = wsl + 32;
  LAS float* rpbL = (LAS float*)(lds + OFFD_RPB);
  if (u.type == 0 && tid < 465) rpbL[32 + tid] = p.na_rpb[(size_t)(l * 4 + u.hh) * 465 + tid] * (1.f / ATT_SCALE);
  float m_reg = -1e30f, l_reg = 0; f32x16 o[4] = {}; bf16x8 qr[8];
  const bf16* Qw = U + (size_t)(qrow0 + wid * 32 + r32) * NINP + qcol + hi * 8;
#pragma unroll
  for (int d0 = 0; d0 < 8; ++d0) qr[d0] = *reinterpret_cast<const bf16x8*>(Qw + d0 * 16);
  unsigned koff[2], voff[2];
#pragma unroll
  for (int i = 0; i < 2; ++i) { const int pch = (wid * 2 + i) * 64 + lane;
    { const int row = pch >> 4, c = (pch & 15) ^ (row & 15); koff[i] = (unsigned)(row * NINP + kcol + c * 8); }
    { const int sidx = pch >> 5, q = pch & 31, kk = (sidx >> 2) * 8 + (q >> 2), k = (kk & ~0xC) | ((kk & 4) << 1) | ((kk & 8) >> 1);
      voff[i] = (unsigned)(k * NINP + vcol + (sidx & 3) * 32 + (q & 3) * 8); } }
  const int vb0 = (int)(uintptr_t)V_lds + v_rd_base(lane);
#define DMA_K(jt) do { const bf16* tb_ = U + (size_t)tile_row(u, (jt)) * NINP; LAS unsigned char* dst_ = K_lds + ((jt) % NSLOT) * SHM_K + wid * 2048; \
    _Pragma("unroll") for (int i_ = 0; i_ < 2; ++i_) __builtin_amdgcn_global_load_lds((const unsigned*)(tb_ + koff[i_]), (LAS unsigned*)(dst_ + i_ * 1024), 16, 0, 0); } while (0)
#define DMA_V(jt) do { const bf16* tb_ = U + (size_t)tile_row(u, (jt)) * NINP; LAS unsigned char* dst_ = V_lds + ((jt) % NSLOT) * SHM_V + wid * 2048; \
    _Pragma("unroll") for (int i_ = 0; i_ < 2; ++i_) __builtin_amdgcn_global_load_lds((const unsigned*)(tb_ + voff[i_]), (LAS unsigned*)(dst_ + i_ * 1024), 16, 0, 0); } while (0)
#define STEP_SYNC4() asm volatile("s_waitcnt vmcnt(4) lgkmcnt(0)\n\ts_barrier" ::: "memory")
#define STEP_SYNC0() asm volatile("s_waitcnt vmcnt(0) lgkmcnt(0)\n\ts_barrier" ::: "memory")
#define RESC(a) do { if (__any((a) < 1.f)) { if (hi == 0) al_l[r32] = (a); asm volatile("s_waitcnt lgkmcnt(0)" ::: "memory"); \
    _Pragma("unroll") for (int d = 0; d < 4; ++d) _Pragma("unroll") for (int r = 0; r < 16; ++r) o[d][r] *= al_l[crow(r, hi)]; } } while (0)
#define SCORE(P0, P1, jt, ACT) do { ACT = tile_active(u, (jt), wid); if (ACT) { qkt(P0, P1, K_lds + ((jt) % NSLOT) * SHM_K, qr, r32, hi); apply_mask(P0, P1, u, (jt), wid, r32, hi, rpbL); } else fill_ninf(P0, P1); } while (0)
  f32x16 pA0, pA1, pB0, pB1; float mnA, mnB, alA, alB; bf16x8 pa0, pa1, pa2, pa3; const int NT = u.nloc + 4; bool actA, actB;
  DMA_K(0); DMA_K(1); DMA_V(0);
  PAT_SYNC(STEP_SYNC4());
  DMA_K(2); DMA_V(1);
  SCORE(pA0, pA1, 0, actA); partialSM(pA0, pA1, m_reg, mnA, alA);
#pragma unroll 1
  for (int s = 1; s + 1 < NT; s += 2) {
    PAT_SYNC(STEP_SYNC4());
    DMA_K(s + 2); DMA_V(s + 1);
    SBAR(); SCORE(pB0, pB1, s, actB);
    finishSM(pA0, pA1, alA, l_reg, pa0, pa1, pa2, pa3); SBAR();
    if (actA) pv_d0(o, vb0 + ((s - 1) % NSLOT) * SHM_V, pa0, pa1, pa2, pa3); partialSM(pB0, pB1, m_reg, mnB, alB);
    RESC(alB);
    PAT_SYNC(STEP_SYNC4());
    if (s + 3 < NT) DMA_K(s + 3); DMA_V(s + 2);
    SBAR(); SCORE(pA0, pA1, s + 1, actA);
    finishSM(pB0, pB1, alB, l_reg, pa0, pa1, pa2, pa3); SBAR();
    if (actB) pv_d0(o, vb0 + (s % NSLOT) * SHM_V, pa0, pa1, pa2, pa3); partialSM(pA0, pA1, m_reg, mnA, alA);
    RESC(alA);
  }
  PAT_SYNC(STEP_SYNC0());
  SBAR(); SCORE(pB0, pB1, NT - 1, actB);
  finishSM(pA0, pA1, alA, l_reg, pa0, pa1, pa2, pa3); SBAR();
  if (actA) pv_d0(o, vb0 + ((NT - 2) % NSLOT) * SHM_V, pa0, pa1, pa2, pa3); partialSM(pB0, pB1, m_reg, mnB, alB);
  RESC(alB);
  finishSM(pB0, pB1, alB, l_reg, pa0, pa1, pa2, pa3); SBAR();
  if (actB) pv_d0(o, vb0 + ((NT - 1) % NSLOT) * SHM_V, pa0, pa1, pa2, pa3);
  if (u.type & 1) { constexpr float C = ATT_SCALE * 1.4426950408889634f; l_reg += __builtin_amdgcn_exp2f((p.wa_sink[l * 4 + u.hh] * (1.f / ATT_SCALE) - m_reg) * C); }
  if (hi == 0) li_l[r32] = l_reg; asm volatile("s_waitcnt lgkmcnt(0)" ::: "memory");
  float rli[16];
#pragma unroll
  for (int r = 0; r < 16; ++r) rli[r] = __builtin_amdgcn_rcpf(li_l[crow(r, hi)]);
  bf16* Ow = MIX + (size_t)(qrow0 + wid * 32) * DM + ocol;
#pragma unroll
  for (int r = 0; r < 16; r += 2) {
#pragma unroll
    for (int d0 = 0; d0 < 4; ++d0) {
      const float a = o[d0][r] * rli[r], b = o[d0][r + 1] * rli[r + 1];
      const float send = (lane & 1) ? a : b, got = __shfl_xor(send, 1);
      const int orow = crow(r, hi) + (lane & 1), ocl = d0 * 32 + (r32 & ~1);
      if (F8_OUTPROJ) { const float lo = ((lane & 1) ? got : a) * MIX_SCALE, hi2 = ((lane & 1) ? b : got) * MIX_SCALE;
        *(unsigned short*)((unsigned char*)MIX + (size_t)(qrow0 + wid * 32 + orow) * DM + ocol + ocl) = (unsigned short)pack4f8(lo, hi2, 0.f, 0.f); }
      else { const unsigned w = (lane & 1) ? pk2(got, b) : pk2(a, got); *(unsigned*)(Ow + (size_t)orow * DM + ocl) = w; } } }
  asm volatile("s_waitcnt lgkmcnt(0)\n\ts_barrier" ::: "memory");
#undef DMA_K
#undef DMA_V
#undef STEP_SYNC4
#undef STEP_SYNC0
#undef RESC
#undef SCORE
}
#ifndef ATT_DMA
#define ATT_DMA 1
#endif
__device__ __forceinline__ void phase_attn(const Prm& p, int l, LAS unsigned char* lds, int wg, int nwg, int tid) {
    const int nu = 512 + (l == 0 ? 16 : 0);
    for (int it = wg; it < nu; it += nwg) {
        UnitD u;
        if (it < 256) { u.type = 0; u.b = it >> 7; u.hh = (it >> 5) & 3; const int blk = it & 31; u.q0 = blk * 256; u.nloc = 12; u.kbase = min(max(blk * 4 - 4, 0), 116); }
        else if (it < 512) { const int r = it - 256; u.type = 1; u.b = r >> 7; u.hh = (r >> 5) & 3; const int blk = r & 31; u.q0 = blk * 256; u.nloc = 8; u.kbase = blk * 256 - 128; }
        else { const int r = it - 512; u.type = 2 + (r >> 3); u.b = (r >> 2) & 1; u.hh = r & 3; u.q0 = 0; u.nloc = 0; u.kbase = 0; }
        if (ATT_DMA) attn_unit_dma(p, l, u, lds, tid); else attn_unit(p, l, u, lds, tid);
    }
}
}
__device__ __forceinline__ void lds_barrier() { asm volatile("s_waitcnt lgkmcnt(0)\n\ts_barrier" ::: "memory"); }
namespace ssd {
typedef short s16x4 __attribute__((ext_vector_type(4)));
typedef float f32x16 __attribute__((ext_vector_type(16)));
constexpr int NCH = 66;
constexpr size_t WS_ST = WS_YD, WS_HS = WS_YD + 66 * MiB, WS_DEC = 1259 * MiB;
__device__ __forceinline__ int crow(int r, int hi) { return (r & 3) + 8 * (r >> 2) + 4 * hi; }
__device__ __forceinline__ int chunk_row0(int b, int c) { return c < 2 ? T_LAT + b * CTXL + c * 128 : b * SEQL + (c - 2) * 128; }
__device__ __forceinline__ s16x4 ds_tr(unsigned addr) { s16x4 r; asm volatile("ds_read_b64_tr_b16 %0, %1" : "=&v"(r) : "v"(addr) : "memory"); return r; }
struct Raw { s16x4 lo, hi; };
__device__ __forceinline__ Raw raw_tr_nat(unsigned base, int stride, int k0, int idx0, int lane) {
    const int i16 = lane & 15, g16 = (lane >> 4) & 1, hl = lane >> 5;
    const unsigned a = base + (unsigned)((k0 + 8 * hl + (i16 >> 2)) * stride + (idx0 + 16 * g16 + 4 * (i16 & 3)) * 2);
    Raw r; r.lo = ds_tr(a); r.hi = ds_tr(a + 4 * stride); return r;
}
__device__ __forceinline__ Raw raw_tr_acc(unsigned base, int stride, int k0, int idx0, int lane) {
    const int i16 = lane & 15, g16 = (lane >> 4) & 1, hl = lane >> 5;
    const unsigned a = base + (unsigned)((k0 + 4 * hl + (i16 >> 2)) * stride + (idx0 + 16 * g16 + 4 * (i16 & 3)) * 2);
    Raw r; r.lo = ds_tr(a); r.hi = ds_tr(a + 8 * stride); return r;
}
__device__ __forceinline__ void raw_wait2(Raw& a, Raw& b) { asm volatile("s_waitcnt lgkmcnt(0)" : "+v"(a.lo), "+v"(a.hi), "+v"(b.lo), "+v"(b.hi) :: "memory"); }
__device__ __forceinline__ void raw_wait6(Raw& a, Raw& b, Raw& c, Raw& d, Raw& e, Raw& f) {
    asm volatile("s_waitcnt lgkmcnt(0)" : "+v"(a.lo), "+v"(a.hi), "+v"(b.lo), "+v"(b.hi), "+v"(c.lo), "+v"(c.hi), "+v"(d.lo), "+v"(d.hi), "+v"(e.lo), "+v"(e.hi), "+v"(f.lo), "+v"(f.hi) :: "memory"); }
__device__ __forceinline__ bf16x8 join8(const Raw& r) { return (bf16x8){r.lo[0], r.lo[1], r.lo[2], r.lo[3], r.hi[0], r.hi[1], r.hi[2], r.hi[3]}; }
__device__ __forceinline__ unsigned cvtpk(float lo, float hi) { unsigned r; asm volatile("v_cvt_pk_bf16_f32 %0, %1, %2\n\ts_nop 1" : "=v"(r) : "v"(lo), "v"(hi)); return r; }
__device__ __forceinline__ void scan128(float& v0, float& v1, int lane) {
#pragma unroll
    for (int o = 1; o < 64; o <<= 1) { const int src = (lane >= o ? lane - o : lane) << 2;
        const float t0 = __builtin_bit_cast(float, __builtin_amdgcn_ds_bpermute(src, __builtin_bit_cast(int, v0))), t1 = __builtin_bit_cast(float, __builtin_amdgcn_ds_bpermute(src, __builtin_bit_cast(int, v1)));
        if (lane >= o) { v0 += t0; v1 += t1; } }
    v1 += __builtin_bit_cast(float, __builtin_amdgcn_ds_bpermute(63 << 2, __builtin_bit_cast(int, v0)));
}
__device__ __forceinline__ float lane63(float v) { return __builtin_bit_cast(float, __builtin_amdgcn_ds_bpermute(63 << 2, __builtin_bit_cast(int, v))); }

constexpr int BST = 320, XST = 576;
constexpr int S2_B = 0, S2_X = 128 * BST, S2_W = S2_X + 128 * XST, S2_END = S2_W + 8 * 128 * 4;
__device__ __forceinline__ void phase_states(const Prm& p, int l, LAS unsigned char* lds, int wg, int nwg, int tid) {
    const bf16* XA = (const bf16*)(p.ws + WS_XBC); const float* DT = (const float*)(p.ws + WS_DT);
    bf16* ST = (bf16*)(p.ws + WS_ST); float* DEC = (float*)(p.ws + WS_DEC);
    const int wid = __builtin_amdgcn_readfirstlane(tid >> 6), lane = tid & 63, hl = lane >> 5;
    for (int it = wg; it < 2 * NCH * 4; it += nwg) {
        const int b = it / (NCH * 4), rem = it % (NCH * 4), c = rem >> 2, g = (rem >> 1) & 1, hq = rem & 1;
        const int row0 = chunk_row0(b, c), h = 8 * g + 4 * hq + (wid & 3), dir = wid >> 2;
        { v4u tb[4], tx[8];
#pragma unroll
          for (int i = 0; i < 4; ++i) { const int id = tid + 512 * i, r = id >> 4, ch = id & 15; tb[i] = *(const v4u*)(XA + (size_t)(row0 + r) * XBCW + 1024 + g * 128 + ch * 8); }
#pragma unroll
          for (int i = 0; i < 8; ++i) { const int id = tid + 512 * i, r = id >> 5, ch = id & 31; tx[i] = *(const v4u*)(XA + (size_t)(row0 + r) * XBCW + (8 * g + 4 * hq) * 64 + ch * 8); }
#pragma unroll
          for (int i = 0; i < 4; ++i) { const int id = tid + 512 * i, r = id >> 4, ch = id & 15; *(LAS v4u*)(lds + S2_B + r * BST + ch * 16) = tb[i]; }
#pragma unroll
          for (int i = 0; i < 8; ++i) { const int id = tid + 512 * i, r = id >> 5, ch = id & 31; *(LAS v4u*)(lds + S2_X + r * XST + ch * 16) = tx[i]; } }
        const float a = -__expf(p.a_log[l * 32 + dir * 16 + h]);
        const float d0 = DT[(size_t)(row0 + lane) * 32 + dir * 16 + h], d1 = DT[(size_t)(row0 + 64 + lane) * 32 + dir * 16 + h];
        float P0 = a * d0, P1 = a * d1; scan128(P0, P1, lane);
        const float tot = lane63(P1);
        LAS float* wL = (LAS float*)(lds + S2_W) + wid * 128;
        wL[lane] = (dir == 0 ? __expf(tot - P0) : __expf(P0 - a * d0)) * d0;
        wL[64 + lane] = (dir == 0 ? __expf(tot - P1) : __expf(P1 - a * d1)) * d1;
        if (lane == 0) DEC[((b * NCH + c) * 2 + dir) * 16 + h] = __expf(tot);
        __syncthreads();
        f32x16 acc[2][4];
#pragma unroll
        for (int i = 0; i < 2; ++i)
#pragma unroll
            for (int j = 0; j < 4; ++j) acc[i][j] = f32x16{};
        const unsigned bB = (unsigned)(uintptr_t)(lds + S2_B), bX = (unsigned)(uintptr_t)(lds + S2_X);
#pragma unroll 1
        for (int ks = 0; ks < 8; ++ks) {
            const f32x4 w0 = *(const LAS f32x4*)(wL + 16 * ks + 8 * hl), w1 = *(const LAS f32x4*)(wL + 16 * ks + 8 * hl + 4);
            bf16x8 xa[2], bb[4];
            { Raw rx0 = raw_tr_nat(bX, XST, 16 * ks, (wid & 3) * 64, lane), rx1 = raw_tr_nat(bX, XST, 16 * ks, (wid & 3) * 64 + 32, lane);
              Raw rb0 = raw_tr_nat(bB, BST, 16 * ks, 0, lane), rb1 = raw_tr_nat(bB, BST, 16 * ks, 32, lane), rb2 = raw_tr_nat(bB, BST, 16 * ks, 64, lane), rb3 = raw_tr_nat(bB, BST, 16 * ks, 96, lane);
              raw_wait6(rx0, rx1, rb0, rb1, rb2, rb3);
              xa[0] = join8(rx0); xa[1] = join8(rx1); bb[0] = join8(rb0); bb[1] = join8(rb1); bb[2] = join8(rb2); bb[3] = join8(rb3); }
#pragma unroll
            for (int pt = 0; pt < 2; ++pt) {
                v4u q = *reinterpret_cast<v4u*>(&xa[pt]);
                q.x = cvtpk(bflo(q.x) * w0[0], bfhi(q.x) * w0[1]); q.y = cvtpk(bflo(q.y) * w0[2], bfhi(q.y) * w0[3]);
                q.z = cvtpk(bflo(q.z) * w1[0], bfhi(q.z) * w1[1]); q.w = cvtpk(bflo(q.w) * w1[2], bfhi(q.w) * w1[3]);
                xa[pt] = *reinterpret_cast<bf16x8*>(&q); }
#pragma unroll
            for (int pt = 0; pt < 2; ++pt)
#pragma unroll
                for (int nt = 0; nt < 4; ++nt) acc[pt][nt] = __builtin_amdgcn_mfma_f32_32x32x16_bf16(xa[pt], bb[nt], acc[pt][nt], 0, 0, 0);
        }
        lds_barrier();
        { LAS unsigned char* tile = lds + wid * 16384;
          const int swz = (lane & 1) | (hl << 1);
          LAS unsigned char* wbase = tile + ((lane & 1) + 4 * hl) * 256 + (((lane & 31) >> 1) << 2);
#pragma unroll
          for (int nt = 0; nt < 4; ++nt) { LAS unsigned char* wb = wbase + ((nt ^ swz) << 6);
#pragma unroll
            for (int pt = 0; pt < 2; ++pt)
#pragma unroll
                for (int r = 0; r < 16; r += 2) {
                    const float x0 = acc[pt][nt][r], x1 = acc[pt][nt][r + 1];
                    const float send = (lane & 1) ? x0 : x1, got = __builtin_bit_cast(float, __builtin_amdgcn_update_dpp(0, __builtin_bit_cast(int, send), 0xB1, 0xF, 0xF, false));
                    const unsigned w = (lane & 1) ? pk2(got, x1) : pk2(x0, got);
                    *(LAS unsigned*)(wb + (pt * 32 + crow(r, 0)) * 256) = w; } }
          LDS_WAIT(); asm volatile("" ::: "memory");
          bf16* so = ST + ((size_t)((b * NCH + c) * 2 + dir) * 16 + h) * 8192 + (size_t)(lane >> 4) * 128 + (lane & 15) * 8;
          const LAS unsigned char* rb0 = tile + (lane >> 4) * 256 + (((lane & 15) ^ (((lane >> 4) & 1) << 2)) << 4);
          const LAS unsigned char* rb1 = tile + (lane >> 4) * 256 + (((lane & 15) ^ (((lane >> 4) & 1) << 2) ^ 8) << 4);
#pragma unroll
          for (int ps = 0; ps < 16; ++ps) { const v4u w = *(const LAS v4u*)(((ps & 1) ? rb1 : rb0) + ps * 1024);
              *(v4u*)(so + ps * 512) = w; } }
        lds_barrier();
    }
}

__device__ __forceinline__ void phase_scan(const Prm& p, int gtid, int ngt) {
    const bf16* ST = (const bf16*)(p.ws + WS_ST); bf16* HS = (bf16*)(p.ws + WS_HS); const float* DEC = (const float*)(p.ws + WS_DEC);
    constexpr int NB = 22; static_assert(NCH % NB == 0, "scan batches");
    for (int e = gtid; e < 2 * 2 * 16 * 2048; e += ngt) {
        const int q = e & 2047, hu = __builtin_amdgcn_readfirstlane(e >> 11), h = hu & 15, dir = (hu >> 4) & 1, b = hu >> 5;
        f32x4 hs = {0.f, 0.f, 0.f, 0.f};
#pragma unroll 1
        for (int i0 = 0; i0 < NCH; i0 += NB) {
            v2u sv[NB]; float dc[NB];
#pragma unroll
            for (int k = 0; k < NB; ++k) { const int i = i0 + k, c = dir == 0 ? i : (i < 2 ? 1 - i : NCH + 1 - i);
                sv[k] = __builtin_nontemporal_load((const v2u*)(ST + ((size_t)((b * NCH + c) * 2 + dir) * 16 + h) * 8192 + q * 4)); dc[k] = DEC[((b * NCH + c) * 2 + dir) * 16 + h]; }
#pragma unroll
            for (int k = 0; k < NB; ++k) { const int i = i0 + k, c = dir == 0 ? i : (i < 2 ? 1 - i : NCH + 1 - i);
                v2u o; o.x = pk2(hs[0], hs[1]); o.y = pk2(hs[2], hs[3]); *(v2u*)(HS + ((size_t)((b * NCH + c) * 2 + dir) * 16 + h) * 8192 + q * 4) = o;
                hs[0] = dc[k] * hs[0] + bflo(sv[k].x); hs[1] = dc[k] * hs[1] + bfhi(sv[k].x); hs[2] = dc[k] * hs[2] + bflo(sv[k].y); hs[3] = dc[k] * hs[3] + bfhi(sv[k].y); }
        }
    }
}

constexpr int CST = 272, XSS = 80;
constexpr size_t WS_Y = WS_XG;
constexpr int S4_B = 0, S4_C = 128 * CST, S4_X = 2 * 128 * CST, S4_ARR = 3 * 128 * CST, S4_YX = S4_ARR + 8 * 2 * 128 * 4, S4_END = S4_YX + 4 * 16 * 64 * 4;
static_assert(S4_END <= RING_BYTES && S2_END <= RING_BYTES && 8 * 32 * XSS <= 128 * CST, "ssd LDS");
__device__ __forceinline__ void phase_ssd_out(const Prm& p, int l, LAS unsigned char* lds, int wg, int nwg, int tid) {
    const bf16* XA = (const bf16*)(p.ws + WS_XBC); const float* DT = (const float*)(p.ws + WS_DT); const bf16* HS = (const bf16*)(p.ws + WS_HS);
    bf16* Y = (bf16*)(p.ws + WS_Y);
    const int wid = __builtin_amdgcn_readfirstlane(tid >> 6), lane = tid & 63, hl = lane >> 5, l31 = lane & 31, pt = (wid >> 1) & 1, dir = wid >> 2;
    const int c_lo = (l == 0) ? 0 : 2, ncu = NCH - c_lo;
    for (int it = wg; it < 2 * ncu * 8; it += nwg) {
        const int b = it / (ncu * 8), rem = it % (ncu * 8), c = c_lo + (rem >> 3), g = (rem >> 2) & 1, hp = rem & 3, h = 8 * g + 2 * hp + (wid & 1);
        const int row0 = chunk_row0(b, c);
        { v4u tb[4], tc[4];
#pragma unroll
          for (int i = 0; i < 4; ++i) { const int id = tid + 512 * i, r = id >> 4, ch = id & 15; const bf16* src = XA + (size_t)(row0 + r) * XBCW + g * 128 + ch * 8; tb[i] = *(const v4u*)(src + 1024); tc[i] = *(const v4u*)(src + 1280); }
#pragma unroll
          for (int i = 0; i < 4; ++i) { const int id = tid + 512 * i, r = id >> 4, ch = id & 15; *(LAS v4u*)(lds + S4_B + r * CST + ch * 16) = tb[i]; *(LAS v4u*)(lds + S4_C + r * CST + ch * 16) = tc[i]; } }
        v4u tx[4];
#pragma unroll
        for (int i = 0; i < 4; ++i) { const int id = tid + 512 * i, r = id >> 4, ch = id & 15; tx[i] = *(const v4u*)(XA + (size_t)(row0 + r) * XBCW + (8 * g + 2 * hp) * 64 + ch * 8); }
        bf16x8 hs[8];
        { const bf16* hp_ = HS + ((size_t)((b * NCH + c) * 2 + dir) * 16 + h) * 8192 + (size_t)(pt * 32 + l31) * 128 + 8 * hl;
#pragma unroll
          for (int ks = 0; ks < 8; ++ks) hs[ks] = __builtin_nontemporal_load((const bf16x8*)(hp_ + 16 * ks)); }
        LAS float* QL = (LAS float*)(lds + S4_ARR) + wid * 256; LAS float* DL = QL + 128;
        float ebase;
        { const float a = -__expf(p.a_log[l * 32 + dir * 16 + h]);
          const float d0 = DT[(size_t)(row0 + lane) * 32 + dir * 16 + h], d1 = DT[(size_t)(row0 + 64 + lane) * 32 + dir * 16 + h];
          float q0 = a * d0, q1 = a * d1; scan128(q0, q1, lane); const float tot = lane63(q1);
          QL[lane] = dir == 0 ? q0 : a * d0 - q0; QL[64 + lane] = dir == 0 ? q1 : a * d1 - q1; DL[lane] = d0; DL[64 + lane] = d1; ebase = dir == 0 ? 0.f : tot; }
        lds_barrier();
#pragma unroll
        for (int j = 0; j < 2; ++j) { const int id = wid * 2 + j, st = id >> 2, tt = id & 3; f32x16 X = f32x16{};
#pragma unroll
            for (int ks = 0; ks < 8; ++ks) { const bf16x8 bfr = *(const LAS bf16x8*)(lds + S4_B + (st * 32 + l31) * CST + (16 * ks + 8 * hl) * 2), cfr = *(const LAS bf16x8*)(lds + S4_C + (tt * 32 + l31) * CST + (16 * ks + 8 * hl) * 2);
                X = __builtin_amdgcn_mfma_f32_32x32x16_bf16(bfr, cfr, X, 0, 0, 0); }
#pragma unroll
            for (int i = 0; i < 4; ++i) { v2u w; w.x = pk2(X[4 * i], X[4 * i + 1]); w.y = pk2(X[4 * i + 2], X[4 * i + 3]);
                *(LAS v2u*)(lds + S4_X + (tt * 32 + l31) * CST + (st * 32 + 8 * i + 4 * hl) * 2) = w; } }
        lds_barrier();
        bf16x8 xf[8];
        {
#pragma unroll
          for (int i = 0; i < 4; ++i) { const int id = tid + 512 * i, r = id >> 4, ch = id & 15; *(LAS v4u*)(lds + S4_B + r * CST + ch * 16) = tx[i]; }
          lds_barrier();
          const unsigned bXs = (unsigned)(uintptr_t)(lds + S4_B); const int c0 = (wid & 1) * 64 + pt * 32;
#pragma unroll
          for (int q = 0; q < 4; ++q) { Raw r0 = raw_tr_acc(bXs, CST, 32 * q, c0, lane), r1 = raw_tr_acc(bXs, CST, 32 * q + 16, c0, lane); raw_wait2(r0, r1); xf[2 * q] = join8(r0); xf[2 * q + 1] = join8(r1); }
        }
        const float dsum = p.d_skip[l * 32 + h] + p.d_skip[l * 32 + 16 + h];
        LAS float* YX = (LAS float*)(lds + S4_YX) + (wid & 3) * 1024;
#pragma unroll 1
        for (int tt = 0; tt < 4; ++tt) {
            const int tl = tt * 32 + l31;
            const float Qt = QL[tl];
            f32x16 yacc = f32x16{};
#pragma unroll
            for (int st = 0; st < 4; ++st) {
                if (dir == 0 ? (st > tt) : (st < tt)) continue;
                __builtin_amdgcn_sched_barrier(0);
                float mv[16];
#define SSD_BLK(OK) _Pragma("unroll") for (int i = 0; i < 4; ++i) { const v2u w = *(const LAS v2u*)(lds + S4_X + tl * CST + (st * 32 + 8 * i + 4 * hl) * 2); \
                    const f32x4 qv = *(const LAS f32x4*)(QL + st * 32 + 8 * i + 4 * hl), dv = *(const LAS f32x4*)(DL + st * 32 + 8 * i + 4 * hl); \
                    const float xv[4] = {bflo(w.x), bfhi(w.x), bflo(w.y), bfhi(w.y)}; \
                    _Pragma("unroll") for (int j = 0; j < 4; ++j) { const int s = st * 32 + 8 * i + 4 * hl + j; (void)s; mv[4 * i + j] = (OK) ? __expf(Qt - qv[j]) * dv[j] * xv[j] : 0.f; } }
                if (st != tt) { SSD_BLK(true) } else { SSD_BLK(dir == 0 ? (s <= tl) : (s >= tl)) }
#undef SSD_BLK
#pragma unroll
                for (int s2 = 0; s2 < 2; ++s2) { v4u q; q.x = cvtpk(mv[8 * s2 + 0], mv[8 * s2 + 1]); q.y = cvtpk(mv[8 * s2 + 2], mv[8 * s2 + 3]); q.z = cvtpk(mv[8 * s2 + 4], mv[8 * s2 + 5]); q.w = cvtpk(mv[8 * s2 + 6], mv[8 * s2 + 7]);
                    yacc = __builtin_amdgcn_mfma_f32_32x32x16_bf16(xf[2 * st + s2], *reinterpret_cast<bf16x8*>(&q), yacc, 0, 0, 0); }
            }
            __builtin_amdgcn_sched_barrier(0);
            { const LAS unsigned char* cfp = lds + S4_C + tl * CST + 16 * hl; f32x16 G = f32x16{};
#pragma unroll
              for (int ks = 0; ks < 8; ++ks) G = __builtin_amdgcn_mfma_f32_32x32x16_bf16(hs[ks], *(const LAS bf16x8*)(cfp + 32 * ks), G, 0, 0, 0);
              const float e = __expf(ebase + Qt);
#pragma unroll
              for (int r = 0; r < 16; ++r) yacc[r] += e * G[r]; }
            if (dir == 1) {
#pragma unroll
                for (int r = 0; r < 16; ++r) YX[r * 64 + lane] = yacc[r]; }
            lds_barrier();
            if (dir == 0) {
                v2u ow[4];
#pragma unroll
                for (int i = 0; i < 4; ++i) { const v2u xw = *(const LAS v2u*)(lds + S4_B + tl * CST + ((wid & 1) * 64 + pt * 32 + 8 * i + 4 * hl) * 2);
                    f32x4 o; o[0] = yacc[4 * i] + YX[(4 * i) * 64 + lane] + dsum * bflo(xw.x); o[1] = yacc[4 * i + 1] + YX[(4 * i + 1) * 64 + lane] + dsum * bfhi(xw.x);
                    o[2] = yacc[4 * i + 2] + YX[(4 * i + 2) * 64 + lane] + dsum * bflo(xw.y); o[3] = yacc[4 * i + 3] + YX[(4 * i + 3) * 64 + lane] + dsum * bfhi(xw.y);
                    ow[i].x = pk2(o[0], o[1]); ow[i].y = pk2(o[2], o[3]); }
                LDS_WAIT(); asm volatile("" ::: "memory");
#pragma unroll
                for (int i = 0; i < 4; ++i) *(LAS v2u*)((LAS unsigned char*)YX + l31 * XSS + (8 * i + 4 * hl) * 2) = ow[i]; }
            lds_barrier();
            { const int t = tid >> 4, k = tid & 15, piece = (k >> 3) + 2 * ((k >> 2) & 1);
              const v4u w = *(const LAS v4u*)(lds + S4_YX + piece * 4096 + t * XSS + (k & 3) * 16);
              *(v4u*)(Y + (size_t)(row0 + tt * 32 + t) * 1024 + (8 * g + 2 * hp) * 64 + k * 8) = w; }
            lds_barrier();
        }
    }
}
}
#ifdef PROBE_IN
#define PIN_T0(bit) const bool pin_on_ = ((PROBE_IN) & (bit)) != 0; const long long pin_t0_ = wall_clock64();
#define PIN_T1(bit) if (pin_on_) { const long long pin_t1_ = wall_clock64(), pin_d_ = (pin_t1_ - pin_t0_) * (PROBE_MULT); while (wall_clock64() - pin_t1_ < pin_d_) __builtin_amdgcn_s_sleep(16); }
#else
#define PIN_T0(bit)
#define PIN_T1(bit)
#endif
__device__ __forceinline__ void phase_norm2_router(const Prm& p, int l, LAS unsigned char* lds, int wg, int nwg, int tid, int wave, int lane) {
    unsigned char* H = p.ws + WS_H; const bf16* WR = (const bf16*)(p.ws + WS_WRT);
    const int ntok = (l == 0) ? T_ALL : T_LAT;
    constexpr int HROW = 4096 + 16, CAP = 96, AST = 33;
    LAS unsigned char* hfL = lds; LAS float* part = (LAS float*)(lds + 66048); LAS float* tabL = (LAS float*)(lds + 66048 + 16384); LAS float* affL = (LAS float*)(lds + 66048 + 16384 + 32768);
    LAS int* lcnt = (LAS int*)(lds + 66048 + 16384 + 32768 + CAP * AST * 4);
    static_assert(66048 + 16384 + 32768 + CAP * AST * 4 + 256 <= LDSCTL_OFF, "norm2 LDS map");
    int* tok_e = (int*)(p.ws + WS_TOK); int* tok_pos = (int*)(p.ws + WS_TOK + TOKTAB); float* tok_gate = (float*)(p.ws + WS_TOK + 2 * TOKTAB);
    unsigned* cnt = (unsigned*)(p.ws + OFF_CNT) + l * 32 * 16;
    const int tpw = (ntok + nwg - 1) / nwg, t0 = wg * tpw, t1 = (t0 + tpw < ntok) ? t0 + tpw : ntok;
    if (t0 >= t1) return;
    const int vsA = t0 >= T_LAT ? 2 : (t0 >> 13);
    PIN_T0(1)
    {
        const int vsB = (t1 - 1) >= T_LAT ? 2 : ((t1 - 1) >> 13);
        for (int u = tid; u < 2 * 512; u += NWAVES * 64) { const int s = u >> 9, col = 4 * (u & 511); const float* md = (const float*)(p.ws + OFF_MOD) + (size_t)(l * 3 + (s ? vsB : vsA)) * MODW;
            const f32x4 g = *(const f32x4*)(p.norm_ffn + l * DM + col), s1 = modv4(md + 4 * DM + col), s0 = modv4(md + 3 * DM + col);
            *(LAS f32x4*)(tabL + s * 4096 + col) = g * (s1 + 1.f); *(LAS f32x4*)(tabL + s * 4096 + 2048 + col) = s0; }
    }
    lds_barrier();
    const int fr = lane & 15, fq = lane >> 4;
    bf16x8 b0[8], b1[8];
#pragma unroll
    for (int ks = 0; ks < 8; ++ks) { const int k0 = wave * 256 + ks * 32 + 8 * fq; b0[ks] = *(const bf16x8*)(WR + (size_t)fr * DM + k0); b1[ks] = *(const bf16x8*)(WR + (size_t)(16 + fr) * DM + k0); }
    PIN_T1(1)
#pragma unroll 1
    for (int c0 = t0; c0 < t1; c0 += CAP) {
        const int cend = (c0 + CAP < t1) ? c0 + CAP : t1, nn = cend - c0, ng = (nn + 15) >> 4;
        if (tid < 32) lcnt[tid] = 0;
        v2u rawA[2][8], rawB[2][8];
#define N2_ISSUE(buf, gi) do { _Pragma("unroll") for (int rr = 0; rr < 2; ++rr) { const int m_ = c0 + 16 * (gi) + wave * 2 + rr; \
            if ((gi) < ng && m_ < cend) { const bf16* wsrow = (m_ >= T_LAT) ? (const bf16*)(p.ws + WS_XC) + (size_t)(m_ - T_LAT) * DM : (const bf16*)(p.ws + WS_X) + (size_t)m_ * DM; \
                _Pragma("unroll") for (int j = 0; j < 8; ++j) buf[rr][j] = *(const v2u*)(wsrow + 256 * j + 4 * lane); } } } while (0)
#define N2_GROUP(buf, g, gnext) do { \
            f32x4 v[2][8]; \
            _Pragma("unroll") for (int rr = 0; rr < 2; ++rr) _Pragma("unroll") for (int j = 0; j < 8; ++j) v[rr][j] = bf4(buf[rr][j]); \
            N2_ISSUE(buf, gnext); \
            _Pragma("unroll") for (int rr = 0; rr < 2; ++rr) { const int r = wave * 2 + rr, m = c0 + 16 * (g) + r; \
                if (m < cend) { \
                    const float rstd = row_rstd(v[rr]); \
                    const int vs = m >= T_LAT ? 2 : (m >> 13); const LAS float* tab = tabL + (vs == vsA ? 0 : 4096); \
                    _Pragma("unroll") for (int j = 0; j < 8; ++j) { const int col = 256 * j + 4 * lane; const f32x4 A = *(const LAS f32x4*)(tab + col), S0 = *(const LAS f32x4*)(tab + 2048 + col); \
                        const f32x4 o = (v[rr][j] * rstd) * A + S0; \
                        v2u w; w.x = pk2(o[0], o[1]); w.y = pk2(o[2], o[3]); \
                        *(unsigned*)(H + (size_t)m * DM + col) = pack4f8(o[0], o[1], o[2], o[3]);     \
                        *(LAS v2u*)(hfL + r * HROW + col * 2) = w; } \
                } } \
            lds_barrier(); \
            {     \
                f32x4 a0 = {0.f, 0.f, 0.f, 0.f}, a1 = a0; \
                _Pragma("unroll") for (int ks = 0; ks < 8; ++ks) { const int k0 = wave * 256 + ks * 32 + 8 * fq; \
                    const bf16x8 af = *(const LAS bf16x8*)(hfL + fr * HROW + k0 * 2); \
                    a0 = __builtin_amdgcn_mfma_f32_16x16x32_bf16(af, b0[ks], a0, 0, 0, 0); a1 = __builtin_amdgcn_mfma_f32_16x16x32_bf16(af, b1[ks], a1, 0, 0, 0); } \
                _Pragma("unroll") for (int i = 0; i < 4; ++i) { part[(wave * 16 + 4 * fq + i) * 32 + fr] = a0[i]; part[(wave * 16 + 4 * fq + i) * 32 + 16 + fr] = a1[i]; } \
            } \
            lds_barrier(); \
            { float s_ = 0.f; \
              _Pragma("unroll") for (int w = 0; w < 8; ++w) s_ += part[w * 512 + tid]; \
              affL[(16 * (g) + (tid >> 5)) * AST + (tid & 31)] = sigmoid_f(s_); } \
        } while (0)
#pragma unroll
        for (int rr = 0; rr < 2; ++rr)
#pragma unroll
            for (int j = 0; j < 8; ++j) { rawA[rr][j] = (v2u){0u, 0u}; rawB[rr][j] = (v2u){0u, 0u}; }
        N2_ISSUE(rawA, 0); N2_ISSUE(rawB, 1);
        { PIN_T0(2)
#pragma unroll 1
        for (int g = 0; g < ng; g += 2) {
            N2_GROUP(rawA, g, g + 2);
            if (g + 1 < ng) N2_GROUP(rawB, g + 1, g + 3);
        }
        lds_barrier();
        PIN_T1(2) }
#undef N2_ISSUE
#undef N2_GROUP
        PIN_T0(4)
        const bool act = tid < nn; int e0 = 0, e1 = 0, r0 = 0, r1 = 0; float g0 = 0.f, g1 = 0.f;
        if (act) {
            const LAS float* af = affL + tid * AST;
            int bg = 0; float bs = -INFINITY;
#pragma unroll
            for (int g = 0; g < 4; ++g) { float t1_ = -INFINITY, t2_ = -INFINITY;
#pragma unroll
                for (int j = 0; j < 8; ++j) { const float s = af[8 * g + j] + p.router_bias[8 * g + j]; if (s > t1_) { t2_ = t1_; t1_ = s; } else if (s > t2_) t2_ = s; }
                const float gs = t1_ + t2_; if (gs > bs) { bs = gs; bg = g; } }
            float t1_ = -INFINITY, t2_ = -INFINITY; int i1 = 0, i2 = 0;
#pragma unroll
            for (int j = 0; j < 8; ++j) { const float s = af[8 * bg + j] + p.router_bias[8 * bg + j]; if (s > t1_) { t2_ = t1_; i2 = i1; t1_ = s; i1 = j; } else if (s > t2_) { t2_ = s; i2 = j; } }
            e0 = 8 * bg + i1; e1 = 8 * bg + i2; const float f0 = af[e0], f1 = af[e1], inv = 1.f / (f0 + f1); g0 = f0 * inv; g1 = f1 * inv;
            r0 = __hip_atomic_fetch_add(lcnt + e0, 1, __ATOMIC_RELAXED, __HIP_MEMORY_SCOPE_WORKGROUP); r1 = __hip_atomic_fetch_add(lcnt + e1, 1, __ATOMIC_RELAXED, __HIP_MEMORY_SCOPE_WORKGROUP);
        }
        lds_barrier();
        if (tid < 32) { const int c = lcnt[tid]; lcnt[32 + tid] = c ? (int)atomicAdd(cnt + tid * 16, (unsigned)c) : 0; }
        lds_barrier();
        if (act) { const int m = c0 + tid, p0 = lcnt[32 + e0] + r0, p1 = lcnt[32 + e1] + r1;
            int* list = (int*)(p.ws + WS_LIST); list[(size_t)e0 * LCAP + p0] = m; list[(size_t)e1 * LCAP + p1] = m;
            tok_e[2 * m] = e0; tok_e[2 * m + 1] = e1; tok_pos[2 * m] = p0; tok_pos[2 * m + 1] = p1; tok_gate[2 * m] = g0; tok_gate[2 * m + 1] = g1; }
        lds_barrier();
        PIN_T1(4)
    }
}
__device__ __forceinline__ void build_seg_tables(const Prm& p, int l, LAS unsigned char* lds, int tid) {
    LAS int* seg = (LAS int*)(lds + L_SEG); LAS int* cntL = (LAS int*)(lds + L_CNT); LAS int* blke = (LAS int*)(lds + L_BLKE); LAS int* nblkp = (LAS int*)(lds + L_NBLK);
    LAS int* incl = (LAS int*)(lds + L_INCL);
    const unsigned* cnt = (const unsigned*)(p.ws + OFF_CNT) + l * 32 * 16;
    __syncthreads();
    LAS int* pbL = (LAS int*)(lds + L_PB);
    if (tid < 32) { const int c = (int)cnt[tid * 16]; cntL[tid] = c; pbL[tid] = (c + 255) >> 8; }
    __syncthreads();
    if (tid < 32) { int inc = 0;
#pragma unroll
        for (int k = 0; k < 32; ++k) { int v = pbL[k]; asm volatile("" : "+v"(v)); inc += (k <= tid) ? v : 0; }
        seg[tid] = (inc - pbL[tid]) * 256; incl[tid] = inc; if (tid == 31) { seg[32] = inc * 256; *nblkp = inc; } }
    __syncthreads();
    if (tid < MAXBLK + 3) { int e = 0;
#pragma unroll
        for (int k = 0; k < 32; ++k) e += (incl[k] <= tid) ? 1 : 0;
        e = e < 31 ? e : 31; blke[tid] = e; ((LAS int*)(lds + L_BLKH))[tid] = (cntL[e] - 256 * (tid - (seg[e] >> 8)) <= 128) ? 1 : 0; }
    __syncthreads();
}
template <class Sched>
__device__ __forceinline__ void build_row_table(const Prm& p, const Sched& S, LAS unsigned char* lds, int tid) {
    const LAS int* seg = (const LAS int*)(lds + L_SEG); const LAS int* cntL = (const LAS int*)(lds + L_CNT); const LAS int* blke = (const LAS int*)(lds + L_BLKE);
    LAS unsigned* T = (LAS unsigned*)(lds + L_ROWT); const int* list = (const int*)(p.ws + WS_LIST);
#pragma unroll 1
    for (int i = 0; i < 8; ++i) { pg8::Unit u; if (!S.next(i, u)) break;
        const int e = blke[u.pm], base = (u.pm - (seg[e] >> 8)) * 256;
        if (tid < 256) { const int pos = base + tid; T[i * 256 + tid] = pos < cntL[e] ? (unsigned)WS_H + (unsigned)list[(size_t)e * LCAP + pos] * 2048u : ZERO_OFF; } }
    __syncthreads();
}
#ifndef SKIP_GU
#define SKIP_GU true
#endif
#ifndef SKIP_DN
#define SKIP_DN true
#endif
#ifndef STATES_ALL
#define STATES_ALL 1
#endif
#ifndef GRAB_WAIT
#define GRAB_WAIT 16
#endif
#ifndef NCONV
#define NCONV 16
#endif
constexpr int N_PHASES = 24;
__global__ void __launch_bounds__(NWAVES * 64, 2) mk_fwd(Prm p) {
    extern __shared__ __attribute__((aligned(16))) unsigned char lds_raw[];
    LAS unsigned char* lds = (LAS unsigned char*)lds_raw;
    const int tid0 = threadIdx.x, wave = __builtin_amdgcn_readfirstlane(tid0 >> 6);
#define OPQ int tid = tid0; asm volatile("" : "+v"(tid)); const int lane = tid & 63;
    const int G = gridDim.x, bx = blockIdx.x, vcu = (G % 8 == 0) ? (bx % 8) * (G / 8) + bx / 8 : bx;
    const int gw = vcu * NWAVES + wave, ngw = G * NWAVES;
    unsigned char* ws = p.ws;
    for (int u = tid0; u < (LDS_BYTES - LDSCTL_OFF) / 4; u += NWAVES * 64) ((LAS unsigned*)(lds + LDSCTL_OFF))[u] = 0u;
    __syncthreads();
#if MK_ONE_LAUNCH
    XcdBarrier bar = xcd_barrier_post((unsigned*)ws + CW_BAR, (volatile LAS unsigned*)(lds + L_BARW));
#define GRID_BAR() xcd_barrier(bar)
#define GRID_BAR_WD(ded) do { if (CONV_QUEUE) xcd_barrier_work(bar, p, lds, tid0, (ded) ? 16 : GRAB_WAIT); else xcd_barrier(bar); } while (0)
#define GRID_BAR_W() GRID_BAR_WD(false)
#else
#define GRID_BAR() do {} while (0)
#define GRID_BAR_W() do {} while (0)
#define GRID_BAR_WD(ded) do {} while (0)
#endif
#define WORKERS_(units) (((units) + (((units) + G - 1) / G) - 1) / (((units) + G - 1) / G))
#define WORKERS(units) ((CONV_QUEUE && MK_ONE_LAUNCH) ? ((WORKERS_(units) + 7) / 8 * 8 < G ? (WORKERS_(units) + 7) / 8 * 8 : G) : G)
#ifdef PROBE_SITES
#define PROBE_T0(bit) const bool pr_on_ = ((PROBE_SITES) & (bit)) != 0; const long long pr_t0_ = wall_clock64();
#define PROBE_T1(bit) if (pr_on_) { const long long pr_t1_ = wall_clock64(), pr_d_ = (pr_t1_ - pr_t0_) * (PROBE_MULT); while (wall_clock64() - pr_t1_ < pr_d_) __builtin_amdgcn_s_sleep(16); }
#else
#define PROBE_T0(bit)
#define PROBE_T1(bit)
#endif
    const int lo = p.ph_lo, hi = p.ph_hi;
#define IN(k) (lo <= (k) && (k) < hi)
#ifndef DUPMASK
#define DUPMASK 0
#endif
#define REPS(kind) for (int rep_ = 0; rep_ < (((DUPMASK) >> (kind)) & 1) + 1; ++rep_)
    if (IN(0)) REPS(0) { PROBE_T0(1 << (0)) OPQ phase_prologue(p, lds, gw, ngw, wave, lane, rep_ == 0); GRID_BAR(); PROBE_T1(1 << (0)) }
    for (int l = 0; l < 2; ++l) {
        const int pb = 1 + 11 * l;
        if (IN(pb + 0)) { PROBE_T0(1 << (pb + 0)) OPQ if (l > 0) { if (CONV_QUEUE) { PROBE_T0(1 << 25) queue_drain(p, lds, tid, (unsigned)(Q_L1 + NP_PROJ)); PROBE_T1(1 << 25) }     build_seg_tables(p, l - 1, lds, tid); row_stream<true, false, false>(p, l, l - 1, T_ALL, gw, ngw, tid, lane, lds, (const LAS int*)(lds + L_SEG)); } else row_stream<false, false, true>(p, l, 0, T_ALL, gw, ngw, tid, lane, lds, (const LAS int*)(lds + L_SEG)); GRID_BAR_W(); PROBE_T1(1 << (pb + 0)) }
        if (IN(pb + 1)) REPS(2) { PROBE_T0(1 << (pb + 1))
            pg8::Gemm g{(const pg8::bf16_t*)(ws + WS_H), (const pg8::bf16_t*)(ws + WS_WIN + (size_t)l * NINP * DM * (F8_INPROJ ? 1 : 2)), T_ALL, NINP, F8_INPROJ ? DM / 2 : DM};
            const int Ge = WORKERS((T_ALL / 256) * (NINP / 256));
            pg8::StaticOrder S; S.init(T_ALL, NINP, Ge, bx);
            pg8::EpiInProj E{(pg8::bf16_t*)(ws + WS_U), NINP, (const float*)(ws + WS_ROPE), C_QB / 256, C_VB / 256, T_LAT, F8_INPROJ ? 1.f / W8_SCALE : 1.f};
            if (bx < Ge) pg8::gemm_phase<pg8::EpiInProj, pg8::StaticOrder, true, true, F8_INPROJ != 0>(lds, g, S, E);
            GRID_BAR_WD(bx >= Ge);
            PROBE_T1(1 << (pb + 1))
        }
        if (IN(pb + 2)) REPS(3) { PROBE_T0(1 << (pb + 2)) OPQ
            const bool cx = (l == 0) && G > 64; const int cgw = cx ? (bx < 16 ? (1 << 30) : (bx - 16) * NWAVES + wave) : gw, cngw = cx ? (G - 16) * NWAVES : ngw;
            if ((bx >> 3) & 1) { att::phase_attn(p, l, lds, bx, G, tid); phase_conv(p, l, cgw, cngw, lane); } else { phase_conv(p, l, cgw, cngw, lane); att::phase_attn(p, l, lds, bx, G, tid); } GRID_BAR_W(); PROBE_T1(1 << (pb + 2)) }
        if (IN(pb + 3)) REPS(4) { PROBE_T0(1 << (pb + 3)) OPQ const int Ge = STATES_ALL ? G : WORKERS(2 * ssd::NCH * 4); if (vcu < Ge) ssd::phase_states(p, l, lds, vcu, Ge, tid); GRID_BAR_WD(vcu >= Ge);       PROBE_T1(1 << (pb + 3)) }
        if (IN(pb + 4)) REPS(5) { PROBE_T0(1 << (pb + 4)) OPQ ssd::phase_scan(p, bx * (NWAVES * 64) + tid, G * NWAVES * 64); GRID_BAR_W(); PROBE_T1(1 << (pb + 4)) }
        if (IN(pb + 5)) REPS(6) { PROBE_T0(1 << (pb + 5)) OPQ const int Ge = WORKERS(2 * (ssd::NCH - (l == 0 ? 0 : 2)) * 8); if (vcu < Ge) ssd::phase_ssd_out(p, l, lds, vcu, Ge, tid); GRID_BAR_WD(vcu >= Ge); PROBE_T1(1 << (pb + 5)) }
        if (IN(pb + 6)) REPS(7) { PROBE_T0(1 << (pb + 6)) OPQ phase_gnorm(p, l, gw, ngw, lane); GRID_BAR_W(); PROBE_T1(1 << (pb + 6)) }
        if (IN(pb + 7)) { PROBE_T0(1 << (pb + 7))
            const int M = (l == 0) ? T_ALL : T_LAT;
            pg8::Gemm g{(const pg8::bf16_t*)(ws + WS_H), (const pg8::bf16_t*)(ws + WS_WOUT + (size_t)l * DM * DM * (F8_OUTPROJ ? 1 : 2)), M, DM, F8_OUTPROJ ? DM / 2 : DM};
            const int Ge = WORKERS((M / 256) * (DM / 256));
            pg8::StaticOrder S; S.init(M, DM, Ge, bx);
            pg8::EpiRes E{(l == 0) ? (const void*)p.x : (const void*)(ws + WS_X), (pg8::bf16_t*)(ws + WS_X), (l == 0) ? (const void*)p.ctx : (const void*)(ws + WS_XC), (pg8::bf16_t*)(ws + WS_XC),
                          (const float*)(ws + OFF_MOD) + (size_t)l * 3 * MODW + 2 * DM, DM, T_LAT, MODW, F8_OUTPROJ ? 1.f / (W8_SCALE * MIX_SCALE) : 1.f, l == 0 ? 1 : 0};
            if (bx < Ge) pg8::gemm_phase<pg8::EpiRes, pg8::StaticOrder, true, true, F8_OUTPROJ != 0>(lds, g, S, E);
            GRID_BAR_WD(bx >= Ge);
            PROBE_T1(1 << (pb + 7))
        }
        if (IN(pb + 8)) { PROBE_T0(1 << (pb + 8)) OPQ phase_norm2_router(p, l, lds, bx, G, tid, wave, lane); GRID_BAR_W(); PROBE_T1(1 << (pb + 8)) }
        if (IN(pb + 9) && CONV_QUEUE && (l == 1 || Q_L0EXP)) { OPQ PROBE_T0(l == 1 ? (1 << 26) : (1 << 24)) queue_drain(p, lds, tid, (unsigned)(l == 1 ? Q_TOTAL : Q_L0)); GRID_BAR(); PROBE_T1(l == 1 ? (1 << 26) : (1 << 24)) }
        if (IN(pb + 9)) REPS(11) { PROBE_T0(1 << (pb + 9))
            OPQ build_seg_tables(p, l, lds, tid);
            const int nblk = __builtin_amdgcn_readfirstlane(*(const LAS int*)(lds + L_NBLK));
            pg8::Gemm g{(const pg8::bf16_t*)ws, (const pg8::bf16_t*)(ws + WS_WGU + (size_t)l * 32 * 2048 * 2048), nblk * 256, 2048, DM / 2};
            pg8::GroupedOrderT<SKIP_GU, true> S{G, vcu, nblk, (const LAS int*)(lds + L_BLKE), (const LAS int*)(lds + L_BLKH), (long)2048 * 2048, (const LAS unsigned*)(lds + L_ROWT)};
            build_row_table(p, S, lds, tid);
            pg8::EpiGateUp E{ws + WS_ACT, DFF, 1.f / W8_SCALE};
            pg8::gemm_phase<pg8::EpiGateUp, pg8::GroupedOrderT<SKIP_GU, true>, true, true, true>(lds, g, S, E);
            GRID_BAR_W();
            PROBE_T1(1 << (pb + 9))
        }
        if (IN(pb + 10)) REPS(12) { PROBE_T0(1 << (pb + 10))
            OPQ if (CONV_QUEUE && Q_L0EXP && l == 0) queue_drain(p, lds, tid, (unsigned)Q_L1);
            build_seg_tables(p, l, lds, tid);
            const int nblk = __builtin_amdgcn_readfirstlane(*(const LAS int*)(lds + L_NBLK));
            pg8::Gemm g{(const pg8::bf16_t*)(ws + WS_ACT), (const pg8::bf16_t*)(ws + WS_WDN + (size_t)l * 32 * 2048 * 1024), nblk * 256, DM, DFF / 2};
            pg8::GroupedOrderT<SKIP_DN> S{G, vcu, nblk, (const LAS int*)(lds + L_BLKE), (const LAS int*)(lds + L_BLKH), (long)2048 * 1024, nullptr};
            pg8::EpiF8 E{ws + WS_YB, DM, Y8_SCALE / W8_SCALE};
            pg8::gemm_phase<pg8::EpiF8, pg8::GroupedOrderT<SKIP_DN>, true, true, true>(lds, g, S, E);
            GRID_BAR_W();
            PROBE_T1(1 << (pb + 10))
        }
    }
    if (IN(23)) { PROBE_T0(1 << (23)) OPQ build_seg_tables(p, 1, lds, tid); row_stream<true, true, false>(p, 1, 1, T_LAT, gw, ngw, tid, lane, lds, (const LAS int*)(lds + L_SEG)); PROBE_T1(1 << (23)) }
#undef IN
}

extern "C" void kernel_launch(void* const* d_in, const int* in_sizes, int n_in, void* d_out, int out_size, void* d_ws, size_t ws_size, hipStream_t stream) {
    static int grid = 0;
    if (grid == 0) {
        if (n_in != 24 || in_sizes[0] != T_LAT * DM || out_size != T_LAT * DM || ws_size < WS_END) {
            fprintf(stderr, "kernel_launch: unexpected shapes: n_in %d in0 %d out %d ws %zu (need %zu)\n", n_in, n_in > 0 ? in_sizes[0] : -1, out_size, ws_size, (size_t)WS_END); grid = -1; return; }
        int dev = 0, cus = 0, per_cu = 0;
        if (hipGetDevice(&dev) != hipSuccess || hipDeviceGetAttribute(&cus, hipDeviceAttributeMultiprocessorCount, dev) != hipSuccess) { grid = -1; return; }
        if (hipFuncSetAttribute((const void*)mk_fwd, hipFuncAttributeMaxDynamicSharedMemorySize, LDS_BYTES) != hipSuccess) { fprintf(stderr, "kernel_launch: hipFuncSetAttribute failed\n"); grid = -1; return; }
        if (hipOccupancyMaxActiveBlocksPerMultiprocessor(&per_cu, (const void*)mk_fwd, NWAVES * 64, LDS_BYTES) != hipSuccess || per_cu < 1) {
            fprintf(stderr, "kernel_launch: occupancy query reports %d blocks per CU\n", per_cu); }
        (void)hipGetLastError();
        grid = cus;
    }
    if (grid < 0) return;
    if (hipMemsetAsync((char*)d_ws + WS_CTL, 0, CTL_ZERO_BYTES, stream) != hipSuccess) { fprintf(stderr, "kernel_launch: memset failed\n"); return; }
    Prm p{};
    p.x = (const float*)d_in[0]; p.c = (const float*)d_in[1]; p.ctx = (const float*)d_in[2]; p.c_ctx = (const float*)d_in[3]; p.w_ada = (const float*)d_in[4]; p.b_ada = (const float*)d_in[5];
    p.norm_mix = (const float*)d_in[6]; p.norm_ffn = (const float*)d_in[7]; p.norm_final = (const float*)d_in[8]; p.w_in = (const float*)d_in[9]; p.w_out = (const float*)d_in[10];
    p.na_rpb = (const float*)d_in[11]; p.wa_sink = (const float*)d_in[12]; p.conv_w = (const float*)d_in[13]; p.conv_b = (const float*)d_in[14]; p.a_log = (const float*)d_in[15];
    p.dt_bias = (const float*)d_in[16]; p.d_skip = (const float*)d_in[17]; p.ssd_norm = (const float*)d_in[18]; p.w_router = (const float*)d_in[19]; p.router_bias = (const float*)d_in[20];
    p.w_gate = (const float*)d_in[21]; p.w_up = (const float*)d_in[22]; p.w_down = (const float*)d_in[23];
    p.out = (float*)d_out; p.ws = (unsigned char*)d_ws;
#if MK_ONE_LAUNCH
    p.ph_lo = 0; p.ph_hi = N_PHASES;
    hipLaunchKernelGGL(mk_fwd, dim3(grid), dim3(NWAVES * 64), LDS_BYTES, stream, p);
#else
    for (int ph = 0; ph < N_PHASES; ++ph) { p.ph_lo = ph; p.ph_hi = ph + 1; hipLaunchKernelGGL(mk_fwd, dim3(grid), dim3(NWAVES * 64), LDS_BYTES, stream, p); }
#endif
    const hipError_t le = hipPeekAtLastError();
    if (le != hipSuccess) fprintf(stderr, "kernel_launch: launch failed: %s\n", hipGetErrorName(le));
}
```
